# Optimizing an MI355X kernel written in HIP

```python
import math
import jax, jax.numpy as jnp
from jax import lax
import numpy as np

D_MODEL = 1024
BATCH = 4
SEQ = 4096
DEPTH = 1

CTX_LEN = 256
GRID_W = 64
ROPE_BASE = 10000.0
NORM_EPS = 1e-6
Q_BLOCK = 128

MLA_HEADS = 8
MLA_NOPE = 64
MLA_ROPE = 32
MLA_V = 64
MLA_Q_RANK = 256
MLA_KV_RANK = 128
DIFF_HEADS = 4
DIFF_QK = 64
DIFF_V = 2 * DIFF_QK

MIX_WIDTH = MLA_HEADS * MLA_V + DIFF_HEADS * DIFF_V
IN_SPLITS = (
    MLA_Q_RANK,
    MLA_Q_RANK + MLA_KV_RANK,
    MLA_Q_RANK + MLA_KV_RANK + MLA_ROPE,
    MLA_Q_RANK + MLA_KV_RANK + MLA_ROPE + DIFF_HEADS * 2 * DIFF_QK,
    MLA_Q_RANK + MLA_KV_RANK + MLA_ROPE + 2 * DIFF_HEADS * 2 * DIFF_QK,
)
IN_COLS = IN_SPLITS[-1] + DIFF_HEADS * DIFF_V

N_EXPERTS = 256
TOP_K = 8
N_GROUPS = 8
TOPK_GROUPS = 4
EXPERT_FF = 256
SHARED_FF = 256
ROUTED_SCALE = 2.5
MOE_BLOCK = 128

kernel_name = 'hybrid_mla_diffattn_moe_dit'


def _rms(x, g):
    xf = x.astype(jnp.float32)
    y = xf * lax.rsqrt(jnp.mean(xf * xf, axis=-1, keepdims=True) + NORM_EPS)
    return (y * g.astype(jnp.float32)).astype(x.dtype)


def _modulate(h, shift, scale):
    return h * (1 + scale) + shift


def _axial_tables(n_ctx, rows, rot_dim):
    n_freq = rot_dim // 4
    inv = ROPE_BASE ** (-(jnp.arange(n_freq, dtype=jnp.float32) / n_freq))
    row = jnp.repeat(jnp.arange(rows, dtype=jnp.float32), GRID_W)
    col = jnp.tile(jnp.arange(GRID_W, dtype=jnp.float32), rows)
    theta = jnp.concatenate([row[:, None] * inv, col[:, None] * inv], axis=-1)
    theta = jnp.concatenate([jnp.zeros((n_ctx, 2 * n_freq), jnp.float32), theta], axis=0)
    return jnp.cos(theta), jnp.sin(theta)


def _rope(x, cos, sin):
    half = x.shape[-1] // 2
    x1, x2 = x[..., :half], x[..., half:]
    cos = cos.astype(x.dtype)
    sin = sin.astype(x.dtype)
    return jnp.concatenate([x1 * cos - x2 * sin, x1 * sin + x2 * cos], axis=-1)


def _sweep(fn, qs):
    def to_blocks(q):
        b, h, s, d = q.shape
        return q.reshape(b, h, s // Q_BLOCK, Q_BLOCK, d).transpose(2, 0, 1, 3, 4)
    out = lax.map(lambda args: fn(*args), tuple(to_blocks(q) for q in qs))
    nb, b, h, qb, dv = out.shape
    return out.transpose(1, 2, 0, 3, 4).reshape(b, h, nb * qb, dv)


def _attend(q, k, v, scale):
    s = jnp.einsum('bhqd,bhkd->bhqk', q, k, preferred_element_type=jnp.float32) * scale
    p = jax.nn.softmax(s, axis=-1)
    return jnp.einsum('bhqk,bhkd->bhqd', p.astype(v.dtype), v)


def _diff_attend(q1, q2, k1, k2, v, lam, scale):
    s1 = jnp.einsum('bhqd,bhkd->bhqk', q1, k1, preferred_element_type=jnp.float32) * scale
    s2 = jnp.einsum('bhqd,bhkd->bhqk', q2, k2, preferred_element_type=jnp.float32) * scale
    p = jax.nn.softmax(s1, axis=-1) - lam * jax.nn.softmax(s2, axis=-1)
    return jnp.einsum('bhqk,bhkd->bhqd', p.astype(v.dtype), v)


def _merge_heads(o):
    b, h, s, d = o.shape
    return o.transpose(0, 2, 1, 3).reshape(b, s, h * d)


def _mixer(h, n_ctx, lam_init, w_in, g_q, w_uq, g_kv, w_ukv, lq1, lk1, lq2, lk2, g_sub, w_out,
           cos_m, sin_m, cos_d, sin_d, with_ctx):
    b, n, _ = h.shape
    p = h @ w_in
    c_q, c_kv, k_r, dq, dk, dv = jnp.split(p, IN_SPLITS, axis=-1)

    q_m = (_rms(c_q, g_q) @ w_uq).reshape(b, n, MLA_HEADS, MLA_NOPE + MLA_ROPE).transpose(0, 2, 1, 3)
    q_m = jnp.concatenate([q_m[..., :MLA_NOPE], _rope(q_m[..., MLA_NOPE:], cos_m, sin_m)], axis=-1)
    kv = (_rms(c_kv, g_kv) @ w_ukv).reshape(b, n, MLA_HEADS, MLA_NOPE + MLA_V).transpose(0, 2, 1, 3)
    k_nope, v_m = kv[..., :MLA_NOPE], kv[..., MLA_NOPE:]
    k_r = _rope(k_r, cos_m, sin_m)
    k_m = jnp.concatenate([k_nope, jnp.broadcast_to(k_r[:, None], (b, MLA_HEADS, n, MLA_ROPE))], axis=-1)
    scale_m = 1.0 / math.sqrt(MLA_NOPE + MLA_ROPE)

    dq = _rope(dq.reshape(b, n, DIFF_HEADS, 2, DIFF_QK).transpose(0, 2, 3, 1, 4), cos_d, sin_d)
    dk = _rope(dk.reshape(b, n, DIFF_HEADS, 2, DIFF_QK).transpose(0, 2, 3, 1, 4), cos_d, sin_d)
    q1, q2 = dq[:, :, 0], dq[:, :, 1]
    k1, k2 = dk[:, :, 0], dk[:, :, 1]
    v_d = dv.reshape(b, n, DIFF_HEADS, DIFF_V).transpose(0, 2, 1, 3)
    lam = (jnp.exp(jnp.sum(lq1.astype(jnp.float32) * lk1.astype(jnp.float32)))
           - jnp.exp(jnp.sum(lq2.astype(jnp.float32) * lk2.astype(jnp.float32))) + lam_init)
    scale_d = 1.0 / math.sqrt(DIFF_QK)

    def combine(o_m, o_d):
        o_d = _rms(o_d, g_sub) * (1.0 - lam_init)
        return jnp.concatenate([_merge_heads(o_m), _merge_heads(o_d)], axis=-1) @ w_out

    o_m_lat = _sweep(lambda qb: _attend(qb, k_m, v_m, scale_m), (q_m[:, :, n_ctx:],))
    o_d_lat = _sweep(lambda a, c: _diff_attend(a, c, k1, k2, v_d, lam, scale_d),
                     (q1[:, :, n_ctx:], q2[:, :, n_ctx:]))
    y_lat = combine(o_m_lat, o_d_lat)
    y_ctx = None
    if with_ctx:
        o_m_ctx = _attend(q_m[:, :, :n_ctx], k_m[:, :, :n_ctx], v_m[:, :, :n_ctx], scale_m)
        o_d_ctx = _diff_attend(q1[:, :, :n_ctx], q2[:, :, :n_ctx], k1[:, :, :n_ctx], k2[:, :, :n_ctx],
                               v_d[:, :, :n_ctx], lam, scale_d)
        y_ctx = combine(o_m_ctx, o_d_ctx)
    return y_lat, y_ctx


def _swiglu(x, w_gate, w_up, w_down):
    return (jax.nn.silu(x @ w_gate) * (x @ w_up)) @ w_down


def _grouped_experts(hf, e_idx, w, w1, w3, w2):
    t, k = e_idx.shape
    n_assign = t * k
    n_exp = w1.shape[0]
    n_blocks = -(-(n_assign + n_exp * (MOE_BLOCK - 1)) // MOE_BLOCK)
    n_slots = n_blocks * MOE_BLOCK
    e_flat = e_idx.reshape(n_assign)
    tok_flat = jnp.repeat(jnp.arange(t, dtype=jnp.int32), k)
    w_flat = w.reshape(n_assign)
    order = jnp.argsort(e_flat)
    e_sorted = e_flat[order]
    counts = jnp.bincount(e_flat, length=n_exp)
    start = jnp.cumsum(counts) - counts
    padded = (counts + MOE_BLOCK - 1) // MOE_BLOCK * MOE_BLOCK
    pend = jnp.cumsum(padded)
    pstart = pend - padded
    dest = pstart[e_sorted] + (jnp.arange(n_assign, dtype=jnp.int32) - start[e_sorted])
    slot_tok = jnp.zeros((n_slots,), jnp.int32).at[dest].set(tok_flat[order])
    slot_w = jnp.zeros((n_slots,), w.dtype).at[dest].set(w_flat[order])
    blk_e = jnp.minimum(jnp.searchsorted(pend, jnp.arange(n_blocks, dtype=pend.dtype) * MOE_BLOCK, side='right'),
                        n_exp - 1)

    def block(args):
        tok, wt, e = args
        return _swiglu(hf[tok], w1[e], w3[e], w2[e]) * wt[:, None]

    y = lax.map(block, (slot_tok.reshape(n_blocks, MOE_BLOCK), slot_w.reshape(n_blocks, MOE_BLOCK), blk_e))
    return jax.ops.segment_sum(y.reshape(n_slots, -1), slot_tok, num_segments=t)


def _moe(h, w_r, b_r, w1, w3, w2, ws1, ws3, ws2):
    b, n, d = h.shape
    t = b * n
    hf = h.reshape(t, d)
    s = jax.nn.sigmoid(jnp.einsum('td,de->te', hf, w_r, preferred_element_type=jnp.float32))
    s_sel = s + b_r.astype(jnp.float32)
    per_group = N_EXPERTS // N_GROUPS
    grp_score = lax.top_k(s_sel.reshape(t, N_GROUPS, per_group), 2)[0].sum(-1)
    _, g_idx = lax.top_k(grp_score, TOPK_GROUPS)
    g_mask = jax.nn.one_hot(g_idx, N_GROUPS, dtype=jnp.float32).sum(1) > 0
    e_mask = jnp.repeat(g_mask, per_group, axis=1)
    _, e_idx = lax.top_k(jnp.where(e_mask, s_sel, -jnp.inf), TOP_K)
    wts = jnp.take_along_axis(s, e_idx, axis=1)
    wts = wts / jnp.sum(wts, axis=-1, keepdims=True) * ROUTED_SCALE
    routed = _grouped_experts(hf, e_idx, wts.astype(h.dtype), w1, w3, w2)
    shared = _swiglu(hf, ws1, ws3, ws2)
    return (routed + shared).reshape(b, n, d)


def setup_inputs(seed: int = 0) -> dict:
    key = jax.random.key(seed)
    ks = jax.random.split(key, 32)
    L, D = DEPTH, D_MODEL

    def nrm(k, shape, scale):
        return jax.random.normal(k, shape, jnp.float32) * scale

    return {
        'x': nrm(ks[0], (BATCH, SEQ, D), 1.0),
        'c': nrm(ks[1], (BATCH, D), 1.0),
        'ctx': nrm(ks[2], (BATCH, CTX_LEN, D), 1.0),
        'c_ctx': nrm(ks[3], (D,), 1.0),
        'w_mod': nrm(ks[4], (L, D, 6 * D), 0.5 * D ** -0.5),
        'b_mod': nrm(ks[5], (L, 6 * D), 0.02),
        'g_attn': 1.0 + nrm(ks[6], (L, D), 0.02),
        'g_ffn': 1.0 + nrm(ks[7], (L, D), 0.02),
        'w_in': nrm(ks[8], (L, D, IN_COLS), D ** -0.5),
        'g_q_lat': 1.0 + nrm(ks[9], (L, MLA_Q_RANK), 0.02),
        'w_uq': nrm(ks[10], (L, MLA_Q_RANK, MLA_HEADS * (MLA_NOPE + MLA_ROPE)), MLA_Q_RANK ** -0.5),
        'g_kv_lat': 1.0 + nrm(ks[11], (L, MLA_KV_RANK), 0.02),
        'w_ukv': nrm(ks[12], (L, MLA_KV_RANK, MLA_HEADS * (MLA_NOPE + MLA_V)), MLA_KV_RANK ** -0.5),
        'lam_q1': nrm(ks[13], (L, DIFF_QK), 0.1),
        'lam_k1': nrm(ks[14], (L, DIFF_QK), 0.1),
        'lam_q2': nrm(ks[15], (L, DIFF_QK), 0.1),
        'lam_k2': nrm(ks[16], (L, DIFF_QK), 0.1),
        'g_subln': 1.0 + nrm(ks[17], (L, DIFF_V), 0.02),
        'w_out': nrm(ks[18], (L, MIX_WIDTH, D), MIX_WIDTH ** -0.5),
        'w_router': nrm(ks[19], (L, D, N_EXPERTS), D ** -0.5),
        'router_bias': nrm(ks[20], (L, N_EXPERTS), 0.01),
        'w1': nrm(ks[21], (L, N_EXPERTS, D, EXPERT_FF), D ** -0.5),
        'w3': nrm(ks[22], (L, N_EXPERTS, D, EXPERT_FF), D ** -0.5),
        'w2': nrm(ks[23], (L, N_EXPERTS, EXPERT_FF, D), EXPERT_FF ** -0.5),
        'ws1': nrm(ks[24], (L, D, SHARED_FF), D ** -0.5),
        'ws3': nrm(ks[25], (L, D, SHARED_FF), D ** -0.5),
        'ws2': nrm(ks[26], (L, SHARED_FF, D), SHARED_FF ** -0.5),
        'g_final': 1.0 + nrm(ks[27], (D,), 0.02),
    }


def reference(x, c, ctx, c_ctx, w_mod, b_mod, g_attn, g_ffn, w_in, g_q_lat, w_uq, g_kv_lat, w_ukv,
              lam_q1, lam_k1, lam_q2, lam_k2, g_subln, w_out, w_router, router_bias, w1, w3, w2,
              ws1, ws3, ws2, g_final):
    n_lat = x.shape[1]
    n_ctx = ctx.shape[1]
    rows = n_lat // GRID_W
    cos_m, sin_m = _axial_tables(n_ctx, rows, MLA_ROPE)
    cos_d, sin_d = _axial_tables(n_ctx, rows, DIFF_QK)
    xc = ctx
    for l in range(DEPTH):
        with_ctx = l < DEPTH - 1
        lam_init = 0.8 - 0.6 * math.exp(-0.3 * l)
        mod_x = jnp.split(jax.nn.silu(c) @ w_mod[l] + b_mod[l], 6, axis=-1)
        mod_c = jnp.split(jax.nn.silu(c_ctx) @ w_mod[l] + b_mod[l], 6, axis=-1)
        sh1, sc1, gt1, sh2, sc2, gt2 = [m[:, None, :] for m in mod_x]
        csh1, csc1, cgt1, csh2, csc2, cgt2 = mod_c

        h = jnp.concatenate([_modulate(_rms(xc, g_attn[l]), csh1, csc1),
                             _modulate(_rms(x, g_attn[l]), sh1, sc1)], axis=1)
        y_lat, y_ctx = _mixer(h, n_ctx, lam_init, w_in[l], g_q_lat[l], w_uq[l], g_kv_lat[l], w_ukv[l],
                              lam_q1[l], lam_k1[l], lam_q2[l], lam_k2[l], g_subln[l], w_out[l],
                              cos_m, sin_m, cos_d, sin_d, with_ctx)
        x = x + gt1 * y_lat
        x = x + gt2 * _moe(_modulate(_rms(x, g_ffn[l]), sh2, sc2), w_router[l], router_bias[l],
                           w1[l], w3[l], w2[l], ws1[l], ws3[l], ws2[l])
        if with_ctx:
            xc = xc + cgt1 * y_ctx
            xc = xc + cgt2 * _moe(_modulate(_rms(xc, g_ffn[l]), csh2, csc2), w_router[l], router_bias[l],
                                  w1[l], w3[l], w2[l], ws1[l], ws3[l], ws2[l])
    return _rms(x, g_final)
```

```cpp
#include <hip/hip_runtime.h>
#include <cstdio>
#include <cstdint>

constexpr int NB = 4, SEQ = 4096, NCTX = 256, NTOK = SEQ + NCTX, DM = 1024;
constexpr int MALL = NB * NTOK;
constexpr int MLAT = NB * SEQ;
constexpr int IN_COLS = 1952, NP1 = 2048;
constexpr int NEXP = 256, TOPK = 8, EFF = 256;
constexpr int NSLOT = MLAT * TOPK + MLAT;
constexpr float EPS = 1e-6f;
constexpr float LAM_INIT = 0.2f;

typedef unsigned short bf16;
__device__ __forceinline__ unsigned f2bf(float f) { unsigned u = __builtin_bit_cast(unsigned, f); return (u + 0x7fffu + ((u >> 16) & 1u)) >> 16; }
__device__ __forceinline__ float bf2f(bf16 h) { return __builtin_bit_cast(float, (unsigned)h << 16); }

constexpr size_t MiB = 1u << 20;
constexpr size_t WS_CTL = 0;
constexpr size_t WS_MOD = 3 * MiB;
constexpr size_t WS_TAB = 3 * MiB + 512 * 1024;
constexpr size_t WS_X1 = 402 * MiB;
constexpr size_t WS_SSQ = 466 * MiB;
constexpr size_t WS_EIDX = 467 * MiB;
constexpr size_t WS_EW = WS_EIDX + 512 * 1024;
constexpr size_t WS_ERANK = 468 * MiB;
constexpr size_t WS_SLOTOF = WS_ERANK + 512 * 1024;
constexpr size_t WS_SLOTTOK = 469 * MiB;
constexpr size_t WS_SLOTW = 470 * MiB;
constexpr size_t WS_OFF = 471 * MiB;
constexpr size_t WS_XN = 472 * MiB;
constexpr size_t WS_P1 = 506 * MiB;
constexpr size_t WS_QM = 574 * MiB;
constexpr size_t WS_KVM = 600 * MiB;
constexpr size_t WS_MIX = 634 * MiB;
constexpr size_t WS_OS = 666 * MiB;
constexpr size_t WS_TMP = 730 * MiB;
constexpr size_t WS_H2 = 472 * MiB;
constexpr size_t WS_H2F = 504 * MiB;
constexpr size_t WS_LOG = 568 * MiB;
constexpr size_t WS_ACT = 584 * MiB;
constexpr size_t WS_Y = 656 * MiB;
constexpr size_t WS_END = 944 * MiB;
constexpr int CW_COUNT = 1024;

__host__ __device__ __forceinline__ int perm32_log(int p) { return 16 * ((p >> 2) & 1) + 4 * (p >> 3) + (p & 3); }
__host__ __device__ __forceinline__ int perm64_log(int p) { return 32 * ((p >> 2) & 1) + 16 * (p >> 5) + 4 * ((p >> 3) & 3) + (p & 3); }
__host__ __device__ __forceinline__ int p1_logical(int p) {
    if (p < 384) return p;
    if (p < 416) return 384 + perm32_log(p - 384);
    if (p < 512) return -1;
    if (p < 1024) { int q = p - 512; return 416 + (q & ~63) + perm64_log(q & 63); }
    if (p < 1536) { int q = p - 1024; return 928 + (q & ~63) + perm64_log(q & 63); }
    return 1440 + (p - 1536);
}
__host__ __device__ __forceinline__ int qm_logical(int p) { int h = p / 96, r = p % 96; return h * 96 + (r < 64 ? r : 64 + perm32_log(r - 64)); }

struct Ptrs {
    const float* in[28]; float* out; unsigned char* ws;
};

__global__ void k_mod(Ptrs P) {
    int idx = blockIdx.x * 256 + threadIdx.x;
    if (idx < 5 * 6144) {
        int r = idx / 6144, j = idx % 6144;
        const float* cv = r < 4 ? P.in[1] + r * DM : P.in[3];
        const float* W = P.in[4];
        float acc = 0.f;
        for (int k = 0; k < DM; ++k) { float c = cv[k]; float s = c / (1.f + __expf(-c)); acc += s * W[(size_t)k * 6144 + j]; }
        ((float*)(P.ws + WS_MOD))[idx] = acc + P.in[5][j];
    }
    if (idx < 64 * 16) {
        int v = idx / 16, f = idx % 16;
        float inv = exp2f(-(float)f / 16.f * 13.287712379549449f);
        float th = (float)v * inv;
        float2 cs; cs.x = cosf(th); cs.y = sinf(th);
        ((float2*)(P.ws + WS_TAB))[idx] = cs;
    }
    if (idx < 64 * 8) {
        int v = idx / 8, f = idx % 8;
        float inv = exp2f(-(float)f / 8.f * 13.287712379549449f);
        float th = (float)v * inv;
        float2 cs; cs.x = cosf(th); cs.y = sinf(th);
        ((float2*)(P.ws + WS_TAB) + 1024)[idx] = cs;
    }
}

__global__ void k_xn(Ptrs P) {
    int r = blockIdx.x, b = r / NTOK, n = r % NTOK;
    const float* src = n < NCTX ? P.in[2] + ((size_t)b * NCTX + n) * DM : P.in[0] + ((size_t)b * SEQ + (n - NCTX)) * DM;
    const float* mod = (const float*)(P.ws + WS_MOD) + (n < NCTX ? 4 : b) * 6144;
    __shared__ float red[256];
    float v[4]; float ss = 0.f;
    for (int i = 0; i < 4; ++i) { v[i] = src[threadIdx.x + 256 * i]; ss += v[i] * v[i]; }
    red[threadIdx.x] = ss; __syncthreads();
    for (int o = 128; o > 0; o >>= 1) { if (threadIdx.x < o) red[threadIdx.x] += red[threadIdx.x + o]; __syncthreads(); }
    float rs = rsqrtf(red[0] / DM + EPS);
    bf16* dst = (bf16*)(P.ws + WS_XN) + (size_t)r * DM;
    for (int i = 0; i < 4; ++i) { int j = threadIdx.x + 256 * i; float y = v[i] * rs * P.in[6][j]; y = y * (1.f + mod[1024 + j]) + mod[j]; dst[j] = (bf16)f2bf(y); }
}

template <class F> __global__ __launch_bounds__(256) void k_gemm(F f, int N, int K) {
    __shared__ float As[16][65], Bs[16][65];
    const int z = blockIdx.z, bm = blockIdx.y * 64, bn = blockIdx.x * 64, tid = threadIdx.x, tx = tid & 15, ty = tid >> 4;
    const int rows = f.rows(z); if (bm >= rows) return;
    float acc[4][4] = {};
    for (int k0 = 0; k0 < K; k0 += 16) {
        for (int i = tid; i < 1024; i += 256) { int m = i >> 4, k = i & 15; As[k][m] = (bm + m < rows) ? f.a(z, bm + m, k0 + k) : 0.f; }
        for (int i = tid; i < 1024; i += 256) { int k = i >> 6, n = i & 63; Bs[k][n] = (bn + n < N) ? f.b(z, k0 + k, bn + n) : 0.f; }
        __syncthreads();
#pragma unroll
        for (int k = 0; k < 16; ++k) {
            float a[4], b[4];
#pragma unroll
            for (int i = 0; i < 4; ++i) { a[i] = As[k][ty * 4 + i]; b[i] = Bs[k][tx * 4 + i]; }
#pragma unroll
            for (int i = 0; i < 4; ++i)
#pragma unroll
                for (int j = 0; j < 4; ++j) acc[i][j] += a[i] * b[j];
        }
        __syncthreads();
    }
    for (int i = 0; i < 4; ++i) for (int j = 0; j < 4; ++j) { int m = bm + ty * 4 + i, n = bn + tx * 4 + j; if (m < rows && n < N) f.c(z, m, n, acc[i][j]); }
}

struct FIn { Ptrs P;
    __device__ int rows(int) const { return MALL; }
    __device__ float a(int, int m, int k) const { return bf2f(((const bf16*)(P.ws + WS_XN))[(size_t)m * DM + k]); }
    __device__ float b(int, int k, int n) const { int l = p1_logical(n); return l < 0 ? 0.f : bf2f((bf16)f2bf(P.in[8][(size_t)k * IN_COLS + l])); }
    __device__ void c(int, int m, int n, float v) const { ((float*)(P.ws + WS_TMP))[(size_t)m * NP1 + n] = v; }
};
__global__ void k_p1_finish(Ptrs P) {
    int r = blockIdx.x, n = r % NTOK;
    const float* t = (const float*)(P.ws + WS_TMP) + (size_t)r * NP1;
    bf16* o = (bf16*)(P.ws + WS_P1) + (size_t)r * NP1;
    float* ssq = (float*)(P.ws + WS_SSQ) + (size_t)r * 8;
    const float2* TD = (const float2*)(P.ws + WS_TAB); const float2* TM = TD + 1024;
    const bool lat = n >= NCTX; const int s = n - NCTX, gr = s >> 6, gc = s & 63;
    __shared__ float red[256];
    int tid = threadIdx.x;
    float v = t[tid]; red[tid] = v * v; __syncthreads();
    for (int oo = 128; oo > 0; oo >>= 1) { if (tid < oo) red[tid] += red[tid + oo]; __syncthreads(); }
    if (tid == 0) { ssq[0] = red[0]; ssq[1] = ssq[2] = ssq[3] = 0.f; }
    __syncthreads();
    float w = tid < 128 ? t[256 + tid] : 0.f; red[tid] = w * w; __syncthreads();
    for (int oo = 128; oo > 0; oo >>= 1) { if (tid < oo) red[tid] += red[tid + oo]; __syncthreads(); }
    if (tid == 0) { ssq[4] = red[0]; ssq[5] = ssq[6] = ssq[7] = 0.f; }
    for (int p = tid; p < NP1; p += 256) {
        float val = t[p];
        if (p >= 384 && p < 416) {
            int ph = p - 384, nn = (ph >> 2) & 1, i = 4 * (ph >> 3) + (ph & 3);
            float x1 = t[nn ? p - 4 : p], x2 = t[nn ? p : p + 4];
            float2 cs = lat ? TM[(i < 8 ? gr : gc) * 8 + (i & 7)] : make_float2(1.f, 0.f);
            val = nn ? x1 * cs.y + x2 * cs.x : x1 * cs.x - x2 * cs.y;
        } else if (p >= 512 && p < 1536) {
            int ph = (p - 512) & 63, nn = (ph >> 2) & 1, i = 16 * (ph >> 5) + 4 * ((ph >> 3) & 3) + (ph & 3);
            float x1 = t[nn ? p - 4 : p], x2 = t[nn ? p : p + 4];
            float2 cs = lat ? TD[(i < 16 ? gr : gc) * 16 + (i & 15)] : make_float2(1.f, 0.f);
            val = nn ? x1 * cs.y + x2 * cs.x : x1 * cs.x - x2 * cs.y;
        }
        o[p] = (bf16)f2bf(val);
    }
}
struct FUp { Ptrs P;
    __device__ int rows(int) const { return MALL; }
    __device__ float a(int, int m, int k) const { return bf2f(((const bf16*)(P.ws + WS_P1))[(size_t)m * NP1 + k]); }
    __device__ float b(int, int k, int n) const {
        if (n < 768) return k < 256 ? bf2f((bf16)f2bf(P.in[9][k] * P.in[10][(size_t)k * 768 + qm_logical(n)])) : 0.f;
        return k >= 256 ? bf2f((bf16)f2bf(P.in[11][k - 256] * P.in[12][(size_t)(k - 256) * 1024 + (n - 768)])) : 0.f; }
    __device__ void c(int, int m, int n, float v) const { ((float*)(P.ws + WS_TMP))[(size_t)m * NP1 + n] = v; }
};
__global__ void k_up_finish(Ptrs P) {
    int r = blockIdx.x, n = r % NTOK;
    const float* t = (const float*)(P.ws + WS_TMP) + (size_t)r * NP1;
    const float* ssq = (const float*)(P.ws + WS_SSQ) + (size_t)r * 8;
    const float rq = rsqrtf((ssq[0] + ssq[1] + ssq[2] + ssq[3]) / 256.f + EPS), rkv = rsqrtf((ssq[4] + ssq[5] + ssq[6] + ssq[7]) / 128.f + EPS);
    const float2* TM = (const float2*)(P.ws + WS_TAB) + 1024;
    const bool lat = n >= NCTX; const int s = n - NCTX, gr = s >> 6, gc = s & 63;
    bf16* qo = (bf16*)(P.ws + WS_QM) + (size_t)r * 768; bf16* kvo = (bf16*)(P.ws + WS_KVM) + (size_t)r * 1024;
    for (int p = threadIdx.x; p < 1792; p += 256) {
        if (p < 768) {
            int rr = p % 96; float val = t[p] * rq;
            if (rr >= 64) { int ph = rr - 64, nn = (ph >> 2) & 1, i = 4 * (ph >> 3) + (ph & 3);
                float x1 = t[nn ? p - 4 : p] * rq, x2 = t[nn ? p : p + 4] * rq;
                float2 cs = lat ? TM[(i < 8 ? gr : gc) * 8 + (i & 7)] : make_float2(1.f, 0.f);
                val = nn ? x1 * cs.y + x2 * cs.x : x1 * cs.x - x2 * cs.y; }
            qo[p] = (bf16)f2bf(val);
        } else kvo[p - 768] = (bf16)f2bf(t[p] * rkv);
    }
}

template <int MODE> __global__ __launch_bounds__(256) void k_attn(Ptrs P) {
    const int t = blockIdx.x * 256 + threadIdx.x;
    const int b = (blockIdx.x * 256) / SEQ, s = t % SEQ, hh = blockIdx.y, sl = blockIdx.z;
    const bf16* P1 = (const bf16*)(P.ws + WS_P1); const bf16* QM = (const bf16*)(P.ws + WS_QM); const bf16* KV = (const bf16*)(P.ws + WS_KVM);
    const size_t qrow = (size_t)b * NTOK + NCTX + s, k0row = (size_t)b * NTOK;
    constexpr int DQK = MODE == 0 ? 96 : 64;
    float q[DQK]; float o[64]; float m = -1e30f, l = 0.f;
    const float scale = MODE == 0 ? 0.10206207261596575f : 0.125f;
    if (MODE == 0) { _Pragma("unroll") for (int d = 0; d < 96; ++d) q[d] = bf2f(QM[qrow * 768 + hh * 96 + d]) * scale; }
    else { _Pragma("unroll") for (int d = 0; d < 64; ++d) q[d] = bf2f(P1[qrow * NP1 + 512 + hh * 64 + d]) * scale; }
    _Pragma("unroll") for (int d = 0; d < 64; ++d) o[d] = 0.f;
    for (int j = 0; j < NTOK; ++j) {
        const size_t kr = k0row + j; float sc = 0.f;
        if (MODE == 0) {
            const bf16* kn = KV + kr * 1024 + hh * 128; const bf16* kro = P1 + kr * NP1 + 384;
            _Pragma("unroll") for (int d = 0; d < 64; ++d) sc += q[d] * bf2f(kn[d]);
            _Pragma("unroll") for (int d = 0; d < 32; ++d) sc += q[64 + d] * bf2f(kro[d]);
        } else { const bf16* kk = P1 + kr * NP1 + 1024 + hh * 64; _Pragma("unroll") for (int d = 0; d < 64; ++d) sc += q[d] * bf2f(kk[d]); }
        float mn = fmaxf(m, sc), al = __expf(m - mn), p = __expf(sc - mn);
        l = l * al + p; m = mn;
        const bf16* vv = MODE == 0 ? KV + kr * 1024 + hh * 128 + 64 : P1 + kr * NP1 + 1536 + (hh >> 1) * 128 + sl * 64;
        _Pragma("unroll") for (int d = 0; d < 64; ++d) o[d] = o[d] * al + p * bf2f(vv[d]);
    }
    const float il = 1.f / l;
    if (MODE == 0) { bf16* mo = (bf16*)(P.ws + WS_MIX) + (size_t)t * DM + hh * 64; _Pragma("unroll") for (int d = 0; d < 64; ++d) mo[d] = (bf16)f2bf(o[d] * il); }
    else { float* oo = (float*)(P.ws + WS_OS) + ((size_t)t * 8 + hh) * 128 + sl * 64; _Pragma("unroll") for (int d = 0; d < 64; ++d) oo[d] = o[d] * il; }
}
__global__ void k_diff_finish(Ptrs P) {
    const int t = blockIdx.x, h = threadIdx.x >> 6  , lane = threadIdx.x & 63;
    float d1 = 0.f, d2 = 0.f; for (int i = 0; i < 64; ++i) { d1 += P.in[13][i] * P.in[14][i]; d2 += P.in[15][i] * P.in[16][i]; }
    const float lam = __expf(d1) - __expf(d2) + LAM_INIT;
    const float* os = (const float*)(P.ws + WS_OS) + ((size_t)t * 8 + 2 * h) * 128;
    float v0 = os[lane] - lam * os[128 + lane], v1 = os[64 + lane] - lam * os[128 + 64 + lane];
    float ss = v0 * v0 + v1 * v1;
    for (int o = 1; o < 64; o <<= 1) ss += __shfl_xor(ss, o);
    const float rs = rsqrtf(ss / 128.f + EPS) * (1.f - LAM_INIT);
    bf16* mo = (bf16*)(P.ws + WS_MIX) + (size_t)t * DM + 512 + h * 128;
    mo[lane] = (bf16)f2bf(v0 * rs * P.in[17][lane]); mo[64 + lane] = (bf16)f2bf(v1 * rs * P.in[17][64 + lane]);
}

struct FOut { Ptrs P;
    __device__ int rows(int) const { return MLAT; }
    __device__ float a(int, int m, int k) const { return bf2f(((const bf16*)(P.ws + WS_MIX))[(size_t)m * DM + k]); }
    __device__ float b(int, int k, int n) const { return bf2f((bf16)f2bf(P.in[18][(size_t)k * DM + n])); }
    __device__ void c(int, int m, int n, float v) const { const float* mod = (const float*)(P.ws + WS_MOD) + (m / SEQ) * 6144;
        ((float*)(P.ws + WS_X1))[(size_t)m * DM + n] = P.in[0][(size_t)m * DM + n] + mod[2048 + n] * v; }
};
__global__ void k_h2(Ptrs P) {
    int t = blockIdx.x, b = t / SEQ;
    const float* src = (const float*)(P.ws + WS_X1) + (size_t)t * DM;
    const float* mod = (const float*)(P.ws + WS_MOD) + b * 6144;
    __shared__ float red[256];
    float v[4]; float ss = 0.f;
    for (int i = 0; i < 4; ++i) { v[i] = src[threadIdx.x + 256 * i]; ss += v[i] * v[i]; }
    red[threadIdx.x] = ss; __syncthreads();
    for (int o = 128; o > 0; o >>= 1) { if (threadIdx.x < o) red[threadIdx.x] += red[threadIdx.x + o]; __syncthreads(); }
    float rs = rsqrtf(red[0] / DM + EPS);
    for (int i = 0; i < 4; ++i) { int j = threadIdx.x + 256 * i; float y = v[i] * rs * P.in[7][j]; y = y * (1.f + mod[4096 + j]) + mod[3072 + j];
        ((bf16*)(P.ws + WS_H2))[(size_t)t * DM + j] = (bf16)f2bf(y); ((float*)(P.ws + WS_H2F))[(size_t)t * DM + j] = y; }
}
struct FRouter { Ptrs P;
    __device__ int rows(int) const { return MLAT; }
    __device__ float a(int, int m, int k) const { return ((const float*)(P.ws + WS_H2F))[(size_t)m * DM + k]; }
    __device__ float b(int, int k, int n) const { return P.in[19][(size_t)k * NEXP + n]; }
    __device__ void c(int, int m, int n, float v) const { ((float*)(P.ws + WS_LOG))[(size_t)m * NEXP + n] = v; }
};
__global__ __launch_bounds__(256) void k_route(Ptrs P) {
    const int t = blockIdx.x * 4 + (threadIdx.x >> 6), lane = threadIdx.x & 63;
    const float4 lg = ((const float4*)(P.ws + WS_LOG))[(size_t)t * 64 + lane];
    const float4 bi = ((const float4*)P.in[20])[lane];
    float s[4] = {1.f / (1.f + __expf(-lg.x)), 1.f / (1.f + __expf(-lg.y)), 1.f / (1.f + __expf(-lg.z)), 1.f / (1.f + __expf(-lg.w))};
    float v[4] = {s[0] + bi.x, s[1] + bi.y, s[2] + bi.z, s[3] + bi.w};
    float m1 = fmaxf(v[0], v[1]), m2 = fminf(v[0], v[1]);
    for (int i = 2; i < 4; ++i) { float x = v[i]; m2 = fmaxf(m2, fminf(m1, x)); m1 = fmaxf(m1, x); }
    for (int o = 1; o < 8; o <<= 1) { float b1 = __shfl_xor(m1, o), b2 = __shfl_xor(m2, o); float n1 = fmaxf(m1, b1), n2 = fmaxf(fminf(m1, b1), fmaxf(m2, b2)); m1 = n1; m2 = n2; }
    const float gs = m1 + m2; const int g = lane >> 3; int rank = 0;
    for (int j = 0; j < 8; ++j) { float o = __shfl(gs, j * 8); rank += (o > gs || (o == gs && j < g)) ? 1 : 0; }
    if (rank >= 4) { v[0] = v[1] = v[2] = v[3] = -INFINITY; }
    int my_e = 0; float my_s = 0.f; float ssum = 0.f;
    for (int k = 0; k < 8; ++k) {
        float bv = v[0]; int bi_ = 0;
        for (int i = 1; i < 4; ++i) if (v[i] > bv) { bv = v[i]; bi_ = i; }
        int be = lane * 4 + bi_;
        for (int o = 1; o < 64; o <<= 1) { float ov = __shfl_xor(bv, o); int oe = __shfl_xor(be, o); if (ov > bv || (ov == bv && oe < be)) { bv = ov; be = oe; } }
        const int wl = be >> 2, wi = be & 3;
        float sv = wi == 0 ? s[0] : wi == 1 ? s[1] : wi == 2 ? s[2] : s[3];
        sv = __shfl(sv, wl);
        if (lane == wl) { if (wi == 0) v[0] = -INFINITY; else if (wi == 1) v[1] = -INFINITY; else if (wi == 2) v[2] = -INFINITY; else v[3] = -INFINITY; }
        ssum += sv; if (lane == k) { my_e = be; my_s = sv; }
    }
    if (lane < 8) {
        int* cnt = (int*)(P.ws + WS_CTL) + CW_COUNT;
        int rk = atomicAdd(&cnt[my_e], 1);
        ((int*)(P.ws + WS_EIDX))[(size_t)t * 8 + lane] = my_e;
        ((float*)(P.ws + WS_EW))[(size_t)t * 8 + lane] = my_s / ssum * 2.5f;
        ((int*)(P.ws + WS_ERANK))[(size_t)t * 8 + lane] = rk;
    }
}
__global__ __launch_bounds__(256) void k_slots(Ptrs P) {
    __shared__ int off[257];
    const int* cnt = (const int*)(P.ws + WS_CTL) + CW_COUNT;
    if (threadIdx.x == 0) { int a = 0; for (int e = 0; e < 256; ++e) { off[e] = a; a += cnt[e]; } off[256] = a; }
    __syncthreads();
    if (blockIdx.x == 0) { int* go = (int*)(P.ws + WS_OFF); go[threadIdx.x] = off[threadIdx.x]; if (threadIdx.x == 0) { go[256] = off[256]; go[257] = NSLOT; } }
    int idx = blockIdx.x * 256 + threadIdx.x;
    int e = ((const int*)(P.ws + WS_EIDX))[idx], rk = ((const int*)(P.ws + WS_ERANK))[idx];
    int slot = off[e] + rk;
    ((int*)(P.ws + WS_SLOTOF))[idx] = slot;
    ((int*)(P.ws + WS_SLOTTOK))[slot] = idx >> 3;
    ((float*)(P.ws + WS_SLOTW))[slot] = ((const float*)(P.ws + WS_EW))[idx];
    if (idx < MLAT) { ((int*)(P.ws + WS_SLOTTOK))[MLAT * 8 + idx] = idx; ((float*)(P.ws + WS_SLOTW))[MLAT * 8 + idx] = 1.f; }
}
__global__ __launch_bounds__(256) void k_exp1(Ptrs P) {
    const int z = blockIdx.z; const int* off = (const int*)(P.ws + WS_OFF); const int rows = off[z + 1] - off[z]; const int m0 = blockIdx.y * 16; if (m0 >= rows) return;
    const float* w1 = z < 256 ? P.in[21] + (size_t)z * DM * EFF : P.in[24]; const float* w3 = z < 256 ? P.in[22] + (size_t)z * DM * EFF : P.in[25];
    __shared__ float hs[16][DM];
    for (int i = threadIdx.x; i < 16 * DM; i += 256) { int m = i / DM, k = i % DM; int slot = off[z] + m0 + m; hs[m][k] = (m0 + m < rows) ? bf2f(((const bf16*)(P.ws + WS_H2))[(size_t)((const int*)(P.ws + WS_SLOTTOK))[slot] * DM + k]) : 0.f; }
    __syncthreads();
    const int n = threadIdx.x; float g[16] = {}, u[16] = {};
    for (int k = 0; k < DM; ++k) { float a = bf2f((bf16)f2bf(w1[(size_t)k * EFF + n])), b = bf2f((bf16)f2bf(w3[(size_t)k * EFF + n]));
#pragma unroll
        for (int m = 0; m < 16; ++m) { g[m] += hs[m][k] * a; u[m] += hs[m][k] * b; } }
    for (int m = 0; m < 16; ++m) if (m0 + m < rows) { float gg = g[m]; float act = gg / (1.f + __expf(-gg)) * u[m]; ((bf16*)(P.ws + WS_ACT))[(size_t)(off[z] + m0 + m) * EFF + n] = (bf16)f2bf(act); }
}
struct FExp2 { Ptrs P;
    __device__ int rows(int z) const { const int* off = (const int*)(P.ws + WS_OFF); return off[z + 1] - off[z]; }
    __device__ float a(int z, int m, int k) const { const int* off = (const int*)(P.ws + WS_OFF); return bf2f(((const bf16*)(P.ws + WS_ACT))[(size_t)(off[z] + m) * EFF + k]); }
    __device__ float b(int z, int k, int n) const { const float* w = z < 256 ? P.in[23] + (size_t)z * EFF * DM : P.in[26]; return bf2f((bf16)f2bf(w[(size_t)k * DM + n])); }
    __device__ void c(int z, int m, int n, float v) const { const int* off = (const int*)(P.ws + WS_OFF); size_t slot = off[z] + m;
        ((bf16*)(P.ws + WS_Y))[slot * DM + n] = (bf16)f2bf(v * ((const float*)(P.ws + WS_SLOTW))[slot]); }
};
__global__ void k_combine(Ptrs P) {
    int t = blockIdx.x, b = t / SEQ;
    const float* x1 = (const float*)(P.ws + WS_X1) + (size_t)t * DM;
    const float* mod = (const float*)(P.ws + WS_MOD) + b * 6144;
    const bf16* Y = (const bf16*)(P.ws + WS_Y); const int* so = (const int*)(P.ws + WS_SLOTOF) + (size_t)t * 8;
    __shared__ float red[256];
    float v[4]; float ss = 0.f;
    for (int i = 0; i < 4; ++i) { int j = threadIdx.x + 256 * i; float a = bf2f(Y[(size_t)(MLAT * 8 + t) * DM + j]);
        for (int k = 0; k < 8; ++k) a += bf2f(Y[(size_t)so[k] * DM + j]);
        v[i] = x1[j] + mod[5120 + j] * a; ss += v[i] * v[i]; }
    red[threadIdx.x] = ss; __syncthreads();
    for (int o = 128; o > 0; o >>= 1) { if (threadIdx.x < o) red[threadIdx.x] += red[threadIdx.x + o]; __syncthreads(); }
    float rs = rsqrtf(red[0] / DM + EPS);
    for (int i = 0; i < 4; ++i) { int j = threadIdx.x + 256 * i; P.out[(size_t)t * DM + j] = v[i] * rs * P.in[27][j]; }
}

extern "C" void kernel_launch(void* const* d_in, const int* in_sizes, int n_in, void* d_out, int out_size, void* d_ws, size_t ws_size, hipStream_t stream) {
    if (n_in != 28 || out_size != MLAT * DM || ws_size < WS_END) { fprintf(stderr, "kernel_launch: unexpected shapes n_in %d out %d ws %zu\n", n_in, out_size, ws_size); return; }
    Ptrs P{}; for (int i = 0; i < 28; ++i) P.in[i] = (const float*)d_in[i]; P.out = (float*)d_out; P.ws = (unsigned char*)d_ws;
    hipMemsetAsync((char*)d_ws + WS_CTL, 0, 1 * MiB, stream);
    k_mod<<<120, 256, 0, stream>>>(P);
    k_xn<<<MALL, 256, 0, stream>>>(P);
    k_gemm<FIn><<<dim3(NP1 / 64, MALL / 64, 1), 256, 0, stream>>>(FIn{P}, NP1, DM);
    k_p1_finish<<<MALL, 256, 0, stream>>>(P);
    k_gemm<FUp><<<dim3(1792 / 64, MALL / 64, 1), 256, 0, stream>>>(FUp{P}, 1792, 384);
    k_up_finish<<<MALL, 256, 0, stream>>>(P);
    k_attn<0><<<dim3(MLAT / 256, 8, 1), 256, 0, stream>>>(P);
    k_attn<1><<<dim3(MLAT / 256, 8, 2), 256, 0, stream>>>(P);
    k_diff_finish<<<MLAT, 256, 0, stream>>>(P);
    k_gemm<FOut><<<dim3(DM / 64, MLAT / 64, 1), 256, 0, stream>>>(FOut{P}, DM, DM);
    k_h2<<<MLAT, 256, 0, stream>>>(P);
    k_gemm<FRouter><<<dim3(NEXP / 64, MLAT / 64, 1), 256, 0, stream>>>(FRouter{P}, NEXP, DM);
    k_route<<<MLAT / 4, 256, 0, stream>>>(P);
    k_slots<<<MLAT * 8 / 256, 256, 0, stream>>>(P);
    k_exp1<<<dim3(1, MLAT / 16, 257), 256, 0, stream>>>(P);
    k_gemm<FExp2><<<dim3(DM / 64, MLAT / 64, 257), 256, 0, stream>>>(FExp2{P}, DM, EFF);
    k_combine<<<MLAT, 256, 0, stream>>>(P);
}
```

```cpp
#include <hip/hip_runtime.h>
#include <cstdio>
#include <cstdint>

constexpr int NB = 4, SEQ = 4096, NCTX = 256, NTOK = SEQ + NCTX, DM = 1024;
constexpr int MALL = NB * NTOK;
constexpr int MLAT = NB * SEQ;
constexpr int IN_COLS = 1952, NP1 = 2048;
constexpr int NEXP = 256, TOPK = 8, EFF = 256;
constexpr int NSLOT = MLAT * TOPK + MLAT;
constexpr float EPS = 1e-6f;
constexpr float LAM_INIT = 0.2f;

typedef unsigned short bf16;
__device__ __forceinline__ unsigned f2bf(float f) { unsigned u = __builtin_bit_cast(unsigned, f); return (u + 0x7fffu + ((u >> 16) & 1u)) >> 16; }
__device__ __forceinline__ float bf2f(bf16 h) { return __builtin_bit_cast(float, (unsigned)h << 16); }

constexpr size_t MiB = 1u << 20;
constexpr size_t WS_CTL = 0;
constexpr size_t WS_MOD = 3 * MiB;
constexpr size_t WS_TAB = 3 * MiB + 512 * 1024;
constexpr size_t WS_X1 = 402 * MiB;
constexpr size_t WS_SSQ = 466 * MiB;
constexpr size_t WS_EIDX = 467 * MiB;
constexpr size_t WS_EW = WS_EIDX + 512 * 1024;
constexpr size_t WS_ERANK = 468 * MiB;
constexpr size_t WS_SLOTOF = WS_ERANK + 512 * 1024;
constexpr size_t WS_SLOTTOK = 469 * MiB;
constexpr size_t WS_SLOTW = 470 * MiB;
constexpr size_t WS_OFF = 471 * MiB;
constexpr size_t WS_XN = 472 * MiB;
constexpr size_t WS_P1 = 506 * MiB;
constexpr size_t WS_QM = 574 * MiB;
constexpr size_t WS_KVM = 600 * MiB;
constexpr size_t WS_MIX = 634 * MiB;
constexpr size_t WS_OS = 666 * MiB;
constexpr size_t WS_TMP = 730 * MiB;
constexpr size_t WS_H2 = 472 * MiB;
constexpr size_t WS_H2F = 504 * MiB;
constexpr size_t WS_LOG = 568 * MiB;
constexpr size_t WS_ACT = 584 * MiB;
constexpr size_t WS_Y = 656 * MiB;
constexpr size_t WS_END = 944 * MiB;
constexpr int CW_COUNT = 1024;

__host__ __device__ __forceinline__ int perm32_log(int p) { return 16 * ((p >> 2) & 1) + 4 * (p >> 3) + (p & 3); }
__host__ __device__ __forceinline__ int perm64_log(int p) { return 32 * ((p >> 2) & 1) + 16 * (p >> 5) + 4 * ((p >> 3) & 3) + (p & 3); }
__host__ __device__ __forceinline__ int p1_logical(int p) {
    if (p < 384) return p;
    if (p < 416) return 384 + perm32_log(p - 384);
    if (p < 512) return -1;
    if (p < 1024) { int q = p - 512; return 416 + (q & ~63) + perm64_log(q & 63); }
    if (p < 1536) { int q = p - 1024; return 928 + (q & ~63) + perm64_log(q & 63); }
    return 1440 + (p - 1536);
}
__host__ __device__ __forceinline__ int qm_logical(int p) { int h = p / 96, r = p % 96; return h * 96 + (r < 64 ? r : 64 + perm32_log(r - 64)); }

struct Ptrs {
    const float* in[28]; float* out; unsigned char* ws;
};

__global__ void k_mod(Ptrs P) {
    int idx = blockIdx.x * 256 + threadIdx.x;
    if (idx < 5 * 6144) {
        int r = idx / 6144, j = idx % 6144;
        const float* cv = r < 4 ? P.in[1] + r * DM : P.in[3];
        const float* W = P.in[4];
        float acc = 0.f;
        for (int k = 0; k < DM; ++k) { float c = cv[k]; float s = c / (1.f + __expf(-c)); acc += s * W[(size_t)k * 6144 + j]; }
        ((float*)(P.ws + WS_MOD))[idx] = acc + P.in[5][j];
    }
    if (idx < 64 * 16) {
        int v = idx / 16, f = idx % 16;
        float inv = exp2f(-(float)f / 16.f * 13.287712379549449f);
        float th = (float)v * inv;
        float2 cs; cs.x = cosf(th); cs.y = sinf(th);
        ((float2*)(P.ws + WS_TAB))[idx] = cs;
    }
    if (idx < 64 * 8) {
        int v = idx / 8, f = idx % 8;
        float inv = exp2f(-(float)f / 8.f * 13.287712379549449f);
        float th = (float)v * inv;
        float2 cs; cs.x = cosf(th); cs.y = sinf(th);
        ((float2*)(P.ws + WS_TAB) + 1024)[idx] = cs;
    }
}

__global__ void k_xn(Ptrs P) {
    int r = blockIdx.x, b = r / NTOK, n = r % NTOK;
    const float* src = n < NCTX ? P.in[2] + ((size_t)b * NCTX + n) * DM : P.in[0] + ((size_t)b * SEQ + (n - NCTX)) * DM;
    const float* mod = (const float*)(P.ws + WS_MOD) + (n < NCTX ? 4 : b) * 6144;
    __shared__ float red[256];
    float v[4]; float ss = 0.f;
    for (int i = 0; i < 4; ++i) { v[i] = src[threadIdx.x + 256 * i]; ss += v[i] * v[i]; }
    red[threadIdx.x] = ss; __syncthreads();
    for (int o = 128; o > 0; o >>= 1) { if (threadIdx.x < o) red[threadIdx.x] += red[threadIdx.x + o]; __syncthreads(); }
    float rs = rsqrtf(red[0] / DM + EPS);
    bf16* dst = (bf16*)(P.ws + WS_XN) + (size_t)r * DM;
    for (int i = 0; i < 4; ++i) { int j = threadIdx.x + 256 * i; float y = v[i] * rs * P.in[6][j]; y = y * (1.f + mod[1024 + j]) + mod[j]; dst[j] = (bf16)f2bf(y); }
}

template <class F> __global__ __launch_bounds__(256) void k_gemm(F f, int N, int K) {
    __shared__ float As[16][65], Bs[16][65];
    const int z = blockIdx.z, bm = blockIdx.y * 64, bn = blockIdx.x * 64, tid = threadIdx.x, tx = tid & 15, ty = tid >> 4;
    const int rows = f.rows(z); if (bm >= rows) return;
    float acc[4][4] = {};
    for (int k0 = 0; k0 < K; k0 += 16) {
        for (int i = tid; i < 1024; i += 256) { int m = i >> 4, k = i & 15; As[k][m] = (bm + m < rows) ? f.a(z, bm + m, k0 + k) : 0.f; }
        for (int i = tid; i < 1024; i += 256) { int k = i >> 6, n = i & 63; Bs[k][n] = (bn + n < N) ? f.b(z, k0 + k, bn + n) : 0.f; }
        __syncthreads();
#pragma unroll
        for (int k = 0; k < 16; ++k) {
            float a[4], b[4];
#pragma unroll
            for (int i = 0; i < 4; ++i) { a[i] = As[k][ty * 4 + i]; b[i] = Bs[k][tx * 4 + i]; }
#pragma unroll
            for (int i = 0; i < 4; ++i)
#pragma unroll
                for (int j = 0; j < 4; ++j) acc[i][j] += a[i] * b[j];
        }
        __syncthreads();
    }
    for (int i = 0; i < 4; ++i) for (int j = 0; j < 4; ++j) { int m = bm + ty * 4 + i, n = bn + tx * 4 + j; if (m < rows && n < N) f.c(z, m, n, acc[i][j]); }
}

struct FIn { Ptrs P;
    __device__ int rows(int) const { return MALL; }
    __device__ float a(int, int m, int k) const { return bf2f(((const bf16*)(P.ws + WS_XN))[(size_t)m * DM + k]); }
    __device__ float b(int, int k, int n) const { int l = p1_logical(n); return l < 0 ? 0.f : bf2f((bf16)f2bf(P.in[8][(size_t)k * IN_COLS + l])); }
    __device__ void c(int, int m, int n, float v) const { ((float*)(P.ws + WS_TMP))[(size_t)m * NP1 + n] = v; }
};
__global__ void k_p1_finish(Ptrs P) {
    int r = blockIdx.x, n = r % NTOK;
    const float* t = (const float*)(P.ws + WS_TMP) + (size_t)r * NP1;
    bf16* o = (bf16*)(P.ws + WS_P1) + (size_t)r * NP1;
    float* ssq = (float*)(P.ws + WS_SSQ) + (size_t)r * 8;
    const float2* TD = (const float2*)(P.ws + WS_TAB); const float2* TM = TD + 1024;
    const bool lat = n >= NCTX; const int s = n - NCTX, gr = s >> 6, gc = s & 63;
    __shared__ float red[256];
    int tid = threadIdx.x;
    float v = t[tid]; red[tid] = v * v; __syncthreads();
    for (int oo = 128; oo > 0; oo >>= 1) { if (tid < oo) red[tid] += red[tid + oo]; __syncthreads(); }
    if (tid == 0) { ssq[0] = red[0]; ssq[1] = ssq[2] = ssq[3] = 0.f; }
    __syncthreads();
    float w = tid < 128 ? t[256 + tid] : 0.f; red[tid] = w * w; __syncthreads();
    for (int oo = 128; oo > 0; oo >>= 1) { if (tid < oo) red[tid] += red[tid + oo]; __syncthreads(); }
    if (tid == 0) { ssq[4] = red[0]; ssq[5] = ssq[6] = ssq[7] = 0.f; }
    for (int p = tid; p < NP1; p += 256) {
        float val = t[p];
        if (p >= 384 && p < 416) {
            int ph = p - 384, nn = (ph >> 2) & 1, i = 4 * (ph >> 3) + (ph & 3);
            float x1 = t[nn ? p - 4 : p], x2 = t[nn ? p : p + 4];
            float2 cs = lat ? TM[(i < 8 ? gr : gc) * 8 + (i & 7)] : make_float2(1.f, 0.f);
            val = nn ? x1 * cs.y + x2 * cs.x : x1 * cs.x - x2 * cs.y;
        } else if (p >= 512 && p < 1536) {
            int ph = (p - 512) & 63, nn = (ph >> 2) & 1, i = 16 * (ph >> 5) + 4 * ((ph >> 3) & 3) + (ph & 3);
            float x1 = t[nn ? p - 4 : p], x2 = t[nn ? p : p + 4];
            float2 cs = lat ? TD[(i < 16 ? gr : gc) * 16 + (i & 15)] : make_float2(1.f, 0.f);
            val = nn ? x1 * cs.y + x2 * cs.x : x1 * cs.x - x2 * cs.y;
        }
        o[p] = (bf16)f2bf(val);
    }
}
struct FUp { Ptrs P;
    __device__ int rows(int) const { return MALL; }
    __device__ float a(int, int m, int k) const { return bf2f(((const bf16*)(P.ws + WS_P1))[(size_t)m * NP1 + k]); }
    __device__ float b(int, int k, int n) const {
        if (n < 768) return k < 256 ? bf2f((bf16)f2bf(P.in[9][k] * P.in[10][(size_t)k * 768 + qm_logical(n)])) : 0.f;
        return k >= 256 ? bf2f((bf16)f2bf(P.in[11][k - 256] * P.in[12][(size_t)(k - 256) * 1024 + (n - 768)])) : 0.f; }
    __device__ void c(int, int m, int n, float v) const { ((float*)(P.ws + WS_TMP))[(size_t)m * NP1 + n] = v; }
};
__global__ void k_up_finish(Ptrs P) {
    int r = blockIdx.x, n = r % NTOK;
    const float* t = (const float*)(P.ws + WS_TMP) + (size_t)r * NP1;
    const float* ssq = (const float*)(P.ws + WS_SSQ) + (size_t)r * 8;
    const float rq = rsqrtf((ssq[0] + ssq[1] + ssq[2] + ssq[3]) / 256.f + EPS), rkv = rsqrtf((ssq[4] + ssq[5] + ssq[6] + ssq[7]) / 128.f + EPS);
    const float2* TM = (const float2*)(P.ws + WS_TAB) + 1024;
    const bool lat = n >= NCTX; const int s = n - NCTX, gr = s >> 6, gc = s & 63;
    bf16* qo = (bf16*)(P.ws + WS_QM) + (size_t)r * 768; bf16* kvo = (bf16*)(P.ws + WS_KVM) + (size_t)r * 1024;
    for (int p = threadIdx.x; p < 1792; p += 256) {
        if (p < 768) {
            int rr = p % 96; float val = t[p] * rq;
            if (rr >= 64) { int ph = rr - 64, nn = (ph >> 2) & 1, i = 4 * (ph >> 3) + (ph & 3);
                float x1 = t[nn ? p - 4 : p] * rq, x2 = t[nn ? p : p + 4] * rq;
                float2 cs = lat ? TM[(i < 8 ? gr : gc) * 8 + (i & 7)] : make_float2(1.f, 0.f);
                val = nn ? x1 * cs.y + x2 * cs.x : x1 * cs.x - x2 * cs.y; }
            qo[p] = (bf16)f2bf(val);
        } else kvo[p - 768] = (bf16)f2bf(t[p] * rkv);
    }
}

template <int MODE> __global__ __launch_bounds__(256) void k_attn(Ptrs P) {
    const int t = blockIdx.x * 256 + threadIdx.x;
    const int b = (blockIdx.x * 256) / SEQ, s = t % SEQ, hh = blockIdx.y, sl = blockIdx.z;
    const bf16* P1 = (const bf16*)(P.ws + WS_P1); const bf16* QM = (const bf16*)(P.ws + WS_QM); const bf16* KV = (const bf16*)(P.ws + WS_KVM);
    const size_t qrow = (size_t)b * NTOK + NCTX + s, k0row = (size_t)b * NTOK;
    constexpr int DQK = MODE == 0 ? 96 : 64;
    float q[DQK]; float o[64]; float m = -1e30f, l = 0.f;
    const float scale = MODE == 0 ? 0.10206207261596575f : 0.125f;
    if (MODE == 0) { _Pragma("unroll") for (int d = 0; d < 96; ++d) q[d] = bf2f(QM[qrow * 768 + hh * 96 + d]) * scale; }
    else { _Pragma("unroll") for (int d = 0; d < 64; ++d) q[d] = bf2f(P1[qrow * NP1 + 512 + hh * 64 + d]) * scale; }
    _Pragma("unroll") for (int d = 0; d < 64; ++d) o[d] = 0.f;
    for (int j = 0; j < NTOK; ++j) {
        const size_t kr = k0row + j; float sc = 0.f;
        if (MODE == 0) {
            const bf16* kn = KV + kr * 1024 + hh * 128; const bf16* kro = P1 + kr * NP1 + 384;
            _Pragma("unroll") for (int d = 0; d < 64; ++d) sc += q[d] * bf2f(kn[d]);
            _Pragma("unroll") for (int d = 0; d < 32; ++d) sc += q[64 + d] * bf2f(kro[d]);
        } else { const bf16* kk = P1 + kr * NP1 + 1024 + hh * 64; _Pragma("unroll") for (int d = 0; d < 64; ++d) sc += q[d] * bf2f(kk[d]); }
        float mn = fmaxf(m, sc), al = __expf(m - mn), p = __expf(sc - mn);
        l = l * al + p; m = mn;
        const bf16* vv = MODE == 0 ? KV + kr * 1024 + hh * 128 + 64 : P1 + kr * NP1 + 1536 + (hh >> 1) * 128 + sl * 64;
        _Pragma("unroll") for (int d = 0; d < 64; ++d) o[d] = o[d] * al + p * bf2f(vv[d]);
    }
    const float il = 1.f / l;
    if (MODE == 0) { bf16* mo = (bf16*)(P.ws + WS_MIX) + (size_t)t * DM + hh * 64; _Pragma("unroll") for (int d = 0; d < 64; ++d) mo[d] = (bf16)f2bf(o[d] * il); }
    else { float* oo = (float*)(P.ws + WS_OS) + ((size_t)t * 8 + hh) * 128 + sl * 64; _Pragma("unroll") for (int d = 0; d < 64; ++d) oo[d] = o[d] * il; }
}
__global__ void k_diff_finish(Ptrs P) {
    const int t = blockIdx.x, h = threadIdx.x >> 6  , lane = threadIdx.x & 63;
    float d1 = 0.f, d2 = 0.f; for (int i = 0; i < 64; ++i) { d1 += P.in[13][i] * P.in[14][i]; d2 += P.in[15][i] * P.in[16][i]; }
    const float lam = __expf(d1) - __expf(d2) + LAM_INIT;
    const float* os = (const float*)(P.ws + WS_OS) + ((size_t)t * 8 + 2 * h) * 128;
    float v0 = os[lane] - lam * os[128 + lane], v1 = os[64 + lane] - lam * os[128 + 64 + lane];
    float ss = v0 * v0 + v1 * v1;
    for (int o = 1; o < 64; o <<= 1) ss += __shfl_xor(ss, o);
    const float rs = rsqrtf(ss / 128.f + EPS) * (1.f - LAM_INIT);
    bf16* mo = (bf16*)(P.ws + WS_MIX) + (size_t)t * DM + 512 + h * 128;
    mo[lane] = (bf16)f2bf(v0 * rs * P.in[17][lane]); mo[64 + lane] = (bf16)f2bf(v1 * rs * P.in[17][64 + lane]);
}

struct FOut { Ptrs P;
    __device__ int rows(int) const { return MLAT; }
    __device__ float a(int, int m, int k) const { return bf2f(((const bf16*)(P.ws + WS_MIX))[(size_t)m * DM + k]); }
    __device__ float b(int, int k, int n) const { return bf2f((bf16)f2bf(P.in[18][(size_t)k * DM + n])); }
    __device__ void c(int, int m, int n, float v) const { const float* mod = (const float*)(P.ws + WS_MOD) + (m / SEQ) * 6144;
        ((float*)(P.ws + WS_X1))[(size_t)m * DM + n] = P.in[0][(size_t)m * DM + n] + mod[2048 + n] * v; }
};
__global__ void k_h2(Ptrs P) {
    int t = blockIdx.x, b = t / SEQ;
    const float* src = (const float*)(P.ws + WS_X1) + (size_t)t * DM;
    const float* mod = (const float*)(P.ws + WS_MOD) + b * 6144;
    __shared__ float red[256];
    float v[4]; float ss = 0.f;
    for (int i = 0; i < 4; ++i) { v[i] = src[threadIdx.x + 256 * i]; ss += v[i] * v[i]; }
    red[threadIdx.x] = ss; __syncthreads();
    for (int o = 128; o > 0; o >>= 1) { if (threadIdx.x < o) red[threadIdx.x] += red[threadIdx.x + o]; __syncthreads(); }
    float rs = rsqrtf(red[0] / DM + EPS);
    for (int i = 0; i < 4; ++i) { int j = threadIdx.x + 256 * i; float y = v[i] * rs * P.in[7][j]; y = y * (1.f + mod[4096 + j]) + mod[3072 + j];
        ((bf16*)(P.ws + WS_H2))[(size_t)t * DM + j] = (bf16)f2bf(y); ((float*)(P.ws + WS_H2F))[(size_t)t * DM + j] = y; }
}
struct FRouter { Ptrs P;
    __device__ int rows(int) const { return MLAT; }
    __device__ float a(int, int m, int k) const { return ((const float*)(P.ws + WS_H2F))[(size_t)m * DM + k]; }
    __device__ float b(int, int k, int n) const { return P.in[19][(size_t)k * NEXP + n]; }
    __device__ void c(int, int m, int n, float v) const { ((float*)(P.ws + WS_LOG))[(size_t)m * NEXP + n] = v; }
};
__global__ __launch_bounds__(256) void k_route(Ptrs P) {
    const int t = blockIdx.x * 4 + (threadIdx.x >> 6), lane = threadIdx.x & 63;
    const float4 lg = ((const float4*)(P.ws + WS_LOG))[(size_t)t * 64 + lane];
    const float4 bi = ((const float4*)P.in[20])[lane];
    float s[4] = {1.f / (1.f + __expf(-lg.x)), 1.f / (1.f + __expf(-lg.y)), 1.f / (1.f + __expf(-lg.z)), 1.f / (1.f + __expf(-lg.w))};
    float v[4] = {s[0] + bi.x, s[1] + bi.y, s[2] + bi.z, s[3] + bi.w};
    float m1 = fmaxf(v[0], v[1]), m2 = fminf(v[0], v[1]);
    for (int i = 2; i < 4; ++i) { float x = v[i]; m2 = fmaxf(m2, fminf(m1, x)); m1 = fmaxf(m1, x); }
    for (int o = 1; o < 8; o <<= 1) { float b1 = __shfl_xor(m1, o), b2 = __shfl_xor(m2, o); float n1 = fmaxf(m1, b1), n2 = fmaxf(fminf(m1, b1), fmaxf(m2, b2)); m1 = n1; m2 = n2; }
    const float gs = m1 + m2; const int g = lane >> 3; int rank = 0;
    for (int j = 0; j < 8; ++j) { float o = __shfl(gs, j * 8); rank += (o > gs || (o == gs && j < g)) ? 1 : 0; }
    if (rank >= 4) { v[0] = v[1] = v[2] = v[3] = -INFINITY; }
    int my_e = 0; float my_s = 0.f; float ssum = 0.f;
    for (int k = 0; k < 8; ++k) {
        float bv = v[0]; int bi_ = 0;
        for (int i = 1; i < 4; ++i) if (v[i] > bv) { bv = v[i]; bi_ = i; }
        int be = lane * 4 + bi_;
        for (int o = 1; o < 64; o <<= 1) { float ov = __shfl_xor(bv, o); int oe = __shfl_xor(be, o); if (ov > bv || (ov == bv && oe < be)) { bv = ov; be = oe; } }
        const int wl = be >> 2, wi = be & 3;
        float sv = wi == 0 ? s[0] : wi == 1 ? s[1] : wi == 2 ? s[2] : s[3];
        sv = __shfl(sv, wl);
        if (lane == wl) { if (wi == 0) v[0] = -INFINITY; else if (wi == 1) v[1] = -INFINITY; else if (wi == 2) v[2] = -INFINITY; else v[3] = -INFINITY; }
        ssum += sv; if (lane == k) { my_e = be; my_s = sv; }
    }
    if (lane < 8) {
        int* cnt = (int*)(P.ws + WS_CTL) + CW_COUNT;
        int rk = atomicAdd(&cnt[my_e], 1);
        ((int*)(P.ws + WS_EIDX))[(size_t)t * 8 + lane] = my_e;
        ((float*)(P.ws + WS_EW))[(size_t)t * 8 + lane] = my_s / ssum * 2.5f;
        ((int*)(P.ws + WS_ERANK))[(size_t)t * 8 + lane] = rk;
    }
}
__global__ __launch_bounds__(256) void k_slots(Ptrs P) {
    __shared__ int off[257];
    const int* cnt = (const int*)(P.ws + WS_CTL) + CW_COUNT;
    if (threadIdx.x == 0) { int a = 0; for (int e = 0; e < 256; ++e) { off[e] = a; a += cnt[e]; } off[256] = a; }
    __syncthreads();
    if (blockIdx.x == 0) { int* go = (int*)(P.ws + WS_OFF); go[threadIdx.x] = off[threadIdx.x]; if (threadIdx.x == 0) { go[256] = off[256]; go[257] = NSLOT; } }
    int idx = blockIdx.x * 256 + threadIdx.x;
    int e = ((const int*)(P.ws + WS_EIDX))[idx], rk = ((const int*)(P.ws + WS_ERANK))[idx];
    int slot = off[e] + rk;
    ((int*)(P.ws + WS_SLOTOF))[idx] = slot;
    ((int*)(P.ws + WS_SLOTTOK))[slot] = idx >> 3;
    ((float*)(P.ws + WS_SLOTW))[slot] = ((const float*)(P.ws + WS_EW))[idx];
    if (idx < MLAT) { ((int*)(P.ws + WS_SLOTTOK))[MLAT * 8 + idx] = idx; ((float*)(P.ws + WS_SLOTW))[MLAT * 8 + idx] = 1.f; }
}
__global__ __launch_bounds__(256) void k_exp1(Ptrs P) {
    const int z = blockIdx.z; const int* off = (const int*)(P.ws + WS_OFF); const int rows = off[z + 1] - off[z]; const int m0 = blockIdx.y * 16; if (m0 >= rows) return;
    const float* w1 = z < 256 ? P.in[21] + (size_t)z * DM * EFF : P.in[24]; const float* w3 = z < 256 ? P.in[22] + (size_t)z * DM * EFF : P.in[25];
    __shared__ float hs[16][DM];
    for (int i = threadIdx.x; i < 16 * DM; i += 256) { int m = i / DM, k = i % DM; int slot = off[z] + m0 + m; hs[m][k] = (m0 + m < rows) ? bf2f(((const bf16*)(P.ws + WS_H2))[(size_t)((const int*)(P.ws + WS_SLOTTOK))[slot] * DM + k]) : 0.f; }
    __syncthreads();
    const int n = threadIdx.x; float g[16] = {}, u[16] = {};
    for (int k = 0; k < DM; ++k) { float a = bf2f((bf16)f2bf(w1[(size_t)k * EFF + n])), b = bf2f((bf16)f2bf(w3[(size_t)k * EFF + n]));
#pragma unroll
        for (int m = 0; m < 16; ++m) { g[m] += hs[m][k] * a; u[m] += hs[m][k] * b; } }
    for (int m = 0; m < 16; ++m) if (m0 + m < rows) { float gg = g[m]; float act = gg / (1.f + __expf(-gg)) * u[m]; ((bf16*)(P.ws + WS_ACT))[(size_t)(off[z] + m0 + m) * EFF + n] = (bf16)f2bf(act); }
}
struct FExp2 { Ptrs P;
    __device__ int rows(int z) const { const int* off = (const int*)(P.ws + WS_OFF); return off[z + 1] - off[z]; }
    __device__ float a(int z, int m, int k) const { const int* off = (const int*)(P.ws + WS_OFF); return bf2f(((const bf16*)(P.ws + WS_ACT))[(size_t)(off[z] + m) * EFF + k]); }
    __device__ float b(int z, int k, int n) const { const float* w = z < 256 ? P.in[23] + (size_t)z * EFF * DM : P.in[26]; return bf2f((bf16)f2bf(w[(size_t)k * DM + n])); }
    __device__ void c(int z, int m, int n, float v) const { const int* off = (const int*)(P.ws + WS_OFF); size_t slot = off[z] + m;
        ((bf16*)(P.ws + WS_Y))[slot * DM + n] = (bf16)f2bf(v * ((const float*)(P.ws + WS_SLOTW))[slot]); }
};
__global__ void k_combine(Ptrs P) {
    int t = blockIdx.x, b = t / SEQ;
    const float* x1 = (const float*)(P.ws + WS_X1) + (size_t)t * DM;
    const float* mod = (const float*)(P.ws + WS_MOD) + b * 6144;
    const bf16* Y = (const bf16*)(P.ws + WS_Y); const int* so = (const int*)(P.ws + WS_SLOTOF) + (size_t)t * 8;
    __shared__ float red[256];
    float v[4]; float ss = 0.f;
    for (int i = 0; i < 4; ++i) { int j = threadIdx.x + 256 * i; float a = bf2f(Y[(size_t)(MLAT * 8 + t) * DM + j]);
        for (int k = 0; k < 8; ++k) a += bf2f(Y[(size_t)so[k] * DM + j]);
        v[i] = x1[j] + mod[5120 + j] * a; ss += v[i] * v[i]; }
    red[threadIdx.x] = ss; __syncthreads();
    for (int o = 128; o > 0; o >>= 1) { if (threadIdx.x < o) red[threadIdx.x] += red[threadIdx.x + o]; __syncthreads(); }
    float rs = rsqrtf(red[0] / DM + EPS);
    for (int i = 0; i < 4; ++i) { int j = threadIdx.x + 256 * i; P.out[(size_t)t * DM + j] = v[i] * rs * P.in[27][j]; }
}

#define GAS __attribute__((address_space(1)))
#define LAS __attribute__((address_space(3)))
typedef short bf16x8 __attribute__((ext_vector_type(8)));
typedef short s16x4 __attribute__((ext_vector_type(4)));
typedef float f32x4 __attribute__((ext_vector_type(4)));
typedef float f32x2 __attribute__((ext_vector_type(2)));
typedef float f32x16 __attribute__((ext_vector_type(16)));
typedef unsigned u32x4 __attribute__((ext_vector_type(4)));
typedef unsigned u32x2 __attribute__((ext_vector_type(2)));
#define RLX_AGENT __ATOMIC_RELAXED, __HIP_MEMORY_SCOPE_AGENT
#define LDS_WAIT() asm volatile("s_waitcnt lgkmcnt(0)" ::: "memory")
#define VM_WAIT() asm volatile("s_waitcnt vmcnt(0)" ::: "memory")

constexpr size_t WS_MODP = 1 * MiB;
constexpr size_t WS_WIN = 4 * MiB;
constexpr size_t WS_WUP = 8 * MiB;
constexpr size_t WS_WOUT = 10 * MiB;
constexpr size_t WS_WR = 12 * MiB;
constexpr size_t WS_W13 = 16 * MiB;
constexpr size_t WS_W2 = 273 * MiB;
constexpr size_t WS_UT = WS_OFF + 4096;
static_assert(WS_W2 + (size_t)257 * 1024 * 256 * 2 <= WS_X1, "ws map");
constexpr int CW_NUNIT = 2048;
constexpr int CW_BAR = 4096;

__device__ __forceinline__ unsigned cvt_pk_bf16(float lo, float hi) { unsigned r; asm volatile("v_cvt_pk_bf16_f32 %0, %1, %2" : "=v"(r) : "v"(lo), "v"(hi)); return r; }
__device__ __forceinline__ unsigned pk2(float lo, float hi) { return f2bf(lo) | (f2bf(hi) << 16); }
__device__ __forceinline__ u32x4 pack8(f32x4 a, f32x4 b) { u32x4 w; w.x = cvt_pk_bf16(a[0], a[1]); w.y = cvt_pk_bf16(a[2], a[3]); w.z = cvt_pk_bf16(b[0], b[1]); w.w = cvt_pk_bf16(b[2], b[3]); return w; }
__device__ __forceinline__ float wave_sum(float v) {
#pragma unroll
    for (int o = 1; o < 64; o <<= 1) v += __shfl_xor(v, o);
    return v;
}

namespace pg8 {
constexpr int BM = 256, BK = 64, HALF = 128, HTB = HALF * BK * 2, STAGE_BYTES = 8 * HTB;
__host__ __device__ __forceinline__ int lds_byte(int r, int c) { const int st = (r >> 4) * 2 + (c >> 5), rr = r & 15, cc = c & 31, ob = rr * 64 + cc * 2; return st * 1024 + (ob ^ (((ob >> 9) & 1) << 5)); }
__host__ __device__ __forceinline__ void stage_rc(int b, int& R, int& C) { const int st = b / 1024, sb = b % 1024, swz = sb ^ (((sb >> 9) & 1) << 5); R = (st >> 1) * 16 + swz / 64; C = (st & 1) * 32 + (swz % 64) / 2; }
__host__ __device__ __forceinline__ int perm32(int rho) { const int n = rho >> 4, i = rho & 15; return 8 * (i >> 2) + 4 * n + (i & 3); }

struct Unit { int pm, pn, r0, nv; };
struct Gemm { const bf16* A; const bf16* Bt; int lda, K; };

struct StaticOrder {
    int nM, nN, nwg, G, c;
    __device__ void init(int M, int N, int G_, int c_) { nM = M / BM; nN = N / BM; nwg = nM * nN; G = G_; c = c_; }
    __device__ bool next(int i, Unit& u) const {
        const long L = (long)i * G + c; if (L >= nwg) return false;
        int wgid = (int)L; { const int q = nwg / 8, r = nwg % 8, xcd = wgid % 8, off = wgid / 8; wgid = (xcd < r ? xcd * (q + 1) : r * (q + 1) + (xcd - r) * q) + off; }
        const int nig = 8 * nN, gid = wgid / nig, fm = gid * 8, gsz = (nM - fm) < 8 ? (nM - fm) : 8;
        u.pm = fm + ((wgid % nig) % gsz); u.pn = (wgid % nig) / gsz; u.r0 = u.pm * BM; u.nv = BM; return true;
    }
    __device__ __forceinline__ int a_row(const Unit& u, int r) const { return u.pm * BM + r; }
};

template <class Epi, class Sched>
__device__ __forceinline__ void gemm_phase(LAS unsigned char* lds, const Gemm g, const Sched& S, const Epi& E) {
    const int tid = threadIdx.x, wid = __builtin_amdgcn_readfirstlane(tid >> 6), lane = tid & 63, wr = wid >> 2, wc = wid & 3, fr = lane & 15, fq = lane >> 4;
    int K = g.K; asm volatile("" : "+s"(K));
    const int nt = K / BK;
    int RA[2], CA[2]; unsigned voffB[2];
#pragma unroll
    for (int i = 0; i < 2; ++i) { int R, C; stage_rc(tid * 16 + i * 8192, R, C); RA[i] = R; CA[i] = C; const int Rb = Epi::PERM ? ((R & ~31) + perm32(R & 31)) : R; voffB[i] = (unsigned)(Rb * K + C) * 2u; }
    const size_t kstep = (size_t)(BK * 2);
    const size_t hstepB = (size_t)HALF * K * 2, tstepB = 2 * hstepB;
    const unsigned ldsw = (unsigned)wid * 1024u;
    const int aoff = lds_byte(wr * 64 + fr, fq * 8), boff = lds_byte(wc * 32 + fr, fq * 8);
#define PG8_SA(b, h) (((b) * 2 + (h)) * HTB)
#define PG8_SB(b, h) ((4 + (b) * 2 + (h)) * HTB)
#define PG8_STAGE(bufoff, gbase, voff) do { _Pragma("unroll") for (int _i = 0; _i < 2; ++_i) \
        __builtin_amdgcn_global_load_lds((const unsigned*)((const char*)(gbase) + (voff)[_i]), (LAS unsigned*)(lds + (bufoff) + ldsw + _i * 8192), 16, 0, 0); } while (0)
#define PG8_LDA(dst, b, h) do { _Pragma("unroll") for (int m = 0; m < 4; ++m) _Pragma("unroll") for (int k = 0; k < 2; ++k) dst[m][k] = *(const LAS bf16x8*)(lds + PG8_SA(b, h) + aoff + m * 2048 + k * 1024); } while (0)
#define PG8_LDB(dst, b, h) do { _Pragma("unroll") for (int n = 0; n < 2; ++n) _Pragma("unroll") for (int k = 0; k < 2; ++k) dst[n][k] = *(const LAS bf16x8*)(lds + PG8_SB(b, h) + boff + n * 2048 + k * 1024); } while (0)
#define PG8_MMA(ai, bj, At, Bt) do { __builtin_amdgcn_s_setprio(1); _Pragma("unroll") for (int m = 0; m < 4; ++m) _Pragma("unroll") for (int n = 0; n < 2; ++n) _Pragma("unroll") for (int k = 0; k < 2; ++k) \
        acc[ai][bj][m][n] = __builtin_amdgcn_mfma_f32_16x16x32_bf16(Bt[n][k], At[m][k], acc[ai][bj][m][n], 0, 0, 0); __builtin_amdgcn_s_setprio(0); } while (0)
#define PG8_WAIT_V(n) asm volatile("s_waitcnt vmcnt(" #n ")" ::: "memory")
#define PG8_WAIT_L(n) asm volatile("s_waitcnt lgkmcnt(" #n ")" ::: "memory")
#define PG8_BAR __builtin_amdgcn_s_barrier()
#define PG8_SCHED __builtin_amdgcn_sched_barrier(0)
#define PG8_AOFFS(dst, u) do { _Pragma("unroll") for (int _h = 0; _h < 2; ++_h) _Pragma("unroll") for (int _i = 0; _i < 2; ++_i) \
        dst[_h][_i] = (unsigned)(((size_t)S.a_row(u, _h * HALF + RA[_i]) * (size_t)g.lda + (size_t)CA[_i]) * 2u); } while (0)
    Unit cur, nxt; int ui = 0;
    if (!S.next(0, cur)) return;
    f32x4 acc[2][2][4][2];
#pragma unroll
    for (int a = 0; a < 2; ++a)
#pragma unroll
        for (int b = 0; b < 2; ++b)
#pragma unroll
            for (int m = 0; m < 4; ++m)
#pragma unroll
                for (int n = 0; n < 2; ++n) acc[a][b][m][n] = (f32x4){0.f, 0.f, 0.f, 0.f};
    bf16x8 At[4][2], B0[2][2], B1[2][2];
    unsigned vA[2][2], vN[2][2];
    PG8_AOFFS(vA, cur);
    const char* Ab = (const char*)g.A; const char* cB = (const char*)g.Bt + (size_t)cur.pn * tstepB;
    PG8_STAGE(PG8_SB(0, 0), cB, voffB); PG8_STAGE(PG8_SB(0, 1), cB + hstepB, voffB); PG8_STAGE(PG8_SA(0, 0), Ab, vA[0]); PG8_STAGE(PG8_SA(0, 1), Ab, vA[1]);
    if (wr == 1) PG8_BAR;
    PG8_WAIT_V(2); PG8_BAR;
    PG8_STAGE(PG8_SB(1, 0), cB + kstep, voffB); PG8_STAGE(PG8_SA(1, 0), Ab + kstep, vA[0]); PG8_STAGE(PG8_SB(1, 1), cB + hstepB + kstep, voffB);
    PG8_WAIT_V(6); PG8_BAR;
    for (;;) {
        const bool has_next = S.next(ui + 1, nxt);
        const char* nB = has_next ? (const char*)g.Bt + (size_t)nxt.pn * tstepB : cB;
        if (has_next) { PG8_AOFFS(vN, nxt); } else { vN[0][0] = vA[0][0]; vN[0][1] = vA[0][1]; vN[1][0] = vA[1][0]; vN[1][1] = vA[1][1]; }
        for (int t = 0; t < nt; t += 2) {
            const bool last = (t == nt - 2);
            const char* a1 = Ab + (size_t)(t + 1) * kstep;
            const char* a2 = Ab + (last ? (size_t)0 : (size_t)(t + 2) * kstep); const char* b2 = last ? nB : cB + (size_t)(t + 2) * kstep;
            const char* a3 = a2 + kstep; const char* b3 = b2 + kstep;
            unsigned w0[2], w1[2];
            w0[0] = last ? vN[0][0] : vA[0][0]; w0[1] = last ? vN[0][1] : vA[0][1]; w1[0] = last ? vN[1][0] : vA[1][0]; w1[1] = last ? vN[1][1] : vA[1][1];
            PG8_LDB(B0, 0, 0); PG8_LDB(B1, 0, 1); PG8_SCHED; PG8_LDA(At, 0, 0); PG8_STAGE(PG8_SA(1, 1), a1, vA[1]);
            PG8_WAIT_V(8); PG8_WAIT_L(0); PG8_BAR; PG8_MMA(0, 0, At, B0); PG8_MMA(0, 1, At, B1); PG8_BAR; PG8_SCHED;
            PG8_LDA(At, 0, 1); PG8_STAGE(PG8_SB(0, 0), b2, voffB); PG8_STAGE(PG8_SB(0, 1), b2 + hstepB, voffB); PG8_STAGE(PG8_SA(0, 0), a2, w0);
            PG8_WAIT_V(8); PG8_WAIT_L(0); PG8_BAR; PG8_MMA(1, 0, At, B0); PG8_MMA(1, 1, At, B1); PG8_BAR; PG8_SCHED;
            PG8_LDB(B0, 1, 0); PG8_LDB(B1, 1, 1); PG8_SCHED; PG8_LDA(At, 1, 0); PG8_STAGE(PG8_SA(0, 1), a2, w1);
            PG8_WAIT_V(8); PG8_WAIT_L(0); PG8_BAR; PG8_MMA(0, 0, At, B0); PG8_MMA(0, 1, At, B1); PG8_BAR; PG8_SCHED;
            PG8_LDA(At, 1, 1); PG8_STAGE(PG8_SB(1, 0), b3, voffB); PG8_STAGE(PG8_SB(1, 1), b3 + hstepB, voffB); PG8_STAGE(PG8_SA(1, 0), a3, w0);
            PG8_WAIT_V(8); PG8_WAIT_L(0); PG8_BAR; PG8_MMA(1, 0, At, B0); PG8_MMA(1, 1, At, B1); PG8_BAR; PG8_SCHED;
        }
        if (wr == 0) PG8_BAR;
        E(acc, cur, wr, wc, fr, fq);
        if (!has_next) break;
#pragma unroll
        for (int a = 0; a < 2; ++a)
#pragma unroll
            for (int b = 0; b < 2; ++b)
#pragma unroll
                for (int m = 0; m < 4; ++m)
#pragma unroll
                    for (int n = 0; n < 2; ++n) acc[a][b][m][n] = (f32x4){0.f, 0.f, 0.f, 0.f};
        cur = nxt; cB = nB; ++ui;
        vA[0][0] = vN[0][0]; vA[0][1] = vN[0][1]; vA[1][0] = vN[1][0]; vA[1][1] = vN[1][1];
        if (wr == 1) PG8_BAR;
    }
    PG8_WAIT_V(0);
    PG8_BAR;
#undef PG8_SA
#undef PG8_SB
#undef PG8_STAGE
#undef PG8_LDA
#undef PG8_LDB
#undef PG8_MMA
#undef PG8_WAIT_V
#undef PG8_WAIT_L
#undef PG8_BAR
#undef PG8_SCHED
#undef PG8_AOFFS
}
}

using pg8::Unit;
typedef f32x4 Acc[2][2][4][2];

struct EpiInProj {
    static constexpr bool PERM = true;
    bf16* P1; float* SSQ; const float2* TD; const float2* TM;
    __device__ __forceinline__ void operator()(const Acc& acc, const Unit& u, int wr, int wc, int fr, int fq) const {
        const int pm = u.pm, pn = u.pn, jt = pm % 17; const bool lat = jt > 0;
        const int row0 = pm * 256 + wr * 64 + fr, col0 = pn * 256 + wc * 32 + 8 * fq;
        if (pn == 0 || pn >= 6 || (pn == 1)) {
#pragma unroll
            for (int ai = 0; ai < 2; ++ai)
#pragma unroll
                for (int m = 0; m < 4; ++m) {
                    const int r = row0 + ai * 128 + m * 16; bf16* rowp = P1 + (size_t)r * NP1 + col0;
                    *(u32x4*)(rowp) = pack8(acc[ai][0][m][0], acc[ai][0][m][1]);
                    if (pn != 1) *(u32x4*)(rowp + 128) = pack8(acc[ai][1][m][0], acc[ai][1][m][1]);
                    if (pn <= 1) {
                        float s = 0.f;
#pragma unroll
                        for (int bj = 0; bj < 2; ++bj) { if (pn == 1 && bj == 1) break;
#pragma unroll
                            for (int n = 0; n < 2; ++n) { const f32x4 x = acc[ai][bj][m][n]; s += (x[0] * x[0] + x[1] * x[1]) + (x[2] * x[2] + x[3] * x[3]); } }
                        s += __shfl_xor(s, 16); s += __shfl_xor(s, 32);
                        if (fq == 0) SSQ[(size_t)r * 8 + pn * 4 + wc] = s;
                    }
                    if (pn == 1 && wc == 0) {
                        f32x4 x1 = acc[ai][1][m][0], x2 = acc[ai][1][m][1], o1 = x1, o2 = x2;
                        if (lat) { const int gr = (jt - 1) * 4 + 2 * ai + wr, gc = 16 * m + fr;
                            const float2* tp = TM + (fq < 2 ? gr * 8 + 4 * fq : gc * 8 + 4 * (fq - 2));
                            const f32x4 t0 = *(const f32x4*)tp, t1 = *(const f32x4*)(tp + 2);
                            const f32x4 cs = {t0[0], t0[2], t1[0], t1[2]}, sn = {t0[1], t0[3], t1[1], t1[3]};
                            o1 = x1 * cs - x2 * sn; o2 = x1 * sn + x2 * cs; }
                        *(u32x4*)(rowp + 128) = pack8(o1, o2);
                    }
                }
        } else {
            const int g = wc & 1;
#pragma unroll
            for (int ai = 0; ai < 2; ++ai) {
                const int gr = (jt - 1) * 4 + 2 * ai + wr;
#pragma unroll
                for (int m = 0; m < 4; ++m) {
                    const int r = row0 + ai * 128 + m * 16; bf16* rowp = P1 + (size_t)r * NP1 + col0;
                    f32x4 cs = {1.f, 1.f, 1.f, 1.f}, sn = {0.f, 0.f, 0.f, 0.f};
                    if (lat) { const int gc = 16 * m + fr; const float2* tp = TD + (g == 0 ? gr : gc) * 16 + 4 * fq;
                        const f32x4 t0 = *(const f32x4*)tp, t1 = *(const f32x4*)(tp + 2);
                        cs = (f32x4){t0[0], t0[2], t1[0], t1[2]}; sn = (f32x4){t0[1], t0[3], t1[1], t1[3]}; }
#pragma unroll
                    for (int bj = 0; bj < 2; ++bj) { const f32x4 x1 = acc[ai][bj][m][0], x2 = acc[ai][bj][m][1];
                        *(u32x4*)(rowp + bj * 128) = pack8(x1 * cs - x2 * sn, x1 * sn + x2 * cs); }
                }
            }
        }
    }
};

struct EpiUp {
    static constexpr bool PERM = true;
    bf16* QM; bf16* KVM; const float* SSQ; const float2* TM;
    __device__ __forceinline__ void operator()(const Acc& acc, const Unit& u, int wr, int wc, int fr, int fq) const {
        const int pm = u.pm, pn = u.pn, jt = pm % 17; const bool lat = jt > 0, isq = pn < 3;
        const int row0 = pm * 256 + wr * 64 + fr, col0 = pn * 256 + wc * 32 + 8 * fq;
#pragma unroll
        for (int ai = 0; ai < 2; ++ai)
#pragma unroll
            for (int m = 0; m < 4; ++m) {
                const int r = row0 + ai * 128 + m * 16;
                const f32x4 sq = *(const f32x4*)(SSQ + (size_t)r * 8 + (isq ? 0 : 4));
                const float rs = rsqrtf(((sq[0] + sq[1]) + (sq[2] + sq[3])) * (isq ? 1.f / 256.f : 1.f / 128.f) + EPS);
#pragma unroll
                for (int bj = 0; bj < 2; ++bj) {
                    f32x4 x1 = acc[ai][bj][m][0] * rs, x2 = acc[ai][bj][m][1] * rs;
                    if (isq) {
                        const int G = 8 * pn + 4 * bj + wc;
                        if (lat && (G % 3) == 2) { const int gr = (jt - 1) * 4 + 2 * ai + wr, gc = 16 * m + fr;
                            const float2* tp = TM + (fq < 2 ? gr * 8 + 4 * fq : gc * 8 + 4 * (fq - 2));
                            const f32x4 t0 = *(const f32x4*)tp, t1 = *(const f32x4*)(tp + 2);
                            const f32x4 cs = {t0[0], t0[2], t1[0], t1[2]}, sn = {t0[1], t0[3], t1[1], t1[3]};
                            const f32x4 o1 = x1 * cs - x2 * sn, o2 = x1 * sn + x2 * cs; x1 = o1; x2 = o2; }
                        *(u32x4*)(QM + (size_t)r * 768 + col0 + bj * 128) = pack8(x1, x2);
                    } else *(u32x4*)(KVM + (size_t)r * 1024 + (col0 - 768) + bj * 128) = pack8(x1, x2);
                }
            }
    }
};

struct EpiOut {
    static constexpr bool PERM = false;
    const float* x; const float* MOD; float* X1;
    __device__ __forceinline__ void operator()(const Acc& acc, const Unit& u, int wr, int wc, int fr, int fq) const {
        const int b = u.pm / 16; const float* gt = MOD + b * 6144 + 2048;
        const int row0 = u.pm * 256 + wr * 64 + fr, col0 = u.pn * 256 + wc * 32 + 4 * fq;
        f32x4 gv[2][2];
#pragma unroll
        for (int bj = 0; bj < 2; ++bj)
#pragma unroll
            for (int n = 0; n < 2; ++n) gv[bj][n] = *(const f32x4*)(gt + col0 + bj * 128 + n * 16);
#pragma unroll
        for (int ai = 0; ai < 2; ++ai)
#pragma unroll
            for (int m = 0; m < 4; ++m) { const size_t off = (size_t)(row0 + ai * 128 + m * 16) * DM + col0;
#pragma unroll
                for (int bj = 0; bj < 2; ++bj)
#pragma unroll
                    for (int n = 0; n < 2; ++n) { const f32x4 xv = *(const f32x4*)(x + off + bj * 128 + n * 16);
                        *(f32x4*)(X1 + off + bj * 128 + n * 16) = xv + gv[bj][n] * acc[ai][bj][m][n]; } }
    }
};
struct EpiF32 {
    static constexpr bool PERM = false;
    float* O; int ldc;
    __device__ __forceinline__ void operator()(const Acc& acc, const Unit& u, int wr, int wc, int fr, int fq) const {
        const int row0 = u.pm * 256 + wr * 64 + fr, col0 = u.pn * 256 + wc * 32 + 4 * fq;
#pragma unroll
        for (int ai = 0; ai < 2; ++ai)
#pragma unroll
            for (int m = 0; m < 4; ++m) { const size_t off = (size_t)(row0 + ai * 128 + m * 16) * ldc + col0;
#pragma unroll
                for (int bj = 0; bj < 2; ++bj)
#pragma unroll
                    for (int n = 0; n < 2; ++n) *(f32x4*)(O + off + bj * 128 + n * 16) = acc[ai][bj][m][n]; }
    }
};
struct EpiAct {
    static constexpr bool PERM = true;
    bf16* ACT;
    __device__ __forceinline__ void operator()(const Acc& acc, const Unit& u, int wr, int wc, int fr, int fq) const {
        const int half = u.pn & 1, colb = half * 128 + wc * 32 + 8 * fq;
#pragma unroll
        for (int ai = 0; ai < 2; ++ai)
#pragma unroll
            for (int m = 0; m < 4; ++m) { const int tr = ai * 128 + wr * 64 + m * 16 + fr;
                f32x4 a[2];
#pragma unroll
                for (int n = 0; n < 2; ++n) { const f32x4 gt = acc[ai][0][m][n], up = acc[ai][1][m][n];
#pragma unroll
                    for (int e = 0; e < 4; ++e) a[n][e] = gt[e] * __builtin_amdgcn_rcpf(1.f + __expf(-gt[e])) * up[e]; }
                if (tr < u.nv) *(u32x4*)(ACT + (size_t)(u.r0 + tr) * EFF + colb) = pack8(a[0], a[1]); }
    }
};
struct EpiY {
    static constexpr bool PERM = true;
    bf16* Y; const float* SW;
    __device__ __forceinline__ void operator()(const Acc& acc, const Unit& u, int wr, int wc, int fr, int fq) const {
        const int colb = (u.pn & 3) * 256 + wc * 32 + 8 * fq;
#pragma unroll
        for (int ai = 0; ai < 2; ++ai)
#pragma unroll
            for (int m = 0; m < 4; ++m) { const int tr = ai * 128 + wr * 64 + m * 16 + fr;
                if (tr < u.nv) { const float w = SW[u.r0 + tr]; bf16* rowp = Y + (size_t)(u.r0 + tr) * DM + colb;
#pragma unroll
                    for (int bj = 0; bj < 2; ++bj) *(u32x4*)(rowp + bj * 128) = pack8(acc[ai][bj][m][0] * w, acc[ai][bj][m][1] * w); } }
    }
};

template <int SUB, bool GATHER> struct ExpSched {
    const int* ut; int ntot; int G, c; const int* slot_tok;
    __device__ bool next(int i, Unit& u) const {
        const int L = i * G + c; if (L >= ntot) return false;
        const int cu = L / SUB, sub = L % SUB;
        const int e = __builtin_amdgcn_readfirstlane(__hip_atomic_load(ut + cu * 4 + 0, RLX_AGENT));
        const int r0 = __builtin_amdgcn_readfirstlane(__hip_atomic_load(ut + cu * 4 + 1, RLX_AGENT));
        const int nv = __builtin_amdgcn_readfirstlane(__hip_atomic_load(ut + cu * 4 + 2, RLX_AGENT));
        u.pm = cu; u.pn = e * SUB + sub; u.r0 = r0; u.nv = nv; return true;
    }
    __device__ __forceinline__ int a_row(const Unit& u, int r) const {
        if (GATHER) return r < u.nv ? slot_tok[u.r0 + r] : 0;
        const int s = u.r0 + r; return s < NSLOT ? s : NSLOT - 1;
    }
};

namespace attn {
#define SBAR() __builtin_amdgcn_sched_barrier(0)
constexpr float THR = 8.f;
template <int MODE> struct Cfg;
template <> struct Cfg<0> { static constexpr int DQK = 96, DV = 64, LDQ = 768, LDK0 = 1024, LDK1 = 2048, LDV = 1024; static constexpr float SCALE = 0.10206207261596575f; };
template <> struct Cfg<1> { static constexpr int DQK = 64, DV = 128, LDQ = 2048, LDK0 = 2048, LDK1 = 2048, LDV = 2048; static constexpr float SCALE = 0.125f; };
__device__ __forceinline__ int crow(int r, int hi) { return (r & 3) + 8 * (r >> 2) + 4 * hi; }
__device__ __forceinline__ unsigned cvtpk(float lo, float hi) { unsigned r; asm volatile("v_cvt_pk_bf16_f32 %0, %1, %2" : "=v"(r) : "v"(lo), "v"(hi)); return r; }

template <int MODE> __device__ __forceinline__ void partialSM(f32x16& p0, f32x16& p1, float& m_reg, float& mn, float& alpha) {
    constexpr float SCALE = Cfg<MODE>::SCALE, C = SCALE * 1.4426950408889634f;
    float pmax = p0[0];
#pragma unroll
    for (int r = 1; r < 16; ++r) pmax = fmaxf(pmax, p0[r]);
#pragma unroll
    for (int r = 0; r < 16; ++r) pmax = fmaxf(pmax, p1[r]);
    { auto rr = __builtin_amdgcn_permlane32_swap(__float_as_uint(pmax), __float_as_uint(pmax), false, false);
      pmax = fmaxf(__uint_as_float(rr[0]), __uint_as_float(rr[1])); }
    if (__builtin_expect(__all(pmax - m_reg <= THR / SCALE), 1)) { mn = m_reg; alpha = 1.f; }
    else { mn = fmaxf(m_reg, pmax); alpha = __builtin_amdgcn_exp2f((m_reg - mn) * C); m_reg = mn; }
    const float mnC = -mn * C;
#pragma unroll
    for (int r = 0; r < 16; ++r) p0[r] = fmaf(p0[r], C, mnC);
#pragma unroll
    for (int r = 0; r < 16; ++r) p1[r] = fmaf(p1[r], C, mnC);
#pragma unroll
    for (int r = 0; r < 16; ++r) p0[r] = __builtin_amdgcn_exp2f(p0[r]);
}
__device__ __forceinline__ void finishSM(f32x16& p0, f32x16& p1, float alpha, float& l_reg, bf16x8& pa0, bf16x8& pa1, bf16x8& pa2, bf16x8& pa3) {
#pragma unroll
    for (int r = 0; r < 16; ++r) p1[r] = __builtin_amdgcn_exp2f(p1[r]);
    float ps = 0;
#pragma unroll
    for (int r = 0; r < 16; ++r) ps += p0[r];
#pragma unroll
    for (int r = 0; r < 16; ++r) ps += p1[r];
    { auto rr = __builtin_amdgcn_permlane32_swap(__float_as_uint(ps), __float_as_uint(ps), false, false);
      ps = __uint_as_float(rr[0]) + __uint_as_float(rr[1]); }
    l_reg = l_reg * alpha + ps;
#define PK4(P, BASE, OUT) do { unsigned a0 = cvtpk(P[BASE + 0], P[BASE + 1]), a1 = cvtpk(P[BASE + 2], P[BASE + 3]);   \
    unsigned b0 = cvtpk(P[BASE + 4], P[BASE + 5]), b1 = cvtpk(P[BASE + 6], P[BASE + 7]);                              \
    auto r0 = __builtin_amdgcn_permlane32_swap(a0, b0, false, false); auto r1 = __builtin_amdgcn_permlane32_swap(a1, b1, false, false); \
    u32x4 w = {r0[0], r1[0], r0[1], r1[1]}; OUT = *reinterpret_cast<bf16x8*>(&w); } while (0)
    PK4(p0, 0, pa0); PK4(p0, 8, pa1); PK4(p1, 0, pa2); PK4(p1, 8, pa3);
#undef PK4
}
template <int NQ, int KROW> __device__ __forceinline__ void qkt(f32x16& p0, f32x16& p1, const char* Ks, const bf16x8* qr, int r32, int hi) {
    p0 = f32x16{}; p1 = f32x16{};
#pragma unroll
    for (int d0 = 0; d0 < NQ; ++d0) { const int cb = d0 * 32 + hi * 16;
        const bf16x8 b0 = *reinterpret_cast<const bf16x8*>(Ks + r32 * KROW + cb);
        const bf16x8 b1 = *reinterpret_cast<const bf16x8*>(Ks + (32 + r32) * KROW + cb);
        p0 = __builtin_amdgcn_mfma_f32_32x32x16_bf16(b0, qr[d0], p0, 0, 0, 0);
        p1 = __builtin_amdgcn_mfma_f32_32x32x16_bf16(b1, qr[d0], p1, 0, 0, 0); }
}
template <int NC> __device__ __forceinline__ int v_st(int k, int c) { const int kk = (k & ~0xC) | ((k & 4) << 1) | ((k & 8) >> 1); return ((kk >> 3) * NC + (c >> 5)) * 512 + ((kk & 7) * 32 + (c & 31)) * 2; }
__device__ __forceinline__ int v_rd_base(int lane) { return ((lane & 3) << 3) | (((lane >> 2) & 3) << 6) | (((lane >> 4) & 1) << 5) | (((lane >> 5) & 1) << 8); }
template <int OFF> __device__ __forceinline__ s16x4 tr_read(int vb) {
    s16x4 r; asm volatile("ds_read_b64_tr_b16 %0, %1 offset:%2" : "=&v"(r) : "v"(vb), "i"(OFF) : "memory"); return r;
}
template <int NC, int D0> __device__ __forceinline__ void pv_one(f32x16& od, int vb, bf16x8 pa0, bf16x8 pa1, bf16x8 pa2, bf16x8 pa3) {
#define VOFF(ks, half) (D0 * 512 + (ks) * (NC * 1024) + (half) * (NC * 512))
    const s16x4 l0 = tr_read<VOFF(0, 0)>(vb), h0 = tr_read<VOFF(0, 1)>(vb), l1 = tr_read<VOFF(1, 0)>(vb), h1 = tr_read<VOFF(1, 1)>(vb);
    const s16x4 l2 = tr_read<VOFF(2, 0)>(vb), h2 = tr_read<VOFF(2, 1)>(vb), l3 = tr_read<VOFF(3, 0)>(vb), h3 = tr_read<VOFF(3, 1)>(vb);
#undef VOFF
    asm volatile("s_waitcnt lgkmcnt(0)" ::: "memory"); SBAR();
#define PK(L, H) (bf16x8){L[0], L[1], L[2], L[3], H[0], H[1], H[2], H[3]}
    od = __builtin_amdgcn_mfma_f32_32x32x16_bf16(pa0, PK(l0, h0), od, 0, 0, 0);
    od = __builtin_amdgcn_mfma_f32_32x32x16_bf16(pa1, PK(l1, h1), od, 0, 0, 0);
    od = __builtin_amdgcn_mfma_f32_32x32x16_bf16(pa2, PK(l2, h2), od, 0, 0, 0);
    od = __builtin_amdgcn_mfma_f32_32x32x16_bf16(pa3, PK(l3, h3), od, 0, 0, 0);
#undef PK
}
template <int NC> __device__ __forceinline__ void pv_all(f32x16* o, int vb, bf16x8 pa0, bf16x8 pa1, bf16x8 pa2, bf16x8 pa3) {
    pv_one<NC, 0>(o[0], vb, pa0, pa1, pa2, pa3); pv_one<NC, 1>(o[1], vb, pa0, pa1, pa2, pa3);
    if constexpr (NC == 4) { pv_one<NC, 2>(o[2], vb, pa0, pa1, pa2, pa3); pv_one<NC, 3>(o[3], vb, pa0, pa1, pa2, pa3); }
}
template <int MODE> constexpr int lds_bytes() { return 2 * 64 * Cfg<MODE>::DV * 2 + 2 * 64 * (Cfg<MODE>::DQK * 2 + 16) + 8 * 64 * 4; }

template <int MODE>
__device__ __forceinline__ void unit(const bf16* __restrict__ Qb, const bf16* __restrict__ K0, const bf16* __restrict__ K1, const bf16* __restrict__ Vh, void* Ob, int ldo, char* lds) {
    using C = Cfg<MODE>;
    constexpr int DQK = C::DQK, DV = C::DV, NQ = DQK / 16, NC = DV / 32, KROW = DQK * 2 + 16, SHM_K = 64 * KROW, SHM_V = 64 * DV * 2;
    const int tid = threadIdx.x, wid = tid >> 6, lane = tid & 63, r32 = lane & 31, hi = lane >> 5;
    char* V_lds = lds; char* K_lds = lds + 2 * SHM_V;
    float* ws = (float*)(lds + 2 * SHM_V + 2 * SHM_K) + wid * 64; float* li_l = ws; float* al_l = ws + 32;
    float m_reg = -1e30f, l_reg = 0; f32x16 o[NC]; bf16x8 qr[NQ];
#pragma unroll
    for (int d = 0; d < NC; ++d) o[d] = f32x16{};
    const bf16* Qw = Qb + (size_t)(wid * 32 + r32) * C::LDQ + hi * 8;
#pragma unroll
    for (int d0 = 0; d0 < NQ; ++d0) qr[d0] = *reinterpret_cast<const bf16x8*>(Qw + d0 * 16);
    const int vb0 = (int)(uintptr_t)V_lds + v_rd_base(lane);
    const int kr0 = tid >> 3, kc0 = tid & 7;
    const int krr = (tid & 255) >> 2, krc = tid & 3;
    const int vr0 = MODE == 0 ? (tid >> 3) : (tid >> 4), vc0 = MODE == 0 ? (tid & 7) * 8 : (tid & 15) * 8;
    const int vst0 = v_st<NC>(vr0, vc0), vst1 = v_st<NC>(32 + vr0, vc0);
    struct { bf16x8 ka, kb, va, vb; } sr_[2];
#define SLOAD(i, k0) do { sr_[i].ka = *reinterpret_cast<const bf16x8*>(K0 + (size_t)((k0) + kr0) * C::LDK0 + kc0 * 8); \
        if (MODE == 0) { sr_[i].kb = *reinterpret_cast<const bf16x8*>(K1 + (size_t)((k0) + krr) * C::LDK1 + krc * 8); } \
        sr_[i].va = *reinterpret_cast<const bf16x8*>(Vh + (size_t)((k0) + vr0) * C::LDV + vc0); \
        if (MODE == 1) { sr_[i].vb = *reinterpret_cast<const bf16x8*>(Vh + (size_t)((k0) + 32 + vr0) * C::LDV + vc0); } } while (0)
#define SWRITE(b, i) do { *(bf16x8*)(K_lds + (b) * SHM_K + kr0 * KROW + kc0 * 16) = sr_[i].ka; \
        if (MODE == 0) { *(bf16x8*)(K_lds + (b) * SHM_K + krr * KROW + 128 + krc * 16) = sr_[i].kb; } \
        *(bf16x8*)(V_lds + (b) * SHM_V + vst0) = sr_[i].va; \
        if (MODE == 1) { *(bf16x8*)(V_lds + (b) * SHM_V + vst1) = sr_[i].vb; } } while (0)
#define SWAIT() asm volatile("s_waitcnt vmcnt(3)" ::: "memory")
#define RESC(a) do { if (__any((a) < 1.f)) { if (hi == 0) al_l[r32] = (a); asm volatile("s_waitcnt lgkmcnt(0)" ::: "memory"); \
        _Pragma("unroll") for (int d = 0; d < NC; ++d) _Pragma("unroll") for (int r = 0; r < 16; ++r) o[d][r] *= al_l[crow(r, hi)]; } } while (0)
    f32x16 pA0, pA1, pB0, pB1; float mnA, mnB, alA, alB; bf16x8 pa0, pa1, pa2, pa3; constexpr int NT = NTOK / 64;
    constexpr int SE = 0, SO = 1;
    SLOAD(SE, 0); asm volatile("s_waitcnt vmcnt(0)" ::: "memory"); SWRITE(0, SE); __syncthreads();
    qkt<NQ, KROW>(pA0, pA1, K_lds, qr, r32, hi); partialSM<MODE>(pA0, pA1, m_reg, mnA, alA);
    SLOAD(SO, 64); SLOAD(SE, 128);
    SWAIT(); SWRITE(1, SO); __syncthreads();
    for (int j = 1; j + 1 < NT; j += 2) {
        SBAR(); qkt<NQ, KROW>(pB0, pB1, K_lds + SHM_K, qr, r32, hi);
        finishSM(pA0, pA1, alA, l_reg, pa0, pa1, pa2, pa3); SBAR();
        SLOAD(SO, (j + 2) * 64); SBAR();
        pv_all<NC>(o, vb0, pa0, pa1, pa2, pa3); partialSM<MODE>(pB0, pB1, m_reg, mnB, alB);
        __syncthreads(); SWAIT(); SWRITE(0, SE);
        RESC(alB); __syncthreads();
        SBAR(); qkt<NQ, KROW>(pA0, pA1, K_lds, qr, r32, hi);
        finishSM(pB0, pB1, alB, l_reg, pa0, pa1, pa2, pa3); SBAR();
        if (j + 3 < NT) SLOAD(SE, (j + 3) * 64); SBAR();
        pv_all<NC>(o, vb0 + SHM_V, pa0, pa1, pa2, pa3); partialSM<MODE>(pA0, pA1, m_reg, mnA, alA);
        __syncthreads(); if (j + 3 < NT) { SWAIT(); } else { asm volatile("s_waitcnt vmcnt(0)" ::: "memory"); } SWRITE(1, SO);
        RESC(alA); __syncthreads();
    }
    SBAR(); qkt<NQ, KROW>(pB0, pB1, K_lds + SHM_K, qr, r32, hi);
    finishSM(pA0, pA1, alA, l_reg, pa0, pa1, pa2, pa3); SBAR();
    pv_all<NC>(o, vb0, pa0, pa1, pa2, pa3); partialSM<MODE>(pB0, pB1, m_reg, mnB, alB);
    __syncthreads(); RESC(alB);
    finishSM(pB0, pB1, alB, l_reg, pa0, pa1, pa2, pa3); SBAR();
    pv_all<NC>(o, vb0 + SHM_V, pa0, pa1, pa2, pa3);
    if (hi == 0) li_l[r32] = l_reg; asm volatile("s_waitcnt lgkmcnt(0)" ::: "memory");
    float rli[16];
#pragma unroll
    for (int r = 0; r < 16; ++r) rli[r] = __builtin_amdgcn_rcpf(li_l[crow(r, hi)]);
#pragma unroll
    for (int r = 0; r < 16; ++r) { const int orow = wid * 32 + crow(r, hi);
#pragma unroll
        for (int d0 = 0; d0 < NC; ++d0) {
            if (MODE == 0) ((bf16*)Ob)[(size_t)orow * ldo + d0 * 32 + r32] = (bf16)f2bf(o[d0][r] * rli[r]);
            else ((float*)Ob)[(size_t)orow * ldo + d0 * 32 + r32] = o[d0][r] * rli[r]; } }
    __syncthreads();
#undef SLOAD
#undef SWRITE
#undef SWAIT
#undef RESC
}
#undef SBAR
}

#define XB_TMO      128
#define XB_XCNT(j)  (256  + 64 * (j))
#define XB_XSUB(j)  (1280 + 64 * (j))
#define XB_XGEN(j)  (2304 + 64 * (j))
#define XB_TOP      3328
#define XB_TOPGEN   3392
#define XCD_BAR_WORDS 3456
#define XB_SPIN_CAP (1u << 20)
__device__ __forceinline__ unsigned xb_ld(unsigned* p)              { return __hip_atomic_load(p, __ATOMIC_RELAXED, __HIP_MEMORY_SCOPE_AGENT); }
__device__ __forceinline__ unsigned xb_add(unsigned* p, unsigned v) { return __hip_atomic_fetch_add(p, v, __ATOMIC_RELAXED, __HIP_MEMORY_SCOPE_AGENT); }
__device__ __forceinline__ unsigned xb_xcc_id() { return (unsigned)__builtin_amdgcn_s_getreg((3 << 11) | 20) & 0xFu; }
#define XB_SPIN(cond, bar) do { unsigned _sp = 0; while (cond) { __builtin_amdgcn_s_sleep(1); \
    if ((++_sp & 255u) == 0u) { if (xb_ld(&(bar)[XB_TMO])) break; if (_sp > XB_SPIN_CAP) { atomicAdd(&(bar)[XB_TMO], 1u); break; } } } } while (0)
struct XcdBarrier { unsigned* bar; unsigned x; volatile LAS unsigned* st; };
__device__ __forceinline__ XcdBarrier xcd_barrier_post(unsigned* bar, volatile LAS unsigned* st) {
    XcdBarrier b; b.bar = bar; b.x = xb_xcc_id(); b.st = st;
    if (threadIdx.x == 0) (void)xb_add(&bar[XB_XCNT(b.x)], 1u);
    return b;
}
__device__ __forceinline__ void xcd_barrier_complete(unsigned* bar, unsigned x, unsigned& nloc, unsigned& nx) {
    const unsigned G = gridDim.x * gridDim.y * gridDim.z;
    unsigned sum, cnt, mine, sp = 0u;
    for (;;) {
        sum = 0u; cnt = 0u; mine = 0u;
#pragma unroll
        for (unsigned j = 0; j < 16; ++j) { const unsigned c = xb_ld(&bar[XB_XCNT(j)]); sum += c; cnt += (c > 0u) ? 1u : 0u; mine = (j == x) ? c : mine; }
        if (sum == G) break;
        __builtin_amdgcn_s_sleep(1);
        if ((++sp & 255u) == 0u) { if (xb_ld(&bar[XB_TMO])) break; if (sp > XB_SPIN_CAP) { atomicAdd(&bar[XB_TMO], 1u); break; } }
    }
    nloc = mine > 0u ? mine : 1u; nx = cnt > 0u ? cnt : 1u;
}
__device__ __forceinline__ void xcd_barrier(const XcdBarrier& b) {
    asm volatile("s_waitcnt vmcnt(0)" ::: "memory");
    __syncthreads();
    if (threadIdx.x == 0) {
        unsigned* bar = b.bar;
        __builtin_amdgcn_s_waitcnt(0);
        unsigned nloc = b.st[0], nx = b.st[1];
        if (nloc == 0u) { xcd_barrier_complete(bar, b.x, nloc, nx); b.st[0] = nloc; b.st[1] = nx; }
        const unsigned old = xb_add(&bar[XB_XSUB(b.x)], 1u);
        const unsigned gen = old / nloc;
        if (old + 1u == (gen + 1u) * nloc) {
            __builtin_amdgcn_fence(__ATOMIC_RELEASE, "agent");
            asm volatile("s_waitcnt vmcnt(0)" ::: "memory");
            const unsigned og = xb_add(&bar[XB_TOP], 1u);
            const unsigned tg = og / nx;
            if (og + 1u == (tg + 1u) * nx) xb_add(&bar[XB_TOPGEN], 1u);
            else XB_SPIN(xb_ld(&bar[XB_TOPGEN]) == tg, bar);
            __builtin_amdgcn_fence(__ATOMIC_ACQUIRE, "agent");
            xb_add(&bar[XB_XGEN(b.x)], 1u);
            asm volatile("s_waitcnt vmcnt(0)" ::: "memory");
        } else {
            XB_SPIN(xb_ld(&bar[XB_XGEN(b.x)]) == gen, bar);
            __builtin_amdgcn_fence(__ATOMIC_ACQUIRE, "agent");
            asm volatile("s_waitcnt vmcnt(0)" ::: "memory");
        }
    }
    __syncthreads();
}

constexpr int NWAVES = 8;
constexpr int RING_BYTES = 131072, LDSCTL_OFF = RING_BYTES, MISC_OFF = LDSCTL_OFF + 320, LDS_BYTES = 147456;
struct Frame {
    LAS unsigned char* lds; volatile LAS unsigned* MISC; unsigned* ctl;
    int tid, lane, wave, vcu, G;
    Ptrs P;
};

template <class SrcF> __device__ __forceinline__ void transpose_item(const SrcF& f, int K, bf16* WT, int p0, int k0, LAS float* scr, int lane) {
#pragma unroll 8
    for (int i = 0; i < 32; ++i) { const int kk = 2 * i + (lane >> 5); scr[kk * 33 + (lane & 31)] = f(k0 + kk, p0 + (lane & 31)); }
    LDS_WAIT(); asm volatile("" ::: "memory");
    const int c = lane & 7;
#pragma unroll
    for (int j = 0; j < 4; ++j) { const int n = (lane >> 3) + 8 * j; const LAS float* s = scr + (8 * c) * 33 + n;
        u32x4 o; o.x = pk2(s[0 * 33], s[1 * 33]); o.y = pk2(s[2 * 33], s[3 * 33]); o.z = pk2(s[4 * 33], s[5 * 33]); o.w = pk2(s[6 * 33], s[7 * 33]);
        *(u32x4*)(WT + (size_t)(p0 + n) * K + k0 + 8 * c) = o; }
    LDS_WAIT(); asm volatile("" ::: "memory");
}
struct SrcWin { const float* w; __device__ float operator()(int k, int p) const { const int l = p1_logical(p); return l < 0 ? 0.f : w[(size_t)k * IN_COLS + l]; } };
struct SrcWup { const float *gq, *wuq, *gkv, *wukv;
    __device__ float operator()(int k, int p) const {
        if (p < 768) return k < 256 ? gq[k] * wuq[(size_t)k * 768 + qm_logical(p)] : 0.f;
        return k >= 256 ? gkv[k - 256] * wukv[(size_t)(k - 256) * 1024 + (p - 768)] : 0.f; } };
struct SrcPlain { const float* w; int N; int coff; __device__ float operator()(int k, int p) const { return w[(size_t)k * N + p + coff]; } };

__device__ __forceinline__ void ph0_prep(Frame& F, bool do_experts) {
    LAS float* scr = (LAS float*)(F.lds + F.wave * 16384);
    const int gw = F.vcu * NWAVES + F.wave, NGW = F.G * NWAVES, lane = F.lane;
    const Ptrs& P = F.P; unsigned char* ws = P.ws;
    constexpr int I_IN = 16 * 64, I_UP = 6 * 56, I_OUT = 16 * 32, I_R = 16 * 8, I_SMALL = I_IN + I_UP + I_OUT + I_R;
    for (int it = gw; it < I_SMALL; it += NGW) {
        int r = it;
        if (r < I_IN) { transpose_item(SrcWin{P.in[8]}, 1024, (bf16*)(ws + WS_WIN), (r % 64) * 32, (r / 64) * 64, scr, lane); continue; } r -= I_IN;
        if (r < I_UP) { transpose_item(SrcWup{P.in[9], P.in[10], P.in[11], P.in[12]}, 384, (bf16*)(ws + WS_WUP), (r % 56) * 32, (r / 56) * 64, scr, lane); continue; } r -= I_UP;
        if (r < I_OUT) { transpose_item(SrcPlain{P.in[18], 1024, 0}, 1024, (bf16*)(ws + WS_WOUT), (r % 32) * 32, (r / 32) * 64, scr, lane); continue; } r -= I_OUT;
        transpose_item(SrcPlain{P.in[19], 256, 0}, 1024, (bf16*)(ws + WS_WR), (r % 8) * 32, (r / 8) * 64, scr, lane);
    }
    for (int it = gw; it < 96 * 16; it += NGW) {
        const int cg = it % 96, kp = it / 96;
#pragma unroll
        for (int r = 0; r < 5; ++r) { const float c = (r < 4 ? P.in[1] + r * DM : P.in[3])[kp * 64 + lane]; scr[r * 64 + lane] = c / (1.f + __expf(-c)); }
        LDS_WAIT(); asm volatile("" ::: "memory");
        float acc[5] = {0.f, 0.f, 0.f, 0.f, 0.f};
        const float* W = P.in[4] + (size_t)(kp * 64) * 6144 + cg * 64 + lane;
#pragma unroll 8
        for (int kk = 0; kk < 64; ++kk) { const float w = W[(size_t)kk * 6144];
#pragma unroll
            for (int r = 0; r < 5; ++r) acc[r] += scr[r * 64 + kk] * w; }
        LDS_WAIT(); asm volatile("" ::: "memory");
#pragma unroll
        for (int r = 0; r < 5; ++r) ((float*)(ws + WS_MODP))[(size_t)(kp * 5 + r) * 6144 + cg * 64 + lane] = acc[r];
    }
    { const int idx = (F.vcu * 512 + F.tid);
      if (idx < 1024) { const int v = idx / 16, f = idx % 16; const float th = (float)v * exp2f(-(float)f / 16.f * 13.287712379549449f);
          ((float2*)(ws + WS_TAB))[idx] = make_float2(__builtin_amdgcn_cosf(th * 0.15915494309189535f), __builtin_amdgcn_sinf(th * 0.15915494309189535f)); }
      else if (idx < 1536) { const int i2 = idx - 1024, v = i2 / 8, f = i2 % 8; const float th = (float)v * exp2f(-(float)f / 8.f * 13.287712379549449f);
          ((float2*)(ws + WS_TAB))[idx] = make_float2(__builtin_amdgcn_cosf(th * 0.15915494309189535f), __builtin_amdgcn_sinf(th * 0.15915494309189535f)); } }
    if (do_experts) {
        constexpr int IPE = 256 + 128;
        for (int it = gw; it < 257 * IPE; it += NGW) {
            const int e = it / IPE; int r = it % IPE;
            if (r < 256) { const int p0 = (r % 16) * 32, half = p0 >> 8, up = (p0 >> 7) & 1;
                const float* w = e < 256 ? (up ? P.in[22] : P.in[21]) + (size_t)e * DM * EFF : (up ? P.in[25] : P.in[24]);
                const SrcPlain s{w, EFF, half * 128 - (p0 & ~127)};
                transpose_item(s, 1024, (bf16*)(ws + WS_W13) + (size_t)e * 512 * 1024, p0, (r / 16) * 64, scr, lane); }
            else { r -= 256; const SrcPlain s{e < 256 ? P.in[23] + (size_t)e * EFF * DM : P.in[26], 1024, 0};
                transpose_item(s, 256, (bf16*)(ws + WS_W2) + (size_t)e * 1024 * 256, (r % 32) * 32, (r / 32) * 64, scr, lane); }
        }
    }
}

__device__ __forceinline__ void ph1_xn(Frame& F) {
    const Ptrs& P = F.P; unsigned char* ws = P.ws;
    const float* MODP = (const float*)(ws + WS_MODP);
    for (int idx = F.vcu * 512 + F.tid; idx < 5 * 6144; idx += F.G * 512) { const int r = idx / 6144, j = idx % 6144; float a = P.in[5][j];
#pragma unroll
        for (int kp = 0; kp < 16; ++kp) a += MODP[(size_t)(kp * 5 + r) * 6144 + j];
        ((float*)(ws + WS_MOD))[idx] = a; }
    const int RPB = (MALL + F.G - 1) / F.G, r_lo = F.vcu * RPB, r_hi = min(MALL, r_lo + RPB);
    if (r_lo >= r_hi) return;
    const int b0 = r_lo / NTOK, b1 = (r_hi - 1) / NTOK;
    LAS float* sm = (LAS float*)F.lds;
    for (int i = F.tid; i < 3 * 2048; i += 512) { const int sl = i / 2048, j = i % 2048; const int r = sl == 0 ? b0 : sl == 1 ? b1 : 4; float a = P.in[5][j];
#pragma unroll
        for (int kp = 0; kp < 16; ++kp) a += MODP[(size_t)(kp * 5 + r) * 6144 + j];
        sm[i] = a; }
    __syncthreads();
    for (int r = r_lo + F.wave; r < r_hi; r += NWAVES) {
        const int b = r / NTOK, n = r % NTOK;
        const float* src = n < NCTX ? P.in[2] + ((size_t)b * NCTX + n) * DM : P.in[0] + ((size_t)b * SEQ + (n - NCTX)) * DM;
        const LAS float* md = sm + (n < NCTX ? 2 : (b == b0 ? 0 : 1)) * 2048;
        const f32x4* xr = (const f32x4*)src + F.lane;
        f32x4 v[4]; float s = 0.f;
#pragma unroll
        for (int j = 0; j < 4; ++j) { v[j] = xr[64 * j]; s += (v[j][0] * v[j][0] + v[j][1] * v[j][1]) + (v[j][2] * v[j][2] + v[j][3] * v[j][3]); }
        const float rs = rsqrtf(wave_sum(s) * (1.f / DM) + EPS);
        u32x2* o8 = (u32x2*)((bf16*)(ws + WS_XN) + (size_t)r * DM) + F.lane;
#pragma unroll
        for (int j = 0; j < 4; ++j) { const int c = 4 * F.lane + 256 * j; const f32x4 g = *(const f32x4*)(P.in[6] + c);
            const f32x4 sh = *(const LAS f32x4*)(md + c), sc = *(const LAS f32x4*)(md + 1024 + c);
            const f32x4 y = (v[j] * rs * g) * (sc + 1.f) + sh;
            u32x2 w; w.x = cvt_pk_bf16(y[0], y[1]); w.y = cvt_pk_bf16(y[2], y[3]); o8[64 * j] = w; }
    }
    __syncthreads();
}
__device__ __forceinline__ void ph6_h2(Frame& F) {
    const Ptrs& P = F.P; unsigned char* ws = P.ws;
    const int gw = F.vcu * NWAVES + F.wave, NGW = F.G * NWAVES;
    for (int t = gw; t < MLAT; t += NGW) {
        const int b = t / SEQ; const float* md = (const float*)(ws + WS_MOD) + b * 6144;
        const f32x4* xr = (const f32x4*)((const float*)(ws + WS_X1) + (size_t)t * DM) + F.lane;
        f32x4 v[4]; float s = 0.f;
#pragma unroll
        for (int j = 0; j < 4; ++j) { v[j] = xr[64 * j]; s += (v[j][0] * v[j][0] + v[j][1] * v[j][1]) + (v[j][2] * v[j][2] + v[j][3] * v[j][3]); }
        const float rs = rsqrtf(wave_sum(s) * (1.f / DM) + EPS);
        u32x2* o8 = (u32x2*)((bf16*)(ws + WS_H2) + (size_t)t * DM) + F.lane;
#pragma unroll
        for (int j = 0; j < 4; ++j) { const int c = 4 * F.lane + 256 * j; const f32x4 g = *(const f32x4*)(P.in[7] + c);
            const f32x4 sh = *(const f32x4*)(md + 3072 + c), sc = *(const f32x4*)(md + 4096 + c);
            const f32x4 y = (v[j] * rs * g) * (sc + 1.f) + sh;
            u32x2 w; w.x = cvt_pk_bf16(y[0], y[1]); w.y = cvt_pk_bf16(y[2], y[3]); o8[64 * j] = w; }
    }
}
__device__ __forceinline__ void ph7_route(Frame& F) {
    const Ptrs& P = F.P; unsigned char* ws = P.ws; const int lane = F.lane;
    const int gw = F.vcu * NWAVES + F.wave, NGW = F.G * NWAVES;
    const f32x4 bi = ((const f32x4*)P.in[20])[lane];
    for (int t = gw; t < MLAT; t += NGW) {
        const f32x4 lg = ((const f32x4*)(ws + WS_LOG))[(size_t)t * 64 + lane];
        float s[4], v[4];
#pragma unroll
        for (int i = 0; i < 4; ++i) { s[i] = 1.f / (1.f + __expf(-lg[i])); v[i] = s[i] + bi[i]; }
        float m1 = fmaxf(v[0], v[1]), m2 = fminf(v[0], v[1]);
#pragma unroll
        for (int i = 2; i < 4; ++i) { const float x = v[i]; m2 = fmaxf(m2, fminf(m1, x)); m1 = fmaxf(m1, x); }
#pragma unroll
        for (int o = 1; o < 8; o <<= 1) { const float b1 = __shfl_xor(m1, o), b2 = __shfl_xor(m2, o); const float n1 = fmaxf(m1, b1), n2 = fmaxf(fminf(m1, b1), fmaxf(m2, b2)); m1 = n1; m2 = n2; }
        const float gs = m1 + m2; const int g = lane >> 3; int rank = 0;
#pragma unroll
        for (int j = 0; j < 8; ++j) { const float o = __shfl(gs, j * 8); rank += (o > gs || (o == gs && j < g)) ? 1 : 0; }
        if (rank >= 4) { v[0] = v[1] = v[2] = v[3] = -INFINITY; }
        int my_e = 0; float my_s = 0.f, ssum = 0.f;
#pragma unroll
        for (int k = 0; k < 8; ++k) {
            float bv = v[0]; int bi_ = 0;
#pragma unroll
            for (int i = 1; i < 4; ++i) if (v[i] > bv) { bv = v[i]; bi_ = i; }
            int be = lane * 4 + bi_;
#pragma unroll
            for (int o = 1; o < 64; o <<= 1) { const float ov = __shfl_xor(bv, o); const int oe = __shfl_xor(be, o); if (ov > bv || (ov == bv && oe < be)) { bv = ov; be = oe; } }
            const int wl = be >> 2, wi = be & 3;
            float sv = wi == 0 ? s[0] : wi == 1 ? s[1] : wi == 2 ? s[2] : s[3];
            sv = __shfl(sv, wl);
            if (lane == wl) { if (wi == 0) v[0] = -INFINITY; else if (wi == 1) v[1] = -INFINITY; else if (wi == 2) v[2] = -INFINITY; else v[3] = -INFINITY; }
            ssum += sv; if (lane == k) { my_e = be; my_s = sv; }
        }
        if (lane < 8) {
            int* cnt = (int*)(ws + WS_CTL) + CW_COUNT;
            const int rk = atomicAdd(&cnt[my_e], 1);
            ((int*)(ws + WS_EIDX))[(size_t)t * 8 + lane] = my_e;
            ((float*)(ws + WS_EW))[(size_t)t * 8 + lane] = my_s / ssum * 2.5f;
            ((int*)(ws + WS_ERANK))[(size_t)t * 8 + lane] = rk;
        }
    }
}
__device__ __forceinline__ void ph8_slots(Frame& F) {
    const Ptrs& P = F.P; unsigned char* ws = P.ws;
    LAS int* off = (LAS int*)F.lds;
    LAS int* cst = off + 260;
    unsigned* cnt = (unsigned*)(ws + WS_CTL) + CW_COUNT;
    if (F.wave == 0) { const int lane = F.lane; int n[4], c[4], sn = 0, sc = 0;
#pragma unroll
        for (int i = 0; i < 4; ++i) { n[i] = (int)cnt[4 * lane + i]; c[i] = (n[i] + 255) >> 8; sn += n[i]; sc += c[i]; }
        int in = sn, ic = sc;
#pragma unroll
        for (int o = 1; o < 64; o <<= 1) { const int tn = __shfl_up(in, o), tc = __shfl_up(ic, o); if (lane >= o) { in += tn; ic += tc; } }
        int an = in - sn, ac = ic - sc;
#pragma unroll
        for (int i = 0; i < 4; ++i) { off[4 * lane + i] = an; cst[4 * lane + i] = ac; an += n[i]; ac += c[i]; }
        if (lane == 63) { off[256] = an; cst[256] = ac; off[257] = NSLOT; cst[257] = ac + MLAT / 256; } }
    __syncthreads();
    for (int idx = F.vcu * 512 + F.tid; idx < MLAT * 8; idx += F.G * 512) {
        const int e = ((const int*)(ws + WS_EIDX))[idx], rk = ((const int*)(ws + WS_ERANK))[idx];
        const int slot = off[e] + rk;
        ((int*)(ws + WS_SLOTOF))[idx] = slot; ((int*)(ws + WS_SLOTTOK))[slot] = idx >> 3; ((float*)(ws + WS_SLOTW))[slot] = ((const float*)(ws + WS_EW))[idx];
        if (idx < MLAT) { ((int*)(ws + WS_SLOTTOK))[MLAT * 8 + idx] = idx; ((float*)(ws + WS_SLOTW))[MLAT * 8 + idx] = 1.f; }
    }
    if (F.vcu == 0) {
        int* go = (int*)(ws + WS_OFF); int* ut = (int*)(ws + WS_UT);
        for (int e = F.tid; e < 258; e += 512) go[e] = off[e];
        for (int e = F.tid; e < 257; e += 512) { const int n = off[e + 1] - off[e], c0 = cst[e], nc = cst[e + 1] - c0;
            for (int j = 0; j < nc; ++j) { ut[(c0 + j) * 4 + 0] = e; ut[(c0 + j) * 4 + 1] = off[e] + j * 256; ut[(c0 + j) * 4 + 2] = min(256, n - j * 256); ut[(c0 + j) * 4 + 3] = 0; } }
        if (F.tid == 0) ((int*)(ws + WS_CTL))[CW_NUNIT] = cst[257];
    }
    __syncthreads();
}
__device__ __forceinline__ float bflo(unsigned w) { return __builtin_bit_cast(float, w << 16); }
__device__ __forceinline__ float bfhi(unsigned w) { return __builtin_bit_cast(float, w & 0xffff0000u); }
__device__ __forceinline__ void ph11_combine(Frame& F) {
    const Ptrs& P = F.P; unsigned char* ws = P.ws; const int lane = F.lane;
    const int gw = F.vcu * NWAVES + F.wave, NGW = F.G * NWAVES;
    const bf16* Y = (const bf16*)(ws + WS_Y);
    for (int t = gw; t < MLAT; t += NGW) {
        const int b = t / SEQ; const float* gt2 = (const float*)(ws + WS_MOD) + b * 6144 + 5120;
        const int* so = (const int*)(ws + WS_SLOTOF) + (size_t)t * 8;
        int sl[9];
#pragma unroll
        for (int k = 0; k < 8; ++k) sl[k] = so[k];
        sl[8] = MLAT * 8 + t;
        float a[2][8];
#pragma unroll
        for (int h = 0; h < 2; ++h)
#pragma unroll
            for (int i = 0; i < 8; ++i) a[h][i] = 0.f;
#pragma unroll
        for (int k = 0; k < 9; ++k)
#pragma unroll
            for (int h = 0; h < 2; ++h) { const u32x4 w = *(const u32x4*)(Y + (size_t)sl[k] * DM + h * 512 + lane * 8);
                a[h][0] += bflo(w.x); a[h][1] += bfhi(w.x); a[h][2] += bflo(w.y); a[h][3] += bfhi(w.y); a[h][4] += bflo(w.z); a[h][5] += bfhi(w.z); a[h][6] += bflo(w.w); a[h][7] += bfhi(w.w); }
        const float* x1 = (const float*)(ws + WS_X1) + (size_t)t * DM;
        float ss = 0.f;
#pragma unroll
        for (int h = 0; h < 2; ++h)
#pragma unroll
            for (int q = 0; q < 2; ++q) { const int c = h * 512 + lane * 8 + q * 4; const f32x4 xv = *(const f32x4*)(x1 + c), gv = *(const f32x4*)(gt2 + c);
#pragma unroll
                for (int e = 0; e < 4; ++e) { const float v = xv[e] + gv[e] * a[h][q * 4 + e]; a[h][q * 4 + e] = v; ss += v * v; } }
        const float rs = rsqrtf(wave_sum(ss) * (1.f / DM) + EPS);
#pragma unroll
        for (int h = 0; h < 2; ++h)
#pragma unroll
            for (int q = 0; q < 2; ++q) { const int c = h * 512 + lane * 8 + q * 4; const f32x4 gf = *(const f32x4*)(P.in[27] + c);
                f32x4 o;
#pragma unroll
                for (int e = 0; e < 4; ++e) o[e] = a[h][q * 4 + e] * rs * gf[e];
                *(f32x4*)(P.out + (size_t)t * DM + c) = o; }
    }
}
__device__ __forceinline__ void ph4b_diff_finish(Frame& F) {
    const Ptrs& P = F.P; unsigned char* ws = P.ws; const int lane = F.lane;
    const int gw = F.vcu * NWAVES + F.wave, NGW = F.G * NWAVES;
    float d1 = P.in[13][lane] * P.in[14][lane], d2 = P.in[15][lane] * P.in[16][lane];
    d1 = wave_sum(d1); d2 = wave_sum(d2);
    const float lam = __expf(d1) - __expf(d2) + LAM_INIT;
    const float g0 = P.in[17][lane], g1 = P.in[17][64 + lane];
    for (int it = gw; it < MLAT * 4; it += NGW) {
        const int t = it >> 2, h = it & 3;
        const float* os = (const float*)(ws + WS_OS) + ((size_t)t * 8 + 2 * h) * 128;
        const float v0 = os[lane] - lam * os[128 + lane], v1 = os[64 + lane] - lam * os[128 + 64 + lane];
        const float rs = rsqrtf(wave_sum(v0 * v0 + v1 * v1) * (1.f / 128.f) + EPS) * (1.f - LAM_INIT);
        bf16* mo = (bf16*)(ws + WS_MIX) + (size_t)t * DM + 512 + h * 128;
        mo[lane] = (bf16)f2bf(v0 * rs * g0); mo[64 + lane] = (bf16)f2bf(v1 * rs * g1);
    }
}

enum { P_PREP = 0, P_XN, P_INPROJ, P_UP, P_ATTN, P_DIFFFIN, P_OUT, P_H2, P_ROUTER, P_ROUTE, P_SLOTS, P_EXP1, P_EXP2, P_COMB, P_END };
struct Args { Ptrs P; int ph_lo, ph_hi, li, pad; };
__global__ void __launch_bounds__(NWAVES * 64, 2) mk_fwd(Args args) {
    extern __shared__ __attribute__((aligned(16))) unsigned char lds[];
    Frame F;
    F.lds = (LAS unsigned char*)lds; F.MISC = (volatile LAS unsigned*)(F.lds + MISC_OFF);
    F.tid = threadIdx.x; F.lane = F.tid & 63; F.wave = __builtin_amdgcn_readfirstlane(F.tid >> 6);
    F.G = gridDim.x; { const int bx = blockIdx.x; F.vcu = (F.G % 8 == 0) ? (bx % 8) * (F.G / 8) + bx / 8 : bx; }
    F.P = args.P; unsigned char* ws = args.P.ws; F.ctl = (unsigned*)(ws + WS_CTL);
    for (int u = F.tid; u < (LDS_BYTES - LDSCTL_OFF) / 4; u += NWAVES * 64) ((LAS unsigned*)(F.lds + LDSCTL_OFF))[u] = 0u;
    __syncthreads();
    XcdBarrier bar = xcd_barrier_post(F.ctl + CW_BAR + args.li * XCD_BAR_WORDS, F.MISC + 8);
    const int lo = args.ph_lo, hi = args.ph_hi;
#ifndef PHMASK
#define PHMASK 0xFFFF
#endif
#define IN(k) ((((PHMASK) >> (k)) & 1) && lo <= (k) && (k) < hi)
#define SEAM(k) do { if (IN(k) && IN((k) + 1)) xcd_barrier(bar); } while (0)
    if (IN(P_PREP)) { ph0_prep(F, true); } SEAM(P_PREP);
    if (IN(P_XN)) { ph1_xn(F); } SEAM(P_XN);
    if (IN(P_INPROJ)) {
        pg8::Gemm g{(const bf16*)(ws + WS_XN), (const bf16*)(ws + WS_WIN), 1024, 1024}; pg8::StaticOrder S; S.init(MALL, NP1, F.G, (int)blockIdx.x);
        EpiInProj E{(bf16*)(ws + WS_P1), (float*)(ws + WS_SSQ), (const float2*)(ws + WS_TAB), (const float2*)(ws + WS_TAB) + 1024};
        pg8::gemm_phase(F.lds, g, S, E);
    } SEAM(P_INPROJ);
    if (IN(P_UP)) {
        pg8::Gemm g{(const bf16*)(ws + WS_P1), (const bf16*)(ws + WS_WUP), 2048, 384}; pg8::StaticOrder S; S.init(MALL, 1792, F.G, (int)blockIdx.x);
        EpiUp E{(bf16*)(ws + WS_QM), (bf16*)(ws + WS_KVM), (const float*)(ws + WS_SSQ), (const float2*)(ws + WS_TAB) + 1024};
        pg8::gemm_phase(F.lds, g, S, E);
    } SEAM(P_UP);
    if (IN(P_ATTN)) {
        const bf16* P1 = (const bf16*)(ws + WS_P1); const bf16* QM = (const bf16*)(ws + WS_QM); const bf16* KVM = (const bf16*)(ws + WS_KVM);
        for (int U = F.vcu; U < 1024; U += F.G) {
            const int Up = U & 511, bh = Up >> 4, qb = Up & 15, b = bh >> 3, hh = bh & 7;
            if (U < 512) {
                const bf16* K0 = KVM + (size_t)b * NTOK * 1024 + hh * 128;
                attn::unit<0>(QM + (size_t)(b * NTOK + NCTX + qb * 256) * 768 + hh * 96, K0, P1 + (size_t)b * NTOK * NP1 + 384, K0 + 64,
                              (bf16*)(ws + WS_MIX) + (size_t)(b * SEQ + qb * 256) * DM + hh * 64, DM, (char*)lds);
            } else {
                const bf16* Pb = P1 + (size_t)b * NTOK * NP1;
                attn::unit<1>(P1 + (size_t)(b * NTOK + NCTX + qb * 256) * NP1 + 512 + hh * 64, Pb + 1024 + hh * 64, nullptr, Pb + 1536 + (hh >> 1) * 128,
                              (float*)(ws + WS_OS) + ((size_t)(b * SEQ + qb * 256) * 8 + hh) * 128, 1024, (char*)lds);
            }
        }
    } SEAM(P_ATTN);
    if (IN(P_DIFFFIN)) { ph4b_diff_finish(F); } SEAM(P_DIFFFIN);
    if (IN(P_OUT)) {
        pg8::Gemm g{(const bf16*)(ws + WS_MIX), (const bf16*)(ws + WS_WOUT), 1024, 1024}; pg8::StaticOrder S; S.init(MLAT, DM, F.G, (int)blockIdx.x);
        EpiOut E{F.P.in[0], (const float*)(ws + WS_MOD), (float*)(ws + WS_X1)};
        pg8::gemm_phase(F.lds, g, S, E);
    } SEAM(P_OUT);
    if (IN(P_H2)) { ph6_h2(F); } SEAM(P_H2);
    if (IN(P_ROUTER)) {
        pg8::Gemm g{(const bf16*)(ws + WS_H2), (const bf16*)(ws + WS_WR), 1024, 1024}; pg8::StaticOrder S; S.init(MLAT, NEXP, F.G, (int)blockIdx.x);
        EpiF32 E{(float*)(ws + WS_LOG), NEXP};
        pg8::gemm_phase(F.lds, g, S, E);
    } SEAM(P_ROUTER);
    if (IN(P_ROUTE)) { ph7_route(F); } SEAM(P_ROUTE);
    if (IN(P_SLOTS)) { ph8_slots(F); } SEAM(P_SLOTS);
    if (IN(P_EXP1)) {
        const int nu = (int)xb_ld(F.ctl + CW_NUNIT);
        pg8::Gemm g{(const bf16*)(ws + WS_H2), (const bf16*)(ws + WS_W13), 1024, 1024};
        ExpSched<2, true> S{(const int*)(ws + WS_UT), nu * 2, F.G, F.vcu, (const int*)(ws + WS_SLOTTOK)};
        EpiAct E{(bf16*)(ws + WS_ACT)};
        pg8::gemm_phase(F.lds, g, S, E);
    } SEAM(P_EXP1);
    if (IN(P_EXP2)) {
        const int nu = (int)xb_ld(F.ctl + CW_NUNIT);
        pg8::Gemm g{(const bf16*)(ws + WS_ACT), (const bf16*)(ws + WS_W2), 256, 256};
        ExpSched<4, false> S{(const int*)(ws + WS_UT), nu * 4, F.G, F.vcu, nullptr};
        EpiY E{(bf16*)(ws + WS_Y), (const float*)(ws + WS_SLOTW)};
        pg8::gemm_phase(F.lds, g, S, E);
    } SEAM(P_EXP2);
    if (IN(P_COMB)) { ph11_combine(F); }
#undef IN
#undef SEAM
}

static int g_grid = 0;
static int mk_setup() {
    if (g_grid) return g_grid;
    int dev = 0, cus = 0;
    if (hipGetDevice(&dev) != hipSuccess || hipDeviceGetAttribute(&cus, hipDeviceAttributeMultiprocessorCount, dev) != hipSuccess) { fprintf(stderr, "kernel_launch: device query failed\n"); g_grid = -1; return -1; }
    if (hipFuncSetAttribute((const void*)mk_fwd, hipFuncAttributeMaxDynamicSharedMemorySize, LDS_BYTES) != hipSuccess) { fprintf(stderr, "kernel_launch: hipFuncSetAttribute failed\n"); g_grid = -1; return -1; }
    int per_cu = 0;
    if (hipOccupancyMaxActiveBlocksPerMultiprocessor(&per_cu, (const void*)mk_fwd, NWAVES * 64, LDS_BYTES) != hipSuccess || per_cu < 1) { fprintf(stderr, "kernel_launch: occupancy query says %d blocks/CU\n", per_cu); }
    (void)hipGetLastError();
    g_grid = cus;
    return g_grid;
}
static void mk_run(const Ptrs& P, int lo, int hi, int li, hipStream_t stream) {
    Args a{}; a.P = P; a.ph_lo = lo; a.ph_hi = hi; a.li = li; a.pad = 0;
    hipLaunchKernelGGL(mk_fwd, dim3(g_grid), dim3(NWAVES * 64), LDS_BYTES, stream, a);
}
extern "C" void kernel_launch(void* const* d_in, const int* in_sizes, int n_in, void* d_out, int out_size, void* d_ws, size_t ws_size, hipStream_t stream) {
    if (n_in != 28 || out_size != MLAT * DM || ws_size < WS_END) { fprintf(stderr, "kernel_launch: unexpected shapes n_in %d out %d ws %zu\n", n_in, out_size, ws_size); return; }
    if (mk_setup() <= 0) return;
    Ptrs P{}; for (int i = 0; i < 28; ++i) P.in[i] = (const float*)d_in[i]; P.out = (float*)d_out; P.ws = (unsigned char*)d_ws;
    (void)hipMemsetAsync((char*)d_ws + WS_CTL, 0, 1 * MiB, stream);
    int li = 0;
#define FAST(lo, hi) mk_run(P, lo, hi, li++, stream)
    FAST(P_PREP, P_COMB + 1);
#undef FAST
}
```

```cpp
#include <hip/hip_runtime.h>
#include <cstdio>
#include <cstdint>

constexpr int NB = 4, SEQ = 4096, NCTX = 256, NTOK = SEQ + NCTX, DM = 1024;
constexpr int MALL = NB * NTOK;
constexpr int MLAT = NB * SEQ;
constexpr int IN_COLS = 1952, NP1 = 2048;
constexpr int NEXP = 256, TOPK = 8, EFF = 256;
constexpr int NSLOT = MLAT * TOPK + MLAT;
constexpr float EPS = 1e-6f;
constexpr float LAM_INIT = 0.2f;

typedef unsigned short bf16;
__device__ __forceinline__ unsigned f2bf(float f) { unsigned u = __builtin_bit_cast(unsigned, f); return (u + 0x7fffu + ((u >> 16) & 1u)) >> 16; }
__device__ __forceinline__ float bf2f(bf16 h) { return __builtin_bit_cast(float, (unsigned)h << 16); }

constexpr size_t MiB = 1u << 20;
constexpr size_t WS_CTL = 0;
constexpr size_t WS_MOD = 3 * MiB;
constexpr size_t WS_TAB = 3 * MiB + 512 * 1024;
constexpr size_t WS_X1 = 402 * MiB;
constexpr size_t WS_SSQ = 466 * MiB;
constexpr size_t WS_EIDX = 467 * MiB;
constexpr size_t WS_EW = WS_EIDX + 512 * 1024;
constexpr size_t WS_ERANK = 468 * MiB;
constexpr size_t WS_SLOTOF = WS_ERANK + 512 * 1024;
constexpr size_t WS_SLOTTOK = 469 * MiB;
constexpr size_t WS_SLOTW = 470 * MiB;
constexpr size_t WS_OFF = 471 * MiB;
constexpr size_t WS_XN = 472 * MiB;
constexpr size_t WS_P1 = 506 * MiB;
constexpr size_t WS_QM = 574 * MiB;
constexpr size_t WS_KVM = 600 * MiB;
constexpr size_t WS_MIX = 634 * MiB;
constexpr size_t WS_OS = 666 * MiB;
constexpr size_t WS_TMP = 730 * MiB;
constexpr size_t WS_H2 = 472 * MiB;
constexpr size_t WS_H2F = 504 * MiB;
constexpr size_t WS_LOG = 568 * MiB;
constexpr size_t WS_ACT = 584 * MiB;
constexpr size_t WS_Y = 656 * MiB;
constexpr size_t WS_END = 944 * MiB;
constexpr int CW_COUNT = 1024;

__host__ __device__ __forceinline__ int perm32_log(int p) { return 16 * ((p >> 2) & 1) + 4 * (p >> 3) + (p & 3); }
__host__ __device__ __forceinline__ int perm64_log(int p) { return 32 * ((p >> 2) & 1) + 16 * (p >> 5) + 4 * ((p >> 3) & 3) + (p & 3); }
__host__ __device__ __forceinline__ int p1_logical(int p) {
    if (p < 384) return p;
    if (p < 416) return 384 + perm32_log(p - 384);
    if (p < 512) return -1;
    if (p < 1024) { int q = p - 512; return 416 + (q & ~63) + perm64_log(q & 63); }
    if (p < 1536) { int q = p - 1024; return 928 + (q & ~63) + perm64_log(q & 63); }
    return 1440 + (p - 1536);
}
__host__ __device__ __forceinline__ int qm_logical(int p) { int h = p / 96, r = p % 96; return h * 96 + (r < 64 ? r : 64 + perm32_log(r - 64)); }

struct Ptrs {
    const float* in[28]; float* out; unsigned char* ws;
};

__global__ void k_mod(Ptrs P) {
    int idx = blockIdx.x * 256 + threadIdx.x;
    if (idx < 5 * 6144) {
        int r = idx / 6144, j = idx % 6144;
        const float* cv = r < 4 ? P.in[1] + r * DM : P.in[3];
        const float* W = P.in[4];
        float acc = 0.f;
        for (int k = 0; k < DM; ++k) { float c = cv[k]; float s = c / (1.f + __expf(-c)); acc += s * W[(size_t)k * 6144 + j]; }
        ((float*)(P.ws + WS_MOD))[idx] = acc + P.in[5][j];
    }
    if (idx < 64 * 16) {
        int v = idx / 16, f = idx % 16;
        float inv = exp2f(-(float)f / 16.f * 13.287712379549449f);
        float th = (float)v * inv;
        float2 cs; cs.x = cosf(th); cs.y = sinf(th);
        ((float2*)(P.ws + WS_TAB))[idx] = cs;
    }
    if (idx < 64 * 8) {
        int v = idx / 8, f = idx % 8;
        float inv = exp2f(-(float)f / 8.f * 13.287712379549449f);
        float th = (float)v * inv;
        float2 cs; cs.x = cosf(th); cs.y = sinf(th);
        ((float2*)(P.ws + WS_TAB) + 1024)[idx] = cs;
    }
}

__global__ void k_xn(Ptrs P) {
    int r = blockIdx.x, b = r / NTOK, n = r % NTOK;
    const float* src = n < NCTX ? P.in[2] + ((size_t)b * NCTX + n) * DM : P.in[0] + ((size_t)b * SEQ + (n - NCTX)) * DM;
    const float* mod = (const float*)(P.ws + WS_MOD) + (n < NCTX ? 4 : b) * 6144;
    __shared__ float red[256];
    float v[4]; float ss = 0.f;
    for (int i = 0; i < 4; ++i) { v[i] = src[threadIdx.x + 256 * i]; ss += v[i] * v[i]; }
    red[threadIdx.x] = ss; __syncthreads();
    for (int o = 128; o > 0; o >>= 1) { if (threadIdx.x < o) red[threadIdx.x] += red[threadIdx.x + o]; __syncthreads(); }
    float rs = rsqrtf(red[0] / DM + EPS);
    bf16* dst = (bf16*)(P.ws + WS_XN) + (size_t)r * DM;
    for (int i = 0; i < 4; ++i) { int j = threadIdx.x + 256 * i; float y = v[i] * rs * P.in[6][j]; y = y * (1.f + mod[1024 + j]) + mod[j]; dst[j] = (bf16)f2bf(y); }
}

template <class F> __global__ __launch_bounds__(256) void k_gemm(F f, int N, int K) {
    __shared__ float As[16][65], Bs[16][65];
    const int z = blockIdx.z, bm = blockIdx.y * 64, bn = blockIdx.x * 64, tid = threadIdx.x, tx = tid & 15, ty = tid >> 4;
    const int rows = f.rows(z); if (bm >= rows) return;
    float acc[4][4] = {};
    for (int k0 = 0; k0 < K; k0 += 16) {
        for (int i = tid; i < 1024; i += 256) { int m = i >> 4, k = i & 15; As[k][m] = (bm + m < rows) ? f.a(z, bm + m, k0 + k) : 0.f; }
        for (int i = tid; i < 1024; i += 256) { int k = i >> 6, n = i & 63; Bs[k][n] = (bn + n < N) ? f.b(z, k0 + k, bn + n) : 0.f; }
        __syncthreads();
#pragma unroll
        for (int k = 0; k < 16; ++k) {
            float a[4], b[4];
#pragma unroll
            for (int i = 0; i < 4; ++i) { a[i] = As[k][ty * 4 + i]; b[i] = Bs[k][tx * 4 + i]; }
#pragma unroll
            for (int i = 0; i < 4; ++i)
#pragma unroll
                for (int j = 0; j < 4; ++j) acc[i][j] += a[i] * b[j];
        }
        __syncthreads();
    }
    for (int i = 0; i < 4; ++i) for (int j = 0; j < 4; ++j) { int m = bm + ty * 4 + i, n = bn + tx * 4 + j; if (m < rows && n < N) f.c(z, m, n, acc[i][j]); }
}

struct FIn { Ptrs P;
    __device__ int rows(int) const { return MALL; }
    __device__ float a(int, int m, int k) const { return bf2f(((const bf16*)(P.ws + WS_XN))[(size_t)m * DM + k]); }
    __device__ float b(int, int k, int n) const { int l = p1_logical(n); return l < 0 ? 0.f : bf2f((bf16)f2bf(P.in[8][(size_t)k * IN_COLS + l])); }
    __device__ void c(int, int m, int n, float v) const { ((float*)(P.ws + WS_TMP))[(size_t)m * NP1 + n] = v; }
};
__global__ void k_p1_finish(Ptrs P) {
    int r = blockIdx.x, n = r % NTOK;
    const float* t = (const float*)(P.ws + WS_TMP) + (size_t)r * NP1;
    bf16* o = (bf16*)(P.ws + WS_P1) + (size_t)r * NP1;
    float* ssq = (float*)(P.ws + WS_SSQ) + (size_t)r * 8;
    const float2* TD = (const float2*)(P.ws + WS_TAB); const float2* TM = TD + 1024;
    const bool lat = n >= NCTX; const int s = n - NCTX, gr = s >> 6, gc = s & 63;
    __shared__ float red[256];
    int tid = threadIdx.x;
    float v = t[tid]; red[tid] = v * v; __syncthreads();
    for (int oo = 128; oo > 0; oo >>= 1) { if (tid < oo) red[tid] += red[tid + oo]; __syncthreads(); }
    if (tid == 0) { ssq[0] = red[0]; ssq[1] = ssq[2] = ssq[3] = 0.f; }
    __syncthreads();
    float w = tid < 128 ? t[256 + tid] : 0.f; red[tid] = w * w; __syncthreads();
    for (int oo = 128; oo > 0; oo >>= 1) { if (tid < oo) red[tid] += red[tid + oo]; __syncthreads(); }
    if (tid == 0) { ssq[4] = red[0]; ssq[5] = ssq[6] = ssq[7] = 0.f; }
    for (int p = tid; p < NP1; p += 256) {
        float val = t[p];
        if (p >= 384 && p < 416) {
            int ph = p - 384, nn = (ph >> 2) & 1, i = 4 * (ph >> 3) + (ph & 3);
            float x1 = t[nn ? p - 4 : p], x2 = t[nn ? p : p + 4];
            float2 cs = lat ? TM[(i < 8 ? gr : gc) * 8 + (i & 7)] : make_float2(1.f, 0.f);
            val = nn ? x1 * cs.y + x2 * cs.x : x1 * cs.x - x2 * cs.y;
        } else if (p >= 512 && p < 1536) {
            int ph = (p - 512) & 63, nn = (ph >> 2) & 1, i = 16 * (ph >> 5) + 4 * ((ph >> 3) & 3) + (ph & 3);
            float x1 = t[nn ? p - 4 : p], x2 = t[nn ? p : p + 4];
            float2 cs = lat ? TD[(i < 16 ? gr : gc) * 16 + (i & 15)] : make_float2(1.f, 0.f);
            val = nn ? x1 * cs.y + x2 * cs.x : x1 * cs.x - x2 * cs.y;
        }
        o[p] = (bf16)f2bf(val);
    }
}
struct FUp { Ptrs P;
    __device__ int rows(int) const { return MALL; }
    __device__ float a(int, int m, int k) const { return bf2f(((const bf16*)(P.ws + WS_P1))[(size_t)m * NP1 + k]); }
    __device__ float b(int, int k, int n) const {
        if (n < 768) return k < 256 ? bf2f((bf16)f2bf(P.in[9][k] * P.in[10][(size_t)k * 768 + qm_logical(n)])) : 0.f;
        return k >= 256 ? bf2f((bf16)f2bf(P.in[11][k - 256] * P.in[12][(size_t)(k - 256) * 1024 + (n - 768)])) : 0.f; }
    __device__ void c(int, int m, int n, float v) const { ((float*)(P.ws + WS_TMP))[(size_t)m * NP1 + n] = v; }
};
__global__ void k_up_finish(Ptrs P) {
    int r = blockIdx.x, n = r % NTOK;
    const float* t = (const float*)(P.ws + WS_TMP) + (size_t)r * NP1;
    const float* ssq = (const float*)(P.ws + WS_SSQ) + (size_t)r * 8;
    const float rq = rsqrtf((ssq[0] + ssq[1] + ssq[2] + ssq[3]) / 256.f + EPS), rkv = rsqrtf((ssq[4] + ssq[5] + ssq[6] + ssq[7]) / 128.f + EPS);
    const float2* TM = (const float2*)(P.ws + WS_TAB) + 1024;
    const bool lat = n >= NCTX; const int s = n - NCTX, gr = s >> 6, gc = s & 63;
    bf16* qo = (bf16*)(P.ws + WS_QM) + (size_t)r * 768; bf16* kvo = (bf16*)(P.ws + WS_KVM) + (size_t)r * 1024;
    for (int p = threadIdx.x; p < 1792; p += 256) {
        if (p < 768) {
            int rr = p % 96; float val = t[p] * rq;
            if (rr >= 64) { int ph = rr - 64, nn = (ph >> 2) & 1, i = 4 * (ph >> 3) + (ph & 3);
                float x1 = t[nn ? p - 4 : p] * rq, x2 = t[nn ? p : p + 4] * rq;
                float2 cs = lat ? TM[(i < 8 ? gr : gc) * 8 + (i & 7)] : make_float2(1.f, 0.f);
                val = nn ? x1 * cs.y + x2 * cs.x : x1 * cs.x - x2 * cs.y; }
            qo[p] = (bf16)f2bf(val);
        } else kvo[p - 768] = (bf16)f2bf(t[p] * rkv);
    }
}

template <int MODE> __global__ __launch_bounds__(256) void k_attn(Ptrs P) {
    const int t = blockIdx.x * 256 + threadIdx.x;
    const int b = (blockIdx.x * 256) / SEQ, s = t % SEQ, hh = blockIdx.y, sl = blockIdx.z;
    const bf16* P1 = (const bf16*)(P.ws + WS_P1); const bf16* QM = (const bf16*)(P.ws + WS_QM); const bf16* KV = (const bf16*)(P.ws + WS_KVM);
    const size_t qrow = (size_t)b * NTOK + NCTX + s, k0row = (size_t)b * NTOK;
    constexpr int DQK = MODE == 0 ? 96 : 64;
    float q[DQK]; float o[64]; float m = -1e30f, l = 0.f;
    const float scale = MODE == 0 ? 0.10206207261596575f : 0.125f;
    if (MODE == 0) { _Pragma("unroll") for (int d = 0; d < 96; ++d) q[d] = bf2f(QM[qrow * 768 + hh * 96 + d]) * scale; }
    else { _Pragma("unroll") for (int d = 0; d < 64; ++d) q[d] = bf2f(P1[qrow * NP1 + 512 + hh * 64 + d]) * scale; }
    _Pragma("unroll") for (int d = 0; d < 64; ++d) o[d] = 0.f;
    for (int j = 0; j < NTOK; ++j) {
        const size_t kr = k0row + j; float sc = 0.f;
        if (MODE == 0) {
            const bf16* kn = KV + kr * 1024 + hh * 128; const bf16* kro = P1 + kr * NP1 + 384;
            _Pragma("unroll") for (int d = 0; d < 64; ++d) sc += q[d] * bf2f(kn[d]);
            _Pragma("unroll") for (int d = 0; d < 32; ++d) sc += q[64 + d] * bf2f(kro[d]);
        } else { const bf16* kk = P1 + kr * NP1 + 1024 + hh * 64; _Pragma("unroll") for (int d = 0; d < 64; ++d) sc += q[d] * bf2f(kk[d]); }
        float mn = fmaxf(m, sc), al = __expf(m - mn), p = __expf(sc - mn);
        l = l * al + p; m = mn;
        const bf16* vv = MODE == 0 ? KV + kr * 1024 + hh * 128 + 64 : P1 + kr * NP1 + 1536 + (hh >> 1) * 128 + sl * 64;
        _Pragma("unroll") for (int d = 0; d < 64; ++d) o[d] = o[d] * al + p * bf2f(vv[d]);
    }
    const float il = 1.f / l;
    if (MODE == 0) { bf16* mo = (bf16*)(P.ws + WS_MIX) + (size_t)t * DM + hh * 64; _Pragma("unroll") for (int d = 0; d < 64; ++d) mo[d] = (bf16)f2bf(o[d] * il); }
    else { float* oo = (float*)(P.ws + WS_OS) + ((size_t)t * 8 + hh) * 128 + sl * 64; _Pragma("unroll") for (int d = 0; d < 64; ++d) oo[d] = o[d] * il; }
}
__global__ void k_diff_finish(Ptrs P) {
    const int t = blockIdx.x, h = threadIdx.x >> 6  , lane = threadIdx.x & 63;
    float d1 = 0.f, d2 = 0.f; for (int i = 0; i < 64; ++i) { d1 += P.in[13][i] * P.in[14][i]; d2 += P.in[15][i] * P.in[16][i]; }
    const float lam = __expf(d1) - __expf(d2) + LAM_INIT;
    const float* os = (const float*)(P.ws + WS_OS) + ((size_t)t * 8 + 2 * h) * 128;
    float v0 = os[lane] - lam * os[128 + lane], v1 = os[64 + lane] - lam * os[128 + 64 + lane];
    float ss = v0 * v0 + v1 * v1;
    for (int o = 1; o < 64; o <<= 1) ss += __shfl_xor(ss, o);
    const float rs = rsqrtf(ss / 128.f + EPS) * (1.f - LAM_INIT);
    bf16* mo = (bf16*)(P.ws + WS_MIX) + (size_t)t * DM + 512 + h * 128;
    mo[lane] = (bf16)f2bf(v0 * rs * P.in[17][lane]); mo[64 + lane] = (bf16)f2bf(v1 * rs * P.in[17][64 + lane]);
}

struct FOut { Ptrs P;
    __device__ int rows(int) const { return MLAT; }
    __device__ float a(int, int m, int k) const { return bf2f(((const bf16*)(P.ws + WS_MIX))[(size_t)m * DM + k]); }
    __device__ float b(int, int k, int n) const { return bf2f((bf16)f2bf(P.in[18][(size_t)k * DM + n])); }
    __device__ void c(int, int m, int n, float v) const { const float* mod = (const float*)(P.ws + WS_MOD) + (m / SEQ) * 6144;
        ((float*)(P.ws + WS_X1))[(size_t)m * DM + n] = P.in[0][(size_t)m * DM + n] + mod[2048 + n] * v; }
};
__global__ void k_h2(Ptrs P) {
    int t = blockIdx.x, b = t / SEQ;
    const float* src = (const float*)(P.ws + WS_X1) + (size_t)t * DM;
    const float* mod = (const float*)(P.ws + WS_MOD) + b * 6144;
    __shared__ float red[256];
    float v[4]; float ss = 0.f;
    for (int i = 0; i < 4; ++i) { v[i] = src[threadIdx.x + 256 * i]; ss += v[i] * v[i]; }
    red[threadIdx.x] = ss; __syncthreads();
    for (int o = 128; o > 0; o >>= 1) { if (threadIdx.x < o) red[threadIdx.x] += red[threadIdx.x + o]; __syncthreads(); }
    float rs = rsqrtf(red[0] / DM + EPS);
    for (int i = 0; i < 4; ++i) { int j = threadIdx.x + 256 * i; float y = v[i] * rs * P.in[7][j]; y = y * (1.f + mod[4096 + j]) + mod[3072 + j];
        ((bf16*)(P.ws + WS_H2))[(size_t)t * DM + j] = (bf16)f2bf(y); ((float*)(P.ws + WS_H2F))[(size_t)t * DM + j] = y; }
}
struct FRouter { Ptrs P;
    __device__ int rows(int) const { return MLAT; }
    __device__ float a(int, int m, int k) const { return ((const float*)(P.ws + WS_H2F))[(size_t)m * DM + k]; }
    __device__ float b(int, int k, int n) const { return P.in[19][(size_t)k * NEXP + n]; }
    __device__ void c(int, int m, int n, float v) const { ((float*)(P.ws + WS_LOG))[(size_t)m * NEXP + n] = v; }
};
__global__ __launch_bounds__(256) void k_route(Ptrs P) {
    const int t = blockIdx.x * 4 + (threadIdx.x >> 6), lane = threadIdx.x & 63;
    const float4 lg = ((const float4*)(P.ws + WS_LOG))[(size_t)t * 64 + lane];
    const float4 bi = ((const float4*)P.in[20])[lane];
    float s[4] = {1.f / (1.f + __expf(-lg.x)), 1.f / (1.f + __expf(-lg.y)), 1.f / (1.f + __expf(-lg.z)), 1.f / (1.f + __expf(-lg.w))};
    float v[4] = {s[0] + bi.x, s[1] + bi.y, s[2] + bi.z, s[3] + bi.w};
    float m1 = fmaxf(v[0], v[1]), m2 = fminf(v[0], v[1]);
    for (int i = 2; i < 4; ++i) { float x = v[i]; m2 = fmaxf(m2, fminf(m1, x)); m1 = fmaxf(m1, x); }
    for (int o = 1; o < 8; o <<= 1) { float b1 = __shfl_xor(m1, o), b2 = __shfl_xor(m2, o); float n1 = fmaxf(m1, b1), n2 = fmaxf(fminf(m1, b1), fmaxf(m2, b2)); m1 = n1; m2 = n2; }
    const float gs = m1 + m2; const int g = lane >> 3; int rank = 0;
    for (int j = 0; j < 8; ++j) { float o = __shfl(gs, j * 8); rank += (o > gs || (o == gs && j < g)) ? 1 : 0; }
    if (rank >= 4) { v[0] = v[1] = v[2] = v[3] = -INFINITY; }
    int my_e = 0; float my_s = 0.f; float ssum = 0.f;
    for (int k = 0; k < 8; ++k) {
        float bv = v[0]; int bi_ = 0;
        for (int i = 1; i < 4; ++i) if (v[i] > bv) { bv = v[i]; bi_ = i; }
        int be = lane * 4 + bi_;
        for (int o = 1; o < 64; o <<= 1) { float ov = __shfl_xor(bv, o); int oe = __shfl_xor(be, o); if (ov > bv || (ov == bv && oe < be)) { bv = ov; be = oe; } }
        const int wl = be >> 2, wi = be & 3;
        float sv = wi == 0 ? s[0] : wi == 1 ? s[1] : wi == 2 ? s[2] : s[3];
        sv = __shfl(sv, wl);
        if (lane == wl) { if (wi == 0) v[0] = -INFINITY; else if (wi == 1) v[1] = -INFINITY; else if (wi == 2) v[2] = -INFINITY; else v[3] = -INFINITY; }
        ssum += sv; if (lane == k) { my_e = be; my_s = sv; }
    }
    if (lane < 8) {
        int* cnt = (int*)(P.ws + WS_CTL) + CW_COUNT;
        int rk = atomicAdd(&cnt[my_e], 1);
        ((int*)(P.ws + WS_EIDX))[(size_t)t * 8 + lane] = my_e;
        ((float*)(P.ws + WS_EW))[(size_t)t * 8 + lane] = my_s / ssum * 2.5f;
        ((int*)(P.ws + WS_ERANK))[(size_t)t * 8 + lane] = rk;
    }
}
__global__ __launch_bounds__(256) void k_slots(Ptrs P) {
    __shared__ int off[257];
    const int* cnt = (const int*)(P.ws + WS_CTL) + CW_COUNT;
    if (threadIdx.x == 0) { int a = 0; for (int e = 0; e < 256; ++e) { off[e] = a; a += cnt[e]; } off[256] = a; }
    __syncthreads();
    if (blockIdx.x == 0) { int* go = (int*)(P.ws + WS_OFF); go[threadIdx.x] = off[threadIdx.x]; if (threadIdx.x == 0) { go[256] = off[256]; go[257] = NSLOT; } }
    int idx = blockIdx.x * 256 + threadIdx.x;
    int e = ((const int*)(P.ws + WS_EIDX))[idx], rk = ((const int*)(P.ws + WS_ERANK))[idx];
    int slot = off[e] + rk;
    ((int*)(P.ws + WS_SLOTOF))[idx] = slot;
    ((int*)(P.ws + WS_SLOTTOK))[slot] = idx >> 3;
    ((float*)(P.ws + WS_SLOTW))[slot] = ((const float*)(P.ws + WS_EW))[idx];
    if (idx < MLAT) { ((int*)(P.ws + WS_SLOTTOK))[MLAT * 8 + idx] = idx; ((float*)(P.ws + WS_SLOTW))[MLAT * 8 + idx] = 1.f; }
}
__global__ __launch_bounds__(256) void k_exp1(Ptrs P) {
    const int z = blockIdx.z; const int* off = (const int*)(P.ws + WS_OFF); const int rows = off[z + 1] - off[z]; const int m0 = blockIdx.y * 16; if (m0 >= rows) return;
    const float* w1 = z < 256 ? P.in[21] + (size_t)z * DM * EFF : P.in[24]; const float* w3 = z < 256 ? P.in[22] + (size_t)z * DM * EFF : P.in[25];
    __shared__ float hs[16][DM];
    for (int i = threadIdx.x; i < 16 * DM; i += 256) { int m = i / DM, k = i % DM; int slot = off[z] + m0 + m; hs[m][k] = (m0 + m < rows) ? bf2f(((const bf16*)(P.ws + WS_H2))[(size_t)((const int*)(P.ws + WS_SLOTTOK))[slot] * DM + k]) : 0.f; }
    __syncthreads();
    const int n = threadIdx.x; float g[16] = {}, u[16] = {};
    for (int k = 0; k < DM; ++k) { float a = bf2f((bf16)f2bf(w1[(size_t)k * EFF + n])), b = bf2f((bf16)f2bf(w3[(size_t)k * EFF + n]));
#pragma unroll
        for (int m = 0; m < 16; ++m) { g[m] += hs[m][k] * a; u[m] += hs[m][k] * b; } }
    for (int m = 0; m < 16; ++m) if (m0 + m < rows) { float gg = g[m]; float act = gg / (1.f + __expf(-gg)) * u[m]; ((bf16*)(P.ws + WS_ACT))[(size_t)(off[z] + m0 + m) * EFF + n] = (bf16)f2bf(act); }
}
struct FExp2 { Ptrs P;
    __device__ int rows(int z) const { const int* off = (const int*)(P.ws + WS_OFF); return off[z + 1] - off[z]; }
    __device__ float a(int z, int m, int k) const { const int* off = (const int*)(P.ws + WS_OFF); return bf2f(((const bf16*)(P.ws + WS_ACT))[(size_t)(off[z] + m) * EFF + k]); }
    __device__ float b(int z, int k, int n) const { const float* w = z < 256 ? P.in[23] + (size_t)z * EFF * DM : P.in[26]; return bf2f((bf16)f2bf(w[(size_t)k * DM + n])); }
    __device__ void c(int z, int m, int n, float v) const { const int* off = (const int*)(P.ws + WS_OFF); size_t slot = off[z] + m;
        ((bf16*)(P.ws + WS_Y))[slot * DM + n] = (bf16)f2bf(v * ((const float*)(P.ws + WS_SLOTW))[slot]); }
};
__global__ void k_combine(Ptrs P) {
    int t = blockIdx.x, b = t / SEQ;
    const float* x1 = (const float*)(P.ws + WS_X1) + (size_t)t * DM;
    const float* mod = (const float*)(P.ws + WS_MOD) + b * 6144;
    const bf16* Y = (const bf16*)(P.ws + WS_Y); const int* so = (const int*)(P.ws + WS_SLOTOF) + (size_t)t * 8;
    __shared__ float red[256];
    float v[4]; float ss = 0.f;
    for (int i = 0; i < 4; ++i) { int j = threadIdx.x + 256 * i; float a = bf2f(Y[(size_t)(MLAT * 8 + t) * DM + j]);
        for (int k = 0; k < 8; ++k) a += bf2f(Y[(size_t)so[k] * DM + j]);
        v[i] = x1[j] + mod[5120 + j] * a; ss += v[i] * v[i]; }
    red[threadIdx.x] = ss; __syncthreads();
    for (int o = 128; o > 0; o >>= 1) { if (threadIdx.x < o) red[threadIdx.x] += red[threadIdx.x + o]; __syncthreads(); }
    float rs = rsqrtf(red[0] / DM + EPS);
    for (int i = 0; i < 4; ++i) { int j = threadIdx.x + 256 * i; P.out[(size_t)t * DM + j] = v[i] * rs * P.in[27][j]; }
}

#define GAS __attribute__((address_space(1)))
#define LAS __attribute__((address_space(3)))
typedef short bf16x8 __attribute__((ext_vector_type(8)));
typedef short s16x4 __attribute__((ext_vector_type(4)));
typedef float f32x4 __attribute__((ext_vector_type(4)));
typedef float f32x2 __attribute__((ext_vector_type(2)));
typedef float f32x16 __attribute__((ext_vector_type(16)));
typedef float f32x8 __attribute__((ext_vector_type(8)));
typedef unsigned u32x4 __attribute__((ext_vector_type(4)));
typedef unsigned u32x2 __attribute__((ext_vector_type(2)));
#define RLX_AGENT __ATOMIC_RELAXED, __HIP_MEMORY_SCOPE_AGENT
#define LDS_WAIT() asm volatile("s_waitcnt lgkmcnt(0)" ::: "memory")
#define VM_WAIT() asm volatile("s_waitcnt vmcnt(0)" ::: "memory")

constexpr size_t WS_MODP = 1 * MiB;
constexpr size_t WS_WIN = 4 * MiB;
constexpr size_t WS_WUP = 8 * MiB;
constexpr size_t WS_WOUT = 10 * MiB;
constexpr size_t WS_WR = 12 * MiB;
constexpr size_t WS_W13 = 16 * MiB;
constexpr size_t WS_W2 = 273 * MiB;
constexpr size_t WS_UT = WS_OFF + 4096;
static_assert(WS_W2 + (size_t)257 * 1024 * 256 * 2 <= WS_X1, "ws map");
constexpr size_t WS_LOGP = WS_Y;
constexpr int CW_NUNIT = 2048;
constexpr int CW_BAR = 4096;

__device__ __forceinline__ unsigned cvt_pk_bf16(float lo, float hi) { unsigned r; asm volatile("v_cvt_pk_bf16_f32 %0, %1, %2" : "=v"(r) : "v"(lo), "v"(hi)); return r; }
__device__ __forceinline__ unsigned pk2(float lo, float hi) { return f2bf(lo) | (f2bf(hi) << 16); }
__device__ __forceinline__ u32x4 pack8(f32x4 a, f32x4 b) { u32x4 w; w.x = cvt_pk_bf16(a[0], a[1]); w.y = cvt_pk_bf16(a[2], a[3]); w.z = cvt_pk_bf16(b[0], b[1]); w.w = cvt_pk_bf16(b[2], b[3]); return w; }
__device__ __forceinline__ float wave_sum(float v) {
#pragma unroll
    for (int o = 1; o < 64; o <<= 1) v += __shfl_xor(v, o);
    return v;
}

namespace pg8 {
constexpr int BM = 256, BK = 64, HALF = 128, HTB = HALF * BK * 2, STAGE_BYTES = 8 * HTB;
__host__ __device__ __forceinline__ int lds_byte(int r, int c) { const int st = (r >> 4) * 2 + (c >> 5), rr = r & 15, cc = c & 31, ob = rr * 64 + cc * 2; return st * 1024 + (ob ^ (((ob >> 9) & 1) << 5)); }
__host__ __device__ __forceinline__ void stage_rc(int b, int& R, int& C) { const int st = b / 1024, sb = b % 1024, swz = sb ^ (((sb >> 9) & 1) << 5); R = (st >> 1) * 16 + swz / 64; C = (st & 1) * 32 + (swz % 64) / 2; }
__host__ __device__ __forceinline__ int perm32(int rho) { const int n = rho >> 4, i = rho & 15; return 8 * (i >> 2) + 4 * n + (i & 3); }

struct Unit { int pm, pn, r0, nv, k0; };
struct Gemm { const bf16* A; const bf16* Bt; int lda, ldb, K; };

struct StaticOrder {
    int nM, nN, nwg, G, c;
    __device__ void init(int M, int N, int G_, int c_) { nM = M / BM; nN = N / BM; nwg = nM * nN; G = G_; c = c_; }
    __device__ bool next(int i, Unit& u) const {
        const long L = (long)i * G + c; if (L >= nwg) return false;
        int wgid = (int)L; { const int q = nwg / 8, r = nwg % 8, xcd = wgid % 8, off = wgid / 8; wgid = (xcd < r ? xcd * (q + 1) : r * (q + 1) + (xcd - r) * q) + off; }
        const int nig = 8 * nN, gid = wgid / nig, fm = gid * 8, gsz = (nM - fm) < 8 ? (nM - fm) : 8;
        u.pm = fm + ((wgid % nig) % gsz); u.pn = (wgid % nig) / gsz; u.r0 = u.pm * BM; u.nv = BM; u.k0 = 0; return true;
    }
    __device__ __forceinline__ int a_row(const Unit& u, int r) const { return u.pm * BM + r; }
};

template <class Epi, class Sched>
__device__ __forceinline__ void gemm_phase(LAS unsigned char* lds, const Gemm g, const Sched& S, const Epi& E) {
    const int tid = threadIdx.x, wid = __builtin_amdgcn_readfirstlane(tid >> 6), lane = tid & 63, wr = wid >> 2, wc = wid & 3, fr = lane & 15, fq = lane >> 4;
    int K = g.K; asm volatile("" : "+s"(K));
    const int nt = K / BK;
    int RA[2], CA[2]; unsigned voffB[2];
#pragma unroll
    for (int i = 0; i < 2; ++i) { int R, C; stage_rc(tid * 16 + i * 8192, R, C); RA[i] = R; CA[i] = C; const int Rb = Epi::PERM ? ((R & ~31) + perm32(R & 31)) : R; voffB[i] = (unsigned)(Rb * g.ldb + C) * 2u; }
    const size_t kstep = (size_t)(BK * 2);
    const size_t hstepB = (size_t)HALF * g.ldb * 2, tstepB = 2 * hstepB;
    const unsigned ldsw = (unsigned)wid * 1024u;
    const int aoff = lds_byte(wr * 64 + fr, fq * 8), boff = lds_byte(wc * 32 + fr, fq * 8);
#define PG8_SA(b, h) (((b) * 2 + (h)) * HTB)
#define PG8_SB(b, h) ((4 + (b) * 2 + (h)) * HTB)
#define PG8_STAGE(bufoff, gbase, voff) do { _Pragma("unroll") for (int _i = 0; _i < 2; ++_i) \
        __builtin_amdgcn_global_load_lds((const unsigned*)((const char*)(gbase) + (voff)[_i]), (LAS unsigned*)(lds + (bufoff) + ldsw + _i * 8192), 16, 0, 0); } while (0)
#define PG8_LDA(dst, b, h) do { _Pragma("unroll") for (int m = 0; m < 4; ++m) _Pragma("unroll") for (int k = 0; k < 2; ++k) dst[m][k] = *(const LAS bf16x8*)(lds + PG8_SA(b, h) + aoff + m * 2048 + k * 1024); } while (0)
#define PG8_LDB(dst, b, h) do { _Pragma("unroll") for (int n = 0; n < 2; ++n) _Pragma("unroll") for (int k = 0; k < 2; ++k) dst[n][k] = *(const LAS bf16x8*)(lds + PG8_SB(b, h) + boff + n * 2048 + k * 1024); } while (0)
#define PG8_MMA(ai, bj, At, Bt) do { __builtin_amdgcn_s_setprio(1); _Pragma("unroll") for (int m = 0; m < 4; ++m) _Pragma("unroll") for (int n = 0; n < 2; ++n) _Pragma("unroll") for (int k = 0; k < 2; ++k) \
        acc[ai][bj][m][n] = __builtin_amdgcn_mfma_f32_16x16x32_bf16(Bt[n][k], At[m][k], acc[ai][bj][m][n], 0, 0, 0); __builtin_amdgcn_s_setprio(0); } while (0)
#define PG8_WAIT_V(n) asm volatile("s_waitcnt vmcnt(" #n ")" ::: "memory")
#define PG8_WAIT_L(n) asm volatile("s_waitcnt lgkmcnt(" #n ")" ::: "memory")
#define PG8_BAR __builtin_amdgcn_s_barrier()
#define PG8_SCHED __builtin_amdgcn_sched_barrier(0)
#define PG8_AOFFS(dst, u) do { _Pragma("unroll") for (int _h = 0; _h < 2; ++_h) _Pragma("unroll") for (int _i = 0; _i < 2; ++_i) \
        dst[_h][_i] = (unsigned)(((size_t)S.a_row(u, _h * HALF + RA[_i]) * (size_t)g.lda + (size_t)(CA[_i] + (u).k0)) * 2u); } while (0)
    Unit cur, nxt; int ui = 0;
    if (!S.next(0, cur)) return;
    f32x4 acc[2][2][4][2];
#pragma unroll
    for (int a = 0; a < 2; ++a)
#pragma unroll
        for (int b = 0; b < 2; ++b)
#pragma unroll
            for (int m = 0; m < 4; ++m)
#pragma unroll
                for (int n = 0; n < 2; ++n) acc[a][b][m][n] = (f32x4){0.f, 0.f, 0.f, 0.f};
    bf16x8 At[4][2], B0[2][2], B1[2][2];
    unsigned vA[2][2], vN[2][2];
    PG8_AOFFS(vA, cur);
    const char* Ab = (const char*)g.A; const char* cB = (const char*)g.Bt + (size_t)cur.pn * tstepB + (size_t)cur.k0 * 2;
    PG8_STAGE(PG8_SB(0, 0), cB, voffB); PG8_STAGE(PG8_SB(0, 1), cB + hstepB, voffB); PG8_STAGE(PG8_SA(0, 0), Ab, vA[0]); PG8_STAGE(PG8_SA(0, 1), Ab, vA[1]);
    if (wr == 1) PG8_BAR;
    PG8_WAIT_V(2); PG8_BAR;
    PG8_STAGE(PG8_SB(1, 0), cB + kstep, voffB); PG8_STAGE(PG8_SA(1, 0), Ab + kstep, vA[0]); PG8_STAGE(PG8_SB(1, 1), cB + hstepB + kstep, voffB);
    PG8_WAIT_V(6); PG8_BAR;
    for (;;) {
        const bool has_next = S.next(ui + 1, nxt);
        const char* nB = has_next ? (const char*)g.Bt + (size_t)nxt.pn * tstepB + (size_t)nxt.k0 * 2 : cB;
        if (has_next) { PG8_AOFFS(vN, nxt); } else { vN[0][0] = vA[0][0]; vN[0][1] = vA[0][1]; vN[1][0] = vA[1][0]; vN[1][1] = vA[1][1]; }
        for (int t = 0; t < nt; t += 2) {
            const bool last = (t == nt - 2); const bool full = cur.nv > HALF;
            const char* a1 = Ab + (size_t)(t + 1) * kstep;
            const char* a2 = Ab + (last ? (size_t)0 : (size_t)(t + 2) * kstep); const char* b2 = last ? nB : cB + (size_t)(t + 2) * kstep;
            const char* a3 = a2 + kstep; const char* b3 = b2 + kstep;
            unsigned w0[2], w1[2];
            w0[0] = last ? vN[0][0] : vA[0][0]; w0[1] = last ? vN[0][1] : vA[0][1]; w1[0] = last ? vN[1][0] : vA[1][0]; w1[1] = last ? vN[1][1] : vA[1][1];
            PG8_LDB(B0, 0, 0); PG8_LDB(B1, 0, 1); PG8_SCHED; PG8_LDA(At, 0, 0); PG8_STAGE(PG8_SA(1, 1), a1, vA[1]);
            PG8_WAIT_V(8); PG8_WAIT_L(0); PG8_BAR; PG8_MMA(0, 0, At, B0); PG8_MMA(0, 1, At, B1); PG8_BAR; PG8_SCHED;
            PG8_LDA(At, 0, 1); PG8_STAGE(PG8_SB(0, 0), b2, voffB); PG8_STAGE(PG8_SB(0, 1), b2 + hstepB, voffB); PG8_STAGE(PG8_SA(0, 0), a2, w0);
            PG8_WAIT_V(8); PG8_WAIT_L(0); PG8_BAR; if (full) { PG8_MMA(1, 0, At, B0); PG8_MMA(1, 1, At, B1); } PG8_BAR; PG8_SCHED;
            PG8_LDB(B0, 1, 0); PG8_LDB(B1, 1, 1); PG8_SCHED; PG8_LDA(At, 1, 0); PG8_STAGE(PG8_SA(0, 1), a2, w1);
            PG8_WAIT_V(8); PG8_WAIT_L(0); PG8_BAR; PG8_MMA(0, 0, At, B0); PG8_MMA(0, 1, At, B1); PG8_BAR; PG8_SCHED;
            PG8_LDA(At, 1, 1); PG8_STAGE(PG8_SB(1, 0), b3, voffB); PG8_STAGE(PG8_SB(1, 1), b3 + hstepB, voffB); PG8_STAGE(PG8_SA(1, 0), a3, w0);
            PG8_WAIT_V(8); PG8_WAIT_L(0); PG8_BAR; if (full) { PG8_MMA(1, 0, At, B0); PG8_MMA(1, 1, At, B1); } PG8_BAR; PG8_SCHED;
        }
        if (wr == 0) PG8_BAR;
        E(acc, cur, wr, wc, fr, fq);
        if (!has_next) break;
#pragma unroll
        for (int a = 0; a < 2; ++a)
#pragma unroll
            for (int b = 0; b < 2; ++b)
#pragma unroll
                for (int m = 0; m < 4; ++m)
#pragma unroll
                    for (int n = 0; n < 2; ++n) acc[a][b][m][n] = (f32x4){0.f, 0.f, 0.f, 0.f};
        cur = nxt; cB = nB; ++ui;
        vA[0][0] = vN[0][0]; vA[0][1] = vN[0][1]; vA[1][0] = vN[1][0]; vA[1][1] = vN[1][1];
        if (wr == 1) PG8_BAR;
    }
    PG8_WAIT_V(0);
    PG8_BAR;
#undef PG8_SA
#undef PG8_SB
#undef PG8_STAGE
#undef PG8_LDA
#undef PG8_LDB
#undef PG8_MMA
#undef PG8_WAIT_V
#undef PG8_WAIT_L
#undef PG8_BAR
#undef PG8_SCHED
#undef PG8_AOFFS
}
}

using pg8::Unit;
typedef f32x4 Acc[2][2][4][2];

struct EpiInProj {
    static constexpr bool PERM = true;
    bf16* P1; float* SSQ; const float2* TD; const float2* TM;
    __device__ __forceinline__ void operator()(const Acc& acc, const Unit& u, int wr, int wc, int fr, int fq) const {
        const int pm = u.pm, pn = u.pn, jt = pm % 17; const bool lat = jt > 0;
        const int row0 = pm * 256 + wr * 64 + fr, col0 = pn * 256 + wc * 32 + 8 * fq;
        if (pn == 0 || pn >= 6 || (pn == 1)) {
#pragma unroll
            for (int ai = 0; ai < 2; ++ai)
#pragma unroll
                for (int m = 0; m < 4; ++m) {
                    const int r = row0 + ai * 128 + m * 16; bf16* rowp = P1 + (size_t)r * NP1 + col0;
                    *(u32x4*)(rowp) = pack8(acc[ai][0][m][0], acc[ai][0][m][1]);
                    if (pn != 1) *(u32x4*)(rowp + 128) = pack8(acc[ai][1][m][0], acc[ai][1][m][1]);
                    if (pn <= 1) {
                        float s = 0.f;
#pragma unroll
                        for (int bj = 0; bj < 2; ++bj) { if (pn == 1 && bj == 1) break;
#pragma unroll
                            for (int n = 0; n < 2; ++n) { const f32x4 x = acc[ai][bj][m][n]; s += (x[0] * x[0] + x[1] * x[1]) + (x[2] * x[2] + x[3] * x[3]); } }
                        s += __shfl_xor(s, 16); s += __shfl_xor(s, 32);
                        if (fq == 0) SSQ[(size_t)r * 8 + pn * 4 + wc] = s;
                    }
                    if (pn == 1 && wc == 0) {
                        f32x4 x1 = acc[ai][1][m][0], x2 = acc[ai][1][m][1], o1 = x1, o2 = x2;
                        if (lat) { const int gr = (jt - 1) * 4 + 2 * ai + wr, gc = 16 * m + fr;
                            const float2* tp = TM + (fq < 2 ? gr * 8 + 4 * fq : gc * 8 + 4 * (fq - 2));
                            const f32x4 t0 = *(const f32x4*)tp, t1 = *(const f32x4*)(tp + 2);
                            const f32x4 cs = {t0[0], t0[2], t1[0], t1[2]}, sn = {t0[1], t0[3], t1[1], t1[3]};
                            o1 = x1 * cs - x2 * sn; o2 = x1 * sn + x2 * cs; }
                        *(u32x4*)(rowp + 128) = pack8(o1, o2);
                    }
                }
        } else {
            const int g = wc & 1; const float qs = pn < 4 ? 0.125f * 1.4426950408889634f : 1.f;
#pragma unroll
            for (int ai = 0; ai < 2; ++ai) {
                const int gr = (jt - 1) * 4 + 2 * ai + wr;
#pragma unroll
                for (int m = 0; m < 4; ++m) {
                    const int r = row0 + ai * 128 + m * 16; bf16* rowp = P1 + (size_t)r * NP1 + col0;
                    f32x4 cs = {1.f, 1.f, 1.f, 1.f}, sn = {0.f, 0.f, 0.f, 0.f};
                    if (lat) { const int gc = 16 * m + fr; const float2* tp = TD + (g == 0 ? gr : gc) * 16 + 4 * fq;
                        const f32x4 t0 = *(const f32x4*)tp, t1 = *(const f32x4*)(tp + 2);
                        cs = (f32x4){t0[0], t0[2], t1[0], t1[2]}; sn = (f32x4){t0[1], t0[3], t1[1], t1[3]}; }
#pragma unroll
                    for (int bj = 0; bj < 2; ++bj) { const f32x4 x1 = acc[ai][bj][m][0] * qs, x2 = acc[ai][bj][m][1] * qs;
                        *(u32x4*)(rowp + bj * 128) = pack8(x1 * cs - x2 * sn, x1 * sn + x2 * cs); }
                }
            }
        }
    }
};

struct EpiUp {
    static constexpr bool PERM = true;
    bf16* QM; bf16* KVM; const float* SSQ; const float2* TM;
    __device__ __forceinline__ void operator()(const Acc& acc, const Unit& u, int wr, int wc, int fr, int fq) const {
        const int pm = u.pm, pn = u.pn, jt = pm % 17; const bool lat = jt > 0, isq = pn < 3;
        const int row0 = pm * 256 + wr * 64 + fr, col0 = pn * 256 + wc * 32 + 8 * fq;
#pragma unroll
        for (int ai = 0; ai < 2; ++ai)
#pragma unroll
            for (int m = 0; m < 4; ++m) {
                const int r = row0 + ai * 128 + m * 16;
                const f32x4 sq = *(const f32x4*)(SSQ + (size_t)r * 8 + (isq ? 0 : 4));
                const float rs = rsqrtf(((sq[0] + sq[1]) + (sq[2] + sq[3])) * (isq ? 1.f / 256.f : 1.f / 128.f) + EPS) * (isq ? 0.10206207261596575f * 1.4426950408889634f : 1.f);
#pragma unroll
                for (int bj = 0; bj < 2; ++bj) {
                    f32x4 x1 = acc[ai][bj][m][0] * rs, x2 = acc[ai][bj][m][1] * rs;
                    if (isq) {
                        const int G = 8 * pn + 4 * bj + wc;
                        if (lat && (G % 3) == 2) { const int gr = (jt - 1) * 4 + 2 * ai + wr, gc = 16 * m + fr;
                            const float2* tp = TM + (fq < 2 ? gr * 8 + 4 * fq : gc * 8 + 4 * (fq - 2));
                            const f32x4 t0 = *(const f32x4*)tp, t1 = *(const f32x4*)(tp + 2);
                            const f32x4 cs = {t0[0], t0[2], t1[0], t1[2]}, sn = {t0[1], t0[3], t1[1], t1[3]};
                            const f32x4 o1 = x1 * cs - x2 * sn, o2 = x1 * sn + x2 * cs; x1 = o1; x2 = o2; }
                        *(u32x4*)(QM + (size_t)r * 768 + col0 + bj * 128) = pack8(x1, x2);
                    } else *(u32x4*)(KVM + (size_t)r * 1024 + (col0 - 768) + bj * 128) = pack8(x1, x2);
                }
            }
    }
};

struct EpiOut {
    static constexpr bool PERM = false;
    const float* x; const float* MOD; float* X1;
    __device__ __forceinline__ void operator()(const Acc& acc, const Unit& u, int wr, int wc, int fr, int fq) const {
        const int b = u.pm / 16; const float* gt = MOD + b * 6144 + 2048;
        const int row0 = u.pm * 256 + wr * 64 + fr, col0 = u.pn * 256 + wc * 32 + 4 * fq;
        f32x4 gv[2][2];
#pragma unroll
        for (int bj = 0; bj < 2; ++bj)
#pragma unroll
            for (int n = 0; n < 2; ++n) gv[bj][n] = *(const f32x4*)(gt + col0 + bj * 128 + n * 16);
#pragma unroll
        for (int ai = 0; ai < 2; ++ai)
#pragma unroll
            for (int m = 0; m < 4; ++m) { const size_t off = (size_t)(row0 + ai * 128 + m * 16) * DM + col0;
#pragma unroll
                for (int bj = 0; bj < 2; ++bj)
#pragma unroll
                    for (int n = 0; n < 2; ++n) { const f32x4 xv = *(const f32x4*)(x + off + bj * 128 + n * 16);
                        *(f32x4*)(X1 + off + bj * 128 + n * 16) = xv + gv[bj][n] * acc[ai][bj][m][n]; } }
    }
};
struct EpiF32 {
    static constexpr bool PERM = false;
    float* O; int ldc;
    __device__ __forceinline__ void operator()(const Acc& acc, const Unit& u, int wr, int wc, int fr, int fq) const {
        const int row0 = u.pm * 256 + wr * 64 + fr, col0 = u.pn * 256 + wc * 32 + 4 * fq;
#pragma unroll
        for (int ai = 0; ai < 2; ++ai)
#pragma unroll
            for (int m = 0; m < 4; ++m) { const size_t off = (size_t)(row0 + ai * 128 + m * 16) * ldc + col0;
#pragma unroll
                for (int bj = 0; bj < 2; ++bj)
#pragma unroll
                    for (int n = 0; n < 2; ++n) *(f32x4*)(O + off + bj * 128 + n * 16) = acc[ai][bj][m][n]; }
    }
};
struct EpiAct {
    static constexpr bool PERM = true;
    bf16* ACT; const float* SW;
    __device__ __forceinline__ void operator()(const Acc& acc, const Unit& u, int wr, int wc, int fr, int fq) const {
        const int half = u.pn & 1, colb = half * 128 + wc * 32 + 8 * fq;
#pragma unroll
        for (int ai = 0; ai < 2; ++ai)
#pragma unroll
            for (int m = 0; m < 4; ++m) { const int tr = ai * 128 + wr * 64 + m * 16 + fr;
                f32x4 a[2];
#pragma unroll
                for (int n = 0; n < 2; ++n) { const f32x4 gt = acc[ai][0][m][n], up = acc[ai][1][m][n];
#pragma unroll
                    for (int e = 0; e < 4; ++e) a[n][e] = gt[e] * __builtin_amdgcn_rcpf(1.f + __expf(-gt[e])) * up[e]; }
                if (tr < u.nv) { const float w = SW[u.r0 + tr]; *(u32x4*)(ACT + (size_t)(u.r0 + tr) * EFF + colb) = pack8(a[0] * w, a[1] * w); } }
    }
};
struct EpiY {
    static constexpr bool PERM = true;
    bf16* Y;
    __device__ __forceinline__ void operator()(const Acc& acc, const Unit& u, int wr, int wc, int fr, int fq) const {
        const int colb = (u.pn & 3) * 256 + wc * 32 + 8 * fq;
#pragma unroll
        for (int ai = 0; ai < 2; ++ai)
#pragma unroll
            for (int m = 0; m < 4; ++m) { const int tr = ai * 128 + wr * 64 + m * 16 + fr;
                if (tr < u.nv) { bf16* rowp = Y + (size_t)(u.r0 + tr) * DM + colb;
#pragma unroll
                    for (int bj = 0; bj < 2; ++bj) *(u32x4*)(rowp + bj * 128) = pack8(acc[ai][bj][m][0], acc[ai][bj][m][1]); } }
    }
};

template <int SUB, bool GATHER> struct ExpSched {
    const LAS int* uc; int nmine; const int* slot_tok;
    __device__ bool next(int i, Unit& u) const {
        if (i >= nmine) return false;
        const int e = __builtin_amdgcn_readfirstlane(uc[i * 4 + 0]), r0 = __builtin_amdgcn_readfirstlane(uc[i * 4 + 1]);
        const int nv = __builtin_amdgcn_readfirstlane(uc[i * 4 + 2]), sub = __builtin_amdgcn_readfirstlane(uc[i * 4 + 3]);
        u.pm = 0; u.pn = e * SUB + sub; u.r0 = r0; u.nv = nv; u.k0 = 0; return true;
    }
    __device__ __forceinline__ int a_row(const Unit& u, int r) const {
        if (GATHER) return r < u.nv ? slot_tok[u.r0 + r] : 0;
        const int s = u.r0 + r; return s < NSLOT ? s : NSLOT - 1;
    }
};
template <int SUB> __device__ __forceinline__ int exp_units_to_lds(LAS int* uc, const int* ut, int ntot, int G, int c) {
    const int nmine = c < ntot ? (ntot - 1 - c) / G + 1 : 0;
    if ((int)threadIdx.x < nmine && threadIdx.x < 64) { const int L = (int)threadIdx.x * G + c, cu = L / SUB;
        uc[threadIdx.x * 4 + 0] = ut[cu * 4 + 0]; uc[threadIdx.x * 4 + 1] = ut[cu * 4 + 1]; uc[threadIdx.x * 4 + 2] = ut[cu * 4 + 2]; uc[threadIdx.x * 4 + 3] = L % SUB; }
    __syncthreads();
    return nmine < 64 ? nmine : 64;
}
struct RouterOrder {
    int G, c;
    __device__ bool next(int i, Unit& u) const { const int L = i * G + c; if (L >= 256) return false; u.pm = L >> 2; u.pn = 0; u.r0 = u.pm * 256; u.nv = 256; u.k0 = (L & 3) * 256; return true; }
    __device__ __forceinline__ int a_row(const Unit& u, int r) const { return u.pm * 256 + r; }
};
struct UpOrder {
    int G, c;
    __device__ bool next(int i, Unit& u) const { const int L = i * G + c; if (L >= 68 * 7) return false; u.pm = L / 7; u.pn = L % 7; u.r0 = u.pm * 256; u.nv = 256; u.k0 = u.pn < 3 ? 0 : 128; return true; }
    __device__ __forceinline__ int a_row(const Unit& u, int r) const { return u.pm * 256 + r; }
};
struct EpiLogP {
    static constexpr bool PERM = false;
    float* O;
    __device__ __forceinline__ void operator()(const Acc& acc, const Unit& u, int wr, int wc, int fr, int fq) const {
        float* base = O + (size_t)(u.k0 >> 8) * MLAT * NEXP;
        const int row0 = u.pm * 256 + wr * 64 + fr, col0 = wc * 32 + 4 * fq;
#pragma unroll
        for (int ai = 0; ai < 2; ++ai)
#pragma unroll
            for (int m = 0; m < 4; ++m) { const size_t off = (size_t)(row0 + ai * 128 + m * 16) * NEXP + col0;
#pragma unroll
                for (int bj = 0; bj < 2; ++bj)
#pragma unroll
                    for (int n = 0; n < 2; ++n) *(f32x4*)(base + off + bj * 128 + n * 16) = acc[ai][bj][m][n]; }
    }
};

namespace attn {
#define SBAR() __builtin_amdgcn_sched_barrier(0)
constexpr float THR = 8.f;
template <int MODE> struct Cfg;
template <> struct Cfg<0> { static constexpr int DQK = 96, DV = 64, LDQ = 768, LDK0 = 1024, LDK1 = 2048, LDV = 1024; static constexpr float SCALE = 0.10206207261596575f; };
template <> struct Cfg<1> { static constexpr int DQK = 64, DV = 128, LDQ = 2048, LDK0 = 2048, LDK1 = 2048, LDV = 2048; static constexpr float SCALE = 0.125f; };
__device__ __forceinline__ int crow(int r, int hi) { return (r & 3) + 8 * (r >> 2) + 4 * hi; }
__device__ __forceinline__ unsigned cvtpk(float lo, float hi) { unsigned r; asm volatile("v_cvt_pk_bf16_f32 %0, %1, %2" : "=v"(r) : "v"(lo), "v"(hi)); return r; }

constexpr float THR2 = 11.5f;
__device__ __forceinline__ float max3f(float a, float b, float c) { return __builtin_fmaxf(__builtin_fmaxf(a, b), c); }
__device__ __forceinline__ void partialSM(f32x16& p0, f32x16& p1, float& m_reg, float& alpha, bool first) {
    float a = max3f(p0[0], p0[1], p1[0]), b = max3f(p0[2], p0[3], p1[1]); a = max3f(a, p1[2], p1[3]);
#pragma unroll
    for (int r = 4; r < 16; r += 4) { a = max3f(a, p0[r], p0[r + 1]); b = max3f(b, p0[r + 2], p0[r + 3]); a = max3f(a, p1[r], p1[r + 1]); b = max3f(b, p1[r + 2], p1[r + 3]); }
    float pmax = __builtin_fmaxf(a, b);
    { auto rr = __builtin_amdgcn_permlane32_swap(__float_as_uint(pmax), __float_as_uint(pmax), false, false);
      pmax = __builtin_fmaxf(__uint_as_float(rr[0]), __uint_as_float(rr[1])); }
    alpha = 1.f;
    if (__builtin_expect(first || __any(pmax > THR2), 0)) {
        const float dl = first ? pmax : __builtin_fmaxf(pmax, 0.f);
        m_reg += dl; alpha = first ? 1.f : __builtin_amdgcn_exp2f(-dl);
#pragma unroll
        for (int r = 0; r < 16; ++r) { p0[r] -= dl; p1[r] -= dl; }
    }
#pragma unroll
    for (int r = 0; r < 16; ++r) p0[r] = __builtin_amdgcn_exp2f(p0[r]);
}
__device__ __forceinline__ void finishSM(f32x16& p0, f32x16& p1, float alpha, float& l_reg, bf16x8& pa0, bf16x8& pa1, bf16x8& pa2, bf16x8& pa3) {
#pragma unroll
    for (int r = 0; r < 16; ++r) p1[r] = __builtin_amdgcn_exp2f(p1[r]);
    float ps = 0;
#pragma unroll
    for (int r = 0; r < 16; ++r) ps += p0[r];
#pragma unroll
    for (int r = 0; r < 16; ++r) ps += p1[r];
    { auto rr = __builtin_amdgcn_permlane32_swap(__float_as_uint(ps), __float_as_uint(ps), false, false);
      ps = __uint_as_float(rr[0]) + __uint_as_float(rr[1]); }
    l_reg = l_reg * alpha + ps;
#define PK4(P, BASE, OUT) do { u32x4 w = {cvtpk(P[BASE + 0], P[BASE + 1]), cvtpk(P[BASE + 2], P[BASE + 3]), cvtpk(P[BASE + 4], P[BASE + 5]), cvtpk(P[BASE + 6], P[BASE + 7])}; OUT = *reinterpret_cast<bf16x8*>(&w); } while (0)
    PK4(p0, 0, pa0); PK4(p0, 8, pa1); PK4(p1, 0, pa2); PK4(p1, 8, pa3);
#undef PK4
}
template <int NQ, int KROW> __device__ __forceinline__ void qkt(f32x16& p0, f32x16& p1, const char* Ks, const bf16x8* qr, float m_ref, int r32, int hi) {
    f32x16 negm;
#pragma unroll
    for (int r = 0; r < 16; ++r) negm[r] = -m_ref;
    p0 = negm; p1 = negm;
#pragma unroll
    for (int d0 = 0; d0 < NQ; ++d0) { const int cb = d0 * 32 + hi * 16;
        const bf16x8 b0 = *reinterpret_cast<const bf16x8*>(Ks + r32 * KROW + cb);
        const bf16x8 b1 = *reinterpret_cast<const bf16x8*>(Ks + (32 + r32) * KROW + cb);
        p0 = __builtin_amdgcn_mfma_f32_32x32x16_bf16(b0, qr[d0], p0, 0, 0, 0);
        p1 = __builtin_amdgcn_mfma_f32_32x32x16_bf16(b1, qr[d0], p1, 0, 0, 0); }
}
template <int NC> __device__ __forceinline__ int v_st(int k, int c) { const int kk = k; return ((kk >> 3) * NC + (c >> 5)) * 512 + ((kk & 7) * 32 + (c & 31)) * 2; }
__device__ __forceinline__ int v_rd_base(int lane) { return ((lane & 3) << 3) | (((lane >> 2) & 3) << 6) | (((lane >> 4) & 1) << 5) | (((lane >> 5) & 1) << 8); }
template <int OFF> __device__ __forceinline__ s16x4 tr_read(int vb) {
    s16x4 r; asm volatile("ds_read_b64_tr_b16 %0, %1 offset:%2" : "=&v"(r) : "v"(vb), "i"(OFF) : "memory"); return r;
}
template <int NC, int D0> __device__ __forceinline__ void pv_one(f32x16& od, int vb, bf16x8 pa0, bf16x8 pa1, bf16x8 pa2, bf16x8 pa3) {
#define VOFF(ks, half) (D0 * 512 + (ks) * (NC * 1024) + (half) * (NC * 512))
    const s16x4 l0 = tr_read<VOFF(0, 0)>(vb), h0 = tr_read<VOFF(0, 1)>(vb), l1 = tr_read<VOFF(1, 0)>(vb), h1 = tr_read<VOFF(1, 1)>(vb);
    const s16x4 l2 = tr_read<VOFF(2, 0)>(vb), h2 = tr_read<VOFF(2, 1)>(vb), l3 = tr_read<VOFF(3, 0)>(vb), h3 = tr_read<VOFF(3, 1)>(vb);
#undef VOFF
    asm volatile("s_waitcnt lgkmcnt(0)" ::: "memory"); SBAR();
#define PK(L, H) (bf16x8){L[0], L[1], L[2], L[3], H[0], H[1], H[2], H[3]}
    od = __builtin_amdgcn_mfma_f32_32x32x16_bf16(pa0, PK(l0, h0), od, 0, 0, 0);
    od = __builtin_amdgcn_mfma_f32_32x32x16_bf16(pa1, PK(l1, h1), od, 0, 0, 0);
    od = __builtin_amdgcn_mfma_f32_32x32x16_bf16(pa2, PK(l2, h2), od, 0, 0, 0);
    od = __builtin_amdgcn_mfma_f32_32x32x16_bf16(pa3, PK(l3, h3), od, 0, 0, 0);
#undef PK
}
template <int NC> __device__ __forceinline__ void pv_all(f32x16* o, int vb, bf16x8 pa0, bf16x8 pa1, bf16x8 pa2, bf16x8 pa3) {
    pv_one<NC, 0>(o[0], vb, pa0, pa1, pa2, pa3); pv_one<NC, 1>(o[1], vb, pa0, pa1, pa2, pa3);
    if constexpr (NC == 4) { pv_one<NC, 2>(o[2], vb, pa0, pa1, pa2, pa3); pv_one<NC, 3>(o[3], vb, pa0, pa1, pa2, pa3); }
}
template <int MODE> constexpr int lds_bytes() { return 2 * 64 * Cfg<MODE>::DV * 2 + 2 * 64 * (Cfg<MODE>::DQK * 2 + 16) + 8 * 64 * 4; }

template <int MODE>
__device__ __forceinline__ void unit(const bf16* __restrict__ Qb, const bf16* __restrict__ K0, const bf16* __restrict__ K1, const bf16* __restrict__ Vh, void* Ob, int ldo, char* lds) {
    using C = Cfg<MODE>;
    constexpr int DQK = C::DQK, DV = C::DV, NQ = DQK / 16, NC = DV / 32, KROW = DQK * 2 + 16, SHM_K = 64 * KROW, SHM_V = 64 * DV * 2;
    const int tid = threadIdx.x, wid = tid >> 6, lane = tid & 63, r32 = lane & 31, hi = lane >> 5;
    char* V_lds = lds; char* K_lds = lds + 2 * SHM_V;
    float* ws = (float*)(lds + 2 * SHM_V + 2 * SHM_K) + wid * 64; float* li_l = ws; float* al_l = ws + 32;
    float m_reg = 0.f, l_reg = 0; f32x16 o[NC]; bf16x8 qr[NQ];
#pragma unroll
    for (int d = 0; d < NC; ++d) o[d] = f32x16{};
    const bf16* Qw = Qb + (size_t)(wid * 32 + r32) * C::LDQ + hi * 8;
#pragma unroll
    for (int d0 = 0; d0 < NQ; ++d0) qr[d0] = *reinterpret_cast<const bf16x8*>(Qw + d0 * 16);
    const int vb0 = (int)(uintptr_t)V_lds + v_rd_base(lane);
    const int kr0 = tid >> 3, kc0 = tid & 7;
    const int krr = (tid & 255) >> 2, krc = tid & 3;
    const int vr0 = MODE == 0 ? (tid >> 3) : (tid >> 4), vc0 = MODE == 0 ? (tid & 7) * 8 : (tid & 15) * 8;
    const int vst0 = v_st<NC>(vr0, vc0), vst1 = v_st<NC>(32 + vr0, vc0);
    constexpr int SDEPTH = 2;
    struct { bf16x8 ka, kb, va, vb; } sr_[SDEPTH];
#define SLOAD(i, k0) do { sr_[i].ka = *reinterpret_cast<const bf16x8*>(K0 + (size_t)((k0) + kr0) * C::LDK0 + kc0 * 8); \
        if (MODE == 0) { sr_[i].kb = *reinterpret_cast<const bf16x8*>(K1 + (size_t)((k0) + krr) * C::LDK1 + krc * 8); } \
        sr_[i].va = *reinterpret_cast<const bf16x8*>(Vh + (size_t)((k0) + vr0) * C::LDV + vc0); \
        if (MODE == 1) { sr_[i].vb = *reinterpret_cast<const bf16x8*>(Vh + (size_t)((k0) + 32 + vr0) * C::LDV + vc0); } } while (0)
#define SWRITE(b, i) do { *(bf16x8*)(K_lds + (b) * SHM_K + kr0 * KROW + kc0 * 16) = sr_[i].ka; \
        if (MODE == 0) { *(bf16x8*)(K_lds + (b) * SHM_K + krr * KROW + 128 + krc * 16) = sr_[i].kb; } \
        *(bf16x8*)(V_lds + (b) * SHM_V + vst0) = sr_[i].va; \
        if (MODE == 1) { *(bf16x8*)(V_lds + (b) * SHM_V + vst1) = sr_[i].vb; } } while (0)
#define SWAIT() asm volatile("s_waitcnt vmcnt(3)" ::: "memory")
#define RESC(a) do { if (__any((a) < 1.f)) { if (hi == 0) al_l[r32] = (a); asm volatile("s_waitcnt lgkmcnt(0)" ::: "memory"); \
        _Pragma("unroll") for (int d = 0; d < NC; ++d) _Pragma("unroll") for (int r = 0; r < 16; ++r) o[d][r] *= al_l[crow(r, hi)]; } } while (0)
    f32x16 pA0, pA1, pB0, pB1; float alA = 1.f, alB = 1.f; bf16x8 pa0, pa1, pa2, pa3; constexpr int NT = NTOK / 64;
    constexpr int SE = 0, SO = SDEPTH - 1;
    SLOAD(SE, 0); asm volatile("s_waitcnt vmcnt(0)" ::: "memory"); SWRITE(0, SE); __syncthreads();
    qkt<NQ, KROW>(pA0, pA1, K_lds, qr, m_reg, r32, hi); partialSM(pA0, pA1, m_reg, alA, true);
    SLOAD(SO, 64); if (SDEPTH == 2) SLOAD(SE, 128);
    SWAIT(); SWRITE(1, SO); __syncthreads();
    for (int j = 1; j + 1 < NT; j += 2) {
        SBAR(); qkt<NQ, KROW>(pB0, pB1, K_lds + SHM_K, qr, m_reg, r32, hi);
        finishSM(pA0, pA1, alA, l_reg, pa0, pa1, pa2, pa3); SBAR();
        SLOAD(SO, (j + SDEPTH) * 64); SBAR();
        pv_all<NC>(o, vb0, pa0, pa1, pa2, pa3); partialSM(pB0, pB1, m_reg, alB, false);
        __syncthreads(); SWAIT(); SWRITE(0, SE);
        RESC(alB); __syncthreads();
        SBAR(); qkt<NQ, KROW>(pA0, pA1, K_lds, qr, m_reg, r32, hi);
        finishSM(pB0, pB1, alB, l_reg, pa0, pa1, pa2, pa3); SBAR();
        if (SDEPTH == 1 || j + 3 < NT) SLOAD(SE, (j + 1 + SDEPTH) * 64); SBAR();
        pv_all<NC>(o, vb0 + SHM_V, pa0, pa1, pa2, pa3); partialSM(pA0, pA1, m_reg, alA, false);
        __syncthreads(); SWAIT(); SWRITE(1, SO);
        RESC(alA); __syncthreads();
    }
    SBAR(); qkt<NQ, KROW>(pB0, pB1, K_lds + SHM_K, qr, m_reg, r32, hi);
    finishSM(pA0, pA1, alA, l_reg, pa0, pa1, pa2, pa3); SBAR();
    pv_all<NC>(o, vb0, pa0, pa1, pa2, pa3); partialSM(pB0, pB1, m_reg, alB, false);
    __syncthreads(); RESC(alB);
    finishSM(pB0, pB1, alB, l_reg, pa0, pa1, pa2, pa3); SBAR();
    pv_all<NC>(o, vb0 + SHM_V, pa0, pa1, pa2, pa3);
    if (hi == 0) li_l[r32] = l_reg; asm volatile("s_waitcnt lgkmcnt(0)" ::: "memory");
    float rli[16];
#pragma unroll
    for (int r = 0; r < 16; ++r) rli[r] = __builtin_amdgcn_rcpf(li_l[crow(r, hi)]);
#pragma unroll
    for (int r = 0; r < 16; ++r) { const int orow = wid * 32 + crow(r, hi);
#pragma unroll
        for (int d0 = 0; d0 < NC; ++d0) {
            if (MODE == 0) ((bf16*)Ob)[(size_t)orow * ldo + d0 * 32 + r32] = (bf16)f2bf(o[d0][r] * rli[r]);
            else ((float*)Ob)[(size_t)orow * ldo + d0 * 32 + r32] = o[d0][r] * rli[r]; } }
    __syncthreads();
#undef SLOAD
#undef SWRITE
#undef SWAIT
#undef RESC
}
#undef SBAR
}

#define XB_TMO      128
#define XB_XCNT(j)  (256  + 64 * (j))
#define XB_XSUB(j)  (1280 + 64 * (j))
#define XB_XGEN(j)  (2304 + 64 * (j))
#define XB_TOP      3328
#define XB_TOPGEN   3392
#define XCD_BAR_WORDS 3456
#define XB_SPIN_CAP (1u << 20)
__device__ __forceinline__ unsigned xb_ld(unsigned* p)              { return __hip_atomic_load(p, __ATOMIC_RELAXED, __HIP_MEMORY_SCOPE_AGENT); }
__device__ __forceinline__ unsigned xb_add(unsigned* p, unsigned v) { return __hip_atomic_fetch_add(p, v, __ATOMIC_RELAXED, __HIP_MEMORY_SCOPE_AGENT); }
__device__ __forceinline__ unsigned xb_xcc_id() { return (unsigned)__builtin_amdgcn_s_getreg((3 << 11) | 20) & 0xFu; }
#define XB_SPIN(cond, bar) do { unsigned _sp = 0; while (cond) { __builtin_amdgcn_s_sleep(1); \
    if ((++_sp & 255u) == 0u) { if (xb_ld(&(bar)[XB_TMO])) break; if (_sp > XB_SPIN_CAP) { atomicAdd(&(bar)[XB_TMO], 1u); break; } } } } while (0)
struct XcdBarrier { unsigned* bar; unsigned x; volatile LAS unsigned* st; };
__device__ __forceinline__ XcdBarrier xcd_barrier_post(unsigned* bar, volatile LAS unsigned* st) {
    XcdBarrier b; b.bar = bar; b.x = xb_xcc_id(); b.st = st;
    if (threadIdx.x == 0) (void)xb_add(&bar[XB_XCNT(b.x)], 1u);
    return b;
}
__device__ __forceinline__ void xcd_barrier_complete(unsigned* bar, unsigned x, unsigned& nloc, unsigned& nx) {
    const unsigned G = gridDim.x * gridDim.y * gridDim.z;
    unsigned sum, cnt, mine, sp = 0u;
    for (;;) {
        sum = 0u; cnt = 0u; mine = 0u;
#pragma unroll
        for (unsigned j = 0; j < 16; ++j) { const unsigned c = xb_ld(&bar[XB_XCNT(j)]); sum += c; cnt += (c > 0u) ? 1u : 0u; mine = (j == x) ? c : mine; }
        if (sum == G) break;
        __builtin_amdgcn_s_sleep(1);
        if ((++sp & 255u) == 0u) { if (xb_ld(&bar[XB_TMO])) break; if (sp > XB_SPIN_CAP) { atomicAdd(&bar[XB_TMO], 1u); break; } }
    }
    nloc = mine > 0u ? mine : 1u; nx = cnt > 0u ? cnt : 1u;
}
__device__ __forceinline__ void xcd_barrier(const XcdBarrier& b) {
    asm volatile("s_waitcnt vmcnt(0)" ::: "memory");
    __syncthreads();
    if (threadIdx.x == 0) {
        unsigned* bar = b.bar;
        __builtin_amdgcn_s_waitcnt(0);
        unsigned nloc = b.st[0], nx = b.st[1];
        if (nloc == 0u) { xcd_barrier_complete(bar, b.x, nloc, nx); b.st[0] = nloc; b.st[1] = nx; }
        const unsigned old = xb_add(&bar[XB_XSUB(b.x)], 1u);
        const unsigned gen = old / nloc;
        if (old + 1u == (gen + 1u) * nloc) {
            __builtin_amdgcn_fence(__ATOMIC_RELEASE, "agent");
            asm volatile("s_waitcnt vmcnt(0)" ::: "memory");
            const unsigned og = xb_add(&bar[XB_TOP], 1u);
            const unsigned tg = og / nx;
            if (og + 1u == (tg + 1u) * nx) xb_add(&bar[XB_TOPGEN], 1u);
            else XB_SPIN(xb_ld(&bar[XB_TOPGEN]) == tg, bar);
            __builtin_amdgcn_fence(__ATOMIC_ACQUIRE, "agent");
            xb_add(&bar[XB_XGEN(b.x)], 1u);
            asm volatile("s_waitcnt vmcnt(0)" ::: "memory");
        } else {
            XB_SPIN(xb_ld(&bar[XB_XGEN(b.x)]) == gen, bar);
            __builtin_amdgcn_fence(__ATOMIC_ACQUIRE, "agent");
            asm volatile("s_waitcnt vmcnt(0)" ::: "memory");
        }
    }
    __syncthreads();
}

constexpr int NWAVES = 8;
constexpr int RING_BYTES = 131072, LDSCTL_OFF = RING_BYTES, MISC_OFF = LDSCTL_OFF + 320, UCACHE_OFF = RING_BYTES + 1024  , LDS_BYTES = 147456;
struct Frame {
    LAS unsigned char* lds; volatile LAS unsigned* MISC; unsigned* ctl;
    int tid, lane, wave, vcu, G;
    Ptrs P;
};

template <class SrcF> __device__ __forceinline__ void transpose_item(const SrcF& f, int K, bf16* WT, int p0, int k0, LAS float* scr, int lane) {
    float t[32];
#pragma unroll
    for (int i = 0; i < 32; ++i) t[i] = f(k0 + 2 * i + (lane >> 5), p0 + (lane & 31));
#pragma unroll
    for (int i = 0; i < 32; ++i) scr[(2 * i + (lane >> 5)) * 33 + (lane & 31)] = t[i];
    LDS_WAIT(); asm volatile("" ::: "memory");
    const int c = lane & 7;
#pragma unroll
    for (int j = 0; j < 4; ++j) { const int n = (lane >> 3) + 8 * j; const LAS float* s = scr + (8 * c) * 33 + n;
        u32x4 o; o.x = pk2(s[0 * 33], s[1 * 33]); o.y = pk2(s[2 * 33], s[3 * 33]); o.z = pk2(s[4 * 33], s[5 * 33]); o.w = pk2(s[6 * 33], s[7 * 33]);
        *(u32x4*)(WT + (size_t)(p0 + n) * K + k0 + 8 * c) = o; }
    LDS_WAIT(); asm volatile("" ::: "memory");
}
struct SrcWin { const float* w; __device__ float operator()(int k, int p) const { const int l = p1_logical(p); return l < 0 ? 0.f : w[(size_t)k * IN_COLS + l]; } };
struct SrcWup { const float *gq, *wuq, *gkv, *wukv;
    __device__ float operator()(int k, int p) const {
        if (p < 768) return k < 256 ? gq[k] * wuq[(size_t)k * 768 + qm_logical(p)] : 0.f;
        return k >= 256 ? gkv[k - 256] * wukv[(size_t)(k - 256) * 1024 + (p - 768)] : 0.f; } };
struct SrcPlain { const float* w; int N; int coff; __device__ float operator()(int k, int p) const { return w[(size_t)k * N + p + coff]; } };

__device__ __forceinline__ void ph0_prep(Frame& F) {
    LAS float* scr = (LAS float*)(F.lds + F.wave * 16384);
    const int gw = F.vcu * NWAVES + F.wave, NGW = F.G * NWAVES, lane = F.lane;
    const Ptrs& P = F.P; unsigned char* ws = P.ws;
    constexpr int I_IN = 16 * 64, I_UP = 6 * 56, I_OUT = 16 * 32, I_R = 16 * 8, I_SMALL = I_IN + I_UP + I_OUT + I_R;
    for (int it = gw; it < I_SMALL; it += NGW) {
        int r = it;
        if (r < I_IN) { transpose_item(SrcWin{P.in[8]}, 1024, (bf16*)(ws + WS_WIN), (r % 64) * 32, (r / 64) * 64, scr, lane); continue; } r -= I_IN;
        if (r < I_UP) { transpose_item(SrcWup{P.in[9], P.in[10], P.in[11], P.in[12]}, 384, (bf16*)(ws + WS_WUP), (r % 56) * 32, (r / 56) * 64, scr, lane); continue; } r -= I_UP;
        if (r < I_OUT) { transpose_item(SrcPlain{P.in[18], 1024, 0}, 1024, (bf16*)(ws + WS_WOUT), (r % 32) * 32, (r / 32) * 64, scr, lane); continue; } r -= I_OUT;
        transpose_item(SrcPlain{P.in[19], 256, 0}, 1024, (bf16*)(ws + WS_WR), (r % 8) * 32, (r / 8) * 64, scr, lane);
    }
    for (int it = gw; it < 96 * 16; it += NGW) {
        const int cg = it % 96, kp = it / 96;
#pragma unroll
        for (int r = 0; r < 5; ++r) { const float c = (r < 4 ? P.in[1] + r * DM : P.in[3])[kp * 64 + lane]; scr[r * 64 + lane] = c / (1.f + __expf(-c)); }
        LDS_WAIT(); asm volatile("" ::: "memory");
        float acc[5] = {0.f, 0.f, 0.f, 0.f, 0.f};
        const float* W = P.in[4] + (size_t)(kp * 64) * 6144 + cg * 64 + lane;
#pragma unroll 8
        for (int kk = 0; kk < 64; ++kk) { const float w = W[(size_t)kk * 6144];
#pragma unroll
            for (int r = 0; r < 5; ++r) acc[r] += scr[r * 64 + kk] * w; }
        LDS_WAIT(); asm volatile("" ::: "memory");
#pragma unroll
        for (int r = 0; r < 5; ++r) ((float*)(ws + WS_MODP))[(size_t)(kp * 5 + r) * 6144 + cg * 64 + lane] = acc[r];
    }
    { const int idx = (F.vcu * 512 + F.tid);
      if (idx < 1024) { const int v = idx / 16, f = idx % 16; const float th = (float)v * exp2f(-(float)f / 16.f * 13.287712379549449f);
          ((float2*)(ws + WS_TAB))[idx] = make_float2(__builtin_amdgcn_cosf(th * 0.15915494309189535f), __builtin_amdgcn_sinf(th * 0.15915494309189535f)); }
      else if (idx < 1536) { const int i2 = idx - 1024, v = i2 / 8, f = i2 % 8; const float th = (float)v * exp2f(-(float)f / 8.f * 13.287712379549449f);
          ((float2*)(ws + WS_TAB))[idx] = make_float2(__builtin_amdgcn_cosf(th * 0.15915494309189535f), __builtin_amdgcn_sinf(th * 0.15915494309189535f)); } }
}
__device__ __forceinline__ void ph0_experts(Frame& F) {
    LAS float* scr = (LAS float*)(F.lds + F.wave * 16384);
    const int gw = F.vcu * NWAVES + F.wave, NGW = F.G * NWAVES, lane = F.lane;
    const Ptrs& P = F.P; unsigned char* ws = P.ws;
    {
        constexpr int IPE = 256 + 128;
        for (int it = gw; it < 257 * IPE; it += NGW) {
            const int e = it / IPE; int r = it % IPE;
            if (r < 256) { const int p0 = (r % 16) * 32, half = p0 >> 8, up = (p0 >> 7) & 1;
                const float* w = e < 256 ? (up ? P.in[22] : P.in[21]) + (size_t)e * DM * EFF : (up ? P.in[25] : P.in[24]);
                const SrcPlain s{w, EFF, half * 128 - (p0 & ~127)};
                transpose_item(s, 1024, (bf16*)(ws + WS_W13) + (size_t)e * 512 * 1024, p0, (r / 16) * 64, scr, lane); }
            else { r -= 256; const SrcPlain s{e < 256 ? P.in[23] + (size_t)e * EFF * DM : P.in[26], 1024, 0};
                transpose_item(s, 256, (bf16*)(ws + WS_W2) + (size_t)e * 1024 * 256, (r % 32) * 32, (r / 32) * 64, scr, lane); }
        }
    }
    __syncthreads();
}
__device__ __forceinline__ void ph1_xn(Frame& F) {
    const Ptrs& P = F.P; unsigned char* ws = P.ws;
    const float* MODP = (const float*)(ws + WS_MODP);
    for (int idx = F.vcu * 512 + F.tid; idx < 5 * 6144; idx += F.G * 512) { const int r = idx / 6144, j = idx % 6144; float a = P.in[5][j];
#pragma unroll
        for (int kp = 0; kp < 16; ++kp) a += MODP[(size_t)(kp * 5 + r) * 6144 + j];
        ((float*)(ws + WS_MOD))[idx] = a; }
    const int RPB = (MALL + F.G - 1) / F.G, r_lo = F.vcu * RPB, r_hi = min(MALL, r_lo + RPB);
    if (r_lo >= r_hi) return;
    const int b0 = r_lo / NTOK, b1 = (r_hi - 1) / NTOK;
    LAS float* sm = (LAS float*)F.lds;
    for (int i = F.tid; i < 3 * 2048; i += 512) { const int sl = i / 2048, j = i % 2048; const int r = sl == 0 ? b0 : sl == 1 ? b1 : 4; float a = P.in[5][j];
#pragma unroll
        for (int kp = 0; kp < 16; ++kp) a += MODP[(size_t)(kp * 5 + r) * 6144 + j];
        sm[i] = a; }
    __syncthreads();
    auto rowsrc = [&](int r) -> const f32x4* { const int b = r / NTOK, n = r % NTOK;
        return (const f32x4*)(n < NCTX ? P.in[2] + ((size_t)b * NCTX + n) * DM : P.in[0] + ((size_t)b * SEQ + (n - NCTX)) * DM) + F.lane; };
    f32x4 v[4], nv[4];
    { const int r = r_lo + F.wave; if (r < r_hi) { const f32x4* xr = rowsrc(r);
#pragma unroll
        for (int j = 0; j < 4; ++j) v[j] = xr[64 * j]; } }
    for (int r = r_lo + F.wave; r < r_hi; r += NWAVES) {
        const int b = r / NTOK, n = r % NTOK;
        { const int rn = r + NWAVES < r_hi ? r + NWAVES : r; const f32x4* xr = rowsrc(rn);
#pragma unroll
          for (int j = 0; j < 4; ++j) nv[j] = xr[64 * j]; }
        const LAS float* md = sm + (n < NCTX ? 2 : (b == b0 ? 0 : 1)) * 2048;
        float s = 0.f;
#pragma unroll
        for (int j = 0; j < 4; ++j) s += (v[j][0] * v[j][0] + v[j][1] * v[j][1]) + (v[j][2] * v[j][2] + v[j][3] * v[j][3]);
        const float rs = rsqrtf(wave_sum(s) * (1.f / DM) + EPS);
        u32x2* o8 = (u32x2*)((bf16*)(ws + WS_XN) + (size_t)r * DM) + F.lane;
#pragma unroll
        for (int j = 0; j < 4; ++j) { const int c = 4 * F.lane + 256 * j; const f32x4 g = *(const f32x4*)(P.in[6] + c);
            const f32x4 sh = *(const LAS f32x4*)(md + c), sc = *(const LAS f32x4*)(md + 1024 + c);
            const f32x4 y = (v[j] * rs * g) * (sc + 1.f) + sh;
            u32x2 w; w.x = cvt_pk_bf16(y[0], y[1]); w.y = cvt_pk_bf16(y[2], y[3]); o8[64 * j] = w; }
#pragma unroll
        for (int j = 0; j < 4; ++j) v[j] = nv[j];
    }
    __syncthreads();
}
__device__ __forceinline__ void ph6_h2(Frame& F) {
    const Ptrs& P = F.P; unsigned char* ws = P.ws;
    const int gw = F.vcu * NWAVES + F.wave, NGW = F.G * NWAVES;
    f32x4 v[4], nv[4];
    if (gw < MLAT) { const f32x4* xr = (const f32x4*)((const float*)(ws + WS_X1) + (size_t)gw * DM) + F.lane;
#pragma unroll
        for (int j = 0; j < 4; ++j) v[j] = xr[64 * j]; }
    for (int t = gw; t < MLAT; t += NGW) {
        const int b = t / SEQ; const float* md = (const float*)(ws + WS_MOD) + b * 6144;
        { const int tn = t + NGW < MLAT ? t + NGW : t; const f32x4* xr = (const f32x4*)((const float*)(ws + WS_X1) + (size_t)tn * DM) + F.lane;
#pragma unroll
          for (int j = 0; j < 4; ++j) nv[j] = xr[64 * j]; }
        float s = 0.f;
#pragma unroll
        for (int j = 0; j < 4; ++j) s += (v[j][0] * v[j][0] + v[j][1] * v[j][1]) + (v[j][2] * v[j][2] + v[j][3] * v[j][3]);
        const float rs = rsqrtf(wave_sum(s) * (1.f / DM) + EPS);
        u32x2* o8 = (u32x2*)((bf16*)(ws + WS_H2) + (size_t)t * DM) + F.lane;
#pragma unroll
        for (int j = 0; j < 4; ++j) { const int c = 4 * F.lane + 256 * j; const f32x4 g = *(const f32x4*)(P.in[7] + c);
            const f32x4 sh = *(const f32x4*)(md + 3072 + c), sc = *(const f32x4*)(md + 4096 + c);
            const f32x4 y = (v[j] * rs * g) * (sc + 1.f) + sh;
            u32x2 w; w.x = cvt_pk_bf16(y[0], y[1]); w.y = cvt_pk_bf16(y[2], y[3]); o8[64 * j] = w; }
#pragma unroll
        for (int j = 0; j < 4; ++j) v[j] = nv[j];
    }
}
__device__ __forceinline__ void ph7_route(Frame& F) {
    const Ptrs& P = F.P; unsigned char* ws = P.ws; const int lane = F.lane;
    const int gw = F.vcu * NWAVES + F.wave, NGW = F.G * NWAVES;
    const f32x4 bi = ((const f32x4*)P.in[20])[lane];
    for (int t = gw; t < MLAT; t += NGW) {
        f32x4 lg = ((const f32x4*)(ws + WS_LOGP))[(size_t)t * 64 + lane];
#pragma unroll
        for (int kp = 1; kp < 4; ++kp) lg += ((const f32x4*)(ws + WS_LOGP))[((size_t)kp * MLAT + t) * 64 + lane];
        float s[4], v[4];
#pragma unroll
        for (int i = 0; i < 4; ++i) { s[i] = 1.f / (1.f + __expf(-lg[i])); v[i] = s[i] + bi[i]; }
        float m1 = fmaxf(v[0], v[1]), m2 = fminf(v[0], v[1]);
#pragma unroll
        for (int i = 2; i < 4; ++i) { const float x = v[i]; m2 = fmaxf(m2, fminf(m1, x)); m1 = fmaxf(m1, x); }
#pragma unroll
        for (int o = 1; o < 8; o <<= 1) { const float b1 = __shfl_xor(m1, o), b2 = __shfl_xor(m2, o); const float n1 = fmaxf(m1, b1), n2 = fmaxf(fminf(m1, b1), fmaxf(m2, b2)); m1 = n1; m2 = n2; }
        const float gs = m1 + m2; const int g = lane >> 3; int rank = 0;
#pragma unroll
        for (int j = 0; j < 8; ++j) { const float o = __shfl(gs, j * 8); rank += (o > gs || (o == gs && j < g)) ? 1 : 0; }
        if (rank >= 4) { v[0] = v[1] = v[2] = v[3] = -INFINITY; }
        int my_e = 0; float my_s = 0.f, ssum = 0.f;
#pragma unroll
        for (int k = 0; k < 8; ++k) {
            float bv = v[0]; int bi_ = 0;
#pragma unroll
            for (int i = 1; i < 4; ++i) if (v[i] > bv) { bv = v[i]; bi_ = i; }
            int be = lane * 4 + bi_;
#pragma unroll
            for (int o = 1; o < 64; o <<= 1) { const float ov = __shfl_xor(bv, o); const int oe = __shfl_xor(be, o); if (ov > bv || (ov == bv && oe < be)) { bv = ov; be = oe; } }
            const int wl = be >> 2, wi = be & 3;
            float sv = wi == 0 ? s[0] : wi == 1 ? s[1] : wi == 2 ? s[2] : s[3];
            sv = __shfl(sv, wl);
            if (lane == wl) { if (wi == 0) v[0] = -INFINITY; else if (wi == 1) v[1] = -INFINITY; else if (wi == 2) v[2] = -INFINITY; else v[3] = -INFINITY; }
            ssum += sv; if (lane == k) { my_e = be; my_s = sv; }
        }
        if (lane < 8) {
            int* cnt = (int*)(ws + WS_CTL) + CW_COUNT;
            const int rk = atomicAdd(&cnt[my_e], 1);
            ((int*)(ws + WS_EIDX))[(size_t)t * 8 + lane] = my_e;
            ((float*)(ws + WS_EW))[(size_t)t * 8 + lane] = my_s / ssum * 2.5f;
            ((int*)(ws + WS_ERANK))[(size_t)t * 8 + lane] = rk;
        }
    }
}
__device__ __forceinline__ void ph8_slots(Frame& F) {
    const Ptrs& P = F.P; unsigned char* ws = P.ws;
    LAS int* off = (LAS int*)F.lds;
    LAS int* cst = off + 260;
    unsigned* cnt = (unsigned*)(ws + WS_CTL) + CW_COUNT;
    if (F.wave == 0) { const int lane = F.lane; int n[4], c[4], sn = 0, sc = 0;
#pragma unroll
        for (int i = 0; i < 4; ++i) { n[i] = (int)cnt[4 * lane + i]; c[i] = (n[i] + 255) >> 8; sn += n[i]; sc += c[i]; }
        int in = sn, ic = sc;
#pragma unroll
        for (int o = 1; o < 64; o <<= 1) { const int tn = __shfl_up(in, o), tc = __shfl_up(ic, o); if (lane >= o) { in += tn; ic += tc; } }
        int an = in - sn, ac = ic - sc;
#pragma unroll
        for (int i = 0; i < 4; ++i) { off[4 * lane + i] = an; cst[4 * lane + i] = ac; an += n[i]; ac += c[i]; }
        if (lane == 63) { off[256] = an; cst[256] = ac; off[257] = NSLOT; cst[257] = ac + MLAT / 256; } }
    __syncthreads();
    for (int idx = F.vcu * 512 + F.tid; idx < MLAT * 8; idx += F.G * 512) {
        const int e = ((const int*)(ws + WS_EIDX))[idx], rk = ((const int*)(ws + WS_ERANK))[idx];
        const int slot = off[e] + rk;
        ((int*)(ws + WS_SLOTOF))[idx] = slot; ((int*)(ws + WS_SLOTTOK))[slot] = idx >> 3; ((float*)(ws + WS_SLOTW))[slot] = ((const float*)(ws + WS_EW))[idx];
        if (idx < MLAT) { ((int*)(ws + WS_SLOTTOK))[MLAT * 8 + idx] = idx; ((float*)(ws + WS_SLOTW))[MLAT * 8 + idx] = 1.f; }
    }
    if (F.vcu == 0) {
        int* go = (int*)(ws + WS_OFF); int* ut = (int*)(ws + WS_UT);
        for (int e = F.tid; e < 258; e += 512) go[e] = off[e];
        for (int e = F.tid; e < 257; e += 512) { const int n = off[e + 1] - off[e], c0 = cst[e], nc = cst[e + 1] - c0;
            for (int j = 0; j < nc; ++j) { ut[(c0 + j) * 4 + 0] = e; ut[(c0 + j) * 4 + 1] = off[e] + j * 256; ut[(c0 + j) * 4 + 2] = min(256, n - j * 256); ut[(c0 + j) * 4 + 3] = 0; } }
        if (F.tid == 0) ((int*)(ws + WS_CTL))[CW_NUNIT] = cst[257];
    }
    __syncthreads();
}
__device__ __forceinline__ float bflo(unsigned w) { return __builtin_bit_cast(float, w << 16); }
__device__ __forceinline__ float bfhi(unsigned w) { return __builtin_bit_cast(float, w & 0xffff0000u); }
__device__ __forceinline__ void ph11_combine(Frame& F) {
    const Ptrs& P = F.P; unsigned char* ws = P.ws; const int lane = F.lane;
    const int gw = F.vcu * NWAVES + F.wave, NGW = F.G * NWAVES;
    const bf16* Y = (const bf16*)(ws + WS_Y);
    u32x4 yw[9][2], nyw[9][2]; f32x4 xw[4], nxw[4]; int nsl[8];
    auto ldslots = [&](int t) {
#pragma unroll
        for (int k = 0; k < 8; ++k) nsl[k] = ((const int*)(ws + WS_SLOTOF))[(size_t)t * 8 + k]; };
    auto ldrows = [&](int t) {
#pragma unroll
        for (int k = 0; k < 9; ++k) { const int sl = k < 8 ? nsl[k] : MLAT * 8 + t;
#pragma unroll
            for (int h = 0; h < 2; ++h) nyw[k][h] = *(const u32x4*)(Y + (size_t)sl * DM + h * 512 + lane * 8); }
#pragma unroll
        for (int q = 0; q < 4; ++q) nxw[q] = *(const f32x4*)((const float*)(ws + WS_X1) + (size_t)t * DM + (q >> 1) * 512 + lane * 8 + (q & 1) * 4); };
    if (gw < MLAT) { ldslots(gw); ldrows(gw); if (gw + NGW < MLAT) ldslots(gw + NGW); }
    for (int t = gw; t < MLAT; t += NGW) {
        const int b = t / SEQ; const float* gt2 = (const float*)(ws + WS_MOD) + b * 6144 + 5120;
#pragma unroll
        for (int k = 0; k < 9; ++k) { yw[k][0] = nyw[k][0]; yw[k][1] = nyw[k][1]; }
#pragma unroll
        for (int q = 0; q < 4; ++q) xw[q] = nxw[q];
        if (t + NGW < MLAT) { ldrows(t + NGW); if (t + 2 * NGW < MLAT) ldslots(t + 2 * NGW); }
        float a[2][8];
#pragma unroll
        for (int h = 0; h < 2; ++h)
#pragma unroll
            for (int i = 0; i < 8; ++i) a[h][i] = 0.f;
#pragma unroll
        for (int k = 0; k < 9; ++k)
#pragma unroll
            for (int h = 0; h < 2; ++h) { const u32x4 w = yw[k][h];
                a[h][0] += bflo(w.x); a[h][1] += bfhi(w.x); a[h][2] += bflo(w.y); a[h][3] += bfhi(w.y); a[h][4] += bflo(w.z); a[h][5] += bfhi(w.z); a[h][6] += bflo(w.w); a[h][7] += bfhi(w.w); }
        float ss = 0.f;
#pragma unroll
        for (int h = 0; h < 2; ++h)
#pragma unroll
            for (int q = 0; q < 2; ++q) { const int c = h * 512 + lane * 8 + q * 4; const f32x4 xv = xw[h * 2 + q], gv = *(const f32x4*)(gt2 + c);
#pragma unroll
                for (int e = 0; e < 4; ++e) { const float v = xv[e] + gv[e] * a[h][q * 4 + e]; a[h][q * 4 + e] = v; ss += v * v; } }
        const float rs = rsqrtf(wave_sum(ss) * (1.f / DM) + EPS);
#pragma unroll
        for (int h = 0; h < 2; ++h)
#pragma unroll
            for (int q = 0; q < 2; ++q) { const int c = h * 512 + lane * 8 + q * 4; const f32x4 gf = *(const f32x4*)(P.in[27] + c);
                f32x4 o;
#pragma unroll
                for (int e = 0; e < 4; ++e) o[e] = a[h][q * 4 + e] * rs * gf[e];
                *(f32x4*)(P.out + (size_t)t * DM + c) = o; }
    }
}
__device__ __forceinline__ void ph4b_diff_finish(Frame& F) {
    const Ptrs& P = F.P; unsigned char* ws = P.ws; const int lane = F.lane;
    const int gw = F.vcu * NWAVES + F.wave, NGW = F.G * NWAVES;
    float d1 = P.in[13][lane] * P.in[14][lane], d2 = P.in[15][lane] * P.in[16][lane];
    d1 = wave_sum(d1); d2 = wave_sum(d2);
    const float lam = __expf(d1) - __expf(d2) + LAM_INIT;
    const float g0 = P.in[17][lane], g1 = P.in[17][64 + lane];
    for (int t = gw; t < MLAT; t += NGW) {
        const float* os = (const float*)(ws + WS_OS) + (size_t)t * 8 * 128;
        float x[4][4];
#pragma unroll
        for (int h = 0; h < 4; ++h) { x[h][0] = os[(2 * h) * 128 + lane]; x[h][1] = os[(2 * h) * 128 + 64 + lane]; x[h][2] = os[(2 * h + 1) * 128 + lane]; x[h][3] = os[(2 * h + 1) * 128 + 64 + lane]; }
#pragma unroll
        for (int h = 0; h < 4; ++h) {
            const float v0 = x[h][0] - lam * x[h][2], v1 = x[h][1] - lam * x[h][3];
            const float rs = rsqrtf(wave_sum(v0 * v0 + v1 * v1) * (1.f / 128.f) + EPS) * (1.f - LAM_INIT);
            bf16* mo = (bf16*)(ws + WS_MIX) + (size_t)t * DM + 512 + h * 128;
            mo[lane] = (bf16)f2bf(v0 * rs * g0); mo[64 + lane] = (bf16)f2bf(v1 * rs * g1); }
    }
}

enum { P_PREP = 0, P_XN, P_INPROJ, P_UP, P_ATTN, P_DIFFFIN, P_OUT, P_H2, P_ROUTER, P_ROUTE, P_SLOTS, P_EXP1, P_EXP2, P_COMB, P_END };
struct Args { Ptrs P; int ph_lo, ph_hi, li, pad; };
__global__ void __launch_bounds__(NWAVES * 64, 2) mk_fwd(Args args) {
    extern __shared__ __attribute__((aligned(16))) unsigned char lds[];
    Frame F;
    F.lds = (LAS unsigned char*)lds; F.MISC = (volatile LAS unsigned*)(F.lds + MISC_OFF);
    F.tid = threadIdx.x; F.lane = F.tid & 63; F.wave = __builtin_amdgcn_readfirstlane(F.tid >> 6);
    F.G = gridDim.x; { const int bx = blockIdx.x; F.vcu = (F.G % 8 == 0) ? (bx % 8) * (F.G / 8) + bx / 8 : bx; }
    F.P = args.P; unsigned char* ws = args.P.ws; F.ctl = (unsigned*)(ws + WS_CTL);
    for (int u = F.tid; u < (LDS_BYTES - LDSCTL_OFF) / 4; u += NWAVES * 64) ((LAS unsigned*)(F.lds + LDSCTL_OFF))[u] = 0u;
    __syncthreads();
    XcdBarrier bar = xcd_barrier_post(F.ctl + CW_BAR + args.li * XCD_BAR_WORDS, F.MISC + 8);
    const int lo = args.ph_lo, hi = args.ph_hi;
#ifndef PHMASK
#define PHMASK 0xFFFF
#endif
#define IN(k) ((((PHMASK) >> (k)) & 1) && lo <= (k) && (k) < hi)
#define SEAM(k) do { if (IN(k) && IN((k) + 1)) xcd_barrier(bar); } while (0)
    if (IN(P_PREP)) { ph0_prep(F); } SEAM(P_PREP);
    if (IN(P_XN)) { ph1_xn(F); } SEAM(P_XN);
    if (IN(P_INPROJ)) {
        pg8::Gemm g{(const bf16*)(ws + WS_XN), (const bf16*)(ws + WS_WIN), 1024, 1024, 1024}; pg8::StaticOrder S; S.init(MALL, NP1, F.G, (int)blockIdx.x);
        EpiInProj E{(bf16*)(ws + WS_P1), (float*)(ws + WS_SSQ), (const float2*)(ws + WS_TAB), (const float2*)(ws + WS_TAB) + 1024};
        pg8::gemm_phase(F.lds, g, S, E);
    } SEAM(P_INPROJ);
    if (IN(P_UP)) {
        pg8::Gemm g{(const bf16*)(ws + WS_P1), (const bf16*)(ws + WS_WUP), 2048, 384, 256}; UpOrder S{F.G, F.vcu};
        EpiUp E{(bf16*)(ws + WS_QM), (bf16*)(ws + WS_KVM), (const float*)(ws + WS_SSQ), (const float2*)(ws + WS_TAB) + 1024};
        pg8::gemm_phase(F.lds, g, S, E);
    } SEAM(P_UP);
    if (IN(P_ATTN)) {
        const bf16* P1 = (const bf16*)(ws + WS_P1); const bf16* QM = (const bf16*)(ws + WS_QM); const bf16* KVM = (const bf16*)(ws + WS_KVM);
        const int cslot = F.vcu % 5; int ui = 0;
        bool conv_done = false;
        for (int U = F.vcu; U < 1024; U += F.G, ++ui) {
            if (ui == cslot) { ph0_experts(F); conv_done = true; }
            const int Up = U & 511, bh = Up >> 4, qb = Up & 15, b = bh >> 3, hh = bh & 7;
            if (U < 512) {
                const bf16* K0 = KVM + (size_t)b * NTOK * 1024 + hh * 128;
                attn::unit<0>(QM + (size_t)(b * NTOK + NCTX + qb * 256) * 768 + hh * 96, K0, P1 + (size_t)b * NTOK * NP1 + 384, K0 + 64,
                              (bf16*)(ws + WS_MIX) + (size_t)(b * SEQ + qb * 256) * DM + hh * 64, DM, (char*)lds);
            } else {
                const bf16* Pb = P1 + (size_t)b * NTOK * NP1;
                attn::unit<1>(P1 + (size_t)(b * NTOK + NCTX + qb * 256) * NP1 + 512 + hh * 64, Pb + 1024 + hh * 64, nullptr, Pb + 1536 + (hh >> 1) * 128,
                              (float*)(ws + WS_OS) + ((size_t)(b * SEQ + qb * 256) * 8 + hh) * 128, 1024, (char*)lds);
            }
        }
        if (!conv_done) ph0_experts(F);
    } SEAM(P_ATTN);
    if (IN(P_DIFFFIN)) { ph4b_diff_finish(F); } SEAM(P_DIFFFIN);
    if (IN(P_OUT)) {
        pg8::Gemm g{(const bf16*)(ws + WS_MIX), (const bf16*)(ws + WS_WOUT), 1024, 1024, 1024}; pg8::StaticOrder S; S.init(MLAT, DM, F.G, (int)blockIdx.x);
        EpiOut E{F.P.in[0], (const float*)(ws + WS_MOD), (float*)(ws + WS_X1)};
        pg8::gemm_phase(F.lds, g, S, E);
    } SEAM(P_OUT);
    if (IN(P_H2)) { ph6_h2(F); } SEAM(P_H2);
    if (IN(P_ROUTER)) {
        pg8::Gemm g{(const bf16*)(ws + WS_H2), (const bf16*)(ws + WS_WR), 1024, 1024, 256}; RouterOrder S{F.G, F.vcu};
        EpiLogP E{(float*)(ws + WS_LOGP)};
        pg8::gemm_phase(F.lds, g, S, E);
    } SEAM(P_ROUTER);
    if (IN(P_ROUTE)) { ph7_route(F); } SEAM(P_ROUTE);
    if (IN(P_SLOTS)) { ph8_slots(F); } SEAM(P_SLOTS);
    if (IN(P_EXP1)) {
        const int nu = (int)xb_ld(F.ctl + CW_NUNIT); LAS int* uc = (LAS int*)(F.lds + UCACHE_OFF);
        const int nmine = exp_units_to_lds<2>(uc, (const int*)(ws + WS_UT), nu * 2, F.G, F.vcu);
        pg8::Gemm g{(const bf16*)(ws + WS_H2), (const bf16*)(ws + WS_W13), 1024, 1024, 1024};
        ExpSched<2, true> S{uc, nmine, (const int*)(ws + WS_SLOTTOK)};
        EpiAct E{(bf16*)(ws + WS_ACT), (const float*)(ws + WS_SLOTW)};
        pg8::gemm_phase(F.lds, g, S, E);
    } SEAM(P_EXP1);
    if (IN(P_EXP2)) {
        const int nu = (int)xb_ld(F.ctl + CW_NUNIT); LAS int* uc = (LAS int*)(F.lds + UCACHE_OFF);
        const int nmine = exp_units_to_lds<4>(uc, (const int*)(ws + WS_UT), nu * 4, F.G, F.vcu);
        pg8::Gemm g{(const bf16*)(ws + WS_ACT), (const bf16*)(ws + WS_W2), 256, 256, 256};
        ExpSched<4, false> S{uc, nmine, nullptr};
        EpiY E{(bf16*)(ws + WS_Y)};
        pg8::gemm_phase(F.lds, g, S, E);
    } SEAM(P_EXP2);
    if (IN(P_COMB)) { ph11_combine(F); }
#undef IN
#undef SEAM
}

static int g_grid = 0;
static int mk_setup() {
    if (g_grid) return g_grid;
    int dev = 0, cus = 0;
    if (hipGetDevice(&dev) != hipSuccess || hipDeviceGetAttribute(&cus, hipDeviceAttributeMultiprocessorCount, dev) != hipSuccess) { fprintf(stderr, "kernel_launch: device query failed\n"); g_grid = -1; return -1; }
    if (hipFuncSetAttribute((const void*)mk_fwd, hipFuncAttributeMaxDynamicSharedMemorySize, LDS_BYTES) != hipSuccess) { fprintf(stderr, "kernel_launch: hipFuncSetAttribute failed\n"); g_grid = -1; return -1; }
    int per_cu = 0;
    if (hipOccupancyMaxActiveBlocksPerMultiprocessor(&per_cu, (const void*)mk_fwd, NWAVES * 64, LDS_BYTES) != hipSuccess || per_cu < 1) { fprintf(stderr, "kernel_launch: occupancy query says %d blocks/CU\n", per_cu); }
    (void)hipGetLastError();
    g_grid = cus;
    return g_grid;
}
static void mk_run(const Ptrs& P, int lo, int hi, int li, hipStream_t stream) {
    Args a{}; a.P = P; a.ph_lo = lo; a.ph_hi = hi; a.li = li; a.pad = 0;
    hipLaunchKernelGGL(mk_fwd, dim3(g_grid), dim3(NWAVES * 64), LDS_BYTES, stream, a);
}
extern "C" void kernel_launch(void* const* d_in, const int* in_sizes, int n_in, void* d_out, int out_size, void* d_ws, size_t ws_size, hipStream_t stream) {
    if (n_in != 28 || out_size != MLAT * DM || ws_size < WS_END) { fprintf(stderr, "kernel_launch: unexpected shapes n_in %d out %d ws %zu\n", n_in, out_size, ws_size); return; }
    if (mk_setup() <= 0) return;
    Ptrs P{}; for (int i = 0; i < 28; ++i) P.in[i] = (const float*)d_in[i]; P.out = (float*)d_out; P.ws = (unsigned char*)d_ws;
    (void)hipMemsetAsync((char*)d_ws + WS_CTL, 0, 1 * MiB, stream);
    int li = 0;
#define FAST(lo, hi) mk_run(P, lo, hi, li++, stream)
    FAST(P_PREP, P_COMB + 1);
#undef FAST
}
```

```cpp
#include <hip/hip_runtime.h>
#include <cstdio>
#include <cstdint>

constexpr int NB = 4, SEQ = 4096, NCTX = 256, NTOK = SEQ + NCTX, DM = 1024;
constexpr int MALL = NB * NTOK;
constexpr int MLAT = NB * SEQ;
constexpr int IN_COLS = 1952, NP1 = 2048;
constexpr int NEXP = 256, TOPK = 8, EFF = 256;
constexpr int NSLOT = MLAT * TOPK + MLAT;
constexpr float EPS = 1e-6f;
constexpr float LAM_INIT = 0.2f;

typedef unsigned short bf16;
__device__ __forceinline__ unsigned f2bf(float f) { unsigned u = __builtin_bit_cast(unsigned, f); return (u + 0x7fffu + ((u >> 16) & 1u)) >> 16; }
__device__ __forceinline__ float bf2f(bf16 h) { return __builtin_bit_cast(float, (unsigned)h << 16); }

constexpr size_t MiB = 1u << 20;
constexpr size_t WS_CTL = 0;
constexpr size_t WS_MOD = 3 * MiB;
constexpr size_t WS_TAB = 3 * MiB + 512 * 1024;
constexpr size_t WS_X1 = 402 * MiB;
constexpr size_t WS_SSQ = 466 * MiB;
constexpr size_t WS_EIDX = 467 * MiB;
constexpr size_t WS_EW = WS_EIDX + 512 * 1024;
constexpr size_t WS_ERANK = 468 * MiB;
constexpr size_t WS_SLOTOF = WS_ERANK + 512 * 1024;
constexpr size_t WS_SLOTTOK = 469 * MiB;
constexpr size_t WS_SLOTW = 470 * MiB;
constexpr size_t WS_OFF = 471 * MiB;
constexpr size_t WS_XN = 472 * MiB;
constexpr size_t WS_P1 = 506 * MiB;
constexpr size_t WS_QM = 574 * MiB;
constexpr size_t WS_KVM = 600 * MiB;
constexpr size_t WS_MIX = 634 * MiB;
constexpr size_t WS_OS = 666 * MiB;
constexpr size_t WS_TMP = 730 * MiB;
constexpr size_t WS_H2 = 472 * MiB;
constexpr size_t WS_H2F = 504 * MiB;
constexpr size_t WS_LOG = 568 * MiB;
constexpr size_t WS_ACT = 584 * MiB;
constexpr size_t WS_Y = 656 * MiB;
constexpr size_t WS_END = 944 * MiB;
constexpr int CW_COUNT = 1024;

__host__ __device__ __forceinline__ int perm32_log(int p) { return 16 * ((p >> 2) & 1) + 4 * (p >> 3) + (p & 3); }
__host__ __device__ __forceinline__ int perm64_log(int p) { return 32 * ((p >> 2) & 1) + 16 * (p >> 5) + 4 * ((p >> 3) & 3) + (p & 3); }
__host__ __device__ __forceinline__ int p1_logical(int p) {
    if (p < 384) return p;
    if (p < 416) return 384 + perm32_log(p - 384);
    if (p < 512) return -1;
    if (p < 1024) { int q = p - 512; return 416 + (q & ~63) + perm64_log(q & 63); }
    if (p < 1536) { int q = p - 1024; return 928 + (q & ~63) + perm64_log(q & 63); }
    return 1440 + (p - 1536);
}
__host__ __device__ __forceinline__ int qm_logical(int p) { int h = p / 96, r = p % 96; return h * 96 + (r < 64 ? r : 64 + perm32_log(r - 64)); }

struct Ptrs {
    const float* in[28]; float* out; unsigned char* ws;
};

__global__ void k_mod(Ptrs P) {
    int idx = blockIdx.x * 256 + threadIdx.x;
    if (idx < 5 * 6144) {
        int r = idx / 6144, j = idx % 6144;
        const float* cv = r < 4 ? P.in[1] + r * DM : P.in[3];
        const float* W = P.in[4];
        float acc = 0.f;
        for (int k = 0; k < DM; ++k) { float c = cv[k]; float s = c / (1.f + __expf(-c)); acc += s * W[(size_t)k * 6144 + j]; }
        ((float*)(P.ws + WS_MOD))[idx] = acc + P.in[5][j];
    }
    if (idx < 64 * 16) {
        int v = idx / 16, f = idx % 16;
        float inv = exp2f(-(float)f / 16.f * 13.287712379549449f);
        float th = (float)v * inv;
        float2 cs; cs.x = cosf(th); cs.y = sinf(th);
        ((float2*)(P.ws + WS_TAB))[idx] = cs;
    }
    if (idx < 64 * 8) {
        int v = idx / 8, f = idx % 8;
        float inv = exp2f(-(float)f / 8.f * 13.287712379549449f);
        float th = (float)v * inv;
        float2 cs; cs.x = cosf(th); cs.y = sinf(th);
        ((float2*)(P.ws + WS_TAB) + 1024)[idx] = cs;
    }
}

__global__ void k_xn(Ptrs P) {
    int r = blockIdx.x, b = r / NTOK, n = r % NTOK;
    const float* src = n < NCTX ? P.in[2] + ((size_t)b * NCTX + n) * DM : P.in[0] + ((size_t)b * SEQ + (n - NCTX)) * DM;
    const float* mod = (const float*)(P.ws + WS_MOD) + (n < NCTX ? 4 : b) * 6144;
    __shared__ float red[256];
    float v[4]; float ss = 0.f;
    for (int i = 0; i < 4; ++i) { v[i] = src[threadIdx.x + 256 * i]; ss += v[i] * v[i]; }
    red[threadIdx.x] = ss; __syncthreads();
    for (int o = 128; o > 0; o >>= 1) { if (threadIdx.x < o) red[threadIdx.x] += red[threadIdx.x + o]; __syncthreads(); }
    float rs = rsqrtf(red[0] / DM + EPS);
    bf16* dst = (bf16*)(P.ws + WS_XN) + (size_t)r * DM;
    for (int i = 0; i < 4; ++i) { int j = threadIdx.x + 256 * i; float y = v[i] * rs * P.in[6][j]; y = y * (1.f + mod[1024 + j]) + mod[j]; dst[j] = (bf16)f2bf(y); }
}

template <class F> __global__ __launch_bounds__(256) void k_gemm(F f, int N, int K) {
    __shared__ float As[16][65], Bs[16][65];
    const int z = blockIdx.z, bm = blockIdx.y * 64, bn = blockIdx.x * 64, tid = threadIdx.x, tx = tid & 15, ty = tid >> 4;
    const int rows = f.rows(z); if (bm >= rows) return;
    float acc[4][4] = {};
    for (int k0 = 0; k0 < K; k0 += 16) {
        for (int i = tid; i < 1024; i += 256) { int m = i >> 4, k = i & 15; As[k][m] = (bm + m < rows) ? f.a(z, bm + m, k0 + k) : 0.f; }
        for (int i = tid; i < 1024; i += 256) { int k = i >> 6, n = i & 63; Bs[k][n] = (bn + n < N) ? f.b(z, k0 + k, bn + n) : 0.f; }
        __syncthreads();
#pragma unroll
        for (int k = 0; k < 16; ++k) {
            float a[4], b[4];
#pragma unroll
            for (int i = 0; i < 4; ++i) { a[i] = As[k][ty * 4 + i]; b[i] = Bs[k][tx * 4 + i]; }
#pragma unroll
            for (int i = 0; i < 4; ++i)
#pragma unroll
                for (int j = 0; j < 4; ++j) acc[i][j] += a[i] * b[j];
        }
        __syncthreads();
    }
    for (int i = 0; i < 4; ++i) for (int j = 0; j < 4; ++j) { int m = bm + ty * 4 + i, n = bn + tx * 4 + j; if (m < rows && n < N) f.c(z, m, n, acc[i][j]); }
}

struct FIn { Ptrs P;
    __device__ int rows(int) const { return MALL; }
    __device__ float a(int, int m, int k) const { return bf2f(((const bf16*)(P.ws + WS_XN))[(size_t)m * DM + k]); }
    __device__ float b(int, int k, int n) const { int l = p1_logical(n); return l < 0 ? 0.f : bf2f((bf16)f2bf(P.in[8][(size_t)k * IN_COLS + l])); }
    __device__ void c(int, int m, int n, float v) const { ((float*)(P.ws + WS_TMP))[(size_t)m * NP1 + n] = v; }
};
__global__ void k_p1_finish(Ptrs P) {
    int r = blockIdx.x, n = r % NTOK;
    const float* t = (const float*)(P.ws + WS_TMP) + (size_t)r * NP1;
    bf16* o = (bf16*)(P.ws + WS_P1) + (size_t)r * NP1;
    float* ssq = (float*)(P.ws + WS_SSQ) + (size_t)r * 8;
    const float2* TD = (const float2*)(P.ws + WS_TAB); const float2* TM = TD + 1024;
    const bool lat = n >= NCTX; const int s = n - NCTX, gr = s >> 6, gc = s & 63;
    __shared__ float red[256];
    int tid = threadIdx.x;
    float v = t[tid]; red[tid] = v * v; __syncthreads();
    for (int oo = 128; oo > 0; oo >>= 1) { if (tid < oo) red[tid] += red[tid + oo]; __syncthreads(); }
    if (tid == 0) { ssq[0] = red[0]; ssq[1] = ssq[2] = ssq[3] = 0.f; }
    __syncthreads();
    float w = tid < 128 ? t[256 + tid] : 0.f; red[tid] = w * w; __syncthreads();
    for (int oo = 128; oo > 0; oo >>= 1) { if (tid < oo) red[tid] += red[tid + oo]; __syncthreads(); }
    if (tid == 0) { ssq[4] = red[0]; ssq[5] = ssq[6] = ssq[7] = 0.f; }
    for (int p = tid; p < NP1; p += 256) {
        float val = t[p];
        if (p >= 384 && p < 416) {
            int ph = p - 384, nn = (ph >> 2) & 1, i = 4 * (ph >> 3) + (ph & 3);
            float x1 = t[nn ? p - 4 : p], x2 = t[nn ? p : p + 4];
            float2 cs = lat ? TM[(i < 8 ? gr : gc) * 8 + (i & 7)] : make_float2(1.f, 0.f);
            val = nn ? x1 * cs.y + x2 * cs.x : x1 * cs.x - x2 * cs.y;
        } else if (p >= 512 && p < 1536) {
            int ph = (p - 512) & 63, nn = (ph >> 2) & 1, i = 16 * (ph >> 5) + 4 * ((ph >> 3) & 3) + (ph & 3);
            float x1 = t[nn ? p - 4 : p], x2 = t[nn ? p : p + 4];
            float2 cs = lat ? TD[(i < 16 ? gr : gc) * 16 + (i & 15)] : make_float2(1.f, 0.f);
            val = nn ? x1 * cs.y + x2 * cs.x : x1 * cs.x - x2 * cs.y;
        }
        o[p] = (bf16)f2bf(val);
    }
}
struct FUp { Ptrs P;
    __device__ int rows(int) const { return MALL; }
    __device__ float a(int, int m, int k) const { return bf2f(((const bf16*)(P.ws + WS_P1))[(size_t)m * NP1 + k]); }
    __device__ float b(int, int k, int n) const {
        if (n < 768) return k < 256 ? bf2f((bf16)f2bf(P.in[9][k] * P.in[10][(size_t)k * 768 + qm_logical(n)])) : 0.f;
        return k >= 256 ? bf2f((bf16)f2bf(P.in[11][k - 256] * P.in[12][(size_t)(k - 256) * 1024 + (n - 768)])) : 0.f; }
    __device__ void c(int, int m, int n, float v) const { ((float*)(P.ws + WS_TMP))[(size_t)m * NP1 + n] = v; }
};
__global__ void k_up_finish(Ptrs P) {
    int r = blockIdx.x, n = r % NTOK;
    const float* t = (const float*)(P.ws + WS_TMP) + (size_t)r * NP1;
    const float* ssq = (const float*)(P.ws + WS_SSQ) + (size_t)r * 8;
    const float rq = rsqrtf((ssq[0] + ssq[1] + ssq[2] + ssq[3]) / 256.f + EPS), rkv = rsqrtf((ssq[4] + ssq[5] + ssq[6] + ssq[7]) / 128.f + EPS);
    const float2* TM = (const float2*)(P.ws + WS_TAB) + 1024;
    const bool lat = n >= NCTX; const int s = n - NCTX, gr = s >> 6, gc = s & 63;
    bf16* qo = (bf16*)(P.ws + WS_QM) + (size_t)r * 768; bf16* kvo = (bf16*)(P.ws + WS_KVM) + (size_t)r * 1024;
    for (int p = threadIdx.x; p < 1792; p += 256) {
        if (p < 768) {
            int rr = p % 96; float val = t[p] * rq;
            if (rr >= 64) { int ph = rr - 64, nn = (ph >> 2) & 1, i = 4 * (ph >> 3) + (ph & 3);
                float x1 = t[nn ? p - 4 : p] * rq, x2 = t[nn ? p : p + 4] * rq;
                float2 cs = lat ? TM[(i < 8 ? gr : gc) * 8 + (i & 7)] : make_float2(1.f, 0.f);
                val = nn ? x1 * cs.y + x2 * cs.x : x1 * cs.x - x2 * cs.y; }
            qo[p] = (bf16)f2bf(val);
        } else kvo[p - 768] = (bf16)f2bf(t[p] * rkv);
    }
}

template <int MODE> __global__ __launch_bounds__(256) void k_attn(Ptrs P) {
    const int t = blockIdx.x * 256 + threadIdx.x;
    const int b = (blockIdx.x * 256) / SEQ, s = t % SEQ, hh = blockIdx.y, sl = blockIdx.z;
    const bf16* P1 = (const bf16*)(P.ws + WS_P1); const bf16* QM = (const bf16*)(P.ws + WS_QM); const bf16* KV = (const bf16*)(P.ws + WS_KVM);
    const size_t qrow = (size_t)b * NTOK + NCTX + s, k0row = (size_t)b * NTOK;
    constexpr int DQK = MODE == 0 ? 96 : 64;
    float q[DQK]; float o[64]; float m = -1e30f, l = 0.f;
    const float scale = MODE == 0 ? 0.10206207261596575f : 0.125f;
    if (MODE == 0) { _Pragma("unroll") for (int d = 0; d < 96; ++d) q[d] = bf2f(QM[qrow * 768 + hh * 96 + d]) * scale; }
    else { _Pragma("unroll") for (int d = 0; d < 64; ++d) q[d] = bf2f(P1[qrow * NP1 + 512 + hh * 64 + d]) * scale; }
    _Pragma("unroll") for (int d = 0; d < 64; ++d) o[d] = 0.f;
    for (int j = 0; j < NTOK; ++j) {
        const size_t kr = k0row + j; float sc = 0.f;
        if (MODE == 0) {
            const bf16* kn = KV + kr * 1024 + hh * 128; const bf16* kro = P1 + kr * NP1 + 384;
            _Pragma("unroll") for (int d = 0; d < 64; ++d) sc += q[d] * bf2f(kn[d]);
            _Pragma("unroll") for (int d = 0; d < 32; ++d) sc += q[64 + d] * bf2f(kro[d]);
        } else { const bf16* kk = P1 + kr * NP1 + 1024 + hh * 64; _Pragma("unroll") for (int d = 0; d < 64; ++d) sc += q[d] * bf2f(kk[d]); }
        float mn = fmaxf(m, sc), al = __expf(m - mn), p = __expf(sc - mn);
        l = l * al + p; m = mn;
        const bf16* vv = MODE == 0 ? KV + kr * 1024 + hh * 128 + 64 : P1 + kr * NP1 + 1536 + (hh >> 1) * 128 + sl * 64;
        _Pragma("unroll") for (int d = 0; d < 64; ++d) o[d] = o[d] * al + p * bf2f(vv[d]);
    }
    const float il = 1.f / l;
    if (MODE == 0) { bf16* mo = (bf16*)(P.ws + WS_MIX) + (size_t)t * DM + hh * 64; _Pragma("unroll") for (int d = 0; d < 64; ++d) mo[d] = (bf16)f2bf(o[d] * il); }
    else { float* oo = (float*)(P.ws + WS_OS) + ((size_t)t * 8 + hh) * 128 + sl * 64; _Pragma("unroll") for (int d = 0; d < 64; ++d) oo[d] = o[d] * il; }
}
__global__ void k_diff_finish(Ptrs P) {
    const int t = blockIdx.x, h = threadIdx.x >> 6  , lane = threadIdx.x & 63;
    float d1 = 0.f, d2 = 0.f; for (int i = 0; i < 64; ++i) { d1 += P.in[13][i] * P.in[14][i]; d2 += P.in[15][i] * P.in[16][i]; }
    const float lam = __expf(d1) - __expf(d2) + LAM_INIT;
    const float* os = (const float*)(P.ws + WS_OS) + ((size_t)t * 8 + 2 * h) * 128;
    float v0 = os[lane] - lam * os[128 + lane], v1 = os[64 + lane] - lam * os[128 + 64 + lane];
    float ss = v0 * v0 + v1 * v1;
    for (int o = 1; o < 64; o <<= 1) ss += __shfl_xor(ss, o);
    const float rs = rsqrtf(ss / 128.f + EPS) * (1.f - LAM_INIT);
    bf16* mo = (bf16*)(P.ws + WS_MIX) + (size_t)t * DM + 512 + h * 128;
    mo[lane] = (bf16)f2bf(v0 * rs * P.in[17][lane]); mo[64 + lane] = (bf16)f2bf(v1 * rs * P.in[17][64 + lane]);
}

struct FOut { Ptrs P;
    __device__ int rows(int) const { return MLAT; }
    __device__ float a(int, int m, int k) const { return bf2f(((const bf16*)(P.ws + WS_MIX))[(size_t)m * DM + k]); }
    __device__ float b(int, int k, int n) const { return bf2f((bf16)f2bf(P.in[18][(size_t)k * DM + n])); }
    __device__ void c(int, int m, int n, float v) const { const float* mod = (const float*)(P.ws + WS_MOD) + (m / SEQ) * 6144;
        ((float*)(P.ws + WS_X1))[(size_t)m * DM + n] = P.in[0][(size_t)m * DM + n] + mod[2048 + n] * v; }
};
__global__ void k_h2(Ptrs P) {
    int t = blockIdx.x, b = t / SEQ;
    const float* src = (const float*)(P.ws + WS_X1) + (size_t)t * DM;
    const float* mod = (const float*)(P.ws + WS_MOD) + b * 6144;
    __shared__ float red[256];
    float v[4]; float ss = 0.f;
    for (int i = 0; i < 4; ++i) { v[i] = src[threadIdx.x + 256 * i]; ss += v[i] * v[i]; }
    red[threadIdx.x] = ss; __syncthreads();
    for (int o = 128; o > 0; o >>= 1) { if (threadIdx.x < o) red[threadIdx.x] += red[threadIdx.x + o]; __syncthreads(); }
    float rs = rsqrtf(red[0] / DM + EPS);
    for (int i = 0; i < 4; ++i) { int j = threadIdx.x + 256 * i; float y = v[i] * rs * P.in[7][j]; y = y * (1.f + mod[4096 + j]) + mod[3072 + j];
        ((bf16*)(P.ws + WS_H2))[(size_t)t * DM + j] = (bf16)f2bf(y); ((float*)(P.ws + WS_H2F))[(size_t)t * DM + j] = y; }
}
struct FRouter { Ptrs P;
    __device__ int rows(int) const { return MLAT; }
    __device__ float a(int, int m, int k) const { return ((const float*)(P.ws + WS_H2F))[(size_t)m * DM + k]; }
    __device__ float b(int, int k, int n) const { return P.in[19][(size_t)k * NEXP + n]; }
    __device__ void c(int, int m, int n, float v) const { ((float*)(P.ws + WS_LOG))[(size_t)m * NEXP + n] = v; }
};
__global__ __launch_bounds__(256) void k_route(Ptrs P) {
    const int t = blockIdx.x * 4 + (threadIdx.x >> 6), lane = threadIdx.x & 63;
    const float4 lg = ((const float4*)(P.ws + WS_LOG))[(size_t)t * 64 + lane];
    const float4 bi = ((const float4*)P.in[20])[lane];
    float s[4] = {1.f / (1.f + __expf(-lg.x)), 1.f / (1.f + __expf(-lg.y)), 1.f / (1.f + __expf(-lg.z)), 1.f / (1.f + __expf(-lg.w))};
    float v[4] = {s[0] + bi.x, s[1] + bi.y, s[2] + bi.z, s[3] + bi.w};
    float m1 = fmaxf(v[0], v[1]), m2 = fminf(v[0], v[1]);
    for (int i = 2; i < 4; ++i) { float x = v[i]; m2 = fmaxf(m2, fminf(m1, x)); m1 = fmaxf(m1, x); }
    for (int o = 1; o < 8; o <<= 1) { float b1 = __shfl_xor(m1, o), b2 = __shfl_xor(m2, o); float n1 = fmaxf(m1, b1), n2 = fmaxf(fminf(m1, b1), fmaxf(m2, b2)); m1 = n1; m2 = n2; }
    const float gs = m1 + m2; const int g = lane >> 3; int rank = 0;
    for (int j = 0; j < 8; ++j) { float o = __shfl(gs, j * 8); rank += (o > gs || (o == gs && j < g)) ? 1 : 0; }
    if (rank >= 4) { v[0] = v[1] = v[2] = v[3] = -INFINITY; }
    int my_e = 0; float my_s = 0.f; float ssum = 0.f;
    for (int k = 0; k < 8; ++k) {
        float bv = v[0]; int bi_ = 0;
        for (int i = 1; i < 4; ++i) if (v[i] > bv) { bv = v[i]; bi_ = i; }
        int be = lane * 4 + bi_;
        for (int o = 1; o < 64; o <<= 1) { float ov = __shfl_xor(bv, o); int oe = __shfl_xor(be, o); if (ov > bv || (ov == bv && oe < be)) { bv = ov; be = oe; } }
        const int wl = be >> 2, wi = be & 3;
        float sv = wi == 0 ? s[0] : wi == 1 ? s[1] : wi == 2 ? s[2] : s[3];
        sv = __shfl(sv, wl);
        if (lane == wl) { if (wi == 0) v[0] = -INFINITY; else if (wi == 1) v[1] = -INFINITY; else if (wi == 2) v[2] = -INFINITY; else v[3] = -INFINITY; }
        ssum += sv; if (lane == k) { my_e = be; my_s = sv; }
    }
    if (lane < 8) {
        int* cnt = (int*)(P.ws + WS_CTL) + CW_COUNT;
        int rk = atomicAdd(&cnt[my_e], 1);
        ((int*)(P.ws + WS_EIDX))[(size_t)t * 8 + lane] = my_e;
        ((float*)(P.ws + WS_EW))[(size_t)t * 8 + lane] = my_s / ssum * 2.5f;
        ((int*)(P.ws + WS_ERANK))[(size_t)t * 8 + lane] = rk;
    }
}
__global__ __launch_bounds__(256) void k_slots(Ptrs P) {
    __shared__ int off[257];
    const int* cnt = (const int*)(P.ws + WS_CTL) + CW_COUNT;
    if (threadIdx.x == 0) { int a = 0; for (int e = 0; e < 256; ++e) { off[e] = a; a += cnt[e]; } off[256] = a; }
    __syncthreads();
    if (blockIdx.x == 0) { int* go = (int*)(P.ws + WS_OFF); go[threadIdx.x] = off[threadIdx.x]; if (threadIdx.x == 0) { go[256] = off[256]; go[257] = NSLOT; } }
    int idx = blockIdx.x * 256 + threadIdx.x;
    int e = ((const int*)(P.ws + WS_EIDX))[idx], rk = ((const int*)(P.ws + WS_ERANK))[idx];
    int slot = off[e] + rk;
    ((int*)(P.ws + WS_SLOTOF))[idx] = slot;
    ((int*)(P.ws + WS_SLOTTOK))[slot] = idx >> 3;
    ((float*)(P.ws + WS_SLOTW))[slot] = ((const float*)(P.ws + WS_EW))[idx];
    if (idx < MLAT) { ((int*)(P.ws + WS_SLOTTOK))[MLAT * 8 + idx] = idx; ((float*)(P.ws + WS_SLOTW))[MLAT * 8 + idx] = 1.f; }
}
__global__ __launch_bounds__(256) void k_exp1(Ptrs P) {
    const int z = blockIdx.z; const int* off = (const int*)(P.ws + WS_OFF); const int rows = off[z + 1] - off[z]; const int m0 = blockIdx.y * 16; if (m0 >= rows) return;
    const float* w1 = z < 256 ? P.in[21] + (size_t)z * DM * EFF : P.in[24]; const float* w3 = z < 256 ? P.in[22] + (size_t)z * DM * EFF : P.in[25];
    __shared__ float hs[16][DM];
    for (int i = threadIdx.x; i < 16 * DM; i += 256) { int m = i / DM, k = i % DM; int slot = off[z] + m0 + m; hs[m][k] = (m0 + m < rows) ? bf2f(((const bf16*)(P.ws + WS_H2))[(size_t)((const int*)(P.ws + WS_SLOTTOK))[slot] * DM + k]) : 0.f; }
    __syncthreads();
    const int n = threadIdx.x; float g[16] = {}, u[16] = {};
    for (int k = 0; k < DM; ++k) { float a = bf2f((bf16)f2bf(w1[(size_t)k * EFF + n])), b = bf2f((bf16)f2bf(w3[(size_t)k * EFF + n]));
#pragma unroll
        for (int m = 0; m < 16; ++m) { g[m] += hs[m][k] * a; u[m] += hs[m][k] * b; } }
    for (int m = 0; m < 16; ++m) if (m0 + m < rows) { float gg = g[m]; float act = gg / (1.f + __expf(-gg)) * u[m]; ((bf16*)(P.ws + WS_ACT))[(size_t)(off[z] + m0 + m) * EFF + n] = (bf16)f2bf(act); }
}
struct FExp2 { Ptrs P;
    __device__ int rows(int z) const { const int* off = (const int*)(P.ws + WS_OFF); return off[z + 1] - off[z]; }
    __device__ float a(int z, int m, int k) const { const int* off = (const int*)(P.ws + WS_OFF); return bf2f(((const bf16*)(P.ws + WS_ACT))[(size_t)(off[z] + m) * EFF + k]); }
    __device__ float b(int z, int k, int n) const { const float* w = z < 256 ? P.in[23] + (size_t)z * EFF * DM : P.in[26]; return bf2f((bf16)f2bf(w[(size_t)k * DM + n])); }
    __device__ void c(int z, int m, int n, float v) const { const int* off = (const int*)(P.ws + WS_OFF); size_t slot = off[z] + m;
        ((bf16*)(P.ws + WS_Y))[slot * DM + n] = (bf16)f2bf(v * ((const float*)(P.ws + WS_SLOTW))[slot]); }
};
__global__ void k_combine(Ptrs P) {
    int t = blockIdx.x, b = t / SEQ;
    const float* x1 = (const float*)(P.ws + WS_X1) + (size_t)t * DM;
    const float* mod = (const float*)(P.ws + WS_MOD) + b * 6144;
    const bf16* Y = (const bf16*)(P.ws + WS_Y); const int* so = (const int*)(P.ws + WS_SLOTOF) + (size_t)t * 8;
    __shared__ float red[256];
    float v[4]; float ss = 0.f;
    for (int i = 0; i < 4; ++i) { int j = threadIdx.x + 256 * i; float a = bf2f(Y[(size_t)(MLAT * 8 + t) * DM + j]);
        for (int k = 0; k < 8; ++k) a += bf2f(Y[(size_t)so[k] * DM + j]);
        v[i] = x1[j] + mod[5120 + j] * a; ss += v[i] * v[i]; }
    red[threadIdx.x] = ss; __syncthreads();
    for (int o = 128; o > 0; o >>= 1) { if (threadIdx.x < o) red[threadIdx.x] += red[threadIdx.x + o]; __syncthreads(); }
    float rs = rsqrtf(red[0] / DM + EPS);
    for (int i = 0; i < 4; ++i) { int j = threadIdx.x + 256 * i; P.out[(size_t)t * DM + j] = v[i] * rs * P.in[27][j]; }
}

#define GAS __attribute__((address_space(1)))
#define LAS __attribute__((address_space(3)))
typedef short bf16x8 __attribute__((ext_vector_type(8)));
typedef short s16x4 __attribute__((ext_vector_type(4)));
typedef float f32x4 __attribute__((ext_vector_type(4)));
typedef float f32x2 __attribute__((ext_vector_type(2)));
typedef float f32x16 __attribute__((ext_vector_type(16)));
typedef float f32x8 __attribute__((ext_vector_type(8)));
typedef unsigned u32x4 __attribute__((ext_vector_type(4)));
typedef unsigned u32x2 __attribute__((ext_vector_type(2)));
#define RLX_AGENT __ATOMIC_RELAXED, __HIP_MEMORY_SCOPE_AGENT
#define LDS_WAIT() asm volatile("s_waitcnt lgkmcnt(0)" ::: "memory")
#define VM_WAIT() asm volatile("s_waitcnt vmcnt(0)" ::: "memory")

constexpr size_t WS_MODP = 1 * MiB;
constexpr size_t WS_WIN = 4 * MiB;
constexpr size_t WS_WUP = 8 * MiB;
constexpr size_t WS_WOUT = 10 * MiB;
constexpr size_t WS_WR = 12 * MiB;
constexpr size_t WS_W13 = 16 * MiB;
constexpr size_t WS_W2 = 273 * MiB;
constexpr size_t WS_UT = WS_OFF + 4096;
static_assert(WS_W2 + (size_t)257 * 1024 * 256 * 2 <= WS_X1, "ws map");
constexpr size_t WS_LOGP = WS_Y;
constexpr int CW_NUNIT = 2048;
constexpr int CW_BAR = 4096;

__device__ __forceinline__ unsigned cvt_pk_bf16(float lo, float hi) { unsigned r; asm volatile("v_cvt_pk_bf16_f32 %0, %1, %2" : "=v"(r) : "v"(lo), "v"(hi)); return r; }
__device__ __forceinline__ unsigned pk2(float lo, float hi) { return f2bf(lo) | (f2bf(hi) << 16); }
__device__ __forceinline__ u32x4 pack8(f32x4 a, f32x4 b) { u32x4 w; w.x = cvt_pk_bf16(a[0], a[1]); w.y = cvt_pk_bf16(a[2], a[3]); w.z = cvt_pk_bf16(b[0], b[1]); w.w = cvt_pk_bf16(b[2], b[3]); return w; }
__device__ __forceinline__ float wave_sum(float v) {
#pragma unroll
    for (int o = 1; o < 64; o <<= 1) v += __shfl_xor(v, o);
    return v;
}

namespace pg8 {
constexpr int BM = 256, BK = 64, HALF = 128, HTB = HALF * BK * 2, STAGE_BYTES = 8 * HTB;
__host__ __device__ __forceinline__ int lds_byte(int r, int c) { const int st = (r >> 4) * 2 + (c >> 5), rr = r & 15, cc = c & 31, ob = rr * 64 + cc * 2; return st * 1024 + (ob ^ (((ob >> 9) & 1) << 5)); }
__host__ __device__ __forceinline__ void stage_rc(int b, int& R, int& C) { const int st = b / 1024, sb = b % 1024, swz = sb ^ (((sb >> 9) & 1) << 5); R = (st >> 1) * 16 + swz / 64; C = (st & 1) * 32 + (swz % 64) / 2; }
__host__ __device__ __forceinline__ int perm32(int rho) { const int n = rho >> 4, i = rho & 15; return 8 * (i >> 2) + 4 * n + (i & 3); }

struct Unit { int pm, pn, r0, nv, k0; };
struct Gemm { const bf16* A; const bf16* Bt; int lda, ldb, K; };

struct StaticOrder {
    int nM, nN, nwg, G, c;
    __device__ void init(int M, int N, int G_, int c_) { nM = M / BM; nN = N / BM; nwg = nM * nN; G = G_; c = c_; }
    __device__ bool next(int i, Unit& u) const {
        const long L = (long)i * G + c; if (L >= nwg) return false;
        int wgid = (int)L; { const int q = nwg / 8, r = nwg % 8, xcd = wgid % 8, off = wgid / 8; wgid = (xcd < r ? xcd * (q + 1) : r * (q + 1) + (xcd - r) * q) + off; }
        const int nig = 8 * nN, gid = wgid / nig, fm = gid * 8, gsz = (nM - fm) < 8 ? (nM - fm) : 8;
        u.pm = fm + ((wgid % nig) % gsz); u.pn = (wgid % nig) / gsz; u.r0 = u.pm * BM; u.nv = BM; u.k0 = 0; return true;
    }
    __device__ __forceinline__ int a_row(const Unit& u, int r) const { return u.pm * BM + r; }
};

template <class Epi, class Sched>
__device__ __forceinline__ void gemm_phase(LAS unsigned char* lds, const Gemm g, const Sched& S, const Epi& E) {
    const int tid = threadIdx.x, wid = __builtin_amdgcn_readfirstlane(tid >> 6), lane = tid & 63, wr = wid >> 2, wc = wid & 3, fr = lane & 15, fq = lane >> 4;
    int K = g.K; asm volatile("" : "+s"(K));
    const int nt = K / BK;
    int RA[2], CA[2]; unsigned voffB[2];
#pragma unroll
    for (int i = 0; i < 2; ++i) { int R, C; stage_rc(tid * 16 + i * 8192, R, C); RA[i] = R; CA[i] = C; const int Rb = Epi::PERM ? ((R & ~31) + perm32(R & 31)) : R; voffB[i] = (unsigned)(Rb * g.ldb + C) * 2u; }
    const size_t kstep = (size_t)(BK * 2);
    const size_t hstepB = (size_t)HALF * g.ldb * 2, tstepB = 2 * hstepB;
    const unsigned ldsw = (unsigned)wid * 1024u;
    const int aoff = lds_byte(wr * 64 + fr, fq * 8), boff = lds_byte(wc * 32 + fr, fq * 8);
#define PG8_SA(b, h) (((b) * 2 + (h)) * HTB)
#define PG8_SB(b, h) ((4 + (b) * 2 + (h)) * HTB)
#define PG8_STAGE(bufoff, gbase, voff) do { _Pragma("unroll") for (int _i = 0; _i < 2; ++_i) \
        __builtin_amdgcn_global_load_lds((const unsigned*)((const char*)(gbase) + (voff)[_i]), (LAS unsigned*)(lds + (bufoff) + ldsw + _i * 8192), 16, 0, 0); } while (0)
#define PG8_LDA(dst, b, h) do { _Pragma("unroll") for (int m = 0; m < 4; ++m) _Pragma("unroll") for (int k = 0; k < 2; ++k) dst[m][k] = *(const LAS bf16x8*)(lds + PG8_SA(b, h) + aoff + m * 2048 + k * 1024); } while (0)
#define PG8_LDB(dst, b, h) do { _Pragma("unroll") for (int n = 0; n < 2; ++n) _Pragma("unroll") for (int k = 0; k < 2; ++k) dst[n][k] = *(const LAS bf16x8*)(lds + PG8_SB(b, h) + boff + n * 2048 + k * 1024); } while (0)
#define PG8_MMA(ai, bj, At, Bt) do { __builtin_amdgcn_s_setprio(1); _Pragma("unroll") for (int m = 0; m < 4; ++m) _Pragma("unroll") for (int n = 0; n < 2; ++n) _Pragma("unroll") for (int k = 0; k < 2; ++k) \
        acc[ai][bj][m][n] = __builtin_amdgcn_mfma_f32_16x16x32_bf16(Bt[n][k], At[m][k], acc[ai][bj][m][n], 0, 0, 0); __builtin_amdgcn_s_setprio(0); } while (0)
#define PG8_WAIT_V(n) asm volatile("s_waitcnt vmcnt(" #n ")" ::: "memory")
#define PG8_WAIT_L(n) asm volatile("s_waitcnt lgkmcnt(" #n ")" ::: "memory")
#define PG8_BAR __builtin_amdgcn_s_barrier()
#define PG8_SCHED __builtin_amdgcn_sched_barrier(0)
#define PG8_AOFFS(dst, u) do { _Pragma("unroll") for (int _h = 0; _h < 2; ++_h) _Pragma("unroll") for (int _i = 0; _i < 2; ++_i) \
        dst[_h][_i] = (unsigned)(((size_t)S.a_row(u, _h * HALF + RA[_i]) * (size_t)g.lda + (size_t)(CA[_i] + (u).k0)) * 2u); } while (0)
    Unit cur, nxt; int ui = 0;
    if (!S.next(0, cur)) return;
    f32x4 acc[2][2][4][2];
#pragma unroll
    for (int a = 0; a < 2; ++a)
#pragma unroll
        for (int b = 0; b < 2; ++b)
#pragma unroll
            for (int m = 0; m < 4; ++m)
#pragma unroll
                for (int n = 0; n < 2; ++n) acc[a][b][m][n] = (f32x4){0.f, 0.f, 0.f, 0.f};
    bf16x8 At[4][2], B0[2][2], B1[2][2];
    unsigned vA[2][2], vN[2][2];
    PG8_AOFFS(vA, cur);
    const char* Ab = (const char*)g.A; const char* cB = (const char*)g.Bt + (size_t)cur.pn * tstepB + (size_t)cur.k0 * 2;
    PG8_STAGE(PG8_SB(0, 0), cB, voffB); PG8_STAGE(PG8_SB(0, 1), cB + hstepB, voffB); PG8_STAGE(PG8_SA(0, 0), Ab, vA[0]); PG8_STAGE(PG8_SA(0, 1), Ab, vA[1]);
    if (wr == 1) PG8_BAR;
    PG8_WAIT_V(2); PG8_BAR;
    PG8_STAGE(PG8_SB(1, 0), cB + kstep, voffB); PG8_STAGE(PG8_SA(1, 0), Ab + kstep, vA[0]); PG8_STAGE(PG8_SB(1, 1), cB + hstepB + kstep, voffB);
    PG8_WAIT_V(6); PG8_BAR;
    for (;;) {
        const bool has_next = S.next(ui + 1, nxt);
        const char* nB = has_next ? (const char*)g.Bt + (size_t)nxt.pn * tstepB + (size_t)nxt.k0 * 2 : cB;
        if (has_next) { PG8_AOFFS(vN, nxt); } else { vN[0][0] = vA[0][0]; vN[0][1] = vA[0][1]; vN[1][0] = vA[1][0]; vN[1][1] = vA[1][1]; }
        for (int t = 0; t < nt; t += 2) {
            const bool last = (t == nt - 2); const bool full = cur.nv > HALF;
            const char* a1 = Ab + (size_t)(t + 1) * kstep;
            const char* a2 = Ab + (last ? (size_t)0 : (size_t)(t + 2) * kstep); const char* b2 = last ? nB : cB + (size_t)(t + 2) * kstep;
            const char* a3 = a2 + kstep; const char* b3 = b2 + kstep;
            unsigned w0[2], w1[2];
            w0[0] = last ? vN[0][0] : vA[0][0]; w0[1] = last ? vN[0][1] : vA[0][1]; w1[0] = last ? vN[1][0] : vA[1][0]; w1[1] = last ? vN[1][1] : vA[1][1];
            PG8_LDB(B0, 0, 0); PG8_LDB(B1, 0, 1); PG8_SCHED; PG8_LDA(At, 0, 0); PG8_STAGE(PG8_SA(1, 1), a1, vA[1]);
            PG8_WAIT_V(8); PG8_WAIT_L(0); PG8_BAR; PG8_MMA(0, 0, At, B0); PG8_MMA(0, 1, At, B1); PG8_BAR; PG8_SCHED;
            PG8_LDA(At, 0, 1); PG8_STAGE(PG8_SB(0, 0), b2, voffB); PG8_STAGE(PG8_SB(0, 1), b2 + hstepB, voffB); PG8_STAGE(PG8_SA(0, 0), a2, w0);
            PG8_WAIT_V(8); PG8_WAIT_L(0); PG8_BAR; if (full) { PG8_MMA(1, 0, At, B0); PG8_MMA(1, 1, At, B1); } PG8_BAR; PG8_SCHED;
            PG8_LDB(B0, 1, 0); PG8_LDB(B1, 1, 1); PG8_SCHED; PG8_LDA(At, 1, 0); PG8_STAGE(PG8_SA(0, 1), a2, w1);
            PG8_WAIT_V(8); PG8_WAIT_L(0); PG8_BAR; PG8_MMA(0, 0, At, B0); PG8_MMA(0, 1, At, B1); PG8_BAR; PG8_SCHED;
            PG8_LDA(At, 1, 1); PG8_STAGE(PG8_SB(1, 0), b3, voffB); PG8_STAGE(PG8_SB(1, 1), b3 + hstepB, voffB); PG8_STAGE(PG8_SA(1, 0), a3, w0);
            PG8_WAIT_V(8); PG8_WAIT_L(0); PG8_BAR; if (full) { PG8_MMA(1, 0, At, B0); PG8_MMA(1, 1, At, B1); } PG8_BAR; PG8_SCHED;
        }
        if (wr == 0) PG8_BAR;
        E(acc, cur, wr, wc, fr, fq);
        if (!has_next) break;
#pragma unroll
        for (int a = 0; a < 2; ++a)
#pragma unroll
            for (int b = 0; b < 2; ++b)
#pragma unroll
                for (int m = 0; m < 4; ++m)
#pragma unroll
                    for (int n = 0; n < 2; ++n) acc[a][b][m][n] = (f32x4){0.f, 0.f, 0.f, 0.f};
        cur = nxt; cB = nB; ++ui;
        vA[0][0] = vN[0][0]; vA[0][1] = vN[0][1]; vA[1][0] = vN[1][0]; vA[1][1] = vN[1][1];
        if (wr == 1) PG8_BAR;
    }
    PG8_WAIT_V(0);
    PG8_BAR;
#undef PG8_SA
#undef PG8_SB
#undef PG8_STAGE
#undef PG8_LDA
#undef PG8_LDB
#undef PG8_MMA
#undef PG8_WAIT_V
#undef PG8_WAIT_L
#undef PG8_BAR
#undef PG8_SCHED
#undef PG8_AOFFS
}
}

using pg8::Unit;
typedef f32x4 Acc[2][2][4][2];

struct EpiInProj {
    static constexpr bool PERM = true;
    bf16* P1; float* SSQ; const float2* TD; const float2* TM;
    __device__ __forceinline__ void operator()(const Acc& acc, const Unit& u, int wr, int wc, int fr, int fq) const {
        const int pm = u.pm, pn = u.pn, jt = pm % 17; const bool lat = jt > 0;
        const int row0 = pm * 256 + wr * 64 + fr, col0 = pn * 256 + wc * 32 + 8 * fq;
        if (pn == 0 || pn >= 6 || (pn == 1)) {
#pragma unroll
            for (int ai = 0; ai < 2; ++ai)
#pragma unroll
                for (int m = 0; m < 4; ++m) {
                    const int r = row0 + ai * 128 + m * 16; bf16* rowp = P1 + (size_t)r * NP1 + col0;
                    *(u32x4*)(rowp) = pack8(acc[ai][0][m][0], acc[ai][0][m][1]);
                    if (pn != 1) *(u32x4*)(rowp + 128) = pack8(acc[ai][1][m][0], acc[ai][1][m][1]);
                    if (pn <= 1) {
                        float s = 0.f;
#pragma unroll
                        for (int bj = 0; bj < 2; ++bj) { if (pn == 1 && bj == 1) break;
#pragma unroll
                            for (int n = 0; n < 2; ++n) { const f32x4 x = acc[ai][bj][m][n]; s += (x[0] * x[0] + x[1] * x[1]) + (x[2] * x[2] + x[3] * x[3]); } }
                        s += __shfl_xor(s, 16); s += __shfl_xor(s, 32);
                        if (fq == 0) SSQ[(size_t)r * 8 + pn * 4 + wc] = s;
                    }
                    if (pn == 1 && wc == 0) {
                        f32x4 x1 = acc[ai][1][m][0], x2 = acc[ai][1][m][1], o1 = x1, o2 = x2;
                        if (lat) { const int gr = (jt - 1) * 4 + 2 * ai + wr, gc = 16 * m + fr;
                            const float2* tp = TM + (fq < 2 ? gr * 8 + 4 * fq : gc * 8 + 4 * (fq - 2));
                            const f32x4 t0 = *(const f32x4*)tp, t1 = *(const f32x4*)(tp + 2);
                            const f32x4 cs = {t0[0], t0[2], t1[0], t1[2]}, sn = {t0[1], t0[3], t1[1], t1[3]};
                            o1 = x1 * cs - x2 * sn; o2 = x1 * sn + x2 * cs; }
                        *(u32x4*)(rowp + 128) = pack8(o1, o2);
                    }
                }
        } else {
            const int g = wc & 1; const float qs = pn < 4 ? 0.125f * 1.4426950408889634f : 1.f;
#pragma unroll
            for (int ai = 0; ai < 2; ++ai) {
                const int gr = (jt - 1) * 4 + 2 * ai + wr;
#pragma unroll
                for (int m = 0; m < 4; ++m) {
                    const int r = row0 + ai * 128 + m * 16; bf16* rowp = P1 + (size_t)r * NP1 + col0;
                    f32x4 cs = {1.f, 1.f, 1.f, 1.f}, sn = {0.f, 0.f, 0.f, 0.f};
                    if (lat) { const int gc = 16 * m + fr; const float2* tp = TD + (g == 0 ? gr : gc) * 16 + 4 * fq;
                        const f32x4 t0 = *(const f32x4*)tp, t1 = *(const f32x4*)(tp + 2);
                        cs = (f32x4){t0[0], t0[2], t1[0], t1[2]}; sn = (f32x4){t0[1], t0[3], t1[1], t1[3]}; }
#pragma unroll
                    for (int bj = 0; bj < 2; ++bj) { const f32x4 x1 = acc[ai][bj][m][0] * qs, x2 = acc[ai][bj][m][1] * qs;
                        *(u32x4*)(rowp + bj * 128) = pack8(x1 * cs - x2 * sn, x1 * sn + x2 * cs); }
                }
            }
        }
    }
};

struct EpiUp {
    static constexpr bool PERM = true;
    bf16* QM; bf16* KVM; const float* SSQ; const float2* TM;
    __device__ __forceinline__ void operator()(const Acc& acc, const Unit& u, int wr, int wc, int fr, int fq) const {
        const int pm = u.pm, pn = u.pn, jt = pm % 17; const bool lat = jt > 0, isq = pn < 3;
        const int row0 = pm * 256 + wr * 64 + fr, col0 = pn * 256 + wc * 32 + 8 * fq;
#pragma unroll
        for (int ai = 0; ai < 2; ++ai)
#pragma unroll
            for (int m = 0; m < 4; ++m) {
                const int r = row0 + ai * 128 + m * 16;
                const f32x4 sq = *(const f32x4*)(SSQ + (size_t)r * 8 + (isq ? 0 : 4));
                const float rs = rsqrtf(((sq[0] + sq[1]) + (sq[2] + sq[3])) * (isq ? 1.f / 256.f : 1.f / 128.f) + EPS) * (isq ? 0.10206207261596575f * 1.4426950408889634f : 1.f);
#pragma unroll
                for (int bj = 0; bj < 2; ++bj) {
                    f32x4 x1 = acc[ai][bj][m][0] * rs, x2 = acc[ai][bj][m][1] * rs;
                    if (isq) {
                        const int G = 8 * pn + 4 * bj + wc;
                        if (lat && (G % 3) == 2) { const int gr = (jt - 1) * 4 + 2 * ai + wr, gc = 16 * m + fr;
                            const float2* tp = TM + (fq < 2 ? gr * 8 + 4 * fq : gc * 8 + 4 * (fq - 2));
                            const f32x4 t0 = *(const f32x4*)tp, t1 = *(const f32x4*)(tp + 2);
                            const f32x4 cs = {t0[0], t0[2], t1[0], t1[2]}, sn = {t0[1], t0[3], t1[1], t1[3]};
                            const f32x4 o1 = x1 * cs - x2 * sn, o2 = x1 * sn + x2 * cs; x1 = o1; x2 = o2; }
                        *(u32x4*)(QM + (size_t)r * 768 + col0 + bj * 128) = pack8(x1, x2);
                    } else *(u32x4*)(KVM + (size_t)r * 1024 + (col0 - 768) + bj * 128) = pack8(x1, x2);
                }
            }
    }
};

struct EpiOut {
    static constexpr bool PERM = false;
    const float* x; const float* MOD; float* X1;
    __device__ __forceinline__ void operator()(const Acc& acc, const Unit& u, int wr, int wc, int fr, int fq) const {
        const int b = u.pm / 16; const float* gt = MOD + b * 6144 + 2048;
        const int row0 = u.pm * 256 + wr * 64 + fr, col0 = u.pn * 256 + wc * 32 + 4 * fq;
        f32x4 gv[2][2];
#pragma unroll
        for (int bj = 0; bj < 2; ++bj)
#pragma unroll
            for (int n = 0; n < 2; ++n) gv[bj][n] = *(const f32x4*)(gt + col0 + bj * 128 + n * 16);
#pragma unroll
        for (int ai = 0; ai < 2; ++ai)
#pragma unroll
            for (int m = 0; m < 4; ++m) { const size_t off = (size_t)(row0 + ai * 128 + m * 16) * DM + col0;
#pragma unroll
                for (int bj = 0; bj < 2; ++bj)
#pragma unroll
                    for (int n = 0; n < 2; ++n) { const f32x4 xv = *(const f32x4*)(x + off + bj * 128 + n * 16);
                        *(f32x4*)(X1 + off + bj * 128 + n * 16) = xv + gv[bj][n] * acc[ai][bj][m][n]; } }
    }
};
struct EpiF32 {
    static constexpr bool PERM = false;
    float* O; int ldc;
    __device__ __forceinline__ void operator()(const Acc& acc, const Unit& u, int wr, int wc, int fr, int fq) const {
        const int row0 = u.pm * 256 + wr * 64 + fr, col0 = u.pn * 256 + wc * 32 + 4 * fq;
#pragma unroll
        for (int ai = 0; ai < 2; ++ai)
#pragma unroll
            for (int m = 0; m < 4; ++m) { const size_t off = (size_t)(row0 + ai * 128 + m * 16) * ldc + col0;
#pragma unroll
                for (int bj = 0; bj < 2; ++bj)
#pragma unroll
                    for (int n = 0; n < 2; ++n) *(f32x4*)(O + off + bj * 128 + n * 16) = acc[ai][bj][m][n]; }
    }
};
struct EpiAct {
    static constexpr bool PERM = true;
    bf16* ACT; const float* SW;
    __device__ __forceinline__ void operator()(const Acc& acc, const Unit& u, int wr, int wc, int fr, int fq) const {
        const int half = u.pn & 1, colb = half * 128 + wc * 32 + 8 * fq;
#pragma unroll
        for (int ai = 0; ai < 2; ++ai)
#pragma unroll
            for (int m = 0; m < 4; ++m) { const int tr = ai * 128 + wr * 64 + m * 16 + fr;
                f32x4 a[2];
#pragma unroll
                for (int n = 0; n < 2; ++n) { const f32x4 gt = acc[ai][0][m][n], up = acc[ai][1][m][n];
#pragma unroll
                    for (int e = 0; e < 4; ++e) a[n][e] = gt[e] * __builtin_amdgcn_rcpf(1.f + __expf(-gt[e])) * up[e]; }
                if (tr < u.nv) { const float w = SW[u.r0 + tr]; *(u32x4*)(ACT + (size_t)(u.r0 + tr) * EFF + colb) = pack8(a[0] * w, a[1] * w); } }
    }
};
constexpr float YSCALE = 32.f;
__device__ __forceinline__ unsigned pk4_fp8(f32x4 v) { int w = 0; w = __builtin_amdgcn_cvt_pk_fp8_f32(v[0], v[1], w, false); w = __builtin_amdgcn_cvt_pk_fp8_f32(v[2], v[3], w, true); return (unsigned)w; }
struct EpiY {
    static constexpr bool PERM = true;
    unsigned char* Y;
    __device__ __forceinline__ void operator()(const Acc& acc, const Unit& u, int wr, int wc, int fr, int fq) const {
        const int colb = (u.pn & 3) * 256 + wc * 64 + 16 * fq;
#pragma unroll
        for (int ai = 0; ai < 2; ++ai)
#pragma unroll
            for (int m = 0; m < 4; ++m) { const int tr = ai * 128 + wr * 64 + m * 16 + fr;
                if (tr < u.nv) { u32x4 w; w.x = pk4_fp8(acc[ai][0][m][0] * YSCALE); w.y = pk4_fp8(acc[ai][0][m][1] * YSCALE); w.z = pk4_fp8(acc[ai][1][m][0] * YSCALE); w.w = pk4_fp8(acc[ai][1][m][1] * YSCALE);
                    *(u32x4*)(Y + (size_t)(u.r0 + tr) * DM + colb) = w; } }
    }
};

template <int SUB, bool GATHER> struct ExpSched {
    const LAS int* uc; int nmine; const int* slot_tok;
    __device__ bool next(int i, Unit& u) const {
        if (i >= nmine) return false;
        const int e = __builtin_amdgcn_readfirstlane(uc[i * 4 + 0]), r0 = __builtin_amdgcn_readfirstlane(uc[i * 4 + 1]);
        const int nv = __builtin_amdgcn_readfirstlane(uc[i * 4 + 2]), sub = __builtin_amdgcn_readfirstlane(uc[i * 4 + 3]);
        u.pm = 0; u.pn = e * SUB + sub; u.r0 = r0; u.nv = nv; u.k0 = 0; return true;
    }
    __device__ __forceinline__ int a_row(const Unit& u, int r) const {
        if (GATHER) return r < u.nv ? slot_tok[u.r0 + r] : 0;
        const int s = u.r0 + r; return s < NSLOT ? s : NSLOT - 1;
    }
};
template <int SUB> __device__ __forceinline__ int exp_units_to_lds(LAS int* uc, const int* ut, int ntot, int G, int c) {
    const int nmine = c < ntot ? (ntot - 1 - c) / G + 1 : 0;
    if ((int)threadIdx.x < nmine && threadIdx.x < 64) { const int L = (int)threadIdx.x * G + c, cu = L / SUB;
        uc[threadIdx.x * 4 + 0] = ut[cu * 4 + 0]; uc[threadIdx.x * 4 + 1] = ut[cu * 4 + 1]; uc[threadIdx.x * 4 + 2] = ut[cu * 4 + 2]; uc[threadIdx.x * 4 + 3] = L % SUB; }
    __syncthreads();
    return nmine < 64 ? nmine : 64;
}
struct RouterOrder {
    int G, c;
    __device__ bool next(int i, Unit& u) const { const int L = i * G + c; if (L >= 256) return false; u.pm = L >> 2; u.pn = 0; u.r0 = u.pm * 256; u.nv = 256; u.k0 = (L & 3) * 256; return true; }
    __device__ __forceinline__ int a_row(const Unit& u, int r) const { return u.pm * 256 + r; }
};
struct UpOrder {
    int G, c;
    __device__ bool next(int i, Unit& u) const { const int L = i * G + c; if (L >= 68 * 7) return false; u.pm = L / 7; u.pn = L % 7; u.r0 = u.pm * 256; u.nv = 256; u.k0 = u.pn < 3 ? 0 : 128; return true; }
    __device__ __forceinline__ int a_row(const Unit& u, int r) const { return u.pm * 256 + r; }
};
struct EpiLogP {
    static constexpr bool PERM = false;
    float* O;
    __device__ __forceinline__ void operator()(const Acc& acc, const Unit& u, int wr, int wc, int fr, int fq) const {
        float* base = O + (size_t)(u.k0 >> 8) * MLAT * NEXP;
        const int row0 = u.pm * 256 + wr * 64 + fr, col0 = wc * 32 + 4 * fq;
#pragma unroll
        for (int ai = 0; ai < 2; ++ai)
#pragma unroll
            for (int m = 0; m < 4; ++m) { const size_t off = (size_t)(row0 + ai * 128 + m * 16) * NEXP + col0;
#pragma unroll
                for (int bj = 0; bj < 2; ++bj)
#pragma unroll
                    for (int n = 0; n < 2; ++n) *(f32x4*)(base + off + bj * 128 + n * 16) = acc[ai][bj][m][n]; }
    }
};

namespace attn {
#define SBAR() __builtin_amdgcn_sched_barrier(0)
constexpr float THR = 8.f;
template <int MODE> struct Cfg;
template <> struct Cfg<0> { static constexpr int DQK = 96, DV = 64, LDQ = 768, LDK0 = 1024, LDK1 = 2048, LDV = 1024; static constexpr float SCALE = 0.10206207261596575f; };
template <> struct Cfg<1> { static constexpr int DQK = 64, DV = 128, LDQ = 2048, LDK0 = 2048, LDK1 = 2048, LDV = 2048; static constexpr float SCALE = 0.125f; };
__device__ __forceinline__ int crow(int r, int hi) { return (r & 3) + 8 * (r >> 2) + 4 * hi; }
__device__ __forceinline__ unsigned cvtpk(float lo, float hi) { unsigned r; asm volatile("v_cvt_pk_bf16_f32 %0, %1, %2" : "=v"(r) : "v"(lo), "v"(hi)); return r; }

constexpr float THR2 = 11.5f;
__device__ __forceinline__ float max3f(float a, float b, float c) { return __builtin_fmaxf(__builtin_fmaxf(a, b), c); }
__device__ __forceinline__ void partialSM(f32x16& p0, f32x16& p1, float& m_reg, float& alpha, bool first) {
    float a = max3f(p0[0], p0[1], p1[0]), b = max3f(p0[2], p0[3], p1[1]); a = max3f(a, p1[2], p1[3]);
#pragma unroll
    for (int r = 4; r < 16; r += 4) { a = max3f(a, p0[r], p0[r + 1]); b = max3f(b, p0[r + 2], p0[r + 3]); a = max3f(a, p1[r], p1[r + 1]); b = max3f(b, p1[r + 2], p1[r + 3]); }
    float pmax = __builtin_fmaxf(a, b);
    { auto rr = __builtin_amdgcn_permlane32_swap(__float_as_uint(pmax), __float_as_uint(pmax), false, false);
      pmax = __builtin_fmaxf(__uint_as_float(rr[0]), __uint_as_float(rr[1])); }
    alpha = 1.f;
    if (__builtin_expect(first || __any(pmax > THR2), 0)) {
        const float dl = first ? pmax : __builtin_fmaxf(pmax, 0.f);
        m_reg += dl; alpha = first ? 1.f : __builtin_amdgcn_exp2f(-dl);
#pragma unroll
        for (int r = 0; r < 16; ++r) { p0[r] -= dl; p1[r] -= dl; }
    }
#pragma unroll
    for (int r = 0; r < 16; ++r) p0[r] = __builtin_amdgcn_exp2f(p0[r]);
}
__device__ __forceinline__ void finishSM(f32x16& p0, f32x16& p1, float alpha, float& l_reg, bf16x8& pa0, bf16x8& pa1, bf16x8& pa2, bf16x8& pa3) {
#pragma unroll
    for (int r = 0; r < 16; ++r) p1[r] = __builtin_amdgcn_exp2f(p1[r]);
    float ps = 0;
#pragma unroll
    for (int r = 0; r < 16; ++r) ps += p0[r];
#pragma unroll
    for (int r = 0; r < 16; ++r) ps += p1[r];
    { auto rr = __builtin_amdgcn_permlane32_swap(__float_as_uint(ps), __float_as_uint(ps), false, false);
      ps = __uint_as_float(rr[0]) + __uint_as_float(rr[1]); }
    l_reg = l_reg * alpha + ps;
#define PK4(P, BASE, OUT) do { u32x4 w = {cvtpk(P[BASE + 0], P[BASE + 1]), cvtpk(P[BASE + 2], P[BASE + 3]), cvtpk(P[BASE + 4], P[BASE + 5]), cvtpk(P[BASE + 6], P[BASE + 7])}; OUT = *reinterpret_cast<bf16x8*>(&w); } while (0)
    PK4(p0, 0, pa0); PK4(p0, 8, pa1); PK4(p1, 0, pa2); PK4(p1, 8, pa3);
#undef PK4
}
template <int NQ, int KROW> __device__ __forceinline__ void qkt(f32x16& p0, f32x16& p1, const char* Ks, const bf16x8* qr, float m_ref, int r32, int hi) {
    f32x16 negm;
#pragma unroll
    for (int r = 0; r < 16; ++r) negm[r] = -m_ref;
    p0 = negm; p1 = negm;
#pragma unroll
    for (int d0 = 0; d0 < NQ; ++d0) { const int cb = d0 * 32 + hi * 16;
        const bf16x8 b0 = *reinterpret_cast<const bf16x8*>(Ks + r32 * KROW + cb);
        const bf16x8 b1 = *reinterpret_cast<const bf16x8*>(Ks + (32 + r32) * KROW + cb);
        p0 = __builtin_amdgcn_mfma_f32_32x32x16_bf16(b0, qr[d0], p0, 0, 0, 0);
        p1 = __builtin_amdgcn_mfma_f32_32x32x16_bf16(b1, qr[d0], p1, 0, 0, 0); }
}
template <int NC> __device__ __forceinline__ int v_st(int k, int c) { const int kk = k; return ((kk >> 3) * NC + (c >> 5)) * 512 + ((kk & 7) * 32 + (c & 31)) * 2; }
__device__ __forceinline__ int v_rd_base(int lane) { return ((lane & 3) << 3) | (((lane >> 2) & 3) << 6) | (((lane >> 4) & 1) << 5) | (((lane >> 5) & 1) << 8); }
template <int OFF> __device__ __forceinline__ s16x4 tr_read(int vb) {
    s16x4 r; asm volatile("ds_read_b64_tr_b16 %0, %1 offset:%2" : "=&v"(r) : "v"(vb), "i"(OFF) : "memory"); return r;
}
template <int NC, int D0> __device__ __forceinline__ void pv_one(f32x16& od, int vb, bf16x8 pa0, bf16x8 pa1, bf16x8 pa2, bf16x8 pa3) {
#define VOFF(ks, half) (D0 * 512 + (ks) * (NC * 1024) + (half) * (NC * 512))
    const s16x4 l0 = tr_read<VOFF(0, 0)>(vb), h0 = tr_read<VOFF(0, 1)>(vb), l1 = tr_read<VOFF(1, 0)>(vb), h1 = tr_read<VOFF(1, 1)>(vb);
    const s16x4 l2 = tr_read<VOFF(2, 0)>(vb), h2 = tr_read<VOFF(2, 1)>(vb), l3 = tr_read<VOFF(3, 0)>(vb), h3 = tr_read<VOFF(3, 1)>(vb);
#undef VOFF
    asm volatile("s_waitcnt lgkmcnt(0)" ::: "memory"); SBAR();
#define PK(L, H) (bf16x8){L[0], L[1], L[2], L[3], H[0], H[1], H[2], H[3]}
    od = __builtin_amdgcn_mfma_f32_32x32x16_bf16(pa0, PK(l0, h0), od, 0, 0, 0);
    od = __builtin_amdgcn_mfma_f32_32x32x16_bf16(pa1, PK(l1, h1), od, 0, 0, 0);
    od = __builtin_amdgcn_mfma_f32_32x32x16_bf16(pa2, PK(l2, h2), od, 0, 0, 0);
    od = __builtin_amdgcn_mfma_f32_32x32x16_bf16(pa3, PK(l3, h3), od, 0, 0, 0);
#undef PK
}
template <int NC> __device__ __forceinline__ void pv_all(f32x16* o, int vb, bf16x8 pa0, bf16x8 pa1, bf16x8 pa2, bf16x8 pa3) {
    pv_one<NC, 0>(o[0], vb, pa0, pa1, pa2, pa3); pv_one<NC, 1>(o[1], vb, pa0, pa1, pa2, pa3);
    if constexpr (NC == 4) { pv_one<NC, 2>(o[2], vb, pa0, pa1, pa2, pa3); pv_one<NC, 3>(o[3], vb, pa0, pa1, pa2, pa3); }
}
template <int MODE> constexpr int lds_bytes() { return 2 * 64 * Cfg<MODE>::DV * 2 + 2 * 64 * (Cfg<MODE>::DQK * 2 + 16) + 8 * 64 * 4; }

template <int MODE>
__device__ __forceinline__ void unit(const bf16* __restrict__ Qb, const bf16* __restrict__ K0, const bf16* __restrict__ K1, const bf16* __restrict__ Vh, void* Ob, int ldo, char* lds) {
    using C = Cfg<MODE>;
    constexpr int DQK = C::DQK, DV = C::DV, NQ = DQK / 16, NC = DV / 32, KROW = DQK * 2 + 16, SHM_K = 64 * KROW, SHM_V = 64 * DV * 2;
    const int tid = threadIdx.x, wid = tid >> 6, lane = tid & 63, r32 = lane & 31, hi = lane >> 5;
    char* V_lds = lds; char* K_lds = lds + 2 * SHM_V;
    float* ws = (float*)(lds + 2 * SHM_V + 2 * SHM_K) + wid * 64; float* li_l = ws; float* al_l = ws + 32;
    float m_reg = 0.f, l_reg = 0; f32x16 o[NC]; bf16x8 qr[NQ];
#pragma unroll
    for (int d = 0; d < NC; ++d) o[d] = f32x16{};
    const bf16* Qw = Qb + (size_t)(wid * 32 + r32) * C::LDQ + hi * 8;
#pragma unroll
    for (int d0 = 0; d0 < NQ; ++d0) qr[d0] = *reinterpret_cast<const bf16x8*>(Qw + d0 * 16);
    const int vb0 = (int)(uintptr_t)V_lds + v_rd_base(lane);
    const int kr0 = tid >> 3, kc0 = tid & 7;
    const int krr = (tid & 255) >> 2, krc = tid & 3;
    const int vr0 = MODE == 0 ? (tid >> 3) : (tid >> 4), vc0 = MODE == 0 ? (tid & 7) * 8 : (tid & 15) * 8;
    const int vst0 = v_st<NC>(vr0, vc0), vst1 = v_st<NC>(32 + vr0, vc0);
    constexpr int SDEPTH = 2;
    struct { bf16x8 ka, kb, va, vb; } sr_[SDEPTH];
#define SLOAD(i, k0) do { sr_[i].ka = *reinterpret_cast<const bf16x8*>(K0 + (size_t)((k0) + kr0) * C::LDK0 + kc0 * 8); \
        if (MODE == 0) { sr_[i].kb = *reinterpret_cast<const bf16x8*>(K1 + (size_t)((k0) + krr) * C::LDK1 + krc * 8); } \
        sr_[i].va = *reinterpret_cast<const bf16x8*>(Vh + (size_t)((k0) + vr0) * C::LDV + vc0); \
        if (MODE == 1) { sr_[i].vb = *reinterpret_cast<const bf16x8*>(Vh + (size_t)((k0) + 32 + vr0) * C::LDV + vc0); } } while (0)
#define SWRITE(b, i) do { *(bf16x8*)(K_lds + (b) * SHM_K + kr0 * KROW + kc0 * 16) = sr_[i].ka; \
        if (MODE == 0) { *(bf16x8*)(K_lds + (b) * SHM_K + krr * KROW + 128 + krc * 16) = sr_[i].kb; } \
        *(bf16x8*)(V_lds + (b) * SHM_V + vst0) = sr_[i].va; \
        if (MODE == 1) { *(bf16x8*)(V_lds + (b) * SHM_V + vst1) = sr_[i].vb; } } while (0)
#define SWAIT() asm volatile("s_waitcnt vmcnt(3)" ::: "memory")
#define RESC(a) do { if (__any((a) < 1.f)) { if (hi == 0) al_l[r32] = (a); asm volatile("s_waitcnt lgkmcnt(0)" ::: "memory"); \
        _Pragma("unroll") for (int d = 0; d < NC; ++d) _Pragma("unroll") for (int r = 0; r < 16; ++r) o[d][r] *= al_l[crow(r, hi)]; } } while (0)
    f32x16 pA0, pA1, pB0, pB1; float alA = 1.f, alB = 1.f; bf16x8 pa0, pa1, pa2, pa3; constexpr int NT = NTOK / 64;
    constexpr int SE = 0, SO = SDEPTH - 1;
    SLOAD(SE, 0); asm volatile("s_waitcnt vmcnt(0)" ::: "memory"); SWRITE(0, SE); __syncthreads();
    qkt<NQ, KROW>(pA0, pA1, K_lds, qr, m_reg, r32, hi); partialSM(pA0, pA1, m_reg, alA, true);
    SLOAD(SO, 64); if (SDEPTH == 2) SLOAD(SE, 128);
    SWAIT(); SWRITE(1, SO); __syncthreads();
    for (int j = 1; j + 1 < NT; j += 2) {
        SBAR(); qkt<NQ, KROW>(pB0, pB1, K_lds + SHM_K, qr, m_reg, r32, hi);
        finishSM(pA0, pA1, alA, l_reg, pa0, pa1, pa2, pa3); SBAR();
        SLOAD(SO, (j + SDEPTH) * 64); SBAR();
        pv_all<NC>(o, vb0, pa0, pa1, pa2, pa3); partialSM(pB0, pB1, m_reg, alB, false);
        __syncthreads(); SWAIT(); SWRITE(0, SE);
        RESC(alB); __syncthreads();
        SBAR(); qkt<NQ, KROW>(pA0, pA1, K_lds, qr, m_reg, r32, hi);
        finishSM(pB0, pB1, alB, l_reg, pa0, pa1, pa2, pa3); SBAR();
        if (SDEPTH == 1 || j + 3 < NT) SLOAD(SE, (j + 1 + SDEPTH) * 64); SBAR();
        pv_all<NC>(o, vb0 + SHM_V, pa0, pa1, pa2, pa3); partialSM(pA0, pA1, m_reg, alA, false);
        __syncthreads(); SWAIT(); SWRITE(1, SO);
        RESC(alA); __syncthreads();
    }
    SBAR(); qkt<NQ, KROW>(pB0, pB1, K_lds + SHM_K, qr, m_reg, r32, hi);
    finishSM(pA0, pA1, alA, l_reg, pa0, pa1, pa2, pa3); SBAR();
    pv_all<NC>(o, vb0, pa0, pa1, pa2, pa3); partialSM(pB0, pB1, m_reg, alB, false);
    __syncthreads(); RESC(alB);
    finishSM(pB0, pB1, alB, l_reg, pa0, pa1, pa2, pa3); SBAR();
    pv_all<NC>(o, vb0 + SHM_V, pa0, pa1, pa2, pa3);
    if (hi == 0) li_l[r32] = l_reg; asm volatile("s_waitcnt lgkmcnt(0)" ::: "memory");
    float rli[16];
#pragma unroll
    for (int r = 0; r < 16; ++r) rli[r] = __builtin_amdgcn_rcpf(li_l[crow(r, hi)]);
#pragma unroll
    for (int r = 0; r < 16; ++r) { const int orow = wid * 32 + crow(r, hi);
#pragma unroll
        for (int d0 = 0; d0 < NC; ++d0) {
            if (MODE == 0) ((bf16*)Ob)[(size_t)orow * ldo + d0 * 32 + r32] = (bf16)f2bf(o[d0][r] * rli[r]);
            else ((float*)Ob)[(size_t)orow * ldo + d0 * 32 + r32] = o[d0][r] * rli[r]; } }
    __syncthreads();
#undef SLOAD
#undef SWRITE
#undef SWAIT
#undef RESC
}
#undef SBAR
}

#define XB_TMO      128
#define XB_XCNT(j)  (256  + 64 * (j))
#define XB_XSUB(j)  (1280 + 64 * (j))
#define XB_XGEN(j)  (2304 + 64 * (j))
#define XB_TOP      3328
#define XB_TOPGEN   3392
#define XCD_BAR_WORDS 3456
#define XB_SPIN_CAP (1u << 20)
__device__ __forceinline__ unsigned xb_ld(unsigned* p)              { return __hip_atomic_load(p, __ATOMIC_RELAXED, __HIP_MEMORY_SCOPE_AGENT); }
__device__ __forceinline__ unsigned xb_add(unsigned* p, unsigned v) { return __hip_atomic_fetch_add(p, v, __ATOMIC_RELAXED, __HIP_MEMORY_SCOPE_AGENT); }
__device__ __forceinline__ unsigned xb_xcc_id() { return (unsigned)__builtin_amdgcn_s_getreg((3 << 11) | 20) & 0xFu; }
#define XB_SPIN(cond, bar) do { unsigned _sp = 0; while (cond) { __builtin_amdgcn_s_sleep(1); \
    if ((++_sp & 255u) == 0u) { if (xb_ld(&(bar)[XB_TMO])) break; if (_sp > XB_SPIN_CAP) { atomicAdd(&(bar)[XB_TMO], 1u); break; } } } } while (0)
struct XcdBarrier { unsigned* bar; unsigned x; volatile LAS unsigned* st; };
__device__ __forceinline__ XcdBarrier xcd_barrier_post(unsigned* bar, volatile LAS unsigned* st) {
    XcdBarrier b; b.bar = bar; b.x = xb_xcc_id(); b.st = st;
    if (threadIdx.x == 0) (void)xb_add(&bar[XB_XCNT(b.x)], 1u);
    return b;
}
__device__ __forceinline__ void xcd_barrier_complete(unsigned* bar, unsigned x, unsigned& nloc, unsigned& nx) {
    const unsigned G = gridDim.x * gridDim.y * gridDim.z;
    unsigned sum, cnt, mine, sp = 0u;
    for (;;) {
        sum = 0u; cnt = 0u; mine = 0u;
#pragma unroll
        for (unsigned j = 0; j < 16; ++j) { const unsigned c = xb_ld(&bar[XB_XCNT(j)]); sum += c; cnt += (c > 0u) ? 1u : 0u; mine = (j == x) ? c : mine; }
        if (sum == G) break;
        __builtin_amdgcn_s_sleep(1);
        if ((++sp & 255u) == 0u) { if (xb_ld(&bar[XB_TMO])) break; if (sp > XB_SPIN_CAP) { atomicAdd(&bar[XB_TMO], 1u); break; } }
    }
    nloc = mine > 0u ? mine : 1u; nx = cnt > 0u ? cnt : 1u;
}
__device__ __forceinline__ void xcd_barrier(const XcdBarrier& b) {
    asm volatile("s_waitcnt vmcnt(0)" ::: "memory");
    __syncthreads();
    if (threadIdx.x == 0) {
        unsigned* bar = b.bar;
        __builtin_amdgcn_s_waitcnt(0);
        unsigned nloc = b.st[0], nx = b.st[1];
        if (nloc == 0u) { xcd_barrier_complete(bar, b.x, nloc, nx); b.st[0] = nloc; b.st[1] = nx; }
        const unsigned old = xb_add(&bar[XB_XSUB(b.x)], 1u);
        const unsigned gen = old / nloc;
        if (old + 1u == (gen + 1u) * nloc) {
            __builtin_amdgcn_fence(__ATOMIC_RELEASE, "agent");
            asm volatile("s_waitcnt vmcnt(0)" ::: "memory");
            const unsigned og = xb_add(&bar[XB_TOP], 1u);
            const unsigned tg = og / nx;
            if (og + 1u == (tg + 1u) * nx) xb_add(&bar[XB_TOPGEN], 1u);
            else XB_SPIN(xb_ld(&bar[XB_TOPGEN]) == tg, bar);
            __builtin_amdgcn_fence(__ATOMIC_ACQUIRE, "agent");
            xb_add(&bar[XB_XGEN(b.x)], 1u);
            asm volatile("s_waitcnt vmcnt(0)" ::: "memory");
        } else {
            XB_SPIN(xb_ld(&bar[XB_XGEN(b.x)]) == gen, bar);
            __builtin_amdgcn_fence(__ATOMIC_ACQUIRE, "agent");
            asm volatile("s_waitcnt vmcnt(0)" ::: "memory");
        }
    }
    __syncthreads();
}

constexpr int NWAVES = 8;
constexpr int RING_BYTES = 131072, LDSCTL_OFF = RING_BYTES, MISC_OFF = LDSCTL_OFF + 320, UCACHE_OFF = RING_BYTES + 1024  , LDS_BYTES = 147456;
struct Frame {
    LAS unsigned char* lds; volatile LAS unsigned* MISC; unsigned* ctl;
    int tid, lane, wave, vcu, G;
    Ptrs P;
};

template <class SrcF> __device__ __forceinline__ void transpose_item(const SrcF& f, int K, bf16* WT, int p0, int k0, LAS float* scr, int lane) {
    float t[32];
#pragma unroll
    for (int i = 0; i < 32; ++i) t[i] = f(k0 + 2 * i + (lane >> 5), p0 + (lane & 31));
#pragma unroll
    for (int i = 0; i < 32; ++i) scr[(2 * i + (lane >> 5)) * 33 + (lane & 31)] = t[i];
    LDS_WAIT(); asm volatile("" ::: "memory");
    const int c = lane & 7;
#pragma unroll
    for (int j = 0; j < 4; ++j) { const int n = (lane >> 3) + 8 * j; const LAS float* s = scr + (8 * c) * 33 + n;
        u32x4 o; o.x = cvt_pk_bf16(s[0 * 33], s[1 * 33]); o.y = cvt_pk_bf16(s[2 * 33], s[3 * 33]); o.z = cvt_pk_bf16(s[4 * 33], s[5 * 33]); o.w = cvt_pk_bf16(s[6 * 33], s[7 * 33]);
        *(u32x4*)(WT + (size_t)(p0 + n) * K + k0 + 8 * c) = o; }
    LDS_WAIT(); asm volatile("" ::: "memory");
}
struct SrcWin { const float* w; __device__ float operator()(int k, int p) const { const int l = p1_logical(p); return l < 0 ? 0.f : w[(size_t)k * IN_COLS + l]; } };
struct SrcWup { const float *gq, *wuq, *gkv, *wukv;
    __device__ float operator()(int k, int p) const {
        if (p < 768) return k < 256 ? gq[k] * wuq[(size_t)k * 768 + qm_logical(p)] : 0.f;
        return k >= 256 ? gkv[k - 256] * wukv[(size_t)(k - 256) * 1024 + (p - 768)] : 0.f; } };
struct SrcPlain { const float* w; int N; int coff; __device__ float operator()(int k, int p) const { return w[(size_t)k * N + p + coff]; } };

__device__ __forceinline__ void ph0_prep(Frame& F) {
    LAS float* scr = (LAS float*)(F.lds + F.wave * 16384);
    const int gw = F.vcu * NWAVES + F.wave, NGW = F.G * NWAVES, lane = F.lane;
    const Ptrs& P = F.P; unsigned char* ws = P.ws;
    constexpr int I_IN = 16 * 64, I_UP = 6 * 56, I_OUT = 16 * 32, I_R = 16 * 8, I_SMALL = I_IN + I_UP + I_OUT + I_R;
    for (int it = gw; it < I_SMALL; it += NGW) {
        int r = it;
        if (r < I_IN) { transpose_item(SrcWin{P.in[8]}, 1024, (bf16*)(ws + WS_WIN), (r % 64) * 32, (r / 64) * 64, scr, lane); continue; } r -= I_IN;
        if (r < I_UP) { transpose_item(SrcWup{P.in[9], P.in[10], P.in[11], P.in[12]}, 384, (bf16*)(ws + WS_WUP), (r % 56) * 32, (r / 56) * 64, scr, lane); continue; } r -= I_UP;
        if (r < I_OUT) { transpose_item(SrcPlain{P.in[18], 1024, 0}, 1024, (bf16*)(ws + WS_WOUT), (r % 32) * 32, (r / 32) * 64, scr, lane); continue; } r -= I_OUT;
        transpose_item(SrcPlain{P.in[19], 256, 0}, 1024, (bf16*)(ws + WS_WR), (r % 8) * 32, (r / 8) * 64, scr, lane);
    }
    for (int it = gw; it < 96 * 16; it += NGW) {
        const int cg = it % 96, kp = it / 96;
#pragma unroll
        for (int r = 0; r < 5; ++r) { const float c = (r < 4 ? P.in[1] + r * DM : P.in[3])[kp * 64 + lane]; scr[r * 64 + lane] = c / (1.f + __expf(-c)); }
        LDS_WAIT(); asm volatile("" ::: "memory");
        float acc[5] = {0.f, 0.f, 0.f, 0.f, 0.f};
        const float* W = P.in[4] + (size_t)(kp * 64) * 6144 + cg * 64 + lane;
#pragma unroll 8
        for (int kk = 0; kk < 64; ++kk) { const float w = W[(size_t)kk * 6144];
#pragma unroll
            for (int r = 0; r < 5; ++r) acc[r] += scr[r * 64 + kk] * w; }
        LDS_WAIT(); asm volatile("" ::: "memory");
#pragma unroll
        for (int r = 0; r < 5; ++r) ((float*)(ws + WS_MODP))[(size_t)(kp * 5 + r) * 6144 + cg * 64 + lane] = acc[r];
    }
    { const int idx = (F.vcu * 512 + F.tid);
      if (idx < 1024) { const int v = idx / 16, f = idx % 16; const float th = (float)v * exp2f(-(float)f / 16.f * 13.287712379549449f);
          ((float2*)(ws + WS_TAB))[idx] = make_float2(__builtin_amdgcn_cosf(th * 0.15915494309189535f), __builtin_amdgcn_sinf(th * 0.15915494309189535f)); }
      else if (idx < 1536) { const int i2 = idx - 1024, v = i2 / 8, f = i2 % 8; const float th = (float)v * exp2f(-(float)f / 8.f * 13.287712379549449f);
          ((float2*)(ws + WS_TAB))[idx] = make_float2(__builtin_amdgcn_cosf(th * 0.15915494309189535f), __builtin_amdgcn_sinf(th * 0.15915494309189535f)); } }
}
struct CvItem { const float* src; int ld; bf16* dst; int K; };
__device__ __forceinline__ CvItem cv_decode(const Ptrs& P, int it, int lane) {
    constexpr int IPE = 256 + 128; unsigned char* ws = P.ws;
    const int e = it / IPE; int r = it % IPE; CvItem c;
    if (r < 256) { const int p0 = (r % 16) * 32, k0 = (r / 16) * 64, half = p0 >> 8, up = (p0 >> 7) & 1;
        const float* w = e < 256 ? (up ? P.in[22] : P.in[21]) + (size_t)e * DM * EFF : (up ? P.in[25] : P.in[24]);
        c.src = w + (size_t)(k0 + (lane >> 5)) * EFF + half * 128 + (p0 & 127) + (lane & 31); c.ld = EFF; c.K = 1024;
        c.dst = (bf16*)(ws + WS_W13) + ((size_t)e * 512 + p0) * 1024 + k0; }
    else { r -= 256; const int p0 = (r % 32) * 32, k0 = (r / 32) * 64;
        const float* w = e < 256 ? P.in[23] + (size_t)e * EFF * DM : P.in[26];
        c.src = w + (size_t)(k0 + (lane >> 5)) * DM + p0 + (lane & 31); c.ld = DM; c.K = 256;
        c.dst = (bf16*)(ws + WS_W2) + ((size_t)e * 1024 + p0) * 256 + k0; }
    return c;
}
#define CV_LOAD(t, c) do { _Pragma("unroll") for (int _i = 0; _i < 32; ++_i) t[_i] = (c).src[(size_t)(2 * _i) * (c).ld]; } while (0)
#define CV_FINISH(t, c) do { _Pragma("unroll") for (int _i = 0; _i < 32; ++_i) scr[(2 * _i + (lane >> 5)) * 33 + (lane & 31)] = t[_i]; \
        LDS_WAIT(); asm volatile("" ::: "memory"); const int _c = lane & 7; \
        _Pragma("unroll") for (int _j = 0; _j < 4; ++_j) { const int _n = (lane >> 3) + 8 * _j; const LAS float* _s = scr + (8 * _c) * 33 + _n; \
            u32x4 _o; _o.x = cvt_pk_bf16(_s[0 * 33], _s[1 * 33]); _o.y = cvt_pk_bf16(_s[2 * 33], _s[3 * 33]); _o.z = cvt_pk_bf16(_s[4 * 33], _s[5 * 33]); _o.w = cvt_pk_bf16(_s[6 * 33], _s[7 * 33]); \
            *(u32x4*)((c).dst + (size_t)_n * (c).K + 8 * _c) = _o; } \
        LDS_WAIT(); asm volatile("" ::: "memory"); } while (0)
__device__ __forceinline__ void ph0_experts(Frame& F) {
    LAS float* scr = (LAS float*)(F.lds + F.wave * 16384);
    const int gw = F.vcu * NWAVES + F.wave, NGW = F.G * NWAVES, lane = F.lane, NIT = 257 * 384;
    const Ptrs& P = F.P;
    float ta[32], tb[32];
    int it = gw; CvItem ca, cb;
    if (it < NIT) { ca = cv_decode(P, it, lane); CV_LOAD(ta, ca); }
    for (; it < NIT; it += 2 * NGW) {
        const int it2 = it + NGW, it3 = it + 2 * NGW;
        if (it2 < NIT) { cb = cv_decode(P, it2, lane); CV_LOAD(tb, cb); }
        CV_FINISH(ta, ca);
        if (it3 < NIT) { ca = cv_decode(P, it3, lane); CV_LOAD(ta, ca); }
        if (it2 < NIT) CV_FINISH(tb, cb);
    }
    __syncthreads();
}
#undef CV_LOAD
#undef CV_FINISH
__device__ __forceinline__ void ph1_xn(Frame& F) {
    const Ptrs& P = F.P; unsigned char* ws = P.ws;
    const float* MODP = (const float*)(ws + WS_MODP);
    for (int idx = F.vcu * 512 + F.tid; idx < 5 * 6144; idx += F.G * 512) { const int r = idx / 6144, j = idx % 6144; float a = P.in[5][j];
#pragma unroll
        for (int kp = 0; kp < 16; ++kp) a += MODP[(size_t)(kp * 5 + r) * 6144 + j];
        ((float*)(ws + WS_MOD))[idx] = a; }
    const int RPB = (MALL + F.G - 1) / F.G, r_lo = F.vcu * RPB, r_hi = min(MALL, r_lo + RPB);
    if (r_lo >= r_hi) return;
    const int b0 = r_lo / NTOK, b1 = (r_hi - 1) / NTOK;
    LAS float* sm = (LAS float*)F.lds;
    for (int i = F.tid; i < 3 * 2048; i += 512) { const int sl = i / 2048, j = i % 2048; const int r = sl == 0 ? b0 : sl == 1 ? b1 : 4; float a = P.in[5][j];
#pragma unroll
        for (int kp = 0; kp < 16; ++kp) a += MODP[(size_t)(kp * 5 + r) * 6144 + j];
        sm[i] = a; }
    __syncthreads();
    auto rowsrc = [&](int r) -> const f32x4* { const int b = r / NTOK, n = r % NTOK;
        return (const f32x4*)(n < NCTX ? P.in[2] + ((size_t)b * NCTX + n) * DM : P.in[0] + ((size_t)b * SEQ + (n - NCTX)) * DM) + F.lane; };
    f32x4 v[4], nv[4];
    { const int r = r_lo + F.wave; if (r < r_hi) { const f32x4* xr = rowsrc(r);
#pragma unroll
        for (int j = 0; j < 4; ++j) v[j] = xr[64 * j]; } }
    for (int r = r_lo + F.wave; r < r_hi; r += NWAVES) {
        const int b = r / NTOK, n = r % NTOK;
        { const int rn = r + NWAVES < r_hi ? r + NWAVES : r; const f32x4* xr = rowsrc(rn);
#pragma unroll
          for (int j = 0; j < 4; ++j) nv[j] = xr[64 * j]; }
        const LAS float* md = sm + (n < NCTX ? 2 : (b == b0 ? 0 : 1)) * 2048;
        float s = 0.f;
#pragma unroll
        for (int j = 0; j < 4; ++j) s += (v[j][0] * v[j][0] + v[j][1] * v[j][1]) + (v[j][2] * v[j][2] + v[j][3] * v[j][3]);
        const float rs = rsqrtf(wave_sum(s) * (1.f / DM) + EPS);
        u32x2* o8 = (u32x2*)((bf16*)(ws + WS_XN) + (size_t)r * DM) + F.lane;
#pragma unroll
        for (int j = 0; j < 4; ++j) { const int c = 4 * F.lane + 256 * j; const f32x4 g = *(const f32x4*)(P.in[6] + c);
            const f32x4 sh = *(const LAS f32x4*)(md + c), sc = *(const LAS f32x4*)(md + 1024 + c);
            const f32x4 y = (v[j] * rs * g) * (sc + 1.f) + sh;
            u32x2 w; w.x = cvt_pk_bf16(y[0], y[1]); w.y = cvt_pk_bf16(y[2], y[3]); o8[64 * j] = w; }
#pragma unroll
        for (int j = 0; j < 4; ++j) v[j] = nv[j];
    }
    __syncthreads();
}
__device__ __forceinline__ void ph6_h2(Frame& F) {
    const Ptrs& P = F.P; unsigned char* ws = P.ws;
    const int gw = F.vcu * NWAVES + F.wave, NGW = F.G * NWAVES;
    f32x4 v[4], nv[4];
    if (gw < MLAT) { const f32x4* xr = (const f32x4*)((const float*)(ws + WS_X1) + (size_t)gw * DM) + F.lane;
#pragma unroll
        for (int j = 0; j < 4; ++j) v[j] = xr[64 * j]; }
    for (int t = gw; t < MLAT; t += NGW) {
        const int b = t / SEQ; const float* md = (const float*)(ws + WS_MOD) + b * 6144;
        { const int tn = t + NGW < MLAT ? t + NGW : t; const f32x4* xr = (const f32x4*)((const float*)(ws + WS_X1) + (size_t)tn * DM) + F.lane;
#pragma unroll
          for (int j = 0; j < 4; ++j) nv[j] = xr[64 * j]; }
        float s = 0.f;
#pragma unroll
        for (int j = 0; j < 4; ++j) s += (v[j][0] * v[j][0] + v[j][1] * v[j][1]) + (v[j][2] * v[j][2] + v[j][3] * v[j][3]);
        const float rs = rsqrtf(wave_sum(s) * (1.f / DM) + EPS);
        u32x2* o8 = (u32x2*)((bf16*)(ws + WS_H2) + (size_t)t * DM) + F.lane;
#pragma unroll
        for (int j = 0; j < 4; ++j) { const int c = 4 * F.lane + 256 * j; const f32x4 g = *(const f32x4*)(P.in[7] + c);
            const f32x4 sh = *(const f32x4*)(md + 3072 + c), sc = *(const f32x4*)(md + 4096 + c);
            const f32x4 y = (v[j] * rs * g) * (sc + 1.f) + sh;
            u32x2 w; w.x = cvt_pk_bf16(y[0], y[1]); w.y = cvt_pk_bf16(y[2], y[3]); o8[64 * j] = w; }
#pragma unroll
        for (int j = 0; j < 4; ++j) v[j] = nv[j];
    }
}
__device__ __forceinline__ void ph7_route(Frame& F) {
    const Ptrs& P = F.P; unsigned char* ws = P.ws; const int lane = F.lane;
    const int gw = F.vcu * NWAVES + F.wave, NGW = F.G * NWAVES;
    const f32x4 bi = ((const f32x4*)P.in[20])[lane];
    for (int t = gw; t < MLAT; t += NGW) {
        f32x4 lg = ((const f32x4*)(ws + WS_LOGP))[(size_t)t * 64 + lane];
#pragma unroll
        for (int kp = 1; kp < 4; ++kp) lg += ((const f32x4*)(ws + WS_LOGP))[((size_t)kp * MLAT + t) * 64 + lane];
        float s[4], v[4];
#pragma unroll
        for (int i = 0; i < 4; ++i) { s[i] = 1.f / (1.f + __expf(-lg[i])); v[i] = s[i] + bi[i]; }
        float m1 = fmaxf(v[0], v[1]), m2 = fminf(v[0], v[1]);
#pragma unroll
        for (int i = 2; i < 4; ++i) { const float x = v[i]; m2 = fmaxf(m2, fminf(m1, x)); m1 = fmaxf(m1, x); }
#pragma unroll
        for (int o = 1; o < 8; o <<= 1) { const float b1 = __shfl_xor(m1, o), b2 = __shfl_xor(m2, o); const float n1 = fmaxf(m1, b1), n2 = fmaxf(fminf(m1, b1), fmaxf(m2, b2)); m1 = n1; m2 = n2; }
        const float gs = m1 + m2; const int g = lane >> 3; int rank = 0;
#pragma unroll
        for (int j = 0; j < 8; ++j) { const float o = __shfl(gs, j * 8); rank += (o > gs || (o == gs && j < g)) ? 1 : 0; }
        if (rank >= 4) { v[0] = v[1] = v[2] = v[3] = -INFINITY; }
        int my_e = 0; float my_s = 0.f, ssum = 0.f;
#pragma unroll
        for (int k = 0; k < 8; ++k) {
            float bv = v[0]; int bi_ = 0;
#pragma unroll
            for (int i = 1; i < 4; ++i) if (v[i] > bv) { bv = v[i]; bi_ = i; }
            int be = lane * 4 + bi_;
#pragma unroll
            for (int o = 1; o < 64; o <<= 1) { const float ov = __shfl_xor(bv, o); const int oe = __shfl_xor(be, o); if (ov > bv || (ov == bv && oe < be)) { bv = ov; be = oe; } }
            const int wl = be >> 2, wi = be & 3;
            float sv = wi == 0 ? s[0] : wi == 1 ? s[1] : wi == 2 ? s[2] : s[3];
            sv = __shfl(sv, wl);
            if (lane == wl) { if (wi == 0) v[0] = -INFINITY; else if (wi == 1) v[1] = -INFINITY; else if (wi == 2) v[2] = -INFINITY; else v[3] = -INFINITY; }
            ssum += sv; if (lane == k) { my_e = be; my_s = sv; }
        }
        if (lane < 8) {
            int* cnt = (int*)(ws + WS_CTL) + CW_COUNT;
            const int rk = atomicAdd(&cnt[my_e], 1);
            ((int*)(ws + WS_EIDX))[(size_t)t * 8 + lane] = my_e;
            ((float*)(ws + WS_EW))[(size_t)t * 8 + lane] = my_s / ssum * 2.5f;
            ((int*)(ws + WS_ERANK))[(size_t)t * 8 + lane] = rk;
        }
    }
}
__device__ __forceinline__ void ph8_slots(Frame& F) {
    const Ptrs& P = F.P; unsigned char* ws = P.ws;
    LAS int* off = (LAS int*)F.lds;
    LAS int* cst = off + 260;
    unsigned* cnt = (unsigned*)(ws + WS_CTL) + CW_COUNT;
    if (F.wave == 0) { const int lane = F.lane; int n[4], c[4], sn = 0, sc = 0;
#pragma unroll
        for (int i = 0; i < 4; ++i) { n[i] = (int)cnt[4 * lane + i]; c[i] = (n[i] + 255) >> 8; sn += n[i]; sc += c[i]; }
        int in = sn, ic = sc;
#pragma unroll
        for (int o = 1; o < 64; o <<= 1) { const int tn = __shfl_up(in, o), tc = __shfl_up(ic, o); if (lane >= o) { in += tn; ic += tc; } }
        int an = in - sn, ac = ic - sc;
#pragma unroll
        for (int i = 0; i < 4; ++i) { off[4 * lane + i] = an; cst[4 * lane + i] = ac; an += n[i]; ac += c[i]; }
        if (lane == 63) { off[256] = an; cst[256] = ac; off[257] = NSLOT; cst[257] = ac + MLAT / 256; } }
    __syncthreads();
    for (int idx = F.vcu * 512 + F.tid; idx < MLAT * 8; idx += F.G * 512) {
        const int e = ((const int*)(ws + WS_EIDX))[idx], rk = ((const int*)(ws + WS_ERANK))[idx];
        const int slot = off[e] + rk;
        ((int*)(ws + WS_SLOTOF))[idx] = slot; ((int*)(ws + WS_SLOTTOK))[slot] = idx >> 3; ((float*)(ws + WS_SLOTW))[slot] = ((const float*)(ws + WS_EW))[idx];
        if (idx < MLAT) { ((int*)(ws + WS_SLOTTOK))[MLAT * 8 + idx] = idx; ((float*)(ws + WS_SLOTW))[MLAT * 8 + idx] = 1.f; }
    }
    if (F.vcu == 0) {
        int* go = (int*)(ws + WS_OFF); int* ut = (int*)(ws + WS_UT);
        for (int e = F.tid; e < 258; e += 512) go[e] = off[e];
        for (int e = F.tid; e < 257; e += 512) { const int n = off[e + 1] - off[e], c0 = cst[e], nc = cst[e + 1] - c0;
            for (int j = 0; j < nc; ++j) { ut[(c0 + j) * 4 + 0] = e; ut[(c0 + j) * 4 + 1] = off[e] + j * 256; ut[(c0 + j) * 4 + 2] = min(256, n - j * 256); ut[(c0 + j) * 4 + 3] = 0; } }
        if (F.tid == 0) ((int*)(ws + WS_CTL))[CW_NUNIT] = cst[257];
    }
    __syncthreads();
}
__device__ __forceinline__ void ph11_combine(Frame& F) {
    const Ptrs& P = F.P; unsigned char* ws = P.ws; const int lane = F.lane;
    const int gw = F.vcu * NWAVES + F.wave, NGW = F.G * NWAVES;
    const unsigned char* Y = (const unsigned char*)(ws + WS_Y);
    const int cbase = 256 * (lane >> 4) + 32 * ((lane >> 2) & 3) + 8 * (lane & 3);
    u32x4 yw[9], nyw[9]; f32x4 xw[4], nxw[4]; int nsl[8];
    auto ldslots = [&](int t) {
#pragma unroll
        for (int k = 0; k < 8; ++k) nsl[k] = ((const int*)(ws + WS_SLOTOF))[(size_t)t * 8 + k]; };
    auto ldrows = [&](int t) {
#pragma unroll
        for (int k = 0; k < 9; ++k) { const int sl = k < 8 ? nsl[k] : MLAT * 8 + t; nyw[k] = *(const u32x4*)(Y + (size_t)sl * DM + lane * 16); }
#pragma unroll
        for (int q = 0; q < 4; ++q) nxw[q] = *(const f32x4*)((const float*)(ws + WS_X1) + (size_t)t * DM + cbase + (q >> 1) * 128 + (q & 1) * 4); };
    if (gw < MLAT) { ldslots(gw); ldrows(gw); if (gw + NGW < MLAT) ldslots(gw + NGW); }
    for (int t = gw; t < MLAT; t += NGW) {
        const int b = t / SEQ; const float* gt2 = (const float*)(ws + WS_MOD) + b * 6144 + 5120;
#pragma unroll
        for (int k = 0; k < 9; ++k) yw[k] = nyw[k];
#pragma unroll
        for (int q = 0; q < 4; ++q) xw[q] = nxw[q];
        if (t + NGW < MLAT) { ldrows(t + NGW); if (t + 2 * NGW < MLAT) ldslots(t + 2 * NGW); }
        float a[16];
#pragma unroll
        for (int i = 0; i < 16; ++i) a[i] = 0.f;
#pragma unroll
        for (int k = 0; k < 9; ++k)
#pragma unroll
            for (int d = 0; d < 4; ++d) { const int w = (int)yw[k][d];
                const f32x2 lo = __builtin_amdgcn_cvt_pk_f32_fp8(w, false), hi = __builtin_amdgcn_cvt_pk_f32_fp8(w, true);
                a[4 * d + 0] += lo[0]; a[4 * d + 1] += lo[1]; a[4 * d + 2] += hi[0]; a[4 * d + 3] += hi[1]; }
        float ss = 0.f;
#pragma unroll
        for (int q = 0; q < 4; ++q) { const int c = cbase + (q >> 1) * 128 + (q & 1) * 4; const f32x4 xv = xw[q], gv = *(const f32x4*)(gt2 + c);
#pragma unroll
            for (int e = 0; e < 4; ++e) { const float v = xv[e] + gv[e] * (a[q * 4 + e] * (1.f / YSCALE)); a[q * 4 + e] = v; ss += v * v; } }
        const float rs = rsqrtf(wave_sum(ss) * (1.f / DM) + EPS);
#pragma unroll
        for (int q = 0; q < 4; ++q) { const int c = cbase + (q >> 1) * 128 + (q & 1) * 4; const f32x4 gf = *(const f32x4*)(P.in[27] + c);
            f32x4 o;
#pragma unroll
            for (int e = 0; e < 4; ++e) o[e] = a[q * 4 + e] * rs * gf[e];
            *(f32x4*)(P.out + (size_t)t * DM + c) = o; }
    }
}
__device__ __forceinline__ void ph4b_diff_finish(Frame& F) {
    const Ptrs& P = F.P; unsigned char* ws = P.ws; const int lane = F.lane;
    const int gw = F.vcu * NWAVES + F.wave, NGW = F.G * NWAVES;
    float d1 = P.in[13][lane] * P.in[14][lane], d2 = P.in[15][lane] * P.in[16][lane];
    d1 = wave_sum(d1); d2 = wave_sum(d2);
    const float lam = __expf(d1) - __expf(d2) + LAM_INIT;
    const float g0 = P.in[17][lane], g1 = P.in[17][64 + lane];
    for (int t = gw; t < MLAT; t += NGW) {
        const float* os = (const float*)(ws + WS_OS) + (size_t)t * 8 * 128;
        float x[4][4];
#pragma unroll
        for (int h = 0; h < 4; ++h) { x[h][0] = os[(2 * h) * 128 + lane]; x[h][1] = os[(2 * h) * 128 + 64 + lane]; x[h][2] = os[(2 * h + 1) * 128 + lane]; x[h][3] = os[(2 * h + 1) * 128 + 64 + lane]; }
#pragma unroll
        for (int h = 0; h < 4; ++h) {
            const float v0 = x[h][0] - lam * x[h][2], v1 = x[h][1] - lam * x[h][3];
            const float rs = rsqrtf(wave_sum(v0 * v0 + v1 * v1) * (1.f / 128.f) + EPS) * (1.f - LAM_INIT);
            bf16* mo = (bf16*)(ws + WS_MIX) + (size_t)t * DM + 512 + h * 128;
            mo[lane] = (bf16)f2bf(v0 * rs * g0); mo[64 + lane] = (bf16)f2bf(v1 * rs * g1); }
    }
}

enum { P_PREP = 0, P_XN, P_INPROJ, P_UP, P_ATTN, P_DIFFFIN, P_OUT, P_H2, P_ROUTER, P_ROUTE, P_SLOTS, P_EXP1, P_EXP2, P_COMB, P_END };
struct Args { Ptrs P; int ph_lo, ph_hi, li, pad; };
__global__ void __launch_bounds__(NWAVES * 64, 2) mk_fwd(Args args) {
    extern __shared__ __attribute__((aligned(16))) unsigned char lds[];
    Frame F;
    F.lds = (LAS unsigned char*)lds; F.MISC = (volatile LAS unsigned*)(F.lds + MISC_OFF);
    F.tid = threadIdx.x; F.lane = F.tid & 63; F.wave = __builtin_amdgcn_readfirstlane(F.tid >> 6);
    F.G = gridDim.x; { const int bx = blockIdx.x; F.vcu = (F.G % 8 == 0) ? (bx % 8) * (F.G / 8) + bx / 8 : bx; }
    F.P = args.P; unsigned char* ws = args.P.ws; F.ctl = (unsigned*)(ws + WS_CTL);
    for (int u = F.tid; u < (LDS_BYTES - LDSCTL_OFF) / 4; u += NWAVES * 64) ((LAS unsigned*)(F.lds + LDSCTL_OFF))[u] = 0u;
    __syncthreads();
    XcdBarrier bar = xcd_barrier_post(F.ctl + CW_BAR + args.li * XCD_BAR_WORDS, F.MISC + 8);
    const int lo = args.ph_lo, hi = args.ph_hi;
#ifndef PHMASK
#define PHMASK 0xFFFF
#endif
#define IN(k) ((((PHMASK) >> (k)) & 1) && lo <= (k) && (k) < hi)
#define SEAM(k) do { if (IN(k) && IN((k) + 1)) xcd_barrier(bar); } while (0)
    if (IN(P_PREP)) { ph0_prep(F); } SEAM(P_PREP);
    if (IN(P_XN)) { ph1_xn(F); } SEAM(P_XN);
    if (IN(P_INPROJ)) {
        pg8::Gemm g{(const bf16*)(ws + WS_XN), (const bf16*)(ws + WS_WIN), 1024, 1024, 1024}; pg8::StaticOrder S; S.init(MALL, NP1, F.G, (int)blockIdx.x);
        EpiInProj E{(bf16*)(ws + WS_P1), (float*)(ws + WS_SSQ), (const float2*)(ws + WS_TAB), (const float2*)(ws + WS_TAB) + 1024};
        pg8::gemm_phase(F.lds, g, S, E);
    } SEAM(P_INPROJ);
    if (IN(P_UP)) {
        pg8::Gemm g{(const bf16*)(ws + WS_P1), (const bf16*)(ws + WS_WUP), 2048, 384, 256}; UpOrder S{F.G, F.vcu};
        EpiUp E{(bf16*)(ws + WS_QM), (bf16*)(ws + WS_KVM), (const float*)(ws + WS_SSQ), (const float2*)(ws + WS_TAB) + 1024};
        pg8::gemm_phase(F.lds, g, S, E);
    } SEAM(P_UP);
    if (IN(P_ATTN)) {
        const bf16* P1 = (const bf16*)(ws + WS_P1); const bf16* QM = (const bf16*)(ws + WS_QM); const bf16* KVM = (const bf16*)(ws + WS_KVM);
        const int cslot = F.vcu % 5; int ui = 0;
        bool conv_done = false;
        for (int U = F.vcu; U < 1024; U += F.G, ++ui) {
            if (ui == cslot) { ph0_experts(F); conv_done = true; }
            const int Up = U & 511, bh = Up >> 4, qb = Up & 15, b = bh >> 3, hh = bh & 7;
            if (U < 512) {
                const bf16* K0 = KVM + (size_t)b * NTOK * 1024 + hh * 128;
                attn::unit<0>(QM + (size_t)(b * NTOK + NCTX + qb * 256) * 768 + hh * 96, K0, P1 + (size_t)b * NTOK * NP1 + 384, K0 + 64,
                              (bf16*)(ws + WS_MIX) + (size_t)(b * SEQ + qb * 256) * DM + hh * 64, DM, (char*)lds);
            } else {
                const bf16* Pb = P1 + (size_t)b * NTOK * NP1;
                attn::unit<1>(P1 + (size_t)(b * NTOK + NCTX + qb * 256) * NP1 + 512 + hh * 64, Pb + 1024 + hh * 64, nullptr, Pb + 1536 + (hh >> 1) * 128,
                              (float*)(ws + WS_OS) + ((size_t)(b * SEQ + qb * 256) * 8 + hh) * 128, 1024, (char*)lds);
            }
        }
        if (!conv_done) ph0_experts(F);
    } SEAM(P_ATTN);
    if (IN(P_DIFFFIN)) { ph4b_diff_finish(F); } SEAM(P_DIFFFIN);
    if (IN(P_OUT)) {
        pg8::Gemm g{(const bf16*)(ws + WS_MIX), (const bf16*)(ws + WS_WOUT), 1024, 1024, 1024}; pg8::StaticOrder S; S.init(MLAT, DM, F.G, (int)blockIdx.x);
        EpiOut E{F.P.in[0], (const float*)(ws + WS_MOD), (float*)(ws + WS_X1)};
        pg8::gemm_phase(F.lds, g, S, E);
    } SEAM(P_OUT);
    if (IN(P_H2)) { ph6_h2(F); } SEAM(P_H2);
    if (IN(P_ROUTER)) {
        pg8::Gemm g{(const bf16*)(ws + WS_H2), (const bf16*)(ws + WS_WR), 1024, 1024, 256}; RouterOrder S{F.G, F.vcu};
        EpiLogP E{(float*)(ws + WS_LOGP)};
        pg8::gemm_phase(F.lds, g, S, E);
    } SEAM(P_ROUTER);
    if (IN(P_ROUTE)) { ph7_route(F); } SEAM(P_ROUTE);
    if (IN(P_SLOTS)) { ph8_slots(F); } SEAM(P_SLOTS);
    if (IN(P_EXP1)) {
        const int nu = (int)xb_ld(F.ctl + CW_NUNIT); LAS int* uc = (LAS int*)(F.lds + UCACHE_OFF);
        const int nmine = exp_units_to_lds<2>(uc, (const int*)(ws + WS_UT), nu * 2, F.G, F.vcu);
        pg8::Gemm g{(const bf16*)(ws + WS_H2), (const bf16*)(ws + WS_W13), 1024, 1024, 1024};
        ExpSched<2, true> S{uc, nmine, (const int*)(ws + WS_SLOTTOK)};
        EpiAct E{(bf16*)(ws + WS_ACT), (const float*)(ws + WS_SLOTW)};
        pg8::gemm_phase(F.lds, g, S, E);
    } SEAM(P_EXP1);
    if (IN(P_EXP2)) {
        const int nu = (int)xb_ld(F.ctl + CW_NUNIT); LAS int* uc = (LAS int*)(F.lds + UCACHE_OFF);
        const int nmine = exp_units_to_lds<4>(uc, (const int*)(ws + WS_UT), nu * 4, F.G, F.vcu);
        pg8::Gemm g{(const bf16*)(ws + WS_ACT), (const bf16*)(ws + WS_W2), 256, 256, 256};
        ExpSched<4, false> S{uc, nmine, nullptr};
        EpiY E{(unsigned char*)(ws + WS_Y)};
        pg8::gemm_phase(F.lds, g, S, E);
    } SEAM(P_EXP2);
    if (IN(P_COMB)) { ph11_combine(F); }
#undef IN
#undef SEAM
}

static int g_grid = 0;
static int mk_setup() {
    if (g_grid) return g_grid;
    int dev = 0, cus = 0;
    if (hipGetDevice(&dev) != hipSuccess || hipDeviceGetAttribute(&cus, hipDeviceAttributeMultiprocessorCount, dev) != hipSuccess) { fprintf(stderr, "kernel_launch: device query failed\n"); g_grid = -1; return -1; }
    if (hipFuncSetAttribute((const void*)mk_fwd, hipFuncAttributeMaxDynamicSharedMemorySize, LDS_BYTES) != hipSuccess) { fprintf(stderr, "kernel_launch: hipFuncSetAttribute failed\n"); g_grid = -1; return -1; }
    int per_cu = 0;
    if (hipOccupancyMaxActiveBlocksPerMultiprocessor(&per_cu, (const void*)mk_fwd, NWAVES * 64, LDS_BYTES) != hipSuccess || per_cu < 1) { fprintf(stderr, "kernel_launch: occupancy query says %d blocks/CU\n", per_cu); }
    (void)hipGetLastError();
    g_grid = cus;
    return g_grid;
}
static void mk_run(const Ptrs& P, int lo, int hi, int li, hipStream_t stream) {
    Args a{}; a.P = P; a.ph_lo = lo; a.ph_hi = hi; a.li = li; a.pad = 0;
    hipLaunchKernelGGL(mk_fwd, dim3(g_grid), dim3(NWAVES * 64), LDS_BYTES, stream, a);
}
extern "C" void kernel_launch(void* const* d_in, const int* in_sizes, int n_in, void* d_out, int out_size, void* d_ws, size_t ws_size, hipStream_t stream) {
    if (n_in != 28 || out_size != MLAT * DM || ws_size < WS_END) { fprintf(stderr, "kernel_launch: unexpected shapes n_in %d out %d ws %zu\n", n_in, out_size, ws_size); return; }
    if (mk_setup() <= 0) return;
    Ptrs P{}; for (int i = 0; i < 28; ++i) P.in[i] = (const float*)d_in[i]; P.out = (float*)d_out; P.ws = (unsigned char*)d_ws;
    (void)hipMemsetAsync((char*)d_ws + WS_CTL, 0, 1 * MiB, stream);
    int li = 0;
#define FAST(lo, hi) mk_run(P, lo, hi, li++, stream)
    FAST(P_PREP, P_COMB + 1);
#undef FAST
}
```

```cpp
#include <hip/hip_runtime.h>
#include <cstdio>
#include <cstdint>

constexpr int NB = 4, SEQ = 4096, NCTX = 256, NTOK = SEQ + NCTX, DM = 1024;
constexpr int MALL = NB * NTOK;
constexpr int MLAT = NB * SEQ;
constexpr int IN_COLS = 1952, NP1 = 2048;
constexpr int NEXP = 256, TOPK = 8, EFF = 256;
constexpr int NSLOT = MLAT * TOPK + MLAT;
constexpr float EPS = 1e-6f;
constexpr float LAM_INIT = 0.2f;

typedef unsigned short bf16;
__device__ __forceinline__ unsigned f2bf(float f) { unsigned u = __builtin_bit_cast(unsigned, f); return (u + 0x7fffu + ((u >> 16) & 1u)) >> 16; }
__device__ __forceinline__ float bf2f(bf16 h) { return __builtin_bit_cast(float, (unsigned)h << 16); }

constexpr size_t MiB = 1u << 20;
constexpr size_t WS_CTL = 0;
constexpr size_t WS_MOD = 3 * MiB;
constexpr size_t WS_TAB = 3 * MiB + 512 * 1024;
constexpr size_t WS_X1 = 402 * MiB;
constexpr size_t WS_SSQ = 466 * MiB;
constexpr size_t WS_EIDX = 467 * MiB;
constexpr size_t WS_EW = WS_EIDX + 512 * 1024;
constexpr size_t WS_ERANK = 468 * MiB;
constexpr size_t WS_SLOTOF = WS_ERANK + 512 * 1024;
constexpr size_t WS_SLOTTOK = 469 * MiB;
constexpr size_t WS_SLOTW = 470 * MiB;
constexpr size_t WS_OFF = 471 * MiB;
constexpr size_t WS_XN = 472 * MiB;
constexpr size_t WS_P1 = 506 * MiB;
constexpr size_t WS_QM = 574 * MiB;
constexpr size_t WS_KVM = 600 * MiB;
constexpr size_t WS_MIX = 634 * MiB;
constexpr size_t WS_OS = 666 * MiB;
constexpr size_t WS_TMP = 730 * MiB;
constexpr size_t WS_H2 = 472 * MiB;
constexpr size_t WS_H2F = 504 * MiB;
constexpr size_t WS_LOG = 568 * MiB;
constexpr size_t WS_ACT = 584 * MiB;
constexpr size_t WS_Y = 656 * MiB;
constexpr size_t WS_END = 944 * MiB;
constexpr int CW_COUNT = 1024;

__host__ __device__ __forceinline__ int perm32_log(int p) { return 16 * ((p >> 2) & 1) + 4 * (p >> 3) + (p & 3); }
__host__ __device__ __forceinline__ int perm64_log(int p) { return 32 * ((p >> 2) & 1) + 16 * (p >> 5) + 4 * ((p >> 3) & 3) + (p & 3); }
__host__ __device__ __forceinline__ int p1_logical(int p) {
    if (p < 384) return p;
    if (p < 416) return 384 + perm32_log(p - 384);
    if (p < 512) return -1;
    if (p < 1024) { int q = p - 512; return 416 + (q & ~63) + perm64_log(q & 63); }
    if (p < 1536) { int q = p - 1024; return 928 + (q & ~63) + perm64_log(q & 63); }
    return 1440 + (p - 1536);
}
__host__ __device__ __forceinline__ int qm_logical(int p) { int h = p / 96, r = p % 96; return h * 96 + (r < 64 ? r : 64 + perm32_log(r - 64)); }

struct Ptrs {
    const float* in[28]; float* out; unsigned char* ws;
};

__global__ void k_mod(Ptrs P) {
    int idx = blockIdx.x * 256 + threadIdx.x;
    if (idx < 5 * 6144) {
        int r = idx / 6144, j = idx % 6144;
        const float* cv = r < 4 ? P.in[1] + r * DM : P.in[3];
        const float* W = P.in[4];
        float acc = 0.f;
        for (int k = 0; k < DM; ++k) { float c = cv[k]; float s = c / (1.f + __expf(-c)); acc += s * W[(size_t)k * 6144 + j]; }
        ((float*)(P.ws + WS_MOD))[idx] = acc + P.in[5][j];
    }
    if (idx < 64 * 16) {
        int v = idx / 16, f = idx % 16;
        float inv = exp2f(-(float)f / 16.f * 13.287712379549449f);
        float th = (float)v * inv;
        float2 cs; cs.x = cosf(th); cs.y = sinf(th);
        ((float2*)(P.ws + WS_TAB))[idx] = cs;
    }
    if (idx < 64 * 8) {
        int v = idx / 8, f = idx % 8;
        float inv = exp2f(-(float)f / 8.f * 13.287712379549449f);
        float th = (float)v * inv;
        float2 cs; cs.x = cosf(th); cs.y = sinf(th);
        ((float2*)(P.ws + WS_TAB) + 1024)[idx] = cs;
    }
}

__global__ void k_xn(Ptrs P) {
    int r = blockIdx.x, b = r / NTOK, n = r % NTOK;
    const float* src = n < NCTX ? P.in[2] + ((size_t)b * NCTX + n) * DM : P.in[0] + ((size_t)b * SEQ + (n - NCTX)) * DM;
    const float* mod = (const float*)(P.ws + WS_MOD) + (n < NCTX ? 4 : b) * 6144;
    __shared__ float red[256];
    float v[4]; float ss = 0.f;
    for (int i = 0; i < 4; ++i) { v[i] = src[threadIdx.x + 256 * i]; ss += v[i] * v[i]; }
    red[threadIdx.x] = ss; __syncthreads();
    for (int o = 128; o > 0; o >>= 1) { if (threadIdx.x < o) red[threadIdx.x] += red[threadIdx.x + o]; __syncthreads(); }
    float rs = rsqrtf(red[0] / DM + EPS);
    bf16* dst = (bf16*)(P.ws + WS_XN) + (size_t)r * DM;
    for (int i = 0; i < 4; ++i) { int j = threadIdx.x + 256 * i; float y = v[i] * rs * P.in[6][j]; y = y * (1.f + mod[1024 + j]) + mod[j]; dst[j] = (bf16)f2bf(y); }
}

template <class F> __global__ __launch_bounds__(256) void k_gemm(F f, int N, int K) {
    __shared__ float As[16][65], Bs[16][65];
    const int z = blockIdx.z, bm = blockIdx.y * 64, bn = blockIdx.x * 64, tid = threadIdx.x, tx = tid & 15, ty = tid >> 4;
    const int rows = f.rows(z); if (bm >= rows) return;
    float acc[4][4] = {};
    for (int k0 = 0; k0 < K; k0 += 16) {
        for (int i = tid; i < 1024; i += 256) { int m = i >> 4, k = i & 15; As[k][m] = (bm + m < rows) ? f.a(z, bm + m, k0 + k) : 0.f; }
        for (int i = tid; i < 1024; i += 256) { int k = i >> 6, n = i & 63; Bs[k][n] = (bn + n < N) ? f.b(z, k0 + k, bn + n) : 0.f; }
        __syncthreads();
#pragma unroll
        for (int k = 0; k < 16; ++k) {
            float a[4], b[4];
#pragma unroll
            for (int i = 0; i < 4; ++i) { a[i] = As[k][ty * 4 + i]; b[i] = Bs[k][tx * 4 + i]; }
#pragma unroll
            for (int i = 0; i < 4; ++i)
#pragma unroll
                for (int j = 0; j < 4; ++j) acc[i][j] += a[i] * b[j];
        }
        __syncthreads();
    }
    for (int i = 0; i < 4; ++i) for (int j = 0; j < 4; ++j) { int m = bm + ty * 4 + i, n = bn + tx * 4 + j; if (m < rows && n < N) f.c(z, m, n, acc[i][j]); }
}

struct FIn { Ptrs P;
    __device__ int rows(int) const { return MALL; }
    __device__ float a(int, int m, int k) const { return bf2f(((const bf16*)(P.ws + WS_XN))[(size_t)m * DM + k]); }
    __device__ float b(int, int k, int n) const { int l = p1_logical(n); return l < 0 ? 0.f : bf2f((bf16)f2bf(P.in[8][(size_t)k * IN_COLS + l])); }
    __device__ void c(int, int m, int n, float v) const { ((float*)(P.ws + WS_TMP))[(size_t)m * NP1 + n] = v; }
};
__global__ void k_p1_finish(Ptrs P) {
    int r = blockIdx.x, n = r % NTOK;
    const float* t = (const float*)(P.ws + WS_TMP) + (size_t)r * NP1;
    bf16* o = (bf16*)(P.ws + WS_P1) + (size_t)r * NP1;
    float* ssq = (float*)(P.ws + WS_SSQ) + (size_t)r * 8;
    const float2* TD = (const float2*)(P.ws + WS_TAB); const float2* TM = TD + 1024;
    const bool lat = n >= NCTX; const int s = n - NCTX, gr = s >> 6, gc = s & 63;
    __shared__ float red[256];
    int tid = threadIdx.x;
    float v = t[tid]; red[tid] = v * v; __syncthreads();
    for (int oo = 128; oo > 0; oo >>= 1) { if (tid < oo) red[tid] += red[tid + oo]; __syncthreads(); }
    if (tid == 0) { ssq[0] = red[0]; ssq[1] = ssq[2] = ssq[3] = 0.f; }
    __syncthreads();
    float w = tid < 128 ? t[256 + tid] : 0.f; red[tid] = w * w; __syncthreads();
    for (int oo = 128; oo > 0; oo >>= 1) { if (tid < oo) red[tid] += red[tid + oo]; __syncthreads(); }
    if (tid == 0) { ssq[4] = red[0]; ssq[5] = ssq[6] = ssq[7] = 0.f; }
    for (int p = tid; p < NP1; p += 256) {
        float val = t[p];
        if (p >= 384 && p < 416) {
            int ph = p - 384, nn = (ph >> 2) & 1, i = 4 * (ph >> 3) + (ph & 3);
            float x1 = t[nn ? p - 4 : p], x2 = t[nn ? p : p + 4];
            float2 cs = lat ? TM[(i < 8 ? gr : gc) * 8 + (i & 7)] : make_float2(1.f, 0.f);
            val = nn ? x1 * cs.y + x2 * cs.x : x1 * cs.x - x2 * cs.y;
        } else if (p >= 512 && p < 1536) {
            int ph = (p - 512) & 63, nn = (ph >> 2) & 1, i = 16 * (ph >> 5) + 4 * ((ph >> 3) & 3) + (ph & 3);
            float x1 = t[nn ? p - 4 : p], x2 = t[nn ? p : p + 4];
            float2 cs = lat ? TD[(i < 16 ? gr : gc) * 16 + (i & 15)] : make_float2(1.f, 0.f);
            val = nn ? x1 * cs.y + x2 * cs.x : x1 * cs.x - x2 * cs.y;
        }
        o[p] = (bf16)f2bf(val);
    }
}
struct FUp { Ptrs P;
    __device__ int rows(int) const { return MALL; }
    __device__ float a(int, int m, int k) const { return bf2f(((const bf16*)(P.ws + WS_P1))[(size_t)m * NP1 + k]); }
    __device__ float b(int, int k, int n) const {
        if (n < 768) return k < 256 ? bf2f((bf16)f2bf(P.in[9][k] * P.in[10][(size_t)k * 768 + qm_logical(n)])) : 0.f;
        return k >= 256 ? bf2f((bf16)f2bf(P.in[11][k - 256] * P.in[12][(size_t)(k - 256) * 1024 + (n - 768)])) : 0.f; }
    __device__ void c(int, int m, int n, float v) const { ((float*)(P.ws + WS_TMP))[(size_t)m * NP1 + n] = v; }
};
__global__ void k_up_finish(Ptrs P) {
    int r = blockIdx.x, n = r % NTOK;
    const float* t = (const float*)(P.ws + WS_TMP) + (size_t)r * NP1;
    const float* ssq = (const float*)(P.ws + WS_SSQ) + (size_t)r * 8;
    const float rq = rsqrtf((ssq[0] + ssq[1] + ssq[2] + ssq[3]) / 256.f + EPS), rkv = rsqrtf((ssq[4] + ssq[5] + ssq[6] + ssq[7]) / 128.f + EPS);
    const float2* TM = (const float2*)(P.ws + WS_TAB) + 1024;
    const bool lat = n >= NCTX; const int s = n - NCTX, gr = s >> 6, gc = s & 63;
    bf16* qo = (bf16*)(P.ws + WS_QM) + (size_t)r * 768; bf16* kvo = (bf16*)(P.ws + WS_KVM) + (size_t)r * 1024;
    for (int p = threadIdx.x; p < 1792; p += 256) {
        if (p < 768) {
            int rr = p % 96; float val = t[p] * rq;
            if (rr >= 64) { int ph = rr - 64, nn = (ph >> 2) & 1, i = 4 * (ph >> 3) + (ph & 3);
                float x1 = t[nn ? p - 4 : p] * rq, x2 = t[nn ? p : p + 4] * rq;
                float2 cs = lat ? TM[(i < 8 ? gr : gc) * 8 + (i & 7)] : make_float2(1.f, 0.f);
                val = nn ? x1 * cs.y + x2 * cs.x : x1 * cs.x - x2 * cs.y; }
            qo[p] = (bf16)f2bf(val);
        } else kvo[p - 768] = (bf16)f2bf(t[p] * rkv);
    }
}

template <int MODE> __global__ __launch_bounds__(256) void k_attn(Ptrs P) {
    const int t = blockIdx.x * 256 + threadIdx.x;
    const int b = (blockIdx.x * 256) / SEQ, s = t % SEQ, hh = blockIdx.y, sl = blockIdx.z;
    const bf16* P1 = (const bf16*)(P.ws + WS_P1); const bf16* QM = (const bf16*)(P.ws + WS_QM); const bf16* KV = (const bf16*)(P.ws + WS_KVM);
    const size_t qrow = (size_t)b * NTOK + NCTX + s, k0row = (size_t)b * NTOK;
    constexpr int DQK = MODE == 0 ? 96 : 64;
    float q[DQK]; float o[64]; float m = -1e30f, l = 0.f;
    const float scale = MODE == 0 ? 0.10206207261596575f : 0.125f;
    if (MODE == 0) { _Pragma("unroll") for (int d = 0; d < 96; ++d) q[d] = bf2f(QM[qrow * 768 + hh * 96 + d]) * scale; }
    else { _Pragma("unroll") for (int d = 0; d < 64; ++d) q[d] = bf2f(P1[qrow * NP1 + 512 + hh * 64 + d]) * scale; }
    _Pragma("unroll") for (int d = 0; d < 64; ++d) o[d] = 0.f;
    for (int j = 0; j < NTOK; ++j) {
        const size_t kr = k0row + j; float sc = 0.f;
        if (MODE == 0) {
            const bf16* kn = KV + kr * 1024 + hh * 128; const bf16* kro = P1 + kr * NP1 + 384;
            _Pragma("unroll") for (int d = 0; d < 64; ++d) sc += q[d] * bf2f(kn[d]);
            _Pragma("unroll") for (int d = 0; d < 32; ++d) sc += q[64 + d] * bf2f(kro[d]);
        } else { const bf16* kk = P1 + kr * NP1 + 1024 + hh * 64; _Pragma("unroll") for (int d = 0; d < 64; ++d) sc += q[d] * bf2f(kk[d]); }
        float mn = fmaxf(m, sc), al = __expf(m - mn), p = __expf(sc - mn);
        l = l * al + p; m = mn;
        const bf16* vv = MODE == 0 ? KV + kr * 1024 + hh * 128 + 64 : P1 + kr * NP1 + 1536 + (hh >> 1) * 128 + sl * 64;
        _Pragma("unroll") for (int d = 0; d < 64; ++d) o[d] = o[d] * al + p * bf2f(vv[d]);
    }
    const float il = 1.f / l;
    if (MODE == 0) { bf16* mo = (bf16*)(P.ws + WS_MIX) + (size_t)t * DM + hh * 64; _Pragma("unroll") for (int d = 0; d < 64; ++d) mo[d] = (bf16)f2bf(o[d] * il); }
    else { float* oo = (float*)(P.ws + WS_OS) + ((size_t)t * 8 + hh) * 128 + sl * 64; _Pragma("unroll") for (int d = 0; d < 64; ++d) oo[d] = o[d] * il; }
}
__global__ void k_diff_finish(Ptrs P) {
    const int t = blockIdx.x, h = threadIdx.x >> 6  , lane = threadIdx.x & 63;
    float d1 = 0.f, d2 = 0.f; for (int i = 0; i < 64; ++i) { d1 += P.in[13][i] * P.in[14][i]; d2 += P.in[15][i] * P.in[16][i]; }
    const float lam = __expf(d1) - __expf(d2) + LAM_INIT;
    const float* os = (const float*)(P.ws + WS_OS) + ((size_t)t * 8 + 2 * h) * 128;
    float v0 = os[lane] - lam * os[128 + lane], v1 = os[64 + lane] - lam * os[128 + 64 + lane];
    float ss = v0 * v0 + v1 * v1;
    for (int o = 1; o < 64; o <<= 1) ss += __shfl_xor(ss, o);
    const float rs = rsqrtf(ss / 128.f + EPS) * (1.f - LAM_INIT);
    bf16* mo = (bf16*)(P.ws + WS_MIX) + (size_t)t * DM + 512 + h * 128;
    mo[lane] = (bf16)f2bf(v0 * rs * P.in[17][lane]); mo[64 + lane] = (bf16)f2bf(v1 * rs * P.in[17][64 + lane]);
}

struct FOut { Ptrs P;
    __device__ int rows(int) const { return MLAT; }
    __device__ float a(int, int m, int k) const { return bf2f(((const bf16*)(P.ws + WS_MIX))[(size_t)m * DM + k]); }
    __device__ float b(int, int k, int n) const { return bf2f((bf16)f2bf(P.in[18][(size_t)k * DM + n])); }
    __device__ void c(int, int m, int n, float v) const { const float* mod = (const float*)(P.ws + WS_MOD) + (m / SEQ) * 6144;
        ((float*)(P.ws + WS_X1))[(size_t)m * DM + n] = P.in[0][(size_t)m * DM + n] + mod[2048 + n] * v; }
};
__global__ void k_h2(Ptrs P) {
    int t = blockIdx.x, b = t / SEQ;
    const float* src = (const float*)(P.ws + WS_X1) + (size_t)t * DM;
    const float* mod = (const float*)(P.ws + WS_MOD) + b * 6144;
    __shared__ float red[256];
    float v[4]; float ss = 0.f;
    for (int i = 0; i < 4; ++i) { v[i] = src[threadIdx.x + 256 * i]; ss += v[i] * v[i]; }
    red[threadIdx.x] = ss; __syncthreads();
    for (int o = 128; o > 0; o >>= 1) { if (threadIdx.x < o) red[threadIdx.x] += red[threadIdx.x + o]; __syncthreads(); }
    float rs = rsqrtf(red[0] / DM + EPS);
    for (int i = 0; i < 4; ++i) { int j = threadIdx.x + 256 * i; float y = v[i] * rs * P.in[7][j]; y = y * (1.f + mod[4096 + j]) + mod[3072 + j];
        ((bf16*)(P.ws + WS_H2))[(size_t)t * DM + j] = (bf16)f2bf(y); ((float*)(P.ws + WS_H2F))[(size_t)t * DM + j] = y; }
}
struct FRouter { Ptrs P;
    __device__ int rows(int) const { return MLAT; }
    __device__ float a(int, int m, int k) const { return ((const float*)(P.ws + WS_H2F))[(size_t)m * DM + k]; }
    __device__ float b(int, int k, int n) const { return P.in[19][(size_t)k * NEXP + n]; }
    __device__ void c(int, int m, int n, float v) const { ((float*)(P.ws + WS_LOG))[(size_t)m * NEXP + n] = v; }
};
__global__ __launch_bounds__(256) void k_route(Ptrs P) {
    const int t = blockIdx.x * 4 + (threadIdx.x >> 6), lane = threadIdx.x & 63;
    const float4 lg = ((const float4*)(P.ws + WS_LOG))[(size_t)t * 64 + lane];
    const float4 bi = ((const float4*)P.in[20])[lane];
    float s[4] = {1.f / (1.f + __expf(-lg.x)), 1.f / (1.f + __expf(-lg.y)), 1.f / (1.f + __expf(-lg.z)), 1.f / (1.f + __expf(-lg.w))};
    float v[4] = {s[0] + bi.x, s[1] + bi.y, s[2] + bi.z, s[3] + bi.w};
    float m1 = fmaxf(v[0], v[1]), m2 = fminf(v[0], v[1]);
    for (int i = 2; i < 4; ++i) { float x = v[i]; m2 = fmaxf(m2, fminf(m1, x)); m1 = fmaxf(m1, x); }
    for (int o = 1; o < 8; o <<= 1) { float b1 = __shfl_xor(m1, o), b2 = __shfl_xor(m2, o); float n1 = fmaxf(m1, b1), n2 = fmaxf(fminf(m1, b1), fmaxf(m2, b2)); m1 = n1; m2 = n2; }
    const float gs = m1 + m2; const int g = lane >> 3; int rank = 0;
    for (int j = 0; j < 8; ++j) { float o = __shfl(gs, j * 8); rank += (o > gs || (o == gs && j < g)) ? 1 : 0; }
    if (rank >= 4) { v[0] = v[1] = v[2] = v[3] = -INFINITY; }
    int my_e = 0; float my_s = 0.f; float ssum = 0.f;
    for (int k = 0; k < 8; ++k) {
        float bv = v[0]; int bi_ = 0;
        for (int i = 1; i < 4; ++i) if (v[i] > bv) { bv = v[i]; bi_ = i; }
        int be = lane * 4 + bi_;
        for (int o = 1; o < 64; o <<= 1) { float ov = __shfl_xor(bv, o); int oe = __shfl_xor(be, o); if (ov > bv || (ov == bv && oe < be)) { bv = ov; be = oe; } }
        const int wl = be >> 2, wi = be & 3;
        float sv = wi == 0 ? s[0] : wi == 1 ? s[1] : wi == 2 ? s[2] : s[3];
        sv = __shfl(sv, wl);
        if (lane == wl) { if (wi == 0) v[0] = -INFINITY; else if (wi == 1) v[1] = -INFINITY; else if (wi == 2) v[2] = -INFINITY; else v[3] = -INFINITY; }
        ssum += sv; if (lane == k) { my_e = be; my_s = sv; }
    }
    if (lane < 8) {
        int* cnt = (int*)(P.ws + WS_CTL) + CW_COUNT;
        int rk = atomicAdd(&cnt[my_e], 1);
        ((int*)(P.ws + WS_EIDX))[(size_t)t * 8 + lane] = my_e;
        ((float*)(P.ws + WS_EW))[(size_t)t * 8 + lane] = my_s / ssum * 2.5f;
        ((int*)(P.ws + WS_ERANK))[(size_t)t * 8 + lane] = rk;
    }
}
__global__ __launch_bounds__(256) void k_slots(Ptrs P) {
    __shared__ int off[257];
    const int* cnt = (const int*)(P.ws + WS_CTL) + CW_COUNT;
    if (threadIdx.x == 0) { int a = 0; for (int e = 0; e < 256; ++e) { off[e] = a; a += cnt[e]; } off[256] = a; }
    __syncthreads();
    if (blockIdx.x == 0) { int* go = (int*)(P.ws + WS_OFF); go[threadIdx.x] = off[threadIdx.x]; if (threadIdx.x == 0) { go[256] = off[256]; go[257] = NSLOT; } }
    int idx = blockIdx.x * 256 + threadIdx.x;
    int e = ((const int*)(P.ws + WS_EIDX))[idx], rk = ((const int*)(P.ws + WS_ERANK))[idx];
    int slot = off[e] + rk;
    ((int*)(P.ws + WS_SLOTOF))[idx] = slot;
    ((int*)(P.ws + WS_SLOTTOK))[slot] = idx >> 3;
    ((float*)(P.ws + WS_SLOTW))[slot] = ((const float*)(P.ws + WS_EW))[idx];
    if (idx < MLAT) { ((int*)(P.ws + WS_SLOTTOK))[MLAT * 8 + idx] = idx; ((float*)(P.ws + WS_SLOTW))[MLAT * 8 + idx] = 1.f; }
}
__global__ __launch_bounds__(256) void k_exp1(Ptrs P) {
    const int z = blockIdx.z; const int* off = (const int*)(P.ws + WS_OFF); const int rows = off[z + 1] - off[z]; const int m0 = blockIdx.y * 16; if (m0 >= rows) return;
    const float* w1 = z < 256 ? P.in[21] + (size_t)z * DM * EFF : P.in[24]; const float* w3 = z < 256 ? P.in[22] + (size_t)z * DM * EFF : P.in[25];
    __shared__ float hs[16][DM];
    for (int i = threadIdx.x; i < 16 * DM; i += 256) { int m = i / DM, k = i % DM; int slot = off[z] + m0 + m; hs[m][k] = (m0 + m < rows) ? bf2f(((const bf16*)(P.ws + WS_H2))[(size_t)((const int*)(P.ws + WS_SLOTTOK))[slot] * DM + k]) : 0.f; }
    __syncthreads();
    const int n = threadIdx.x; float g[16] = {}, u[16] = {};
    for (int k = 0; k < DM; ++k) { float a = bf2f((bf16)f2bf(w1[(size_t)k * EFF + n])), b = bf2f((bf16)f2bf(w3[(size_t)k * EFF + n]));
#pragma unroll
        for (int m = 0; m < 16; ++m) { g[m] += hs[m][k] * a; u[m] += hs[m][k] * b; } }
    for (int m = 0; m < 16; ++m) if (m0 + m < rows) { float gg = g[m]; float act = gg / (1.f + __expf(-gg)) * u[m]; ((bf16*)(P.ws + WS_ACT))[(size_t)(off[z] + m0 + m) * EFF + n] = (bf16)f2bf(act); }
}
struct FExp2 { Ptrs P;
    __device__ int rows(int z) const { const int* off = (const int*)(P.ws + WS_OFF); return off[z + 1] - off[z]; }
    __device__ float a(int z, int m, int k) const { const int* off = (const int*)(P.ws + WS_OFF); return bf2f(((const bf16*)(P.ws + WS_ACT))[(size_t)(off[z] + m) * EFF + k]); }
    __device__ float b(int z, int k, int n) const { const float* w = z < 256 ? P.in[23] + (size_t)z * EFF * DM : P.in[26]; return bf2f((bf16)f2bf(w[(size_t)k * DM + n])); }
    __device__ void c(int z, int m, int n, float v) const { const int* off = (const int*)(P.ws + WS_OFF); size_t slot = off[z] + m;
        ((bf16*)(P.ws + WS_Y))[slot * DM + n] = (bf16)f2bf(v * ((const float*)(P.ws + WS_SLOTW))[slot]); }
};
__global__ void k_combine(Ptrs P) {
    int t = blockIdx.x, b = t / SEQ;
    const float* x1 = (const float*)(P.ws + WS_X1) + (size_t)t * DM;
    const float* mod = (const float*)(P.ws + WS_MOD) + b * 6144;
    const bf16* Y = (const bf16*)(P.ws + WS_Y); const int* so = (const int*)(P.ws + WS_SLOTOF) + (size_t)t * 8;
    __shared__ float red[256];
    float v[4]; float ss = 0.f;
    for (int i = 0; i < 4; ++i) { int j = threadIdx.x + 256 * i; float a = bf2f(Y[(size_t)(MLAT * 8 + t) * DM + j]);
        for (int k = 0; k < 8; ++k) a += bf2f(Y[(size_t)so[k] * DM + j]);
        v[i] = x1[j] + mod[5120 + j] * a; ss += v[i] * v[i]; }
    red[threadIdx.x] = ss; __syncthreads();
    for (int o = 128; o > 0; o >>= 1) { if (threadIdx.x < o) red[threadIdx.x] += red[threadIdx.x + o]; __syncthreads(); }
    float rs = rsqrtf(red[0] / DM + EPS);
    for (int i = 0; i < 4; ++i) { int j = threadIdx.x + 256 * i; P.out[(size_t)t * DM + j] = v[i] * rs * P.in[27][j]; }
}

#define GAS __attribute__((address_space(1)))
#define LAS __attribute__((address_space(3)))
typedef short bf16x8 __attribute__((ext_vector_type(8)));
typedef short s16x4 __attribute__((ext_vector_type(4)));
typedef float f32x4 __attribute__((ext_vector_type(4)));
typedef float f32x2 __attribute__((ext_vector_type(2)));
typedef float f32x16 __attribute__((ext_vector_type(16)));
typedef float f32x8 __attribute__((ext_vector_type(8)));
typedef unsigned u32x4 __attribute__((ext_vector_type(4)));
typedef unsigned u32x2 __attribute__((ext_vector_type(2)));
#define RLX_AGENT __ATOMIC_RELAXED, __HIP_MEMORY_SCOPE_AGENT
#define LDS_WAIT() asm volatile("s_waitcnt lgkmcnt(0)" ::: "memory")
#define VM_WAIT() asm volatile("s_waitcnt vmcnt(0)" ::: "memory")

constexpr size_t WS_MODP = 1 * MiB;
constexpr size_t WS_WIN = 4 * MiB;
constexpr size_t WS_WUP = 8 * MiB;
constexpr size_t WS_WOUT = 10 * MiB;
constexpr size_t WS_WR = 12 * MiB;
constexpr size_t WS_W13 = 16 * MiB;
constexpr size_t WS_W2 = 273 * MiB;
constexpr size_t WS_UT = WS_OFF + 4096;
static_assert(WS_W2 + (size_t)257 * 1024 * 256 * 2 <= WS_X1, "ws map");
constexpr size_t WS_LOGP = WS_Y;
constexpr int CW_NUNIT = 2048;
constexpr int CW_NFULL = 2049;
constexpr int CW_BAR = 4096;

__device__ __forceinline__ unsigned cvt_pk_bf16(float lo, float hi) { unsigned r; asm volatile("v_cvt_pk_bf16_f32 %0, %1, %2" : "=v"(r) : "v"(lo), "v"(hi)); return r; }
__device__ __forceinline__ unsigned pk2(float lo, float hi) { return f2bf(lo) | (f2bf(hi) << 16); }
__device__ __forceinline__ u32x4 pack8(f32x4 a, f32x4 b) { u32x4 w; w.x = cvt_pk_bf16(a[0], a[1]); w.y = cvt_pk_bf16(a[2], a[3]); w.z = cvt_pk_bf16(b[0], b[1]); w.w = cvt_pk_bf16(b[2], b[3]); return w; }
__device__ __forceinline__ float bflo(unsigned w) { return __builtin_bit_cast(float, w << 16); }
__device__ __forceinline__ float bfhi(unsigned w) { return __builtin_bit_cast(float, w & 0xffff0000u); }
__device__ __forceinline__ float wave_sum(float v) {
#pragma unroll
    for (int o = 1; o < 64; o <<= 1) v += __shfl_xor(v, o);
    return v;
}

namespace pg8 {
constexpr int BM = 256, BK = 64, HALF = 128, HTB = HALF * BK * 2, STAGE_BYTES = 8 * HTB;
__host__ __device__ __forceinline__ int lds_byte(int r, int c) { const int st = (r >> 4) * 2 + (c >> 5), rr = r & 15, cc = c & 31, ob = rr * 64 + cc * 2; return st * 1024 + (ob ^ (((ob >> 9) & 1) << 5)); }
__host__ __device__ __forceinline__ void stage_rc(int b, int& R, int& C) { const int st = b / 1024, sb = b % 1024, swz = sb ^ (((sb >> 9) & 1) << 5); R = (st >> 1) * 16 + swz / 64; C = (st & 1) * 32 + (swz % 64) / 2; }
__host__ __device__ __forceinline__ int perm32(int rho) { const int n = rho >> 4, i = rho & 15; return 8 * (i >> 2) + 4 * n + (i & 3); }

struct Unit { int pm, pn, r0, nv, k0; };
struct Gemm { const bf16* A; const bf16* Bt; int lda, ldb, K; };

struct StaticOrder {
    int nM, nN, nwg, G, c;
    __device__ void init(int M, int N, int G_, int c_) { nM = M / BM; nN = N / BM; nwg = nM * nN; G = G_; c = c_; }
    __device__ bool next(int i, Unit& u) const {
        const long L = (long)i * G + c; if (L >= nwg) return false;
        int wgid = (int)L; { const int q = nwg / 8, r = nwg % 8, xcd = wgid % 8, off = wgid / 8; wgid = (xcd < r ? xcd * (q + 1) : r * (q + 1) + (xcd - r) * q) + off; }
        const int nig = 8 * nN, gid = wgid / nig, fm = gid * 8, gsz = (nM - fm) < 8 ? (nM - fm) : 8;
        u.pm = fm + ((wgid % nig) % gsz); u.pn = (wgid % nig) / gsz; u.r0 = u.pm * BM; u.nv = BM; u.k0 = 0; return true;
    }
    __device__ __forceinline__ int a_row(const Unit& u, int r) const { return u.pm * BM + r; }
};

template <class Epi, class Sched>
__device__ __forceinline__ void gemm_phase(LAS unsigned char* lds, const Gemm g, const Sched& S, const Epi& E) {
    const int tid = threadIdx.x, wid = __builtin_amdgcn_readfirstlane(tid >> 6), lane = tid & 63, wr = wid >> 2, wc = wid & 3, fr = lane & 15, fq = lane >> 4;
    int K = g.K; asm volatile("" : "+s"(K));
    const int nt = K / BK;
    int RA[2], CA[2]; unsigned voffB[2];
#pragma unroll
    for (int i = 0; i < 2; ++i) { int R, C; stage_rc(tid * 16 + i * 8192, R, C); RA[i] = R; CA[i] = C; const int Rb = Epi::PERM ? ((R & ~31) + perm32(R & 31)) : R; voffB[i] = (unsigned)(Rb * g.ldb + C) * 2u; }
    const size_t kstep = (size_t)(BK * 2);
    const size_t hstepB = (size_t)HALF * g.ldb * 2, tstepB = 2 * hstepB;
    const unsigned ldsw = (unsigned)wid * 1024u;
    const int aoff = lds_byte(wr * 64 + fr, fq * 8), boff = lds_byte(wc * 32 + fr, fq * 8);
#define PG8_SA(b, h) (((b) * 2 + (h)) * HTB)
#define PG8_SB(b, h) ((4 + (b) * 2 + (h)) * HTB)
#define PG8_STAGE(bufoff, gbase, voff) do { _Pragma("unroll") for (int _i = 0; _i < 2; ++_i) \
        __builtin_amdgcn_global_load_lds((const unsigned*)((const char*)(gbase) + (voff)[_i]), (LAS unsigned*)(lds + (bufoff) + ldsw + _i * 8192), 16, 0, 0); } while (0)
#define PG8_LDA(dst, b, h) do { _Pragma("unroll") for (int m = 0; m < 4; ++m) _Pragma("unroll") for (int k = 0; k < 2; ++k) dst[m][k] = *(const LAS bf16x8*)(lds + PG8_SA(b, h) + aoff + m * 2048 + k * 1024); } while (0)
#define PG8_LDB(dst, b, h) do { _Pragma("unroll") for (int n = 0; n < 2; ++n) _Pragma("unroll") for (int k = 0; k < 2; ++k) dst[n][k] = *(const LAS bf16x8*)(lds + PG8_SB(b, h) + boff + n * 2048 + k * 1024); } while (0)
#define PG8_MMA(ai, bj, At, Bt) do { __builtin_amdgcn_s_setprio(1); _Pragma("unroll") for (int m = 0; m < 4; ++m) _Pragma("unroll") for (int n = 0; n < 2; ++n) _Pragma("unroll") for (int k = 0; k < 2; ++k) \
        acc[ai][bj][m][n] = __builtin_amdgcn_mfma_f32_16x16x32_bf16(Bt[n][k], At[m][k], acc[ai][bj][m][n], 0, 0, 0); __builtin_amdgcn_s_setprio(0); } while (0)
#define PG8_WAIT_V(n) asm volatile("s_waitcnt vmcnt(" #n ")" ::: "memory")
#define PG8_WAIT_L(n) asm volatile("s_waitcnt lgkmcnt(" #n ")" ::: "memory")
#define PG8_BAR __builtin_amdgcn_s_barrier()
#define PG8_SCHED __builtin_amdgcn_sched_barrier(0)
#define PG8_AOFFS(dst, u) do { _Pragma("unroll") for (int _h = 0; _h < 2; ++_h) _Pragma("unroll") for (int _i = 0; _i < 2; ++_i) \
        dst[_h][_i] = (unsigned)(((size_t)S.a_row(u, _h * HALF + RA[_i]) * (size_t)g.lda + (size_t)(CA[_i] + (u).k0)) * 2u); } while (0)
    Unit cur, nxt; int ui = 0;
    if (!S.next(0, cur)) return;
    f32x4 acc[2][2][4][2];
#pragma unroll
    for (int a = 0; a < 2; ++a)
#pragma unroll
        for (int b = 0; b < 2; ++b)
#pragma unroll
            for (int m = 0; m < 4; ++m)
#pragma unroll
                for (int n = 0; n < 2; ++n) acc[a][b][m][n] = (f32x4){0.f, 0.f, 0.f, 0.f};
    bf16x8 At[4][2], B0[2][2], B1[2][2];
    unsigned vA[2][2], vN[2][2];
    PG8_AOFFS(vA, cur);
    const char* Ab = (const char*)g.A; const char* cB = (const char*)g.Bt + (size_t)cur.pn * tstepB + (size_t)cur.k0 * 2;
    PG8_STAGE(PG8_SB(0, 0), cB, voffB); PG8_STAGE(PG8_SB(0, 1), cB + hstepB, voffB); PG8_STAGE(PG8_SA(0, 0), Ab, vA[0]); PG8_STAGE(PG8_SA(0, 1), Ab, vA[1]);
    if (wr == 1) PG8_BAR;
    PG8_WAIT_V(2); PG8_BAR;
    PG8_STAGE(PG8_SB(1, 0), cB + kstep, voffB); PG8_STAGE(PG8_SA(1, 0), Ab + kstep, vA[0]); PG8_STAGE(PG8_SB(1, 1), cB + hstepB + kstep, voffB);
    PG8_WAIT_V(6); PG8_BAR;
    for (;;) {
        const bool has_next = S.next(ui + 1, nxt);
        const char* nB = has_next ? (const char*)g.Bt + (size_t)nxt.pn * tstepB + (size_t)nxt.k0 * 2 : cB;
        if (has_next) { PG8_AOFFS(vN, nxt); } else { vN[0][0] = vA[0][0]; vN[0][1] = vA[0][1]; vN[1][0] = vA[1][0]; vN[1][1] = vA[1][1]; }
        for (int t = 0; t < nt; t += 2) {
            const bool last = (t == nt - 2); const bool full = cur.nv > HALF;
            const char* a1 = Ab + (size_t)(t + 1) * kstep;
            const char* a2 = Ab + (last ? (size_t)0 : (size_t)(t + 2) * kstep); const char* b2 = last ? nB : cB + (size_t)(t + 2) * kstep;
            const char* a3 = a2 + kstep; const char* b3 = b2 + kstep;
            unsigned w0[2], w1[2];
            w0[0] = last ? vN[0][0] : vA[0][0]; w0[1] = last ? vN[0][1] : vA[0][1]; w1[0] = last ? vN[1][0] : vA[1][0]; w1[1] = last ? vN[1][1] : vA[1][1];
            PG8_LDB(B0, 0, 0); PG8_LDB(B1, 0, 1); PG8_SCHED; PG8_LDA(At, 0, 0); PG8_STAGE(PG8_SA(1, 1), a1, vA[1]);
            PG8_WAIT_V(8); PG8_WAIT_L(0); PG8_BAR; PG8_MMA(0, 0, At, B0); PG8_MMA(0, 1, At, B1); PG8_BAR; PG8_SCHED;
            PG8_LDA(At, 0, 1); PG8_STAGE(PG8_SB(0, 0), b2, voffB); PG8_STAGE(PG8_SB(0, 1), b2 + hstepB, voffB); PG8_STAGE(PG8_SA(0, 0), a2, w0);
            PG8_WAIT_V(8); PG8_WAIT_L(0); PG8_BAR; if (full) { PG8_MMA(1, 0, At, B0); PG8_MMA(1, 1, At, B1); } PG8_BAR; PG8_SCHED;
            PG8_LDB(B0, 1, 0); PG8_LDB(B1, 1, 1); PG8_SCHED; PG8_LDA(At, 1, 0); PG8_STAGE(PG8_SA(0, 1), a2, w1);
            PG8_WAIT_V(8); PG8_WAIT_L(0); PG8_BAR; PG8_MMA(0, 0, At, B0); PG8_MMA(0, 1, At, B1); PG8_BAR; PG8_SCHED;
            PG8_LDA(At, 1, 1); PG8_STAGE(PG8_SB(1, 0), b3, voffB); PG8_STAGE(PG8_SB(1, 1), b3 + hstepB, voffB); PG8_STAGE(PG8_SA(1, 0), a3, w0);
            PG8_WAIT_V(8); PG8_WAIT_L(0); PG8_BAR; if (full) { PG8_MMA(1, 0, At, B0); PG8_MMA(1, 1, At, B1); } PG8_BAR; PG8_SCHED;
        }
        if (wr == 0) PG8_BAR;
        E(acc, cur, wr, wc, fr, fq);
        if (!has_next) break;
#pragma unroll
        for (int a = 0; a < 2; ++a)
#pragma unroll
            for (int b = 0; b < 2; ++b)
#pragma unroll
                for (int m = 0; m < 4; ++m)
#pragma unroll
                    for (int n = 0; n < 2; ++n) acc[a][b][m][n] = (f32x4){0.f, 0.f, 0.f, 0.f};
        cur = nxt; cB = nB; ++ui;
        vA[0][0] = vN[0][0]; vA[0][1] = vN[0][1]; vA[1][0] = vN[1][0]; vA[1][1] = vN[1][1];
        if (wr == 1) PG8_BAR;
    }
    PG8_WAIT_V(0);
    PG8_BAR;
#undef PG8_SA
#undef PG8_SB
#undef PG8_STAGE
#undef PG8_LDA
#undef PG8_LDB
#undef PG8_MMA
#undef PG8_WAIT_V
#undef PG8_WAIT_L
#undef PG8_BAR
#undef PG8_SCHED
#undef PG8_AOFFS
}
}

using pg8::Unit;
typedef f32x4 Acc[2][2][4][2];

struct EpiInProj {
    static constexpr bool PERM = true;
    bf16* P1; float* SSQ; const float2* TD; const float2* TM;
    __device__ __forceinline__ void operator()(const Acc& acc, const Unit& u, int wr, int wc, int fr, int fq) const {
        const int pm = u.pm, pn = u.pn, jt = pm % 17; const bool lat = jt > 0;
        const int row0 = pm * 256 + wr * 64 + fr, col0 = pn * 256 + wc * 32 + 8 * fq;
        if (pn == 0 || pn >= 6 || (pn == 1)) {
#pragma unroll
            for (int ai = 0; ai < 2; ++ai)
#pragma unroll
                for (int m = 0; m < 4; ++m) {
                    const int r = row0 + ai * 128 + m * 16; bf16* rowp = P1 + (size_t)r * NP1 + col0;
                    *(u32x4*)(rowp) = pack8(acc[ai][0][m][0], acc[ai][0][m][1]);
                    if (pn != 1) *(u32x4*)(rowp + 128) = pack8(acc[ai][1][m][0], acc[ai][1][m][1]);
                    if (pn <= 1) {
                        float s = 0.f;
#pragma unroll
                        for (int bj = 0; bj < 2; ++bj) { if (pn == 1 && bj == 1) break;
#pragma unroll
                            for (int n = 0; n < 2; ++n) { const f32x4 x = acc[ai][bj][m][n]; s += (x[0] * x[0] + x[1] * x[1]) + (x[2] * x[2] + x[3] * x[3]); } }
                        s += __shfl_xor(s, 16); s += __shfl_xor(s, 32);
                        if (fq == 0) SSQ[(size_t)r * 8 + pn * 4 + wc] = s;
                    }
                    if (pn == 1 && wc == 0) {
                        f32x4 x1 = acc[ai][1][m][0], x2 = acc[ai][1][m][1], o1 = x1, o2 = x2;
                        if (lat) { const int gr = (jt - 1) * 4 + 2 * ai + wr, gc = 16 * m + fr;
                            const float2* tp = TM + (fq < 2 ? gr * 8 + 4 * fq : gc * 8 + 4 * (fq - 2));
                            const f32x4 t0 = *(const f32x4*)tp, t1 = *(const f32x4*)(tp + 2);
                            const f32x4 cs = {t0[0], t0[2], t1[0], t1[2]}, sn = {t0[1], t0[3], t1[1], t1[3]};
                            o1 = x1 * cs - x2 * sn; o2 = x1 * sn + x2 * cs; }
                        *(u32x4*)(rowp + 128) = pack8(o1, o2);
                    }
                }
        } else {
            const int g = wc & 1; const float qs = pn < 4 ? 0.125f * 1.4426950408889634f : 1.f;
#pragma unroll
            for (int ai = 0; ai < 2; ++ai) {
                const int gr = (jt - 1) * 4 + 2 * ai + wr;
#pragma unroll
                for (int m = 0; m < 4; ++m) {
                    const int r = row0 + ai * 128 + m * 16; bf16* rowp = P1 + (size_t)r * NP1 + col0;
                    f32x4 cs = {1.f, 1.f, 1.f, 1.f}, sn = {0.f, 0.f, 0.f, 0.f};
                    if (lat) { const int gc = 16 * m + fr; const float2* tp = TD + (g == 0 ? gr : gc) * 16 + 4 * fq;
                        const f32x4 t0 = *(const f32x4*)tp, t1 = *(const f32x4*)(tp + 2);
                        cs = (f32x4){t0[0], t0[2], t1[0], t1[2]}; sn = (f32x4){t0[1], t0[3], t1[1], t1[3]}; }
#pragma unroll
                    for (int bj = 0; bj < 2; ++bj) { const f32x4 x1 = acc[ai][bj][m][0] * qs, x2 = acc[ai][bj][m][1] * qs;
                        *(u32x4*)(rowp + bj * 128) = pack8(x1 * cs - x2 * sn, x1 * sn + x2 * cs); }
                }
            }
        }
    }
};

struct EpiUp {
    static constexpr bool PERM = true;
    bf16* QM; bf16* KVM; const float* SSQ; const float2* TM;
    __device__ __forceinline__ void operator()(const Acc& acc, const Unit& u, int wr, int wc, int fr, int fq) const {
        const int pm = u.pm, pn = u.pn, jt = pm % 17; const bool lat = jt > 0, isq = pn < 3;
        const int row0 = pm * 256 + wr * 64 + fr, col0 = pn * 256 + wc * 32 + 8 * fq;
#pragma unroll
        for (int ai = 0; ai < 2; ++ai)
#pragma unroll
            for (int m = 0; m < 4; ++m) {
                const int r = row0 + ai * 128 + m * 16;
                const f32x4 sq = *(const f32x4*)(SSQ + (size_t)r * 8 + (isq ? 0 : 4));
                const float rs = rsqrtf(((sq[0] + sq[1]) + (sq[2] + sq[3])) * (isq ? 1.f / 256.f : 1.f / 128.f) + EPS) * (isq ? 0.10206207261596575f * 1.4426950408889634f : 1.f);
#pragma unroll
                for (int bj = 0; bj < 2; ++bj) {
                    f32x4 x1 = acc[ai][bj][m][0] * rs, x2 = acc[ai][bj][m][1] * rs;
                    if (isq) {
                        const int G = 8 * pn + 4 * bj + wc;
                        if (lat && (G % 3) == 2) { const int gr = (jt - 1) * 4 + 2 * ai + wr, gc = 16 * m + fr;
                            const float2* tp = TM + (fq < 2 ? gr * 8 + 4 * fq : gc * 8 + 4 * (fq - 2));
                            const f32x4 t0 = *(const f32x4*)tp, t1 = *(const f32x4*)(tp + 2);
                            const f32x4 cs = {t0[0], t0[2], t1[0], t1[2]}, sn = {t0[1], t0[3], t1[1], t1[3]};
                            const f32x4 o1 = x1 * cs - x2 * sn, o2 = x1 * sn + x2 * cs; x1 = o1; x2 = o2; }
                        *(u32x4*)(QM + (size_t)r * 768 + col0 + bj * 128) = pack8(x1, x2);
                    } else *(u32x4*)(KVM + (size_t)r * 1024 + (col0 - 768) + bj * 128) = pack8(x1, x2);
                }
            }
    }
};

struct EpiOut {
    static constexpr bool PERM = true;
    const float* x; const float* MOD; bf16* X1;
    __device__ __forceinline__ void operator()(const Acc& acc, const Unit& u, int wr, int wc, int fr, int fq) const {
        const int b = u.pm / 16; const float* gt = MOD + b * 6144 + 2048;
        const int row0 = u.pm * 256 + wr * 64 + fr, col0 = u.pn * 256 + wc * 32 + 8 * fq;
        f32x4 gv[2][2];
#pragma unroll
        for (int bj = 0; bj < 2; ++bj)
#pragma unroll
            for (int n = 0; n < 2; ++n) gv[bj][n] = *(const f32x4*)(gt + col0 + bj * 128 + n * 4);
#pragma unroll
        for (int ai = 0; ai < 2; ++ai)
#pragma unroll
            for (int m = 0; m < 4; ++m) { const size_t off = (size_t)(row0 + ai * 128 + m * 16) * DM + col0;
#pragma unroll
                for (int bj = 0; bj < 2; ++bj) { const f32x4 x0 = *(const f32x4*)(x + off + bj * 128), x1 = *(const f32x4*)(x + off + bj * 128 + 4);
                    *(u32x4*)(X1 + off + bj * 128) = pack8(x0 + gv[bj][0] * acc[ai][bj][m][0], x1 + gv[bj][1] * acc[ai][bj][m][1]); } }
    }
};
struct EpiF32 {
    static constexpr bool PERM = false;
    float* O; int ldc;
    __device__ __forceinline__ void operator()(const Acc& acc, const Unit& u, int wr, int wc, int fr, int fq) const {
        const int row0 = u.pm * 256 + wr * 64 + fr, col0 = u.pn * 256 + wc * 32 + 4 * fq;
#pragma unroll
        for (int ai = 0; ai < 2; ++ai)
#pragma unroll
            for (int m = 0; m < 4; ++m) { const size_t off = (size_t)(row0 + ai * 128 + m * 16) * ldc + col0;
#pragma unroll
                for (int bj = 0; bj < 2; ++bj)
#pragma unroll
                    for (int n = 0; n < 2; ++n) *(f32x4*)(O + off + bj * 128 + n * 16) = acc[ai][bj][m][n]; }
    }
};
struct EpiAct {
    static constexpr bool PERM = true;
    bf16* ACT; const float* SW;
    __device__ __forceinline__ void operator()(const Acc& acc, const Unit& u, int wr, int wc, int fr, int fq) const {
        const int half = u.pn & 1, colb = half * 128 + wc * 32 + 8 * fq;
#pragma unroll
        for (int ai = 0; ai < 2; ++ai)
#pragma unroll
            for (int m = 0; m < 4; ++m) { const int tr = ai * 128 + wr * 64 + m * 16 + fr;
                f32x4 a[2];
#pragma unroll
                for (int n = 0; n < 2; ++n) { const f32x4 gt = acc[ai][0][m][n], up = acc[ai][1][m][n];
#pragma unroll
                    for (int e = 0; e < 4; ++e) a[n][e] = gt[e] * __builtin_amdgcn_rcpf(1.f + __expf(-gt[e])) * up[e]; }
                if (tr < u.nv) { const float w = SW[u.r0 + tr]; *(u32x4*)(ACT + (size_t)(u.r0 + tr) * EFF + colb) = pack8(a[0] * w, a[1] * w); } }
    }
};
constexpr float YSCALE = 32.f;
__device__ __forceinline__ unsigned pk4_fp8(f32x4 v) { int w = 0; w = __builtin_amdgcn_cvt_pk_fp8_f32(v[0], v[1], w, false); w = __builtin_amdgcn_cvt_pk_fp8_f32(v[2], v[3], w, true); return (unsigned)w; }
struct EpiY {
    static constexpr bool PERM = true;
    unsigned char* Y;
    __device__ __forceinline__ void operator()(const Acc& acc, const Unit& u, int wr, int wc, int fr, int fq) const {
        const int colb = (u.pn & 3) * 256 + wc * 64 + 16 * fq;
#pragma unroll
        for (int ai = 0; ai < 2; ++ai)
#pragma unroll
            for (int m = 0; m < 4; ++m) { const int tr = ai * 128 + wr * 64 + m * 16 + fr;
                if (tr < u.nv) { u32x4 w; w.x = pk4_fp8(acc[ai][0][m][0] * YSCALE); w.y = pk4_fp8(acc[ai][0][m][1] * YSCALE); w.z = pk4_fp8(acc[ai][1][m][0] * YSCALE); w.w = pk4_fp8(acc[ai][1][m][1] * YSCALE);
                    *(u32x4*)(Y + (size_t)(u.r0 + tr) * DM + colb) = w; } }
    }
};

template <int SUB, bool GATHER> struct ExpSched {
    const LAS int* uc; int nmine; const int* slot_tok;
    __device__ bool next(int i, Unit& u) const {
        if (i >= nmine) return false;
        const int e = __builtin_amdgcn_readfirstlane(uc[i * 4 + 0]), r0 = __builtin_amdgcn_readfirstlane(uc[i * 4 + 1]);
        const int nv = __builtin_amdgcn_readfirstlane(uc[i * 4 + 2]), sub = __builtin_amdgcn_readfirstlane(uc[i * 4 + 3]);
        u.pm = 0; u.pn = e * SUB + sub; u.r0 = r0; u.nv = nv; u.k0 = 0; return true;
    }
    __device__ __forceinline__ int a_row(const Unit& u, int r) const {
        if (GATHER) return r < u.nv ? slot_tok[u.r0 + r] : 0;
        const int s = u.r0 + r; return s < NSLOT ? s : NSLOT - 1;
    }
};
template <int SUB> __device__ __forceinline__ int exp_units_to_lds(LAS int* uc, const int* ut, int nunit, int nfull, int G, int c) {
    const int NF = nfull * SUB, NH = (nunit - nfull) * SUB, cr = G - 1 - c, nlight = (NF % G) ? G - NF % G : 0;
    const int mf = c < NF ? (NF - 1 - c) / G + 1 : 0;
    const int h0 = (cr < nlight && cr < NH) ? 1 : 0;
    const int NH2 = NH > nlight ? NH - nlight : 0, mh = cr < NH2 ? (NH2 - 1 - cr) / G + 1 : 0;
    const int t = threadIdx.x;
    if (t < mf + h0 + mh && t < 64) { const int L = t < mf ? t * G + c : (t < mf + h0 ? NF + cr : NF + nlight + (t - mf - h0) * G + cr); const int cu = L / SUB;
        uc[t * 4 + 0] = ut[cu * 4 + 0]; uc[t * 4 + 1] = ut[cu * 4 + 1]; uc[t * 4 + 2] = ut[cu * 4 + 2]; uc[t * 4 + 3] = L % SUB; }
    __syncthreads();
    return mf + h0 + mh < 64 ? mf + h0 + mh : 64;
}
struct RouterOrder {
    int G, c;
    __device__ bool next(int i, Unit& u) const { const int L = i * G + c; if (L >= 256) return false; u.pm = L >> 2; u.pn = 0; u.r0 = u.pm * 256; u.nv = 256; u.k0 = (L & 3) * 256; return true; }
    __device__ __forceinline__ int a_row(const Unit& u, int r) const { return u.pm * 256 + r; }
};
struct UpOrder {
    int G, c;
    __device__ bool next(int i, Unit& u) const { const int L = i * G + c; if (L >= 68 * 7) return false; u.pm = L / 7; u.pn = L % 7; u.r0 = u.pm * 256; u.nv = 256; u.k0 = u.pn < 3 ? 0 : 128; return true; }
    __device__ __forceinline__ int a_row(const Unit& u, int r) const { return u.pm * 256 + r; }
};
struct EpiLogP {
    static constexpr bool PERM = false;
    float* O;
    __device__ __forceinline__ void operator()(const Acc& acc, const Unit& u, int wr, int wc, int fr, int fq) const {
        float* base = O + (size_t)(u.k0 >> 8) * MLAT * NEXP;
        const int row0 = u.pm * 256 + wr * 64 + fr, col0 = wc * 32 + 4 * fq;
#pragma unroll
        for (int ai = 0; ai < 2; ++ai)
#pragma unroll
            for (int m = 0; m < 4; ++m) { const size_t off = (size_t)(row0 + ai * 128 + m * 16) * NEXP + col0;
#pragma unroll
                for (int bj = 0; bj < 2; ++bj)
#pragma unroll
                    for (int n = 0; n < 2; ++n) *(f32x4*)(base + off + bj * 128 + n * 16) = acc[ai][bj][m][n]; }
    }
};

namespace attn {
#define SBAR() __builtin_amdgcn_sched_barrier(0)
constexpr float THR = 8.f;
template <int MODE> struct Cfg;
template <> struct Cfg<0> { static constexpr int DQK = 96, DV = 64, LDQ = 768, LDK0 = 1024, LDK1 = 2048, LDV = 1024; static constexpr float SCALE = 0.10206207261596575f; };
template <> struct Cfg<1> { static constexpr int DQK = 64, DV = 128, LDQ = 2048, LDK0 = 2048, LDK1 = 2048, LDV = 2048; static constexpr float SCALE = 0.125f; };
__device__ __forceinline__ int crow(int r, int hi) { return (r & 3) + 8 * (r >> 2) + 4 * hi; }
__device__ __forceinline__ unsigned cvtpk(float lo, float hi) { unsigned r; asm volatile("v_cvt_pk_bf16_f32 %0, %1, %2" : "=v"(r) : "v"(lo), "v"(hi)); return r; }

constexpr float THR2 = 11.5f;
__device__ __forceinline__ float max3f(float a, float b, float c) { return __builtin_fmaxf(__builtin_fmaxf(a, b), c); }
__device__ __forceinline__ void partialSM(f32x16& p0, f32x16& p1, float& m_reg, float& alpha, bool first) {
    float a = max3f(p0[0], p0[1], p1[0]), b = max3f(p0[2], p0[3], p1[1]); a = max3f(a, p1[2], p1[3]);
#pragma unroll
    for (int r = 4; r < 16; r += 4) { a = max3f(a, p0[r], p0[r + 1]); b = max3f(b, p0[r + 2], p0[r + 3]); a = max3f(a, p1[r], p1[r + 1]); b = max3f(b, p1[r + 2], p1[r + 3]); }
    float pmax = __builtin_fmaxf(a, b);
    { auto rr = __builtin_amdgcn_permlane32_swap(__float_as_uint(pmax), __float_as_uint(pmax), false, false);
      pmax = __builtin_fmaxf(__uint_as_float(rr[0]), __uint_as_float(rr[1])); }
    alpha = 1.f;
    if (__builtin_expect(first || __any(pmax > THR2), 0)) {
        const float dl = first ? pmax : __builtin_fmaxf(pmax, 0.f);
        m_reg += dl; alpha = first ? 1.f : __builtin_amdgcn_exp2f(-dl);
#pragma unroll
        for (int r = 0; r < 16; ++r) { p0[r] -= dl; p1[r] -= dl; }
    }
#pragma unroll
    for (int r = 0; r < 16; ++r) p0[r] = __builtin_amdgcn_exp2f(p0[r]);
}
__device__ __forceinline__ void finishSM(f32x16& p0, f32x16& p1, float alpha, float& l_reg, bf16x8& pa0, bf16x8& pa1, bf16x8& pa2, bf16x8& pa3) {
#pragma unroll
    for (int r = 0; r < 16; ++r) p1[r] = __builtin_amdgcn_exp2f(p1[r]);
    float ps = 0;
#pragma unroll
    for (int r = 0; r < 16; ++r) ps += p0[r];
#pragma unroll
    for (int r = 0; r < 16; ++r) ps += p1[r];
    { auto rr = __builtin_amdgcn_permlane32_swap(__float_as_uint(ps), __float_as_uint(ps), false, false);
      ps = __uint_as_float(rr[0]) + __uint_as_float(rr[1]); }
    l_reg = l_reg * alpha + ps;
#define PK4(P, BASE, OUT) do { u32x4 w = {cvtpk(P[BASE + 0], P[BASE + 1]), cvtpk(P[BASE + 2], P[BASE + 3]), cvtpk(P[BASE + 4], P[BASE + 5]), cvtpk(P[BASE + 6], P[BASE + 7])}; OUT = *reinterpret_cast<bf16x8*>(&w); } while (0)
    PK4(p0, 0, pa0); PK4(p0, 8, pa1); PK4(p1, 0, pa2); PK4(p1, 8, pa3);
#undef PK4
}
template <int NQ, int KROW> __device__ __forceinline__ void qkt(f32x16& p0, f32x16& p1, const LAS char* Ks, const bf16x8* qr, float m_ref, int r32, int hi) {
    f32x16 negm;
#pragma unroll
    for (int r = 0; r < 16; ++r) negm[r] = -m_ref;
    p0 = negm; p1 = negm;
#pragma unroll
    for (int d0 = 0; d0 < NQ; ++d0) { const int cb = d0 * 32 + hi * 16;
        const bf16x8 b0 = *(const LAS bf16x8*)(Ks + r32 * KROW + cb);
        const bf16x8 b1 = *(const LAS bf16x8*)(Ks + (32 + r32) * KROW + cb);
        p0 = __builtin_amdgcn_mfma_f32_32x32x16_bf16(b0, qr[d0], p0, 0, 0, 0);
        p1 = __builtin_amdgcn_mfma_f32_32x32x16_bf16(b1, qr[d0], p1, 0, 0, 0); }
}
template <int NC> __device__ __forceinline__ int v_st(int k, int c) { const int kk = k; return ((kk >> 3) * NC + (c >> 5)) * 512 + ((kk & 7) * 32 + (c & 31)) * 2; }
__device__ __forceinline__ int v_rd_base(int lane) { return ((lane & 3) << 3) | (((lane >> 2) & 3) << 6) | (((lane >> 4) & 1) << 5) | (((lane >> 5) & 1) << 8); }
template <int OFF> __device__ __forceinline__ s16x4 tr_read(int vb) {
    s16x4 r; asm volatile("ds_read_b64_tr_b16 %0, %1 offset:%2" : "=&v"(r) : "v"(vb), "i"(OFF) : "memory"); return r;
}
template <int NC, int D0> __device__ __forceinline__ void pv_one(f32x16& od, int vb, bf16x8 pa0, bf16x8 pa1, bf16x8 pa2, bf16x8 pa3) {
#define VOFF(ks, half) (D0 * 512 + (ks) * (NC * 1024) + (half) * (NC * 512))
    const s16x4 l0 = tr_read<VOFF(0, 0)>(vb), h0 = tr_read<VOFF(0, 1)>(vb), l1 = tr_read<VOFF(1, 0)>(vb), h1 = tr_read<VOFF(1, 1)>(vb);
    const s16x4 l2 = tr_read<VOFF(2, 0)>(vb), h2 = tr_read<VOFF(2, 1)>(vb), l3 = tr_read<VOFF(3, 0)>(vb), h3 = tr_read<VOFF(3, 1)>(vb);
#undef VOFF
    asm volatile("s_waitcnt lgkmcnt(0)" ::: "memory"); SBAR();
#define PK(L, H) (bf16x8){L[0], L[1], L[2], L[3], H[0], H[1], H[2], H[3]}
    od = __builtin_amdgcn_mfma_f32_32x32x16_bf16(pa0, PK(l0, h0), od, 0, 0, 0);
    od = __builtin_amdgcn_mfma_f32_32x32x16_bf16(pa1, PK(l1, h1), od, 0, 0, 0);
    od = __builtin_amdgcn_mfma_f32_32x32x16_bf16(pa2, PK(l2, h2), od, 0, 0, 0);
    od = __builtin_amdgcn_mfma_f32_32x32x16_bf16(pa3, PK(l3, h3), od, 0, 0, 0);
#undef PK
}
template <int NC> __device__ __forceinline__ void pv_all(f32x16* o, int vb, bf16x8 pa0, bf16x8 pa1, bf16x8 pa2, bf16x8 pa3) {
    pv_one<NC, 0>(o[0], vb, pa0, pa1, pa2, pa3); pv_one<NC, 1>(o[1], vb, pa0, pa1, pa2, pa3);
    if constexpr (NC == 4) { pv_one<NC, 2>(o[2], vb, pa0, pa1, pa2, pa3); pv_one<NC, 3>(o[3], vb, pa0, pa1, pa2, pa3); }
}
template <int MODE> constexpr int lds_bytes() { return 3 * 64 * Cfg<MODE>::DV * 2 + 3 * 64 * (Cfg<MODE>::DQK * 2 + 16) + 8 * 64 * 4; }

template <int MODE, int EPI>
__device__ __forceinline__ void unit(const bf16* __restrict__ Qb, const bf16* __restrict__ K0, const bf16* __restrict__ K1, const bf16* __restrict__ Vh, void* Ob, int ldo, LAS char* lds, char* stash, float lam, const float* gsub) {
    using C = Cfg<MODE>;
    constexpr int DQK = C::DQK, DV = C::DV, NQ = DQK / 16, NC = DV / 32, KROW = DQK * 2 + 16, SHM_K = 64 * KROW, SHM_V = 64 * DV * 2;
    const int tid = threadIdx.x, wid = tid >> 6, lane = tid & 63, r32 = lane & 31, hi = lane >> 5;
    LAS char* V_lds = lds; LAS char* K_lds = lds + 3 * SHM_V;
    LAS float* ws = (LAS float*)(lds + 3 * SHM_V + 3 * SHM_K) + wid * 64; LAS float* li_l = ws; LAS float* al_l = ws + 32;
    float m_reg = 0.f, l_reg = 0; f32x16 o[NC]; bf16x8 qr[NQ];
#pragma unroll
    for (int d = 0; d < NC; ++d) o[d] = f32x16{};
    const bf16* Qw = Qb + (size_t)(wid * 32 + r32) * C::LDQ + hi * 8;
#pragma unroll
    for (int d0 = 0; d0 < NQ; ++d0) qr[d0] = *reinterpret_cast<const bf16x8*>(Qw + d0 * 16);
    const int vb0 = (int)(uintptr_t)V_lds + v_rd_base(lane);
    const int kr0 = tid >> 3, kc0 = tid & 7;
    const int krr = (tid & 255) >> 2, krc = tid & 3;
    const int vr0 = MODE == 0 ? (tid >> 3) : (tid >> 4), vc0 = MODE == 0 ? (tid & 7) * 8 : (tid & 15) * 8;
    const int vst0 = v_st<NC>(vr0, vc0), vst1 = v_st<NC>(32 + vr0, vc0);
    constexpr int NSET = MODE == 0 ? 2 : 1;
    struct { bf16x8 ka, kb, va, vb; } sr_[NSET];
#define SLOAD(i, k0) do { sr_[i].ka = *reinterpret_cast<const bf16x8*>(K0 + (size_t)((k0) + kr0) * C::LDK0 + kc0 * 8); \
        if (MODE == 0) { sr_[i].kb = *reinterpret_cast<const bf16x8*>(K1 + (size_t)((k0) + krr) * C::LDK1 + krc * 8); } \
        sr_[i].va = *reinterpret_cast<const bf16x8*>(Vh + (size_t)((k0) + vr0) * C::LDV + vc0); \
        if (MODE == 1) { sr_[i].vb = *reinterpret_cast<const bf16x8*>(Vh + (size_t)((k0) + 32 + vr0) * C::LDV + vc0); } } while (0)
#define SWRITE(ko, vo, i) do { *(LAS bf16x8*)(K_lds + (ko) + kr0 * KROW + kc0 * 16) = sr_[i].ka; \
        if (MODE == 0) { *(LAS bf16x8*)(K_lds + (ko) + krr * KROW + 128 + krc * 16) = sr_[i].kb; } \
        *(LAS bf16x8*)(V_lds + (vo) + vst0) = sr_[i].va; \
        if (MODE == 1) { *(LAS bf16x8*)(V_lds + (vo) + vst1) = sr_[i].vb; } } while (0)
#define SWAIT() do { if (NSET == 2) asm volatile("s_waitcnt vmcnt(3)" ::: "memory"); } while (0)
#define RESC(a) do { if (__any((a) < 1.f)) { if (hi == 0) al_l[r32] = (a); asm volatile("s_waitcnt lgkmcnt(0)" ::: "memory"); \
        _Pragma("unroll") for (int d = 0; d < NC; ++d) _Pragma("unroll") for (int r = 0; r < 16; ++r) o[d][r] *= al_l[crow(r, hi)]; } } while (0)
    f32x16 pA0, pA1, pB0, pB1; float alA = 1.f, alB = 1.f; bf16x8 pa0, pa1, pa2, pa3; constexpr int NT = NTOK / 64;
#define STEP(PC0, PC1, ALC, PP0, PP1, ALP, jj, SQ, SV, SW) do { constexpr int SETN = ((jj##_c) + 1) % NSET; \
        if ((jj) + 1 < NT) { SWAIT(); SWRITE((SW) * SHM_K, (SW) * SHM_V, SETN); } \
        SBAR(); qkt<NQ, KROW>(PC0, PC1, K_lds + (SQ) * SHM_K, qr, m_reg, r32, hi); \
        finishSM(PP0, PP1, ALP, l_reg, pa0, pa1, pa2, pa3); SBAR(); \
        if ((jj) + 1 + NSET < NT) SLOAD(SETN, ((jj) + 1 + NSET) * 64); SBAR(); \
        pv_all<NC>(o, vb0 + (SV) * SHM_V, pa0, pa1, pa2, pa3); partialSM(PC0, PC1, m_reg, ALC, false); \
        RESC(ALC); __syncthreads(); } while (0)
    static_assert((NT - 2) % 6 == 0, "tile count: steps 1..NT-2 in groups of 6");
    SLOAD(0, 0); asm volatile("s_waitcnt vmcnt(0)" ::: "memory"); SWRITE(0, 0, 0);
    SLOAD(1 % NSET, 64); if (NSET == 2) SLOAD(0, 128); __syncthreads();
    SWAIT(); SWRITE(SHM_K, SHM_V, 1 % NSET);
    qkt<NQ, KROW>(pA0, pA1, K_lds, qr, m_reg, r32, hi);
    SLOAD(1 % NSET, (1 + NSET) * 64);
    partialSM(pA0, pA1, m_reg, alA, true);
    __syncthreads();
    for (int j = 1; j + 1 < NT; j += 6) {
        constexpr int j_c = 1, j1_c = 2, j2_c = 3, j3_c = 4, j4_c = 5, j5_c = 6; const int j1 = j + 1, j2 = j + 2, j3 = j + 3, j4 = j + 4, j5 = j + 5;
        STEP(pB0, pB1, alB, pA0, pA1, alA, j,  1, 0, 2);
        STEP(pA0, pA1, alA, pB0, pB1, alB, j1, 2, 1, 0);
        STEP(pB0, pB1, alB, pA0, pA1, alA, j2, 0, 2, 1);
        STEP(pA0, pA1, alA, pB0, pB1, alB, j3, 1, 0, 2);
        STEP(pB0, pB1, alB, pA0, pA1, alA, j4, 2, 1, 0);
        STEP(pA0, pA1, alA, pB0, pB1, alB, j5, 0, 2, 1);
    }
    { constexpr int jt_c = NT - 1; const int jt = NT - 1;
      STEP(pB0, pB1, alB, pA0, pA1, alA, jt, (NT - 1) % 3, (NT - 2) % 3, NT % 3); }
    finishSM(pB0, pB1, alB, l_reg, pa0, pa1, pa2, pa3); SBAR();
    pv_all<NC>(o, vb0 + ((NT - 1) % 3) * SHM_V, pa0, pa1, pa2, pa3);
#undef STEP
    if (hi == 0) li_l[r32] = l_reg; asm volatile("s_waitcnt lgkmcnt(0)" ::: "memory");
    float rli[16];
#pragma unroll
    for (int r = 0; r < 16; ++r) rli[r] = __builtin_amdgcn_rcpf(li_l[crow(r, hi)]);
    asm volatile("" : "+s"(ldo), "+s"(stash), "+s"(gsub), "+s"(Ob));
    if constexpr (MODE == 0) {
#pragma unroll
        for (int r = 0; r < 16; ++r) { const int orow = wid * 32 + crow(r, hi);
#pragma unroll
            for (int d0 = 0; d0 < NC; ++d0) ((bf16*)Ob)[(size_t)orow * ldo + d0 * 32 + r32] = (bf16)f2bf(o[d0][r] * rli[r]); }
    } else if constexpr (EPI == 1) {
        char* st = stash + wid * 8192 + lane * 16;
#pragma unroll
        for (int d0 = 0; d0 < NC; ++d0)
#pragma unroll
            for (int q = 0; q < 2; ++q) { u32x4 w;
                w.x = cvtpk(o[d0][8 * q + 0] * rli[8 * q + 0], o[d0][8 * q + 1] * rli[8 * q + 1]); w.y = cvtpk(o[d0][8 * q + 2] * rli[8 * q + 2], o[d0][8 * q + 3] * rli[8 * q + 3]);
                w.z = cvtpk(o[d0][8 * q + 4] * rli[8 * q + 4], o[d0][8 * q + 5] * rli[8 * q + 5]); w.w = cvtpk(o[d0][8 * q + 6] * rli[8 * q + 6], o[d0][8 * q + 7] * rli[8 * q + 7]);
                *(u32x4*)(st + (d0 * 2 + q) * 1024) = w; }
        asm volatile("s_waitcnt vmcnt(0)" ::: "memory");
    } else {
        const char* st = stash + wid * 8192 + lane * 16;
#pragma unroll
        for (int d0 = 0; d0 < NC; ++d0) {
            const u32x4 wa = *(const u32x4*)(st + (d0 * 2 + 0) * 1024), wb = *(const u32x4*)(st + (d0 * 2 + 1) * 1024);
            f32x16 od;
            od[0] = __builtin_bit_cast(float, wa.x << 16); od[1] = __builtin_bit_cast(float, wa.x & 0xffff0000u); od[2] = __builtin_bit_cast(float, wa.y << 16); od[3] = __builtin_bit_cast(float, wa.y & 0xffff0000u);
            od[4] = __builtin_bit_cast(float, wa.z << 16); od[5] = __builtin_bit_cast(float, wa.z & 0xffff0000u); od[6] = __builtin_bit_cast(float, wa.w << 16); od[7] = __builtin_bit_cast(float, wa.w & 0xffff0000u);
            od[8] = __builtin_bit_cast(float, wb.x << 16); od[9] = __builtin_bit_cast(float, wb.x & 0xffff0000u); od[10] = __builtin_bit_cast(float, wb.y << 16); od[11] = __builtin_bit_cast(float, wb.y & 0xffff0000u);
            od[12] = __builtin_bit_cast(float, wb.z << 16); od[13] = __builtin_bit_cast(float, wb.z & 0xffff0000u); od[14] = __builtin_bit_cast(float, wb.w << 16); od[15] = __builtin_bit_cast(float, wb.w & 0xffff0000u);
#pragma unroll
            for (int r = 0; r < 16; ++r) od[r] -= lam * (o[d0][r] * rli[r]);
            o[d0] = od;
        }
        f32x16 ssv;
#pragma unroll
        for (int r = 0; r < 16; ++r) { float x = 0.f;
#pragma unroll
            for (int d0 = 0; d0 < NC; ++d0) x += o[d0][r] * o[d0][r];
            x += __builtin_bit_cast(float, __builtin_amdgcn_update_dpp(0, __builtin_bit_cast(int, x), 0x111, 0xf, 0xf, false));
            x += __builtin_bit_cast(float, __builtin_amdgcn_update_dpp(0, __builtin_bit_cast(int, x), 0x112, 0xf, 0xf, false));
            x += __builtin_bit_cast(float, __builtin_amdgcn_update_dpp(0, __builtin_bit_cast(int, x), 0x114, 0xf, 0xf, false));
            x += __builtin_bit_cast(float, __builtin_amdgcn_update_dpp(0, __builtin_bit_cast(int, x), 0x118, 0xf, 0xf, false));
            x += __builtin_bit_cast(float, __builtin_amdgcn_update_dpp(0, __builtin_bit_cast(int, x), 0x142, 0xa, 0xf, false));
            const float t0 = __builtin_bit_cast(float, __builtin_amdgcn_readlane(__builtin_bit_cast(int, x), 31)), t1 = __builtin_bit_cast(float, __builtin_amdgcn_readlane(__builtin_bit_cast(int, x), 63));
            ssv[r] = rsqrtf((hi ? t1 : t0) * (1.f / 128.f) + EPS) * (1.f - LAM_INIT); }
#pragma unroll
        for (int d0 = 0; d0 < NC; ++d0) { const float g = gsub[d0 * 32 + r32];
#pragma unroll
            for (int r = 0; r < 16; ++r) { const int orow = wid * 32 + crow(r, hi); ((bf16*)Ob)[(size_t)orow * ldo + d0 * 32 + r32] = (bf16)f2bf(o[d0][r] * ssv[r] * g); } }
    }
    __syncthreads();
#undef SLOAD
#undef SWRITE
#undef SWAIT
#undef RESC
}
#undef SBAR
}

#define XB_TMO      128
#define XB_XCNT(j)  (256  + 64 * (j))
#define XB_XSUB(j)  (1280 + 64 * (j))
#define XB_XGEN(j)  (2304 + 64 * (j))
#define XB_TOP      3328
#define XB_TOPGEN   3392
#define XCD_BAR_WORDS 3456
#define XB_SPIN_CAP (1u << 20)
__device__ __forceinline__ unsigned xb_ld(unsigned* p)              { return __hip_atomic_load(p, __ATOMIC_RELAXED, __HIP_MEMORY_SCOPE_AGENT); }
__device__ __forceinline__ unsigned xb_add(unsigned* p, unsigned v) { return __hip_atomic_fetch_add(p, v, __ATOMIC_RELAXED, __HIP_MEMORY_SCOPE_AGENT); }
__device__ __forceinline__ unsigned xb_xcc_id() { return (unsigned)__builtin_amdgcn_s_getreg((3 << 11) | 20) & 0xFu; }
#define XB_SPIN(cond, bar) do { unsigned _sp = 0; while (cond) { __builtin_amdgcn_s_sleep(1); \
    if ((++_sp & 255u) == 0u) { if (xb_ld(&(bar)[XB_TMO])) break; if (_sp > XB_SPIN_CAP) { atomicAdd(&(bar)[XB_TMO], 1u); break; } } } } while (0)
struct XcdBarrier { unsigned* bar; unsigned x; volatile LAS unsigned* st; };
__device__ __forceinline__ XcdBarrier xcd_barrier_post(unsigned* bar, volatile LAS unsigned* st) {
    XcdBarrier b; b.bar = bar; b.x = xb_xcc_id(); b.st = st;
    if (threadIdx.x == 0) (void)xb_add(&bar[XB_XCNT(b.x)], 1u);
    return b;
}
__device__ __forceinline__ void xcd_barrier_complete(unsigned* bar, unsigned x, unsigned& nloc, unsigned& nx) {
    const unsigned G = gridDim.x * gridDim.y * gridDim.z;
    unsigned sum, cnt, mine, sp = 0u;
    for (;;) {
        sum = 0u; cnt = 0u; mine = 0u;
#pragma unroll
        for (unsigned j = 0; j < 16; ++j) { const unsigned c = xb_ld(&bar[XB_XCNT(j)]); sum += c; cnt += (c > 0u) ? 1u : 0u; mine = (j == x) ? c : mine; }
        if (sum == G) break;
        __builtin_amdgcn_s_sleep(1);
        if ((++sp & 255u) == 0u) { if (xb_ld(&bar[XB_TMO])) break; if (sp > XB_SPIN_CAP) { atomicAdd(&bar[XB_TMO], 1u); break; } }
    }
    nloc = mine > 0u ? mine : 1u; nx = cnt > 0u ? cnt : 1u;
}
__device__ __forceinline__ void xcd_barrier(const XcdBarrier& b) {
    asm volatile("s_waitcnt vmcnt(0)" ::: "memory");
    __syncthreads();
    if (threadIdx.x == 0) {
        unsigned* bar = b.bar;
        __builtin_amdgcn_s_waitcnt(0);
        unsigned nloc = b.st[0], nx = b.st[1];
        if (nloc == 0u) { xcd_barrier_complete(bar, b.x, nloc, nx); b.st[0] = nloc; b.st[1] = nx; }
        const unsigned old = xb_add(&bar[XB_XSUB(b.x)], 1u);
        const unsigned gen = old / nloc;
        if (old + 1u == (gen + 1u) * nloc) {
            __builtin_amdgcn_fence(__ATOMIC_RELEASE, "agent");
            asm volatile("s_waitcnt vmcnt(0)" ::: "memory");
            const unsigned og = xb_add(&bar[XB_TOP], 1u);
            const unsigned tg = og / nx;
            if (og + 1u == (tg + 1u) * nx) xb_add(&bar[XB_TOPGEN], 1u);
            else XB_SPIN(xb_ld(&bar[XB_TOPGEN]) == tg, bar);
            __builtin_amdgcn_fence(__ATOMIC_ACQUIRE, "agent");
            xb_add(&bar[XB_XGEN(b.x)], 1u);
            asm volatile("s_waitcnt vmcnt(0)" ::: "memory");
        } else {
            XB_SPIN(xb_ld(&bar[XB_XGEN(b.x)]) == gen, bar);
            __builtin_amdgcn_fence(__ATOMIC_ACQUIRE, "agent");
            asm volatile("s_waitcnt vmcnt(0)" ::: "memory");
        }
    }
    __syncthreads();
}

constexpr int NWAVES = 8;
constexpr int RING_BYTES = 131072, LDS_BYTES = 147456, LDSCTL_OFF = LDS_BYTES - 2048, MISC_OFF = LDSCTL_OFF + 320, UCACHE_OFF = LDSCTL_OFF + 1024  ;

struct Frame {
    LAS unsigned char* lds; volatile LAS unsigned* MISC; unsigned* ctl;
    int tid, lane, wave, vcu, G;
    Ptrs P;
    __device__ __forceinline__ LAS char* lds_c() const { return (LAS char*)lds; }
};

template <class SrcF> __device__ __forceinline__ void transpose_item(const SrcF& f, int K, bf16* WT, int p0, int k0, LAS float* scr, int lane) {
    float t[32];
#pragma unroll
    for (int i = 0; i < 32; ++i) t[i] = f(k0 + 2 * i + (lane >> 5), p0 + (lane & 31));
#pragma unroll
    for (int i = 0; i < 32; ++i) scr[(2 * i + (lane >> 5)) * 33 + (lane & 31)] = t[i];
    LDS_WAIT(); asm volatile("" ::: "memory");
    const int c = lane & 7;
#pragma unroll
    for (int j = 0; j < 4; ++j) { const int n = (lane >> 3) + 8 * j; const LAS float* s = scr + (8 * c) * 33 + n;
        u32x4 o; o.x = cvt_pk_bf16(s[0 * 33], s[1 * 33]); o.y = cvt_pk_bf16(s[2 * 33], s[3 * 33]); o.z = cvt_pk_bf16(s[4 * 33], s[5 * 33]); o.w = cvt_pk_bf16(s[6 * 33], s[7 * 33]);
        *(u32x4*)(WT + (size_t)(p0 + n) * K + k0 + 8 * c) = o; }
    LDS_WAIT(); asm volatile("" ::: "memory");
}
struct SrcWin { const float* w; __device__ float operator()(int k, int p) const { const int l = p1_logical(p); return l < 0 ? 0.f : w[(size_t)k * IN_COLS + l]; } };
struct SrcWup { const float *gq, *wuq, *gkv, *wukv;
    __device__ float operator()(int k, int p) const {
        if (p < 768) return k < 256 ? gq[k] * wuq[(size_t)k * 768 + qm_logical(p)] : 0.f;
        return k >= 256 ? gkv[k - 256] * wukv[(size_t)(k - 256) * 1024 + (p - 768)] : 0.f; } };
struct SrcPlain { const float* w; int N; int coff; __device__ float operator()(int k, int p) const { return w[(size_t)k * N + p + coff]; } };

__device__ __forceinline__ void ph0_prep(Frame& F) {
    LAS float* scr = (LAS float*)(F.lds + F.wave * 16384);
    const int gw = F.vcu * NWAVES + F.wave, NGW = F.G * NWAVES, lane = F.lane;
    const Ptrs& P = F.P; unsigned char* ws = P.ws;
    constexpr int I_IN = 16 * 64, I_UP = 6 * 56, I_OUT = 16 * 32, I_R = 16 * 8, I_SMALL = I_IN + I_UP + I_OUT + I_R;
    for (int it = gw; it < I_SMALL; it += NGW) {
        int r = it;
        if (r < I_IN) { transpose_item(SrcWin{P.in[8]}, 1024, (bf16*)(ws + WS_WIN), (r % 64) * 32, (r / 64) * 64, scr, lane); continue; } r -= I_IN;
        if (r < I_UP) { transpose_item(SrcWup{P.in[9], P.in[10], P.in[11], P.in[12]}, 384, (bf16*)(ws + WS_WUP), (r % 56) * 32, (r / 56) * 64, scr, lane); continue; } r -= I_UP;
        if (r < I_OUT) { transpose_item(SrcPlain{P.in[18], 1024, 0}, 1024, (bf16*)(ws + WS_WOUT), (r % 32) * 32, (r / 32) * 64, scr, lane); continue; } r -= I_OUT;
        transpose_item(SrcPlain{P.in[19], 256, 0}, 1024, (bf16*)(ws + WS_WR), (r % 8) * 32, (r / 8) * 64, scr, lane);
    }
    for (int it = gw; it < 96 * 16; it += NGW) {
        const int cg = it % 96, kp = it / 96;
#pragma unroll
        for (int r = 0; r < 5; ++r) { const float c = (r < 4 ? P.in[1] + r * DM : P.in[3])[kp * 64 + lane]; scr[r * 64 + lane] = c / (1.f + __expf(-c)); }
        LDS_WAIT(); asm volatile("" ::: "memory");
        float acc[5] = {0.f, 0.f, 0.f, 0.f, 0.f};
        const float* W = P.in[4] + (size_t)(kp * 64) * 6144 + cg * 64 + lane;
#pragma unroll 8
        for (int kk = 0; kk < 64; ++kk) { const float w = W[(size_t)kk * 6144];
#pragma unroll
            for (int r = 0; r < 5; ++r) acc[r] += scr[r * 64 + kk] * w; }
        LDS_WAIT(); asm volatile("" ::: "memory");
#pragma unroll
        for (int r = 0; r < 5; ++r) ((float*)(ws + WS_MODP))[(size_t)(kp * 5 + r) * 6144 + cg * 64 + lane] = acc[r];
    }
    { const int idx = (F.vcu * 512 + F.tid);
      if (idx < 1024) { const int v = idx / 16, f = idx % 16; const float th = (float)v * exp2f(-(float)f / 16.f * 13.287712379549449f);
          ((float2*)(ws + WS_TAB))[idx] = make_float2(__builtin_amdgcn_cosf(th * 0.15915494309189535f), __builtin_amdgcn_sinf(th * 0.15915494309189535f)); }
      else if (idx < 1536) { const int i2 = idx - 1024, v = i2 / 8, f = i2 % 8; const float th = (float)v * exp2f(-(float)f / 8.f * 13.287712379549449f);
          ((float2*)(ws + WS_TAB))[idx] = make_float2(__builtin_amdgcn_cosf(th * 0.15915494309189535f), __builtin_amdgcn_sinf(th * 0.15915494309189535f)); } }
}
struct CvItem { const float* src; int ld; bf16* dst; int K; };
__device__ __forceinline__ CvItem cv_decode(const Ptrs& P, int it, int lane) {
    constexpr int IPE = 256 + 128; unsigned char* ws = P.ws;
    const int e = it / IPE; int r = it % IPE; CvItem c;
    if (r < 256) { const int p0 = (r % 16) * 32, k0 = (r / 16) * 64, half = p0 >> 8, up = (p0 >> 7) & 1;
        const float* w = e < 256 ? (up ? P.in[22] : P.in[21]) + (size_t)e * DM * EFF : (up ? P.in[25] : P.in[24]);
        c.src = w + (size_t)(k0 + (lane >> 5)) * EFF + half * 128 + (p0 & 127) + (lane & 31); c.ld = EFF; c.K = 1024;
        c.dst = (bf16*)(ws + WS_W13) + ((size_t)e * 512 + p0) * 1024 + k0; }
    else { r -= 256; const int p0 = (r % 32) * 32, k0 = (r / 32) * 64;
        const float* w = e < 256 ? P.in[23] + (size_t)e * EFF * DM : P.in[26];
        c.src = w + (size_t)(k0 + (lane >> 5)) * DM + p0 + (lane & 31); c.ld = DM; c.K = 256;
        c.dst = (bf16*)(ws + WS_W2) + ((size_t)e * 1024 + p0) * 256 + k0; }
    return c;
}
#define CV_LOAD(t, c) do { _Pragma("unroll") for (int _i = 0; _i < 32; ++_i) t[_i] = (c).src[(size_t)(2 * _i) * (c).ld]; } while (0)
#define CV_FINISH(t, c) do { _Pragma("unroll") for (int _i = 0; _i < 32; ++_i) scr[(2 * _i + (lane >> 5)) * 33 + (lane & 31)] = t[_i]; \
        LDS_WAIT(); asm volatile("" ::: "memory"); const int _c = lane & 7; \
        _Pragma("unroll") for (int _j = 0; _j < 4; ++_j) { const int _n = (lane >> 3) + 8 * _j; const LAS float* _s = scr + (8 * _c) * 33 + _n; \
            u32x4 _o; _o.x = cvt_pk_bf16(_s[0 * 33], _s[1 * 33]); _o.y = cvt_pk_bf16(_s[2 * 33], _s[3 * 33]); _o.z = cvt_pk_bf16(_s[4 * 33], _s[5 * 33]); _o.w = cvt_pk_bf16(_s[6 * 33], _s[7 * 33]); \
            *(u32x4*)((c).dst + (size_t)_n * (c).K + 8 * _c) = _o; } \
        LDS_WAIT(); asm volatile("" ::: "memory"); } while (0)
constexpr int CV_EARLY = 0;
__device__ __forceinline__ void ph0_experts(Frame& F, int r_from, int r_to) {
    LAS float* scr = (LAS float*)(F.lds + F.wave * 16384);
    const int gw = F.vcu * NWAVES + F.wave, NGW = F.G * NWAVES, lane = F.lane, NIT = 257 * 384;
    const Ptrs& P = F.P;
    float ta[32], tb[32];
    const long lim = (long)gw + (long)(r_to < (1 << 20) ? r_to : (1 << 20)) * NGW; const int NE = (int)(lim < NIT ? lim : NIT);
    int it = gw + r_from * NGW; CvItem ca, cb;
    if (it < NE) { ca = cv_decode(P, it, lane); CV_LOAD(ta, ca); }
    for (; it < NE; it += 2 * NGW) {
        const int it2 = it + NGW, it3 = it + 2 * NGW;
        if (it2 < NE) { cb = cv_decode(P, it2, lane); CV_LOAD(tb, cb); }
        CV_FINISH(ta, ca);
        if (it3 < NE) { ca = cv_decode(P, it3, lane); CV_LOAD(ta, ca); }
        if (it2 < NE) CV_FINISH(tb, cb);
    }
    __syncthreads();
}
#undef CV_LOAD
#undef CV_FINISH
__device__ __forceinline__ void ph1_xn(Frame& F) {
    const Ptrs& P = F.P; unsigned char* ws = P.ws;
    const float* MODP = (const float*)(ws + WS_MODP);
    for (int idx = F.vcu * 512 + F.tid; idx < 5 * 6144; idx += F.G * 512) { const int r = idx / 6144, j = idx % 6144; float a = P.in[5][j];
#pragma unroll
        for (int kp = 0; kp < 16; ++kp) a += MODP[(size_t)(kp * 5 + r) * 6144 + j];
        ((float*)(ws + WS_MOD))[idx] = a; }
    const int RPB = (MALL + F.G - 1) / F.G, r_lo = F.vcu * RPB, r_hi = min(MALL, r_lo + RPB);
    if (r_lo >= r_hi) return;
    const int b0 = r_lo / NTOK, b1 = (r_hi - 1) / NTOK;
    LAS float* sm = (LAS float*)F.lds;
    for (int i = F.tid; i < 3 * 2048; i += 512) { const int sl = i / 2048, j = i % 2048; const int r = sl == 0 ? b0 : sl == 1 ? b1 : 4; float a = P.in[5][j];
#pragma unroll
        for (int kp = 0; kp < 16; ++kp) a += MODP[(size_t)(kp * 5 + r) * 6144 + j];
        sm[i] = a; }
    __syncthreads();
    auto rowsrc = [&](int r) -> const f32x4* { const int b = r / NTOK, n = r % NTOK;
        return (const f32x4*)(n < NCTX ? P.in[2] + ((size_t)b * NCTX + n) * DM : P.in[0] + ((size_t)b * SEQ + (n - NCTX)) * DM) + F.lane; };
    f32x4 v[4], nv[4];
    { const int r = r_lo + F.wave; if (r < r_hi) { const f32x4* xr = rowsrc(r);
#pragma unroll
        for (int j = 0; j < 4; ++j) v[j] = xr[64 * j]; } }
    for (int r = r_lo + F.wave; r < r_hi; r += NWAVES) {
        const int b = r / NTOK, n = r % NTOK;
        { const int rn = r + NWAVES < r_hi ? r + NWAVES : r; const f32x4* xr = rowsrc(rn);
#pragma unroll
          for (int j = 0; j < 4; ++j) nv[j] = xr[64 * j]; }
        const LAS float* md = sm + (n < NCTX ? 2 : (b == b0 ? 0 : 1)) * 2048;
        float s = 0.f;
#pragma unroll
        for (int j = 0; j < 4; ++j) s += (v[j][0] * v[j][0] + v[j][1] * v[j][1]) + (v[j][2] * v[j][2] + v[j][3] * v[j][3]);
        const float rs = rsqrtf(wave_sum(s) * (1.f / DM) + EPS);
        u32x2* o8 = (u32x2*)((bf16*)(ws + WS_XN) + (size_t)r * DM) + F.lane;
#pragma unroll
        for (int j = 0; j < 4; ++j) { const int c = 4 * F.lane + 256 * j; const f32x4 g = *(const f32x4*)(P.in[6] + c);
            const f32x4 sh = *(const LAS f32x4*)(md + c), sc = *(const LAS f32x4*)(md + 1024 + c);
            const f32x4 y = (v[j] * rs * g) * (sc + 1.f) + sh;
            u32x2 w; w.x = cvt_pk_bf16(y[0], y[1]); w.y = cvt_pk_bf16(y[2], y[3]); o8[64 * j] = w; }
#pragma unroll
        for (int j = 0; j < 4; ++j) v[j] = nv[j];
    }
    __syncthreads();
}
__device__ __forceinline__ void ph6_h2(Frame& F) {
    const Ptrs& P = F.P; unsigned char* ws = P.ws;
    const int gw = F.vcu * NWAVES + F.wave, NGW = F.G * NWAVES;
    f32x4 v[4], nv[4];
    if (gw < MLAT) { const f32x4* xr = (const f32x4*)((const float*)(ws + WS_X1) + (size_t)gw * DM) + F.lane;
#pragma unroll
        for (int j = 0; j < 4; ++j) v[j] = xr[64 * j]; }
    for (int t = gw; t < MLAT; t += NGW) {
        const int b = t / SEQ; const float* md = (const float*)(ws + WS_MOD) + b * 6144;
        { const int tn = t + NGW < MLAT ? t + NGW : t; const f32x4* xr = (const f32x4*)((const float*)(ws + WS_X1) + (size_t)tn * DM) + F.lane;
#pragma unroll
          for (int j = 0; j < 4; ++j) nv[j] = xr[64 * j]; }
        float s = 0.f;
#pragma unroll
        for (int j = 0; j < 4; ++j) s += (v[j][0] * v[j][0] + v[j][1] * v[j][1]) + (v[j][2] * v[j][2] + v[j][3] * v[j][3]);
        const float rs = rsqrtf(wave_sum(s) * (1.f / DM) + EPS);
        u32x2* o8 = (u32x2*)((bf16*)(ws + WS_H2) + (size_t)t * DM) + F.lane;
#pragma unroll
        for (int j = 0; j < 4; ++j) { const int c = 4 * F.lane + 256 * j; const f32x4 g = *(const f32x4*)(P.in[7] + c);
            const f32x4 sh = *(const f32x4*)(md + 3072 + c), sc = *(const f32x4*)(md + 4096 + c);
            const f32x4 y = (v[j] * rs * g) * (sc + 1.f) + sh;
            u32x2 w; w.x = cvt_pk_bf16(y[0], y[1]); w.y = cvt_pk_bf16(y[2], y[3]); o8[64 * j] = w; }
#pragma unroll
        for (int j = 0; j < 4; ++j) v[j] = nv[j];
    }
}
__device__ __forceinline__ void ph7_route(Frame& F) {
    const Ptrs& P = F.P; unsigned char* ws = P.ws; const int lane = F.lane;
    const int gw = F.vcu * NWAVES + F.wave, NGW = F.G * NWAVES;
    const f32x4 bi = ((const f32x4*)P.in[20])[lane];
    for (int t = gw; t < MLAT; t += NGW) {
        f32x4 lg = ((const f32x4*)(ws + WS_LOGP))[(size_t)t * 64 + lane];
#pragma unroll
        for (int kp = 1; kp < 4; ++kp) lg += ((const f32x4*)(ws + WS_LOGP))[((size_t)kp * MLAT + t) * 64 + lane];
        float s[4], v[4];
#pragma unroll
        for (int i = 0; i < 4; ++i) { s[i] = 1.f / (1.f + __expf(-lg[i])); v[i] = s[i] + bi[i]; }
        float m1 = fmaxf(v[0], v[1]), m2 = fminf(v[0], v[1]);
#pragma unroll
        for (int i = 2; i < 4; ++i) { const float x = v[i]; m2 = fmaxf(m2, fminf(m1, x)); m1 = fmaxf(m1, x); }
#pragma unroll
        for (int o = 1; o < 8; o <<= 1) { const float b1 = __shfl_xor(m1, o), b2 = __shfl_xor(m2, o); const float n1 = fmaxf(m1, b1), n2 = fmaxf(fminf(m1, b1), fmaxf(m2, b2)); m1 = n1; m2 = n2; }
        const float gs = m1 + m2; const int g = lane >> 3; int rank = 0;
#pragma unroll
        for (int j = 0; j < 8; ++j) { const float o = __shfl(gs, j * 8); rank += (o > gs || (o == gs && j < g)) ? 1 : 0; }
        if (rank >= 4) { v[0] = v[1] = v[2] = v[3] = -INFINITY; }
        int my_e = 0; float my_s = 0.f, ssum = 0.f;
#pragma unroll
        for (int k = 0; k < 8; ++k) {
            float bv = v[0]; int bi_ = 0;
#pragma unroll
            for (int i = 1; i < 4; ++i) if (v[i] > bv) { bv = v[i]; bi_ = i; }
            int be = lane * 4 + bi_;
#pragma unroll
            for (int o = 1; o < 64; o <<= 1) { const float ov = __shfl_xor(bv, o); const int oe = __shfl_xor(be, o); if (ov > bv || (ov == bv && oe < be)) { bv = ov; be = oe; } }
            const int wl = be >> 2, wi = be & 3;
            float sv = wi == 0 ? s[0] : wi == 1 ? s[1] : wi == 2 ? s[2] : s[3];
            sv = __shfl(sv, wl);
            if (lane == wl) { if (wi == 0) v[0] = -INFINITY; else if (wi == 1) v[1] = -INFINITY; else if (wi == 2) v[2] = -INFINITY; else v[3] = -INFINITY; }
            ssum += sv; if (lane == k) { my_e = be; my_s = sv; }
        }
        if (lane < 8) {
            int* cnt = (int*)(ws + WS_CTL) + CW_COUNT;
            const int rk = atomicAdd(&cnt[my_e], 1);
            ((int*)(ws + WS_EIDX))[(size_t)t * 8 + lane] = my_e;
            ((float*)(ws + WS_EW))[(size_t)t * 8 + lane] = my_s / ssum * 2.5f;
            ((int*)(ws + WS_ERANK))[(size_t)t * 8 + lane] = rk;
        }
    }
}
__device__ __forceinline__ void ph_route3(Frame& F) {
    const Ptrs& P = F.P; unsigned char* ws = P.ws; const int lane = F.lane, wave = F.wave, fr = lane & 15, fq = lane >> 4;
    LAS unsigned char* At = F.lds;
    const bf16* Wr = (const bf16*)(ws + WS_WR);
    const f32x4 bi = ((const f32x4*)P.in[20])[lane];
    for (int grp = F.vcu; grp < MLAT / 64; grp += F.G) {
        const int t0 = grp * 64, b = t0 / SEQ; const float* md = (const float*)(ws + WS_MOD) + b * 6144;
        u32x4 v[2], nv[2];
        { const u32x4* xr = (const u32x4*)((const bf16*)(ws + WS_X1) + (size_t)(t0 + wave * 8) * DM) + lane; v[0] = xr[0]; v[1] = xr[64]; }
#pragma unroll 1
        for (int i = 0; i < 8; ++i) {
            const int r = wave * 8 + i, t = t0 + r;
            { const int rn = i < 7 ? t + 1 : t; const u32x4* xr = (const u32x4*)((const bf16*)(ws + WS_X1) + (size_t)rn * DM) + lane; nv[0] = xr[0]; nv[1] = xr[64]; }
            float xf[2][8]; float s = 0.f;
#pragma unroll
            for (int h = 0; h < 2; ++h)
#pragma unroll
                for (int d = 0; d < 4; ++d) { xf[h][2 * d] = bflo(v[h][d]); xf[h][2 * d + 1] = bfhi(v[h][d]); s += xf[h][2 * d] * xf[h][2 * d] + xf[h][2 * d + 1] * xf[h][2 * d + 1]; }
            const float rs = rsqrtf(wave_sum(s) * (1.f / DM) + EPS);
#pragma unroll
            for (int h = 0; h < 2; ++h) { const int c = 8 * lane + 512 * h; f32x4 y[2];
#pragma unroll
                for (int q = 0; q < 2; ++q) { const f32x4 g = *(const f32x4*)(P.in[7] + c + 4 * q), sh = *(const f32x4*)(md + 3072 + c + 4 * q), sc = *(const f32x4*)(md + 4096 + c + 4 * q);
                    const f32x4 xv = {xf[h][4 * q], xf[h][4 * q + 1], xf[h][4 * q + 2], xf[h][4 * q + 3]}; y[q] = (xv * rs * g) * (sc + 1.f) + sh; }
                const u32x4 w = pack8(y[0], y[1]);
                *(u32x4*)((bf16*)(ws + WS_H2) + (size_t)t * DM + c) = w;
                const int ch = lane + 64 * h;
                *(LAS u32x4*)(At + r * 2048 + ((ch ^ (r & 15)) << 4)) = w; }
            v[0] = nv[0]; v[1] = nv[1];
        }
        __syncthreads();
        f32x4 acc[4][2];
#pragma unroll
        for (int m = 0; m < 4; ++m) { acc[m][0] = (f32x4){0.f, 0.f, 0.f, 0.f}; acc[m][1] = (f32x4){0.f, 0.f, 0.f, 0.f}; }
        const bf16* wb = Wr + (size_t)(wave * 32 + fr) * 1024 + 8 * fq;
        bf16x8 bq[4][2], nb[4][2];
#pragma unroll
        for (int u = 0; u < 4; ++u) { bq[u][0] = *(const bf16x8*)(wb + 32 * u); bq[u][1] = *(const bf16x8*)(wb + 16 * 1024 + 32 * u); }
#pragma unroll 1
        for (int k4 = 0; k4 < 8; ++k4) {
            if (k4 < 7) {
#pragma unroll
                for (int u = 0; u < 4; ++u) { nb[u][0] = *(const bf16x8*)(wb + 32 * (4 * (k4 + 1) + u)); nb[u][1] = *(const bf16x8*)(wb + 16 * 1024 + 32 * (4 * (k4 + 1) + u)); } }
#pragma unroll
            for (int u = 0; u < 4; ++u) { const int ks = 4 * k4 + u, ch = 4 * ks + fq;
#pragma unroll
                for (int m = 0; m < 4; ++m) { const int r = 16 * m + fr;
                    const bf16x8 a = *(const LAS bf16x8*)(At + r * 2048 + ((ch ^ (r & 15)) << 4));
                    acc[m][0] = __builtin_amdgcn_mfma_f32_16x16x32_bf16(bq[u][0], a, acc[m][0], 0, 0, 0);
                    acc[m][1] = __builtin_amdgcn_mfma_f32_16x16x32_bf16(bq[u][1], a, acc[m][1], 0, 0, 0); } }
#pragma unroll
            for (int u = 0; u < 4; ++u) { bq[u][0] = nb[u][0]; bq[u][1] = nb[u][1]; }
        }
        __syncthreads();
        LAS float* Lg = (LAS float*)F.lds;
#pragma unroll
        for (int m = 0; m < 4; ++m)
#pragma unroll
            for (int n = 0; n < 2; ++n) *(LAS f32x4*)(Lg + (16 * m + fr) * 260 + wave * 32 + 16 * n + 4 * fq) = acc[m][n];
        __syncthreads();
#pragma unroll 1
        for (int i = 0; i < 8; ++i) {
            const int r = wave * 8 + i, t = t0 + r;
            const f32x4 lg = *(const LAS f32x4*)(Lg + r * 260 + 4 * lane);
            float s[4], vv[4];
#pragma unroll
            for (int q = 0; q < 4; ++q) { s[q] = 1.f / (1.f + __expf(-lg[q])); vv[q] = s[q] + bi[q]; }
            float m1 = fmaxf(vv[0], vv[1]), m2 = fminf(vv[0], vv[1]);
#pragma unroll
            for (int q = 2; q < 4; ++q) { const float x = vv[q]; m2 = fmaxf(m2, fminf(m1, x)); m1 = fmaxf(m1, x); }
#pragma unroll
            for (int o = 1; o < 8; o <<= 1) { const float b1 = __shfl_xor(m1, o), b2 = __shfl_xor(m2, o); const float n1 = fmaxf(m1, b1), n2 = fmaxf(fminf(m1, b1), fmaxf(m2, b2)); m1 = n1; m2 = n2; }
            const float gs = m1 + m2; const int g = lane >> 3; int rank = 0;
#pragma unroll
            for (int j = 0; j < 8; ++j) { const float o = __builtin_bit_cast(float, __builtin_amdgcn_readlane(__builtin_bit_cast(int, gs), j * 8)); rank += (o > gs || (o == gs && j < g)) ? 1 : 0; }
            unsigned key[4];
#pragma unroll
            for (int q = 0; q < 4; ++q) key[q] = rank >= 4 ? 0u : ((__builtin_bit_cast(unsigned, vv[q] + 1.f) & 0xFFFFFF00u) | (unsigned)(255 - (lane * 4 + q)));
            int my_e = 0; float my_s = 0.f, ssum = 0.f;
#pragma unroll
            for (int k = 0; k < 8; ++k) {
                unsigned kb = max(max(key[0], key[1]), max(key[2], key[3]));
                kb = max(kb, (unsigned)__builtin_amdgcn_update_dpp(0, (int)kb, 0x111, 0xf, 0xf, false));
                kb = max(kb, (unsigned)__builtin_amdgcn_update_dpp(0, (int)kb, 0x112, 0xf, 0xf, false));
                kb = max(kb, (unsigned)__builtin_amdgcn_update_dpp(0, (int)kb, 0x114, 0xf, 0xf, false));
                kb = max(kb, (unsigned)__builtin_amdgcn_update_dpp(0, (int)kb, 0x118, 0xf, 0xf, false));
                kb = max(kb, (unsigned)__builtin_amdgcn_update_dpp(0, (int)kb, 0x142, 0xa, 0xf, false));
                kb = max(kb, (unsigned)__builtin_amdgcn_update_dpp(0, (int)kb, 0x143, 0xc, 0xf, false));
                const unsigned kw = (unsigned)__builtin_amdgcn_readlane((int)kb, 63);
                const int be = 255 - (int)(kw & 255u), wl = be >> 2, wi = be & 3;
                const float ssel = wi == 0 ? s[0] : wi == 1 ? s[1] : wi == 2 ? s[2] : s[3];
                const float sv = __builtin_bit_cast(float, __builtin_amdgcn_readlane(__builtin_bit_cast(int, ssel), wl));
#pragma unroll
                for (int q = 0; q < 4; ++q) key[q] = key[q] == kw ? 0u : key[q];
                ssum += sv; if (lane == k) { my_e = be; my_s = sv; }
            }
            if (lane < 8) {
                int* cnt = (int*)(ws + WS_CTL) + CW_COUNT;
                const int rk = atomicAdd(&cnt[my_e], 1);
                ((int*)(ws + WS_EIDX))[(size_t)t * 8 + lane] = my_e;
                ((float*)(ws + WS_EW))[(size_t)t * 8 + lane] = my_s / ssum * 2.5f;
                ((int*)(ws + WS_ERANK))[(size_t)t * 8 + lane] = rk;
            }
        }
        __syncthreads();
    }
}
__device__ __forceinline__ void ph8_slots(Frame& F) {
    const Ptrs& P = F.P; unsigned char* ws = P.ws;
    LAS int* off = (LAS int*)F.lds;
    LAS int* cfs = off + 260;
    LAS int* chs = off + 520;
    unsigned* cnt = (unsigned*)(ws + WS_CTL) + CW_COUNT;
    if (F.wave == 0) { const int lane = F.lane; int n[4], cf[4], ch[4], sn = 0, sf = 0, sh = 0;
#pragma unroll
        for (int i = 0; i < 4; ++i) { n[i] = (int)cnt[4 * lane + i]; const int r = n[i] & 255; cf[i] = (n[i] >> 8) + (r > 128 ? 1 : 0); ch[i] = (r > 0 && r <= 128) ? 1 : 0; sn += n[i]; sf += cf[i]; sh += ch[i]; }
        int in = sn, jf = sf, jh = sh;
#pragma unroll
        for (int o = 1; o < 64; o <<= 1) { const int tn = __shfl_up(in, o), tf = __shfl_up(jf, o), th = __shfl_up(jh, o); if (lane >= o) { in += tn; jf += tf; jh += th; } }
        int an = in - sn, af = jf - sf, ah = jh - sh;
#pragma unroll
        for (int i = 0; i < 4; ++i) { off[4 * lane + i] = an; cfs[4 * lane + i] = af; chs[4 * lane + i] = ah; an += n[i]; af += cf[i]; ah += ch[i]; }
        if (lane == 63) { off[256] = an; cfs[256] = af; chs[256] = ah; off[257] = NSLOT; cfs[257] = af + MLAT / 256; chs[257] = ah; } }
    __syncthreads();
    for (int idx = F.vcu * 512 + F.tid; idx < MLAT * 8; idx += F.G * 512) {
        const int e = ((const int*)(ws + WS_EIDX))[idx], rk = ((const int*)(ws + WS_ERANK))[idx];
        const int slot = off[e] + rk;
        ((int*)(ws + WS_SLOTOF))[idx] = slot; ((int*)(ws + WS_SLOTTOK))[slot] = idx >> 3; ((float*)(ws + WS_SLOTW))[slot] = ((const float*)(ws + WS_EW))[idx];
        if (idx < MLAT) { ((int*)(ws + WS_SLOTTOK))[MLAT * 8 + idx] = idx; ((float*)(ws + WS_SLOTW))[MLAT * 8 + idx] = 1.f; }
    }
    if (F.vcu == 0) {
        int* go = (int*)(ws + WS_OFF); int* ut = (int*)(ws + WS_UT);
        const int nfull = cfs[257];
        for (int e = F.tid; e < 258; e += 512) go[e] = off[e];
        for (int e = F.tid; e < 257; e += 512) { const int n = off[e + 1] - off[e], nf = cfs[e + 1] - cfs[e], nh = chs[e + 1] - chs[e];
            for (int j = 0; j < nf; ++j) { int* u = ut + (cfs[e] + j) * 4; u[0] = e; u[1] = off[e] + j * 256; u[2] = min(256, n - j * 256); u[3] = 0; }
            if (nh) { int* u = ut + (nfull + chs[e]) * 4; u[0] = e; u[1] = off[e] + nf * 256; u[2] = n - nf * 256; u[3] = 0; } }
        if (F.tid == 0) { ((int*)(ws + WS_CTL))[CW_NUNIT] = nfull + chs[257]; ((int*)(ws + WS_CTL))[CW_NFULL] = nfull; }
    }
    __syncthreads();
}
__device__ __forceinline__ void ph11_combine(Frame& F) {
    const Ptrs& P = F.P; unsigned char* ws = P.ws; const int lane = F.lane;
    const int gw = F.vcu * NWAVES + F.wave, NGW = F.G * NWAVES;
    const unsigned char* Y = (const unsigned char*)(ws + WS_Y);
    const int cbase = 256 * (lane >> 4) + 32 * ((lane >> 2) & 3) + 8 * (lane & 3);
    u32x4 yw[9], nyw[9]; u32x4 xw[2], nxw[2]; int nsl[8];
    auto ldslots = [&](int t) {
#pragma unroll
        for (int k = 0; k < 8; ++k) nsl[k] = ((const int*)(ws + WS_SLOTOF))[(size_t)t * 8 + k]; };
    auto ldrows = [&](int t) {
#pragma unroll
        for (int k = 0; k < 9; ++k) { const int sl = k < 8 ? nsl[k] : MLAT * 8 + t; nyw[k] = *(const u32x4*)(Y + (size_t)sl * DM + lane * 16); }
        nxw[0] = *(const u32x4*)((const bf16*)(ws + WS_X1) + (size_t)t * DM + cbase); nxw[1] = *(const u32x4*)((const bf16*)(ws + WS_X1) + (size_t)t * DM + cbase + 128); };
    if (gw < MLAT) { ldslots(gw); ldrows(gw); if (gw + NGW < MLAT) ldslots(gw + NGW); }
    for (int t = gw; t < MLAT; t += NGW) {
        const int b = t / SEQ; const float* gt2 = (const float*)(ws + WS_MOD) + b * 6144 + 5120;
#pragma unroll
        for (int k = 0; k < 9; ++k) yw[k] = nyw[k];
        xw[0] = nxw[0]; xw[1] = nxw[1];
        if (t + NGW < MLAT) { ldrows(t + NGW); if (t + 2 * NGW < MLAT) ldslots(t + 2 * NGW); }
        float a[16];
#pragma unroll
        for (int i = 0; i < 16; ++i) a[i] = 0.f;
#pragma unroll
        for (int k = 0; k < 9; ++k)
#pragma unroll
            for (int d = 0; d < 4; ++d) { const int w = (int)yw[k][d];
                const f32x2 lo = __builtin_amdgcn_cvt_pk_f32_fp8(w, false), hi = __builtin_amdgcn_cvt_pk_f32_fp8(w, true);
                a[4 * d + 0] += lo[0]; a[4 * d + 1] += lo[1]; a[4 * d + 2] += hi[0]; a[4 * d + 3] += hi[1]; }
        float ss = 0.f;
#pragma unroll
        for (int q = 0; q < 4; ++q) { const int c = cbase + (q >> 1) * 128 + (q & 1) * 4; const u32x4 xb = xw[q >> 1]; const unsigned x01 = (q & 1) ? xb.z : xb.x, x23 = (q & 1) ? xb.w : xb.y;
            const f32x4 xv = {bflo(x01), bfhi(x01), bflo(x23), bfhi(x23)}, gv = *(const f32x4*)(gt2 + c);
#pragma unroll
            for (int e = 0; e < 4; ++e) { const float v = xv[e] + gv[e] * (a[q * 4 + e] * (1.f / YSCALE)); a[q * 4 + e] = v; ss += v * v; } }
        const float rs = rsqrtf(wave_sum(ss) * (1.f / DM) + EPS);
#pragma unroll
        for (int q = 0; q < 4; ++q) { const int c = cbase + (q >> 1) * 128 + (q & 1) * 4; const f32x4 gf = *(const f32x4*)(P.in[27] + c);
            f32x4 o;
#pragma unroll
            for (int e = 0; e < 4; ++e) o[e] = a[q * 4 + e] * rs * gf[e];
            *(f32x4*)(P.out + (size_t)t * DM + c) = o; }
    }
}
__device__ __forceinline__ void ph4b_diff_finish(Frame& F) {
    const Ptrs& P = F.P; unsigned char* ws = P.ws; const int lane = F.lane;
    const int gw = F.vcu * NWAVES + F.wave, NGW = F.G * NWAVES;
    float d1 = P.in[13][lane] * P.in[14][lane], d2 = P.in[15][lane] * P.in[16][lane];
    d1 = wave_sum(d1); d2 = wave_sum(d2);
    const float lam = __expf(d1) - __expf(d2) + LAM_INIT;
    const float g0 = P.in[17][lane], g1 = P.in[17][64 + lane];
    for (int t = gw; t < MLAT; t += NGW) {
        const float* os = (const float*)(ws + WS_OS) + (size_t)t * 8 * 128;
        float x[4][4];
#pragma unroll
        for (int h = 0; h < 4; ++h) { x[h][0] = os[(2 * h) * 128 + lane]; x[h][1] = os[(2 * h) * 128 + 64 + lane]; x[h][2] = os[(2 * h + 1) * 128 + lane]; x[h][3] = os[(2 * h + 1) * 128 + 64 + lane]; }
#pragma unroll
        for (int h = 0; h < 4; ++h) {
            const float v0 = x[h][0] - lam * x[h][2], v1 = x[h][1] - lam * x[h][3];
            const float rs = rsqrtf(wave_sum(v0 * v0 + v1 * v1) * (1.f / 128.f) + EPS) * (1.f - LAM_INIT);
            bf16* mo = (bf16*)(ws + WS_MIX) + (size_t)t * DM + 512 + h * 128;
            mo[lane] = (bf16)f2bf(v0 * rs * g0); mo[64 + lane] = (bf16)f2bf(v1 * rs * g1); }
    }
}

enum { P_PREP = 0, P_XN, P_INPROJ, P_UP, P_ATTN, P_DIFFFIN, P_OUT, P_H2, P_ROUTER, P_ROUTE, P_SLOTS, P_EXP1, P_EXP2, P_COMB, P_END };
struct Args { Ptrs P; int ph_lo, ph_hi, li, pad; };
__global__ void __launch_bounds__(NWAVES * 64, 2) mk_fwd(Args args) {
    extern __shared__ __attribute__((aligned(16))) unsigned char lds[];
    Frame F;
    F.lds = (LAS unsigned char*)lds; F.MISC = (volatile LAS unsigned*)(F.lds + MISC_OFF);
    F.tid = threadIdx.x; F.lane = F.tid & 63; F.wave = __builtin_amdgcn_readfirstlane(F.tid >> 6);
    F.G = gridDim.x; { const int bx = blockIdx.x; F.vcu = (F.G % 8 == 0) ? (bx % 8) * (F.G / 8) + bx / 8 : bx; }
    F.P = args.P; unsigned char* ws = args.P.ws; F.ctl = (unsigned*)(ws + WS_CTL);
    for (int u = F.tid; u < (LDS_BYTES - LDSCTL_OFF) / 4; u += NWAVES * 64) ((LAS unsigned*)(F.lds + LDSCTL_OFF))[u] = 0u;
    __syncthreads();
    XcdBarrier bar = xcd_barrier_post(F.ctl + CW_BAR + args.li * XCD_BAR_WORDS, F.MISC + 8);
    const int lo = args.ph_lo, hi = args.ph_hi;
#ifndef PHMASK
#define PHMASK 0xFFFF
#endif
#define IN(k) ((((PHMASK) >> (k)) & 1) && lo <= (k) && (k) < hi)
#define SEAM(k) do { if (IN(k) && IN((k) + 1)) xcd_barrier(bar); } while (0)
#define SEAM_SKIP1(k) do { if (IN(k) && IN((k) + 2)) xcd_barrier(bar); } while (0)
#define SEAM_SKIP2(k) do { if (IN(k) && IN((k) + 3)) xcd_barrier(bar); } while (0)
    if (IN(P_PREP)) { ph0_prep(F); } SEAM(P_PREP);
    if (IN(P_XN)) { ph1_xn(F); } SEAM(P_XN);
    if (IN(P_INPROJ)) {
        pg8::Gemm g{(const bf16*)(ws + WS_XN), (const bf16*)(ws + WS_WIN), 1024, 1024, 1024}; pg8::StaticOrder S; S.init(MALL, NP1, F.G, (int)blockIdx.x);
        EpiInProj E{(bf16*)(ws + WS_P1), (float*)(ws + WS_SSQ), (const float2*)(ws + WS_TAB), (const float2*)(ws + WS_TAB) + 1024};
        pg8::gemm_phase(F.lds, g, S, E);
        if (CV_EARLY > 0 && (int)blockIdx.x >= (MALL / 256) * (NP1 / 256) - 2 * F.G) ph0_experts(F, 0, CV_EARLY);
    } SEAM(P_INPROJ);
    if (IN(P_UP)) {
        pg8::Gemm g{(const bf16*)(ws + WS_P1), (const bf16*)(ws + WS_WUP), 2048, 384, 256}; UpOrder S{F.G, F.vcu};
        EpiUp E{(bf16*)(ws + WS_QM), (bf16*)(ws + WS_KVM), (const float*)(ws + WS_SSQ), (const float2*)(ws + WS_TAB) + 1024};
        pg8::gemm_phase(F.lds, g, S, E);
    } SEAM(P_UP);
    if (IN(P_ATTN)) {
        const bf16* P1 = (const bf16*)(ws + WS_P1); const bf16* QM = (const bf16*)(ws + WS_QM); const bf16* KVM = (const bf16*)(ws + WS_KVM);
        const int cslot = F.vcu % 5; int ui = 0;
        bool conv_done = false; int U = F.vcu;
        const int conv_from = ((int)blockIdx.x >= (MALL / 256) * (NP1 / 256) - 2 * F.G) ? CV_EARLY : 0;
        float lam; { float d1 = F.P.in[13][F.lane] * F.P.in[14][F.lane], d2 = F.P.in[15][F.lane] * F.P.in[16][F.lane]; d1 = wave_sum(d1); d2 = wave_sum(d2); lam = __expf(d1) - __expf(d2) + LAM_INIT; }
        for (; U < 512; U += F.G, ++ui) {
            if (ui == cslot) { ph0_experts(F, conv_from, 1 << 30); conv_done = true; }
            const int bh = U >> 4, qb = U & 15, b = bh >> 3, hh = bh & 7;
            const bf16* K0 = KVM + (size_t)b * NTOK * 1024 + hh * 128;
            attn::unit<0, 0>(QM + (size_t)(b * NTOK + NCTX + qb * 256) * 768 + hh * 96, K0, P1 + (size_t)b * NTOK * NP1 + 384, K0 + 64,
                             (bf16*)(ws + WS_MIX) + (size_t)(b * SEQ + qb * 256) * DM + hh * 64, DM, F.lds_c(), nullptr, 0.f, nullptr);
        }
        char* stash = (char*)(ws + WS_OS) + (size_t)F.vcu * 65536;
        const int Ud0 = U;
        for (; U < 768; U += 1024, ++ui) {
            if (ui == cslot) { ph0_experts(F, conv_from, 1 << 30); conv_done = true; }
            const int Up = U - 512, bh = Up >> 4, qb = Up & 15, b = bh >> 2, h = bh & 3;
            const bf16* Pb = P1 + (size_t)b * NTOK * NP1;
            attn::unit<1, 1>(P1 + (size_t)(b * NTOK + NCTX + qb * 256) * NP1 + 512 + (2 * h) * 64, Pb + 1024 + (2 * h) * 64, nullptr, Pb + 1536 + h * 128, nullptr, 0, F.lds_c(),
                             stash, 0.f, nullptr);
        }
        for (U = Ud0; U < 768; U += 1024, ++ui) {
            if (ui == cslot) { ph0_experts(F, conv_from, 1 << 30); conv_done = true; }
            const int Up = U - 512, bh = Up >> 4, qb = Up & 15, b = bh >> 2, h = bh & 3;
            const bf16* Pb = P1 + (size_t)b * NTOK * NP1;
            attn::unit<1, 2>(P1 + (size_t)(b * NTOK + NCTX + qb * 256) * NP1 + 512 + (2 * h + 1) * 64, Pb + 1024 + (2 * h + 1) * 64, nullptr, Pb + 1536 + h * 128,
                             (bf16*)(ws + WS_MIX) + (size_t)(b * SEQ + qb * 256) * DM + 512 + h * 128, DM, F.lds_c(), stash, lam, F.P.in[17]);
        }
        if (!conv_done) ph0_experts(F, conv_from, 1 << 30);
    } SEAM_SKIP1(P_ATTN);
    if (IN(P_OUT)) {
        pg8::Gemm g{(const bf16*)(ws + WS_MIX), (const bf16*)(ws + WS_WOUT), 1024, 1024, 1024}; pg8::StaticOrder S; S.init(MLAT, DM, F.G, (int)blockIdx.x);
        EpiOut E{F.P.in[0], (const float*)(ws + WS_MOD), (bf16*)(ws + WS_X1)};
        pg8::gemm_phase(F.lds, g, S, E);
    } SEAM(P_OUT);
    if (IN(P_H2)) { ph_route3(F); } SEAM_SKIP2(P_H2);
    if (IN(P_SLOTS)) { ph8_slots(F); } SEAM(P_SLOTS);
    if (IN(P_EXP1)) {
        const int nu = (int)xb_ld(F.ctl + CW_NUNIT), nfu = (int)xb_ld(F.ctl + CW_NFULL); LAS int* uc = (LAS int*)(F.lds + UCACHE_OFF);
        const int nmine = exp_units_to_lds<2>(uc, (const int*)(ws + WS_UT), nu, nfu, F.G, F.vcu);
        pg8::Gemm g{(const bf16*)(ws + WS_H2), (const bf16*)(ws + WS_W13), 1024, 1024, 1024};
        ExpSched<2, true> S{uc, nmine, (const int*)(ws + WS_SLOTTOK)};
        EpiAct E{(bf16*)(ws + WS_ACT), (const float*)(ws + WS_SLOTW)};
        pg8::gemm_phase(F.lds, g, S, E);
    } SEAM(P_EXP1);
    if (IN(P_EXP2)) {
        const int nu = (int)xb_ld(F.ctl + CW_NUNIT), nfu = (int)xb_ld(F.ctl + CW_NFULL); LAS int* uc = (LAS int*)(F.lds + UCACHE_OFF);
        const int nmine = exp_units_to_lds<4>(uc, (const int*)(ws + WS_UT), nu, nfu, F.G, F.vcu);
        pg8::Gemm g{(const bf16*)(ws + WS_ACT), (const bf16*)(ws + WS_W2), 256, 256, 256};
        ExpSched<4, false> S{uc, nmine, nullptr};
        EpiY E{(unsigned char*)(ws + WS_Y)};
        pg8::gemm_phase(F.lds, g, S, E);
    } SEAM(P_EXP2);
    if (IN(P_COMB)) { ph11_combine(F); }
#undef IN
#undef SEAM
}

static int g_grid = 0;
static int mk_setup() {
    if (g_grid) return g_grid;
    int dev = 0, cus = 0;
    if (hipGetDevice(&dev) != hipSuccess || hipDeviceGetAttribute(&cus, hipDeviceAttributeMultiprocessorCount, dev) != hipSuccess) { fprintf(stderr, "kernel_launch: device query failed\n"); g_grid = -1; return -1; }
    if (hipFuncSetAttribute((const void*)mk_fwd, hipFuncAttributeMaxDynamicSharedMemorySize, LDS_BYTES) != hipSuccess) { fprintf(stderr, "kernel_launch: hipFuncSetAttribute failed\n"); g_grid = -1; return -1; }
    int per_cu = 0;
    if (hipOccupancyMaxActiveBlocksPerMultiprocessor(&per_cu, (const void*)mk_fwd, NWAVES * 64, LDS_BYTES) != hipSuccess || per_cu < 1) { fprintf(stderr, "kernel_launch: occupancy query says %d blocks/CU\n", per_cu); }
    (void)hipGetLastError();
    g_grid = cus;
    return g_grid;
}
static void mk_run(const Ptrs& P, int lo, int hi, int li, hipStream_t stream) {
    Args a{}; a.P = P; a.ph_lo = lo; a.ph_hi = hi; a.li = li; a.pad = 0;
    hipLaunchKernelGGL(mk_fwd, dim3(g_grid), dim3(NWAVES * 64), LDS_BYTES, stream, a);
}
extern "C" void kernel_launch(void* const* d_in, const int* in_sizes, int n_in, void* d_out, int out_size, void* d_ws, size_t ws_size, hipStream_t stream) {
    if (n_in != 28 || out_size != MLAT * DM || ws_size < WS_END) { fprintf(stderr, "kernel_launch: unexpected shapes n_in %d out %d ws %zu\n", n_in, out_size, ws_size); return; }
    if (mk_setup() <= 0) return;
    Ptrs P{}; for (int i = 0; i < 28; ++i) P.in[i] = (const float*)d_in[i]; P.out = (float*)d_out; P.ws = (unsigned char*)d_ws;
    (void)hipMemsetAsync((char*)d_ws + WS_CTL, 0, 1 * MiB, stream);
    int li = 0;
#define FAST(lo, hi) mk_run(P, lo, hi, li++, stream)
    FAST(P_PREP, P_COMB + 1);
#undef FAST
}
```

```cpp
#include <hip/hip_runtime.h>
#include <cstdio>
#include <cstdint>

constexpr int NB = 4, SEQ = 4096, NCTX = 256, NTOK = SEQ + NCTX, DM = 1024;
constexpr int MALL = NB * NTOK;
constexpr int MLAT = NB * SEQ;
constexpr int IN_COLS = 1952, NP1 = 2048;
constexpr int NEXP = 256, TOPK = 8, EFF = 256;
constexpr int NSLOT = MLAT * TOPK + MLAT;
constexpr float EPS = 1e-6f;
constexpr float LAM_INIT = 0.2f;

typedef unsigned short bf16;
__device__ __forceinline__ unsigned f2bf(float f) { unsigned u = __builtin_bit_cast(unsigned, f); return (u + 0x7fffu + ((u >> 16) & 1u)) >> 16; }
__device__ __forceinline__ float bf2f(bf16 h) { return __builtin_bit_cast(float, (unsigned)h << 16); }

constexpr size_t MiB = 1u << 20;
constexpr size_t WS_CTL = 0;
constexpr size_t WS_MOD = 3 * MiB;
constexpr size_t WS_TAB = 3 * MiB + 512 * 1024;
constexpr size_t WS_X1 = 402 * MiB;
constexpr size_t WS_SSQ = 466 * MiB;
constexpr size_t WS_EIDX = 467 * MiB;
constexpr size_t WS_EW = WS_EIDX + 512 * 1024;
constexpr size_t WS_ERANK = 468 * MiB;
constexpr size_t WS_SLOTOF = WS_ERANK + 512 * 1024;
constexpr size_t WS_SLOTTOK = 469 * MiB;
constexpr size_t WS_SLOTW = 470 * MiB;
constexpr size_t WS_OFF = 471 * MiB;
constexpr size_t WS_XN = 472 * MiB;
constexpr size_t WS_P1 = 506 * MiB;
constexpr size_t WS_QM = 574 * MiB;
constexpr size_t WS_KVM = 600 * MiB;
constexpr size_t WS_MIX = 634 * MiB;
constexpr size_t WS_OS = 666 * MiB;
constexpr size_t WS_TMP = 730 * MiB;
constexpr size_t WS_H2 = 472 * MiB;
constexpr size_t WS_H2F = 504 * MiB;
constexpr size_t WS_LOG = 568 * MiB;
constexpr size_t WS_ACT = 584 * MiB;
constexpr size_t WS_Y = 656 * MiB;
constexpr size_t WS_END = 944 * MiB;
constexpr int CW_COUNT = 1024;

__host__ __device__ __forceinline__ int perm32_log(int p) { return 16 * ((p >> 2) & 1) + 4 * (p >> 3) + (p & 3); }
__host__ __device__ __forceinline__ int perm64_log(int p) { return 32 * ((p >> 2) & 1) + 16 * (p >> 5) + 4 * ((p >> 3) & 3) + (p & 3); }
__host__ __device__ __forceinline__ int p1_logical(int p) {
    if (p < 384) return p;
    if (p < 416) return 384 + perm32_log(p - 384);
    if (p < 512) return -1;
    if (p < 1024) { int q = p - 512; return 416 + (q & ~63) + perm64_log(q & 63); }
    if (p < 1536) { int q = p - 1024; return 928 + (q & ~63) + perm64_log(q & 63); }
    return 1440 + (p - 1536);
}
__host__ __device__ __forceinline__ int qm_logical(int p) { int h = p / 96, r = p % 96; return h * 96 + (r < 64 ? r : 64 + perm32_log(r - 64)); }

struct Ptrs {
    const float* in[28]; float* out; unsigned char* ws;
};


#define GAS __attribute__((address_space(1)))
#define LAS __attribute__((address_space(3)))
typedef short bf16x8 __attribute__((ext_vector_type(8)));
typedef short s16x4 __attribute__((ext_vector_type(4)));
typedef float f32x4 __attribute__((ext_vector_type(4)));
typedef float f32x2 __attribute__((ext_vector_type(2)));
typedef float f32x16 __attribute__((ext_vector_type(16)));
typedef float f32x8 __attribute__((ext_vector_type(8)));
typedef unsigned u32x4 __attribute__((ext_vector_type(4)));
typedef unsigned u32x2 __attribute__((ext_vector_type(2)));
#define RLX_AGENT __ATOMIC_RELAXED, __HIP_MEMORY_SCOPE_AGENT
#define LDS_WAIT() asm volatile("s_waitcnt lgkmcnt(0)" ::: "memory")
#define VM_WAIT() asm volatile("s_waitcnt vmcnt(0)" ::: "memory")

constexpr size_t WS_MODP = 1 * MiB;
constexpr size_t WS_WIN = 4 * MiB;
constexpr size_t WS_WUP = 8 * MiB;
constexpr size_t WS_WOUT = 10 * MiB;
constexpr size_t WS_WR = 12 * MiB;
constexpr size_t WS_W13 = 16 * MiB;
constexpr size_t WS_W2 = 273 * MiB;
constexpr size_t WS_UT = WS_OFF + 4096;
static_assert(WS_W2 + (size_t)257 * 1024 * 256 * 2 <= WS_X1, "ws map");
constexpr size_t WS_LOGP = WS_Y;
constexpr int CW_NUNIT = 2048;
constexpr int CW_NFULL = 2049;
constexpr int CW_BAR = 4096;

__device__ __forceinline__ unsigned cvt_pk_bf16(float lo, float hi) { unsigned r; asm volatile("v_cvt_pk_bf16_f32 %0, %1, %2" : "=v"(r) : "v"(lo), "v"(hi)); return r; }
__device__ __forceinline__ unsigned pk2(float lo, float hi) { return f2bf(lo) | (f2bf(hi) << 16); }
__device__ __forceinline__ u32x4 pack8(f32x4 a, f32x4 b) { u32x4 w; w.x = cvt_pk_bf16(a[0], a[1]); w.y = cvt_pk_bf16(a[2], a[3]); w.z = cvt_pk_bf16(b[0], b[1]); w.w = cvt_pk_bf16(b[2], b[3]); return w; }
__device__ __forceinline__ float bflo(unsigned w) { return __builtin_bit_cast(float, w << 16); }
__device__ __forceinline__ float bfhi(unsigned w) { return __builtin_bit_cast(float, w & 0xffff0000u); }
__device__ __forceinline__ float wave_sum(float v) {
#pragma unroll
    for (int o = 1; o < 64; o <<= 1) v += __shfl_xor(v, o);
    return v;
}

namespace pg8 {
constexpr int BM = 256, BK = 64, HALF = 128, HTB = HALF * BK * 2, STAGE_BYTES = 8 * HTB;
__host__ __device__ __forceinline__ int lds_byte(int r, int c) { const int st = (r >> 4) * 2 + (c >> 5), rr = r & 15, cc = c & 31, ob = rr * 64 + cc * 2; return st * 1024 + (ob ^ (((ob >> 9) & 1) << 5)); }
__host__ __device__ __forceinline__ void stage_rc(int b, int& R, int& C) { const int st = b / 1024, sb = b % 1024, swz = sb ^ (((sb >> 9) & 1) << 5); R = (st >> 1) * 16 + swz / 64; C = (st & 1) * 32 + (swz % 64) / 2; }
__host__ __device__ __forceinline__ int perm32(int rho) { const int n = rho >> 4, i = rho & 15; return 8 * (i >> 2) + 4 * n + (i & 3); }

struct Unit { int pm, pn, r0, nv, k0; };
struct Gemm { const bf16* A; const bf16* Bt; int lda, ldb, K; };

struct StaticOrder {
    int nM, nN, nwg, G, c;
    __device__ void init(int M, int N, int G_, int c_) { nM = M / BM; nN = N / BM; nwg = nM * nN; G = G_; c = c_; }
    __device__ bool next(int i, Unit& u) const {
        const long L = (long)i * G + c; if (L >= nwg) return false;
        int wgid = (int)L; { const int q = nwg / 8, r = nwg % 8, xcd = wgid % 8, off = wgid / 8; wgid = (xcd < r ? xcd * (q + 1) : r * (q + 1) + (xcd - r) * q) + off; }
        const int nig = 8 * nN, gid = wgid / nig, fm = gid * 8, gsz = (nM - fm) < 8 ? (nM - fm) : 8;
        u.pm = fm + ((wgid % nig) % gsz); u.pn = (wgid % nig) / gsz; u.r0 = u.pm * BM; u.nv = BM; u.k0 = 0; return true;
    }
    __device__ __forceinline__ int a_row(const Unit& u, int r) const { return u.pm * BM + r; }
};

template <class Epi, class Sched>
__device__ __forceinline__ void gemm_phase(LAS unsigned char* lds, const Gemm g, const Sched& S, const Epi& E) {
    const int tid = threadIdx.x, wid = __builtin_amdgcn_readfirstlane(tid >> 6), lane = tid & 63, wr = wid >> 2, wc = wid & 3, fr = lane & 15, fq = lane >> 4;
    int K = g.K; asm volatile("" : "+s"(K));
    const int nt = K / BK;
    int RA[2], CA[2]; unsigned voffB[2];
#pragma unroll
    for (int i = 0; i < 2; ++i) { int R, C; stage_rc(tid * 16 + i * 8192, R, C); RA[i] = R; CA[i] = C; const int Rb = Epi::PERM ? ((R & ~31) + perm32(R & 31)) : R; voffB[i] = (unsigned)(Rb * g.ldb + C) * 2u; }
    const size_t kstep = (size_t)(BK * 2);
    const size_t hstepB = (size_t)HALF * g.ldb * 2, tstepB = 2 * hstepB;
    const unsigned ldsw = (unsigned)wid * 1024u;
    const int aoff = lds_byte(wr * 64 + fr, fq * 8), boff = lds_byte(wc * 32 + fr, fq * 8);
#define PG8_SA(b, h) (((b) * 2 + (h)) * HTB)
#define PG8_SB(b, h) ((4 + (b) * 2 + (h)) * HTB)
#define PG8_STAGE(bufoff, gbase, voff) do { _Pragma("unroll") for (int _i = 0; _i < 2; ++_i) \
        __builtin_amdgcn_global_load_lds((const unsigned*)((const char*)(gbase) + (voff)[_i]), (LAS unsigned*)(lds + (bufoff) + ldsw + _i * 8192), 16, 0, 0); } while (0)
#define PG8_LDA(dst, b, h) do { _Pragma("unroll") for (int m = 0; m < 4; ++m) _Pragma("unroll") for (int k = 0; k < 2; ++k) dst[m][k] = *(const LAS bf16x8*)(lds + PG8_SA(b, h) + aoff + m * 2048 + k * 1024); } while (0)
#define PG8_LDB(dst, b, h) do { _Pragma("unroll") for (int n = 0; n < 2; ++n) _Pragma("unroll") for (int k = 0; k < 2; ++k) dst[n][k] = *(const LAS bf16x8*)(lds + PG8_SB(b, h) + boff + n * 2048 + k * 1024); } while (0)
#define PG8_MMA(ai, bj, At, Bt) do { __builtin_amdgcn_s_setprio(1); _Pragma("unroll") for (int m = 0; m < 4; ++m) _Pragma("unroll") for (int n = 0; n < 2; ++n) _Pragma("unroll") for (int k = 0; k < 2; ++k) \
        acc[ai][bj][m][n] = __builtin_amdgcn_mfma_f32_16x16x32_bf16(Bt[n][k], At[m][k], acc[ai][bj][m][n], 0, 0, 0); __builtin_amdgcn_s_setprio(0); } while (0)
#define PG8_WAIT_V(n) asm volatile("s_waitcnt vmcnt(" #n ")" ::: "memory")
#define PG8_WAIT_L(n) asm volatile("s_waitcnt lgkmcnt(" #n ")" ::: "memory")
#define PG8_BAR __builtin_amdgcn_s_barrier()
#define PG8_SCHED __builtin_amdgcn_sched_barrier(0)
#define PG8_AOFFS(dst, u) do { _Pragma("unroll") for (int _h = 0; _h < 2; ++_h) _Pragma("unroll") for (int _i = 0; _i < 2; ++_i) \
        dst[_h][_i] = (unsigned)(((size_t)S.a_row(u, _h * HALF + RA[_i]) * (size_t)g.lda + (size_t)(CA[_i] + (u).k0)) * 2u); } while (0)
    Unit cur, nxt; int ui = 0;
    if (!S.next(0, cur)) return;
    f32x4 acc[2][2][4][2];
#pragma unroll
    for (int a = 0; a < 2; ++a)
#pragma unroll
        for (int b = 0; b < 2; ++b)
#pragma unroll
            for (int m = 0; m < 4; ++m)
#pragma unroll
                for (int n = 0; n < 2; ++n) acc[a][b][m][n] = (f32x4){0.f, 0.f, 0.f, 0.f};
    bf16x8 At[4][2], B0[2][2], B1[2][2];
    unsigned vA[2][2], vN[2][2];
    PG8_AOFFS(vA, cur);
    const char* Ab = (const char*)g.A; const char* cB = (const char*)g.Bt + (size_t)cur.pn * tstepB + (size_t)cur.k0 * 2;
    PG8_STAGE(PG8_SB(0, 0), cB, voffB); PG8_STAGE(PG8_SB(0, 1), cB + hstepB, voffB); PG8_STAGE(PG8_SA(0, 0), Ab, vA[0]); PG8_STAGE(PG8_SA(0, 1), Ab, vA[1]);
    if (wr == 1) PG8_BAR;
    PG8_WAIT_V(2); PG8_BAR;
    PG8_STAGE(PG8_SB(1, 0), cB + kstep, voffB); PG8_STAGE(PG8_SA(1, 0), Ab + kstep, vA[0]); PG8_STAGE(PG8_SB(1, 1), cB + hstepB + kstep, voffB);
    PG8_WAIT_V(6); PG8_BAR;
    for (;;) {
        const bool has_next = S.next(ui + 1, nxt);
        const char* nB = has_next ? (const char*)g.Bt + (size_t)nxt.pn * tstepB + (size_t)nxt.k0 * 2 : cB;
        if (has_next) { PG8_AOFFS(vN, nxt); } else { vN[0][0] = vA[0][0]; vN[0][1] = vA[0][1]; vN[1][0] = vA[1][0]; vN[1][1] = vA[1][1]; }
        for (int t = 0; t < nt; t += 2) {
            const bool last = (t == nt - 2); const bool full = cur.nv > HALF;
            const char* a1 = Ab + (size_t)(t + 1) * kstep;
            const char* a2 = Ab + (last ? (size_t)0 : (size_t)(t + 2) * kstep); const char* b2 = last ? nB : cB + (size_t)(t + 2) * kstep;
            const char* a3 = a2 + kstep; const char* b3 = b2 + kstep;
            unsigned w0[2], w1[2];
            w0[0] = last ? vN[0][0] : vA[0][0]; w0[1] = last ? vN[0][1] : vA[0][1]; w1[0] = last ? vN[1][0] : vA[1][0]; w1[1] = last ? vN[1][1] : vA[1][1];
            PG8_LDB(B0, 0, 0); PG8_LDB(B1, 0, 1); PG8_SCHED; PG8_LDA(At, 0, 0); PG8_STAGE(PG8_SA(1, 1), a1, vA[1]);
            PG8_WAIT_V(8); PG8_WAIT_L(0); PG8_BAR; PG8_MMA(0, 0, At, B0); PG8_MMA(0, 1, At, B1); PG8_BAR; PG8_SCHED;
            PG8_LDA(At, 0, 1); PG8_STAGE(PG8_SB(0, 0), b2, voffB); PG8_STAGE(PG8_SB(0, 1), b2 + hstepB, voffB); PG8_STAGE(PG8_SA(0, 0), a2, w0);
            PG8_WAIT_V(8); PG8_WAIT_L(0); PG8_BAR; if (full) { PG8_MMA(1, 0, At, B0); PG8_MMA(1, 1, At, B1); } PG8_BAR; PG8_SCHED;
            PG8_LDB(B0, 1, 0); PG8_LDB(B1, 1, 1); PG8_SCHED; PG8_LDA(At, 1, 0); PG8_STAGE(PG8_SA(0, 1), a2, w1);
            PG8_WAIT_V(8); PG8_WAIT_L(0); PG8_BAR; PG8_MMA(0, 0, At, B0); PG8_MMA(0, 1, At, B1); PG8_BAR; PG8_SCHED;
            PG8_LDA(At, 1, 1); PG8_STAGE(PG8_SB(1, 0), b3, voffB); PG8_STAGE(PG8_SB(1, 1), b3 + hstepB, voffB); PG8_STAGE(PG8_SA(1, 0), a3, w0);
            PG8_WAIT_V(8); PG8_WAIT_L(0); PG8_BAR; if (full) { PG8_MMA(1, 0, At, B0); PG8_MMA(1, 1, At, B1); } PG8_BAR; PG8_SCHED;
        }
        if (wr == 0) PG8_BAR;
        E(acc, cur, wr, wc, fr, fq);
        if (!has_next) break;
#pragma unroll
        for (int a = 0; a < 2; ++a)
#pragma unroll
            for (int b = 0; b < 2; ++b)
#pragma unroll
                for (int m = 0; m < 4; ++m)
#pragma unroll
                    for (int n = 0; n < 2; ++n) acc[a][b][m][n] = (f32x4){0.f, 0.f, 0.f, 0.f};
        cur = nxt; cB = nB; ++ui;
        vA[0][0] = vN[0][0]; vA[0][1] = vN[0][1]; vA[1][0] = vN[1][0]; vA[1][1] = vN[1][1];
        if (wr == 1) PG8_BAR;
    }
    PG8_WAIT_V(0);
    PG8_BAR;
#undef PG8_SA
#undef PG8_SB
#undef PG8_STAGE
#undef PG8_LDA
#undef PG8_LDB
#undef PG8_MMA
#undef PG8_WAIT_V
#undef PG8_WAIT_L
#undef PG8_BAR
#undef PG8_SCHED
#undef PG8_AOFFS
}
}

using pg8::Unit;
typedef f32x4 Acc[2][2][4][2];

struct EpiInProj {
    static constexpr bool PERM = true;
    bf16* P1; float* SSQ; const float2* TD; const float2* TM;
    __device__ __forceinline__ void operator()(const Acc& acc, const Unit& u, int wr, int wc, int fr, int fq) const {
        const int pm = u.pm, pn = u.pn, jt = pm % 17; const bool lat = jt > 0;
        const int row0 = pm * 256 + wr * 64 + fr, col0 = pn * 256 + wc * 32 + 8 * fq;
        if (pn == 0 || pn >= 6 || (pn == 1)) {
#pragma unroll
            for (int ai = 0; ai < 2; ++ai)
#pragma unroll
                for (int m = 0; m < 4; ++m) {
                    const int r = row0 + ai * 128 + m * 16; bf16* rowp = P1 + (size_t)r * NP1 + col0;
                    *(u32x4*)(rowp) = pack8(acc[ai][0][m][0], acc[ai][0][m][1]);
                    if (pn != 1) *(u32x4*)(rowp + 128) = pack8(acc[ai][1][m][0], acc[ai][1][m][1]);
                    if (pn <= 1) {
                        float s = 0.f;
#pragma unroll
                        for (int bj = 0; bj < 2; ++bj) { if (pn == 1 && bj == 1) break;
#pragma unroll
                            for (int n = 0; n < 2; ++n) { const f32x4 x = acc[ai][bj][m][n]; s += (x[0] * x[0] + x[1] * x[1]) + (x[2] * x[2] + x[3] * x[3]); } }
                        s += __shfl_xor(s, 16); s += __shfl_xor(s, 32);
                        if (fq == 0) SSQ[(size_t)r * 8 + pn * 4 + wc] = s;
                    }
                    if (pn == 1 && wc == 0) {
                        f32x4 x1 = acc[ai][1][m][0], x2 = acc[ai][1][m][1], o1 = x1, o2 = x2;
                        if (lat) { const int gr = (jt - 1) * 4 + 2 * ai + wr, gc = 16 * m + fr;
                            const float2* tp = TM + (fq < 2 ? gr * 8 + 4 * fq : gc * 8 + 4 * (fq - 2));
                            const f32x4 t0 = *(const f32x4*)tp, t1 = *(const f32x4*)(tp + 2);
                            const f32x4 cs = {t0[0], t0[2], t1[0], t1[2]}, sn = {t0[1], t0[3], t1[1], t1[3]};
                            o1 = x1 * cs - x2 * sn; o2 = x1 * sn + x2 * cs; }
                        *(u32x4*)(rowp + 128) = pack8(o1, o2);
                    }
                }
        } else {
            const int g = wc & 1; const float qs = pn < 4 ? 0.125f * 1.4426950408889634f : 1.f;
#pragma unroll
            for (int ai = 0; ai < 2; ++ai) {
                const int gr = (jt - 1) * 4 + 2 * ai + wr;
#pragma unroll
                for (int m = 0; m < 4; ++m) {
                    const int r = row0 + ai * 128 + m * 16; bf16* rowp = P1 + (size_t)r * NP1 + col0;
                    f32x4 cs = {1.f, 1.f, 1.f, 1.f}, sn = {0.f, 0.f, 0.f, 0.f};
                    if (lat) { const int gc = 16 * m + fr; const float2* tp = TD + (g == 0 ? gr : gc) * 16 + 4 * fq;
                        const f32x4 t0 = *(const f32x4*)tp, t1 = *(const f32x4*)(tp + 2);
                        cs = (f32x4){t0[0], t0[2], t1[0], t1[2]}; sn = (f32x4){t0[1], t0[3], t1[1], t1[3]}; }
#pragma unroll
                    for (int bj = 0; bj < 2; ++bj) { const f32x4 x1 = acc[ai][bj][m][0] * qs, x2 = acc[ai][bj][m][1] * qs;
                        *(u32x4*)(rowp + bj * 128) = pack8(x1 * cs - x2 * sn, x1 * sn + x2 * cs); }
                }
            }
        }
    }
};

struct EpiUp {
    static constexpr bool PERM = true;
    bf16* QM; bf16* KVM; const float* SSQ; const float2* TM;
    __device__ __forceinline__ void operator()(const Acc& acc, const Unit& u, int wr, int wc, int fr, int fq) const {
        const int pm = u.pm, pn = u.pn, jt = pm % 17; const bool lat = jt > 0, isq = pn < 3;
        const int row0 = pm * 256 + wr * 64 + fr, col0 = pn * 256 + wc * 32 + 8 * fq;
#pragma unroll
        for (int ai = 0; ai < 2; ++ai)
#pragma unroll
            for (int m = 0; m < 4; ++m) {
                const int r = row0 + ai * 128 + m * 16;
                const f32x4 sq = *(const f32x4*)(SSQ + (size_t)r * 8 + (isq ? 0 : 4));
                const float rs = rsqrtf(((sq[0] + sq[1]) + (sq[2] + sq[3])) * (isq ? 1.f / 256.f : 1.f / 128.f) + EPS) * (isq ? 0.10206207261596575f * 1.4426950408889634f : 1.f);
#pragma unroll
                for (int bj = 0; bj < 2; ++bj) {
                    f32x4 x1 = acc[ai][bj][m][0] * rs, x2 = acc[ai][bj][m][1] * rs;
                    if (isq) {
                        const int G = 8 * pn + 4 * bj + wc;
                        if (lat && (G % 3) == 2) { const int gr = (jt - 1) * 4 + 2 * ai + wr, gc = 16 * m + fr;
                            const float2* tp = TM + (fq < 2 ? gr * 8 + 4 * fq : gc * 8 + 4 * (fq - 2));
                            const f32x4 t0 = *(const f32x4*)tp, t1 = *(const f32x4*)(tp + 2);
                            const f32x4 cs = {t0[0], t0[2], t1[0], t1[2]}, sn = {t0[1], t0[3], t1[1], t1[3]};
                            const f32x4 o1 = x1 * cs - x2 * sn, o2 = x1 * sn + x2 * cs; x1 = o1; x2 = o2; }
                        *(u32x4*)(QM + (size_t)r * 768 + col0 + bj * 128) = pack8(x1, x2);
                    } else *(u32x4*)(KVM + (size_t)r * 1024 + (col0 - 768) + bj * 128) = pack8(x1, x2);
                }
            }
    }
};

struct EpiOut {
    static constexpr bool PERM = true;
    const float* x; const float* MOD; bf16* X1;
    __device__ __forceinline__ void operator()(const Acc& acc, const Unit& u, int wr, int wc, int fr, int fq) const {
        const int b = u.pm / 16; const float* gt = MOD + b * 6144 + 2048;
        const int row0 = u.pm * 256 + wr * 64 + fr, col0 = u.pn * 256 + wc * 32 + 8 * fq;
        f32x4 gv[2][2];
#pragma unroll
        for (int bj = 0; bj < 2; ++bj)
#pragma unroll
            for (int n = 0; n < 2; ++n) gv[bj][n] = *(const f32x4*)(gt + col0 + bj * 128 + n * 4);
#pragma unroll
        for (int ai = 0; ai < 2; ++ai)
#pragma unroll
            for (int m = 0; m < 4; ++m) { const size_t off = (size_t)(row0 + ai * 128 + m * 16) * DM + col0;
#pragma unroll
                for (int bj = 0; bj < 2; ++bj) { const f32x4 x0 = *(const f32x4*)(x + off + bj * 128), x1 = *(const f32x4*)(x + off + bj * 128 + 4);
                    *(u32x4*)(X1 + off + bj * 128) = pack8(x0 + gv[bj][0] * acc[ai][bj][m][0], x1 + gv[bj][1] * acc[ai][bj][m][1]); } }
    }
};
struct EpiF32 {
    static constexpr bool PERM = false;
    float* O; int ldc;
    __device__ __forceinline__ void operator()(const Acc& acc, const Unit& u, int wr, int wc, int fr, int fq) const {
        const int row0 = u.pm * 256 + wr * 64 + fr, col0 = u.pn * 256 + wc * 32 + 4 * fq;
#pragma unroll
        for (int ai = 0; ai < 2; ++ai)
#pragma unroll
            for (int m = 0; m < 4; ++m) { const size_t off = (size_t)(row0 + ai * 128 + m * 16) * ldc + col0;
#pragma unroll
                for (int bj = 0; bj < 2; ++bj)
#pragma unroll
                    for (int n = 0; n < 2; ++n) *(f32x4*)(O + off + bj * 128 + n * 16) = acc[ai][bj][m][n]; }
    }
};
struct EpiAct {
    static constexpr bool PERM = true;
    bf16* ACT; const float* SW;
    __device__ __forceinline__ void operator()(const Acc& acc, const Unit& u, int wr, int wc, int fr, int fq) const {
        const int half = u.pn & 1, colb = half * 128 + wc * 32 + 8 * fq;
#pragma unroll
        for (int ai = 0; ai < 2; ++ai)
#pragma unroll
            for (int m = 0; m < 4; ++m) { const int tr = ai * 128 + wr * 64 + m * 16 + fr;
                f32x4 a[2];
#pragma unroll
                for (int n = 0; n < 2; ++n) { const f32x4 gt = acc[ai][0][m][n], up = acc[ai][1][m][n];
#pragma unroll
                    for (int e = 0; e < 4; ++e) a[n][e] = gt[e] * __builtin_amdgcn_rcpf(1.f + __expf(-gt[e])) * up[e]; }
                if (tr < u.nv) { const float w = SW[u.r0 + tr]; *(u32x4*)(ACT + (size_t)(u.r0 + tr) * EFF + colb) = pack8(a[0] * w, a[1] * w); } }
    }
};
constexpr float YSCALE = 32.f;
__device__ __forceinline__ unsigned pk4_fp8(f32x4 v) { int w = 0; w = __builtin_amdgcn_cvt_pk_fp8_f32(v[0], v[1], w, false); w = __builtin_amdgcn_cvt_pk_fp8_f32(v[2], v[3], w, true); return (unsigned)w; }
struct EpiY {
    static constexpr bool PERM = true;
    unsigned char* Y;
    __device__ __forceinline__ void operator()(const Acc& acc, const Unit& u, int wr, int wc, int fr, int fq) const {
        const int colb = (u.pn & 3) * 256 + wc * 64 + 16 * fq;
#pragma unroll
        for (int ai = 0; ai < 2; ++ai)
#pragma unroll
            for (int m = 0; m < 4; ++m) { const int tr = ai * 128 + wr * 64 + m * 16 + fr;
                if (tr < u.nv) { u32x4 w; w.x = pk4_fp8(acc[ai][0][m][0] * YSCALE); w.y = pk4_fp8(acc[ai][0][m][1] * YSCALE); w.z = pk4_fp8(acc[ai][1][m][0] * YSCALE); w.w = pk4_fp8(acc[ai][1][m][1] * YSCALE);
                    *(u32x4*)(Y + (size_t)(u.r0 + tr) * DM + colb) = w; } }
    }
};

template <int SUB, bool GATHER> struct ExpSched {
    const LAS int* uc; int nmine; const int* slot_tok;
    __device__ bool next(int i, Unit& u) const {
        if (i >= nmine) return false;
        const int e = __builtin_amdgcn_readfirstlane(uc[i * 4 + 0]), r0 = __builtin_amdgcn_readfirstlane(uc[i * 4 + 1]);
        const int nv = __builtin_amdgcn_readfirstlane(uc[i * 4 + 2]), sub = __builtin_amdgcn_readfirstlane(uc[i * 4 + 3]);
        u.pm = 0; u.pn = e * SUB + sub; u.r0 = r0; u.nv = nv; u.k0 = 0; return true;
    }
    __device__ __forceinline__ int a_row(const Unit& u, int r) const {
        if (GATHER) return r < u.nv ? slot_tok[u.r0 + r] : 0;
        const int s = u.r0 + r; return s < NSLOT ? s : NSLOT - 1;
    }
};
template <int SUB> __device__ __forceinline__ int exp_units_to_lds(LAS int* uc, const int* ut, int nunit, int nfull, int G, int c) {
    const int NF = nfull * SUB, NH = (nunit - nfull) * SUB, cr = G - 1 - c, nlight = (NF % G) ? G - NF % G : 0;
    const int mf = c < NF ? (NF - 1 - c) / G + 1 : 0;
    const int h0 = (cr < nlight && cr < NH) ? 1 : 0;
    const int NH2 = NH > nlight ? NH - nlight : 0, mh = cr < NH2 ? (NH2 - 1 - cr) / G + 1 : 0;
    const int t = threadIdx.x;
    if (t < mf + h0 + mh && t < 64) { const int L = t < mf ? t * G + c : (t < mf + h0 ? NF + cr : NF + nlight + (t - mf - h0) * G + cr); const int cu = L / SUB;
        uc[t * 4 + 0] = ut[cu * 4 + 0]; uc[t * 4 + 1] = ut[cu * 4 + 1]; uc[t * 4 + 2] = ut[cu * 4 + 2]; uc[t * 4 + 3] = L % SUB; }
    __syncthreads();
    return mf + h0 + mh < 64 ? mf + h0 + mh : 64;
}
struct RouterOrder {
    int G, c;
    __device__ bool next(int i, Unit& u) const { const int L = i * G + c; if (L >= 256) return false; u.pm = L >> 2; u.pn = 0; u.r0 = u.pm * 256; u.nv = 256; u.k0 = (L & 3) * 256; return true; }
    __device__ __forceinline__ int a_row(const Unit& u, int r) const { return u.pm * 256 + r; }
};
struct UpOrder {
    int G, c;
    __device__ bool next(int i, Unit& u) const { const int L = i * G + c; if (L >= 68 * 7) return false; u.pm = L / 7; u.pn = L % 7; u.r0 = u.pm * 256; u.nv = 256; u.k0 = u.pn < 3 ? 0 : 128; return true; }
    __device__ __forceinline__ int a_row(const Unit& u, int r) const { return u.pm * 256 + r; }
};
struct EpiLogP {
    static constexpr bool PERM = false;
    float* O;
    __device__ __forceinline__ void operator()(const Acc& acc, const Unit& u, int wr, int wc, int fr, int fq) const {
        float* base = O + (size_t)(u.k0 >> 8) * MLAT * NEXP;
        const int row0 = u.pm * 256 + wr * 64 + fr, col0 = wc * 32 + 4 * fq;
#pragma unroll
        for (int ai = 0; ai < 2; ++ai)
#pragma unroll
            for (int m = 0; m < 4; ++m) { const size_t off = (size_t)(row0 + ai * 128 + m * 16) * NEXP + col0;
#pragma unroll
                for (int bj = 0; bj < 2; ++bj)
#pragma unroll
                    for (int n = 0; n < 2; ++n) *(f32x4*)(base + off + bj * 128 + n * 16) = acc[ai][bj][m][n]; }
    }
};

namespace attn {
#define SBAR() __builtin_amdgcn_sched_barrier(0)
constexpr float THR = 8.f;
template <int MODE> struct Cfg;
template <> struct Cfg<0> { static constexpr int DQK = 96, DV = 64, LDQ = 768, LDK0 = 1024, LDK1 = 2048, LDV = 1024; static constexpr float SCALE = 0.10206207261596575f; };
template <> struct Cfg<1> { static constexpr int DQK = 64, DV = 128, LDQ = 2048, LDK0 = 2048, LDK1 = 2048, LDV = 2048; static constexpr float SCALE = 0.125f; };
__device__ __forceinline__ int crow(int r, int hi) { return (r & 3) + 8 * (r >> 2) + 4 * hi; }
__device__ __forceinline__ unsigned cvtpk(float lo, float hi) { unsigned r; asm volatile("v_cvt_pk_bf16_f32 %0, %1, %2" : "=v"(r) : "v"(lo), "v"(hi)); return r; }

constexpr float THR2 = 11.5f;
__device__ __forceinline__ float max3f(float a, float b, float c) { return __builtin_fmaxf(__builtin_fmaxf(a, b), c); }
__device__ __forceinline__ void partialSM(f32x16& p0, f32x16& p1, float& m_reg, float& alpha, bool first) {
    float a = max3f(p0[0], p0[1], p1[0]), b = max3f(p0[2], p0[3], p1[1]); a = max3f(a, p1[2], p1[3]);
#pragma unroll
    for (int r = 4; r < 16; r += 4) { a = max3f(a, p0[r], p0[r + 1]); b = max3f(b, p0[r + 2], p0[r + 3]); a = max3f(a, p1[r], p1[r + 1]); b = max3f(b, p1[r + 2], p1[r + 3]); }
    float pmax = __builtin_fmaxf(a, b);
    { auto rr = __builtin_amdgcn_permlane32_swap(__float_as_uint(pmax), __float_as_uint(pmax), false, false);
      pmax = __builtin_fmaxf(__uint_as_float(rr[0]), __uint_as_float(rr[1])); }
    alpha = 1.f;
    if (__builtin_expect(first || __any(pmax > THR2), 0)) {
        const float dl = first ? pmax : __builtin_fmaxf(pmax, 0.f);
        m_reg += dl; alpha = first ? 1.f : __builtin_amdgcn_exp2f(-dl);
#pragma unroll
        for (int r = 0; r < 16; ++r) { p0[r] -= dl; p1[r] -= dl; }
    }
#pragma unroll
    for (int r = 0; r < 16; ++r) p0[r] = __builtin_amdgcn_exp2f(p0[r]);
}
__device__ __forceinline__ void finishSM(f32x16& p0, f32x16& p1, float alpha, float& l_reg, bf16x8& pa0, bf16x8& pa1, bf16x8& pa2, bf16x8& pa3) {
#pragma unroll
    for (int r = 0; r < 16; ++r) p1[r] = __builtin_amdgcn_exp2f(p1[r]);
    float ps = 0;
#pragma unroll
    for (int r = 0; r < 16; ++r) ps += p0[r];
#pragma unroll
    for (int r = 0; r < 16; ++r) ps += p1[r];
    { auto rr = __builtin_amdgcn_permlane32_swap(__float_as_uint(ps), __float_as_uint(ps), false, false);
      ps = __uint_as_float(rr[0]) + __uint_as_float(rr[1]); }
    l_reg = l_reg * alpha + ps;
#define PK4(P, BASE, OUT) do { u32x4 w = {cvtpk(P[BASE + 0], P[BASE + 1]), cvtpk(P[BASE + 2], P[BASE + 3]), cvtpk(P[BASE + 4], P[BASE + 5]), cvtpk(P[BASE + 6], P[BASE + 7])}; OUT = *reinterpret_cast<bf16x8*>(&w); } while (0)
    PK4(p0, 0, pa0); PK4(p0, 8, pa1); PK4(p1, 0, pa2); PK4(p1, 8, pa3);
#undef PK4
}
template <int NQ, int KROW> __device__ __forceinline__ void qkt(f32x16& p0, f32x16& p1, const LAS char* Ks, const bf16x8* qr, float m_ref, int r32, int hi) {
    f32x16 negm;
#pragma unroll
    for (int r = 0; r < 16; ++r) negm[r] = -m_ref;
    p0 = negm; p1 = negm;
#pragma unroll
    for (int d0 = 0; d0 < NQ; ++d0) { const int cb = d0 * 32 + hi * 16;
        const bf16x8 b0 = *(const LAS bf16x8*)(Ks + r32 * KROW + cb);
        const bf16x8 b1 = *(const LAS bf16x8*)(Ks + (32 + r32) * KROW + cb);
        p0 = __builtin_amdgcn_mfma_f32_32x32x16_bf16(b0, qr[d0], p0, 0, 0, 0);
        p1 = __builtin_amdgcn_mfma_f32_32x32x16_bf16(b1, qr[d0], p1, 0, 0, 0); }
}
template <int NC> __device__ __forceinline__ int v_st(int k, int c) { const int kk = k; return ((kk >> 3) * NC + (c >> 5)) * 512 + ((kk & 7) * 32 + (c & 31)) * 2; }
__device__ __forceinline__ int v_rd_base(int lane) { return ((lane & 3) << 3) | (((lane >> 2) & 3) << 6) | (((lane >> 4) & 1) << 5) | (((lane >> 5) & 1) << 8); }
template <int OFF> __device__ __forceinline__ s16x4 tr_read(int vb) {
    s16x4 r; asm volatile("ds_read_b64_tr_b16 %0, %1 offset:%2" : "=&v"(r) : "v"(vb), "i"(OFF) : "memory"); return r;
}
template <int NC, int D0> __device__ __forceinline__ void pv_one(f32x16& od, int vb, bf16x8 pa0, bf16x8 pa1, bf16x8 pa2, bf16x8 pa3) {
#define VOFF(ks, half) (D0 * 512 + (ks) * (NC * 1024) + (half) * (NC * 512))
    const s16x4 l0 = tr_read<VOFF(0, 0)>(vb), h0 = tr_read<VOFF(0, 1)>(vb), l1 = tr_read<VOFF(1, 0)>(vb), h1 = tr_read<VOFF(1, 1)>(vb);
    const s16x4 l2 = tr_read<VOFF(2, 0)>(vb), h2 = tr_read<VOFF(2, 1)>(vb), l3 = tr_read<VOFF(3, 0)>(vb), h3 = tr_read<VOFF(3, 1)>(vb);
#undef VOFF
    asm volatile("s_waitcnt lgkmcnt(0)" ::: "memory"); SBAR();
#define PK(L, H) (bf16x8){L[0], L[1], L[2], L[3], H[0], H[1], H[2], H[3]}
    od = __builtin_amdgcn_mfma_f32_32x32x16_bf16(pa0, PK(l0, h0), od, 0, 0, 0);
    od = __builtin_amdgcn_mfma_f32_32x32x16_bf16(pa1, PK(l1, h1), od, 0, 0, 0);
    od = __builtin_amdgcn_mfma_f32_32x32x16_bf16(pa2, PK(l2, h2), od, 0, 0, 0);
    od = __builtin_amdgcn_mfma_f32_32x32x16_bf16(pa3, PK(l3, h3), od, 0, 0, 0);
#undef PK
}
template <int NC> __device__ __forceinline__ void pv_all(f32x16* o, int vb, bf16x8 pa0, bf16x8 pa1, bf16x8 pa2, bf16x8 pa3) {
    pv_one<NC, 0>(o[0], vb, pa0, pa1, pa2, pa3); pv_one<NC, 1>(o[1], vb, pa0, pa1, pa2, pa3);
    if constexpr (NC == 4) { pv_one<NC, 2>(o[2], vb, pa0, pa1, pa2, pa3); pv_one<NC, 3>(o[3], vb, pa0, pa1, pa2, pa3); }
}
template <int MODE> constexpr int lds_bytes() { return 3 * 64 * Cfg<MODE>::DV * 2 + 3 * 64 * (Cfg<MODE>::DQK * 2 + 16) + 8 * 64 * 4; }

template <int MODE, int EPI>
__device__ __forceinline__ void unit(const bf16* __restrict__ Qb, const bf16* __restrict__ K0, const bf16* __restrict__ K1, const bf16* __restrict__ Vh, void* Ob, int ldo, LAS char* lds, char* stash, float lam, const float* gsub) {
    using C = Cfg<MODE>;
    constexpr int DQK = C::DQK, DV = C::DV, NQ = DQK / 16, NC = DV / 32, KROW = DQK * 2 + 16, SHM_K = 64 * KROW, SHM_V = 64 * DV * 2;
    const int tid = threadIdx.x, wid = tid >> 6, lane = tid & 63, r32 = lane & 31, hi = lane >> 5;
    LAS char* V_lds = lds; LAS char* K_lds = lds + 3 * SHM_V;
    LAS float* ws = (LAS float*)(lds + 3 * SHM_V + 3 * SHM_K) + wid * 64; LAS float* li_l = ws; LAS float* al_l = ws + 32;
    float m_reg = 0.f, l_reg = 0; f32x16 o[NC]; bf16x8 qr[NQ];
#pragma unroll
    for (int d = 0; d < NC; ++d) o[d] = f32x16{};
    const bf16* Qw = Qb + (size_t)(wid * 32 + r32) * C::LDQ + hi * 8;
#pragma unroll
    for (int d0 = 0; d0 < NQ; ++d0) qr[d0] = *reinterpret_cast<const bf16x8*>(Qw + d0 * 16);
    const int vb0 = (int)(uintptr_t)V_lds + v_rd_base(lane);
    const int kr0 = tid >> 3, kc0 = tid & 7;
    const int krr = (tid & 255) >> 2, krc = tid & 3;
    const int vr0 = MODE == 0 ? (tid >> 3) : (tid >> 4), vc0 = MODE == 0 ? (tid & 7) * 8 : (tid & 15) * 8;
    const int vst0 = v_st<NC>(vr0, vc0), vst1 = v_st<NC>(32 + vr0, vc0);
    constexpr int NSET = MODE == 0 ? 2 : 1;
    struct { bf16x8 ka, kb, va, vb; } sr_[NSET];
#define SLOAD(i, k0) do { sr_[i].ka = *reinterpret_cast<const bf16x8*>(K0 + (size_t)((k0) + kr0) * C::LDK0 + kc0 * 8); \
        if (MODE == 0) { sr_[i].kb = *reinterpret_cast<const bf16x8*>(K1 + (size_t)((k0) + krr) * C::LDK1 + krc * 8); } \
        sr_[i].va = *reinterpret_cast<const bf16x8*>(Vh + (size_t)((k0) + vr0) * C::LDV + vc0); \
        if (MODE == 1) { sr_[i].vb = *reinterpret_cast<const bf16x8*>(Vh + (size_t)((k0) + 32 + vr0) * C::LDV + vc0); } } while (0)
#define SWRITE(ko, vo, i) do { *(LAS bf16x8*)(K_lds + (ko) + kr0 * KROW + kc0 * 16) = sr_[i].ka; \
        if (MODE == 0) { *(LAS bf16x8*)(K_lds + (ko) + krr * KROW + 128 + krc * 16) = sr_[i].kb; } \
        *(LAS bf16x8*)(V_lds + (vo) + vst0) = sr_[i].va; \
        if (MODE == 1) { *(LAS bf16x8*)(V_lds + (vo) + vst1) = sr_[i].vb; } } while (0)
#define SWAIT() do { if (NSET == 2) asm volatile("s_waitcnt vmcnt(3)" ::: "memory"); } while (0)
#define RESC(a) do { if (__any((a) < 1.f)) { if (hi == 0) al_l[r32] = (a); asm volatile("s_waitcnt lgkmcnt(0)" ::: "memory"); \
        _Pragma("unroll") for (int d = 0; d < NC; ++d) _Pragma("unroll") for (int r = 0; r < 16; ++r) o[d][r] *= al_l[crow(r, hi)]; } } while (0)
    f32x16 pA0, pA1, pB0, pB1; float alA = 1.f, alB = 1.f; bf16x8 pa0, pa1, pa2, pa3; constexpr int NT = NTOK / 64;
#define STEP(PC0, PC1, ALC, PP0, PP1, ALP, jj, SQ, SV, SW) do { constexpr int SETN = ((jj##_c) + 1) % NSET; \
        if ((jj) + 1 < NT) { SWAIT(); SWRITE((SW) * SHM_K, (SW) * SHM_V, SETN); } \
        SBAR(); qkt<NQ, KROW>(PC0, PC1, K_lds + (SQ) * SHM_K, qr, m_reg, r32, hi); \
        finishSM(PP0, PP1, ALP, l_reg, pa0, pa1, pa2, pa3); SBAR(); \
        if ((jj) + 1 + NSET < NT) SLOAD(SETN, ((jj) + 1 + NSET) * 64); SBAR(); \
        pv_all<NC>(o, vb0 + (SV) * SHM_V, pa0, pa1, pa2, pa3); partialSM(PC0, PC1, m_reg, ALC, false); \
        RESC(ALC); __syncthreads(); } while (0)
    static_assert((NT - 2) % 6 == 0, "tile count: steps 1..NT-2 in groups of 6");
    SLOAD(0, 0); asm volatile("s_waitcnt vmcnt(0)" ::: "memory"); SWRITE(0, 0, 0);
    SLOAD(1 % NSET, 64); if (NSET == 2) SLOAD(0, 128); __syncthreads();
    SWAIT(); SWRITE(SHM_K, SHM_V, 1 % NSET);
    qkt<NQ, KROW>(pA0, pA1, K_lds, qr, m_reg, r32, hi);
    SLOAD(1 % NSET, (1 + NSET) * 64);
    partialSM(pA0, pA1, m_reg, alA, true);
    __syncthreads();
    for (int j = 1; j + 1 < NT; j += 6) {
        constexpr int j_c = 1, j1_c = 2, j2_c = 3, j3_c = 4, j4_c = 5, j5_c = 6; const int j1 = j + 1, j2 = j + 2, j3 = j + 3, j4 = j + 4, j5 = j + 5;
        STEP(pB0, pB1, alB, pA0, pA1, alA, j,  1, 0, 2);
        STEP(pA0, pA1, alA, pB0, pB1, alB, j1, 2, 1, 0);
        STEP(pB0, pB1, alB, pA0, pA1, alA, j2, 0, 2, 1);
        STEP(pA0, pA1, alA, pB0, pB1, alB, j3, 1, 0, 2);
        STEP(pB0, pB1, alB, pA0, pA1, alA, j4, 2, 1, 0);
        STEP(pA0, pA1, alA, pB0, pB1, alB, j5, 0, 2, 1);
    }
    { constexpr int jt_c = NT - 1; const int jt = NT - 1;
      STEP(pB0, pB1, alB, pA0, pA1, alA, jt, (NT - 1) % 3, (NT - 2) % 3, NT % 3); }
    finishSM(pB0, pB1, alB, l_reg, pa0, pa1, pa2, pa3); SBAR();
    pv_all<NC>(o, vb0 + ((NT - 1) % 3) * SHM_V, pa0, pa1, pa2, pa3);
#undef STEP
    if (hi == 0) li_l[r32] = l_reg; asm volatile("s_waitcnt lgkmcnt(0)" ::: "memory");
    float rli[16];
#pragma unroll
    for (int r = 0; r < 16; ++r) rli[r] = __builtin_amdgcn_rcpf(li_l[crow(r, hi)]);
    asm volatile("" : "+s"(ldo), "+s"(stash), "+s"(gsub), "+s"(Ob));
    if constexpr (MODE == 0) {
#pragma unroll
        for (int r = 0; r < 16; ++r) { const int orow = wid * 32 + crow(r, hi);
#pragma unroll
            for (int d0 = 0; d0 < NC; ++d0) ((bf16*)Ob)[(size_t)orow * ldo + d0 * 32 + r32] = (bf16)f2bf(o[d0][r] * rli[r]); }
    } else if constexpr (EPI == 1) {
        char* st = stash + wid * 8192 + lane * 16;
#pragma unroll
        for (int d0 = 0; d0 < NC; ++d0)
#pragma unroll
            for (int q = 0; q < 2; ++q) { u32x4 w;
                w.x = cvtpk(o[d0][8 * q + 0] * rli[8 * q + 0], o[d0][8 * q + 1] * rli[8 * q + 1]); w.y = cvtpk(o[d0][8 * q + 2] * rli[8 * q + 2], o[d0][8 * q + 3] * rli[8 * q + 3]);
                w.z = cvtpk(o[d0][8 * q + 4] * rli[8 * q + 4], o[d0][8 * q + 5] * rli[8 * q + 5]); w.w = cvtpk(o[d0][8 * q + 6] * rli[8 * q + 6], o[d0][8 * q + 7] * rli[8 * q + 7]);
                *(u32x4*)(st + (d0 * 2 + q) * 1024) = w; }
        asm volatile("s_waitcnt vmcnt(0)" ::: "memory");
    } else {
        const char* st = stash + wid * 8192 + lane * 16;
#pragma unroll
        for (int d0 = 0; d0 < NC; ++d0) {
            const u32x4 wa = *(const u32x4*)(st + (d0 * 2 + 0) * 1024), wb = *(const u32x4*)(st + (d0 * 2 + 1) * 1024);
            f32x16 od;
            od[0] = __builtin_bit_cast(float, wa.x << 16); od[1] = __builtin_bit_cast(float, wa.x & 0xffff0000u); od[2] = __builtin_bit_cast(float, wa.y << 16); od[3] = __builtin_bit_cast(float, wa.y & 0xffff0000u);
            od[4] = __builtin_bit_cast(float, wa.z << 16); od[5] = __builtin_bit_cast(float, wa.z & 0xffff0000u); od[6] = __builtin_bit_cast(float, wa.w << 16); od[7] = __builtin_bit_cast(float, wa.w & 0xffff0000u);
            od[8] = __builtin_bit_cast(float, wb.x << 16); od[9] = __builtin_bit_cast(float, wb.x & 0xffff0000u); od[10] = __builtin_bit_cast(float, wb.y << 16); od[11] = __builtin_bit_cast(float, wb.y & 0xffff0000u);
            od[12] = __builtin_bit_cast(float, wb.z << 16); od[13] = __builtin_bit_cast(float, wb.z & 0xffff0000u); od[14] = __builtin_bit_cast(float, wb.w << 16); od[15] = __builtin_bit_cast(float, wb.w & 0xffff0000u);
#pragma unroll
            for (int r = 0; r < 16; ++r) od[r] -= lam * (o[d0][r] * rli[r]);
            o[d0] = od;
        }
        f32x16 ssv;
#pragma unroll
        for (int r = 0; r < 16; ++r) { float x = 0.f;
#pragma unroll
            for (int d0 = 0; d0 < NC; ++d0) x += o[d0][r] * o[d0][r];
            x += __builtin_bit_cast(float, __builtin_amdgcn_update_dpp(0, __builtin_bit_cast(int, x), 0x111, 0xf, 0xf, false));
            x += __builtin_bit_cast(float, __builtin_amdgcn_update_dpp(0, __builtin_bit_cast(int, x), 0x112, 0xf, 0xf, false));
            x += __builtin_bit_cast(float, __builtin_amdgcn_update_dpp(0, __builtin_bit_cast(int, x), 0x114, 0xf, 0xf, false));
            x += __builtin_bit_cast(float, __builtin_amdgcn_update_dpp(0, __builtin_bit_cast(int, x), 0x118, 0xf, 0xf, false));
            x += __builtin_bit_cast(float, __builtin_amdgcn_update_dpp(0, __builtin_bit_cast(int, x), 0x142, 0xa, 0xf, false));
            const float t0 = __builtin_bit_cast(float, __builtin_amdgcn_readlane(__builtin_bit_cast(int, x), 31)), t1 = __builtin_bit_cast(float, __builtin_amdgcn_readlane(__builtin_bit_cast(int, x), 63));
            ssv[r] = rsqrtf((hi ? t1 : t0) * (1.f / 128.f) + EPS) * (1.f - LAM_INIT); }
#pragma unroll
        for (int d0 = 0; d0 < NC; ++d0) { const float g = gsub[d0 * 32 + r32];
#pragma unroll
            for (int r = 0; r < 16; ++r) { const int orow = wid * 32 + crow(r, hi); ((bf16*)Ob)[(size_t)orow * ldo + d0 * 32 + r32] = (bf16)f2bf(o[d0][r] * ssv[r] * g); } }
    }
    __syncthreads();
#undef SLOAD
#undef SWRITE
#undef SWAIT
#undef RESC
}
#undef SBAR
}

#define XB_TMO      128
#define XB_XCNT(j)  (256  + 64 * (j))
#define XB_XSUB(j)  (1280 + 64 * (j))
#define XB_XGEN(j)  (2304 + 64 * (j))
#define XB_TOP      3328
#define XB_TOPGEN   3392
#define XCD_BAR_WORDS 3456
#define XB_SPIN_CAP (1u << 20)
__device__ __forceinline__ unsigned xb_ld(unsigned* p)              { return __hip_atomic_load(p, __ATOMIC_RELAXED, __HIP_MEMORY_SCOPE_AGENT); }
__device__ __forceinline__ unsigned xb_add(unsigned* p, unsigned v) { return __hip_atomic_fetch_add(p, v, __ATOMIC_RELAXED, __HIP_MEMORY_SCOPE_AGENT); }
__device__ __forceinline__ unsigned xb_xcc_id() { return (unsigned)__builtin_amdgcn_s_getreg((3 << 11) | 20) & 0xFu; }
#define XB_SPIN(cond, bar) do { unsigned _sp = 0; while (cond) { __builtin_amdgcn_s_sleep(1); \
    if ((++_sp & 255u) == 0u) { if (xb_ld(&(bar)[XB_TMO])) break; if (_sp > XB_SPIN_CAP) { atomicAdd(&(bar)[XB_TMO], 1u); break; } } } } while (0)
struct XcdBarrier { unsigned* bar; unsigned x; volatile LAS unsigned* st; };
__device__ __forceinline__ XcdBarrier xcd_barrier_post(unsigned* bar, volatile LAS unsigned* st) {
    XcdBarrier b; b.bar = bar; b.x = xb_xcc_id(); b.st = st;
    if (threadIdx.x == 0) (void)xb_add(&bar[XB_XCNT(b.x)], 1u);
    return b;
}
__device__ __forceinline__ void xcd_barrier_complete(unsigned* bar, unsigned x, unsigned& nloc, unsigned& nx) {
    const unsigned G = gridDim.x * gridDim.y * gridDim.z;
    unsigned sum, cnt, mine, sp = 0u;
    for (;;) {
        sum = 0u; cnt = 0u; mine = 0u;
#pragma unroll
        for (unsigned j = 0; j < 16; ++j) { const unsigned c = xb_ld(&bar[XB_XCNT(j)]); sum += c; cnt += (c > 0u) ? 1u : 0u; mine = (j == x) ? c : mine; }
        if (sum == G) break;
        __builtin_amdgcn_s_sleep(1);
        if ((++sp & 255u) == 0u) { if (xb_ld(&bar[XB_TMO])) break; if (sp > XB_SPIN_CAP) { atomicAdd(&bar[XB_TMO], 1u); break; } }
    }
    nloc = mine > 0u ? mine : 1u; nx = cnt > 0u ? cnt : 1u;
}
__device__ __forceinline__ void xcd_barrier(const XcdBarrier& b) {
    asm volatile("s_waitcnt vmcnt(0)" ::: "memory");
    __syncthreads();
    if (threadIdx.x == 0) {
        unsigned* bar = b.bar;
        __builtin_amdgcn_s_waitcnt(0);
        unsigned nloc = b.st[0], nx = b.st[1];
        if (nloc == 0u) { xcd_barrier_complete(bar, b.x, nloc, nx); b.st[0] = nloc; b.st[1] = nx; }
        const unsigned old = xb_add(&bar[XB_XSUB(b.x)], 1u);
        const unsigned gen = old / nloc;
        if (old + 1u == (gen + 1u) * nloc) {
            __builtin_amdgcn_fence(__ATOMIC_RELEASE, "agent");
            asm volatile("s_waitcnt vmcnt(0)" ::: "memory");
            const unsigned og = xb_add(&bar[XB_TOP], 1u);
            const unsigned tg = og / nx;
            if (og + 1u == (tg + 1u) * nx) xb_add(&bar[XB_TOPGEN], 1u);
            else XB_SPIN(xb_ld(&bar[XB_TOPGEN]) == tg, bar);
            __builtin_amdgcn_fence(__ATOMIC_ACQUIRE, "agent");
            xb_add(&bar[XB_XGEN(b.x)], 1u);
            asm volatile("s_waitcnt vmcnt(0)" ::: "memory");
        } else {
            XB_SPIN(xb_ld(&bar[XB_XGEN(b.x)]) == gen, bar);
            __builtin_amdgcn_fence(__ATOMIC_ACQUIRE, "agent");
            asm volatile("s_waitcnt vmcnt(0)" ::: "memory");
        }
    }
    __syncthreads();
}

constexpr int NWAVES = 8;
constexpr int RING_BYTES = 131072, LDS_BYTES = 147456, LDSCTL_OFF = LDS_BYTES - 2048, MISC_OFF = LDSCTL_OFF + 320, UCACHE_OFF = LDSCTL_OFF + 1024  ;

struct Frame {
    LAS unsigned char* lds; volatile LAS unsigned* MISC; unsigned* ctl;
    int tid, lane, wave, vcu, G;
    Ptrs P;
    __device__ __forceinline__ LAS char* lds_c() const { return (LAS char*)lds; }
};

template <class SrcF> __device__ __forceinline__ void transpose_item(const SrcF& f, int K, bf16* WT, int p0, int k0, LAS float* scr, int lane) {
    float t[32];
#pragma unroll
    for (int i = 0; i < 32; ++i) t[i] = f(k0 + 2 * i + (lane >> 5), p0 + (lane & 31));
#pragma unroll
    for (int i = 0; i < 32; ++i) scr[(2 * i + (lane >> 5)) * 33 + (lane & 31)] = t[i];
    LDS_WAIT(); asm volatile("" ::: "memory");
    const int c = lane & 7;
#pragma unroll
    for (int j = 0; j < 4; ++j) { const int n = (lane >> 3) + 8 * j; const LAS float* s = scr + (8 * c) * 33 + n;
        u32x4 o; o.x = cvt_pk_bf16(s[0 * 33], s[1 * 33]); o.y = cvt_pk_bf16(s[2 * 33], s[3 * 33]); o.z = cvt_pk_bf16(s[4 * 33], s[5 * 33]); o.w = cvt_pk_bf16(s[6 * 33], s[7 * 33]);
        *(u32x4*)(WT + (size_t)(p0 + n) * K + k0 + 8 * c) = o; }
    LDS_WAIT(); asm volatile("" ::: "memory");
}
struct SrcWin { const float* w; __device__ float operator()(int k, int p) const { const int l = p1_logical(p); return l < 0 ? 0.f : w[(size_t)k * IN_COLS + l]; } };
struct SrcWup { const float *gq, *wuq, *gkv, *wukv;
    __device__ float operator()(int k, int p) const {
        if (p < 768) return k < 256 ? gq[k] * wuq[(size_t)k * 768 + qm_logical(p)] : 0.f;
        return k >= 256 ? gkv[k - 256] * wukv[(size_t)(k - 256) * 1024 + (p - 768)] : 0.f; } };
struct SrcPlain { const float* w; int N; int coff; __device__ float operator()(int k, int p) const { return w[(size_t)k * N + p + coff]; } };

__device__ __forceinline__ void ph0_prep(Frame& F) {
    LAS float* scr = (LAS float*)(F.lds + F.wave * 16384);
    const int gw = F.vcu * NWAVES + F.wave, NGW = F.G * NWAVES, lane = F.lane;
    const Ptrs& P = F.P; unsigned char* ws = P.ws;
    constexpr int I_IN = 16 * 64, I_UP = 6 * 56, I_OUT = 16 * 32, I_R = 16 * 8, I_SMALL = I_IN + I_UP + I_OUT + I_R;
    for (int it = gw; it < I_SMALL; it += NGW) {
        int r = it;
        if (r < I_IN) { transpose_item(SrcWin{P.in[8]}, 1024, (bf16*)(ws + WS_WIN), (r % 64) * 32, (r / 64) * 64, scr, lane); continue; } r -= I_IN;
        if (r < I_UP) { transpose_item(SrcWup{P.in[9], P.in[10], P.in[11], P.in[12]}, 384, (bf16*)(ws + WS_WUP), (r % 56) * 32, (r / 56) * 64, scr, lane); continue; } r -= I_UP;
        if (r < I_OUT) { transpose_item(SrcPlain{P.in[18], 1024, 0}, 1024, (bf16*)(ws + WS_WOUT), (r % 32) * 32, (r / 32) * 64, scr, lane); continue; } r -= I_OUT;
        transpose_item(SrcPlain{P.in[19], 256, 0}, 1024, (bf16*)(ws + WS_WR), (r % 8) * 32, (r / 8) * 64, scr, lane);
    }
    for (int it = gw; it < 96 * 16; it += NGW) {
        const int cg = it % 96, kp = it / 96;
#pragma unroll
        for (int r = 0; r < 5; ++r) { const float c = (r < 4 ? P.in[1] + r * DM : P.in[3])[kp * 64 + lane]; scr[r * 64 + lane] = c / (1.f + __expf(-c)); }
        LDS_WAIT(); asm volatile("" ::: "memory");
        float acc[5] = {0.f, 0.f, 0.f, 0.f, 0.f};
        const float* W = P.in[4] + (size_t)(kp * 64) * 6144 + cg * 64 + lane;
#pragma unroll 8
        for (int kk = 0; kk < 64; ++kk) { const float w = W[(size_t)kk * 6144];
#pragma unroll
            for (int r = 0; r < 5; ++r) acc[r] += scr[r * 64 + kk] * w; }
        LDS_WAIT(); asm volatile("" ::: "memory");
#pragma unroll
        for (int r = 0; r < 5; ++r) ((float*)(ws + WS_MODP))[(size_t)(kp * 5 + r) * 6144 + cg * 64 + lane] = acc[r];
    }
    { const int idx = (F.vcu * 512 + F.tid);
      if (idx < 1024) { const int v = idx / 16, f = idx % 16; const float th = (float)v * exp2f(-(float)f / 16.f * 13.287712379549449f);
          ((float2*)(ws + WS_TAB))[idx] = make_float2(__builtin_amdgcn_cosf(th * 0.15915494309189535f), __builtin_amdgcn_sinf(th * 0.15915494309189535f)); }
      else if (idx < 1536) { const int i2 = idx - 1024, v = i2 / 8, f = i2 % 8; const float th = (float)v * exp2f(-(float)f / 8.f * 13.287712379549449f);
          ((float2*)(ws + WS_TAB))[idx] = make_float2(__builtin_amdgcn_cosf(th * 0.15915494309189535f), __builtin_amdgcn_sinf(th * 0.15915494309189535f)); } }
}
struct CvItem { const float* src; int ld; bf16* dst; int K; };
__device__ __forceinline__ CvItem cv_decode(const Ptrs& P, int it, int lane) {
    constexpr int IPE = 256 + 128; unsigned char* ws = P.ws;
    const int e = it / IPE; int r = it % IPE; CvItem c;
    if (r < 256) { const int p0 = (r % 16) * 32, k0 = (r / 16) * 64, half = p0 >> 8, up = (p0 >> 7) & 1;
        const float* w = e < 256 ? (up ? P.in[22] : P.in[21]) + (size_t)e * DM * EFF : (up ? P.in[25] : P.in[24]);
        c.src = w + (size_t)(k0 + (lane >> 5)) * EFF + half * 128 + (p0 & 127) + (lane & 31); c.ld = EFF; c.K = 1024;
        c.dst = (bf16*)(ws + WS_W13) + ((size_t)e * 512 + p0) * 1024 + k0; }
    else { r -= 256; const int p0 = (r % 32) * 32, k0 = (r / 32) * 64;
        const float* w = e < 256 ? P.in[23] + (size_t)e * EFF * DM : P.in[26];
        c.src = w + (size_t)(k0 + (lane >> 5)) * DM + p0 + (lane & 31); c.ld = DM; c.K = 256;
        c.dst = (bf16*)(ws + WS_W2) + ((size_t)e * 1024 + p0) * 256 + k0; }
    return c;
}
#define CV_LOAD(t, c) do { _Pragma("unroll") for (int _i = 0; _i < 32; ++_i) t[_i] = (c).src[(size_t)(2 * _i) * (c).ld]; } while (0)
#define CV_FINISH(t, c) do { _Pragma("unroll") for (int _i = 0; _i < 32; ++_i) scr[(2 * _i + (lane >> 5)) * 33 + (lane & 31)] = t[_i]; \
        LDS_WAIT(); asm volatile("" ::: "memory"); const int _c = lane & 7; \
        _Pragma("unroll") for (int _j = 0; _j < 4; ++_j) { const int _n = (lane >> 3) + 8 * _j; const LAS float* _s = scr + (8 * _c) * 33 + _n; \
            u32x4 _o; _o.x = cvt_pk_bf16(_s[0 * 33], _s[1 * 33]); _o.y = cvt_pk_bf16(_s[2 * 33], _s[3 * 33]); _o.z = cvt_pk_bf16(_s[4 * 33], _s[5 * 33]); _o.w = cvt_pk_bf16(_s[6 * 33], _s[7 * 33]); \
            *(u32x4*)((c).dst + (size_t)_n * (c).K + 8 * _c) = _o; } \
        LDS_WAIT(); asm volatile("" ::: "memory"); } while (0)
constexpr int CV_EARLY = 0;
__device__ __forceinline__ void ph0_experts(Frame& F, int r_from, int r_to) {
    LAS float* scr = (LAS float*)(F.lds + F.wave * 16384);
    const int gw = F.vcu * NWAVES + F.wave, NGW = F.G * NWAVES, lane = F.lane, NIT = 257 * 384;
    const Ptrs& P = F.P;
    float ta[32], tb[32];
    const long lim = (long)gw + (long)(r_to < (1 << 20) ? r_to : (1 << 20)) * NGW; const int NE = (int)(lim < NIT ? lim : NIT);
    int it = gw + r_from * NGW; CvItem ca, cb;
    if (it < NE) { ca = cv_decode(P, it, lane); CV_LOAD(ta, ca); }
    for (; it < NE; it += 2 * NGW) {
        const int it2 = it + NGW, it3 = it + 2 * NGW;
        if (it2 < NE) { cb = cv_decode(P, it2, lane); CV_LOAD(tb, cb); }
        CV_FINISH(ta, ca);
        if (it3 < NE) { ca = cv_decode(P, it3, lane); CV_LOAD(ta, ca); }
        if (it2 < NE) CV_FINISH(tb, cb);
    }
    __syncthreads();
}
#undef CV_LOAD
#undef CV_FINISH
__device__ __forceinline__ void ph1_xn(Frame& F) {
    const Ptrs& P = F.P; unsigned char* ws = P.ws;
    const float* MODP = (const float*)(ws + WS_MODP);
    for (int idx = F.vcu * 512 + F.tid; idx < 5 * 6144; idx += F.G * 512) { const int r = idx / 6144, j = idx % 6144; float a = P.in[5][j];
#pragma unroll
        for (int kp = 0; kp < 16; ++kp) a += MODP[(size_t)(kp * 5 + r) * 6144 + j];
        ((float*)(ws + WS_MOD))[idx] = a; }
    const int RPB = (MALL + F.G - 1) / F.G, r_lo = F.vcu * RPB, r_hi = min(MALL, r_lo + RPB);
    if (r_lo >= r_hi) return;
    const int b0 = r_lo / NTOK, b1 = (r_hi - 1) / NTOK;
    LAS float* sm = (LAS float*)F.lds;
    for (int i = F.tid; i < 3 * 2048; i += 512) { const int sl = i / 2048, j = i % 2048; const int r = sl == 0 ? b0 : sl == 1 ? b1 : 4; float a = P.in[5][j];
#pragma unroll
        for (int kp = 0; kp < 16; ++kp) a += MODP[(size_t)(kp * 5 + r) * 6144 + j];
        sm[i] = a; }
    __syncthreads();
    auto rowsrc = [&](int r) -> const f32x4* { const int b = r / NTOK, n = r % NTOK;
        return (const f32x4*)(n < NCTX ? P.in[2] + ((size_t)b * NCTX + n) * DM : P.in[0] + ((size_t)b * SEQ + (n - NCTX)) * DM) + F.lane; };
    f32x4 v[4], nv[4];
    { const int r = r_lo + F.wave; if (r < r_hi) { const f32x4* xr = rowsrc(r);
#pragma unroll
        for (int j = 0; j < 4; ++j) v[j] = xr[64 * j]; } }
    for (int r = r_lo + F.wave; r < r_hi; r += NWAVES) {
        const int b = r / NTOK, n = r % NTOK;
        { const int rn = r + NWAVES < r_hi ? r + NWAVES : r; const f32x4* xr = rowsrc(rn);
#pragma unroll
          for (int j = 0; j < 4; ++j) nv[j] = xr[64 * j]; }
        const LAS float* md = sm + (n < NCTX ? 2 : (b == b0 ? 0 : 1)) * 2048;
        float s = 0.f;
#pragma unroll
        for (int j = 0; j < 4; ++j) s += (v[j][0] * v[j][0] + v[j][1] * v[j][1]) + (v[j][2] * v[j][2] + v[j][3] * v[j][3]);
        const float rs = rsqrtf(wave_sum(s) * (1.f / DM) + EPS);
        u32x2* o8 = (u32x2*)((bf16*)(ws + WS_XN) + (size_t)r * DM) + F.lane;
#pragma unroll
        for (int j = 0; j < 4; ++j) { const int c = 4 * F.lane + 256 * j; const f32x4 g = *(const f32x4*)(P.in[6] + c);
            const f32x4 sh = *(const LAS f32x4*)(md + c), sc = *(const LAS f32x4*)(md + 1024 + c);
            const f32x4 y = (v[j] * rs * g) * (sc + 1.f) + sh;
            u32x2 w; w.x = cvt_pk_bf16(y[0], y[1]); w.y = cvt_pk_bf16(y[2], y[3]); o8[64 * j] = w; }
#pragma unroll
        for (int j = 0; j < 4; ++j) v[j] = nv[j];
    }
    __syncthreads();
}
__device__ __forceinline__ void ph6_h2(Frame& F) {
    const Ptrs& P = F.P; unsigned char* ws = P.ws;
    const int gw = F.vcu * NWAVES + F.wave, NGW = F.G * NWAVES;
    f32x4 v[4], nv[4];
    if (gw < MLAT) { const f32x4* xr = (const f32x4*)((const float*)(ws + WS_X1) + (size_t)gw * DM) + F.lane;
#pragma unroll
        for (int j = 0; j < 4; ++j) v[j] = xr[64 * j]; }
    for (int t = gw; t < MLAT; t += NGW) {
        const int b = t / SEQ; const float* md = (const float*)(ws + WS_MOD) + b * 6144;
        { const int tn = t + NGW < MLAT ? t + NGW : t; const f32x4* xr = (const f32x4*)((const float*)(ws + WS_X1) + (size_t)tn * DM) + F.lane;
#pragma unroll
          for (int j = 0; j < 4; ++j) nv[j] = xr[64 * j]; }
        float s = 0.f;
#pragma unroll
        for (int j = 0; j < 4; ++j) s += (v[j][0] * v[j][0] + v[j][1] * v[j][1]) + (v[j][2] * v[j][2] + v[j][3] * v[j][3]);
        const float rs = rsqrtf(wave_sum(s) * (1.f / DM) + EPS);
        u32x2* o8 = (u32x2*)((bf16*)(ws + WS_H2) + (size_t)t * DM) + F.lane;
#pragma unroll
        for (int j = 0; j < 4; ++j) { const int c = 4 * F.lane + 256 * j; const f32x4 g = *(const f32x4*)(P.in[7] + c);
            const f32x4 sh = *(const f32x4*)(md + 3072 + c), sc = *(const f32x4*)(md + 4096 + c);
            const f32x4 y = (v[j] * rs * g) * (sc + 1.f) + sh;
            u32x2 w; w.x = cvt_pk_bf16(y[0], y[1]); w.y = cvt_pk_bf16(y[2], y[3]); o8[64 * j] = w; }
#pragma unroll
        for (int j = 0; j < 4; ++j) v[j] = nv[j];
    }
}
__device__ __forceinline__ void ph7_route(Frame& F) {
    const Ptrs& P = F.P; unsigned char* ws = P.ws; const int lane = F.lane;
    const int gw = F.vcu * NWAVES + F.wave, NGW = F.G * NWAVES;
    const f32x4 bi = ((const f32x4*)P.in[20])[lane];
    for (int t = gw; t < MLAT; t += NGW) {
        f32x4 lg = ((const f32x4*)(ws + WS_LOGP))[(size_t)t * 64 + lane];
#pragma unroll
        for (int kp = 1; kp < 4; ++kp) lg += ((const f32x4*)(ws + WS_LOGP))[((size_t)kp * MLAT + t) * 64 + lane];
        float s[4], v[4];
#pragma unroll
        for (int i = 0; i < 4; ++i) { s[i] = 1.f / (1.f + __expf(-lg[i])); v[i] = s[i] + bi[i]; }
        float m1 = fmaxf(v[0], v[1]), m2 = fminf(v[0], v[1]);
#pragma unroll
        for (int i = 2; i < 4; ++i) { const float x = v[i]; m2 = fmaxf(m2, fminf(m1, x)); m1 = fmaxf(m1, x); }
#pragma unroll
        for (int o = 1; o < 8; o <<= 1) { const float b1 = __shfl_xor(m1, o), b2 = __shfl_xor(m2, o); const float n1 = fmaxf(m1, b1), n2 = fmaxf(fminf(m1, b1), fmaxf(m2, b2)); m1 = n1; m2 = n2; }
        const float gs = m1 + m2; const int g = lane >> 3; int rank = 0;
#pragma unroll
        for (int j = 0; j < 8; ++j) { const float o = __shfl(gs, j * 8); rank += (o > gs || (o == gs && j < g)) ? 1 : 0; }
        if (rank >= 4) { v[0] = v[1] = v[2] = v[3] = -INFINITY; }
        int my_e = 0; float my_s = 0.f, ssum = 0.f;
#pragma unroll
        for (int k = 0; k < 8; ++k) {
            float bv = v[0]; int bi_ = 0;
#pragma unroll
            for (int i = 1; i < 4; ++i) if (v[i] > bv) { bv = v[i]; bi_ = i; }
            int be = lane * 4 + bi_;
#pragma unroll
            for (int o = 1; o < 64; o <<= 1) { const float ov = __shfl_xor(bv, o); const int oe = __shfl_xor(be, o); if (ov > bv || (ov == bv && oe < be)) { bv = ov; be = oe; } }
            const int wl = be >> 2, wi = be & 3;
            float sv = wi == 0 ? s[0] : wi == 1 ? s[1] : wi == 2 ? s[2] : s[3];
            sv = __shfl(sv, wl);
            if (lane == wl) { if (wi == 0) v[0] = -INFINITY; else if (wi == 1) v[1] = -INFINITY; else if (wi == 2) v[2] = -INFINITY; else v[3] = -INFINITY; }
            ssum += sv; if (lane == k) { my_e = be; my_s = sv; }
        }
        if (lane < 8) {
            int* cnt = (int*)(ws + WS_CTL) + CW_COUNT;
            const int rk = atomicAdd(&cnt[my_e], 1);
            ((int*)(ws + WS_EIDX))[(size_t)t * 8 + lane] = my_e;
            ((float*)(ws + WS_EW))[(size_t)t * 8 + lane] = my_s / ssum * 2.5f;
            ((int*)(ws + WS_ERANK))[(size_t)t * 8 + lane] = rk;
        }
    }
}
__device__ __forceinline__ void ph_route3(Frame& F) {
    const Ptrs& P = F.P; unsigned char* ws = P.ws; const int lane = F.lane, wave = F.wave, fr = lane & 15, fq = lane >> 4;
    LAS unsigned char* At = F.lds;
    const bf16* Wr = (const bf16*)(ws + WS_WR);
    const f32x4 bi = ((const f32x4*)P.in[20])[lane];
    for (int grp = F.vcu; grp < MLAT / 64; grp += F.G) {
        const int t0 = grp * 64, b = t0 / SEQ; const float* md = (const float*)(ws + WS_MOD) + b * 6144;
        u32x4 v[2], nv[2];
        { const u32x4* xr = (const u32x4*)((const bf16*)(ws + WS_X1) + (size_t)(t0 + wave * 8) * DM) + lane; v[0] = xr[0]; v[1] = xr[64]; }
#pragma unroll 1
        for (int i = 0; i < 8; ++i) {
            const int r = wave * 8 + i, t = t0 + r;
            { const int rn = i < 7 ? t + 1 : t; const u32x4* xr = (const u32x4*)((const bf16*)(ws + WS_X1) + (size_t)rn * DM) + lane; nv[0] = xr[0]; nv[1] = xr[64]; }
            float xf[2][8]; float s = 0.f;
#pragma unroll
            for (int h = 0; h < 2; ++h)
#pragma unroll
                for (int d = 0; d < 4; ++d) { xf[h][2 * d] = bflo(v[h][d]); xf[h][2 * d + 1] = bfhi(v[h][d]); s += xf[h][2 * d] * xf[h][2 * d] + xf[h][2 * d + 1] * xf[h][2 * d + 1]; }
            const float rs = rsqrtf(wave_sum(s) * (1.f / DM) + EPS);
#pragma unroll
            for (int h = 0; h < 2; ++h) { const int c = 8 * lane + 512 * h; f32x4 y[2];
#pragma unroll
                for (int q = 0; q < 2; ++q) { const f32x4 g = *(const f32x4*)(P.in[7] + c + 4 * q), sh = *(const f32x4*)(md + 3072 + c + 4 * q), sc = *(const f32x4*)(md + 4096 + c + 4 * q);
                    const f32x4 xv = {xf[h][4 * q], xf[h][4 * q + 1], xf[h][4 * q + 2], xf[h][4 * q + 3]}; y[q] = (xv * rs * g) * (sc + 1.f) + sh; }
                const u32x4 w = pack8(y[0], y[1]);
                *(u32x4*)((bf16*)(ws + WS_H2) + (size_t)t * DM + c) = w;
                const int ch = lane + 64 * h;
                *(LAS u32x4*)(At + r * 2048 + ((ch ^ (r & 15)) << 4)) = w; }
            v[0] = nv[0]; v[1] = nv[1];
        }
        __syncthreads();
        f32x4 acc[4][2];
#pragma unroll
        for (int m = 0; m < 4; ++m) { acc[m][0] = (f32x4){0.f, 0.f, 0.f, 0.f}; acc[m][1] = (f32x4){0.f, 0.f, 0.f, 0.f}; }
        const bf16* wb = Wr + (size_t)(wave * 32 + fr) * 1024 + 8 * fq;
        bf16x8 bq[4][2], nb[4][2];
#pragma unroll
        for (int u = 0; u < 4; ++u) { bq[u][0] = *(const bf16x8*)(wb + 32 * u); bq[u][1] = *(const bf16x8*)(wb + 16 * 1024 + 32 * u); }
#pragma unroll 1
        for (int k4 = 0; k4 < 8; ++k4) {
            if (k4 < 7) {
#pragma unroll
                for (int u = 0; u < 4; ++u) { nb[u][0] = *(const bf16x8*)(wb + 32 * (4 * (k4 + 1) + u)); nb[u][1] = *(const bf16x8*)(wb + 16 * 1024 + 32 * (4 * (k4 + 1) + u)); } }
#pragma unroll
            for (int u = 0; u < 4; ++u) { const int ks = 4 * k4 + u, ch = 4 * ks + fq;
#pragma unroll
                for (int m = 0; m < 4; ++m) { const int r = 16 * m + fr;
                    const bf16x8 a = *(const LAS bf16x8*)(At + r * 2048 + ((ch ^ (r & 15)) << 4));
                    acc[m][0] = __builtin_amdgcn_mfma_f32_16x16x32_bf16(bq[u][0], a, acc[m][0], 0, 0, 0);
                    acc[m][1] = __builtin_amdgcn_mfma_f32_16x16x32_bf16(bq[u][1], a, acc[m][1], 0, 0, 0); } }
#pragma unroll
            for (int u = 0; u < 4; ++u) { bq[u][0] = nb[u][0]; bq[u][1] = nb[u][1]; }
        }
        __syncthreads();
        LAS float* Lg = (LAS float*)F.lds;
#pragma unroll
        for (int m = 0; m < 4; ++m)
#pragma unroll
            for (int n = 0; n < 2; ++n) *(LAS f32x4*)(Lg + (16 * m + fr) * 260 + wave * 32 + 16 * n + 4 * fq) = acc[m][n];
        __syncthreads();
#pragma unroll 1
        for (int i = 0; i < 8; ++i) {
            const int r = wave * 8 + i, t = t0 + r;
            const f32x4 lg = *(const LAS f32x4*)(Lg + r * 260 + 4 * lane);
            float s[4], vv[4];
#pragma unroll
            for (int q = 0; q < 4; ++q) { s[q] = 1.f / (1.f + __expf(-lg[q])); vv[q] = s[q] + bi[q]; }
            float m1 = fmaxf(vv[0], vv[1]), m2 = fminf(vv[0], vv[1]);
#pragma unroll
            for (int q = 2; q < 4; ++q) { const float x = vv[q]; m2 = fmaxf(m2, fminf(m1, x)); m1 = fmaxf(m1, x); }
#pragma unroll
            for (int o = 1; o < 8; o <<= 1) { const float b1 = __shfl_xor(m1, o), b2 = __shfl_xor(m2, o); const float n1 = fmaxf(m1, b1), n2 = fmaxf(fminf(m1, b1), fmaxf(m2, b2)); m1 = n1; m2 = n2; }
            const float gs = m1 + m2; const int g = lane >> 3; int rank = 0;
#pragma unroll
            for (int j = 0; j < 8; ++j) { const float o = __builtin_bit_cast(float, __builtin_amdgcn_readlane(__builtin_bit_cast(int, gs), j * 8)); rank += (o > gs || (o == gs && j < g)) ? 1 : 0; }
            unsigned key[4];
#pragma unroll
            for (int q = 0; q < 4; ++q) key[q] = rank >= 4 ? 0u : ((__builtin_bit_cast(unsigned, vv[q] + 1.f) & 0xFFFFFF00u) | (unsigned)(255 - (lane * 4 + q)));
            int my_e = 0; float my_s = 0.f, ssum = 0.f;
#pragma unroll
            for (int k = 0; k < 8; ++k) {
                unsigned kb = max(max(key[0], key[1]), max(key[2], key[3]));
                kb = max(kb, (unsigned)__builtin_amdgcn_update_dpp(0, (int)kb, 0x111, 0xf, 0xf, false));
                kb = max(kb, (unsigned)__builtin_amdgcn_update_dpp(0, (int)kb, 0x112, 0xf, 0xf, false));
                kb = max(kb, (unsigned)__builtin_amdgcn_update_dpp(0, (int)kb, 0x114, 0xf, 0xf, false));
                kb = max(kb, (unsigned)__builtin_amdgcn_update_dpp(0, (int)kb, 0x118, 0xf, 0xf, false));
                kb = max(kb, (unsigned)__builtin_amdgcn_update_dpp(0, (int)kb, 0x142, 0xa, 0xf, false));
                kb = max(kb, (unsigned)__builtin_amdgcn_update_dpp(0, (int)kb, 0x143, 0xc, 0xf, false));
                const unsigned kw = (unsigned)__builtin_amdgcn_readlane((int)kb, 63);
                const int be = 255 - (int)(kw & 255u), wl = be >> 2, wi = be & 3;
                const float ssel = wi == 0 ? s[0] : wi == 1 ? s[1] : wi == 2 ? s[2] : s[3];
                const float sv = __builtin_bit_cast(float, __builtin_amdgcn_readlane(__builtin_bit_cast(int, ssel), wl));
#pragma unroll
                for (int q = 0; q < 4; ++q) key[q] = key[q] == kw ? 0u : key[q];
                ssum += sv; if (lane == k) { my_e = be; my_s = sv; }
            }
            if (lane < 8) {
                int* cnt = (int*)(ws + WS_CTL) + CW_COUNT;
                const int rk = atomicAdd(&cnt[my_e], 1);
                ((int*)(ws + WS_EIDX))[(size_t)t * 8 + lane] = my_e;
                ((float*)(ws + WS_EW))[(size_t)t * 8 + lane] = my_s / ssum * 2.5f;
                ((int*)(ws + WS_ERANK))[(size_t)t * 8 + lane] = rk;
            }
        }
        __syncthreads();
    }
}
__device__ __forceinline__ void ph8_slots(Frame& F) {
    const Ptrs& P = F.P; unsigned char* ws = P.ws;
    LAS int* off = (LAS int*)F.lds;
    LAS int* cfs = off + 260;
    LAS int* chs = off + 520;
    unsigned* cnt = (unsigned*)(ws + WS_CTL) + CW_COUNT;
    if (F.wave == 0) { const int lane = F.lane; int n[4], cf[4], ch[4], sn = 0, sf = 0, sh = 0;
#pragma unroll
        for (int i = 0; i < 4; ++i) { n[i] = (int)cnt[4 * lane + i]; const int r = n[i] & 255; cf[i] = (n[i] >> 8) + (r > 128 ? 1 : 0); ch[i] = (r > 0 && r <= 128) ? 1 : 0; sn += n[i]; sf += cf[i]; sh += ch[i]; }
        int in = sn, jf = sf, jh = sh;
#pragma unroll
        for (int o = 1; o < 64; o <<= 1) { const int tn = __shfl_up(in, o), tf = __shfl_up(jf, o), th = __shfl_up(jh, o); if (lane >= o) { in += tn; jf += tf; jh += th; } }
        int an = in - sn, af = jf - sf, ah = jh - sh;
#pragma unroll
        for (int i = 0; i < 4; ++i) { off[4 * lane + i] = an; cfs[4 * lane + i] = af; chs[4 * lane + i] = ah; an += n[i]; af += cf[i]; ah += ch[i]; }
        if (lane == 63) { off[256] = an; cfs[256] = af; chs[256] = ah; off[257] = NSLOT; cfs[257] = af + MLAT / 256; chs[257] = ah; } }
    __syncthreads();
    for (int idx = F.vcu * 512 + F.tid; idx < MLAT * 8; idx += F.G * 512) {
        const int e = ((const int*)(ws + WS_EIDX))[idx], rk = ((const int*)(ws + WS_ERANK))[idx];
        const int slot = off[e] + rk;
        ((int*)(ws + WS_SLOTOF))[idx] = slot; ((int*)(ws + WS_SLOTTOK))[slot] = idx >> 3; ((float*)(ws + WS_SLOTW))[slot] = ((const float*)(ws + WS_EW))[idx];
        if (idx < MLAT) { ((int*)(ws + WS_SLOTTOK))[MLAT * 8 + idx] = idx; ((float*)(ws + WS_SLOTW))[MLAT * 8 + idx] = 1.f; }
    }
    if (F.vcu == 0) {
        int* go = (int*)(ws + WS_OFF); int* ut = (int*)(ws + WS_UT);
        const int nfull = cfs[257];
        for (int e = F.tid; e < 258; e += 512) go[e] = off[e];
        for (int e = F.tid; e < 257; e += 512) { const int n = off[e + 1] - off[e], nf = cfs[e + 1] - cfs[e], nh = chs[e + 1] - chs[e];
            for (int j = 0; j < nf; ++j) { int* u = ut + (cfs[e] + j) * 4; u[0] = e; u[1] = off[e] + j * 256; u[2] = min(256, n - j * 256); u[3] = 0; }
            if (nh) { int* u = ut + (nfull + chs[e]) * 4; u[0] = e; u[1] = off[e] + nf * 256; u[2] = n - nf * 256; u[3] = 0; } }
        if (F.tid == 0) { ((int*)(ws + WS_CTL))[CW_NUNIT] = nfull + chs[257]; ((int*)(ws + WS_CTL))[CW_NFULL] = nfull; }
    }
    __syncthreads();
}
__device__ __forceinline__ void ph11_combine(Frame& F) {
    const Ptrs& P = F.P; unsigned char* ws = P.ws; const int lane = F.lane;
    const int gw = F.vcu * NWAVES + F.wave, NGW = F.G * NWAVES;
    const unsigned char* Y = (const unsigned char*)(ws + WS_Y);
    const int cbase = 256 * (lane >> 4) + 32 * ((lane >> 2) & 3) + 8 * (lane & 3);
    u32x4 yw[9], nyw[9]; u32x4 xw[2], nxw[2]; int nsl[8];
    auto ldslots = [&](int t) {
#pragma unroll
        for (int k = 0; k < 8; ++k) nsl[k] = ((const int*)(ws + WS_SLOTOF))[(size_t)t * 8 + k]; };
    auto ldrows = [&](int t) {
#pragma unroll
        for (int k = 0; k < 9; ++k) { const int sl = k < 8 ? nsl[k] : MLAT * 8 + t; nyw[k] = *(const u32x4*)(Y + (size_t)sl * DM + lane * 16); }
        nxw[0] = *(const u32x4*)((const bf16*)(ws + WS_X1) + (size_t)t * DM + cbase); nxw[1] = *(const u32x4*)((const bf16*)(ws + WS_X1) + (size_t)t * DM + cbase + 128); };
    if (gw < MLAT) { ldslots(gw); ldrows(gw); if (gw + NGW < MLAT) ldslots(gw + NGW); }
    for (int t = gw; t < MLAT; t += NGW) {
        const int b = t / SEQ; const float* gt2 = (const float*)(ws + WS_MOD) + b * 6144 + 5120;
#pragma unroll
        for (int k = 0; k < 9; ++k) yw[k] = nyw[k];
        xw[0] = nxw[0]; xw[1] = nxw[1];
        if (t + NGW < MLAT) { ldrows(t + NGW); if (t + 2 * NGW < MLAT) ldslots(t + 2 * NGW); }
        float a[16];
#pragma unroll
        for (int i = 0; i < 16; ++i) a[i] = 0.f;
#pragma unroll
        for (int k = 0; k < 9; ++k)
#pragma unroll
            for (int d = 0; d < 4; ++d) { const int w = (int)yw[k][d];
                const f32x2 lo = __builtin_amdgcn_cvt_pk_f32_fp8(w, false), hi = __builtin_amdgcn_cvt_pk_f32_fp8(w, true);
                a[4 * d + 0] += lo[0]; a[4 * d + 1] += lo[1]; a[4 * d + 2] += hi[0]; a[4 * d + 3] += hi[1]; }
        float ss = 0.f;
#pragma unroll
        for (int q = 0; q < 4; ++q) { const int c = cbase + (q >> 1) * 128 + (q & 1) * 4; const u32x4 xb = xw[q >> 1]; const unsigned x01 = (q & 1) ? xb.z : xb.x, x23 = (q & 1) ? xb.w : xb.y;
            const f32x4 xv = {bflo(x01), bfhi(x01), bflo(x23), bfhi(x23)}, gv = *(const f32x4*)(gt2 + c);
#pragma unroll
            for (int e = 0; e < 4; ++e) { const float v = xv[e] + gv[e] * (a[q * 4 + e] * (1.f / YSCALE)); a[q * 4 + e] = v; ss += v * v; } }
        const float rs = rsqrtf(wave_sum(ss) * (1.f / DM) + EPS);
#pragma unroll
        for (int q = 0; q < 4; ++q) { const int c = cbase + (q >> 1) * 128 + (q & 1) * 4; const f32x4 gf = *(const f32x4*)(P.in[27] + c);
            f32x4 o;
#pragma unroll
            for (int e = 0; e < 4; ++e) o[e] = a[q * 4 + e] * rs * gf[e];
            *(f32x4*)(P.out + (size_t)t * DM + c) = o; }
    }
}
__device__ __forceinline__ void ph4b_diff_finish(Frame& F) {
    const Ptrs& P = F.P; unsigned char* ws = P.ws; const int lane = F.lane;
    const int gw = F.vcu * NWAVES + F.wave, NGW = F.G * NWAVES;
    float d1 = P.in[13][lane] * P.in[14][lane], d2 = P.in[15][lane] * P.in[16][lane];
    d1 = wave_sum(d1); d2 = wave_sum(d2);
    const float lam = __expf(d1) - __expf(d2) + LAM_INIT;
    const float g0 = P.in[17][lane], g1 = P.in[17][64 + lane];
    for (int t = gw; t < MLAT; t += NGW) {
        const float* os = (const float*)(ws + WS_OS) + (size_t)t * 8 * 128;
        float x[4][4];
#pragma unroll
        for (int h = 0; h < 4; ++h) { x[h][0] = os[(2 * h) * 128 + lane]; x[h][1] = os[(2 * h) * 128 + 64 + lane]; x[h][2] = os[(2 * h + 1) * 128 + lane]; x[h][3] = os[(2 * h + 1) * 128 + 64 + lane]; }
#pragma unroll
        for (int h = 0; h < 4; ++h) {
            const float v0 = x[h][0] - lam * x[h][2], v1 = x[h][1] - lam * x[h][3];
            const float rs = rsqrtf(wave_sum(v0 * v0 + v1 * v1) * (1.f / 128.f) + EPS) * (1.f - LAM_INIT);
            bf16* mo = (bf16*)(ws + WS_MIX) + (size_t)t * DM + 512 + h * 128;
            mo[lane] = (bf16)f2bf(v0 * rs * g0); mo[64 + lane] = (bf16)f2bf(v1 * rs * g1); }
    }
}

enum { P_PREP = 0, P_XN, P_INPROJ, P_UP, P_ATTN, P_DIFFFIN, P_OUT, P_H2, P_ROUTER, P_ROUTE, P_SLOTS, P_EXP1, P_EXP2, P_COMB, P_END };
struct Args { Ptrs P; int ph_lo, ph_hi, li, pad; };
__global__ void __launch_bounds__(NWAVES * 64, 2) mk_fwd(Args args) {
    extern __shared__ __attribute__((aligned(16))) unsigned char lds[];
    Frame F;
    F.lds = (LAS unsigned char*)lds; F.MISC = (volatile LAS unsigned*)(F.lds + MISC_OFF);
    F.tid = threadIdx.x; F.lane = F.tid & 63; F.wave = __builtin_amdgcn_readfirstlane(F.tid >> 6);
    F.G = gridDim.x; { const int bx = blockIdx.x; F.vcu = (F.G % 8 == 0) ? (bx % 8) * (F.G / 8) + bx / 8 : bx; }
    F.P = args.P; unsigned char* ws = args.P.ws; F.ctl = (unsigned*)(ws + WS_CTL);
    for (int u = F.tid; u < (LDS_BYTES - LDSCTL_OFF) / 4; u += NWAVES * 64) ((LAS unsigned*)(F.lds + LDSCTL_OFF))[u] = 0u;
    __syncthreads();
    XcdBarrier bar = xcd_barrier_post(F.ctl + CW_BAR + args.li * XCD_BAR_WORDS, F.MISC + 8);
    const int lo = args.ph_lo, hi = args.ph_hi;
#ifndef PHMASK
#define PHMASK 0xFFFF
#endif
#define IN(k) ((((PHMASK) >> (k)) & 1) && lo <= (k) && (k) < hi)
#define SEAM(k) do { if (IN(k) && IN((k) + 1)) xcd_barrier(bar); } while (0)
#define SEAM_SKIP1(k) do { if (IN(k) && IN((k) + 2)) xcd_barrier(bar); } while (0)
#define SEAM_SKIP2(k) do { if (IN(k) && IN((k) + 3)) xcd_barrier(bar); } while (0)
    if (IN(P_PREP)) { ph0_prep(F); } SEAM(P_PREP);
    if (IN(P_XN)) { ph1_xn(F); } SEAM(P_XN);
    if (IN(P_INPROJ)) {
        pg8::Gemm g{(const bf16*)(ws + WS_XN), (const bf16*)(ws + WS_WIN), 1024, 1024, 1024}; pg8::StaticOrder S; S.init(MALL, NP1, F.G, (int)blockIdx.x);
        EpiInProj E{(bf16*)(ws + WS_P1), (float*)(ws + WS_SSQ), (const float2*)(ws + WS_TAB), (const float2*)(ws + WS_TAB) + 1024};
        pg8::gemm_phase(F.lds, g, S, E);
        if (CV_EARLY > 0 && (int)blockIdx.x >= (MALL / 256) * (NP1 / 256) - 2 * F.G) ph0_experts(F, 0, CV_EARLY);
    } SEAM(P_INPROJ);
    if (IN(P_UP)) {
        pg8::Gemm g{(const bf16*)(ws + WS_P1), (const bf16*)(ws + WS_WUP), 2048, 384, 256}; UpOrder S{F.G, F.vcu};
        EpiUp E{(bf16*)(ws + WS_QM), (bf16*)(ws + WS_KVM), (const float*)(ws + WS_SSQ), (const float2*)(ws + WS_TAB) + 1024};
        pg8::gemm_phase(F.lds, g, S, E);
    } SEAM(P_UP);
    if (IN(P_ATTN)) {
        const bf16* P1 = (const bf16*)(ws + WS_P1); const bf16* QM = (const bf16*)(ws + WS_QM); const bf16* KVM = (const bf16*)(ws + WS_KVM);
        const int cslot = F.vcu % 5; int ui = 0;
        bool conv_done = false; int U = F.vcu;
        const int conv_from = ((int)blockIdx.x >= (MALL / 256) * (NP1 / 256) - 2 * F.G) ? CV_EARLY : 0;
        float lam; { float d1 = F.P.in[13][F.lane] * F.P.in[14][F.lane], d2 = F.P.in[15][F.lane] * F.P.in[16][F.lane]; d1 = wave_sum(d1); d2 = wave_sum(d2); lam = __expf(d1) - __expf(d2) + LAM_INIT; }
        for (; U < 512; U += F.G, ++ui) {
            if (ui == cslot) { ph0_experts(F, conv_from, 1 << 30); conv_done = true; }
            const int bh = U >> 4, qb = U & 15, b = bh >> 3, hh = bh & 7;
            const bf16* K0 = KVM + (size_t)b * NTOK * 1024 + hh * 128;
            attn::unit<0, 0>(QM + (size_t)(b * NTOK + NCTX + qb * 256) * 768 + hh * 96, K0, P1 + (size_t)b * NTOK * NP1 + 384, K0 + 64,
                             (bf16*)(ws + WS_MIX) + (size_t)(b * SEQ + qb * 256) * DM + hh * 64, DM, F.lds_c(), nullptr, 0.f, nullptr);
        }
        char* stash = (char*)(ws + WS_OS) + (size_t)F.vcu * 65536;
        const int Ud0 = U;
        for (; U < 768; U += 1024, ++ui) {
            if (ui == cslot) { ph0_experts(F, conv_from, 1 << 30); conv_done = true; }
            const int Up = U - 512, bh = Up >> 4, qb = Up & 15, b = bh >> 2, h = bh & 3;
            const bf16* Pb = P1 + (size_t)b * NTOK * NP1;
            attn::unit<1, 1>(P1 + (size_t)(b * NTOK + NCTX + qb * 256) * NP1 + 512 + (2 * h) * 64, Pb + 1024 + (2 * h) * 64, nullptr, Pb + 1536 + h * 128, nullptr, 0, F.lds_c(),
                             stash, 0.f, nullptr);
        }
        for (U = Ud0; U < 768; U += 1024, ++ui) {
            if (ui == cslot) { ph0_experts(F, conv_from, 1 << 30); conv_done = true; }
            const int Up = U - 512, bh = Up >> 4, qb = Up & 15, b = bh >> 2, h = bh & 3;
            const bf16* Pb = P1 + (size_t)b * NTOK * NP1;
            attn::unit<1, 2>(P1 + (size_t)(b * NTOK + NCTX + qb * 256) * NP1 + 512 + (2 * h + 1) * 64, Pb + 1024 + (2 * h + 1) * 64, nullptr, Pb + 1536 + h * 128,
                             (bf16*)(ws + WS_MIX) + (size_t)(b * SEQ + qb * 256) * DM + 512 + h * 128, DM, F.lds_c(), stash, lam, F.P.in[17]);
        }
        if (!conv_done) ph0_experts(F, conv_from, 1 << 30);
    } SEAM_SKIP1(P_ATTN);
    if (IN(P_OUT)) {
        pg8::Gemm g{(const bf16*)(ws + WS_MIX), (const bf16*)(ws + WS_WOUT), 1024, 1024, 1024}; pg8::StaticOrder S; S.init(MLAT, DM, F.G, (int)blockIdx.x);
        EpiOut E{F.P.in[0], (const float*)(ws + WS_MOD), (bf16*)(ws + WS_X1)};
        pg8::gemm_phase(F.lds, g, S, E);
    } SEAM(P_OUT);
    if (IN(P_H2)) { ph_route3(F); } SEAM_SKIP2(P_H2);
    if (IN(P_SLOTS)) { ph8_slots(F); } SEAM(P_SLOTS);
    if (IN(P_EXP1)) {
        const int nu = (int)xb_ld(F.ctl + CW_NUNIT), nfu = (int)xb_ld(F.ctl + CW_NFULL); LAS int* uc = (LAS int*)(F.lds + UCACHE_OFF);
        const int nmine = exp_units_to_lds<2>(uc, (const int*)(ws + WS_UT), nu, nfu, F.G, F.vcu);
        pg8::Gemm g{(const bf16*)(ws + WS_H2), (const bf16*)(ws + WS_W13), 1024, 1024, 1024};
        ExpSched<2, true> S{uc, nmine, (const int*)(ws + WS_SLOTTOK)};
        EpiAct E{(bf16*)(ws + WS_ACT), (const float*)(ws + WS_SLOTW)};
        pg8::gemm_phase(F.lds, g, S, E);
    } SEAM(P_EXP1);
    if (IN(P_EXP2)) {
        const int nu = (int)xb_ld(F.ctl + CW_NUNIT), nfu = (int)xb_ld(F.ctl + CW_NFULL); LAS int* uc = (LAS int*)(F.lds + UCACHE_OFF);
        const int nmine = exp_units_to_lds<4>(uc, (const int*)(ws + WS_UT), nu, nfu, F.G, F.vcu);
        pg8::Gemm g{(const bf16*)(ws + WS_ACT), (const bf16*)(ws + WS_W2), 256, 256, 256};
        ExpSched<4, false> S{uc, nmine, nullptr};
        EpiY E{(unsigned char*)(ws + WS_Y)};
        pg8::gemm_phase(F.lds, g, S, E);
    } SEAM(P_EXP2);
    if (IN(P_COMB)) { ph11_combine(F); }
#undef IN
#undef SEAM
}

static int g_grid = 0;
static int mk_setup() {
    if (g_grid) return g_grid;
    int dev = 0, cus = 0;
    if (hipGetDevice(&dev) != hipSuccess || hipDeviceGetAttribute(&cus, hipDeviceAttributeMultiprocessorCount, dev) != hipSuccess) { fprintf(stderr, "kernel_launch: device query failed\n"); g_grid = -1; return -1; }
    if (hipFuncSetAttribute((const void*)mk_fwd, hipFuncAttributeMaxDynamicSharedMemorySize, LDS_BYTES) != hipSuccess) { fprintf(stderr, "kernel_launch: hipFuncSetAttribute failed\n"); g_grid = -1; return -1; }
    int per_cu = 0;
    if (hipOccupancyMaxActiveBlocksPerMultiprocessor(&per_cu, (const void*)mk_fwd, NWAVES * 64, LDS_BYTES) != hipSuccess || per_cu < 1) { fprintf(stderr, "kernel_launch: occupancy query says %d blocks/CU\n", per_cu); }
    (void)hipGetLastError();
    if (cus != 256) { fprintf(stderr, "kernel_launch: this build's work split assumes a 256-CU device (found %d CUs); nothing launched\n", cus); g_grid = -1; return -1; }
    g_grid = cus;
    return g_grid;
}
static void mk_run(const Ptrs& P, int lo, int hi, int li, hipStream_t stream) {
    Args a{}; a.P = P; a.ph_lo = lo; a.ph_hi = hi; a.li = li; a.pad = 0;
    hipLaunchKernelGGL(mk_fwd, dim3(g_grid), dim3(NWAVES * 64), LDS_BYTES, stream, a);
}
extern "C" void kernel_launch(void* const* d_in, const int* in_sizes, int n_in, void* d_out, int out_size, void* d_ws, size_t ws_size, hipStream_t stream) {
    if (n_in != 28 || out_size != MLAT * DM || ws_size < WS_END) { fprintf(stderr, "kernel_launch: unexpected shapes n_in %d out %d ws %zu\n", n_in, out_size, ws_size); return; }
    if (mk_setup() <= 0) return;
    Ptrs P{}; for (int i = 0; i < 28; ++i) P.in[i] = (const float*)d_in[i]; P.out = (float*)d_out; P.ws = (unsigned char*)d_ws;
    (void)hipMemsetAsync((char*)d_ws + WS_CTL, 0, 1 * MiB, stream);
    int li = 0;
#define FAST(lo, hi) mk_run(P, lo, hi, li++, stream)
    FAST(P_PREP, P_COMB + 1);
#undef FAST
}
```

```cpp
constexpr bool defs_probe = false;
#include <hip/hip_runtime.h>
#include <cstdio>
#include <cstdint>

constexpr int NB = 4, SEQ = 4096, NCTX = 256, NTOK = SEQ + NCTX, DM = 1024;
constexpr int MALL = NB * NTOK;
constexpr int MLAT = NB * SEQ;
constexpr int IN_COLS = 1952, NP1 = 2048;
constexpr int NEXP = 256, TOPK = 8, EFF = 256;
constexpr int NSLOT = MLAT * TOPK + MLAT;
constexpr float EPS = 1e-6f;
constexpr float LAM_INIT = 0.2f;

typedef unsigned short bf16;
__device__ __forceinline__ unsigned f2bf(float f) { unsigned u = __builtin_bit_cast(unsigned, f); return (u + 0x7fffu + ((u >> 16) & 1u)) >> 16; }
__device__ __forceinline__ float bf2f(bf16 h) { return __builtin_bit_cast(float, (unsigned)h << 16); }

constexpr size_t MiB = 1u << 20;
constexpr size_t WS_CTL = 0;
constexpr size_t WS_MOD = 3 * MiB;
constexpr size_t WS_TAB = 3 * MiB + 512 * 1024;
constexpr size_t WS_X1 = 402 * MiB;
constexpr size_t WS_SSQ = 466 * MiB;
constexpr size_t WS_EIDX = 467 * MiB;
constexpr size_t WS_EW = WS_EIDX + 512 * 1024;
constexpr size_t WS_ERANK = 468 * MiB;
constexpr size_t WS_SLOTOF = WS_ERANK + 512 * 1024;
constexpr size_t WS_SLOTTOK = 469 * MiB;
constexpr size_t WS_SLOTW = 470 * MiB;
constexpr size_t WS_OFF = 471 * MiB;
constexpr size_t WS_XN = 472 * MiB;
constexpr size_t WS_P1 = 506 * MiB;
constexpr size_t WS_QM = 574 * MiB;
constexpr size_t WS_KVM = 600 * MiB;
constexpr size_t WS_MIX = 634 * MiB;
constexpr size_t WS_OS = 666 * MiB;
constexpr size_t WS_TMP = 730 * MiB;
constexpr size_t WS_H2 = 472 * MiB;
constexpr size_t WS_H2F = 504 * MiB;
constexpr size_t WS_LOG = 568 * MiB;
constexpr size_t WS_ACT = 584 * MiB;
constexpr size_t WS_Y = 656 * MiB;
constexpr size_t WS_END = 944 * MiB;
constexpr int CW_COUNT = 1024;

__host__ __device__ __forceinline__ int perm32_log(int p) { return 16 * ((p >> 2) & 1) + 4 * (p >> 3) + (p & 3); }
__host__ __device__ __forceinline__ int perm64_log(int p) { return 32 * ((p >> 2) & 1) + 16 * (p >> 5) + 4 * ((p >> 3) & 3) + (p & 3); }
__host__ __device__ __forceinline__ int p1_logical(int p) {
    if (p < 384) return p;
    if (p < 416) return 384 + perm32_log(p - 384);
    if (p < 512) return -1;
    if (p < 1024) { int q = p - 512; return 416 + (q & ~63) + perm64_log(q & 63); }
    if (p < 1536) { int q = p - 1024; return 928 + (q & ~63) + perm64_log(q & 63); }
    return 1440 + (p - 1536);
}
__host__ __device__ __forceinline__ int qm_logical(int p) { int h = p / 96, r = p % 96; return h * 96 + (r < 64 ? r : 64 + perm32_log(r - 64)); }

struct Ptrs {
    const float* in[28]; float* out; unsigned char* ws;
};


#define GAS __attribute__((address_space(1)))
#define LAS __attribute__((address_space(3)))
typedef short bf16x8 __attribute__((ext_vector_type(8)));
typedef short s16x4 __attribute__((ext_vector_type(4)));
typedef float f32x4 __attribute__((ext_vector_type(4)));
typedef float f32x2 __attribute__((ext_vector_type(2)));
typedef float f32x16 __attribute__((ext_vector_type(16)));
typedef float f32x8 __attribute__((ext_vector_type(8)));
typedef unsigned u32x4 __attribute__((ext_vector_type(4)));
typedef unsigned u32x2 __attribute__((ext_vector_type(2)));
#define RLX_AGENT __ATOMIC_RELAXED, __HIP_MEMORY_SCOPE_AGENT
#define LDS_WAIT() asm volatile("s_waitcnt lgkmcnt(0)" ::: "memory")
#define VM_WAIT() asm volatile("s_waitcnt vmcnt(0)" ::: "memory")

constexpr size_t WS_MODP = 1 * MiB;
constexpr size_t WS_WIN = 4 * MiB;
constexpr size_t WS_WUP = 8 * MiB;
constexpr size_t WS_WOUT = 10 * MiB;
constexpr size_t WS_WR = 12 * MiB;
constexpr size_t WS_WCTX = 13 * MiB;
constexpr size_t WS_W13 = 16 * MiB;
constexpr size_t WS_W2 = 273 * MiB;
constexpr size_t WS_UT = WS_OFF + 4096;
static_assert(WS_W2 + (size_t)257 * 1024 * 256 * 2 <= WS_X1, "ws map");
constexpr size_t WS_LOGP = WS_Y;
constexpr int CW_NUNIT = 2048;
constexpr int CW_NFULL = 2049;
constexpr int CW_BAR = 4096;

__device__ __forceinline__ unsigned cvt_pk_bf16(float lo, float hi) { unsigned r; asm volatile("v_cvt_pk_bf16_f32 %0, %1, %2" : "=v"(r) : "v"(lo), "v"(hi)); return r; }
__device__ __forceinline__ unsigned pk2(float lo, float hi) { return f2bf(lo) | (f2bf(hi) << 16); }
__device__ __forceinline__ u32x4 pack8(f32x4 a, f32x4 b) { u32x4 w; w.x = cvt_pk_bf16(a[0], a[1]); w.y = cvt_pk_bf16(a[2], a[3]); w.z = cvt_pk_bf16(b[0], b[1]); w.w = cvt_pk_bf16(b[2], b[3]); return w; }
__device__ __forceinline__ float bflo(unsigned w) { return __builtin_bit_cast(float, w << 16); }
__device__ __forceinline__ float bfhi(unsigned w) { return __builtin_bit_cast(float, w & 0xffff0000u); }
__device__ __forceinline__ float wave_sum(float v) {
#pragma unroll
    for (int o = 1; o < 64; o <<= 1) v += __shfl_xor(v, o);
    return v;
}

namespace pg8 {
constexpr int BM = 256, BK = 64, HALF = 128, HTB = HALF * BK * 2, STAGE_BYTES = 8 * HTB;
__host__ __device__ __forceinline__ int lds_byte(int r, int c) { const int st = (r >> 4) * 2 + (c >> 5), rr = r & 15, cc = c & 31, ob = rr * 64 + cc * 2; return st * 1024 + (ob ^ (((ob >> 9) & 1) << 5)); }
__host__ __device__ __forceinline__ void stage_rc(int b, int& R, int& C) { const int st = b / 1024, sb = b % 1024, swz = sb ^ (((sb >> 9) & 1) << 5); R = (st >> 1) * 16 + swz / 64; C = (st & 1) * 32 + (swz % 64) / 2; }
__host__ __device__ __forceinline__ int perm32(int rho) { const int n = rho >> 4, i = rho & 15; return 8 * (i >> 2) + 4 * n + (i & 3); }

struct Unit { int pm, pn, r0, nv, k0; };
struct Gemm { const bf16* A; const bf16* Bt; int lda, ldb, K; };

struct StaticOrder {
    int nM, nN, nwg, G, c;
    __device__ void init(int M, int N, int G_, int c_) { nM = M / BM; nN = N / BM; nwg = nM * nN; G = G_; c = c_; }
    __device__ bool next(int i, Unit& u) const {
        const long L = (long)i * G + c; if (L >= nwg) return false;
        int wgid = (int)L; { const int q = nwg / 8, r = nwg % 8, xcd = wgid % 8, off = wgid / 8; wgid = (xcd < r ? xcd * (q + 1) : r * (q + 1) + (xcd - r) * q) + off; }
        const int nig = 8 * nN, gid = wgid / nig, fm = gid * 8, gsz = (nM - fm) < 8 ? (nM - fm) : 8;
        u.pm = fm + ((wgid % nig) % gsz); u.pn = (wgid % nig) / gsz; u.r0 = u.pm * BM; u.nv = BM; u.k0 = 0; return true;
    }
    __device__ __forceinline__ int a_row(const Unit& u, int r) const { return u.pm * BM + r; }
};

template <class Epi, class Sched>
__device__ __forceinline__ void gemm_phase(LAS unsigned char* lds, const Gemm g, const Sched& S, const Epi& E) {
    const int tid = threadIdx.x, wid = __builtin_amdgcn_readfirstlane(tid >> 6), lane = tid & 63, wr = wid >> 2, wc = wid & 3, fr = lane & 15, fq = lane >> 4;
    int K = g.K; asm volatile("" : "+s"(K));
    const int nt = K / BK;
    int RA[2], CA[2]; unsigned voffB[2];
#pragma unroll
    for (int i = 0; i < 2; ++i) { int R, C; stage_rc(tid * 16 + i * 8192, R, C); RA[i] = R; CA[i] = C; const int Rb = Epi::PERM ? ((R & ~31) + perm32(R & 31)) : R; voffB[i] = (unsigned)(Rb * g.ldb + C) * 2u; }
    const size_t kstep = (size_t)(BK * 2);
    const size_t hstepB = (size_t)HALF * g.ldb * 2, tstepB = 2 * hstepB;
    const unsigned ldsw = (unsigned)wid * 1024u;
    const int aoff = lds_byte(wr * 64 + fr, fq * 8), boff = lds_byte(wc * 32 + fr, fq * 8);
#define PG8_SA(b, h) (((b) * 2 + (h)) * HTB)
#define PG8_SB(b, h) ((4 + (b) * 2 + (h)) * HTB)
#define PG8_STAGE(bufoff, gbase, voff) do { _Pragma("unroll") for (int _i = 0; _i < 2; ++_i) \
        __builtin_amdgcn_global_load_lds((const unsigned*)((const char*)(gbase) + (voff)[_i]), (LAS unsigned*)(lds + (bufoff) + ldsw + _i * 8192), 16, 0, 0); } while (0)
#define PG8_LDA(dst, b, h) do { _Pragma("unroll") for (int m = 0; m < 4; ++m) _Pragma("unroll") for (int k = 0; k < 2; ++k) dst[m][k] = *(const LAS bf16x8*)(lds + PG8_SA(b, h) + aoff + m * 2048 + k * 1024); } while (0)
#define PG8_LDB(dst, b, h) do { _Pragma("unroll") for (int n = 0; n < 2; ++n) _Pragma("unroll") for (int k = 0; k < 2; ++k) dst[n][k] = *(const LAS bf16x8*)(lds + PG8_SB(b, h) + boff + n * 2048 + k * 1024); } while (0)
#define PG8_MMA(ai, bj, At, Bt) do { __builtin_amdgcn_s_setprio(1); _Pragma("unroll") for (int m = 0; m < 4; ++m) _Pragma("unroll") for (int n = 0; n < 2; ++n) _Pragma("unroll") for (int k = 0; k < 2; ++k) \
        acc[ai][bj][m][n] = __builtin_amdgcn_mfma_f32_16x16x32_bf16(Bt[n][k], At[m][k], acc[ai][bj][m][n], 0, 0, 0); __builtin_amdgcn_s_setprio(0); } while (0)
#define PG8_WAIT_V(n) asm volatile("s_waitcnt vmcnt(" #n ")" ::: "memory")
#define PG8_WAIT_L(n) asm volatile("s_waitcnt lgkmcnt(" #n ")" ::: "memory")
#define PG8_BAR __builtin_amdgcn_s_barrier()
#define PG8_SCHED __builtin_amdgcn_sched_barrier(0)
#define PG8_AOFFS(dst, u) do { _Pragma("unroll") for (int _h = 0; _h < 2; ++_h) _Pragma("unroll") for (int _i = 0; _i < 2; ++_i) \
        dst[_h][_i] = (unsigned)(((size_t)S.a_row(u, _h * HALF + RA[_i]) * (size_t)g.lda + (size_t)(CA[_i] + (u).k0)) * 2u); } while (0)
    Unit cur, nxt; int ui = 0;
    if (!S.next(0, cur)) return;
    f32x4 acc[2][2][4][2];
#pragma unroll
    for (int a = 0; a < 2; ++a)
#pragma unroll
        for (int b = 0; b < 2; ++b)
#pragma unroll
            for (int m = 0; m < 4; ++m)
#pragma unroll
                for (int n = 0; n < 2; ++n) acc[a][b][m][n] = (f32x4){0.f, 0.f, 0.f, 0.f};
    bf16x8 At[4][2], B0[2][2], B1[2][2];
    unsigned vA[2][2], vN[2][2];
    PG8_AOFFS(vA, cur);
    const char* Ab = (const char*)g.A; const char* cB = (const char*)g.Bt + (size_t)cur.pn * tstepB + (size_t)cur.k0 * 2;
    PG8_STAGE(PG8_SB(0, 0), cB, voffB); PG8_STAGE(PG8_SB(0, 1), cB + hstepB, voffB); PG8_STAGE(PG8_SA(0, 0), Ab, vA[0]); PG8_STAGE(PG8_SA(0, 1), Ab, vA[1]);
    if (wr == 1) PG8_BAR;
    PG8_WAIT_V(2); PG8_BAR;
    PG8_STAGE(PG8_SB(1, 0), cB + kstep, voffB); PG8_STAGE(PG8_SA(1, 0), Ab + kstep, vA[0]); PG8_STAGE(PG8_SB(1, 1), cB + hstepB + kstep, voffB);
    PG8_WAIT_V(6); PG8_BAR;
    for (;;) {
        const bool has_next = S.next(ui + 1, nxt);
        const char* nB = has_next ? (const char*)g.Bt + (size_t)nxt.pn * tstepB + (size_t)nxt.k0 * 2 : cB;
        if (has_next) { PG8_AOFFS(vN, nxt); } else { vN[0][0] = vA[0][0]; vN[0][1] = vA[0][1]; vN[1][0] = vA[1][0]; vN[1][1] = vA[1][1]; }
        for (int t = 0; t < nt; t += 2) {
            const bool last = (t == nt - 2); const bool full = cur.nv > HALF;
            const char* a1 = Ab + (size_t)(t + 1) * kstep;
            const char* a2 = Ab + (last ? (size_t)0 : (size_t)(t + 2) * kstep); const char* b2 = last ? nB : cB + (size_t)(t + 2) * kstep;
            const char* a3 = a2 + kstep; const char* b3 = b2 + kstep;
            unsigned w0[2], w1[2];
            w0[0] = last ? vN[0][0] : vA[0][0]; w0[1] = last ? vN[0][1] : vA[0][1]; w1[0] = last ? vN[1][0] : vA[1][0]; w1[1] = last ? vN[1][1] : vA[1][1];
            PG8_LDB(B0, 0, 0); PG8_LDB(B1, 0, 1); PG8_SCHED; PG8_LDA(At, 0, 0); PG8_STAGE(PG8_SA(1, 1), a1, vA[1]);
            PG8_WAIT_V(8); PG8_WAIT_L(0); PG8_BAR; PG8_MMA(0, 0, At, B0); PG8_MMA(0, 1, At, B1); PG8_BAR; PG8_SCHED;
            PG8_LDA(At, 0, 1); PG8_STAGE(PG8_SB(0, 0), b2, voffB); PG8_STAGE(PG8_SB(0, 1), b2 + hstepB, voffB); PG8_STAGE(PG8_SA(0, 0), a2, w0);
            PG8_WAIT_V(8); PG8_WAIT_L(0); PG8_BAR; if (full) { PG8_MMA(1, 0, At, B0); PG8_MMA(1, 1, At, B1); } PG8_BAR; PG8_SCHED;
            PG8_LDB(B0, 1, 0); PG8_LDB(B1, 1, 1); PG8_SCHED; PG8_LDA(At, 1, 0); PG8_STAGE(PG8_SA(0, 1), a2, w1);
            PG8_WAIT_V(8); PG8_WAIT_L(0); PG8_BAR; PG8_MMA(0, 0, At, B0); PG8_MMA(0, 1, At, B1); PG8_BAR; PG8_SCHED;
            PG8_LDA(At, 1, 1); PG8_STAGE(PG8_SB(1, 0), b3, voffB); PG8_STAGE(PG8_SB(1, 1), b3 + hstepB, voffB); PG8_STAGE(PG8_SA(1, 0), a3, w0);
            PG8_WAIT_V(8); PG8_WAIT_L(0); PG8_BAR; if (full) { PG8_MMA(1, 0, At, B0); PG8_MMA(1, 1, At, B1); } PG8_BAR; PG8_SCHED;
        }
        if (wr == 0) PG8_BAR;
        E(acc, cur, wr, wc, fr, fq);
        if (!has_next) break;
#pragma unroll
        for (int a = 0; a < 2; ++a)
#pragma unroll
            for (int b = 0; b < 2; ++b)
#pragma unroll
                for (int m = 0; m < 4; ++m)
#pragma unroll
                    for (int n = 0; n < 2; ++n) acc[a][b][m][n] = (f32x4){0.f, 0.f, 0.f, 0.f};
        cur = nxt; cB = nB; ++ui;
        vA[0][0] = vN[0][0]; vA[0][1] = vN[0][1]; vA[1][0] = vN[1][0]; vA[1][1] = vN[1][1];
        if (wr == 1) PG8_BAR;
    }
    PG8_WAIT_V(0);
    PG8_BAR;
#undef PG8_SA
#undef PG8_SB
#undef PG8_STAGE
#undef PG8_LDA
#undef PG8_LDB
#undef PG8_MMA
#undef PG8_WAIT_V
#undef PG8_WAIT_L
#undef PG8_BAR
#undef PG8_SCHED
#undef PG8_AOFFS
}
}

using pg8::Unit;
typedef f32x4 Acc[2][2][4][2];

struct EpiInProj {
    static constexpr bool PERM = true;
    bf16* P1; float* SSQ; const float2* TD; const float2* TM;
    __device__ __forceinline__ void operator()(const Acc& acc, const Unit& u, int wr, int wc, int fr, int fq) const {
        const int pm = u.pm, pn = u.pn, jt = pm % 17; const bool lat = jt > 0;
        const int row0 = pm * 256 + wr * 64 + fr, col0 = pn * 256 + wc * 32 + 8 * fq;
        if (pn == 0 || pn >= 6 || (pn == 1)) {
#pragma unroll
            for (int ai = 0; ai < 2; ++ai)
#pragma unroll
                for (int m = 0; m < 4; ++m) {
                    const int r = row0 + ai * 128 + m * 16; bf16* rowp = P1 + (size_t)r * NP1 + col0;
                    *(u32x4*)(rowp) = pack8(acc[ai][0][m][0], acc[ai][0][m][1]);
                    if (pn != 1) *(u32x4*)(rowp + 128) = pack8(acc[ai][1][m][0], acc[ai][1][m][1]);
                    if (pn <= 1) {
                        float s = 0.f;
#pragma unroll
                        for (int bj = 0; bj < 2; ++bj) { if (pn == 1 && bj == 1) break;
#pragma unroll
                            for (int n = 0; n < 2; ++n) { const f32x4 x = acc[ai][bj][m][n]; s += (x[0] * x[0] + x[1] * x[1]) + (x[2] * x[2] + x[3] * x[3]); } }
                        s += __shfl_xor(s, 16); s += __shfl_xor(s, 32);
                        if (fq == 0) SSQ[(size_t)r * 8 + pn * 4 + wc] = s;
                    }
                    if (pn == 1 && wc == 0) {
                        f32x4 x1 = acc[ai][1][m][0], x2 = acc[ai][1][m][1], o1 = x1, o2 = x2;
                        if (lat) { const int gr = (jt - 1) * 4 + 2 * ai + wr, gc = 16 * m + fr;
                            const float2* tp = TM + (fq < 2 ? gr * 8 + 4 * fq : gc * 8 + 4 * (fq - 2));
                            const f32x4 t0 = *(const f32x4*)tp, t1 = *(const f32x4*)(tp + 2);
                            const f32x4 cs = {t0[0], t0[2], t1[0], t1[2]}, sn = {t0[1], t0[3], t1[1], t1[3]};
                            o1 = x1 * cs - x2 * sn; o2 = x1 * sn + x2 * cs; }
                        *(u32x4*)(rowp + 128) = pack8(o1, o2);
                    }
                }
        } else {
            const int g = wc & 1; const float qs = pn < 4 ? 0.125f * 1.4426950408889634f : 1.f;
#pragma unroll
            for (int ai = 0; ai < 2; ++ai) {
                const int gr = (jt - 1) * 4 + 2 * ai + wr;
#pragma unroll
                for (int m = 0; m < 4; ++m) {
                    const int r = row0 + ai * 128 + m * 16; bf16* rowp = P1 + (size_t)r * NP1 + col0;
                    f32x4 cs = {1.f, 1.f, 1.f, 1.f}, sn = {0.f, 0.f, 0.f, 0.f};
                    if (lat) { const int gc = 16 * m + fr; const float2* tp = TD + (g == 0 ? gr : gc) * 16 + 4 * fq;
                        const f32x4 t0 = *(const f32x4*)tp, t1 = *(const f32x4*)(tp + 2);
                        cs = (f32x4){t0[0], t0[2], t1[0], t1[2]}; sn = (f32x4){t0[1], t0[3], t1[1], t1[3]}; }
#pragma unroll
                    for (int bj = 0; bj < 2; ++bj) { const f32x4 x1 = acc[ai][bj][m][0] * qs, x2 = acc[ai][bj][m][1] * qs;
                        *(u32x4*)(rowp + bj * 128) = pack8(x1 * cs - x2 * sn, x1 * sn + x2 * cs); }
                }
            }
        }
    }
};

struct EpiUp {
    static constexpr bool PERM = true;
    bf16* QM; bf16* KVM; const float* SSQ; const float2* TM;
    __device__ __forceinline__ void operator()(const Acc& acc, const Unit& u, int wr, int wc, int fr, int fq) const {
        const int pm = u.pm, pn = u.pn, jt = pm % 17; const bool lat = jt > 0, isq = pn < 3;
        const int row0 = pm * 256 + wr * 64 + fr, col0 = pn * 256 + wc * 32 + 8 * fq;
#pragma unroll
        for (int ai = 0; ai < 2; ++ai)
#pragma unroll
            for (int m = 0; m < 4; ++m) {
                const int r = row0 + ai * 128 + m * 16;
                const f32x4 sq = *(const f32x4*)(SSQ + (size_t)r * 8 + (isq ? 0 : 4));
                const float rs = rsqrtf(((sq[0] + sq[1]) + (sq[2] + sq[3])) * (isq ? 1.f / 256.f : 1.f / 128.f) + EPS) * (isq ? 0.10206207261596575f * 1.4426950408889634f : 1.f);
#pragma unroll
                for (int bj = 0; bj < 2; ++bj) {
                    f32x4 x1 = acc[ai][bj][m][0] * rs, x2 = acc[ai][bj][m][1] * rs;
                    if (isq) {
                        const int G = 8 * pn + 4 * bj + wc;
                        if (lat && (G % 3) == 2) { const int gr = (jt - 1) * 4 + 2 * ai + wr, gc = 16 * m + fr;
                            const float2* tp = TM + (fq < 2 ? gr * 8 + 4 * fq : gc * 8 + 4 * (fq - 2));
                            const f32x4 t0 = *(const f32x4*)tp, t1 = *(const f32x4*)(tp + 2);
                            const f32x4 cs = {t0[0], t0[2], t1[0], t1[2]}, sn = {t0[1], t0[3], t1[1], t1[3]};
                            const f32x4 o1 = x1 * cs - x2 * sn, o2 = x1 * sn + x2 * cs; x1 = o1; x2 = o2; }
                        *(u32x4*)(QM + (size_t)r * 768 + col0 + bj * 128) = pack8(x1, x2);
                    } else *(u32x4*)(KVM + (size_t)r * 1024 + (col0 - 768) + bj * 128) = pack8(x1, x2);
                }
            }
    }
};

struct EpiOut {
    static constexpr bool PERM = true;
    const float* x; const float* MOD; bf16* X1;
    __device__ __forceinline__ void operator()(const Acc& acc, const Unit& u, int wr, int wc, int fr, int fq) const {
        const int b = u.pm / 16; const float* gt = MOD + b * 6144 + 2048;
        const int row0 = u.pm * 256 + wr * 64 + fr, col0 = u.pn * 256 + wc * 32 + 8 * fq;
        f32x4 gv[2][2];
#pragma unroll
        for (int bj = 0; bj < 2; ++bj)
#pragma unroll
            for (int n = 0; n < 2; ++n) gv[bj][n] = *(const f32x4*)(gt + col0 + bj * 128 + n * 4);
#pragma unroll
        for (int ai = 0; ai < 2; ++ai)
#pragma unroll
            for (int m = 0; m < 4; ++m) { const size_t off = (size_t)(row0 + ai * 128 + m * 16) * DM + col0;
#pragma unroll
                for (int bj = 0; bj < 2; ++bj) { const f32x4 x0 = *(const f32x4*)(x + off + bj * 128), x1 = *(const f32x4*)(x + off + bj * 128 + 4);
                    *(u32x4*)(X1 + off + bj * 128) = pack8(x0 + gv[bj][0] * acc[ai][bj][m][0], x1 + gv[bj][1] * acc[ai][bj][m][1]); } }
    }
};
struct EpiF32 {
    static constexpr bool PERM = false;
    float* O; int ldc;
    __device__ __forceinline__ void operator()(const Acc& acc, const Unit& u, int wr, int wc, int fr, int fq) const {
        const int row0 = u.pm * 256 + wr * 64 + fr, col0 = u.pn * 256 + wc * 32 + 4 * fq;
#pragma unroll
        for (int ai = 0; ai < 2; ++ai)
#pragma unroll
            for (int m = 0; m < 4; ++m) { const size_t off = (size_t)(row0 + ai * 128 + m * 16) * ldc + col0;
#pragma unroll
                for (int bj = 0; bj < 2; ++bj)
#pragma unroll
                    for (int n = 0; n < 2; ++n) *(f32x4*)(O + off + bj * 128 + n * 16) = acc[ai][bj][m][n]; }
    }
};
struct EpiAct {
    static constexpr bool PERM = true;
    bf16* ACT; const float* SW;
    __device__ __forceinline__ void operator()(const Acc& acc, const Unit& u, int wr, int wc, int fr, int fq) const {
        const int half = u.pn & 1, colb = half * 128 + wc * 32 + 8 * fq;
#pragma unroll
        for (int ai = 0; ai < 2; ++ai)
#pragma unroll
            for (int m = 0; m < 4; ++m) { const int tr = ai * 128 + wr * 64 + m * 16 + fr;
                f32x4 a[2];
#pragma unroll
                for (int n = 0; n < 2; ++n) { const f32x4 gt = acc[ai][0][m][n], up = acc[ai][1][m][n];
#pragma unroll
                    for (int e = 0; e < 4; ++e) a[n][e] = gt[e] * __builtin_amdgcn_rcpf(1.f + __expf(-gt[e])) * up[e]; }
                if (tr < u.nv) { const float w = SW[u.r0 + tr]; *(u32x4*)(ACT + (size_t)(u.r0 + tr) * EFF + colb) = pack8(a[0] * w, a[1] * w); } }
    }
};
constexpr float YSCALE = 32.f;
__device__ __forceinline__ unsigned pk4_fp8(f32x4 v) { int w = 0; w = __builtin_amdgcn_cvt_pk_fp8_f32(v[0], v[1], w, false); w = __builtin_amdgcn_cvt_pk_fp8_f32(v[2], v[3], w, true); return (unsigned)w; }
struct EpiY {
    static constexpr bool PERM = true;
    unsigned char* Y;
    __device__ __forceinline__ void operator()(const Acc& acc, const Unit& u, int wr, int wc, int fr, int fq) const {
        const int colb = (u.pn & 3) * 256 + wc * 64 + 16 * fq;
#pragma unroll
        for (int ai = 0; ai < 2; ++ai)
#pragma unroll
            for (int m = 0; m < 4; ++m) { const int tr = ai * 128 + wr * 64 + m * 16 + fr;
                if (tr < u.nv) { u32x4 w; w.x = pk4_fp8(acc[ai][0][m][0] * YSCALE); w.y = pk4_fp8(acc[ai][0][m][1] * YSCALE); w.z = pk4_fp8(acc[ai][1][m][0] * YSCALE); w.w = pk4_fp8(acc[ai][1][m][1] * YSCALE);
                    *(u32x4*)(Y + (size_t)(u.r0 + tr) * DM + colb) = w; } }
    }
};

template <int SUB, bool GATHER> struct ExpSched {
    const LAS int* uc; int nmine; const int* slot_tok;
    __device__ bool next(int i, Unit& u) const {
        if (i >= nmine) return false;
        const int e = __builtin_amdgcn_readfirstlane(uc[i * 4 + 0]), r0 = __builtin_amdgcn_readfirstlane(uc[i * 4 + 1]);
        const int nv = __builtin_amdgcn_readfirstlane(uc[i * 4 + 2]), sub = __builtin_amdgcn_readfirstlane(uc[i * 4 + 3]);
        u.pm = 0; u.pn = e * SUB + sub; u.r0 = r0; u.nv = nv; u.k0 = 0; return true;
    }
    __device__ __forceinline__ int a_row(const Unit& u, int r) const {
        if (GATHER) return r < u.nv ? slot_tok[u.r0 + r] : 0;
        const int s = u.r0 + r; return s < NSLOT ? s : NSLOT - 1;
    }
};
template <int SUB> __device__ __forceinline__ int exp_units_to_lds(LAS int* uc, const int* ut, int nunit, int nfull, int G, int c) {
    const int NF = nfull * SUB, NH = (nunit - nfull) * SUB, cr = G - 1 - c, nlight = (NF % G) ? G - NF % G : 0;
    const int mf = c < NF ? (NF - 1 - c) / G + 1 : 0;
    const int h0 = (cr < nlight && cr < NH) ? 1 : 0;
    const int NH2 = NH > nlight ? NH - nlight : 0, mh = cr < NH2 ? (NH2 - 1 - cr) / G + 1 : 0;
    const int t = threadIdx.x;
    if (t < mf + h0 + mh && t < 64) { const int L = t < mf ? t * G + c : (t < mf + h0 ? NF + cr : NF + nlight + (t - mf - h0) * G + cr); const int cu = L / SUB;
        uc[t * 4 + 0] = ut[cu * 4 + 0]; uc[t * 4 + 1] = ut[cu * 4 + 1]; uc[t * 4 + 2] = ut[cu * 4 + 2]; uc[t * 4 + 3] = L % SUB; }
    __syncthreads();
    return mf + h0 + mh < 64 ? mf + h0 + mh : 64;
}
struct LatOrder : pg8::StaticOrder {
    __device__ bool next(int i, Unit& u) const { if (!pg8::StaticOrder::next(i, u)) return false; u.pm += (u.pm >> 4) + 1; u.r0 = u.pm * 256; return true; }
};
struct RouterOrder {
    int G, c;
    __device__ bool next(int i, Unit& u) const { const int L = i * G + c; if (L >= 256) return false; u.pm = L >> 2; u.pn = 0; u.r0 = u.pm * 256; u.nv = 256; u.k0 = (L & 3) * 256; return true; }
    __device__ __forceinline__ int a_row(const Unit& u, int r) const { return u.pm * 256 + r; }
};
struct UpOrder {
    int G, c;
    __device__ bool next(int i, Unit& u) const { const int L = i * G + c; if (L >= 68 * 7) return false; u.pm = L / 7; u.pn = L % 7; u.r0 = u.pm * 256; u.nv = 256; u.k0 = u.pn < 3 ? 0 : 128; return true; }
    __device__ __forceinline__ int a_row(const Unit& u, int r) const { return u.pm * 256 + r; }
};
struct EpiLogP {
    static constexpr bool PERM = false;
    float* O;
    __device__ __forceinline__ void operator()(const Acc& acc, const Unit& u, int wr, int wc, int fr, int fq) const {
        float* base = O + (size_t)(u.k0 >> 8) * MLAT * NEXP;
        const int row0 = u.pm * 256 + wr * 64 + fr, col0 = wc * 32 + 4 * fq;
#pragma unroll
        for (int ai = 0; ai < 2; ++ai)
#pragma unroll
            for (int m = 0; m < 4; ++m) { const size_t off = (size_t)(row0 + ai * 128 + m * 16) * NEXP + col0;
#pragma unroll
                for (int bj = 0; bj < 2; ++bj)
#pragma unroll
                    for (int n = 0; n < 2; ++n) *(f32x4*)(base + off + bj * 128 + n * 16) = acc[ai][bj][m][n]; }
    }
};

namespace attn {
#define SBAR() __builtin_amdgcn_sched_barrier(0)
constexpr float THR = 8.f;
template <int MODE> struct Cfg;
template <> struct Cfg<0> { static constexpr int DQK = 96, DV = 64, LDQ = 768, LDK0 = 1024, LDK1 = 2048, LDV = 1024; static constexpr float SCALE = 0.10206207261596575f; };
template <> struct Cfg<1> { static constexpr int DQK = 64, DV = 128, LDQ = 2048, LDK0 = 2048, LDK1 = 2048, LDV = 2048; static constexpr float SCALE = 0.125f; };
__device__ __forceinline__ int crow(int r, int hi) { return (r & 3) + 8 * (r >> 2) + 4 * hi; }
__device__ __forceinline__ unsigned cvtpk(float lo, float hi) { unsigned r; asm volatile("v_cvt_pk_bf16_f32 %0, %1, %2" : "=v"(r) : "v"(lo), "v"(hi)); return r; }

constexpr float THR2 = 11.5f;
__device__ __forceinline__ float max3f(float a, float b, float c) { return __builtin_fmaxf(__builtin_fmaxf(a, b), c); }
template <int ABL = 0> __device__ __forceinline__ void partialSM(f32x16& p0, f32x16& p1, float& m_reg, float& alpha, bool first) {
    float a = max3f(p0[0], p0[1], p1[0]), b = max3f(p0[2], p0[3], p1[1]); a = max3f(a, p1[2], p1[3]);
#pragma unroll
    for (int r = 4; r < 16; r += 4) { a = max3f(a, p0[r], p0[r + 1]); b = max3f(b, p0[r + 2], p0[r + 3]); a = max3f(a, p1[r], p1[r + 1]); b = max3f(b, p1[r + 2], p1[r + 3]); }
    float pmax = __builtin_fmaxf(a, b);
    if (ABL == 7) pmax = p0[0];
    { auto rr = __builtin_amdgcn_permlane32_swap(__float_as_uint(pmax), __float_as_uint(pmax), false, false);
      pmax = __builtin_fmaxf(__uint_as_float(rr[0]), __uint_as_float(rr[1])); }
    alpha = 1.f;
    if (__builtin_expect(first || __any(pmax > THR2), 0)) {
        const float dl = first ? pmax : __builtin_fmaxf(pmax, 0.f);
        m_reg += dl; alpha = first ? 1.f : __builtin_amdgcn_exp2f(-dl);
#pragma unroll
        for (int r = 0; r < 16; ++r) { p0[r] -= dl; p1[r] -= dl; }
    }
#pragma unroll
    for (int r = 0; r < 16; ++r) p0[r] = ABL == 1 ? p0[r] * 0.5f : __builtin_amdgcn_exp2f(p0[r]);
}
template <int ABL = 0> __device__ __forceinline__ void finishSM(f32x16& p0, f32x16& p1, float alpha, float& l_reg, bf16x8& pa0, bf16x8& pa1, bf16x8& pa2, bf16x8& pa3) {
#pragma unroll
    for (int r = 0; r < 16; ++r) p1[r] = ABL == 1 ? p1[r] * 0.5f : __builtin_amdgcn_exp2f(p1[r]);
    float ps = 0;
    if (ABL == 2) ps = p0[0] + p1[15]; else {
        float s0 = p0[0] + p0[4], s1 = p0[1] + p0[5], s2 = p0[2] + p0[6], s3 = p0[3] + p0[7];
        s0 += p0[8]; s1 += p0[9]; s2 += p0[10]; s3 += p0[11]; s0 += p0[12]; s1 += p0[13]; s2 += p0[14]; s3 += p0[15];
#pragma unroll
        for (int r = 0; r < 16; r += 4) { s0 += p1[r]; s1 += p1[r + 1]; s2 += p1[r + 2]; s3 += p1[r + 3]; }
        ps = (s0 + s1) + (s2 + s3); }
    { auto rr = __builtin_amdgcn_permlane32_swap(__float_as_uint(ps), __float_as_uint(ps), false, false);
      ps = __uint_as_float(rr[0]) + __uint_as_float(rr[1]); }
    l_reg = l_reg * alpha + ps;
#define PK4(P, BASE, OUT) do { u32x4 w = {cvtpk(P[BASE + 0], P[BASE + 1]), cvtpk(P[BASE + 2], P[BASE + 3]), cvtpk(P[BASE + 4], P[BASE + 5]), cvtpk(P[BASE + 6], P[BASE + 7])}; OUT = *reinterpret_cast<bf16x8*>(&w); } while (0)
    PK4(p0, 0, pa0); PK4(p0, 8, pa1); PK4(p1, 0, pa2); PK4(p1, 8, pa3);
#undef PK4
}
template <int NQ, int KROW, int ABL = 0> __device__ __forceinline__ void qkt(f32x16& p0, f32x16& p1, const LAS char* Ks, const bf16x8* qr, float m_ref, int r32, int hi) {
    f32x16 negm;
#pragma unroll
    for (int r = 0; r < 16; ++r) negm[r] = -m_ref;
    p0 = negm; p1 = negm;
#pragma unroll
    for (int d0 = 0; d0 < NQ; ++d0) { const int cb = d0 * 32 + hi * 16;
        const bf16x8 b0 = *(const LAS bf16x8*)(Ks + r32 * KROW + cb);
        const bf16x8 b1 = *(const LAS bf16x8*)(Ks + (32 + r32) * KROW + cb);
        if (ABL == 4) { asm volatile("" :: "v"(b0), "v"(b1)); } else {
        p0 = __builtin_amdgcn_mfma_f32_32x32x16_bf16(b0, qr[d0], p0, 0, 0, 0);
        p1 = __builtin_amdgcn_mfma_f32_32x32x16_bf16(b1, qr[d0], p1, 0, 0, 0); } }
}
template <int NC> __device__ __forceinline__ int v_st(int k, int c) { const int kk = k; return ((kk >> 3) * NC + (c >> 5)) * 512 + ((kk & 7) * 32 + (c & 31)) * 2; }
__device__ __forceinline__ int v_rd_base(int lane) { return ((lane & 3) << 3) | (((lane >> 2) & 3) << 6) | (((lane >> 4) & 1) << 5) | (((lane >> 5) & 1) << 8); }
template <int OFF> __device__ __forceinline__ s16x4 tr_read(int vb) {
    s16x4 r; asm volatile("ds_read_b64_tr_b16 %0, %1 offset:%2" : "=&v"(r) : "v"(vb), "i"(OFF) : "memory"); return r;
}
template <int NC, int D0, int ABL = 0> __device__ __forceinline__ void pv_one(f32x16& od, int vb, bf16x8 pa0, bf16x8 pa1, bf16x8 pa2, bf16x8 pa3) {
#define VOFF(ks, half) (D0 * 512 + (ks) * (NC * 1024) + (half) * (NC * 512))
    const s16x4 l0 = tr_read<VOFF(0, 0)>(vb), h0 = tr_read<VOFF(0, 1)>(vb), l1 = tr_read<VOFF(1, 0)>(vb), h1 = tr_read<VOFF(1, 1)>(vb);
    const s16x4 l2 = tr_read<VOFF(2, 0)>(vb), h2 = tr_read<VOFF(2, 1)>(vb), l3 = tr_read<VOFF(3, 0)>(vb), h3 = tr_read<VOFF(3, 1)>(vb);
#undef VOFF
    asm volatile("s_waitcnt lgkmcnt(0)" ::: "memory"); SBAR();
#define PK(L, H) (bf16x8){L[0], L[1], L[2], L[3], H[0], H[1], H[2], H[3]}
    if (ABL == 3) { asm volatile("" :: "v"(l0), "v"(h0), "v"(l1), "v"(h1), "v"(l2), "v"(h2), "v"(l3), "v"(h3)); return; }
    od = __builtin_amdgcn_mfma_f32_32x32x16_bf16(pa0, PK(l0, h0), od, 0, 0, 0);
    od = __builtin_amdgcn_mfma_f32_32x32x16_bf16(pa1, PK(l1, h1), od, 0, 0, 0);
    od = __builtin_amdgcn_mfma_f32_32x32x16_bf16(pa2, PK(l2, h2), od, 0, 0, 0);
    od = __builtin_amdgcn_mfma_f32_32x32x16_bf16(pa3, PK(l3, h3), od, 0, 0, 0);
#undef PK
}
template <int NC, int ABL = 0> __device__ __forceinline__ void pv_all(f32x16* o, int vb, bf16x8 pa0, bf16x8 pa1, bf16x8 pa2, bf16x8 pa3) {
    pv_one<NC, 0, ABL>(o[0], vb, pa0, pa1, pa2, pa3); pv_one<NC, 1, ABL>(o[1], vb, pa0, pa1, pa2, pa3);
    if constexpr (NC == 4) { pv_one<NC, 2, ABL>(o[2], vb, pa0, pa1, pa2, pa3); pv_one<NC, 3, ABL>(o[3], vb, pa0, pa1, pa2, pa3); }
}
template <int MODE> constexpr int lds_bytes() { return 3 * 64 * Cfg<MODE>::DV * 2 + 3 * 64 * (Cfg<MODE>::DQK * 2 + 16) + 8 * 64 * 4; }

template <int MODE, int EPI, int ABL = 0>
__device__ __forceinline__ void unit(const bf16* __restrict__ Qb, const bf16* __restrict__ K0, const bf16* __restrict__ K1, const bf16* __restrict__ Vh, void* Ob, int ldo, LAS char* lds, char* stash, float lam, const float* gsub) {
    using C = Cfg<MODE>;
    constexpr int DQK = C::DQK, DV = C::DV, NQ = DQK / 16, NC = DV / 32, KROW = DQK * 2 + 16, SHM_K = 64 * KROW, SHM_V = 64 * DV * 2;
    const int tid = threadIdx.x, wid = tid >> 6, lane = tid & 63, r32 = lane & 31, hi = lane >> 5;
    LAS char* V_lds = lds; LAS char* K_lds = lds + 3 * SHM_V;
    LAS float* ws = (LAS float*)(lds + 3 * SHM_V + 3 * SHM_K) + wid * 64; LAS float* li_l = ws; LAS float* al_l = ws + 32;
    float m_reg = 0.f, l_reg = 0; f32x16 o[NC]; bf16x8 qr[NQ];
#pragma unroll
    for (int d = 0; d < NC; ++d) o[d] = f32x16{};
    const bf16* Qw = Qb + (size_t)(wid * 32 + r32) * C::LDQ + hi * 8;
#pragma unroll
    for (int d0 = 0; d0 < NQ; ++d0) qr[d0] = *reinterpret_cast<const bf16x8*>(Qw + d0 * 16);
    const int vb0 = (int)(uintptr_t)V_lds + v_rd_base(lane);
    const int kr0 = tid >> 3, kc0 = tid & 7;
    const int krr = (tid & 255) >> 2, krc = tid & 3;
    const int vr0 = MODE == 0 ? (tid >> 3) : (tid >> 4), vc0 = MODE == 0 ? (tid & 7) * 8 : (tid & 15) * 8;
    const int vst0 = v_st<NC>(vr0, vc0), vst1 = v_st<NC>(32 + vr0, vc0);
    constexpr int NSET = MODE == 0 ? 2 : 1;
    struct { bf16x8 ka, kb, va, vb; } sr_[NSET];
#define SLOAD(i, k0) do { sr_[i].ka = *reinterpret_cast<const bf16x8*>(K0 + (size_t)((k0) + kr0) * C::LDK0 + kc0 * 8); \
        if (MODE == 0) { sr_[i].kb = *reinterpret_cast<const bf16x8*>(K1 + (size_t)((k0) + krr) * C::LDK1 + krc * 8); } \
        sr_[i].va = *reinterpret_cast<const bf16x8*>(Vh + (size_t)((k0) + vr0) * C::LDV + vc0); \
        if (MODE == 1) { sr_[i].vb = *reinterpret_cast<const bf16x8*>(Vh + (size_t)((k0) + 32 + vr0) * C::LDV + vc0); } } while (0)
#define SWRITE(ko, vo, i) do { *(LAS bf16x8*)(K_lds + (ko) + kr0 * KROW + kc0 * 16) = sr_[i].ka; \
        if (MODE == 0) { *(LAS bf16x8*)(K_lds + (ko) + krr * KROW + 128 + krc * 16) = sr_[i].kb; } \
        *(LAS bf16x8*)(V_lds + (vo) + vst0) = sr_[i].va; \
        if (MODE == 1) { *(LAS bf16x8*)(V_lds + (vo) + vst1) = sr_[i].vb; } } while (0)
#define SWAIT() do { if (NSET == 2) asm volatile("s_waitcnt vmcnt(3)" ::: "memory"); } while (0)
#define RESC(a) do { if (__any((a) < 1.f)) { if (hi == 0) al_l[r32] = (a); asm volatile("s_waitcnt lgkmcnt(0)" ::: "memory"); \
        _Pragma("unroll") for (int d = 0; d < NC; ++d) _Pragma("unroll") for (int r = 0; r < 16; ++r) o[d][r] *= al_l[crow(r, hi)]; } } while (0)
    f32x16 pA0, pA1, pB0, pB1; float alA = 1.f, alB = 1.f; bf16x8 pa0, pa1, pa2, pa3; constexpr int NT = NTOK / 64;
#define STEP(PC0, PC1, ALC, PP0, PP1, ALP, jj, SQ, SV, SW) do { constexpr int SETN = ((jj##_c) + 1) % NSET; \
        if (ABL != 6 && (jj) + 1 < NT) { SWAIT(); SWRITE((SW) * SHM_K, (SW) * SHM_V, SETN); } \
        SBAR(); qkt<NQ, KROW, ABL>(PC0, PC1, K_lds + (SQ) * SHM_K, qr, m_reg, r32, hi); \
        finishSM<ABL>(PP0, PP1, ALP, l_reg, pa0, pa1, pa2, pa3); SBAR(); \
        if (ABL != 6 && (jj) + 1 + NSET < NT) SLOAD(SETN, ((jj) + 1 + NSET) * 64); SBAR(); \
        pv_all<NC, ABL>(o, vb0 + (SV) * SHM_V, pa0, pa1, pa2, pa3); partialSM<ABL>(PC0, PC1, m_reg, ALC, false); \
        RESC(ALC); if (ABL != 5) __syncthreads(); } while (0)
    static_assert((NT - 2) % 6 == 0, "tile count: steps 1..NT-2 in groups of 6");
    SLOAD(0, 0); asm volatile("s_waitcnt vmcnt(0)" ::: "memory"); SWRITE(0, 0, 0);
    SLOAD(1 % NSET, 64); if (NSET == 2) SLOAD(0, 128); __syncthreads();
    SWAIT(); SWRITE(SHM_K, SHM_V, 1 % NSET);
    qkt<NQ, KROW>(pA0, pA1, K_lds, qr, m_reg, r32, hi);
    SLOAD(1 % NSET, (1 + NSET) * 64);
    partialSM(pA0, pA1, m_reg, alA, true);
    __syncthreads();
    for (int j = 1; j + 1 < NT; j += 6) {
        constexpr int j_c = 1, j1_c = 2, j2_c = 3, j3_c = 4, j4_c = 5, j5_c = 6; const int j1 = j + 1, j2 = j + 2, j3 = j + 3, j4 = j + 4, j5 = j + 5;
        STEP(pB0, pB1, alB, pA0, pA1, alA, j,  1, 0, 2);
        STEP(pA0, pA1, alA, pB0, pB1, alB, j1, 2, 1, 0);
        STEP(pB0, pB1, alB, pA0, pA1, alA, j2, 0, 2, 1);
        STEP(pA0, pA1, alA, pB0, pB1, alB, j3, 1, 0, 2);
        STEP(pB0, pB1, alB, pA0, pA1, alA, j4, 2, 1, 0);
        STEP(pA0, pA1, alA, pB0, pB1, alB, j5, 0, 2, 1);
    }
    { constexpr int jt_c = NT - 1; const int jt = NT - 1;
      STEP(pB0, pB1, alB, pA0, pA1, alA, jt, (NT - 1) % 3, (NT - 2) % 3, NT % 3); }
    finishSM(pB0, pB1, alB, l_reg, pa0, pa1, pa2, pa3); SBAR();
    pv_all<NC>(o, vb0 + ((NT - 1) % 3) * SHM_V, pa0, pa1, pa2, pa3);
#undef STEP
    if (hi == 0) li_l[r32] = l_reg; asm volatile("s_waitcnt lgkmcnt(0)" ::: "memory");
    float rli[16];
#pragma unroll
    for (int r = 0; r < 16; ++r) rli[r] = __builtin_amdgcn_rcpf(li_l[crow(r, hi)]);
    asm volatile("" : "+s"(ldo), "+s"(stash), "+s"(gsub), "+s"(Ob));
    if constexpr (MODE == 0) {
#pragma unroll
        for (int r = 0; r < 16; ++r) { const int orow = wid * 32 + crow(r, hi);
#pragma unroll
            for (int d0 = 0; d0 < NC; ++d0) ((bf16*)Ob)[(size_t)orow * ldo + d0 * 32 + r32] = (bf16)f2bf(o[d0][r] * rli[r]); }
    } else if constexpr (EPI == 1) {
        char* st = stash + wid * 8192 + lane * 16;
#pragma unroll
        for (int d0 = 0; d0 < NC; ++d0)
#pragma unroll
            for (int q = 0; q < 2; ++q) { u32x4 w;
                w.x = cvtpk(o[d0][8 * q + 0] * rli[8 * q + 0], o[d0][8 * q + 1] * rli[8 * q + 1]); w.y = cvtpk(o[d0][8 * q + 2] * rli[8 * q + 2], o[d0][8 * q + 3] * rli[8 * q + 3]);
                w.z = cvtpk(o[d0][8 * q + 4] * rli[8 * q + 4], o[d0][8 * q + 5] * rli[8 * q + 5]); w.w = cvtpk(o[d0][8 * q + 6] * rli[8 * q + 6], o[d0][8 * q + 7] * rli[8 * q + 7]);
                *(u32x4*)(st + (d0 * 2 + q) * 1024) = w; }
        asm volatile("s_waitcnt vmcnt(0)" ::: "memory");
    } else {
        const char* st = stash + wid * 8192 + lane * 16;
#pragma unroll
        for (int d0 = 0; d0 < NC; ++d0) {
            const u32x4 wa = *(const u32x4*)(st + (d0 * 2 + 0) * 1024), wb = *(const u32x4*)(st + (d0 * 2 + 1) * 1024);
            f32x16 od;
            od[0] = __builtin_bit_cast(float, wa.x << 16); od[1] = __builtin_bit_cast(float, wa.x & 0xffff0000u); od[2] = __builtin_bit_cast(float, wa.y << 16); od[3] = __builtin_bit_cast(float, wa.y & 0xffff0000u);
            od[4] = __builtin_bit_cast(float, wa.z << 16); od[5] = __builtin_bit_cast(float, wa.z & 0xffff0000u); od[6] = __builtin_bit_cast(float, wa.w << 16); od[7] = __builtin_bit_cast(float, wa.w & 0xffff0000u);
            od[8] = __builtin_bit_cast(float, wb.x << 16); od[9] = __builtin_bit_cast(float, wb.x & 0xffff0000u); od[10] = __builtin_bit_cast(float, wb.y << 16); od[11] = __builtin_bit_cast(float, wb.y & 0xffff0000u);
            od[12] = __builtin_bit_cast(float, wb.z << 16); od[13] = __builtin_bit_cast(float, wb.z & 0xffff0000u); od[14] = __builtin_bit_cast(float, wb.w << 16); od[15] = __builtin_bit_cast(float, wb.w & 0xffff0000u);
#pragma unroll
            for (int r = 0; r < 16; ++r) od[r] -= lam * (o[d0][r] * rli[r]);
            o[d0] = od;
        }
        f32x16 ssv;
#pragma unroll
        for (int r = 0; r < 16; ++r) { float x = 0.f;
#pragma unroll
            for (int d0 = 0; d0 < NC; ++d0) x += o[d0][r] * o[d0][r];
            x += __builtin_bit_cast(float, __builtin_amdgcn_update_dpp(0, __builtin_bit_cast(int, x), 0x111, 0xf, 0xf, false));
            x += __builtin_bit_cast(float, __builtin_amdgcn_update_dpp(0, __builtin_bit_cast(int, x), 0x112, 0xf, 0xf, false));
            x += __builtin_bit_cast(float, __builtin_amdgcn_update_dpp(0, __builtin_bit_cast(int, x), 0x114, 0xf, 0xf, false));
            x += __builtin_bit_cast(float, __builtin_amdgcn_update_dpp(0, __builtin_bit_cast(int, x), 0x118, 0xf, 0xf, false));
            x += __builtin_bit_cast(float, __builtin_amdgcn_update_dpp(0, __builtin_bit_cast(int, x), 0x142, 0xa, 0xf, false));
            const float t0 = __builtin_bit_cast(float, __builtin_amdgcn_readlane(__builtin_bit_cast(int, x), 31)), t1 = __builtin_bit_cast(float, __builtin_amdgcn_readlane(__builtin_bit_cast(int, x), 63));
            ssv[r] = rsqrtf((hi ? t1 : t0) * (1.f / 128.f) + EPS) * (1.f - LAM_INIT); }
#pragma unroll
        for (int d0 = 0; d0 < NC; ++d0) { const float g = gsub[d0 * 32 + r32];
#pragma unroll
            for (int r = 0; r < 16; ++r) { const int orow = wid * 32 + crow(r, hi); ((bf16*)Ob)[(size_t)orow * ldo + d0 * 32 + r32] = (bf16)f2bf(o[d0][r] * ssv[r] * g); } }
    }
    __syncthreads();
#undef SLOAD
#undef SWRITE
#undef SWAIT
#undef RESC
}
#undef SBAR
}

#define XB_TMO      128
#define XB_XCNT(j)  (256  + 64 * (j))
#define XB_XSUB(j)  (1280 + 64 * (j))
#define XB_XGEN(j)  (2304 + 64 * (j))
#define XB_TOP      3328
#define XB_TOPGEN   3392
#define XCD_BAR_WORDS 3456
#define XB_SPIN_CAP (1u << 20)
__device__ __forceinline__ unsigned xb_ld(unsigned* p)              { return __hip_atomic_load(p, __ATOMIC_RELAXED, __HIP_MEMORY_SCOPE_AGENT); }
__device__ __forceinline__ unsigned xb_add(unsigned* p, unsigned v) { return __hip_atomic_fetch_add(p, v, __ATOMIC_RELAXED, __HIP_MEMORY_SCOPE_AGENT); }
__device__ __forceinline__ unsigned xb_xcc_id() { return (unsigned)__builtin_amdgcn_s_getreg((3 << 11) | 20) & 0xFu; }
#define XB_SPIN(cond, bar) do { unsigned _sp = 0; while (cond) { __builtin_amdgcn_s_sleep(1); \
    if ((++_sp & 255u) == 0u) { if (xb_ld(&(bar)[XB_TMO])) break; if (_sp > XB_SPIN_CAP) { atomicAdd(&(bar)[XB_TMO], 1u); break; } } } } while (0)
struct XcdBarrier { unsigned* bar; unsigned x; volatile LAS unsigned* st; };
__device__ __forceinline__ XcdBarrier xcd_barrier_post(unsigned* bar, volatile LAS unsigned* st) {
    XcdBarrier b; b.bar = bar; b.x = xb_xcc_id(); b.st = st;
    if (threadIdx.x == 0) (void)xb_add(&bar[XB_XCNT(b.x)], 1u);
    return b;
}
__device__ __forceinline__ void xcd_barrier_complete(unsigned* bar, unsigned x, unsigned& nloc, unsigned& nx) {
    const unsigned G = gridDim.x * gridDim.y * gridDim.z;
    unsigned sum, cnt, mine, sp = 0u;
    for (;;) {
        sum = 0u; cnt = 0u; mine = 0u;
#pragma unroll
        for (unsigned j = 0; j < 16; ++j) { const unsigned c = xb_ld(&bar[XB_XCNT(j)]); sum += c; cnt += (c > 0u) ? 1u : 0u; mine = (j == x) ? c : mine; }
        if (sum == G) break;
        __builtin_amdgcn_s_sleep(1);
        if ((++sp & 255u) == 0u) { if (xb_ld(&bar[XB_TMO])) break; if (sp > XB_SPIN_CAP) { atomicAdd(&bar[XB_TMO], 1u); break; } }
    }
    nloc = mine > 0u ? mine : 1u; nx = cnt > 0u ? cnt : 1u;
}
__device__ __forceinline__ void xcd_barrier(const XcdBarrier& b) {
    asm volatile("s_waitcnt vmcnt(0)" ::: "memory");
    __syncthreads();
    if (threadIdx.x == 0) {
        unsigned* bar = b.bar;
        __builtin_amdgcn_s_waitcnt(0);
        unsigned nloc = b.st[0], nx = b.st[1];
        if (nloc == 0u) { xcd_barrier_complete(bar, b.x, nloc, nx); b.st[0] = nloc; b.st[1] = nx; }
        const unsigned old = xb_add(&bar[XB_XSUB(b.x)], 1u);
        const unsigned gen = old / nloc;
        if (old + 1u == (gen + 1u) * nloc) {
            __builtin_amdgcn_fence(__ATOMIC_RELEASE, "agent");
            asm volatile("s_waitcnt vmcnt(0)" ::: "memory");
            const unsigned og = xb_add(&bar[XB_TOP], 1u);
            const unsigned tg = og / nx;
            if (og + 1u == (tg + 1u) * nx) xb_add(&bar[XB_TOPGEN], 1u);
            else XB_SPIN(xb_ld(&bar[XB_TOPGEN]) == tg, bar);
            __builtin_amdgcn_fence(__ATOMIC_ACQUIRE, "agent");
            xb_add(&bar[XB_XGEN(b.x)], 1u);
            asm volatile("s_waitcnt vmcnt(0)" ::: "memory");
        } else {
            XB_SPIN(xb_ld(&bar[XB_XGEN(b.x)]) == gen, bar);
            __builtin_amdgcn_fence(__ATOMIC_ACQUIRE, "agent");
            asm volatile("s_waitcnt vmcnt(0)" ::: "memory");
        }
    }
    __syncthreads();
}

constexpr int NWAVES = 8;
constexpr int RING_BYTES = 131072, LDS_BYTES = 147456, LDSCTL_OFF = LDS_BYTES - 2048, MISC_OFF = LDSCTL_OFF + 320, UCACHE_OFF = LDSCTL_OFF + 1024  ;

struct Frame {
    LAS unsigned char* lds; volatile LAS unsigned* MISC; unsigned* ctl;
    int tid, lane, wave, vcu, G;
    Ptrs P;
    __device__ __forceinline__ LAS char* lds_c() const { return (LAS char*)lds; }
};

template <class SrcF> __device__ __forceinline__ void transpose_item(const SrcF& f, int K, bf16* WT, int p0, int k0, LAS float* scr, int lane) {
    float t[32];
#pragma unroll
    for (int i = 0; i < 32; ++i) t[i] = f(k0 + 2 * i + (lane >> 5), p0 + (lane & 31));
#pragma unroll
    for (int i = 0; i < 32; ++i) scr[(2 * i + (lane >> 5)) * 33 + (lane & 31)] = t[i];
    LDS_WAIT(); asm volatile("" ::: "memory");
    const int c = lane & 7;
#pragma unroll
    for (int j = 0; j < 4; ++j) { const int n = (lane >> 3) + 8 * j; const LAS float* s = scr + (8 * c) * 33 + n;
        u32x4 o; o.x = cvt_pk_bf16(s[0 * 33], s[1 * 33]); o.y = cvt_pk_bf16(s[2 * 33], s[3 * 33]); o.z = cvt_pk_bf16(s[4 * 33], s[5 * 33]); o.w = cvt_pk_bf16(s[6 * 33], s[7 * 33]);
        *(u32x4*)(WT + (size_t)(p0 + n) * K + k0 + 8 * c) = o; }
    LDS_WAIT(); asm volatile("" ::: "memory");
}
struct SrcWin { const float* w; __device__ float operator()(int k, int p) const { const int l = p1_logical(p); return l < 0 ? 0.f : w[(size_t)k * IN_COLS + l]; } };
struct SrcWup { const float *gq, *wuq, *gkv, *wukv;
    __device__ float operator()(int k, int p) const {
        if (p < 768) return k < 256 ? gq[k] * wuq[(size_t)k * 768 + qm_logical(p)] : 0.f;
        return k >= 256 ? gkv[k - 256] * wukv[(size_t)(k - 256) * 1024 + (p - 768)] : 0.f; } };
__host__ __device__ __forceinline__ int ctx_dstcol(int cp) { return cp < 128 ? 256 + cp : cp < 160 ? 384 + (cp - 128) : cp < 672 ? 1024 + (cp - 160) : cp < 1184 ? 1536 + (cp - 672) : -1; }
struct SrcCtx { const float* w; __device__ float operator()(int k, int p) const { const int c = ctx_dstcol(p); const int l = c < 0 ? -1 : p1_logical(c); return l < 0 ? 0.f : w[(size_t)k * IN_COLS + l]; } };
struct SrcPlain { const float* w; int N; int coff; __device__ float operator()(int k, int p) const { return w[(size_t)k * N + p + coff]; } };

__device__ __forceinline__ void ph0_prep(Frame& F) {
    LAS float* scr = (LAS float*)(F.lds + F.wave * 16384);
    const int gw = F.vcu * NWAVES + F.wave, NGW = F.G * NWAVES, lane = F.lane;
    const Ptrs& P = F.P; unsigned char* ws = P.ws;
    constexpr int I_IN = 16 * 64, I_UP = 6 * 56, I_OUT = 16 * 32, I_R = 16 * 8, I_CTX = 16 * 38, I_SMALL = I_IN + I_UP + I_OUT + I_R + I_CTX;
    for (int it = gw; it < I_SMALL; it += NGW) {
        int r = it;
        if (r < I_IN) { transpose_item(SrcWin{P.in[8]}, 1024, (bf16*)(ws + WS_WIN), (r % 64) * 32, (r / 64) * 64, scr, lane); continue; } r -= I_IN;
        if (r < I_UP) { transpose_item(SrcWup{P.in[9], P.in[10], P.in[11], P.in[12]}, 384, (bf16*)(ws + WS_WUP), (r % 56) * 32, (r / 56) * 64, scr, lane); continue; } r -= I_UP;
        if (r < I_OUT) { transpose_item(SrcPlain{P.in[18], 1024, 0}, 1024, (bf16*)(ws + WS_WOUT), (r % 32) * 32, (r / 32) * 64, scr, lane); continue; } r -= I_OUT;
        if (r < I_R) { transpose_item(SrcPlain{P.in[19], 256, 0}, 1024, (bf16*)(ws + WS_WR), (r % 8) * 32, (r / 8) * 64, scr, lane); continue; } r -= I_R;
        transpose_item(SrcCtx{P.in[8]}, 1024, (bf16*)(ws + WS_WCTX), (r % 38) * 32, (r / 38) * 64, scr, lane);
    }
    for (int it = gw; it < 96 * 16; it += NGW) {
        const int cg = it % 96, kp = it / 96;
#pragma unroll
        for (int r = 0; r < 5; ++r) { const float c = (r < 4 ? P.in[1] + r * DM : P.in[3])[kp * 64 + lane]; scr[r * 64 + lane] = c / (1.f + __expf(-c)); }
        LDS_WAIT(); asm volatile("" ::: "memory");
        float acc[5] = {0.f, 0.f, 0.f, 0.f, 0.f};
        const float* W = P.in[4] + (size_t)(kp * 64) * 6144 + cg * 64 + lane;
#pragma unroll 8
        for (int kk = 0; kk < 64; ++kk) { const float w = W[(size_t)kk * 6144];
#pragma unroll
            for (int r = 0; r < 5; ++r) acc[r] += scr[r * 64 + kk] * w; }
        LDS_WAIT(); asm volatile("" ::: "memory");
#pragma unroll
        for (int r = 0; r < 5; ++r) ((float*)(ws + WS_MODP))[(size_t)(kp * 5 + r) * 6144 + cg * 64 + lane] = acc[r];
    }
    { const int idx = (F.vcu * 512 + F.tid);
      if (idx < 1024) { const int v = idx / 16, f = idx % 16; const float th = (float)v * exp2f(-(float)f / 16.f * 13.287712379549449f);
          ((float2*)(ws + WS_TAB))[idx] = make_float2(__builtin_amdgcn_cosf(th * 0.15915494309189535f), __builtin_amdgcn_sinf(th * 0.15915494309189535f)); }
      else if (idx < 1536) { const int i2 = idx - 1024, v = i2 / 8, f = i2 % 8; const float th = (float)v * exp2f(-(float)f / 8.f * 13.287712379549449f);
          ((float2*)(ws + WS_TAB))[idx] = make_float2(__builtin_amdgcn_cosf(th * 0.15915494309189535f), __builtin_amdgcn_sinf(th * 0.15915494309189535f)); } }
}
struct CvItem { const float* src; int ld; bf16* dst; int K; };
__device__ __forceinline__ CvItem cv_decode(const Ptrs& P, int it, int lane) {
    constexpr int IPE = 256 + 128; unsigned char* ws = P.ws;
    const int e = it / IPE; int r = it % IPE; CvItem c;
    if (r < 256) { const int p0 = (r % 16) * 32, k0 = (r / 16) * 64, half = p0 >> 8, up = (p0 >> 7) & 1;
        const float* w = e < 256 ? (up ? P.in[22] : P.in[21]) + (size_t)e * DM * EFF : (up ? P.in[25] : P.in[24]);
        c.src = w + (size_t)(k0 + (lane >> 5)) * EFF + half * 128 + (p0 & 127) + (lane & 31); c.ld = EFF; c.K = 1024;
        c.dst = (bf16*)(ws + WS_W13) + ((size_t)e * 512 + p0) * 1024 + k0; }
    else { r -= 256; const int p0 = (r % 32) * 32, k0 = (r / 32) * 64;
        const float* w = e < 256 ? P.in[23] + (size_t)e * EFF * DM : P.in[26];
        c.src = w + (size_t)(k0 + (lane >> 5)) * DM + p0 + (lane & 31); c.ld = DM; c.K = 256;
        c.dst = (bf16*)(ws + WS_W2) + ((size_t)e * 1024 + p0) * 256 + k0; }
    return c;
}
#ifndef CVV
#define CVV 3
#endif
#ifndef CVP
#define CVP 0
#endif
#define CV_LOAD(t, c) do { _Pragma("unroll") for (int _i = 0; _i < 32; ++_i) { if (CVP == 2 && probe) t[_i] = (float)_i; else if (CVV == 3) t[_i] = __builtin_nontemporal_load((c).src + (size_t)(2 * _i) * (c).ld); else t[_i] = (c).src[(size_t)(2 * _i) * (c).ld]; } } while (0)
#define CV_FINISH(t, c) do { _Pragma("unroll") for (int _i = 0; _i < 32; ++_i) scr[(2 * _i + (lane >> 5)) * 33 + (lane & 31)] = t[_i]; \
        LDS_WAIT(); asm volatile("" ::: "memory"); const int _c = lane & 7; \
        _Pragma("unroll") for (int _j = 0; _j < 4; ++_j) { const int _n = (lane >> 3) + 8 * _j; const LAS float* _s = scr + (8 * _c) * 33 + _n; \
            u32x4 _o; _o.x = cvt_pk_bf16(_s[0 * 33], _s[1 * 33]); _o.y = cvt_pk_bf16(_s[2 * 33], _s[3 * 33]); _o.z = cvt_pk_bf16(_s[4 * 33], _s[5 * 33]); _o.w = cvt_pk_bf16(_s[6 * 33], _s[7 * 33]); \
            if (!(CVP == 1 && probe)) *(u32x4*)((c).dst + (size_t)_n * (c).K + 8 * _c) = _o; else asm volatile("" :: "v"(_o)); } \
        LDS_WAIT(); asm volatile("" ::: "memory"); } while (0)
constexpr int CV_EARLY = 0;
__device__ __forceinline__ void ph0_experts(Frame& F, int r_from, int r_to, bool probe = false) {
    LAS float* scr = (LAS float*)(F.lds + F.wave * 16384);
    const int gw = F.vcu * NWAVES + F.wave, NGW = F.G * NWAVES, lane = F.lane, NIT = 257 * 384;
    const Ptrs& P = F.P;
    float ta[32], tb[32];
    const long lim = (long)gw + (long)(r_to < (1 << 20) ? r_to : (1 << 20)) * NGW; const int NE = (int)(lim < NIT ? lim : NIT);
    int it = gw + r_from * NGW; CvItem ca, cb;
    if (it < NE) { ca = cv_decode(P, it, lane); CV_LOAD(ta, ca); }
    for (; it < NE; it += 2 * NGW) {
        const int it2 = it + NGW, it3 = it + 2 * NGW;
        if (it2 < NE) { cb = cv_decode(P, it2, lane); CV_LOAD(tb, cb); }
        CV_FINISH(ta, ca);
        if (it3 < NE) { ca = cv_decode(P, it3, lane); CV_LOAD(ta, ca); }
        if (it2 < NE) CV_FINISH(tb, cb);
    }
    __syncthreads();
}
#undef CV_LOAD
#undef CV_FINISH
__device__ __forceinline__ void ph1_xn(Frame& F) {
    const Ptrs& P = F.P; unsigned char* ws = P.ws; const int lane = F.lane, wave = F.wave, fr = lane & 15, fq = lane >> 4;
    const float* MODP = (const float*)(ws + WS_MODP);
    for (int idx = F.vcu * 512 + F.tid; idx < 5 * 6144; idx += F.G * 512) { const int r = idx / 6144, j = idx % 6144; float a = P.in[5][j];
#pragma unroll
        for (int kp = 0; kp < 16; ++kp) a += MODP[(size_t)(kp * 5 + r) * 6144 + j];
        ((float*)(ws + WS_MOD))[idx] = a; }
    LAS unsigned char* At = F.lds;
    LAS float* sm = (LAS float*)(F.lds + 32768);
    const int t0 = F.vcu * 64, bl = t0 / SEQ;
    for (int i = F.tid; i < 4096; i += 512) { const int j = i & 2047, mrow = i < 2048 ? bl : 4; float a = P.in[5][j];
#pragma unroll
        for (int kp = 0; kp < 16; ++kp) a += MODP[(size_t)(kp * 5 + mrow) * 6144 + j];
        sm[i] = a; }
    __syncthreads();
    {
        f32x4 v[4], nv[4];
        { const f32x4* xr = (const f32x4*)(P.in[0] + (size_t)(t0 + wave * 8) * DM) + lane;
#pragma unroll
          for (int j = 0; j < 4; ++j) v[j] = xr[64 * j]; }
#pragma unroll 1
        for (int i = 0; i < 8; ++i) {
            const int t = t0 + wave * 8 + i, r = bl * NTOK + NCTX + (t - bl * SEQ);
            { const f32x4* xr = (const f32x4*)(P.in[0] + (size_t)(i < 7 ? t + 1 : t) * DM) + lane;
#pragma unroll
              for (int j = 0; j < 4; ++j) nv[j] = xr[64 * j]; }
            float s = 0.f;
#pragma unroll
            for (int j = 0; j < 4; ++j) s += (v[j][0] * v[j][0] + v[j][1] * v[j][1]) + (v[j][2] * v[j][2] + v[j][3] * v[j][3]);
            const float rs = rsqrtf(wave_sum(s) * (1.f / DM) + EPS);
            u32x2* o8 = (u32x2*)((bf16*)(ws + WS_XN) + (size_t)r * DM) + lane;
#pragma unroll
            for (int j = 0; j < 4; ++j) { const int c = 4 * lane + 256 * j; const f32x4 g = *(const f32x4*)(P.in[6] + c);
                const f32x4 sh = *(const LAS f32x4*)(sm + c), sc = *(const LAS f32x4*)(sm + 1024 + c);
                const f32x4 y = (v[j] * rs * g) * (sc + 1.f) + sh;
                u32x2 w; w.x = cvt_pk_bf16(y[0], y[1]); w.y = cvt_pk_bf16(y[2], y[3]); o8[64 * j] = w; }
#pragma unroll
            for (int j = 0; j < 4; ++j) v[j] = nv[j];
        }
    }
    const int mt = F.vcu >> 2, q = F.vcu & 3, bc = mt >> 4, nc0 = (mt & 15) * 16;
#pragma unroll 1
    for (int i = 0; i < 2; ++i) {
        const int r = 2 * wave + i;
        const f32x4* xr = (const f32x4*)(P.in[2] + ((size_t)bc * NCTX + nc0 + r) * DM) + lane;
        f32x4 v[4]; float s = 0.f;
#pragma unroll
        for (int j = 0; j < 4; ++j) { v[j] = xr[64 * j]; s += (v[j][0] * v[j][0] + v[j][1] * v[j][1]) + (v[j][2] * v[j][2] + v[j][3] * v[j][3]); }
        const float rs = rsqrtf(wave_sum(s) * (1.f / DM) + EPS);
#pragma unroll
        for (int j = 0; j < 4; ++j) { const int c = 4 * lane + 256 * j; const f32x4 g = *(const f32x4*)(P.in[6] + c);
            const f32x4 sh = *(const LAS f32x4*)(sm + 2048 + c), sc = *(const LAS f32x4*)(sm + 3072 + c);
            const f32x4 y = (v[j] * rs * g) * (sc + 1.f) + sh;
            u32x2 w; w.x = cvt_pk_bf16(y[0], y[1]); w.y = cvt_pk_bf16(y[2], y[3]);
            const int ch = (lane >> 1) + 32 * j;
            *(LAS u32x2*)(At + r * 2048 + ((ch ^ r) << 4) + (lane & 1) * 8) = w; }
    }
    __syncthreads();
    {
        const int nt0 = wave < 3 ? 3 * wave : 9 + 2 * (wave - 3), nnt = wave < 3 ? 3 : 2;
        const bf16* wb = (const bf16*)(ws + WS_WCTX) + (size_t)(q * 304 + nt0 * 16 + fr) * 1024 + 8 * fq;
        f32x4 acc[3];
#pragma unroll
        for (int j = 0; j < 3; ++j) acc[j] = (f32x4){0.f, 0.f, 0.f, 0.f};
        bf16x8 bq[4][3], nb[4][3];
#pragma unroll
        for (int u = 0; u < 4; ++u)
#pragma unroll
            for (int j = 0; j < 3; ++j) bq[u][j] = (j < nnt) ? *(const bf16x8*)(wb + (size_t)j * 16 * 1024 + 32 * u) : bf16x8{};
#pragma unroll 1
        for (int k4 = 0; k4 < 8; ++k4) {
            if (k4 < 7) {
#pragma unroll
                for (int u = 0; u < 4; ++u)
#pragma unroll
                    for (int j = 0; j < 3; ++j) nb[u][j] = (j < nnt) ? *(const bf16x8*)(wb + (size_t)j * 16 * 1024 + 32 * (4 * (k4 + 1) + u)) : bf16x8{}; }
#pragma unroll
            for (int u = 0; u < 4; ++u) { const int ch = 4 * (4 * k4 + u) + fq;
                const bf16x8 a = *(const LAS bf16x8*)(At + fr * 2048 + ((ch ^ fr) << 4));
#pragma unroll
                for (int j = 0; j < 3; ++j) acc[j] = __builtin_amdgcn_mfma_f32_16x16x32_bf16(bq[u][j], a, acc[j], 0, 0, 0); }
#pragma unroll
            for (int u = 0; u < 4; ++u)
#pragma unroll
                for (int j = 0; j < 3; ++j) bq[u][j] = nb[u][j];
        }
        const int r = bc * NTOK + nc0 + fr; bf16* P1 = (bf16*)(ws + WS_P1); float ssq = 0.f;
#pragma unroll
        for (int j = 0; j < 3; ++j) if (j < nnt) { const int cp = q * 304 + (nt0 + j) * 16 + 4 * fq, dc = ctx_dstcol(cp);
            if (dc >= 0) { u32x2 w; w.x = cvt_pk_bf16(acc[j][0], acc[j][1]); w.y = cvt_pk_bf16(acc[j][2], acc[j][3]); *(u32x2*)(P1 + (size_t)r * NP1 + dc) = w; }
            if (cp < 128) ssq += (acc[j][0] * acc[j][0] + acc[j][1] * acc[j][1]) + (acc[j][2] * acc[j][2] + acc[j][3] * acc[j][3]); }
        if (q == 0 && wave < 4) { ssq += __shfl_xor(ssq, 16); ssq += __shfl_xor(ssq, 32);
            if (fq == 0) ((float*)(ws + WS_SSQ))[(size_t)r * 8 + 4 + wave] = ssq; }
    }
    __syncthreads();
}
__device__ __forceinline__ void ph6_h2(Frame& F) {
    const Ptrs& P = F.P; unsigned char* ws = P.ws;
    const int gw = F.vcu * NWAVES + F.wave, NGW = F.G * NWAVES;
    f32x4 v[4], nv[4];
    if (gw < MLAT) { const f32x4* xr = (const f32x4*)((const float*)(ws + WS_X1) + (size_t)gw * DM) + F.lane;
#pragma unroll
        for (int j = 0; j < 4; ++j) v[j] = xr[64 * j]; }
    for (int t = gw; t < MLAT; t += NGW) {
        const int b = t / SEQ; const float* md = (const float*)(ws + WS_MOD) + b * 6144;
        { const int tn = t + NGW < MLAT ? t + NGW : t; const f32x4* xr = (const f32x4*)((const float*)(ws + WS_X1) + (size_t)tn * DM) + F.lane;
#pragma unroll
          for (int j = 0; j < 4; ++j) nv[j] = xr[64 * j]; }
        float s = 0.f;
#pragma unroll
        for (int j = 0; j < 4; ++j) s += (v[j][0] * v[j][0] + v[j][1] * v[j][1]) + (v[j][2] * v[j][2] + v[j][3] * v[j][3]);
        const float rs = rsqrtf(wave_sum(s) * (1.f / DM) + EPS);
        u32x2* o8 = (u32x2*)((bf16*)(ws + WS_H2) + (size_t)t * DM) + F.lane;
#pragma unroll
        for (int j = 0; j < 4; ++j) { const int c = 4 * F.lane + 256 * j; const f32x4 g = *(const f32x4*)(P.in[7] + c);
            const f32x4 sh = *(const f32x4*)(md + 3072 + c), sc = *(const f32x4*)(md + 4096 + c);
            const f32x4 y = (v[j] * rs * g) * (sc + 1.f) + sh;
            u32x2 w; w.x = cvt_pk_bf16(y[0], y[1]); w.y = cvt_pk_bf16(y[2], y[3]); o8[64 * j] = w; }
#pragma unroll
        for (int j = 0; j < 4; ++j) v[j] = nv[j];
    }
}
__device__ __forceinline__ void ph7_route(Frame& F) {
    const Ptrs& P = F.P; unsigned char* ws = P.ws; const int lane = F.lane;
    const int gw = F.vcu * NWAVES + F.wave, NGW = F.G * NWAVES;
    const f32x4 bi = ((const f32x4*)P.in[20])[lane];
    for (int t = gw; t < MLAT; t += NGW) {
        f32x4 lg = ((const f32x4*)(ws + WS_LOGP))[(size_t)t * 64 + lane];
#pragma unroll
        for (int kp = 1; kp < 4; ++kp) lg += ((const f32x4*)(ws + WS_LOGP))[((size_t)kp * MLAT + t) * 64 + lane];
        float s[4], v[4];
#pragma unroll
        for (int i = 0; i < 4; ++i) { s[i] = 1.f / (1.f + __expf(-lg[i])); v[i] = s[i] + bi[i]; }
        float m1 = fmaxf(v[0], v[1]), m2 = fminf(v[0], v[1]);
#pragma unroll
        for (int i = 2; i < 4; ++i) { const float x = v[i]; m2 = fmaxf(m2, fminf(m1, x)); m1 = fmaxf(m1, x); }
#pragma unroll
        for (int o = 1; o < 8; o <<= 1) { const float b1 = __shfl_xor(m1, o), b2 = __shfl_xor(m2, o); const float n1 = fmaxf(m1, b1), n2 = fmaxf(fminf(m1, b1), fmaxf(m2, b2)); m1 = n1; m2 = n2; }
        const float gs = m1 + m2; const int g = lane >> 3; int rank = 0;
#pragma unroll
        for (int j = 0; j < 8; ++j) { const float o = __shfl(gs, j * 8); rank += (o > gs || (o == gs && j < g)) ? 1 : 0; }
        if (rank >= 4) { v[0] = v[1] = v[2] = v[3] = -INFINITY; }
        int my_e = 0; float my_s = 0.f, ssum = 0.f;
#pragma unroll
        for (int k = 0; k < 8; ++k) {
            float bv = v[0]; int bi_ = 0;
#pragma unroll
            for (int i = 1; i < 4; ++i) if (v[i] > bv) { bv = v[i]; bi_ = i; }
            int be = lane * 4 + bi_;
#pragma unroll
            for (int o = 1; o < 64; o <<= 1) { const float ov = __shfl_xor(bv, o); const int oe = __shfl_xor(be, o); if (ov > bv || (ov == bv && oe < be)) { bv = ov; be = oe; } }
            const int wl = be >> 2, wi = be & 3;
            float sv = wi == 0 ? s[0] : wi == 1 ? s[1] : wi == 2 ? s[2] : s[3];
            sv = __shfl(sv, wl);
            if (lane == wl) { if (wi == 0) v[0] = -INFINITY; else if (wi == 1) v[1] = -INFINITY; else if (wi == 2) v[2] = -INFINITY; else v[3] = -INFINITY; }
            ssum += sv; if (lane == k) { my_e = be; my_s = sv; }
        }
        if (lane < 8) {
            int* cnt = (int*)(ws + WS_CTL) + CW_COUNT;
            const int rk = atomicAdd(&cnt[my_e], 1);
            ((int*)(ws + WS_EIDX))[(size_t)t * 8 + lane] = my_e;
            ((float*)(ws + WS_EW))[(size_t)t * 8 + lane] = my_s / ssum * 2.5f;
            ((int*)(ws + WS_ERANK))[(size_t)t * 8 + lane] = rk;
        }
    }
}
__device__ __forceinline__ void ph_route3(Frame& F) {
    const Ptrs& P = F.P; unsigned char* ws = P.ws; const int lane = F.lane, wave = F.wave, fr = lane & 15, fq = lane >> 4;
    LAS unsigned char* At = F.lds;
    const bf16* Wr = (const bf16*)(ws + WS_WR);
    const f32x4 bi = ((const f32x4*)P.in[20])[lane];
    for (int grp = F.vcu; grp < MLAT / 64; grp += F.G) {
        const int t0 = grp * 64, b = t0 / SEQ; const float* md = (const float*)(ws + WS_MOD) + b * 6144;
        u32x4 v[2], nv[2];
        { const u32x4* xr = (const u32x4*)((const bf16*)(ws + WS_X1) + (size_t)(t0 + wave * 8) * DM) + lane; v[0] = xr[0]; v[1] = xr[64]; }
#pragma unroll 1
        for (int i = 0; i < 8; ++i) {
            const int r = wave * 8 + i, t = t0 + r;
            { const int rn = i < 7 ? t + 1 : t; const u32x4* xr = (const u32x4*)((const bf16*)(ws + WS_X1) + (size_t)rn * DM) + lane; nv[0] = xr[0]; nv[1] = xr[64]; }
            float xf[2][8]; float s = 0.f;
#pragma unroll
            for (int h = 0; h < 2; ++h)
#pragma unroll
                for (int d = 0; d < 4; ++d) { xf[h][2 * d] = bflo(v[h][d]); xf[h][2 * d + 1] = bfhi(v[h][d]); s += xf[h][2 * d] * xf[h][2 * d] + xf[h][2 * d + 1] * xf[h][2 * d + 1]; }
            const float rs = rsqrtf(wave_sum(s) * (1.f / DM) + EPS);
#pragma unroll
            for (int h = 0; h < 2; ++h) { const int c = 8 * lane + 512 * h; f32x4 y[2];
#pragma unroll
                for (int q = 0; q < 2; ++q) { const f32x4 g = *(const f32x4*)(P.in[7] + c + 4 * q), sh = *(const f32x4*)(md + 3072 + c + 4 * q), sc = *(const f32x4*)(md + 4096 + c + 4 * q);
                    const f32x4 xv = {xf[h][4 * q], xf[h][4 * q + 1], xf[h][4 * q + 2], xf[h][4 * q + 3]}; y[q] = (xv * rs * g) * (sc + 1.f) + sh; }
                const u32x4 w = pack8(y[0], y[1]);
                *(u32x4*)((bf16*)(ws + WS_H2) + (size_t)t * DM + c) = w;
                const int ch = lane + 64 * h;
                *(LAS u32x4*)(At + r * 2048 + ((ch ^ (r & 15)) << 4)) = w; }
            v[0] = nv[0]; v[1] = nv[1];
        }
        __syncthreads();
        f32x4 acc[4][2];
#pragma unroll
        for (int m = 0; m < 4; ++m) { acc[m][0] = (f32x4){0.f, 0.f, 0.f, 0.f}; acc[m][1] = (f32x4){0.f, 0.f, 0.f, 0.f}; }
        const bf16* wb = Wr + (size_t)(wave * 32 + fr) * 1024 + 8 * fq;
        bf16x8 bq[4][2], nb[4][2];
#pragma unroll
        for (int u = 0; u < 4; ++u) { bq[u][0] = *(const bf16x8*)(wb + 32 * u); bq[u][1] = *(const bf16x8*)(wb + 16 * 1024 + 32 * u); }
#pragma unroll 1
        for (int k4 = 0; k4 < 8; ++k4) {
            if (k4 < 7) {
#pragma unroll
                for (int u = 0; u < 4; ++u) { nb[u][0] = *(const bf16x8*)(wb + 32 * (4 * (k4 + 1) + u)); nb[u][1] = *(const bf16x8*)(wb + 16 * 1024 + 32 * (4 * (k4 + 1) + u)); } }
#pragma unroll
            for (int u = 0; u < 4; ++u) { const int ks = 4 * k4 + u, ch = 4 * ks + fq;
#pragma unroll
                for (int m = 0; m < 4; ++m) { const int r = 16 * m + fr;
                    const bf16x8 a = *(const LAS bf16x8*)(At + r * 2048 + ((ch ^ (r & 15)) << 4));
                    acc[m][0] = __builtin_amdgcn_mfma_f32_16x16x32_bf16(bq[u][0], a, acc[m][0], 0, 0, 0);
                    acc[m][1] = __builtin_amdgcn_mfma_f32_16x16x32_bf16(bq[u][1], a, acc[m][1], 0, 0, 0); } }
#pragma unroll
            for (int u = 0; u < 4; ++u) { bq[u][0] = nb[u][0]; bq[u][1] = nb[u][1]; }
        }
        __syncthreads();
        LAS float* Lg = (LAS float*)F.lds;
#pragma unroll
        for (int m = 0; m < 4; ++m)
#pragma unroll
            for (int n = 0; n < 2; ++n) *(LAS f32x4*)(Lg + (16 * m + fr) * 260 + wave * 32 + 16 * n + 4 * fq) = acc[m][n];
        __syncthreads();
#pragma unroll 1
        for (int i = 0; i < 8; ++i) {
            const int r = wave * 8 + i, t = t0 + r;
            const f32x4 lg = *(const LAS f32x4*)(Lg + r * 260 + 4 * lane);
            float s[4], vv[4];
#pragma unroll
            for (int q = 0; q < 4; ++q) { s[q] = 1.f / (1.f + __expf(-lg[q])); vv[q] = s[q] + bi[q]; }
            float m1 = fmaxf(vv[0], vv[1]), m2 = fminf(vv[0], vv[1]);
#pragma unroll
            for (int q = 2; q < 4; ++q) { const float x = vv[q]; m2 = fmaxf(m2, fminf(m1, x)); m1 = fmaxf(m1, x); }
#pragma unroll
            for (int o = 1; o < 8; o <<= 1) { const float b1 = __shfl_xor(m1, o), b2 = __shfl_xor(m2, o); const float n1 = fmaxf(m1, b1), n2 = fmaxf(fminf(m1, b1), fmaxf(m2, b2)); m1 = n1; m2 = n2; }
            const float gs = m1 + m2; const int g = lane >> 3; int rank = 0;
#pragma unroll
            for (int j = 0; j < 8; ++j) { const float o = __builtin_bit_cast(float, __builtin_amdgcn_readlane(__builtin_bit_cast(int, gs), j * 8)); rank += (o > gs || (o == gs && j < g)) ? 1 : 0; }
            unsigned key[4];
#pragma unroll
            for (int q = 0; q < 4; ++q) key[q] = rank >= 4 ? 0u : ((__builtin_bit_cast(unsigned, vv[q] + 1.f) & 0xFFFFFF00u) | (unsigned)(255 - (lane * 4 + q)));
            int my_e = 0; float my_s = 0.f, ssum = 0.f;
#pragma unroll
            for (int k = 0; k < 8; ++k) {
                unsigned kb = max(max(key[0], key[1]), max(key[2], key[3]));
                kb = max(kb, (unsigned)__builtin_amdgcn_update_dpp(0, (int)kb, 0x111, 0xf, 0xf, false));
                kb = max(kb, (unsigned)__builtin_amdgcn_update_dpp(0, (int)kb, 0x112, 0xf, 0xf, false));
                kb = max(kb, (unsigned)__builtin_amdgcn_update_dpp(0, (int)kb, 0x114, 0xf, 0xf, false));
                kb = max(kb, (unsigned)__builtin_amdgcn_update_dpp(0, (int)kb, 0x118, 0xf, 0xf, false));
                kb = max(kb, (unsigned)__builtin_amdgcn_update_dpp(0, (int)kb, 0x142, 0xa, 0xf, false));
                kb = max(kb, (unsigned)__builtin_amdgcn_update_dpp(0, (int)kb, 0x143, 0xc, 0xf, false));
                const unsigned kw = (unsigned)__builtin_amdgcn_readlane((int)kb, 63);
                const int be = 255 - (int)(kw & 255u), wl = be >> 2, wi = be & 3;
                const float ssel = wi == 0 ? s[0] : wi == 1 ? s[1] : wi == 2 ? s[2] : s[3];
                const float sv = __builtin_bit_cast(float, __builtin_amdgcn_readlane(__builtin_bit_cast(int, ssel), wl));
#pragma unroll
                for (int q = 0; q < 4; ++q) key[q] = key[q] == kw ? 0u : key[q];
                ssum += sv; if (lane == k) { my_e = be; my_s = sv; }
            }
            if (lane < 8) {
                int* cnt = (int*)(ws + WS_CTL) + CW_COUNT;
                const int rk = atomicAdd(&cnt[my_e], 1);
                ((int*)(ws + WS_EIDX))[(size_t)t * 8 + lane] = my_e;
                ((float*)(ws + WS_EW))[(size_t)t * 8 + lane] = my_s / ssum * 2.5f;
                ((int*)(ws + WS_ERANK))[(size_t)t * 8 + lane] = rk;
            }
        }
        __syncthreads();
    }
}
__device__ __forceinline__ void ph8_slots(Frame& F) {
    const Ptrs& P = F.P; unsigned char* ws = P.ws;
    LAS int* off = (LAS int*)F.lds;
    LAS int* cfs = off + 260;
    LAS int* chs = off + 520;
    unsigned* cnt = (unsigned*)(ws + WS_CTL) + CW_COUNT;
    if (F.wave == 0) { const int lane = F.lane; int n[4], cf[4], ch[4], sn = 0, sf = 0, sh = 0;
#pragma unroll
        for (int i = 0; i < 4; ++i) { n[i] = (int)cnt[4 * lane + i]; const int r = n[i] & 255; cf[i] = (n[i] >> 8) + (r > 128 ? 1 : 0); ch[i] = (r > 0 && r <= 128) ? 1 : 0; sn += n[i]; sf += cf[i]; sh += ch[i]; }
        int in = sn, jf = sf, jh = sh;
#pragma unroll
        for (int o = 1; o < 64; o <<= 1) { const int tn = __shfl_up(in, o), tf = __shfl_up(jf, o), th = __shfl_up(jh, o); if (lane >= o) { in += tn; jf += tf; jh += th; } }
        int an = in - sn, af = jf - sf, ah = jh - sh;
#pragma unroll
        for (int i = 0; i < 4; ++i) { off[4 * lane + i] = an; cfs[4 * lane + i] = af; chs[4 * lane + i] = ah; an += n[i]; af += cf[i]; ah += ch[i]; }
        if (lane == 63) { off[256] = an; cfs[256] = af; chs[256] = ah; off[257] = NSLOT; cfs[257] = af + MLAT / 256; chs[257] = ah; } }
    __syncthreads();
    for (int idx = F.vcu * 512 + F.tid; idx < MLAT * 8; idx += F.G * 512) {
        const int e = ((const int*)(ws + WS_EIDX))[idx], rk = ((const int*)(ws + WS_ERANK))[idx];
        const int slot = off[e] + rk;
        ((int*)(ws + WS_SLOTOF))[idx] = slot; ((int*)(ws + WS_SLOTTOK))[slot] = idx >> 3; ((float*)(ws + WS_SLOTW))[slot] = ((const float*)(ws + WS_EW))[idx];
        if (idx < MLAT) { ((int*)(ws + WS_SLOTTOK))[MLAT * 8 + idx] = idx; ((float*)(ws + WS_SLOTW))[MLAT * 8 + idx] = 1.f; }
    }
    if (F.vcu == 0) {
        int* go = (int*)(ws + WS_OFF); int* ut = (int*)(ws + WS_UT);
        const int nfull = cfs[257];
        for (int e = F.tid; e < 258; e += 512) go[e] = off[e];
        for (int e = F.tid; e < 257; e += 512) { const int n = off[e + 1] - off[e], nf = cfs[e + 1] - cfs[e], nh = chs[e + 1] - chs[e];
            for (int j = 0; j < nf; ++j) { int* u = ut + (cfs[e] + j) * 4; u[0] = e; u[1] = off[e] + j * 256; u[2] = min(256, n - j * 256); u[3] = 0; }
            if (nh) { int* u = ut + (nfull + chs[e]) * 4; u[0] = e; u[1] = off[e] + nf * 256; u[2] = n - nf * 256; u[3] = 0; } }
        if (F.tid == 0) { ((int*)(ws + WS_CTL))[CW_NUNIT] = nfull + chs[257]; ((int*)(ws + WS_CTL))[CW_NFULL] = nfull; }
    }
    __syncthreads();
}
__device__ __forceinline__ void ph11_combine(Frame& F) {
    const Ptrs& P = F.P; unsigned char* ws = P.ws; const int lane = F.lane;
    const int gw = F.vcu * NWAVES + F.wave, NGW = F.G * NWAVES;
    const unsigned char* Y = (const unsigned char*)(ws + WS_Y);
    const int cbase = 256 * (lane >> 4) + 32 * ((lane >> 2) & 3) + 8 * (lane & 3);
    u32x4 yw[9], nyw[9]; u32x4 xw[2], nxw[2]; int nsl[8];
    auto ldslots = [&](int t) {
#pragma unroll
        for (int k = 0; k < 8; ++k) nsl[k] = ((const int*)(ws + WS_SLOTOF))[(size_t)t * 8 + k]; };
    auto ldrows = [&](int t) {
#pragma unroll
        for (int k = 0; k < 9; ++k) { const int sl = k < 8 ? nsl[k] : MLAT * 8 + t; nyw[k] = *(const u32x4*)(Y + (size_t)sl * DM + lane * 16); }
        nxw[0] = *(const u32x4*)((const bf16*)(ws + WS_X1) + (size_t)t * DM + cbase); nxw[1] = *(const u32x4*)((const bf16*)(ws + WS_X1) + (size_t)t * DM + cbase + 128); };
    if (gw < MLAT) { ldslots(gw); ldrows(gw); if (gw + NGW < MLAT) ldslots(gw + NGW); }
    for (int t = gw; t < MLAT; t += NGW) {
        const int b = t / SEQ; const float* gt2 = (const float*)(ws + WS_MOD) + b * 6144 + 5120;
#pragma unroll
        for (int k = 0; k < 9; ++k) yw[k] = nyw[k];
        xw[0] = nxw[0]; xw[1] = nxw[1];
        if (t + NGW < MLAT) { ldrows(t + NGW); if (t + 2 * NGW < MLAT) ldslots(t + 2 * NGW); }
        float a[16];
#pragma unroll
        for (int i = 0; i < 16; ++i) a[i] = 0.f;
#pragma unroll
        for (int k = 0; k < 9; ++k)
#pragma unroll
            for (int d = 0; d < 4; ++d) { const int w = (int)yw[k][d];
                const f32x2 lo = __builtin_amdgcn_cvt_pk_f32_fp8(w, false), hi = __builtin_amdgcn_cvt_pk_f32_fp8(w, true);
                a[4 * d + 0] += lo[0]; a[4 * d + 1] += lo[1]; a[4 * d + 2] += hi[0]; a[4 * d + 3] += hi[1]; }
        float ss = 0.f;
#pragma unroll
        for (int q = 0; q < 4; ++q) { const int c = cbase + (q >> 1) * 128 + (q & 1) * 4; const u32x4 xb = xw[q >> 1]; const unsigned x01 = (q & 1) ? xb.z : xb.x, x23 = (q & 1) ? xb.w : xb.y;
            const f32x4 xv = {bflo(x01), bfhi(x01), bflo(x23), bfhi(x23)}, gv = *(const f32x4*)(gt2 + c);
#pragma unroll
            for (int e = 0; e < 4; ++e) { const float v = xv[e] + gv[e] * (a[q * 4 + e] * (1.f / YSCALE)); a[q * 4 + e] = v; ss += v * v; } }
        const float rs = rsqrtf(wave_sum(ss) * (1.f / DM) + EPS);
#pragma unroll
        for (int q = 0; q < 4; ++q) { const int c = cbase + (q >> 1) * 128 + (q & 1) * 4; const f32x4 gf = *(const f32x4*)(P.in[27] + c);
            f32x4 o;
#pragma unroll
            for (int e = 0; e < 4; ++e) o[e] = a[q * 4 + e] * rs * gf[e];
            *(f32x4*)(P.out + (size_t)t * DM + c) = o; }
    }
}
__device__ __forceinline__ void ph4b_diff_finish(Frame& F) {
    const Ptrs& P = F.P; unsigned char* ws = P.ws; const int lane = F.lane;
    const int gw = F.vcu * NWAVES + F.wave, NGW = F.G * NWAVES;
    float d1 = P.in[13][lane] * P.in[14][lane], d2 = P.in[15][lane] * P.in[16][lane];
    d1 = wave_sum(d1); d2 = wave_sum(d2);
    const float lam = __expf(d1) - __expf(d2) + LAM_INIT;
    const float g0 = P.in[17][lane], g1 = P.in[17][64 + lane];
    for (int t = gw; t < MLAT; t += NGW) {
        const float* os = (const float*)(ws + WS_OS) + (size_t)t * 8 * 128;
        float x[4][4];
#pragma unroll
        for (int h = 0; h < 4; ++h) { x[h][0] = os[(2 * h) * 128 + lane]; x[h][1] = os[(2 * h) * 128 + 64 + lane]; x[h][2] = os[(2 * h + 1) * 128 + lane]; x[h][3] = os[(2 * h + 1) * 128 + 64 + lane]; }
#pragma unroll
        for (int h = 0; h < 4; ++h) {
            const float v0 = x[h][0] - lam * x[h][2], v1 = x[h][1] - lam * x[h][3];
            const float rs = rsqrtf(wave_sum(v0 * v0 + v1 * v1) * (1.f / 128.f) + EPS) * (1.f - LAM_INIT);
            bf16* mo = (bf16*)(ws + WS_MIX) + (size_t)t * DM + 512 + h * 128;
            mo[lane] = (bf16)f2bf(v0 * rs * g0); mo[64 + lane] = (bf16)f2bf(v1 * rs * g1); }
    }
}

#ifdef PROBE_UNITS
struct ProbeOrder { int n, c; __device__ bool next(int i, Unit& u) const { if (i >= n) return false; u.pm = (c * n + i) % 60; u.pn = (c + i) % 8; u.r0 = u.pm * 256; u.nv = 256; u.k0 = 0; return true; }
    __device__ __forceinline__ int a_row(const Unit& u, int r) const { return u.pm * 256 + r; } };
struct EpiProbe { static constexpr bool PERM = true; bf16* O; int mode;
    __device__ __forceinline__ void operator()(const Acc& acc, const Unit& u, int wr, int wc, int fr, int fq) const {
        if (mode == 0) {
#pragma unroll
            for (int ai = 0; ai < 2; ++ai)
#pragma unroll
                for (int bj = 0; bj < 2; ++bj)
#pragma unroll
                    for (int m = 0; m < 4; ++m) { asm volatile("" :: "v"(acc[ai][bj][m][0]), "v"(acc[ai][bj][m][1])); }
        } else {
            const int row0 = u.pm * 256 + wr * 64 + fr, col0 = u.pn * 256 + (mode == 2 ? wc * 64 : wc * 32) + 8 * fq; const int bjo = mode == 2 ? 32 : 128;
#pragma unroll
            for (int ai = 0; ai < 2; ++ai)
#pragma unroll
                for (int m = 0; m < 4; ++m) { if (mode == 7 && (ai | m)) { asm volatile("" :: "v"(acc[ai][0][m][0]), "v"(acc[ai][0][m][1]), "v"(acc[ai][1][m][0]), "v"(acc[ai][1][m][1])); continue; } bf16* rowp = mode == 8 ? O + (size_t)u.pm * 256 * NP1 + (size_t)(((wr * 4 + wc) * 8 + ai * 4 + m) * 2) * 512 + (fq * 16 + fr) * 8 : mode == 4 ? O + (size_t)blockIdx.x * 65536 + (size_t)(wr * 64 + fr + ai * 128 + m * 16) * 256 + wc * 32 + 8 * fq : O + (size_t)(row0 + ai * 128 + m * 16) * (mode == 3 ? NP1 + 64 : NP1) + col0;
                    *(u32x4*)(rowp) = pack8(acc[ai][0][m][0], acc[ai][0][m][1]); *(u32x4*)(rowp + (mode == 8 ? 512 : mode == 4 ? 128 : bjo)) = pack8(acc[ai][1][m][0], acc[ai][1][m][1]); }
        }
    }
};
#endif

enum { P_PREP = 0, P_XN, P_INPROJ, P_UP, P_ATTN, P_DIFFFIN, P_OUT, P_H2, P_ROUTER, P_ROUTE, P_SLOTS, P_EXP1, P_EXP2, P_COMB, P_PROBE, P_END };
struct Args { Ptrs P; int ph_lo, ph_hi, li, pad; };
__global__ void __launch_bounds__(NWAVES * 64, 2) mk_fwd(Args args) {
    extern __shared__ __attribute__((aligned(16))) unsigned char lds[];
    Frame F;
    F.lds = (LAS unsigned char*)lds; F.MISC = (volatile LAS unsigned*)(F.lds + MISC_OFF);
    F.tid = threadIdx.x; F.lane = F.tid & 63; F.wave = __builtin_amdgcn_readfirstlane(F.tid >> 6);
    F.G = gridDim.x; { const int bx = blockIdx.x; F.vcu = (F.G % 8 == 0) ? (bx % 8) * (F.G / 8) + bx / 8 : bx; }
    F.P = args.P; unsigned char* ws = args.P.ws; F.ctl = (unsigned*)(ws + WS_CTL);
    for (int u = F.tid; u < (LDS_BYTES - LDSCTL_OFF) / 4; u += NWAVES * 64) ((LAS unsigned*)(F.lds + LDSCTL_OFF))[u] = 0u;
    __syncthreads();
    XcdBarrier bar = xcd_barrier_post(F.ctl + CW_BAR + args.li * XCD_BAR_WORDS, F.MISC + 8);
    const int lo = args.ph_lo, hi = args.ph_hi;
#ifndef PHMASK
#define PHMASK 0xFFFF
#endif
#define IN(k) ((((PHMASK) >> (k)) & 1) && lo <= (k) && (k) < hi)
#define SKEW(ticks) do { const unsigned long long t0_ = __builtin_amdgcn_s_memrealtime(); const unsigned long long w_ = (unsigned long long)((F.vcu & 3) * (ticks)); while (__builtin_amdgcn_s_memrealtime() - t0_ < w_) __builtin_amdgcn_s_sleep(8); } while (0)
#define SEAM(k) do { if (IN(k) && IN((k) + 1)) xcd_barrier(bar); } while (0)
#define SEAM_SKIP1(k) do { if (IN(k) && IN((k) + 2)) xcd_barrier(bar); } while (0)
#define SEAM_SKIP2(k) do { if (IN(k) && IN((k) + 3)) xcd_barrier(bar); } while (0)
    if (IN(P_PREP)) { ph0_prep(F); } SEAM(P_PREP);
    if (IN(P_XN)) { ph1_xn(F); } SEAM(P_XN);
    if (IN(P_INPROJ)) {
        pg8::Gemm g{(const bf16*)(ws + WS_XN), (const bf16*)(ws + WS_WIN), 1024, 1024, 1024}; LatOrder S; S.init(MLAT, NP1, F.G, (int)blockIdx.x);
        EpiInProj E{(bf16*)(ws + WS_P1), (float*)(ws + WS_SSQ), (const float2*)(ws + WS_TAB), (const float2*)(ws + WS_TAB) + 1024};
#ifdef SKEW_INPROJ
        SKEW(SKEW_INPROJ);
#endif
        pg8::gemm_phase(F.lds, g, S, E);
        if (CV_EARLY > 0 && (int)blockIdx.x >= (MALL / 256) * (NP1 / 256) - 2 * F.G) ph0_experts(F, 0, CV_EARLY);
    } SEAM(P_INPROJ);
    if (IN(P_UP)) {
        pg8::Gemm g{(const bf16*)(ws + WS_P1), (const bf16*)(ws + WS_WUP), 2048, 384, 256}; UpOrder S{F.G, F.vcu};
        EpiUp E{(bf16*)(ws + WS_QM), (bf16*)(ws + WS_KVM), (const float*)(ws + WS_SSQ), (const float2*)(ws + WS_TAB) + 1024};
        pg8::gemm_phase(F.lds, g, S, E);
    } SEAM(P_UP);
    if (IN(P_ATTN)) {
        const bf16* P1 = (const bf16*)(ws + WS_P1); const bf16* QM = (const bf16*)(ws + WS_QM); const bf16* KVM = (const bf16*)(ws + WS_KVM);
        const int cslot = F.vcu % 5; int ui = 0;
        bool conv_done = false; int U = F.vcu;
        const int conv_from = ((int)blockIdx.x >= (MALL / 256) * (NP1 / 256) - 2 * F.G) ? CV_EARLY : 0;
        float lam; { float d1 = F.P.in[13][F.lane] * F.P.in[14][F.lane], d2 = F.P.in[15][F.lane] * F.P.in[16][F.lane]; d1 = wave_sum(d1); d2 = wave_sum(d2); lam = __expf(d1) - __expf(d2) + LAM_INIT; }
        for (; U < 512; U += F.G, ++ui) {
            if (ui == cslot) { ph0_experts(F, conv_from, 1 << 30); conv_done = true; }
            const int bh = U >> 4, qb = U & 15, b = bh >> 3, hh = bh & 7;
            const bf16* K0 = KVM + (size_t)b * NTOK * 1024 + hh * 128;
            attn::unit<0, 0>(QM + (size_t)(b * NTOK + NCTX + qb * 256) * 768 + hh * 96, K0, P1 + (size_t)b * NTOK * NP1 + 384, K0 + 64,
                             (bf16*)(ws + WS_MIX) + (size_t)(b * SEQ + qb * 256) * DM + hh * 64, DM, F.lds_c(), nullptr, 0.f, nullptr);
        }
        char* stash = (char*)(ws + WS_OS) + (size_t)F.vcu * 65536;
        const int Ud0 = U;
        for (; U < 768; U += 1024, ++ui) {
            if (ui == cslot) { ph0_experts(F, conv_from, 1 << 30); conv_done = true; }
            const int Up = U - 512, bh = Up >> 4, qb = Up & 15, b = bh >> 2, h = bh & 3;
            const bf16* Pb = P1 + (size_t)b * NTOK * NP1;
            attn::unit<1, 1>(P1 + (size_t)(b * NTOK + NCTX + qb * 256) * NP1 + 512 + (2 * h) * 64, Pb + 1024 + (2 * h) * 64, nullptr, Pb + 1536 + h * 128, nullptr, 0, F.lds_c(),
                             stash, 0.f, nullptr);
        }
        for (U = Ud0; U < 768; U += 1024, ++ui) {
            if (ui == cslot) { ph0_experts(F, conv_from, 1 << 30); conv_done = true; }
            const int Up = U - 512, bh = Up >> 4, qb = Up & 15, b = bh >> 2, h = bh & 3;
            const bf16* Pb = P1 + (size_t)b * NTOK * NP1;
            attn::unit<1, 2>(P1 + (size_t)(b * NTOK + NCTX + qb * 256) * NP1 + 512 + (2 * h + 1) * 64, Pb + 1024 + (2 * h + 1) * 64, nullptr, Pb + 1536 + h * 128,
                             (bf16*)(ws + WS_MIX) + (size_t)(b * SEQ + qb * 256) * DM + 512 + h * 128, DM, F.lds_c(), stash, lam, F.P.in[17]);
        }
        if (!conv_done) ph0_experts(F, conv_from, 1 << 30);
#ifdef CONV_PROBE
        if (F.vcu % 5 == 0) ph0_experts(F, 0, 1 << 30, true);
#endif

    } SEAM_SKIP1(P_ATTN);
#ifdef ATTN_PROBE
    if (IN(P_DIFFFIN)) { const bf16* P1 = (const bf16*)(ws + WS_P1); const bf16* QM = (const bf16*)(ws + WS_QM); const bf16* KVM = (const bf16*)(ws + WS_KVM);
        { const int Upr = F.vcu, bh = Upr >> 4, qb = Upr & 15, b = bh >> 3, hh = bh & 7;
          const bf16* K0 = KVM + (size_t)b * NTOK * 1024 + hh * 128;
          attn::unit<ATTN_PROBE_MODE, 0, ATTN_PROBE>(ATTN_PROBE_MODE == 0 ? QM + (size_t)(b * NTOK + NCTX + qb * 256) * 768 + hh * 96 : P1 + (size_t)(b * NTOK + NCTX + qb * 256) * NP1 + 512 + hh * 64,
                             ATTN_PROBE_MODE == 0 ? K0 : P1 + (size_t)b * NTOK * NP1 + 1024 + hh * 64, P1 + (size_t)b * NTOK * NP1 + 384, ATTN_PROBE_MODE == 0 ? K0 + 64 : P1 + (size_t)b * NTOK * NP1 + 1536 + (hh >> 1) * 128,
                             (bf16*)(ws + WS_TMP) + (size_t)Upr * 256 * DM, DM, F.lds_c(), nullptr, 0.f, nullptr); } }
#endif
    if (IN(P_OUT)) {
        pg8::Gemm g{(const bf16*)(ws + WS_MIX), (const bf16*)(ws + WS_WOUT), 1024, 1024, 1024}; pg8::StaticOrder S; S.init(MLAT, DM, F.G, (int)blockIdx.x);
        EpiOut E{F.P.in[0], (const float*)(ws + WS_MOD), (bf16*)(ws + WS_X1)};
        pg8::gemm_phase(F.lds, g, S, E);
    } SEAM(P_OUT);
    if (IN(P_H2)) { ph_route3(F); } SEAM_SKIP2(P_H2);
    if (IN(P_SLOTS)) { ph8_slots(F); } SEAM(P_SLOTS);
    if (IN(P_EXP1)) {
        const int nu = (int)xb_ld(F.ctl + CW_NUNIT), nfu = (int)xb_ld(F.ctl + CW_NFULL); LAS int* uc = (LAS int*)(F.lds + UCACHE_OFF);
        const int nmine = exp_units_to_lds<2>(uc, (const int*)(ws + WS_UT), nu, nfu, F.G, F.vcu);
        pg8::Gemm g{(const bf16*)(ws + WS_H2), (const bf16*)(ws + WS_W13), 1024, 1024, 1024};
        ExpSched<2, true> S{uc, nmine, (const int*)(ws + WS_SLOTTOK)};
        EpiAct E{(bf16*)(ws + WS_ACT), (const float*)(ws + WS_SLOTW)};
#ifdef SKEW_EXP1
        SKEW(SKEW_EXP1);
#endif
        pg8::gemm_phase(F.lds, g, S, E);
    } SEAM(P_EXP1);
    if (IN(P_EXP2)) {
        const int nu = (int)xb_ld(F.ctl + CW_NUNIT), nfu = (int)xb_ld(F.ctl + CW_NFULL); LAS int* uc = (LAS int*)(F.lds + UCACHE_OFF);
        const int nmine = exp_units_to_lds<4>(uc, (const int*)(ws + WS_UT), nu, nfu, F.G, F.vcu);
        pg8::Gemm g{(const bf16*)(ws + WS_ACT), (const bf16*)(ws + WS_W2), 256, 256, 256};
        ExpSched<4, false> S{uc, nmine, nullptr};
        EpiY E{(unsigned char*)(ws + WS_Y)};
#ifdef SKEW_EXP2
        SKEW(SKEW_EXP2);
#endif
        pg8::gemm_phase(F.lds, g, S, E);
    } SEAM(P_EXP2);
    if (IN(P_COMB)) { ph11_combine(F); } SEAM(P_COMB);
#ifdef PROBE_UNITS
    if (IN(P_PROBE)) {
        pg8::Gemm g{(const bf16*)(ws + WS_P1), (const bf16*)(ws + WS_WIN), 2048, 1024, PROBE_K}; ProbeOrder S{PROBE_UNITS, F.vcu};
        EpiProbe E{(bf16*)(ws + WS_TMP), PROBE_EPI};
        pg8::gemm_phase(F.lds, g, S, E);
    }
#endif
#undef IN
#undef SEAM
}

static int g_grid = 0;
static int mk_setup() {
    if (g_grid) return g_grid;
    int dev = 0, cus = 0;
    if (hipGetDevice(&dev) != hipSuccess || hipDeviceGetAttribute(&cus, hipDeviceAttributeMultiprocessorCount, dev) != hipSuccess) { fprintf(stderr, "kernel_launch: device query failed\n"); g_grid = -1; return -1; }
    if (hipFuncSetAttribute((const void*)mk_fwd, hipFuncAttributeMaxDynamicSharedMemorySize, LDS_BYTES) != hipSuccess) { fprintf(stderr, "kernel_launch: hipFuncSetAttribute failed\n"); g_grid = -1; return -1; }
    int per_cu = 0;
    if (hipOccupancyMaxActiveBlocksPerMultiprocessor(&per_cu, (const void*)mk_fwd, NWAVES * 64, LDS_BYTES) != hipSuccess || per_cu < 1) { fprintf(stderr, "kernel_launch: occupancy query says %d blocks/CU\n", per_cu); }
    (void)hipGetLastError();
    if (cus != 256) { fprintf(stderr, "kernel_launch: this build's work split assumes a 256-CU device (found %d CUs); nothing launched\n", cus); g_grid = -1; return -1; }
    g_grid = cus;
    return g_grid;
}
static void mk_run(const Ptrs& P, int lo, int hi, int li, hipStream_t stream) {
    Args a{}; a.P = P; a.ph_lo = lo; a.ph_hi = hi; a.li = li; a.pad = 0;
    hipLaunchKernelGGL(mk_fwd, dim3(g_grid), dim3(NWAVES * 64), LDS_BYTES, stream, a);
}
extern "C" void kernel_launch(void* const* d_in, const int* in_sizes, int n_in, void* d_out, int out_size, void* d_ws, size_t ws_size, hipStream_t stream) {
    if (n_in != 28 || out_size != MLAT * DM || ws_size < WS_END) { fprintf(stderr, "kernel_launch: unexpected shapes n_in %d out %d ws %zu\n", n_in, out_size, ws_size); return; }
    if (mk_setup() <= 0) return;
    Ptrs P{}; for (int i = 0; i < 28; ++i) P.in[i] = (const float*)d_in[i]; P.out = (float*)d_out; P.ws = (unsigned char*)d_ws;
    (void)hipMemsetAsync((char*)d_ws + WS_CTL, 0, 1 * MiB, stream);
    int li = 0;
#define FAST(lo, hi) mk_run(P, lo, hi, li++, stream)
    FAST(P_PREP, (defs_probe ? P_PROBE : P_COMB) + 1);
#undef FAST
}
```

```cpp
constexpr bool defs_probe = false;
#include <hip/hip_runtime.h>
#include <cstdio>
#include <cstdint>

constexpr int NB = 4, SEQ = 4096, NCTX = 256, NTOK = SEQ + NCTX, DM = 1024;
constexpr int MALL = NB * NTOK;
constexpr int MLAT = NB * SEQ;
constexpr int IN_COLS = 1952, NP1 = 2048;
constexpr int NEXP = 256, TOPK = 8, EFF = 256;
constexpr int NSLOT = MLAT * TOPK + MLAT;
constexpr float EPS = 1e-6f;
constexpr float LAM_INIT = 0.2f;

typedef unsigned short bf16;
__device__ __forceinline__ unsigned f2bf(float f) { unsigned u = __builtin_bit_cast(unsigned, f); return (u + 0x7fffu + ((u >> 16) & 1u)) >> 16; }
__device__ __forceinline__ float bf2f(bf16 h) { return __builtin_bit_cast(float, (unsigned)h << 16); }

constexpr size_t MiB = 1u << 20;
constexpr size_t WS_CTL = 0;
constexpr size_t WS_MOD = 3 * MiB;
constexpr size_t WS_TAB = 3 * MiB + 512 * 1024;
constexpr size_t WS_X1 = 402 * MiB;
constexpr size_t WS_SSQ = 466 * MiB;
constexpr size_t WS_EIDX = 467 * MiB;
constexpr size_t WS_EW = WS_EIDX + 512 * 1024;
constexpr size_t WS_ERANK = 468 * MiB;
constexpr size_t WS_SLOTOF = WS_ERANK + 512 * 1024;
constexpr size_t WS_SLOTTOK = 469 * MiB;
constexpr size_t WS_SLOTW = 470 * MiB;
constexpr size_t WS_OFF = 471 * MiB;
constexpr size_t WS_XN = 472 * MiB;
constexpr size_t WS_P1 = 506 * MiB;
constexpr size_t WS_QM = 574 * MiB;
constexpr size_t WS_KVM = 600 * MiB;
constexpr size_t WS_MIX = 634 * MiB;
constexpr size_t WS_OS = 666 * MiB;
constexpr size_t WS_TMP = 730 * MiB;
constexpr size_t WS_H2 = 472 * MiB;
constexpr size_t WS_H2F = 504 * MiB;
constexpr size_t WS_LOG = 568 * MiB;
constexpr size_t WS_ACT = 584 * MiB;
constexpr size_t WS_Y = 656 * MiB;
constexpr size_t WS_END = 944 * MiB;
constexpr int CW_COUNT = 1024;

__host__ __device__ __forceinline__ int perm32_log(int p) { return 16 * ((p >> 2) & 1) + 4 * (p >> 3) + (p & 3); }
__host__ __device__ __forceinline__ int perm64_log(int p) { return 32 * ((p >> 2) & 1) + 16 * (p >> 5) + 4 * ((p >> 3) & 3) + (p & 3); }
__host__ __device__ __forceinline__ int p1_logical(int p) {
    if (p < 384) return p;
    if (p < 416) return 384 + perm32_log(p - 384);
    if (p < 512) return -1;
    if (p < 1024) { int q = p - 512; return 416 + (q & ~63) + perm64_log(q & 63); }
    if (p < 1536) { int q = p - 1024; return 928 + (q & ~63) + perm64_log(q & 63); }
    return 1440 + (p - 1536);
}
__host__ __device__ __forceinline__ int qm_logical(int p) { int h = p / 96, r = p % 96; return h * 96 + (r < 64 ? r : 64 + perm32_log(r - 64)); }

struct Ptrs {
    const float* in[28]; float* out; unsigned char* ws;
};


#define GAS __attribute__((address_space(1)))
#define LAS __attribute__((address_space(3)))
typedef short bf16x8 __attribute__((ext_vector_type(8)));
typedef short s16x4 __attribute__((ext_vector_type(4)));
typedef float f32x4 __attribute__((ext_vector_type(4)));
typedef float f32x2 __attribute__((ext_vector_type(2)));
typedef float f32x16 __attribute__((ext_vector_type(16)));
typedef float f32x8 __attribute__((ext_vector_type(8)));
typedef unsigned u32x4 __attribute__((ext_vector_type(4)));
typedef unsigned u32x2 __attribute__((ext_vector_type(2)));
#define RLX_AGENT __ATOMIC_RELAXED, __HIP_MEMORY_SCOPE_AGENT
#define LDS_WAIT() asm volatile("s_waitcnt lgkmcnt(0)" ::: "memory")
#define VM_WAIT() asm volatile("s_waitcnt vmcnt(0)" ::: "memory")

constexpr size_t WS_MODP = 1 * MiB;
constexpr size_t WS_WIN = 4 * MiB;
constexpr size_t WS_WUP = 8 * MiB;
constexpr size_t WS_WOUT = 10 * MiB;
constexpr size_t WS_WR = 12 * MiB;
constexpr size_t WS_WCTX = 13 * MiB;
constexpr size_t WS_W13 = 16 * MiB;
constexpr size_t WS_W2 = 273 * MiB;
constexpr size_t WS_UT = WS_OFF + 4096;
static_assert(WS_W2 + (size_t)257 * 1024 * 256 * 2 <= WS_X1, "ws map");
constexpr size_t WS_LOGP = WS_Y;
constexpr int CW_NUNIT = 2048;
constexpr int CW_NFULL = 2049;
constexpr int CW_BAR = 4096;

__device__ __forceinline__ unsigned cvt_pk_bf16(float lo, float hi) { unsigned r; asm volatile("v_cvt_pk_bf16_f32 %0, %1, %2" : "=v"(r) : "v"(lo), "v"(hi)); return r; }
__device__ __forceinline__ unsigned pk2(float lo, float hi) { return f2bf(lo) | (f2bf(hi) << 16); }
__device__ __forceinline__ u32x4 pack8(f32x4 a, f32x4 b) { u32x4 w; w.x = cvt_pk_bf16(a[0], a[1]); w.y = cvt_pk_bf16(a[2], a[3]); w.z = cvt_pk_bf16(b[0], b[1]); w.w = cvt_pk_bf16(b[2], b[3]); return w; }
__device__ __forceinline__ float bflo(unsigned w) { return __builtin_bit_cast(float, w << 16); }
__device__ __forceinline__ float bfhi(unsigned w) { return __builtin_bit_cast(float, w & 0xffff0000u); }
__device__ __forceinline__ float wave_sum(float v) {
#pragma unroll
    for (int o = 1; o < 64; o <<= 1) v += __shfl_xor(v, o);
    return v;
}

namespace pg8 {
constexpr int BM = 256, BK = 64, HALF = 128, HTB = HALF * BK * 2, STAGE_BYTES = 8 * HTB;
__host__ __device__ __forceinline__ int lds_byte(int r, int c) { const int st = (r >> 4) * 2 + (c >> 5), rr = r & 15, cc = c & 31, ob = rr * 64 + cc * 2; return st * 1024 + (ob ^ (((ob >> 9) & 1) << 5)); }
__host__ __device__ __forceinline__ void stage_rc(int b, int& R, int& C) { const int st = b / 1024, sb = b % 1024, swz = sb ^ (((sb >> 9) & 1) << 5); R = (st >> 1) * 16 + swz / 64; C = (st & 1) * 32 + (swz % 64) / 2; }
__host__ __device__ __forceinline__ int perm32(int rho) { const int n = rho >> 4, i = rho & 15; return 8 * (i >> 2) + 4 * n + (i & 3); }

struct Unit { int pm, pn, r0, nv, k0; };
struct Gemm { const bf16* A; const bf16* Bt; int lda, ldb, K; };

struct StaticOrder {
    int nM, nN, nwg, G, c;
    __device__ void init(int M, int N, int G_, int c_) { nM = M / BM; nN = N / BM; nwg = nM * nN; G = G_; c = c_; }
    __device__ bool next(int i, Unit& u) const {
        const long L = (long)i * G + c; if (L >= nwg) return false;
        int wgid = (int)L; { const int q = nwg / 8, r = nwg % 8, xcd = wgid % 8, off = wgid / 8; wgid = (xcd < r ? xcd * (q + 1) : r * (q + 1) + (xcd - r) * q) + off; }
        const int nig = 8 * nN, gid = wgid / nig, fm = gid * 8, gsz = (nM - fm) < 8 ? (nM - fm) : 8;
        u.pm = fm + ((wgid % nig) % gsz); u.pn = (wgid % nig) / gsz; u.r0 = u.pm * BM; u.nv = BM; u.k0 = 0; return true;
    }
    __device__ __forceinline__ int a_row(const Unit& u, int r) const { return u.pm * BM + r; }
};

template <class Epi, class Sched>
__device__ __forceinline__ void gemm_phase(LAS unsigned char* lds, const Gemm g, const Sched& S, const Epi& E) {
    const int tid = threadIdx.x, wid = __builtin_amdgcn_readfirstlane(tid >> 6), lane = tid & 63, wr = wid >> 2, wc = wid & 3, fr = lane & 15, fq = lane >> 4;
    int K = g.K; asm volatile("" : "+s"(K));
    const int nt = K / BK;
    int RA[2], CA[2]; unsigned voffB[2];
#pragma unroll
    for (int i = 0; i < 2; ++i) { int R, C; stage_rc(tid * 16 + i * 8192, R, C); RA[i] = R; CA[i] = C; const int Rb = Epi::PERM ? ((R & ~31) + perm32(R & 31)) : R; voffB[i] = (unsigned)(Rb * g.ldb + C) * 2u; }
    const size_t kstep = (size_t)(BK * 2);
    const size_t hstepB = (size_t)HALF * g.ldb * 2, tstepB = 2 * hstepB;
    const unsigned ldsw = (unsigned)wid * 1024u;
    const int aoff = lds_byte(wr * 64 + fr, fq * 8), boff = lds_byte(wc * 32 + fr, fq * 8);
#define PG8_SA(b, h) (((b) * 2 + (h)) * HTB)
#define PG8_SB(b, h) ((4 + (b) * 2 + (h)) * HTB)
#define PG8_STAGE(bufoff, gbase, voff) do { _Pragma("unroll") for (int _i = 0; _i < 2; ++_i) \
        __builtin_amdgcn_global_load_lds((const unsigned*)((const char*)(gbase) + (voff)[_i]), (LAS unsigned*)(lds + (bufoff) + ldsw + _i * 8192), 16, 0, 0); } while (0)
#define PG8_LDA(dst, b, h) do { _Pragma("unroll") for (int m = 0; m < 4; ++m) _Pragma("unroll") for (int k = 0; k < 2; ++k) dst[m][k] = *(const LAS bf16x8*)(lds + PG8_SA(b, h) + aoff + m * 2048 + k * 1024); } while (0)
#define PG8_LDB(dst, b, h) do { _Pragma("unroll") for (int n = 0; n < 2; ++n) _Pragma("unroll") for (int k = 0; k < 2; ++k) dst[n][k] = *(const LAS bf16x8*)(lds + PG8_SB(b, h) + boff + n * 2048 + k * 1024); } while (0)
#define PG8_MMA(ai, bj, At, Bt) do { __builtin_amdgcn_s_setprio(1); _Pragma("unroll") for (int m = 0; m < 4; ++m) _Pragma("unroll") for (int n = 0; n < 2; ++n) _Pragma("unroll") for (int k = 0; k < 2; ++k) \
        acc[ai][bj][m][n] = __builtin_amdgcn_mfma_f32_16x16x32_bf16(Bt[n][k], At[m][k], acc[ai][bj][m][n], 0, 0, 0); __builtin_amdgcn_s_setprio(0); } while (0)
#define PG8_WAIT_V(n) asm volatile("s_waitcnt vmcnt(" #n ")" ::: "memory")
#define PG8_WAIT_L(n) asm volatile("s_waitcnt lgkmcnt(" #n ")" ::: "memory")
#define PG8_BAR __builtin_amdgcn_s_barrier()
#define PG8_SCHED __builtin_amdgcn_sched_barrier(0)
#define PG8_AOFFS(dst, u) do { _Pragma("unroll") for (int _h = 0; _h < 2; ++_h) _Pragma("unroll") for (int _i = 0; _i < 2; ++_i) \
        dst[_h][_i] = (unsigned)(((size_t)S.a_row(u, _h * HALF + RA[_i]) * (size_t)g.lda + (size_t)(CA[_i] + (u).k0)) * 2u); } while (0)
    Unit cur, nxt; int ui = 0;
    if (!S.next(0, cur)) return;
    f32x4 acc[2][2][4][2];
#pragma unroll
    for (int a = 0; a < 2; ++a)
#pragma unroll
        for (int b = 0; b < 2; ++b)
#pragma unroll
            for (int m = 0; m < 4; ++m)
#pragma unroll
                for (int n = 0; n < 2; ++n) acc[a][b][m][n] = (f32x4){0.f, 0.f, 0.f, 0.f};
    bf16x8 At[4][2], B0[2][2], B1[2][2];
    unsigned vA[2][2], vN[2][2];
    PG8_AOFFS(vA, cur);
    const char* Ab = (const char*)g.A; const char* cB = (const char*)g.Bt + (size_t)cur.pn * tstepB + (size_t)cur.k0 * 2;
    PG8_STAGE(PG8_SB(0, 0), cB, voffB); PG8_STAGE(PG8_SB(0, 1), cB + hstepB, voffB); PG8_STAGE(PG8_SA(0, 0), Ab, vA[0]); PG8_STAGE(PG8_SA(0, 1), Ab, vA[1]);
    if (wr == 1) PG8_BAR;
    PG8_WAIT_V(2); PG8_BAR;
    PG8_STAGE(PG8_SB(1, 0), cB + kstep, voffB); PG8_STAGE(PG8_SA(1, 0), Ab + kstep, vA[0]); PG8_STAGE(PG8_SB(1, 1), cB + hstepB + kstep, voffB);
    PG8_WAIT_V(6); PG8_BAR;
    for (;;) {
        const bool has_next = S.next(ui + 1, nxt);
        const char* nB = has_next ? (const char*)g.Bt + (size_t)nxt.pn * tstepB + (size_t)nxt.k0 * 2 : cB;
        if (has_next) { PG8_AOFFS(vN, nxt); } else { vN[0][0] = vA[0][0]; vN[0][1] = vA[0][1]; vN[1][0] = vA[1][0]; vN[1][1] = vA[1][1]; }
        for (int t = 0; t < nt; t += 2) {
            const bool last = (t == nt - 2); const bool full = cur.nv > HALF;
            const char* a1 = Ab + (size_t)(t + 1) * kstep;
            const char* a2 = Ab + (last ? (size_t)0 : (size_t)(t + 2) * kstep); const char* b2 = last ? nB : cB + (size_t)(t + 2) * kstep;
            const char* a3 = a2 + kstep; const char* b3 = b2 + kstep;
            unsigned w0[2], w1[2];
            w0[0] = last ? vN[0][0] : vA[0][0]; w0[1] = last ? vN[0][1] : vA[0][1]; w1[0] = last ? vN[1][0] : vA[1][0]; w1[1] = last ? vN[1][1] : vA[1][1];
            PG8_LDB(B0, 0, 0); PG8_LDB(B1, 0, 1); PG8_SCHED; PG8_LDA(At, 0, 0); PG8_STAGE(PG8_SA(1, 1), a1, vA[1]);
            PG8_WAIT_V(8); PG8_WAIT_L(0); PG8_BAR; PG8_MMA(0, 0, At, B0); PG8_MMA(0, 1, At, B1); PG8_BAR; PG8_SCHED;
            PG8_LDA(At, 0, 1); PG8_STAGE(PG8_SB(0, 0), b2, voffB); PG8_STAGE(PG8_SB(0, 1), b2 + hstepB, voffB); PG8_STAGE(PG8_SA(0, 0), a2, w0);
            PG8_WAIT_V(8); PG8_WAIT_L(0); PG8_BAR; if (full) { PG8_MMA(1, 0, At, B0); PG8_MMA(1, 1, At, B1); } PG8_BAR; PG8_SCHED;
            PG8_LDB(B0, 1, 0); PG8_LDB(B1, 1, 1); PG8_SCHED; PG8_LDA(At, 1, 0); PG8_STAGE(PG8_SA(0, 1), a2, w1);
            PG8_WAIT_V(8); PG8_WAIT_L(0); PG8_BAR; PG8_MMA(0, 0, At, B0); PG8_MMA(0, 1, At, B1); PG8_BAR; PG8_SCHED;
            PG8_LDA(At, 1, 1); PG8_STAGE(PG8_SB(1, 0), b3, voffB); PG8_STAGE(PG8_SB(1, 1), b3 + hstepB, voffB); PG8_STAGE(PG8_SA(1, 0), a3, w0);
            PG8_WAIT_V(8); PG8_WAIT_L(0); PG8_BAR; if (full) { PG8_MMA(1, 0, At, B0); PG8_MMA(1, 1, At, B1); } PG8_BAR; PG8_SCHED;
        }
        if (wr == 0) PG8_BAR;
        E(acc, cur, wr, wc, fr, fq);
        if (!has_next) break;
#pragma unroll
        for (int a = 0; a < 2; ++a)
#pragma unroll
            for (int b = 0; b < 2; ++b)
#pragma unroll
                for (int m = 0; m < 4; ++m)
#pragma unroll
                    for (int n = 0; n < 2; ++n) acc[a][b][m][n] = (f32x4){0.f, 0.f, 0.f, 0.f};
        cur = nxt; cB = nB; ++ui;
        vA[0][0] = vN[0][0]; vA[0][1] = vN[0][1]; vA[1][0] = vN[1][0]; vA[1][1] = vN[1][1];
        if (wr == 1) PG8_BAR;
    }
    PG8_WAIT_V(0);
    PG8_BAR;
#undef PG8_SA
#undef PG8_SB
#undef PG8_STAGE
#undef PG8_LDA
#undef PG8_LDB
#undef PG8_MMA
#undef PG8_WAIT_V
#undef PG8_WAIT_L
#undef PG8_BAR
#undef PG8_SCHED
#undef PG8_AOFFS
}
}

using pg8::Unit;
typedef f32x4 Acc[2][2][4][2];

struct EpiInProj {
    static constexpr bool PERM = true;
    bf16* P1; float* SSQ; const float2* TD; const float2* TM;
    __device__ __forceinline__ void operator()(const Acc& acc, const Unit& u, int wr, int wc, int fr, int fq) const {
        const int pm = u.pm, pn = u.pn, jt = pm % 17; const bool lat = jt > 0;
        const int row0 = pm * 256 + wr * 64 + fr, col0 = pn * 256 + wc * 32 + 8 * fq;
        if (pn == 0 || pn >= 6 || (pn == 1)) {
#pragma unroll
            for (int ai = 0; ai < 2; ++ai)
#pragma unroll
                for (int m = 0; m < 4; ++m) {
                    const int r = row0 + ai * 128 + m * 16; bf16* rowp = P1 + (size_t)r * NP1 + col0;
                    *(u32x4*)(rowp) = pack8(acc[ai][0][m][0], acc[ai][0][m][1]);
                    if (pn != 1) *(u32x4*)(rowp + 128) = pack8(acc[ai][1][m][0], acc[ai][1][m][1]);
                    if (pn <= 1) {
                        float s = 0.f;
#pragma unroll
                        for (int bj = 0; bj < 2; ++bj) { if (pn == 1 && bj == 1) break;
#pragma unroll
                            for (int n = 0; n < 2; ++n) { const f32x4 x = acc[ai][bj][m][n]; s += (x[0] * x[0] + x[1] * x[1]) + (x[2] * x[2] + x[3] * x[3]); } }
                        s += __shfl_xor(s, 16); s += __shfl_xor(s, 32);
                        if (fq == 0) SSQ[(size_t)r * 8 + pn * 4 + wc] = s;
                    }
                    if (pn == 1 && wc == 0) {
                        f32x4 x1 = acc[ai][1][m][0], x2 = acc[ai][1][m][1], o1 = x1, o2 = x2;
                        if (lat) { const int gr = (jt - 1) * 4 + 2 * ai + wr, gc = 16 * m + fr;
                            const float2* tp = TM + (fq < 2 ? gr * 8 + 4 * fq : gc * 8 + 4 * (fq - 2));
                            const f32x4 t0 = *(const f32x4*)tp, t1 = *(const f32x4*)(tp + 2);
                            const f32x4 cs = {t0[0], t0[2], t1[0], t1[2]}, sn = {t0[1], t0[3], t1[1], t1[3]};
                            o1 = x1 * cs - x2 * sn; o2 = x1 * sn + x2 * cs; }
                        *(u32x4*)(rowp + 128) = pack8(o1, o2);
                    }
                }
        } else {
            const int g = wc & 1; const float qs = pn < 4 ? 0.125f * 1.4426950408889634f : 1.f;
#pragma unroll
            for (int ai = 0; ai < 2; ++ai) {
                const int gr = (jt - 1) * 4 + 2 * ai + wr;
#pragma unroll
                for (int m = 0; m < 4; ++m) {
                    const int r = row0 + ai * 128 + m * 16; bf16* rowp = P1 + (size_t)r * NP1 + col0;
                    f32x4 cs = {1.f, 1.f, 1.f, 1.f}, sn = {0.f, 0.f, 0.f, 0.f};
                    if (lat) { const int gc = 16 * m + fr; const float2* tp = TD + (g == 0 ? gr : gc) * 16 + 4 * fq;
                        const f32x4 t0 = *(const f32x4*)tp, t1 = *(const f32x4*)(tp + 2);
                        cs = (f32x4){t0[0], t0[2], t1[0], t1[2]}; sn = (f32x4){t0[1], t0[3], t1[1], t1[3]}; }
#pragma unroll
                    for (int bj = 0; bj < 2; ++bj) { const f32x4 x1 = acc[ai][bj][m][0] * qs, x2 = acc[ai][bj][m][1] * qs;
                        *(u32x4*)(rowp + bj * 128) = pack8(x1 * cs - x2 * sn, x1 * sn + x2 * cs); }
                }
            }
        }
    }
};

struct EpiUp {
    static constexpr bool PERM = true;
    bf16* QM; bf16* KVM; const float* SSQ; const float2* TM;
    __device__ __forceinline__ void operator()(const Acc& acc, const Unit& u, int wr, int wc, int fr, int fq) const {
        const int pm = u.pm, pn = u.pn, jt = pm % 17; const bool lat = jt > 0, isq = pn < 3;
        const int row0 = pm * 256 + wr * 64 + fr, col0 = pn * 256 + wc * 32 + 8 * fq;
#pragma unroll
        for (int ai = 0; ai < 2; ++ai)
#pragma unroll
            for (int m = 0; m < 4; ++m) {
                const int r = row0 + ai * 128 + m * 16;
                const f32x4 sq = *(const f32x4*)(SSQ + (size_t)r * 8 + (isq ? 0 : 4));
                const float rs = rsqrtf(((sq[0] + sq[1]) + (sq[2] + sq[3])) * (isq ? 1.f / 256.f : 1.f / 128.f) + EPS) * (isq ? 0.10206207261596575f * 1.4426950408889634f : 1.f);
#pragma unroll
                for (int bj = 0; bj < 2; ++bj) {
                    f32x4 x1 = acc[ai][bj][m][0] * rs, x2 = acc[ai][bj][m][1] * rs;
                    if (isq) {
                        const int G = 8 * pn + 4 * bj + wc;
                        if (lat && (G % 3) == 2) { const int gr = (jt - 1) * 4 + 2 * ai + wr, gc = 16 * m + fr;
                            const float2* tp = TM + (fq < 2 ? gr * 8 + 4 * fq : gc * 8 + 4 * (fq - 2));
                            const f32x4 t0 = *(const f32x4*)tp, t1 = *(const f32x4*)(tp + 2);
                            const f32x4 cs = {t0[0], t0[2], t1[0], t1[2]}, sn = {t0[1], t0[3], t1[1], t1[3]};
                            const f32x4 o1 = x1 * cs - x2 * sn, o2 = x1 * sn + x2 * cs; x1 = o1; x2 = o2; }
                        *(u32x4*)(QM + (size_t)r * 768 + col0 + bj * 128) = pack8(x1, x2);
                    } else *(u32x4*)(KVM + (size_t)r * 1024 + (col0 - 768) + bj * 128) = pack8(x1, x2);
                }
            }
    }
};

struct EpiOut {
    static constexpr bool PERM = true;
    const float* x; const float* MOD; bf16* X1;
    __device__ __forceinline__ void operator()(const Acc& acc, const Unit& u, int wr, int wc, int fr, int fq) const {
        const int b = u.pm / 16; const float* gt = MOD + b * 6144 + 2048;
        const int row0 = u.pm * 256 + wr * 64 + fr, col0 = u.pn * 256 + wc * 32 + 8 * fq;
        f32x4 gv[2][2];
#pragma unroll
        for (int bj = 0; bj < 2; ++bj)
#pragma unroll
            for (int n = 0; n < 2; ++n) gv[bj][n] = *(const f32x4*)(gt + col0 + bj * 128 + n * 4);
#pragma unroll
        for (int ai = 0; ai < 2; ++ai)
#pragma unroll
            for (int m = 0; m < 4; ++m) { const size_t off = (size_t)(row0 + ai * 128 + m * 16) * DM + col0;
#pragma unroll
                for (int bj = 0; bj < 2; ++bj) { const f32x4 x0 = *(const f32x4*)(x + off + bj * 128), x1 = *(const f32x4*)(x + off + bj * 128 + 4);
                    *(u32x4*)(X1 + off + bj * 128) = pack8(x0 + gv[bj][0] * acc[ai][bj][m][0], x1 + gv[bj][1] * acc[ai][bj][m][1]); } }
    }
};
struct EpiF32 {
    static constexpr bool PERM = false;
    float* O; int ldc;
    __device__ __forceinline__ void operator()(const Acc& acc, const Unit& u, int wr, int wc, int fr, int fq) const {
        const int row0 = u.pm * 256 + wr * 64 + fr, col0 = u.pn * 256 + wc * 32 + 4 * fq;
#pragma unroll
        for (int ai = 0; ai < 2; ++ai)
#pragma unroll
            for (int m = 0; m < 4; ++m) { const size_t off = (size_t)(row0 + ai * 128 + m * 16) * ldc + col0;
#pragma unroll
                for (int bj = 0; bj < 2; ++bj)
#pragma unroll
                    for (int n = 0; n < 2; ++n) *(f32x4*)(O + off + bj * 128 + n * 16) = acc[ai][bj][m][n]; }
    }
};
struct EpiAct {
    static constexpr bool PERM = true;
    bf16* ACT; const float* SW;
    __device__ __forceinline__ void operator()(const Acc& acc, const Unit& u, int wr, int wc, int fr, int fq) const {
        const int half = u.pn & 1, colb = half * 128 + wc * 32 + 8 * fq;
#pragma unroll
        for (int ai = 0; ai < 2; ++ai)
#pragma unroll
            for (int m = 0; m < 4; ++m) { const int tr = ai * 128 + wr * 64 + m * 16 + fr;
                f32x4 a[2];
#pragma unroll
                for (int n = 0; n < 2; ++n) { const f32x4 gt = acc[ai][0][m][n], up = acc[ai][1][m][n];
#pragma unroll
                    for (int e = 0; e < 4; ++e) a[n][e] = gt[e] * __builtin_amdgcn_rcpf(1.f + __expf(-gt[e])) * up[e]; }
                if (tr < u.nv) { const float w = SW[u.r0 + tr]; *(u32x4*)(ACT + (size_t)(u.r0 + tr) * EFF + colb) = pack8(a[0] * w, a[1] * w); } }
    }
};
constexpr float YSCALE = 32.f;
__device__ __forceinline__ unsigned pk4_fp8(f32x4 v) { int w = 0; w = __builtin_amdgcn_cvt_pk_fp8_f32(v[0], v[1], w, false); w = __builtin_amdgcn_cvt_pk_fp8_f32(v[2], v[3], w, true); return (unsigned)w; }
struct EpiY {
    static constexpr bool PERM = true;
    unsigned char* Y;
    __device__ __forceinline__ void operator()(const Acc& acc, const Unit& u, int wr, int wc, int fr, int fq) const {
        const int colb = (u.pn & 3) * 256 + wc * 64 + 16 * fq;
#pragma unroll
        for (int ai = 0; ai < 2; ++ai)
#pragma unroll
            for (int m = 0; m < 4; ++m) { const int tr = ai * 128 + wr * 64 + m * 16 + fr;
                if (tr < u.nv) { u32x4 w; w.x = pk4_fp8(acc[ai][0][m][0] * YSCALE); w.y = pk4_fp8(acc[ai][0][m][1] * YSCALE); w.z = pk4_fp8(acc[ai][1][m][0] * YSCALE); w.w = pk4_fp8(acc[ai][1][m][1] * YSCALE);
                    *(u32x4*)(Y + (size_t)(u.r0 + tr) * DM + colb) = w; } }
    }
};

template <int SUB, bool GATHER> struct ExpSched {
    const LAS int* uc; int nmine; const int* slot_tok;
    __device__ bool next(int i, Unit& u) const {
        if (i >= nmine) return false;
        const int e = __builtin_amdgcn_readfirstlane(uc[i * 4 + 0]), r0 = __builtin_amdgcn_readfirstlane(uc[i * 4 + 1]);
        const int nv = __builtin_amdgcn_readfirstlane(uc[i * 4 + 2]), sub = __builtin_amdgcn_readfirstlane(uc[i * 4 + 3]);
        u.pm = 0; u.pn = e * SUB + sub; u.r0 = r0; u.nv = nv; u.k0 = 0; return true;
    }
    __device__ __forceinline__ int a_row(const Unit& u, int r) const {
        if (GATHER) return r < u.nv ? slot_tok[u.r0 + r] : 0;
        const int s = u.r0 + r; return s < NSLOT ? s : NSLOT - 1;
    }
};
template <int SUB> __device__ __forceinline__ int exp_units_to_lds(LAS int* uc, const int* ut, int nunit, int nfull, int G, int c) {
    const int NF = nfull * SUB, NH = (nunit - nfull) * SUB, cr = G - 1 - c, nlight = (NF % G) ? G - NF % G : 0;
    const int mf = c < NF ? (NF - 1 - c) / G + 1 : 0;
    const int h0 = (cr < nlight && cr < NH) ? 1 : 0;
    const int NH2 = NH > nlight ? NH - nlight : 0, mh = cr < NH2 ? (NH2 - 1 - cr) / G + 1 : 0;
    const int t = threadIdx.x;
    if (t < mf + h0 + mh && t < 64) { const int L = t < mf ? t * G + c : (t < mf + h0 ? NF + cr : NF + nlight + (t - mf - h0) * G + cr); const int cu = L / SUB;
        uc[t * 4 + 0] = ut[cu * 4 + 0]; uc[t * 4 + 1] = ut[cu * 4 + 1]; uc[t * 4 + 2] = ut[cu * 4 + 2]; uc[t * 4 + 3] = L % SUB; }
    __syncthreads();
    return mf + h0 + mh < 64 ? mf + h0 + mh : 64;
}
struct LatOrder : pg8::StaticOrder {
    __device__ bool next(int i, Unit& u) const { if (!pg8::StaticOrder::next(i, u)) return false; u.pm += (u.pm >> 4) + 1; u.r0 = u.pm * 256; return true; }
};
struct RouterOrder {
    int G, c;
    __device__ bool next(int i, Unit& u) const { const int L = i * G + c; if (L >= 256) return false; u.pm = L >> 2; u.pn = 0; u.r0 = u.pm * 256; u.nv = 256; u.k0 = (L & 3) * 256; return true; }
    __device__ __forceinline__ int a_row(const Unit& u, int r) const { return u.pm * 256 + r; }
};
struct UpOrder {
    int G, c;
    __device__ bool next(int i, Unit& u) const { const int L = i * G + c; if (L >= 68 * 7) return false; u.pm = L / 7; u.pn = L % 7; u.r0 = u.pm * 256; u.nv = 256; u.k0 = u.pn < 3 ? 0 : 128; return true; }
    __device__ __forceinline__ int a_row(const Unit& u, int r) const { return u.pm * 256 + r; }
};
struct EpiLogP {
    static constexpr bool PERM = false;
    float* O;
    __device__ __forceinline__ void operator()(const Acc& acc, const Unit& u, int wr, int wc, int fr, int fq) const {
        float* base = O + (size_t)(u.k0 >> 8) * MLAT * NEXP;
        const int row0 = u.pm * 256 + wr * 64 + fr, col0 = wc * 32 + 4 * fq;
#pragma unroll
        for (int ai = 0; ai < 2; ++ai)
#pragma unroll
            for (int m = 0; m < 4; ++m) { const size_t off = (size_t)(row0 + ai * 128 + m * 16) * NEXP + col0;
#pragma unroll
                for (int bj = 0; bj < 2; ++bj)
#pragma unroll
                    for (int n = 0; n < 2; ++n) *(f32x4*)(base + off + bj * 128 + n * 16) = acc[ai][bj][m][n]; }
    }
};

namespace attn {
#define SBAR() __builtin_amdgcn_sched_barrier(0)
constexpr float THR = 8.f;
template <int MODE> struct Cfg;
template <> struct Cfg<0> { static constexpr int DQK = 96, DV = 64, LDQ = 768, LDK0 = 1024, LDK1 = 2048, LDV = 1024; static constexpr float SCALE = 0.10206207261596575f; };
template <> struct Cfg<1> { static constexpr int DQK = 64, DV = 128, LDQ = 2048, LDK0 = 2048, LDK1 = 2048, LDV = 2048; static constexpr float SCALE = 0.125f; };
__device__ __forceinline__ int crow(int r, int hi) { return (r & 3) + 8 * (r >> 2) + 4 * hi; }
__device__ __forceinline__ unsigned cvtpk(float lo, float hi) { unsigned r; asm volatile("v_cvt_pk_bf16_f32 %0, %1, %2" : "=v"(r) : "v"(lo), "v"(hi)); return r; }

constexpr float THR2 = 11.5f;
__device__ __forceinline__ float max3f(float a, float b, float c) { return __builtin_fmaxf(__builtin_fmaxf(a, b), c); }
template <int ABL = 0> __device__ __forceinline__ void partialSM(f32x16& p0, f32x16& p1, float& m_reg, float& alpha, bool first) {
    float a = max3f(p0[0], p0[1], p1[0]), b = max3f(p0[2], p0[3], p1[1]); a = max3f(a, p1[2], p1[3]);
#pragma unroll
    for (int r = 4; r < 16; r += 4) { a = max3f(a, p0[r], p0[r + 1]); b = max3f(b, p0[r + 2], p0[r + 3]); a = max3f(a, p1[r], p1[r + 1]); b = max3f(b, p1[r + 2], p1[r + 3]); }
    float pmax = __builtin_fmaxf(a, b);
    if (ABL == 7) pmax = p0[0];
    { auto rr = __builtin_amdgcn_permlane32_swap(__float_as_uint(pmax), __float_as_uint(pmax), false, false);
      pmax = __builtin_fmaxf(__uint_as_float(rr[0]), __uint_as_float(rr[1])); }
    alpha = 1.f;
    if (__builtin_expect(first || __any(pmax > THR2), 0)) {
        const float dl = first ? pmax : __builtin_fmaxf(pmax, 0.f);
        m_reg += dl; alpha = first ? 1.f : __builtin_amdgcn_exp2f(-dl);
#pragma unroll
        for (int r = 0; r < 16; ++r) { p0[r] -= dl; p1[r] -= dl; }
    }
#pragma unroll
    for (int r = 0; r < 16; ++r) p0[r] = ABL == 1 ? p0[r] * 0.5f : __builtin_amdgcn_exp2f(p0[r]);
}
template <int ABL = 0> __device__ __forceinline__ void finishSM(f32x16& p0, f32x16& p1, float alpha, float& l_reg, bf16x8& pa0, bf16x8& pa1, bf16x8& pa2, bf16x8& pa3) {
#pragma unroll
    for (int r = 0; r < 16; ++r) p1[r] = ABL == 1 ? p1[r] * 0.5f : __builtin_amdgcn_exp2f(p1[r]);
    float ps = 0;
    if (ABL == 2) ps = p0[0] + p1[15]; else {
        float s0 = p0[0] + p0[4], s1 = p0[1] + p0[5], s2 = p0[2] + p0[6], s3 = p0[3] + p0[7];
        s0 += p0[8]; s1 += p0[9]; s2 += p0[10]; s3 += p0[11]; s0 += p0[12]; s1 += p0[13]; s2 += p0[14]; s3 += p0[15];
#pragma unroll
        for (int r = 0; r < 16; r += 4) { s0 += p1[r]; s1 += p1[r + 1]; s2 += p1[r + 2]; s3 += p1[r + 3]; }
        ps = (s0 + s1) + (s2 + s3); }
    { auto rr = __builtin_amdgcn_permlane32_swap(__float_as_uint(ps), __float_as_uint(ps), false, false);
      ps = __uint_as_float(rr[0]) + __uint_as_float(rr[1]); }
    l_reg = l_reg * alpha + ps;
#define PK4(P, BASE, OUT) do { u32x4 w = {cvtpk(P[BASE + 0], P[BASE + 1]), cvtpk(P[BASE + 2], P[BASE + 3]), cvtpk(P[BASE + 4], P[BASE + 5]), cvtpk(P[BASE + 6], P[BASE + 7])}; OUT = *reinterpret_cast<bf16x8*>(&w); } while (0)
    PK4(p0, 0, pa0); PK4(p0, 8, pa1); PK4(p1, 0, pa2); PK4(p1, 8, pa3);
#undef PK4
}
template <int NQ, int KROW, int ABL = 0> __device__ __forceinline__ void qkt(f32x16& p0, f32x16& p1, const LAS char* Ks, const bf16x8* qr, float m_ref, int r32, int hi) {
    f32x16 negm;
#pragma unroll
    for (int r = 0; r < 16; ++r) negm[r] = -m_ref;
    p0 = negm; p1 = negm;
#pragma unroll
    for (int d0 = 0; d0 < NQ; ++d0) { const int cb = d0 * 32 + hi * 16;
        const bf16x8 b0 = *(const LAS bf16x8*)(Ks + r32 * KROW + cb);
        const bf16x8 b1 = *(const LAS bf16x8*)(Ks + (32 + r32) * KROW + cb);
        if (ABL == 4) { asm volatile("" :: "v"(b0), "v"(b1)); } else {
        p0 = __builtin_amdgcn_mfma_f32_32x32x16_bf16(b0, qr[d0], p0, 0, 0, 0);
        p1 = __builtin_amdgcn_mfma_f32_32x32x16_bf16(b1, qr[d0], p1, 0, 0, 0); } }
}
template <int NC> __device__ __forceinline__ int v_st(int k, int c) { const int kk = k; return ((kk >> 3) * NC + (c >> 5)) * 512 + ((kk & 7) * 32 + (c & 31)) * 2; }
__device__ __forceinline__ int v_rd_base(int lane) { return ((lane & 3) << 3) | (((lane >> 2) & 3) << 6) | (((lane >> 4) & 1) << 5) | (((lane >> 5) & 1) << 8); }
template <int OFF> __device__ __forceinline__ s16x4 tr_read(int vb) {
    s16x4 r; asm volatile("ds_read_b64_tr_b16 %0, %1 offset:%2" : "=&v"(r) : "v"(vb), "i"(OFF) : "memory"); return r;
}
template <int NC, int D0, int ABL = 0> __device__ __forceinline__ void pv_one(f32x16& od, int vb, bf16x8 pa0, bf16x8 pa1, bf16x8 pa2, bf16x8 pa3) {
#define VOFF(ks, half) (D0 * 512 + (ks) * (NC * 1024) + (half) * (NC * 512))
    const s16x4 l0 = tr_read<VOFF(0, 0)>(vb), h0 = tr_read<VOFF(0, 1)>(vb), l1 = tr_read<VOFF(1, 0)>(vb), h1 = tr_read<VOFF(1, 1)>(vb);
    const s16x4 l2 = tr_read<VOFF(2, 0)>(vb), h2 = tr_read<VOFF(2, 1)>(vb), l3 = tr_read<VOFF(3, 0)>(vb), h3 = tr_read<VOFF(3, 1)>(vb);
#undef VOFF
    asm volatile("s_waitcnt lgkmcnt(0)" ::: "memory"); SBAR();
#define PK(L, H) (bf16x8){L[0], L[1], L[2], L[3], H[0], H[1], H[2], H[3]}
    if (ABL == 3) { asm volatile("" :: "v"(l0), "v"(h0), "v"(l1), "v"(h1), "v"(l2), "v"(h2), "v"(l3), "v"(h3)); return; }
    od = __builtin_amdgcn_mfma_f32_32x32x16_bf16(pa0, PK(l0, h0), od, 0, 0, 0);
    od = __builtin_amdgcn_mfma_f32_32x32x16_bf16(pa1, PK(l1, h1), od, 0, 0, 0);
    od = __builtin_amdgcn_mfma_f32_32x32x16_bf16(pa2, PK(l2, h2), od, 0, 0, 0);
    od = __builtin_amdgcn_mfma_f32_32x32x16_bf16(pa3, PK(l3, h3), od, 0, 0, 0);
#undef PK
}
template <int NC, int ABL = 0> __device__ __forceinline__ void pv_all(f32x16* o, int vb, bf16x8 pa0, bf16x8 pa1, bf16x8 pa2, bf16x8 pa3) {
    pv_one<NC, 0, ABL>(o[0], vb, pa0, pa1, pa2, pa3); pv_one<NC, 1, ABL>(o[1], vb, pa0, pa1, pa2, pa3);
    if constexpr (NC == 4) { pv_one<NC, 2, ABL>(o[2], vb, pa0, pa1, pa2, pa3); pv_one<NC, 3, ABL>(o[3], vb, pa0, pa1, pa2, pa3); }
}
template <int MODE> constexpr int lds_bytes() { return 4 * (64 * Cfg<MODE>::DV * 2 + 2 * (Cfg<MODE>::DQK / 16) * 1024) + 8 * 64 * 4; }

template <int MODE, int EPI, int ABL = 0>
__device__ __forceinline__ void unit_regs(const bf16* __restrict__ Qb, const bf16* __restrict__ K0, const bf16* __restrict__ K1, const bf16* __restrict__ Vh, void* Ob, int ldo, LAS char* lds, char* stash, float lam, const float* gsub) {
    using C = Cfg<MODE>;
    constexpr int DQK = C::DQK, DV = C::DV, NQ = DQK / 16, NC = DV / 32, KROW = DQK * 2 + 16, SHM_K = 64 * KROW, SHM_V = 64 * DV * 2;
    const int tid = threadIdx.x, wid = tid >> 6, lane = tid & 63, r32 = lane & 31, hi = lane >> 5;
    LAS char* V_lds = lds; LAS char* K_lds = lds + 3 * SHM_V;
    LAS float* ws = (LAS float*)(lds + 3 * SHM_V + 3 * SHM_K) + wid * 64; LAS float* li_l = ws; LAS float* al_l = ws + 32;
    float m_reg = 0.f, l_reg = 0; f32x16 o[NC]; bf16x8 qr[NQ];
#pragma unroll
    for (int d = 0; d < NC; ++d) o[d] = f32x16{};
    const bf16* Qw = Qb + (size_t)(wid * 32 + r32) * C::LDQ + hi * 8;
#pragma unroll
    for (int d0 = 0; d0 < NQ; ++d0) qr[d0] = *reinterpret_cast<const bf16x8*>(Qw + d0 * 16);
    const int vb0 = (int)(uintptr_t)V_lds + v_rd_base(lane);
    const int kr0 = tid >> 3, kc0 = tid & 7;
    const int krr = (tid & 255) >> 2, krc = tid & 3;
    const int vr0 = MODE == 0 ? (tid >> 3) : (tid >> 4), vc0 = MODE == 0 ? (tid & 7) * 8 : (tid & 15) * 8;
    const int vst0 = v_st<NC>(vr0, vc0), vst1 = v_st<NC>(32 + vr0, vc0);
    constexpr int NSET = MODE == 0 ? 2 : 1;
    struct { bf16x8 ka, kb, va, vb; } sr_[NSET];
#define SLOAD(i, k0) do { sr_[i].ka = *reinterpret_cast<const bf16x8*>(K0 + (size_t)((k0) + kr0) * C::LDK0 + kc0 * 8); \
        if (MODE == 0) { sr_[i].kb = *reinterpret_cast<const bf16x8*>(K1 + (size_t)((k0) + krr) * C::LDK1 + krc * 8); } \
        sr_[i].va = *reinterpret_cast<const bf16x8*>(Vh + (size_t)((k0) + vr0) * C::LDV + vc0); \
        if (MODE == 1) { sr_[i].vb = *reinterpret_cast<const bf16x8*>(Vh + (size_t)((k0) + 32 + vr0) * C::LDV + vc0); } } while (0)
#define SWRITE(ko, vo, i) do { *(LAS bf16x8*)(K_lds + (ko) + kr0 * KROW + kc0 * 16) = sr_[i].ka; \
        if (MODE == 0) { *(LAS bf16x8*)(K_lds + (ko) + krr * KROW + 128 + krc * 16) = sr_[i].kb; } \
        *(LAS bf16x8*)(V_lds + (vo) + vst0) = sr_[i].va; \
        if (MODE == 1) { *(LAS bf16x8*)(V_lds + (vo) + vst1) = sr_[i].vb; } } while (0)
#define SWAIT() do { if (NSET == 2) asm volatile("s_waitcnt vmcnt(3)" ::: "memory"); } while (0)
#define RESC(a) do { if (__any((a) < 1.f)) { if (hi == 0) al_l[r32] = (a); asm volatile("s_waitcnt lgkmcnt(0)" ::: "memory"); \
        _Pragma("unroll") for (int d = 0; d < NC; ++d) _Pragma("unroll") for (int r = 0; r < 16; ++r) o[d][r] *= al_l[crow(r, hi)]; } } while (0)
    f32x16 pA0, pA1, pB0, pB1; float alA = 1.f, alB = 1.f; bf16x8 pa0, pa1, pa2, pa3; constexpr int NT = NTOK / 64;
#define STEP(PC0, PC1, ALC, PP0, PP1, ALP, jj, SQ, SV, SW) do { constexpr int SETN = ((jj##_c) + 1) % NSET; \
        if (ABL != 6 && (jj) + 1 < NT) { SWAIT(); SWRITE((SW) * SHM_K, (SW) * SHM_V, SETN); } \
        SBAR(); qkt<NQ, KROW, ABL>(PC0, PC1, K_lds + (SQ) * SHM_K, qr, m_reg, r32, hi); \
        finishSM<ABL>(PP0, PP1, ALP, l_reg, pa0, pa1, pa2, pa3); SBAR(); \
        if (ABL != 6 && (jj) + 1 + NSET < NT) SLOAD(SETN, ((jj) + 1 + NSET) * 64); SBAR(); \
        pv_all<NC, ABL>(o, vb0 + (SV) * SHM_V, pa0, pa1, pa2, pa3); partialSM<ABL>(PC0, PC1, m_reg, ALC, false); \
        RESC(ALC); if (ABL != 5) __syncthreads(); } while (0)
    static_assert((NT - 2) % 6 == 0, "tile count: steps 1..NT-2 in groups of 6");
    SLOAD(0, 0); asm volatile("s_waitcnt vmcnt(0)" ::: "memory"); SWRITE(0, 0, 0);
    SLOAD(1 % NSET, 64); if (NSET == 2) SLOAD(0, 128); __syncthreads();
    SWAIT(); SWRITE(SHM_K, SHM_V, 1 % NSET);
    qkt<NQ, KROW>(pA0, pA1, K_lds, qr, m_reg, r32, hi);
    SLOAD(1 % NSET, (1 + NSET) * 64);
    partialSM(pA0, pA1, m_reg, alA, true);
    __syncthreads();
    for (int j = 1; j + 1 < NT; j += 6) {
        constexpr int j_c = 1, j1_c = 2, j2_c = 3, j3_c = 4, j4_c = 5, j5_c = 6; const int j1 = j + 1, j2 = j + 2, j3 = j + 3, j4 = j + 4, j5 = j + 5;
        STEP(pB0, pB1, alB, pA0, pA1, alA, j,  1, 0, 2);
        STEP(pA0, pA1, alA, pB0, pB1, alB, j1, 2, 1, 0);
        STEP(pB0, pB1, alB, pA0, pA1, alA, j2, 0, 2, 1);
        STEP(pA0, pA1, alA, pB0, pB1, alB, j3, 1, 0, 2);
        STEP(pB0, pB1, alB, pA0, pA1, alA, j4, 2, 1, 0);
        STEP(pA0, pA1, alA, pB0, pB1, alB, j5, 0, 2, 1);
    }
    { constexpr int jt_c = NT - 1; const int jt = NT - 1;
      STEP(pB0, pB1, alB, pA0, pA1, alA, jt, (NT - 1) % 3, (NT - 2) % 3, NT % 3); }
    finishSM(pB0, pB1, alB, l_reg, pa0, pa1, pa2, pa3); SBAR();
    pv_all<NC>(o, vb0 + ((NT - 1) % 3) * SHM_V, pa0, pa1, pa2, pa3);
#undef STEP
    if (hi == 0) li_l[r32] = l_reg; asm volatile("s_waitcnt lgkmcnt(0)" ::: "memory");
    float rli[16];
#pragma unroll
    for (int r = 0; r < 16; ++r) rli[r] = __builtin_amdgcn_rcpf(li_l[crow(r, hi)]);
    asm volatile("" : "+s"(ldo), "+s"(stash), "+s"(gsub), "+s"(Ob));
    if constexpr (MODE == 0) {
#pragma unroll
        for (int r = 0; r < 16; ++r) { const int orow = wid * 32 + crow(r, hi);
#pragma unroll
            for (int d0 = 0; d0 < NC; ++d0) ((bf16*)Ob)[(size_t)orow * ldo + d0 * 32 + r32] = (bf16)f2bf(o[d0][r] * rli[r]); }
    } else if constexpr (EPI == 1) {
        char* st = stash + wid * 8192 + lane * 16;
#pragma unroll
        for (int d0 = 0; d0 < NC; ++d0)
#pragma unroll
            for (int q = 0; q < 2; ++q) { u32x4 w;
                w.x = cvtpk(o[d0][8 * q + 0] * rli[8 * q + 0], o[d0][8 * q + 1] * rli[8 * q + 1]); w.y = cvtpk(o[d0][8 * q + 2] * rli[8 * q + 2], o[d0][8 * q + 3] * rli[8 * q + 3]);
                w.z = cvtpk(o[d0][8 * q + 4] * rli[8 * q + 4], o[d0][8 * q + 5] * rli[8 * q + 5]); w.w = cvtpk(o[d0][8 * q + 6] * rli[8 * q + 6], o[d0][8 * q + 7] * rli[8 * q + 7]);
                *(u32x4*)(st + (d0 * 2 + q) * 1024) = w; }
        asm volatile("s_waitcnt vmcnt(0)" ::: "memory");
    } else {
        const char* st = stash + wid * 8192 + lane * 16;
#pragma unroll
        for (int d0 = 0; d0 < NC; ++d0) {
            const u32x4 wa = *(const u32x4*)(st + (d0 * 2 + 0) * 1024), wb = *(const u32x4*)(st + (d0 * 2 + 1) * 1024);
            f32x16 od;
            od[0] = __builtin_bit_cast(float, wa.x << 16); od[1] = __builtin_bit_cast(float, wa.x & 0xffff0000u); od[2] = __builtin_bit_cast(float, wa.y << 16); od[3] = __builtin_bit_cast(float, wa.y & 0xffff0000u);
            od[4] = __builtin_bit_cast(float, wa.z << 16); od[5] = __builtin_bit_cast(float, wa.z & 0xffff0000u); od[6] = __builtin_bit_cast(float, wa.w << 16); od[7] = __builtin_bit_cast(float, wa.w & 0xffff0000u);
            od[8] = __builtin_bit_cast(float, wb.x << 16); od[9] = __builtin_bit_cast(float, wb.x & 0xffff0000u); od[10] = __builtin_bit_cast(float, wb.y << 16); od[11] = __builtin_bit_cast(float, wb.y & 0xffff0000u);
            od[12] = __builtin_bit_cast(float, wb.z << 16); od[13] = __builtin_bit_cast(float, wb.z & 0xffff0000u); od[14] = __builtin_bit_cast(float, wb.w << 16); od[15] = __builtin_bit_cast(float, wb.w & 0xffff0000u);
#pragma unroll
            for (int r = 0; r < 16; ++r) od[r] -= lam * (o[d0][r] * rli[r]);
            o[d0] = od;
        }
        f32x16 ssv;
#pragma unroll
        for (int r = 0; r < 16; ++r) { float x = 0.f;
#pragma unroll
            for (int d0 = 0; d0 < NC; ++d0) x += o[d0][r] * o[d0][r];
            x += __builtin_bit_cast(float, __builtin_amdgcn_update_dpp(0, __builtin_bit_cast(int, x), 0x111, 0xf, 0xf, false));
            x += __builtin_bit_cast(float, __builtin_amdgcn_update_dpp(0, __builtin_bit_cast(int, x), 0x112, 0xf, 0xf, false));
            x += __builtin_bit_cast(float, __builtin_amdgcn_update_dpp(0, __builtin_bit_cast(int, x), 0x114, 0xf, 0xf, false));
            x += __builtin_bit_cast(float, __builtin_amdgcn_update_dpp(0, __builtin_bit_cast(int, x), 0x118, 0xf, 0xf, false));
            x += __builtin_bit_cast(float, __builtin_amdgcn_update_dpp(0, __builtin_bit_cast(int, x), 0x142, 0xa, 0xf, false));
            const float t0 = __builtin_bit_cast(float, __builtin_amdgcn_readlane(__builtin_bit_cast(int, x), 31)), t1 = __builtin_bit_cast(float, __builtin_amdgcn_readlane(__builtin_bit_cast(int, x), 63));
            ssv[r] = rsqrtf((hi ? t1 : t0) * (1.f / 128.f) + EPS) * (1.f - LAM_INIT); }
#pragma unroll
        for (int d0 = 0; d0 < NC; ++d0) { const float g = gsub[d0 * 32 + r32];
#pragma unroll
            for (int r = 0; r < 16; ++r) { const int orow = wid * 32 + crow(r, hi); ((bf16*)Ob)[(size_t)orow * ldo + d0 * 32 + r32] = (bf16)f2bf(o[d0][r] * ssv[r] * g); } }
    }
    __syncthreads();
#undef SLOAD
#undef SWRITE
#undef SWAIT
#undef RESC
}

template <int NQ, int ABL = 0> __device__ __forceinline__ void qkt_c(f32x16& p0, f32x16& p1, const LAS char* Ks, const bf16x8* qr, float m_ref, int r32, int hi) {
    f32x16 negm;
#pragma unroll
    for (int r = 0; r < 16; ++r) negm[r] = -m_ref;
    p0 = negm; p1 = negm;
#pragma unroll
    for (int d0 = 0; d0 < NQ; ++d0) { const LAS char* kp = Ks + (2 * d0 + hi) * 1024 + r32 * 16;
        const bf16x8 b0 = *(const LAS bf16x8*)kp, b1 = *(const LAS bf16x8*)(kp + 512);
        p0 = __builtin_amdgcn_mfma_f32_32x32x16_bf16(b0, qr[d0], p0, 0, 0, 0);
        p1 = __builtin_amdgcn_mfma_f32_32x32x16_bf16(b1, qr[d0], p1, 0, 0, 0); }
}
template <int MODE, int EPI, int ABL = 0>
__device__ __forceinline__ void unit(const bf16* __restrict__ Qb, const bf16* __restrict__ K0, const bf16* __restrict__ K1, const bf16* __restrict__ Vh, void* Ob, int ldo, LAS char* lds, char* stash, float lam, const float* gsub) {
    using C = Cfg<MODE>;
    constexpr int DQK = C::DQK, DV = C::DV, NQ = DQK / 16, NC = DV / 32, KS = 2 * NQ * 1024, VS = 64 * DV * 2, NT = NTOK / 64;
    const int tid = threadIdx.x, lane = tid & 63, r32 = lane & 31, hi = lane >> 5; const int wid = __builtin_amdgcn_readfirstlane(tid >> 6);
    LAS char* K_lds = lds; LAS char* V_lds = lds + 4 * KS;
    LAS float* ws = (LAS float*)(lds + 4 * KS + 4 * VS) + wid * 64; LAS float* li_l = ws; LAS float* al_l = ws + 32;
    const bf16* ksA = K0 + (size_t)lane * C::LDK0 + wid * 8;
    const bf16* ksB = MODE == 0 ? K1 + (size_t)lane * C::LDK1 + (wid & 3) * 8 : nullptr;
    auto vsrc = [&](int p) -> const bf16* { const int st = 2 * p + (lane >> 5), k8 = st / NC, cb = st % NC; return Vh + (size_t)(k8 * 8 + ((lane >> 2) & 7)) * C::LDV + cb * 32 + (lane & 3) * 8; };
    const bf16* vsA = vsrc(wid); const bf16* vsB = MODE == 1 ? vsrc(wid + 8) : nullptr;
#define GLDS(src, dst) __builtin_amdgcn_global_load_lds((const unsigned*)(src), (LAS unsigned*)(dst), 16, 0, 0)
#define DMA(t, sl) do { GLDS(ksA + (size_t)(t) * 64 * C::LDK0, K_lds + (sl) * KS + wid * 1024); \
        if (MODE == 0) GLDS(ksB + (size_t)(t) * 64 * C::LDK1, K_lds + (sl) * KS + (8 + (wid & 3)) * 1024); \
        GLDS(vsA + (size_t)(t) * 64 * C::LDV, V_lds + (sl) * VS + wid * 1024); \
        if (MODE == 1) GLDS(vsB + (size_t)(t) * 64 * C::LDV, V_lds + (sl) * VS + (wid + 8) * 1024); } while (0)
#define WAIT_BAR(N) asm volatile("s_waitcnt vmcnt(" #N ") lgkmcnt(0)\n\ts_barrier" ::: "memory")
#define RESC(a) do { if (__any((a) < 1.f)) { if (hi == 0) al_l[r32] = (a); asm volatile("s_waitcnt lgkmcnt(0)" ::: "memory"); \
        _Pragma("unroll") for (int d = 0; d < NC; ++d) _Pragma("unroll") for (int r = 0; r < 16; ++r) o[d][r] *= al_l[crow(r, hi)]; } } while (0)
    DMA(0, 0); DMA(1, 1);
    float m_reg = 0.f, l_reg = 0; f32x16 o[NC]; bf16x8 qr[NQ];
#pragma unroll
    for (int d = 0; d < NC; ++d) o[d] = f32x16{};
    const bf16* Qw = Qb + (size_t)(wid * 32 + r32) * C::LDQ + hi * 8;
#pragma unroll
    for (int d0 = 0; d0 < NQ; ++d0) qr[d0] = *reinterpret_cast<const bf16x8*>(Qw + d0 * 16);
    const int vb0 = (int)(uintptr_t)V_lds + v_rd_base(lane);
    f32x16 pA0, pA1, pB0, pB1; float alA = 1.f, alB = 1.f; bf16x8 pa0, pa1, pa2, pa3;
    WAIT_BAR(0);
#define STEPD(PC0, PC1, ALC, PP0, PP1, ALP, jj, SQ, SV, SW, ISSUE, NW) do { \
        if (ISSUE) DMA((jj) + 2, SW); \
        SBAR(); qkt_c<NQ, ABL>(PC0, PC1, K_lds + (SQ) * KS, qr, m_reg, r32, hi); \
        finishSM<ABL>(PP0, PP1, ALP, l_reg, pa0, pa1, pa2, pa3); SBAR(); \
        pv_all<NC, ABL>(o, vb0 + (SV) * VS, pa0, pa1, pa2, pa3); partialSM<ABL>(PC0, PC1, m_reg, ALC, false); \
        RESC(ALC); if ((NW) == 3) WAIT_BAR(3); else WAIT_BAR(0); } while (0)
    static_assert(NT == 68, "tile schedule below: steps 1..64 in groups of 4, then 65, 66, 67");
    DMA(2, 2); qkt_c<NQ, ABL>(pA0, pA1, K_lds, qr, m_reg, r32, hi); partialSM<ABL>(pA0, pA1, m_reg, alA, true); WAIT_BAR(3);
    for (int j = 1; j < 65; j += 4) {
        STEPD(pB0, pB1, alB, pA0, pA1, alA, j,     1, 0, 3, true, 3);
        STEPD(pA0, pA1, alA, pB0, pB1, alB, j + 1, 2, 1, 0, true, 3);
        STEPD(pB0, pB1, alB, pA0, pA1, alA, j + 2, 3, 2, 1, true, 3);
        STEPD(pA0, pA1, alA, pB0, pB1, alB, j + 3, 0, 3, 2, true, 3);
    }
    STEPD(pB0, pB1, alB, pA0, pA1, alA, 65, 1, 0, 3, true, 3);
    STEPD(pA0, pA1, alA, pB0, pB1, alB, 66, 2, 1, 0, false, 0);
    STEPD(pB0, pB1, alB, pA0, pA1, alA, 67, 3, 2, 1, false, 0);
    finishSM<ABL>(pB0, pB1, alB, l_reg, pa0, pa1, pa2, pa3); SBAR();
    pv_all<NC, ABL>(o, vb0 + 3 * VS, pa0, pa1, pa2, pa3);
#undef STEPD
    if (hi == 0) li_l[r32] = l_reg; asm volatile("s_waitcnt lgkmcnt(0)" ::: "memory");
    float rli[16];
#pragma unroll
    for (int r = 0; r < 16; ++r) rli[r] = __builtin_amdgcn_rcpf(li_l[crow(r, hi)]);
    asm volatile("" : "+s"(ldo), "+s"(stash), "+s"(gsub), "+s"(Ob));
    if constexpr (MODE == 0) {
#pragma unroll
        for (int r = 0; r < 16; ++r) { const int orow = wid * 32 + crow(r, hi);
#pragma unroll
            for (int d0 = 0; d0 < NC; ++d0) ((bf16*)Ob)[(size_t)orow * ldo + d0 * 32 + r32] = (bf16)f2bf(o[d0][r] * rli[r]); }
    } else if constexpr (EPI == 1) {
        char* st = stash + wid * 8192 + lane * 16;
#pragma unroll
        for (int d0 = 0; d0 < NC; ++d0)
#pragma unroll
            for (int q = 0; q < 2; ++q) { u32x4 w;
                w.x = cvtpk(o[d0][8 * q + 0] * rli[8 * q + 0], o[d0][8 * q + 1] * rli[8 * q + 1]); w.y = cvtpk(o[d0][8 * q + 2] * rli[8 * q + 2], o[d0][8 * q + 3] * rli[8 * q + 3]);
                w.z = cvtpk(o[d0][8 * q + 4] * rli[8 * q + 4], o[d0][8 * q + 5] * rli[8 * q + 5]); w.w = cvtpk(o[d0][8 * q + 6] * rli[8 * q + 6], o[d0][8 * q + 7] * rli[8 * q + 7]);
                *(u32x4*)(st + (d0 * 2 + q) * 1024) = w; }
        asm volatile("s_waitcnt vmcnt(0)" ::: "memory");
    } else {
        const char* st = stash + wid * 8192 + lane * 16;
#pragma unroll
        for (int d0 = 0; d0 < NC; ++d0) {
            const u32x4 wa = *(const u32x4*)(st + (d0 * 2 + 0) * 1024), wb = *(const u32x4*)(st + (d0 * 2 + 1) * 1024);
            f32x16 od;
            od[0] = __builtin_bit_cast(float, wa.x << 16); od[1] = __builtin_bit_cast(float, wa.x & 0xffff0000u); od[2] = __builtin_bit_cast(float, wa.y << 16); od[3] = __builtin_bit_cast(float, wa.y & 0xffff0000u);
            od[4] = __builtin_bit_cast(float, wa.z << 16); od[5] = __builtin_bit_cast(float, wa.z & 0xffff0000u); od[6] = __builtin_bit_cast(float, wa.w << 16); od[7] = __builtin_bit_cast(float, wa.w & 0xffff0000u);
            od[8] = __builtin_bit_cast(float, wb.x << 16); od[9] = __builtin_bit_cast(float, wb.x & 0xffff0000u); od[10] = __builtin_bit_cast(float, wb.y << 16); od[11] = __builtin_bit_cast(float, wb.y & 0xffff0000u);
            od[12] = __builtin_bit_cast(float, wb.z << 16); od[13] = __builtin_bit_cast(float, wb.z & 0xffff0000u); od[14] = __builtin_bit_cast(float, wb.w << 16); od[15] = __builtin_bit_cast(float, wb.w & 0xffff0000u);
#pragma unroll
            for (int r = 0; r < 16; ++r) od[r] -= lam * (o[d0][r] * rli[r]);
            o[d0] = od;
        }
        f32x16 ssv;
#pragma unroll
        for (int r = 0; r < 16; ++r) { float x = 0.f;
#pragma unroll
            for (int d0 = 0; d0 < NC; ++d0) x += o[d0][r] * o[d0][r];
            x += __builtin_bit_cast(float, __builtin_amdgcn_update_dpp(0, __builtin_bit_cast(int, x), 0x111, 0xf, 0xf, false));
            x += __builtin_bit_cast(float, __builtin_amdgcn_update_dpp(0, __builtin_bit_cast(int, x), 0x112, 0xf, 0xf, false));
            x += __builtin_bit_cast(float, __builtin_amdgcn_update_dpp(0, __builtin_bit_cast(int, x), 0x114, 0xf, 0xf, false));
            x += __builtin_bit_cast(float, __builtin_amdgcn_update_dpp(0, __builtin_bit_cast(int, x), 0x118, 0xf, 0xf, false));
            x += __builtin_bit_cast(float, __builtin_amdgcn_update_dpp(0, __builtin_bit_cast(int, x), 0x142, 0xa, 0xf, false));
            const float t0 = __builtin_bit_cast(float, __builtin_amdgcn_readlane(__builtin_bit_cast(int, x), 31)), t1 = __builtin_bit_cast(float, __builtin_amdgcn_readlane(__builtin_bit_cast(int, x), 63));
            ssv[r] = rsqrtf((hi ? t1 : t0) * (1.f / 128.f) + EPS) * (1.f - LAM_INIT); }
#pragma unroll
        for (int d0 = 0; d0 < NC; ++d0) { const float g = gsub[d0 * 32 + r32];
#pragma unroll
            for (int r = 0; r < 16; ++r) { const int orow = wid * 32 + crow(r, hi); ((bf16*)Ob)[(size_t)orow * ldo + d0 * 32 + r32] = (bf16)f2bf(o[d0][r] * ssv[r] * g); } }
    }
    __syncthreads();
#undef GLDS
#undef DMA
#undef WAIT_BAR
#undef RESC
}

#undef SBAR
}

#define XB_TMO      128
#define XB_XCNT(j)  (256  + 64 * (j))
#define XB_XSUB(j)  (1280 + 64 * (j))
#define XB_XGEN(j)  (2304 + 64 * (j))
#define XB_TOP      3328
#define XB_TOPGEN   3392
#define XCD_BAR_WORDS 3456
#define XB_SPIN_CAP (1u << 20)
__device__ __forceinline__ unsigned xb_ld(unsigned* p)              { return __hip_atomic_load(p, __ATOMIC_RELAXED, __HIP_MEMORY_SCOPE_AGENT); }
__device__ __forceinline__ unsigned xb_add(unsigned* p, unsigned v) { return __hip_atomic_fetch_add(p, v, __ATOMIC_RELAXED, __HIP_MEMORY_SCOPE_AGENT); }
__device__ __forceinline__ unsigned xb_xcc_id() { return (unsigned)__builtin_amdgcn_s_getreg((3 << 11) | 20) & 0xFu; }
#define XB_SPIN(cond, bar) do { unsigned _sp = 0; while (cond) { __builtin_amdgcn_s_sleep(1); \
    if ((++_sp & 255u) == 0u) { if (xb_ld(&(bar)[XB_TMO])) break; if (_sp > XB_SPIN_CAP) { atomicAdd(&(bar)[XB_TMO], 1u); break; } } } } while (0)
struct XcdBarrier { unsigned* bar; unsigned x; volatile LAS unsigned* st; };
__device__ __forceinline__ XcdBarrier xcd_barrier_post(unsigned* bar, volatile LAS unsigned* st) {
    XcdBarrier b; b.bar = bar; b.x = xb_xcc_id(); b.st = st;
    if (threadIdx.x == 0) (void)xb_add(&bar[XB_XCNT(b.x)], 1u);
    return b;
}
__device__ __forceinline__ void xcd_barrier_complete(unsigned* bar, unsigned x, unsigned& nloc, unsigned& nx) {
    const unsigned G = gridDim.x * gridDim.y * gridDim.z;
    unsigned sum, cnt, mine, sp = 0u;
    for (;;) {
        sum = 0u; cnt = 0u; mine = 0u;
#pragma unroll
        for (unsigned j = 0; j < 16; ++j) { const unsigned c = xb_ld(&bar[XB_XCNT(j)]); sum += c; cnt += (c > 0u) ? 1u : 0u; mine = (j == x) ? c : mine; }
        if (sum == G) break;
        __builtin_amdgcn_s_sleep(1);
        if ((++sp & 255u) == 0u) { if (xb_ld(&bar[XB_TMO])) break; if (sp > XB_SPIN_CAP) { atomicAdd(&bar[XB_TMO], 1u); break; } }
    }
    nloc = mine > 0u ? mine : 1u; nx = cnt > 0u ? cnt : 1u;
}
__device__ __forceinline__ void xcd_barrier(const XcdBarrier& b) {
    asm volatile("s_waitcnt vmcnt(0)" ::: "memory");
    __syncthreads();
    if (threadIdx.x == 0) {
        unsigned* bar = b.bar;
        __builtin_amdgcn_s_waitcnt(0);
        unsigned nloc = b.st[0], nx = b.st[1];
        if (nloc == 0u) { xcd_barrier_complete(bar, b.x, nloc, nx); b.st[0] = nloc; b.st[1] = nx; }
        const unsigned old = xb_add(&bar[XB_XSUB(b.x)], 1u);
        const unsigned gen = old / nloc;
        if (old + 1u == (gen + 1u) * nloc) {
            __builtin_amdgcn_fence(__ATOMIC_RELEASE, "agent");
            asm volatile("s_waitcnt vmcnt(0)" ::: "memory");
            const unsigned og = xb_add(&bar[XB_TOP], 1u);
            const unsigned tg = og / nx;
            if (og + 1u == (tg + 1u) * nx) xb_add(&bar[XB_TOPGEN], 1u);
            else XB_SPIN(xb_ld(&bar[XB_TOPGEN]) == tg, bar);
            __builtin_amdgcn_fence(__ATOMIC_ACQUIRE, "agent");
            xb_add(&bar[XB_XGEN(b.x)], 1u);
            asm volatile("s_waitcnt vmcnt(0)" ::: "memory");
        } else {
            XB_SPIN(xb_ld(&bar[XB_XGEN(b.x)]) == gen, bar);
            __builtin_amdgcn_fence(__ATOMIC_ACQUIRE, "agent");
            asm volatile("s_waitcnt vmcnt(0)" ::: "memory");
        }
    }
    __syncthreads();
}

constexpr int NWAVES = 8;
constexpr int RING_BYTES = 131072, LDS_BYTES = 147456, LDSCTL_OFF = LDS_BYTES - 2048, MISC_OFF = LDSCTL_OFF + 320, UCACHE_OFF = LDSCTL_OFF + 1024  ;

struct Frame {
    LAS unsigned char* lds; volatile LAS unsigned* MISC; unsigned* ctl;
    int tid, lane, wave, vcu, G;
    Ptrs P;
    __device__ __forceinline__ LAS char* lds_c() const { return (LAS char*)lds; }
};

template <class SrcF> __device__ __forceinline__ void transpose_item(const SrcF& f, int K, bf16* WT, int p0, int k0, LAS float* scr, int lane) {
    float t[32];
#pragma unroll
    for (int i = 0; i < 32; ++i) t[i] = f(k0 + 2 * i + (lane >> 5), p0 + (lane & 31));
#pragma unroll
    for (int i = 0; i < 32; ++i) scr[(2 * i + (lane >> 5)) * 33 + (lane & 31)] = t[i];
    LDS_WAIT(); asm volatile("" ::: "memory");
    const int c = lane & 7;
#pragma unroll
    for (int j = 0; j < 4; ++j) { const int n = (lane >> 3) + 8 * j; const LAS float* s = scr + (8 * c) * 33 + n;
        u32x4 o; o.x = cvt_pk_bf16(s[0 * 33], s[1 * 33]); o.y = cvt_pk_bf16(s[2 * 33], s[3 * 33]); o.z = cvt_pk_bf16(s[4 * 33], s[5 * 33]); o.w = cvt_pk_bf16(s[6 * 33], s[7 * 33]);
        *(u32x4*)(WT + (size_t)(p0 + n) * K + k0 + 8 * c) = o; }
    LDS_WAIT(); asm volatile("" ::: "memory");
}
struct SrcWin { const float* w; __device__ float operator()(int k, int p) const { const int l = p1_logical(p); return l < 0 ? 0.f : w[(size_t)k * IN_COLS + l]; } };
struct SrcWup { const float *gq, *wuq, *gkv, *wukv;
    __device__ float operator()(int k, int p) const {
        if (p < 768) return k < 256 ? gq[k] * wuq[(size_t)k * 768 + qm_logical(p)] : 0.f;
        return k >= 256 ? gkv[k - 256] * wukv[(size_t)(k - 256) * 1024 + (p - 768)] : 0.f; } };
__host__ __device__ __forceinline__ int ctx_dstcol(int cp) { return cp < 128 ? 256 + cp : cp < 160 ? 384 + (cp - 128) : cp < 672 ? 1024 + (cp - 160) : cp < 1184 ? 1536 + (cp - 672) : -1; }
struct SrcCtx { const float* w; __device__ float operator()(int k, int p) const { const int c = ctx_dstcol(p); const int l = c < 0 ? -1 : p1_logical(c); return l < 0 ? 0.f : w[(size_t)k * IN_COLS + l]; } };
struct SrcPlain { const float* w; int N; int coff; __device__ float operator()(int k, int p) const { return w[(size_t)k * N + p + coff]; } };

__device__ __forceinline__ void ph0_prep(Frame& F) {
    LAS float* scr = (LAS float*)(F.lds + F.wave * 16384);
    const int gw = F.vcu * NWAVES + F.wave, NGW = F.G * NWAVES, lane = F.lane;
    const Ptrs& P = F.P; unsigned char* ws = P.ws;
    constexpr int I_IN = 16 * 64, I_UP = 6 * 56, I_OUT = 16 * 32, I_R = 16 * 8, I_CTX = 16 * 38, I_SMALL = I_IN + I_UP + I_OUT + I_R + I_CTX;
    for (int it = gw; it < I_SMALL; it += NGW) {
        int r = it;
        if (r < I_IN) { transpose_item(SrcWin{P.in[8]}, 1024, (bf16*)(ws + WS_WIN), (r % 64) * 32, (r / 64) * 64, scr, lane); continue; } r -= I_IN;
        if (r < I_UP) { transpose_item(SrcWup{P.in[9], P.in[10], P.in[11], P.in[12]}, 384, (bf16*)(ws + WS_WUP), (r % 56) * 32, (r / 56) * 64, scr, lane); continue; } r -= I_UP;
        if (r < I_OUT) { transpose_item(SrcPlain{P.in[18], 1024, 0}, 1024, (bf16*)(ws + WS_WOUT), (r % 32) * 32, (r / 32) * 64, scr, lane); continue; } r -= I_OUT;
        if (r < I_R) { transpose_item(SrcPlain{P.in[19], 256, 0}, 1024, (bf16*)(ws + WS_WR), (r % 8) * 32, (r / 8) * 64, scr, lane); continue; } r -= I_R;
        transpose_item(SrcCtx{P.in[8]}, 1024, (bf16*)(ws + WS_WCTX), (r % 38) * 32, (r / 38) * 64, scr, lane);
    }
    for (int it = gw; it < 96 * 16; it += NGW) {
        const int cg = it % 96, kp = it / 96;
#pragma unroll
        for (int r = 0; r < 5; ++r) { const float c = (r < 4 ? P.in[1] + r * DM : P.in[3])[kp * 64 + lane]; scr[r * 64 + lane] = c / (1.f + __expf(-c)); }
        LDS_WAIT(); asm volatile("" ::: "memory");
        float acc[5] = {0.f, 0.f, 0.f, 0.f, 0.f};
        const float* W = P.in[4] + (size_t)(kp * 64) * 6144 + cg * 64 + lane;
#pragma unroll 8
        for (int kk = 0; kk < 64; ++kk) { const float w = W[(size_t)kk * 6144];
#pragma unroll
            for (int r = 0; r < 5; ++r) acc[r] += scr[r * 64 + kk] * w; }
        LDS_WAIT(); asm volatile("" ::: "memory");
#pragma unroll
        for (int r = 0; r < 5; ++r) ((float*)(ws + WS_MODP))[(size_t)(kp * 5 + r) * 6144 + cg * 64 + lane] = acc[r];
    }
    { const int idx = (F.vcu * 512 + F.tid);
      if (idx < 1024) { const int v = idx / 16, f = idx % 16; const float th = (float)v * exp2f(-(float)f / 16.f * 13.287712379549449f);
          ((float2*)(ws + WS_TAB))[idx] = make_float2(__builtin_amdgcn_cosf(th * 0.15915494309189535f), __builtin_amdgcn_sinf(th * 0.15915494309189535f)); }
      else if (idx < 1536) { const int i2 = idx - 1024, v = i2 / 8, f = i2 % 8; const float th = (float)v * exp2f(-(float)f / 8.f * 13.287712379549449f);
          ((float2*)(ws + WS_TAB))[idx] = make_float2(__builtin_amdgcn_cosf(th * 0.15915494309189535f), __builtin_amdgcn_sinf(th * 0.15915494309189535f)); } }
}
struct CvItem { const float* src; int ld; bf16* dst; int K; };
__device__ __forceinline__ CvItem cv_decode(const Ptrs& P, int it, int lane) {
    constexpr int IPE = 256 + 128; unsigned char* ws = P.ws;
    const int e = it / IPE; int r = it % IPE; CvItem c;
    if (r < 256) { const int p0 = (r % 16) * 32, k0 = (r / 16) * 64, half = p0 >> 8, up = (p0 >> 7) & 1;
        const float* w = e < 256 ? (up ? P.in[22] : P.in[21]) + (size_t)e * DM * EFF : (up ? P.in[25] : P.in[24]);
        c.src = w + (size_t)(k0 + (lane >> 5)) * EFF + half * 128 + (p0 & 127) + (lane & 31); c.ld = EFF; c.K = 1024;
        c.dst = (bf16*)(ws + WS_W13) + ((size_t)e * 512 + p0) * 1024 + k0; }
    else { r -= 256; const int p0 = (r % 32) * 32, k0 = (r / 32) * 64;
        const float* w = e < 256 ? P.in[23] + (size_t)e * EFF * DM : P.in[26];
        c.src = w + (size_t)(k0 + (lane >> 5)) * DM + p0 + (lane & 31); c.ld = DM; c.K = 256;
        c.dst = (bf16*)(ws + WS_W2) + ((size_t)e * 1024 + p0) * 256 + k0; }
    return c;
}
#ifndef CVV
#define CVV 3
#endif
#ifndef CVP
#define CVP 0
#endif
#define CV_LOAD(t, c) do { _Pragma("unroll") for (int _i = 0; _i < 32; ++_i) { if (CVP == 2 && probe) t[_i] = (float)_i; else if (CVV == 3) t[_i] = __builtin_nontemporal_load((c).src + (size_t)(2 * _i) * (c).ld); else t[_i] = (c).src[(size_t)(2 * _i) * (c).ld]; } } while (0)
#define CV_FINISH(t, c) do { _Pragma("unroll") for (int _i = 0; _i < 32; ++_i) scr[(2 * _i + (lane >> 5)) * 33 + (lane & 31)] = t[_i]; \
        LDS_WAIT(); asm volatile("" ::: "memory"); const int _c = lane & 7; \
        _Pragma("unroll") for (int _j = 0; _j < 4; ++_j) { const int _n = (lane >> 3) + 8 * _j; const LAS float* _s = scr + (8 * _c) * 33 + _n; \
            u32x4 _o; _o.x = cvt_pk_bf16(_s[0 * 33], _s[1 * 33]); _o.y = cvt_pk_bf16(_s[2 * 33], _s[3 * 33]); _o.z = cvt_pk_bf16(_s[4 * 33], _s[5 * 33]); _o.w = cvt_pk_bf16(_s[6 * 33], _s[7 * 33]); \
            if (!(CVP == 1 && probe)) *(u32x4*)((c).dst + (size_t)_n * (c).K + 8 * _c) = _o; else asm volatile("" :: "v"(_o)); } \
        LDS_WAIT(); asm volatile("" ::: "memory"); } while (0)
constexpr int CV_EARLY = 0;
__device__ __forceinline__ void ph0_experts(Frame& F, int r_from, int r_to, bool probe = false) {
    LAS float* scr = (LAS float*)(F.lds + F.wave * 16384);
    const int gw = F.vcu * NWAVES + F.wave, NGW = F.G * NWAVES, lane = F.lane, NIT = 257 * 384;
    const Ptrs& P = F.P;
    float ta[32], tb[32];
    const long lim = (long)gw + (long)(r_to < (1 << 20) ? r_to : (1 << 20)) * NGW; const int NE = (int)(lim < NIT ? lim : NIT);
    int it = gw + r_from * NGW; CvItem ca, cb;
    if (it < NE) { ca = cv_decode(P, it, lane); CV_LOAD(ta, ca); }
    for (; it < NE; it += 2 * NGW) {
        const int it2 = it + NGW, it3 = it + 2 * NGW;
        if (it2 < NE) { cb = cv_decode(P, it2, lane); CV_LOAD(tb, cb); }
        CV_FINISH(ta, ca);
        if (it3 < NE) { ca = cv_decode(P, it3, lane); CV_LOAD(ta, ca); }
        if (it2 < NE) CV_FINISH(tb, cb);
    }
    __syncthreads();
}
#undef CV_LOAD
#undef CV_FINISH
__device__ __forceinline__ void ph1_xn(Frame& F) {
    const Ptrs& P = F.P; unsigned char* ws = P.ws; const int lane = F.lane, wave = F.wave, fr = lane & 15, fq = lane >> 4;
    const float* MODP = (const float*)(ws + WS_MODP);
    for (int idx = F.vcu * 512 + F.tid; idx < 5 * 6144; idx += F.G * 512) { const int r = idx / 6144, j = idx % 6144; float a = P.in[5][j];
#pragma unroll
        for (int kp = 0; kp < 16; ++kp) a += MODP[(size_t)(kp * 5 + r) * 6144 + j];
        ((float*)(ws + WS_MOD))[idx] = a; }
    LAS unsigned char* At = F.lds;
    LAS float* sm = (LAS float*)(F.lds + 32768);
    const int t0 = F.vcu * 64, bl = t0 / SEQ;
    for (int i = F.tid; i < 4096; i += 512) { const int j = i & 2047, mrow = i < 2048 ? bl : 4; float a = P.in[5][j];
#pragma unroll
        for (int kp = 0; kp < 16; ++kp) a += MODP[(size_t)(kp * 5 + mrow) * 6144 + j];
        sm[i] = a; }
    __syncthreads();
    {
        f32x4 v[4], nv[4];
        { const f32x4* xr = (const f32x4*)(P.in[0] + (size_t)(t0 + wave * 8) * DM) + lane;
#pragma unroll
          for (int j = 0; j < 4; ++j) v[j] = xr[64 * j]; }
#pragma unroll 1
        for (int i = 0; i < 8; ++i) {
            const int t = t0 + wave * 8 + i, r = bl * NTOK + NCTX + (t - bl * SEQ);
            { const f32x4* xr = (const f32x4*)(P.in[0] + (size_t)(i < 7 ? t + 1 : t) * DM) + lane;
#pragma unroll
              for (int j = 0; j < 4; ++j) nv[j] = xr[64 * j]; }
            float s = 0.f;
#pragma unroll
            for (int j = 0; j < 4; ++j) s += (v[j][0] * v[j][0] + v[j][1] * v[j][1]) + (v[j][2] * v[j][2] + v[j][3] * v[j][3]);
            const float rs = rsqrtf(wave_sum(s) * (1.f / DM) + EPS);
            u32x2* o8 = (u32x2*)((bf16*)(ws + WS_XN) + (size_t)r * DM) + lane;
#pragma unroll
            for (int j = 0; j < 4; ++j) { const int c = 4 * lane + 256 * j; const f32x4 g = *(const f32x4*)(P.in[6] + c);
                const f32x4 sh = *(const LAS f32x4*)(sm + c), sc = *(const LAS f32x4*)(sm + 1024 + c);
                const f32x4 y = (v[j] * rs * g) * (sc + 1.f) + sh;
                u32x2 w; w.x = cvt_pk_bf16(y[0], y[1]); w.y = cvt_pk_bf16(y[2], y[3]); o8[64 * j] = w; }
#pragma unroll
            for (int j = 0; j < 4; ++j) v[j] = nv[j];
        }
    }
    const int mt = F.vcu >> 2, q = F.vcu & 3, bc = mt >> 4, nc0 = (mt & 15) * 16;
#pragma unroll 1
    for (int i = 0; i < 2; ++i) {
        const int r = 2 * wave + i;
        const f32x4* xr = (const f32x4*)(P.in[2] + ((size_t)bc * NCTX + nc0 + r) * DM) + lane;
        f32x4 v[4]; float s = 0.f;
#pragma unroll
        for (int j = 0; j < 4; ++j) { v[j] = xr[64 * j]; s += (v[j][0] * v[j][0] + v[j][1] * v[j][1]) + (v[j][2] * v[j][2] + v[j][3] * v[j][3]); }
        const float rs = rsqrtf(wave_sum(s) * (1.f / DM) + EPS);
#pragma unroll
        for (int j = 0; j < 4; ++j) { const int c = 4 * lane + 256 * j; const f32x4 g = *(const f32x4*)(P.in[6] + c);
            const f32x4 sh = *(const LAS f32x4*)(sm + 2048 + c), sc = *(const LAS f32x4*)(sm + 3072 + c);
            const f32x4 y = (v[j] * rs * g) * (sc + 1.f) + sh;
            u32x2 w; w.x = cvt_pk_bf16(y[0], y[1]); w.y = cvt_pk_bf16(y[2], y[3]);
            const int ch = (lane >> 1) + 32 * j;
            *(LAS u32x2*)(At + r * 2048 + ((ch ^ r) << 4) + (lane & 1) * 8) = w; }
    }
    __syncthreads();
    {
        const int nt0 = wave < 3 ? 3 * wave : 9 + 2 * (wave - 3), nnt = wave < 3 ? 3 : 2;
        const bf16* wb = (const bf16*)(ws + WS_WCTX) + (size_t)(q * 304 + nt0 * 16 + fr) * 1024 + 8 * fq;
        f32x4 acc[3];
#pragma unroll
        for (int j = 0; j < 3; ++j) acc[j] = (f32x4){0.f, 0.f, 0.f, 0.f};
        bf16x8 bq[4][3], nb[4][3];
#pragma unroll
        for (int u = 0; u < 4; ++u)
#pragma unroll
            for (int j = 0; j < 3; ++j) bq[u][j] = (j < nnt) ? *(const bf16x8*)(wb + (size_t)j * 16 * 1024 + 32 * u) : bf16x8{};
#pragma unroll 1
        for (int k4 = 0; k4 < 8; ++k4) {
            if (k4 < 7) {
#pragma unroll
                for (int u = 0; u < 4; ++u)
#pragma unroll
                    for (int j = 0; j < 3; ++j) nb[u][j] = (j < nnt) ? *(const bf16x8*)(wb + (size_t)j * 16 * 1024 + 32 * (4 * (k4 + 1) + u)) : bf16x8{}; }
#pragma unroll
            for (int u = 0; u < 4; ++u) { const int ch = 4 * (4 * k4 + u) + fq;
                const bf16x8 a = *(const LAS bf16x8*)(At + fr * 2048 + ((ch ^ fr) << 4));
#pragma unroll
                for (int j = 0; j < 3; ++j) acc[j] = __builtin_amdgcn_mfma_f32_16x16x32_bf16(bq[u][j], a, acc[j], 0, 0, 0); }
#pragma unroll
            for (int u = 0; u < 4; ++u)
#pragma unroll
                for (int j = 0; j < 3; ++j) bq[u][j] = nb[u][j];
        }
        const int r = bc * NTOK + nc0 + fr; bf16* P1 = (bf16*)(ws + WS_P1); float ssq = 0.f;
#pragma unroll
        for (int j = 0; j < 3; ++j) if (j < nnt) { const int cp = q * 304 + (nt0 + j) * 16 + 4 * fq, dc = ctx_dstcol(cp);
            if (dc >= 0) { u32x2 w; w.x = cvt_pk_bf16(acc[j][0], acc[j][1]); w.y = cvt_pk_bf16(acc[j][2], acc[j][3]); *(u32x2*)(P1 + (size_t)r * NP1 + dc) = w; }
            if (cp < 128) ssq += (acc[j][0] * acc[j][0] + acc[j][1] * acc[j][1]) + (acc[j][2] * acc[j][2] + acc[j][3] * acc[j][3]); }
        if (q == 0 && wave < 4) { ssq += __shfl_xor(ssq, 16); ssq += __shfl_xor(ssq, 32);
            if (fq == 0) ((float*)(ws + WS_SSQ))[(size_t)r * 8 + 4 + wave] = ssq; }
    }
    __syncthreads();
}
__device__ __forceinline__ void ph6_h2(Frame& F) {
    const Ptrs& P = F.P; unsigned char* ws = P.ws;
    const int gw = F.vcu * NWAVES + F.wave, NGW = F.G * NWAVES;
    f32x4 v[4], nv[4];
    if (gw < MLAT) { const f32x4* xr = (const f32x4*)((const float*)(ws + WS_X1) + (size_t)gw * DM) + F.lane;
#pragma unroll
        for (int j = 0; j < 4; ++j) v[j] = xr[64 * j]; }
    for (int t = gw; t < MLAT; t += NGW) {
        const int b = t / SEQ; const float* md = (const float*)(ws + WS_MOD) + b * 6144;
        { const int tn = t + NGW < MLAT ? t + NGW : t; const f32x4* xr = (const f32x4*)((const float*)(ws + WS_X1) + (size_t)tn * DM) + F.lane;
#pragma unroll
          for (int j = 0; j < 4; ++j) nv[j] = xr[64 * j]; }
        float s = 0.f;
#pragma unroll
        for (int j = 0; j < 4; ++j) s += (v[j][0] * v[j][0] + v[j][1] * v[j][1]) + (v[j][2] * v[j][2] + v[j][3] * v[j][3]);
        const float rs = rsqrtf(wave_sum(s) * (1.f / DM) + EPS);
        u32x2* o8 = (u32x2*)((bf16*)(ws + WS_H2) + (size_t)t * DM) + F.lane;
#pragma unroll
        for (int j = 0; j < 4; ++j) { const int c = 4 * F.lane + 256 * j; const f32x4 g = *(const f32x4*)(P.in[7] + c);
            const f32x4 sh = *(const f32x4*)(md + 3072 + c), sc = *(const f32x4*)(md + 4096 + c);
            const f32x4 y = (v[j] * rs * g) * (sc + 1.f) + sh;
            u32x2 w; w.x = cvt_pk_bf16(y[0], y[1]); w.y = cvt_pk_bf16(y[2], y[3]); o8[64 * j] = w; }
#pragma unroll
        for (int j = 0; j < 4; ++j) v[j] = nv[j];
    }
}
__device__ __forceinline__ void ph7_route(Frame& F) {
    const Ptrs& P = F.P; unsigned char* ws = P.ws; const int lane = F.lane;
    const int gw = F.vcu * NWAVES + F.wave, NGW = F.G * NWAVES;
    const f32x4 bi = ((const f32x4*)P.in[20])[lane];
    for (int t = gw; t < MLAT; t += NGW) {
        f32x4 lg = ((const f32x4*)(ws + WS_LOGP))[(size_t)t * 64 + lane];
#pragma unroll
        for (int kp = 1; kp < 4; ++kp) lg += ((const f32x4*)(ws + WS_LOGP))[((size_t)kp * MLAT + t) * 64 + lane];
        float s[4], v[4];
#pragma unroll
        for (int i = 0; i < 4; ++i) { s[i] = 1.f / (1.f + __expf(-lg[i])); v[i] = s[i] + bi[i]; }
        float m1 = fmaxf(v[0], v[1]), m2 = fminf(v[0], v[1]);
#pragma unroll
        for (int i = 2; i < 4; ++i) { const float x = v[i]; m2 = fmaxf(m2, fminf(m1, x)); m1 = fmaxf(m1, x); }
#pragma unroll
        for (int o = 1; o < 8; o <<= 1) { const float b1 = __shfl_xor(m1, o), b2 = __shfl_xor(m2, o); const float n1 = fmaxf(m1, b1), n2 = fmaxf(fminf(m1, b1), fmaxf(m2, b2)); m1 = n1; m2 = n2; }
        const float gs = m1 + m2; const int g = lane >> 3; int rank = 0;
#pragma unroll
        for (int j = 0; j < 8; ++j) { const float o = __shfl(gs, j * 8); rank += (o > gs || (o == gs && j < g)) ? 1 : 0; }
        if (rank >= 4) { v[0] = v[1] = v[2] = v[3] = -INFINITY; }
        int my_e = 0; float my_s = 0.f, ssum = 0.f;
#pragma unroll
        for (int k = 0; k < 8; ++k) {
            float bv = v[0]; int bi_ = 0;
#pragma unroll
            for (int i = 1; i < 4; ++i) if (v[i] > bv) { bv = v[i]; bi_ = i; }
            int be = lane * 4 + bi_;
#pragma unroll
            for (int o = 1; o < 64; o <<= 1) { const float ov = __shfl_xor(bv, o); const int oe = __shfl_xor(be, o); if (ov > bv || (ov == bv && oe < be)) { bv = ov; be = oe; } }
            const int wl = be >> 2, wi = be & 3;
            float sv = wi == 0 ? s[0] : wi == 1 ? s[1] : wi == 2 ? s[2] : s[3];
            sv = __shfl(sv, wl);
            if (lane == wl) { if (wi == 0) v[0] = -INFINITY; else if (wi == 1) v[1] = -INFINITY; else if (wi == 2) v[2] = -INFINITY; else v[3] = -INFINITY; }
            ssum += sv; if (lane == k) { my_e = be; my_s = sv; }
        }
        if (lane < 8) {
            int* cnt = (int*)(ws + WS_CTL) + CW_COUNT;
            const int rk = atomicAdd(&cnt[my_e], 1);
            ((int*)(ws + WS_EIDX))[(size_t)t * 8 + lane] = my_e;
            ((float*)(ws + WS_EW))[(size_t)t * 8 + lane] = my_s / ssum * 2.5f;
            ((int*)(ws + WS_ERANK))[(size_t)t * 8 + lane] = rk;
        }
    }
}
__device__ __forceinline__ void ph_route3(Frame& F) {
    const Ptrs& P = F.P; unsigned char* ws = P.ws; const int lane = F.lane, wave = F.wave, fr = lane & 15, fq = lane >> 4;
    LAS unsigned char* At = F.lds;
    const bf16* Wr = (const bf16*)(ws + WS_WR);
    const f32x4 bi = ((const f32x4*)P.in[20])[lane];
    for (int grp = F.vcu; grp < MLAT / 64; grp += F.G) {
        const int t0 = grp * 64, b = t0 / SEQ; const float* md = (const float*)(ws + WS_MOD) + b * 6144;
        u32x4 v[2], nv[2];
        { const u32x4* xr = (const u32x4*)((const bf16*)(ws + WS_X1) + (size_t)(t0 + wave * 8) * DM) + lane; v[0] = xr[0]; v[1] = xr[64]; }
#pragma unroll 1
        for (int i = 0; i < 8; ++i) {
            const int r = wave * 8 + i, t = t0 + r;
            { const int rn = i < 7 ? t + 1 : t; const u32x4* xr = (const u32x4*)((const bf16*)(ws + WS_X1) + (size_t)rn * DM) + lane; nv[0] = xr[0]; nv[1] = xr[64]; }
            float xf[2][8]; float s = 0.f;
#pragma unroll
            for (int h = 0; h < 2; ++h)
#pragma unroll
                for (int d = 0; d < 4; ++d) { xf[h][2 * d] = bflo(v[h][d]); xf[h][2 * d + 1] = bfhi(v[h][d]); s += xf[h][2 * d] * xf[h][2 * d] + xf[h][2 * d + 1] * xf[h][2 * d + 1]; }
            const float rs = rsqrtf(wave_sum(s) * (1.f / DM) + EPS);
#pragma unroll
            for (int h = 0; h < 2; ++h) { const int c = 8 * lane + 512 * h; f32x4 y[2];
#pragma unroll
                for (int q = 0; q < 2; ++q) { const f32x4 g = *(const f32x4*)(P.in[7] + c + 4 * q), sh = *(const f32x4*)(md + 3072 + c + 4 * q), sc = *(const f32x4*)(md + 4096 + c + 4 * q);
                    const f32x4 xv = {xf[h][4 * q], xf[h][4 * q + 1], xf[h][4 * q + 2], xf[h][4 * q + 3]}; y[q] = (xv * rs * g) * (sc + 1.f) + sh; }
                const u32x4 w = pack8(y[0], y[1]);
                *(u32x4*)((bf16*)(ws + WS_H2) + (size_t)t * DM + c) = w;
                const int ch = lane + 64 * h;
                *(LAS u32x4*)(At + r * 2048 + ((ch ^ (r & 15)) << 4)) = w; }
            v[0] = nv[0]; v[1] = nv[1];
        }
        __syncthreads();
        f32x4 acc[4][2];
#pragma unroll
        for (int m = 0; m < 4; ++m) { acc[m][0] = (f32x4){0.f, 0.f, 0.f, 0.f}; acc[m][1] = (f32x4){0.f, 0.f, 0.f, 0.f}; }
        const bf16* wb = Wr + (size_t)(wave * 32 + fr) * 1024 + 8 * fq;
        bf16x8 bq[4][2], nb[4][2];
#pragma unroll
        for (int u = 0; u < 4; ++u) { bq[u][0] = *(const bf16x8*)(wb + 32 * u); bq[u][1] = *(const bf16x8*)(wb + 16 * 1024 + 32 * u); }
#pragma unroll 1
        for (int k4 = 0; k4 < 8; ++k4) {
            if (k4 < 7) {
#pragma unroll
                for (int u = 0; u < 4; ++u) { nb[u][0] = *(const bf16x8*)(wb + 32 * (4 * (k4 + 1) + u)); nb[u][1] = *(const bf16x8*)(wb + 16 * 1024 + 32 * (4 * (k4 + 1) + u)); } }
#pragma unroll
            for (int u = 0; u < 4; ++u) { const int ks = 4 * k4 + u, ch = 4 * ks + fq;
#pragma unroll
                for (int m = 0; m < 4; ++m) { const int r = 16 * m + fr;
                    const bf16x8 a = *(const LAS bf16x8*)(At + r * 2048 + ((ch ^ (r & 15)) << 4));
                    acc[m][0] = __builtin_amdgcn_mfma_f32_16x16x32_bf16(bq[u][0], a, acc[m][0], 0, 0, 0);
                    acc[m][1] = __builtin_amdgcn_mfma_f32_16x16x32_bf16(bq[u][1], a, acc[m][1], 0, 0, 0); } }
#pragma unroll
            for (int u = 0; u < 4; ++u) { bq[u][0] = nb[u][0]; bq[u][1] = nb[u][1]; }
        }
        __syncthreads();
        LAS float* Lg = (LAS float*)F.lds;
#pragma unroll
        for (int m = 0; m < 4; ++m)
#pragma unroll
            for (int n = 0; n < 2; ++n) *(LAS f32x4*)(Lg + (16 * m + fr) * 260 + wave * 32 + 16 * n + 4 * fq) = acc[m][n];
        __syncthreads();
#pragma unroll 1
        for (int i = 0; i < 8; ++i) {
            const int r = wave * 8 + i, t = t0 + r;
            const f32x4 lg = *(const LAS f32x4*)(Lg + r * 260 + 4 * lane);
            float s[4], vv[4];
#pragma unroll
            for (int q = 0; q < 4; ++q) { s[q] = 1.f / (1.f + __expf(-lg[q])); vv[q] = s[q] + bi[q]; }
            float m1 = fmaxf(vv[0], vv[1]), m2 = fminf(vv[0], vv[1]);
#pragma unroll
            for (int q = 2; q < 4; ++q) { const float x = vv[q]; m2 = fmaxf(m2, fminf(m1, x)); m1 = fmaxf(m1, x); }
#pragma unroll
            for (int o = 1; o < 8; o <<= 1) { const float b1 = __shfl_xor(m1, o), b2 = __shfl_xor(m2, o); const float n1 = fmaxf(m1, b1), n2 = fmaxf(fminf(m1, b1), fmaxf(m2, b2)); m1 = n1; m2 = n2; }
            const float gs = m1 + m2; const int g = lane >> 3; int rank = 0;
#pragma unroll
            for (int j = 0; j < 8; ++j) { const float o = __builtin_bit_cast(float, __builtin_amdgcn_readlane(__builtin_bit_cast(int, gs), j * 8)); rank += (o > gs || (o == gs && j < g)) ? 1 : 0; }
            unsigned key[4];
#pragma unroll
            for (int q = 0; q < 4; ++q) key[q] = rank >= 4 ? 0u : ((__builtin_bit_cast(unsigned, vv[q] + 1.f) & 0xFFFFFF00u) | (unsigned)(255 - (lane * 4 + q)));
            int my_e = 0; float my_s = 0.f, ssum = 0.f;
#pragma unroll
            for (int k = 0; k < 8; ++k) {
                unsigned kb = max(max(key[0], key[1]), max(key[2], key[3]));
                kb = max(kb, (unsigned)__builtin_amdgcn_update_dpp(0, (int)kb, 0x111, 0xf, 0xf, false));
                kb = max(kb, (unsigned)__builtin_amdgcn_update_dpp(0, (int)kb, 0x112, 0xf, 0xf, false));
                kb = max(kb, (unsigned)__builtin_amdgcn_update_dpp(0, (int)kb, 0x114, 0xf, 0xf, false));
                kb = max(kb, (unsigned)__builtin_amdgcn_update_dpp(0, (int)kb, 0x118, 0xf, 0xf, false));
                kb = max(kb, (unsigned)__builtin_amdgcn_update_dpp(0, (int)kb, 0x142, 0xa, 0xf, false));
                kb = max(kb, (unsigned)__builtin_amdgcn_update_dpp(0, (int)kb, 0x143, 0xc, 0xf, false));
                const unsigned kw = (unsigned)__builtin_amdgcn_readlane((int)kb, 63);
                const int be = 255 - (int)(kw & 255u), wl = be >> 2, wi = be & 3;
                const float ssel = wi == 0 ? s[0] : wi == 1 ? s[1] : wi == 2 ? s[2] : s[3];
                const float sv = __builtin_bit_cast(float, __builtin_amdgcn_readlane(__builtin_bit_cast(int, ssel), wl));
#pragma unroll
                for (int q = 0; q < 4; ++q) key[q] = key[q] == kw ? 0u : key[q];
                ssum += sv; if (lane == k) { my_e = be; my_s = sv; }
            }
            if (lane < 8) {
                int* cnt = (int*)(ws + WS_CTL) + CW_COUNT;
                const int rk = atomicAdd(&cnt[my_e], 1);
                ((int*)(ws + WS_EIDX))[(size_t)t * 8 + lane] = my_e;
                ((float*)(ws + WS_EW))[(size_t)t * 8 + lane] = my_s / ssum * 2.5f;
                ((int*)(ws + WS_ERANK))[(size_t)t * 8 + lane] = rk;
            }
        }
        __syncthreads();
    }
}
__device__ __forceinline__ void ph8_slots(Frame& F) {
    const Ptrs& P = F.P; unsigned char* ws = P.ws;
    LAS int* off = (LAS int*)F.lds;
    LAS int* cfs = off + 260;
    LAS int* chs = off + 520;
    unsigned* cnt = (unsigned*)(ws + WS_CTL) + CW_COUNT;
    if (F.wave == 0) { const int lane = F.lane; int n[4], cf[4], ch[4], sn = 0, sf = 0, sh = 0;
#pragma unroll
        for (int i = 0; i < 4; ++i) { n[i] = (int)cnt[4 * lane + i]; const int r = n[i] & 255; cf[i] = (n[i] >> 8) + (r > 128 ? 1 : 0); ch[i] = (r > 0 && r <= 128) ? 1 : 0; sn += n[i]; sf += cf[i]; sh += ch[i]; }
        int in = sn, jf = sf, jh = sh;
#pragma unroll
        for (int o = 1; o < 64; o <<= 1) { const int tn = __shfl_up(in, o), tf = __shfl_up(jf, o), th = __shfl_up(jh, o); if (lane >= o) { in += tn; jf += tf; jh += th; } }
        int an = in - sn, af = jf - sf, ah = jh - sh;
#pragma unroll
        for (int i = 0; i < 4; ++i) { off[4 * lane + i] = an; cfs[4 * lane + i] = af; chs[4 * lane + i] = ah; an += n[i]; af += cf[i]; ah += ch[i]; }
        if (lane == 63) { off[256] = an; cfs[256] = af; chs[256] = ah; off[257] = NSLOT; cfs[257] = af + MLAT / 256; chs[257] = ah; } }
    __syncthreads();
    for (int idx = F.vcu * 512 + F.tid; idx < MLAT * 8; idx += F.G * 512) {
        const int e = ((const int*)(ws + WS_EIDX))[idx], rk = ((const int*)(ws + WS_ERANK))[idx];
        const int slot = off[e] + rk;
        ((int*)(ws + WS_SLOTOF))[idx] = slot; ((int*)(ws + WS_SLOTTOK))[slot] = idx >> 3; ((float*)(ws + WS_SLOTW))[slot] = ((const float*)(ws + WS_EW))[idx];
        if (idx < MLAT) { ((int*)(ws + WS_SLOTTOK))[MLAT * 8 + idx] = idx; ((float*)(ws + WS_SLOTW))[MLAT * 8 + idx] = 1.f; }
    }
    if (F.vcu == 0) {
        int* go = (int*)(ws + WS_OFF); int* ut = (int*)(ws + WS_UT);
        const int nfull = cfs[257];
        for (int e = F.tid; e < 258; e += 512) go[e] = off[e];
        for (int e = F.tid; e < 257; e += 512) { const int n = off[e + 1] - off[e], nf = cfs[e + 1] - cfs[e], nh = chs[e + 1] - chs[e];
            for (int j = 0; j < nf; ++j) { int* u = ut + (cfs[e] + j) * 4; u[0] = e; u[1] = off[e] + j * 256; u[2] = min(256, n - j * 256); u[3] = 0; }
            if (nh) { int* u = ut + (nfull + chs[e]) * 4; u[0] = e; u[1] = off[e] + nf * 256; u[2] = n - nf * 256; u[3] = 0; } }
        if (F.tid == 0) { ((int*)(ws + WS_CTL))[CW_NUNIT] = nfull + chs[257]; ((int*)(ws + WS_CTL))[CW_NFULL] = nfull; }
    }
    __syncthreads();
}
__device__ __forceinline__ void ph11_combine(Frame& F) {
    const Ptrs& P = F.P; unsigned char* ws = P.ws; const int lane = F.lane;
    const int gw = F.vcu * NWAVES + F.wave, NGW = F.G * NWAVES;
    const unsigned char* Y = (const unsigned char*)(ws + WS_Y);
    const int cbase = 256 * (lane >> 4) + 32 * ((lane >> 2) & 3) + 8 * (lane & 3);
    u32x4 yw[9], nyw[9]; u32x4 xw[2], nxw[2]; int nsl[8];
    auto ldslots = [&](int t) {
#pragma unroll
        for (int k = 0; k < 8; ++k) nsl[k] = ((const int*)(ws + WS_SLOTOF))[(size_t)t * 8 + k]; };
    auto ldrows = [&](int t) {
#pragma unroll
        for (int k = 0; k < 9; ++k) { const int sl = k < 8 ? nsl[k] : MLAT * 8 + t; nyw[k] = *(const u32x4*)(Y + (size_t)sl * DM + lane * 16); }
        nxw[0] = *(const u32x4*)((const bf16*)(ws + WS_X1) + (size_t)t * DM + cbase); nxw[1] = *(const u32x4*)((const bf16*)(ws + WS_X1) + (size_t)t * DM + cbase + 128); };
    if (gw < MLAT) { ldslots(gw); ldrows(gw); if (gw + NGW < MLAT) ldslots(gw + NGW); }
    for (int t = gw; t < MLAT; t += NGW) {
        const int b = t / SEQ; const float* gt2 = (const float*)(ws + WS_MOD) + b * 6144 + 5120;
#pragma unroll
        for (int k = 0; k < 9; ++k) yw[k] = nyw[k];
        xw[0] = nxw[0]; xw[1] = nxw[1];
        if (t + NGW < MLAT) { ldrows(t + NGW); if (t + 2 * NGW < MLAT) ldslots(t + 2 * NGW); }
        float a[16];
#pragma unroll
        for (int i = 0; i < 16; ++i) a[i] = 0.f;
#pragma unroll
        for (int k = 0; k < 9; ++k)
#pragma unroll
            for (int d = 0; d < 4; ++d) { const int w = (int)yw[k][d];
                const f32x2 lo = __builtin_amdgcn_cvt_pk_f32_fp8(w, false), hi = __builtin_amdgcn_cvt_pk_f32_fp8(w, true);
                a[4 * d + 0] += lo[0]; a[4 * d + 1] += lo[1]; a[4 * d + 2] += hi[0]; a[4 * d + 3] += hi[1]; }
        float ss = 0.f;
#pragma unroll
        for (int q = 0; q < 4; ++q) { const int c = cbase + (q >> 1) * 128 + (q & 1) * 4; const u32x4 xb = xw[q >> 1]; const unsigned x01 = (q & 1) ? xb.z : xb.x, x23 = (q & 1) ? xb.w : xb.y;
            const f32x4 xv = {bflo(x01), bfhi(x01), bflo(x23), bfhi(x23)}, gv = *(const f32x4*)(gt2 + c);
#pragma unroll
            for (int e = 0; e < 4; ++e) { const float v = xv[e] + gv[e] * (a[q * 4 + e] * (1.f / YSCALE)); a[q * 4 + e] = v; ss += v * v; } }
        const float rs = rsqrtf(wave_sum(ss) * (1.f / DM) + EPS);
#pragma unroll
        for (int q = 0; q < 4; ++q) { const int c = cbase + (q >> 1) * 128 + (q & 1) * 4; const f32x4 gf = *(const f32x4*)(P.in[27] + c);
            f32x4 o;
#pragma unroll
            for (int e = 0; e < 4; ++e) o[e] = a[q * 4 + e] * rs * gf[e];
            *(f32x4*)(P.out + (size_t)t * DM + c) = o; }
    }
}
__device__ __forceinline__ void ph4b_diff_finish(Frame& F) {
    const Ptrs& P = F.P; unsigned char* ws = P.ws; const int lane = F.lane;
    const int gw = F.vcu * NWAVES + F.wave, NGW = F.G * NWAVES;
    float d1 = P.in[13][lane] * P.in[14][lane], d2 = P.in[15][lane] * P.in[16][lane];
    d1 = wave_sum(d1); d2 = wave_sum(d2);
    const float lam = __expf(d1) - __expf(d2) + LAM_INIT;
    const float g0 = P.in[17][lane], g1 = P.in[17][64 + lane];
    for (int t = gw; t < MLAT; t += NGW) {
        const float* os = (const float*)(ws + WS_OS) + (size_t)t * 8 * 128;
        float x[4][4];
#pragma unroll
        for (int h = 0; h < 4; ++h) { x[h][0] = os[(2 * h) * 128 + lane]; x[h][1] = os[(2 * h) * 128 + 64 + lane]; x[h][2] = os[(2 * h + 1) * 128 + lane]; x[h][3] = os[(2 * h + 1) * 128 + 64 + lane]; }
#pragma unroll
        for (int h = 0; h < 4; ++h) {
            const float v0 = x[h][0] - lam * x[h][2], v1 = x[h][1] - lam * x[h][3];
            const float rs = rsqrtf(wave_sum(v0 * v0 + v1 * v1) * (1.f / 128.f) + EPS) * (1.f - LAM_INIT);
            bf16* mo = (bf16*)(ws + WS_MIX) + (size_t)t * DM + 512 + h * 128;
            mo[lane] = (bf16)f2bf(v0 * rs * g0); mo[64 + lane] = (bf16)f2bf(v1 * rs * g1); }
    }
}

#ifdef PROBE_UNITS
struct ProbeOrder { int n, c; __device__ bool next(int i, Unit& u) const { if (i >= n) return false; u.pm = (c * n + i) % 60; u.pn = (c + i) % 8; u.r0 = u.pm * 256; u.nv = 256; u.k0 = 0; return true; }
    __device__ __forceinline__ int a_row(const Unit& u, int r) const { return u.pm * 256 + r; } };
struct EpiProbe { static constexpr bool PERM = true; bf16* O; int mode;
    __device__ __forceinline__ void operator()(const Acc& acc, const Unit& u, int wr, int wc, int fr, int fq) const {
        if (mode == 0) {
#pragma unroll
            for (int ai = 0; ai < 2; ++ai)
#pragma unroll
                for (int bj = 0; bj < 2; ++bj)
#pragma unroll
                    for (int m = 0; m < 4; ++m) { asm volatile("" :: "v"(acc[ai][bj][m][0]), "v"(acc[ai][bj][m][1])); }
        } else {
            const int row0 = u.pm * 256 + wr * 64 + fr, col0 = u.pn * 256 + (mode == 2 ? wc * 64 : wc * 32) + 8 * fq; const int bjo = mode == 2 ? 32 : 128;
#pragma unroll
            for (int ai = 0; ai < 2; ++ai)
#pragma unroll
                for (int m = 0; m < 4; ++m) { if (mode == 7 && (ai | m)) { asm volatile("" :: "v"(acc[ai][0][m][0]), "v"(acc[ai][0][m][1]), "v"(acc[ai][1][m][0]), "v"(acc[ai][1][m][1])); continue; } bf16* rowp = mode == 8 ? O + (size_t)u.pm * 256 * NP1 + (size_t)(((wr * 4 + wc) * 8 + ai * 4 + m) * 2) * 512 + (fq * 16 + fr) * 8 : mode == 4 ? O + (size_t)blockIdx.x * 65536 + (size_t)(wr * 64 + fr + ai * 128 + m * 16) * 256 + wc * 32 + 8 * fq : O + (size_t)(row0 + ai * 128 + m * 16) * (mode == 3 ? NP1 + 64 : NP1) + col0;
                    *(u32x4*)(rowp) = pack8(acc[ai][0][m][0], acc[ai][0][m][1]); *(u32x4*)(rowp + (mode == 8 ? 512 : mode == 4 ? 128 : bjo)) = pack8(acc[ai][1][m][0], acc[ai][1][m][1]); }
        }
    }
};
#endif

enum { P_PREP = 0, P_XN, P_INPROJ, P_UP, P_ATTN, P_DIFFFIN, P_OUT, P_H2, P_ROUTER, P_ROUTE, P_SLOTS, P_EXP1, P_EXP2, P_COMB, P_PROBE, P_END };
struct Args { Ptrs P; int ph_lo, ph_hi, li, pad; };
__global__ void __launch_bounds__(NWAVES * 64, 2) mk_fwd(Args args) {
    extern __shared__ __attribute__((aligned(16))) unsigned char lds[];
    Frame F;
    F.lds = (LAS unsigned char*)lds; F.MISC = (volatile LAS unsigned*)(F.lds + MISC_OFF);
    F.tid = threadIdx.x; F.lane = F.tid & 63; F.wave = __builtin_amdgcn_readfirstlane(F.tid >> 6);
    F.G = gridDim.x; { const int bx = blockIdx.x; F.vcu = (F.G % 8 == 0) ? (bx % 8) * (F.G / 8) + bx / 8 : bx; }
    F.P = args.P; unsigned char* ws = args.P.ws; F.ctl = (unsigned*)(ws + WS_CTL);
    for (int u = F.tid; u < (LDS_BYTES - LDSCTL_OFF) / 4; u += NWAVES * 64) ((LAS unsigned*)(F.lds + LDSCTL_OFF))[u] = 0u;
    __syncthreads();
    XcdBarrier bar = xcd_barrier_post(F.ctl + CW_BAR + args.li * XCD_BAR_WORDS, F.MISC + 8);
    const int lo = args.ph_lo, hi = args.ph_hi;
#ifndef PHMASK
#define PHMASK 0xFFFF
#endif
#define IN(k) ((((PHMASK) >> (k)) & 1) && lo <= (k) && (k) < hi)
#define SKEW(ticks) do { const unsigned long long t0_ = __builtin_amdgcn_s_memrealtime(); const unsigned long long w_ = (unsigned long long)((F.vcu & 3) * (ticks)); while (__builtin_amdgcn_s_memrealtime() - t0_ < w_) __builtin_amdgcn_s_sleep(8); } while (0)
#define SEAM(k) do { if (IN(k) && IN((k) + 1)) xcd_barrier(bar); } while (0)
#define SEAM_SKIP1(k) do { if (IN(k) && IN((k) + 2)) xcd_barrier(bar); } while (0)
#define SEAM_SKIP2(k) do { if (IN(k) && IN((k) + 3)) xcd_barrier(bar); } while (0)
    if (IN(P_PREP)) { ph0_prep(F); } SEAM(P_PREP);
    if (IN(P_XN)) { ph1_xn(F); } SEAM(P_XN);
    if (IN(P_INPROJ)) {
        pg8::Gemm g{(const bf16*)(ws + WS_XN), (const bf16*)(ws + WS_WIN), 1024, 1024, 1024}; LatOrder S; S.init(MLAT, NP1, F.G, (int)blockIdx.x);
        EpiInProj E{(bf16*)(ws + WS_P1), (float*)(ws + WS_SSQ), (const float2*)(ws + WS_TAB), (const float2*)(ws + WS_TAB) + 1024};
#ifdef SKEW_INPROJ
        SKEW(SKEW_INPROJ);
#endif
        pg8::gemm_phase(F.lds, g, S, E);
        if (CV_EARLY > 0 && (int)blockIdx.x >= (MALL / 256) * (NP1 / 256) - 2 * F.G) ph0_experts(F, 0, CV_EARLY);
    } SEAM(P_INPROJ);
    if (IN(P_UP)) {
        pg8::Gemm g{(const bf16*)(ws + WS_P1), (const bf16*)(ws + WS_WUP), 2048, 384, 256}; UpOrder S{F.G, F.vcu};
        EpiUp E{(bf16*)(ws + WS_QM), (bf16*)(ws + WS_KVM), (const float*)(ws + WS_SSQ), (const float2*)(ws + WS_TAB) + 1024};
        pg8::gemm_phase(F.lds, g, S, E);
    } SEAM(P_UP);
    if (IN(P_ATTN)) {
        const bf16* P1 = (const bf16*)(ws + WS_P1); const bf16* QM = (const bf16*)(ws + WS_QM); const bf16* KVM = (const bf16*)(ws + WS_KVM);
        const int cslot = F.vcu % 5; int ui = 0;
        bool conv_done = false; int U = F.vcu;
        const int conv_from = ((int)blockIdx.x >= (MALL / 256) * (NP1 / 256) - 2 * F.G) ? CV_EARLY : 0;
        float lam; { float d1 = F.P.in[13][F.lane] * F.P.in[14][F.lane], d2 = F.P.in[15][F.lane] * F.P.in[16][F.lane]; d1 = wave_sum(d1); d2 = wave_sum(d2); lam = __expf(d1) - __expf(d2) + LAM_INIT; }
        for (; U < 512; U += F.G, ++ui) {
            if (ui == cslot) { ph0_experts(F, conv_from, 1 << 30); conv_done = true; }
            const int bh = U >> 4, qb = U & 15, b = bh >> 3, hh = bh & 7;
            const bf16* K0 = KVM + (size_t)b * NTOK * 1024 + hh * 128;
            attn::unit<0, 0>(QM + (size_t)(b * NTOK + NCTX + qb * 256) * 768 + hh * 96, K0, P1 + (size_t)b * NTOK * NP1 + 384, K0 + 64,
                             (bf16*)(ws + WS_MIX) + (size_t)(b * SEQ + qb * 256) * DM + hh * 64, DM, F.lds_c(), nullptr, 0.f, nullptr);
        }
        char* stash = (char*)(ws + WS_OS) + (size_t)F.vcu * 65536;
        const int Ud0 = U;
        for (; U < 768; U += 1024, ++ui) {
            if (ui == cslot) { ph0_experts(F, conv_from, 1 << 30); conv_done = true; }
            const int Up = U - 512, bh = Up >> 4, qb = Up & 15, b = bh >> 2, h = bh & 3;
            const bf16* Pb = P1 + (size_t)b * NTOK * NP1;
            attn::unit<1, 1>(P1 + (size_t)(b * NTOK + NCTX + qb * 256) * NP1 + 512 + (2 * h) * 64, Pb + 1024 + (2 * h) * 64, nullptr, Pb + 1536 + h * 128, nullptr, 0, F.lds_c(),
                             stash, 0.f, nullptr);
        }
        for (U = Ud0; U < 768; U += 1024, ++ui) {
            if (ui == cslot) { ph0_experts(F, conv_from, 1 << 30); conv_done = true; }
            const int Up = U - 512, bh = Up >> 4, qb = Up & 15, b = bh >> 2, h = bh & 3;
            const bf16* Pb = P1 + (size_t)b * NTOK * NP1;
            attn::unit<1, 2>(P1 + (size_t)(b * NTOK + NCTX + qb * 256) * NP1 + 512 + (2 * h + 1) * 64, Pb + 1024 + (2 * h + 1) * 64, nullptr, Pb + 1536 + h * 128,
                             (bf16*)(ws + WS_MIX) + (size_t)(b * SEQ + qb * 256) * DM + 512 + h * 128, DM, F.lds_c(), stash, lam, F.P.in[17]);
        }
        if (!conv_done) ph0_experts(F, conv_from, 1 << 30);
#ifdef CONV_PROBE
        if (F.vcu % 5 == 0) ph0_experts(F, 0, 1 << 30, true);
#endif

    } SEAM_SKIP1(P_ATTN);
#ifdef ATTN_PROBE
    if (IN(P_DIFFFIN)) { const bf16* P1 = (const bf16*)(ws + WS_P1); const bf16* QM = (const bf16*)(ws + WS_QM); const bf16* KVM = (const bf16*)(ws + WS_KVM);
        { const int Upr = F.vcu, bh = Upr >> 4, qb = Upr & 15, b = bh >> 3, hh = bh & 7;
          const bf16* K0 = KVM + (size_t)b * NTOK * 1024 + hh * 128;
          attn::unit<ATTN_PROBE_MODE, 0, ATTN_PROBE>(ATTN_PROBE_MODE == 0 ? QM + (size_t)(b * NTOK + NCTX + qb * 256) * 768 + hh * 96 : P1 + (size_t)(b * NTOK + NCTX + qb * 256) * NP1 + 512 + hh * 64,
                             ATTN_PROBE_MODE == 0 ? K0 : P1 + (size_t)b * NTOK * NP1 + 1024 + hh * 64, P1 + (size_t)b * NTOK * NP1 + 384, ATTN_PROBE_MODE == 0 ? K0 + 64 : P1 + (size_t)b * NTOK * NP1 + 1536 + (hh >> 1) * 128,
                             (bf16*)(ws + WS_TMP) + (size_t)Upr * 256 * DM, DM, F.lds_c(), nullptr, 0.f, nullptr); } }
#endif
    if (IN(P_OUT)) {
        pg8::Gemm g{(const bf16*)(ws + WS_MIX), (const bf16*)(ws + WS_WOUT), 1024, 1024, 1024}; pg8::StaticOrder S; S.init(MLAT, DM, F.G, (int)blockIdx.x);
        EpiOut E{F.P.in[0], (const float*)(ws + WS_MOD), (bf16*)(ws + WS_X1)};
        pg8::gemm_phase(F.lds, g, S, E);
    } SEAM(P_OUT);
    if (IN(P_H2)) { ph_route3(F); } SEAM_SKIP2(P_H2);
    if (IN(P_SLOTS)) { ph8_slots(F); } SEAM(P_SLOTS);
    if (IN(P_EXP1)) {
        const int nu = (int)xb_ld(F.ctl + CW_NUNIT), nfu = (int)xb_ld(F.ctl + CW_NFULL); LAS int* uc = (LAS int*)(F.lds + UCACHE_OFF);
        const int nmine = exp_units_to_lds<2>(uc, (const int*)(ws + WS_UT), nu, nfu, F.G, F.vcu);
        pg8::Gemm g{(const bf16*)(ws + WS_H2), (const bf16*)(ws + WS_W13), 1024, 1024, 1024};
        ExpSched<2, true> S{uc, nmine, (const int*)(ws + WS_SLOTTOK)};
        EpiAct E{(bf16*)(ws + WS_ACT), (const float*)(ws + WS_SLOTW)};
#ifdef SKEW_EXP1
        SKEW(SKEW_EXP1);
#endif
        pg8::gemm_phase(F.lds, g, S, E);
    } SEAM(P_EXP1);
    if (IN(P_EXP2)) {
        const int nu = (int)xb_ld(F.ctl + CW_NUNIT), nfu = (int)xb_ld(F.ctl + CW_NFULL); LAS int* uc = (LAS int*)(F.lds + UCACHE_OFF);
        const int nmine = exp_units_to_lds<4>(uc, (const int*)(ws + WS_UT), nu, nfu, F.G, F.vcu);
        pg8::Gemm g{(const bf16*)(ws + WS_ACT), (const bf16*)(ws + WS_W2), 256, 256, 256};
        ExpSched<4, false> S{uc, nmine, nullptr};
        EpiY E{(unsigned char*)(ws + WS_Y)};
#ifdef SKEW_EXP2
        SKEW(SKEW_EXP2);
#endif
        pg8::gemm_phase(F.lds, g, S, E);
    } SEAM(P_EXP2);
    if (IN(P_COMB)) { ph11_combine(F); } SEAM(P_COMB);
#ifdef PROBE_UNITS
    if (IN(P_PROBE)) {
        pg8::Gemm g{(const bf16*)(ws + WS_P1), (const bf16*)(ws + WS_WIN), 2048, 1024, PROBE_K}; ProbeOrder S{PROBE_UNITS, F.vcu};
        EpiProbe E{(bf16*)(ws + WS_TMP), PROBE_EPI};
        pg8::gemm_phase(F.lds, g, S, E);
    }
#endif
#undef IN
#undef SEAM
}

static int g_grid = 0;
static int mk_setup() {
    if (g_grid) return g_grid;
    int dev = 0, cus = 0;
    if (hipGetDevice(&dev) != hipSuccess || hipDeviceGetAttribute(&cus, hipDeviceAttributeMultiprocessorCount, dev) != hipSuccess) { fprintf(stderr, "kernel_launch: device query failed\n"); g_grid = -1; return -1; }
    if (hipFuncSetAttribute((const void*)mk_fwd, hipFuncAttributeMaxDynamicSharedMemorySize, LDS_BYTES) != hipSuccess) { fprintf(stderr, "kernel_launch: hipFuncSetAttribute failed\n"); g_grid = -1; return -1; }
    int per_cu = 0;
    if (hipOccupancyMaxActiveBlocksPerMultiprocessor(&per_cu, (const void*)mk_fwd, NWAVES * 64, LDS_BYTES) != hipSuccess || per_cu < 1) { fprintf(stderr, "kernel_launch: occupancy query says %d blocks/CU\n", per_cu); }
    (void)hipGetLastError();
    if (cus != 256) { fprintf(stderr, "kernel_launch: this build's work split assumes a 256-CU device (found %d CUs); nothing launched\n", cus); g_grid = -1; return -1; }
    g_grid = cus;
    return g_grid;
}
static void mk_run(const Ptrs& P, int lo, int hi, int li, hipStream_t stream) {
    Args a{}; a.P = P; a.ph_lo = lo; a.ph_hi = hi; a.li = li; a.pad = 0;
    hipLaunchKernelGGL(mk_fwd, dim3(g_grid), dim3(NWAVES * 64), LDS_BYTES, stream, a);
}
extern "C" void kernel_launch(void* const* d_in, const int* in_sizes, int n_in, void* d_out, int out_size, void* d_ws, size_t ws_size, hipStream_t stream) {
    if (n_in != 28 || out_size != MLAT * DM || ws_size < WS_END) { fprintf(stderr, "kernel_launch: unexpected shapes n_in %d out %d ws %zu\n", n_in, out_size, ws_size); return; }
    if (mk_setup() <= 0) return;
    Ptrs P{}; for (int i = 0; i < 28; ++i) P.in[i] = (const float*)d_in[i]; P.out = (float*)d_out; P.ws = (unsigned char*)d_ws;
    (void)hipMemsetAsync((char*)d_ws + WS_CTL, 0, 1 * MiB, stream);
    int li = 0;
#define FAST(lo, hi) mk_run(P, lo, hi, li++, stream)
    FAST(P_PREP, (defs_probe ? P_PROBE : P_COMB) + 1);
#undef FAST
}
```

```cpp
constexpr bool defs_probe = false;
#include <hip/hip_runtime.h>
#include <cstdio>
#include <cstdint>

constexpr int NB = 4, SEQ = 4096, NCTX = 256, NTOK = SEQ + NCTX, DM = 1024;
constexpr int MALL = NB * NTOK;
constexpr int MLAT = NB * SEQ;
constexpr int IN_COLS = 1952, NP1 = 2048;
constexpr int NEXP = 256, TOPK = 8, EFF = 256;
constexpr int NSLOT = MLAT * TOPK + MLAT;
constexpr float EPS = 1e-6f;
constexpr float LAM_INIT = 0.2f;

typedef unsigned short bf16;
__device__ __forceinline__ unsigned f2bf(float f) { unsigned u = __builtin_bit_cast(unsigned, f); return (u + 0x7fffu + ((u >> 16) & 1u)) >> 16; }
__device__ __forceinline__ float bf2f(bf16 h) { return __builtin_bit_cast(float, (unsigned)h << 16); }

constexpr size_t MiB = 1u << 20;
constexpr size_t WS_CTL = 0;
constexpr size_t WS_MOD = 3 * MiB;
constexpr size_t WS_TAB = 3 * MiB + 512 * 1024;
constexpr size_t WS_X1 = 402 * MiB;
constexpr size_t WS_SSQ = 466 * MiB;
constexpr size_t WS_EIDX = 467 * MiB;
constexpr size_t WS_EW = WS_EIDX + 512 * 1024;
constexpr size_t WS_ERANK = 468 * MiB;
constexpr size_t WS_SLOTOF = WS_ERANK + 512 * 1024;
constexpr size_t WS_SLOTTOK = 469 * MiB;
constexpr size_t WS_SLOTW = 470 * MiB;
constexpr size_t WS_OFF = 471 * MiB;
constexpr size_t WS_XN = 472 * MiB;
constexpr size_t WS_P1 = 506 * MiB;
constexpr size_t WS_QM = 574 * MiB;
constexpr size_t WS_KVM = 600 * MiB;
constexpr size_t WS_MIX = 634 * MiB;
constexpr size_t WS_OS = 666 * MiB;
constexpr size_t WS_TMP = 730 * MiB;
constexpr size_t WS_H2 = 472 * MiB;
constexpr size_t WS_H2F = 504 * MiB;
constexpr size_t WS_LOG = 568 * MiB;
constexpr size_t WS_ACT = 584 * MiB;
constexpr size_t WS_Y = 656 * MiB;
constexpr size_t WS_END = 944 * MiB;
constexpr int CW_COUNT = 1024;

__host__ __device__ __forceinline__ int perm32_log(int p) { return 16 * ((p >> 2) & 1) + 4 * (p >> 3) + (p & 3); }
__host__ __device__ __forceinline__ int perm64_log(int p) { return 32 * ((p >> 2) & 1) + 16 * (p >> 5) + 4 * ((p >> 3) & 3) + (p & 3); }
__host__ __device__ __forceinline__ int p1_logical(int p) {
    if (p < 384) return p;
    if (p < 416) return 384 + perm32_log(p - 384);
    if (p < 512) return -1;
    if (p < 1024) { int q = p - 512; return 416 + (q & ~63) + perm64_log(q & 63); }
    if (p < 1536) { int q = p - 1024; return 928 + (q & ~63) + perm64_log(q & 63); }
    return 1440 + (p - 1536);
}
__host__ __device__ __forceinline__ int qm_logical(int p) { int h = p / 96, r = p % 96; return h * 96 + (r < 64 ? r : 64 + perm32_log(r - 64)); }

struct Ptrs {
    const float* in[28]; float* out; unsigned char* ws;
};


#define GAS __attribute__((address_space(1)))
#define LAS __attribute__((address_space(3)))
typedef short bf16x8 __attribute__((ext_vector_type(8)));
typedef short s16x4 __attribute__((ext_vector_type(4)));
typedef float f32x4 __attribute__((ext_vector_type(4)));
typedef float f32x2 __attribute__((ext_vector_type(2)));
typedef float f32x16 __attribute__((ext_vector_type(16)));
typedef float f32x8 __attribute__((ext_vector_type(8)));
typedef unsigned u32x4 __attribute__((ext_vector_type(4)));
typedef unsigned u32x2 __attribute__((ext_vector_type(2)));
#define RLX_AGENT __ATOMIC_RELAXED, __HIP_MEMORY_SCOPE_AGENT
#define LDS_WAIT() asm volatile("s_waitcnt lgkmcnt(0)" ::: "memory")
#define VM_WAIT() asm volatile("s_waitcnt vmcnt(0)" ::: "memory")

constexpr size_t WS_MODP = 1 * MiB;
constexpr size_t WS_WIN = 4 * MiB;
constexpr size_t WS_WUP = 8 * MiB;
constexpr size_t WS_WOUT = 10 * MiB;
constexpr size_t WS_WR = 12 * MiB;
constexpr size_t WS_WCTX = 13 * MiB;
constexpr size_t WS_W13 = 16 * MiB;
constexpr size_t WS_W2 = 273 * MiB;
constexpr size_t WS_UT = WS_OFF + 4096;
static_assert(WS_W2 + (size_t)257 * 1024 * 256 * 2 <= WS_X1, "ws map");
constexpr size_t WS_LOGP = WS_Y;
constexpr int CW_NUNIT = 2048;
constexpr int CW_NFULL = 2049;
constexpr int CW_BAR = 4096;

__device__ __forceinline__ unsigned cvt_pk_bf16(float lo, float hi) { unsigned r; asm volatile("v_cvt_pk_bf16_f32 %0, %1, %2" : "=v"(r) : "v"(lo), "v"(hi)); return r; }
__device__ __forceinline__ unsigned pk2(float lo, float hi) { return f2bf(lo) | (f2bf(hi) << 16); }
__device__ __forceinline__ u32x4 pack8(f32x4 a, f32x4 b) { u32x4 w; w.x = cvt_pk_bf16(a[0], a[1]); w.y = cvt_pk_bf16(a[2], a[3]); w.z = cvt_pk_bf16(b[0], b[1]); w.w = cvt_pk_bf16(b[2], b[3]); return w; }
__device__ __forceinline__ float bflo(unsigned w) { return __builtin_bit_cast(float, w << 16); }
__device__ __forceinline__ float bfhi(unsigned w) { return __builtin_bit_cast(float, w & 0xffff0000u); }
__device__ __forceinline__ float wave_sum(float v) {
#pragma unroll
    for (int o = 1; o < 64; o <<= 1) v += __shfl_xor(v, o);
    return v;
}

namespace pg8 {
constexpr int BM = 256, BK = 64, HALF = 128, HTB = HALF * BK * 2, STAGE_BYTES = 8 * HTB;
__host__ __device__ __forceinline__ int lds_byte(int r, int c) { const int st = (r >> 4) * 2 + (c >> 5), rr = r & 15, cc = c & 31, ob = rr * 64 + cc * 2; return st * 1024 + (ob ^ (((ob >> 9) & 1) << 5)); }
__host__ __device__ __forceinline__ void stage_rc(int b, int& R, int& C) { const int st = b / 1024, sb = b % 1024, swz = sb ^ (((sb >> 9) & 1) << 5); R = (st >> 1) * 16 + swz / 64; C = (st & 1) * 32 + (swz % 64) / 2; }
__host__ __device__ __forceinline__ int perm32(int rho) { const int n = rho >> 4, i = rho & 15; return 8 * (i >> 2) + 4 * n + (i & 3); }

struct Unit { int pm, pn, r0, nv, k0; };
struct Gemm { const bf16* A; const bf16* Bt; int lda, ldb, K; };

struct StaticOrder {
    int nM, nN, nwg, G, c;
    __device__ void init(int M, int N, int G_, int c_) { nM = M / BM; nN = N / BM; nwg = nM * nN; G = G_; c = c_; }
    __device__ bool next(int i, Unit& u) const {
        const long L = (long)i * G + c; if (L >= nwg) return false;
        int wgid = (int)L; { const int q = nwg / 8, r = nwg % 8, xcd = wgid % 8, off = wgid / 8; wgid = (xcd < r ? xcd * (q + 1) : r * (q + 1) + (xcd - r) * q) + off; }
        const int nig = 8 * nN, gid = wgid / nig, fm = gid * 8, gsz = (nM - fm) < 8 ? (nM - fm) : 8;
        u.pm = fm + ((wgid % nig) % gsz); u.pn = (wgid % nig) / gsz; u.r0 = u.pm * BM; u.nv = BM; u.k0 = 0; return true;
    }
    __device__ __forceinline__ int a_row(const Unit& u, int r) const { return u.pm * BM + r; }
};

template <class Epi, class Sched>
__device__ __forceinline__ void gemm_phase(LAS unsigned char* lds, const Gemm g, const Sched& S, const Epi& E) {
    const int tid = threadIdx.x, wid = __builtin_amdgcn_readfirstlane(tid >> 6), lane = tid & 63, wr = wid >> 2, wc = wid & 3, fr = lane & 15, fq = lane >> 4;
    int K = g.K; asm volatile("" : "+s"(K));
    const int nt = K / BK;
    int RA[2], CA[2]; unsigned voffB[2];
#pragma unroll
    for (int i = 0; i < 2; ++i) { int R, C; stage_rc(tid * 16 + i * 8192, R, C); RA[i] = R; CA[i] = C; const int Rb = Epi::PERM ? ((R & ~31) + perm32(R & 31)) : R; voffB[i] = (unsigned)(Rb * g.ldb + C) * 2u; }
    const size_t kstep = (size_t)(BK * 2);
    const size_t hstepB = (size_t)HALF * g.ldb * 2, tstepB = 2 * hstepB;
    const unsigned ldsw = (unsigned)wid * 1024u;
    const int aoff = lds_byte(wr * 64 + fr, fq * 8), boff = lds_byte(wc * 32 + fr, fq * 8);
#define PG8_SA(b, h) (((b) * 2 + (h)) * HTB)
#define PG8_SB(b, h) ((4 + (b) * 2 + (h)) * HTB)
#define PG8_STAGE(bufoff, gbase, voff) do { _Pragma("unroll") for (int _i = 0; _i < 2; ++_i) \
        __builtin_amdgcn_global_load_lds((const unsigned*)((const char*)(gbase) + (voff)[_i]), (LAS unsigned*)(lds + (bufoff) + ldsw + _i * 8192), 16, 0, 0); } while (0)
#define PG8_LDA(dst, b, h) do { _Pragma("unroll") for (int m = 0; m < 4; ++m) _Pragma("unroll") for (int k = 0; k < 2; ++k) dst[m][k] = *(const LAS bf16x8*)(lds + PG8_SA(b, h) + aoff + m * 2048 + k * 1024); } while (0)
#define PG8_LDB(dst, b, h) do { _Pragma("unroll") for (int n = 0; n < 2; ++n) _Pragma("unroll") for (int k = 0; k < 2; ++k) dst[n][k] = *(const LAS bf16x8*)(lds + PG8_SB(b, h) + boff + n * 2048 + k * 1024); } while (0)
#define PG8_MMA(ai, bj, At, Bt) do { __builtin_amdgcn_s_setprio(1); _Pragma("unroll") for (int m = 0; m < 4; ++m) _Pragma("unroll") for (int n = 0; n < 2; ++n) _Pragma("unroll") for (int k = 0; k < 2; ++k) \
        acc[ai][bj][m][n] = __builtin_amdgcn_mfma_f32_16x16x32_bf16(Bt[n][k], At[m][k], acc[ai][bj][m][n], 0, 0, 0); __builtin_amdgcn_s_setprio(0); } while (0)
#define PG8_WAIT_V(n) asm volatile("s_waitcnt vmcnt(" #n ")" ::: "memory")
#define PG8_WAIT_L(n) asm volatile("s_waitcnt lgkmcnt(" #n ")" ::: "memory")
#define PG8_BAR __builtin_amdgcn_s_barrier()
#define PG8_SCHED __builtin_amdgcn_sched_barrier(0)
#define PG8_AOFFS(dst, u) do { _Pragma("unroll") for (int _h = 0; _h < 2; ++_h) _Pragma("unroll") for (int _i = 0; _i < 2; ++_i) \
        dst[_h][_i] = (unsigned)(((size_t)S.a_row(u, _h * HALF + RA[_i]) * (size_t)g.lda + (size_t)(CA[_i] + (u).k0)) * 2u); } while (0)
    Unit cur, nxt; int ui = 0;
    if (!S.next(0, cur)) return;
    f32x4 acc[2][2][4][2];
#pragma unroll
    for (int a = 0; a < 2; ++a)
#pragma unroll
        for (int b = 0; b < 2; ++b)
#pragma unroll
            for (int m = 0; m < 4; ++m)
#pragma unroll
                for (int n = 0; n < 2; ++n) acc[a][b][m][n] = (f32x4){0.f, 0.f, 0.f, 0.f};
    bf16x8 At[4][2], B0[2][2], B1[2][2];
    unsigned vA[2][2], vN[2][2];
    PG8_AOFFS(vA, cur);
    const char* Ab = (const char*)g.A; const char* cB = (const char*)g.Bt + (size_t)cur.pn * tstepB + (size_t)cur.k0 * 2;
    PG8_STAGE(PG8_SB(0, 0), cB, voffB); PG8_STAGE(PG8_SB(0, 1), cB + hstepB, voffB); PG8_STAGE(PG8_SA(0, 0), Ab, vA[0]); PG8_STAGE(PG8_SA(0, 1), Ab, vA[1]);
    if (wr == 1) PG8_BAR;
    PG8_WAIT_V(2); PG8_BAR;
    PG8_STAGE(PG8_SB(1, 0), cB + kstep, voffB); PG8_STAGE(PG8_SA(1, 0), Ab + kstep, vA[0]); PG8_STAGE(PG8_SB(1, 1), cB + hstepB + kstep, voffB);
    PG8_WAIT_V(6); PG8_BAR;
    for (;;) {
        const bool has_next = S.next(ui + 1, nxt);
        const char* nB = has_next ? (const char*)g.Bt + (size_t)nxt.pn * tstepB + (size_t)nxt.k0 * 2 : cB;
        if (has_next) { PG8_AOFFS(vN, nxt); } else { vN[0][0] = vA[0][0]; vN[0][1] = vA[0][1]; vN[1][0] = vA[1][0]; vN[1][1] = vA[1][1]; }
        for (int t = 0; t < nt; t += 2) {
            const bool last = (t == nt - 2); const bool full = cur.nv > HALF;
            const char* a1 = Ab + (size_t)(t + 1) * kstep;
            const char* a2 = Ab + (last ? (size_t)0 : (size_t)(t + 2) * kstep); const char* b2 = last ? nB : cB + (size_t)(t + 2) * kstep;
            const char* a3 = a2 + kstep; const char* b3 = b2 + kstep;
            unsigned w0[2], w1[2];
            w0[0] = last ? vN[0][0] : vA[0][0]; w0[1] = last ? vN[0][1] : vA[0][1]; w1[0] = last ? vN[1][0] : vA[1][0]; w1[1] = last ? vN[1][1] : vA[1][1];
            PG8_LDB(B0, 0, 0); PG8_LDB(B1, 0, 1); PG8_SCHED; PG8_LDA(At, 0, 0); PG8_STAGE(PG8_SA(1, 1), a1, vA[1]);
            PG8_WAIT_V(8); PG8_WAIT_L(0); PG8_BAR; PG8_MMA(0, 0, At, B0); PG8_MMA(0, 1, At, B1); PG8_BAR; PG8_SCHED;
            PG8_LDA(At, 0, 1); PG8_STAGE(PG8_SB(0, 0), b2, voffB); PG8_STAGE(PG8_SB(0, 1), b2 + hstepB, voffB); PG8_STAGE(PG8_SA(0, 0), a2, w0);
            PG8_WAIT_V(8); PG8_WAIT_L(0); PG8_BAR; if (full) { PG8_MMA(1, 0, At, B0); PG8_MMA(1, 1, At, B1); } PG8_BAR; PG8_SCHED;
            PG8_LDB(B0, 1, 0); PG8_LDB(B1, 1, 1); PG8_SCHED; PG8_LDA(At, 1, 0); PG8_STAGE(PG8_SA(0, 1), a2, w1);
            PG8_WAIT_V(8); PG8_WAIT_L(0); PG8_BAR; PG8_MMA(0, 0, At, B0); PG8_MMA(0, 1, At, B1); PG8_BAR; PG8_SCHED;
            PG8_LDA(At, 1, 1); PG8_STAGE(PG8_SB(1, 0), b3, voffB); PG8_STAGE(PG8_SB(1, 1), b3 + hstepB, voffB); PG8_STAGE(PG8_SA(1, 0), a3, w0);
            PG8_WAIT_V(8); PG8_WAIT_L(0); PG8_BAR; if (full) { PG8_MMA(1, 0, At, B0); PG8_MMA(1, 1, At, B1); } PG8_BAR; PG8_SCHED;
        }
        if (wr == 0) PG8_BAR;
        E(acc, cur, wr, wc, fr, fq);
        if (!has_next) break;
#pragma unroll
        for (int a = 0; a < 2; ++a)
#pragma unroll
            for (int b = 0; b < 2; ++b)
#pragma unroll
                for (int m = 0; m < 4; ++m)
#pragma unroll
                    for (int n = 0; n < 2; ++n) acc[a][b][m][n] = (f32x4){0.f, 0.f, 0.f, 0.f};
        cur = nxt; cB = nB; ++ui;
        vA[0][0] = vN[0][0]; vA[0][1] = vN[0][1]; vA[1][0] = vN[1][0]; vA[1][1] = vN[1][1];
        if (wr == 1) PG8_BAR;
    }
    PG8_WAIT_V(0);
    PG8_BAR;
#undef PG8_SA
#undef PG8_SB
#undef PG8_STAGE
#undef PG8_LDA
#undef PG8_LDB
#undef PG8_MMA
#undef PG8_WAIT_V
#undef PG8_WAIT_L
#undef PG8_BAR
#undef PG8_SCHED
#undef PG8_AOFFS
}
}

using pg8::Unit;
typedef f32x4 Acc[2][2][4][2];

struct EpiInProj {
    static constexpr bool PERM = true;
    bf16* P1; float* SSQ; const float2* TD; const float2* TM;
    __device__ __forceinline__ void operator()(const Acc& acc, const Unit& u, int wr, int wc, int fr, int fq) const {
        const int pm = u.pm, pn = u.pn, jt = pm % 17; const bool lat = jt > 0;
        const int row0 = pm * 256 + wr * 64 + fr, col0 = pn * 256 + wc * 32 + 8 * fq;
        if (pn == 0 || pn >= 6 || (pn == 1)) {
#pragma unroll
            for (int ai = 0; ai < 2; ++ai)
#pragma unroll
                for (int m = 0; m < 4; ++m) {
                    const int r = row0 + ai * 128 + m * 16; bf16* rowp = P1 + (size_t)r * NP1 + col0;
                    *(u32x4*)(rowp) = pack8(acc[ai][0][m][0], acc[ai][0][m][1]);
                    if (pn != 1) *(u32x4*)(rowp + 128) = pack8(acc[ai][1][m][0], acc[ai][1][m][1]);
                    if (pn <= 1) {
                        float s = 0.f;
#pragma unroll
                        for (int bj = 0; bj < 2; ++bj) { if (pn == 1 && bj == 1) break;
#pragma unroll
                            for (int n = 0; n < 2; ++n) { const f32x4 x = acc[ai][bj][m][n]; s += (x[0] * x[0] + x[1] * x[1]) + (x[2] * x[2] + x[3] * x[3]); } }
                        s += __shfl_xor(s, 16); s += __shfl_xor(s, 32);
                        if (fq == 0) SSQ[(size_t)r * 8 + pn * 4 + wc] = s;
                    }
                    if (pn == 1 && wc == 0) {
                        f32x4 x1 = acc[ai][1][m][0], x2 = acc[ai][1][m][1], o1 = x1, o2 = x2;
                        if (lat) { const int gr = (jt - 1) * 4 + 2 * ai + wr, gc = 16 * m + fr;
                            const float2* tp = TM + (fq < 2 ? gr * 8 + 4 * fq : gc * 8 + 4 * (fq - 2));
                            const f32x4 t0 = *(const f32x4*)tp, t1 = *(const f32x4*)(tp + 2);
                            const f32x4 cs = {t0[0], t0[2], t1[0], t1[2]}, sn = {t0[1], t0[3], t1[1], t1[3]};
                            o1 = x1 * cs - x2 * sn; o2 = x1 * sn + x2 * cs; }
                        *(u32x4*)(rowp + 128) = pack8(o1, o2);
                    }
                }
        } else {
            const int g = wc & 1; const float qs = pn < 4 ? 0.125f * 1.4426950408889634f : 1.f;
#pragma unroll
            for (int ai = 0; ai < 2; ++ai) {
                const int gr = (jt - 1) * 4 + 2 * ai + wr;
#pragma unroll
                for (int m = 0; m < 4; ++m) {
                    const int r = row0 + ai * 128 + m * 16; bf16* rowp = P1 + (size_t)r * NP1 + col0;
                    f32x4 cs = {1.f, 1.f, 1.f, 1.f}, sn = {0.f, 0.f, 0.f, 0.f};
                    if (lat) { const int gc = 16 * m + fr; const float2* tp = TD + (g == 0 ? gr : gc) * 16 + 4 * fq;
                        const f32x4 t0 = *(const f32x4*)tp, t1 = *(const f32x4*)(tp + 2);
                        cs = (f32x4){t0[0], t0[2], t1[0], t1[2]}; sn = (f32x4){t0[1], t0[3], t1[1], t1[3]}; }
#pragma unroll
                    for (int bj = 0; bj < 2; ++bj) { const f32x4 x1 = acc[ai][bj][m][0] * qs, x2 = acc[ai][bj][m][1] * qs;
                        *(u32x4*)(rowp + bj * 128) = pack8(x1 * cs - x2 * sn, x1 * sn + x2 * cs); }
                }
            }
        }
    }
};

struct EpiUp {
    static constexpr bool PERM = true;
    bf16* QM; bf16* KVM; const float* SSQ; const float2* TM;
    __device__ __forceinline__ void operator()(const Acc& acc, const Unit& u, int wr, int wc, int fr, int fq) const {
        const int pm = u.pm, pn = u.pn, jt = pm % 17; const bool lat = jt > 0, isq = pn < 3;
        const int row0 = pm * 256 + wr * 64 + fr, col0 = pn * 256 + wc * 32 + 8 * fq;
#pragma unroll
        for (int ai = 0; ai < 2; ++ai)
#pragma unroll
            for (int m = 0; m < 4; ++m) {
                const int r = row0 + ai * 128 + m * 16;
                const f32x4 sq = *(const f32x4*)(SSQ + (size_t)r * 8 + (isq ? 0 : 4));
                const float rs = rsqrtf(((sq[0] + sq[1]) + (sq[2] + sq[3])) * (isq ? 1.f / 256.f : 1.f / 128.f) + EPS) * (isq ? 0.10206207261596575f * 1.4426950408889634f : 1.f);
#pragma unroll
                for (int bj = 0; bj < 2; ++bj) {
                    f32x4 x1 = acc[ai][bj][m][0] * rs, x2 = acc[ai][bj][m][1] * rs;
                    if (isq) {
                        const int G = 8 * pn + 4 * bj + wc;
                        if (lat && (G % 3) == 2) { const int gr = (jt - 1) * 4 + 2 * ai + wr, gc = 16 * m + fr;
                            const float2* tp = TM + (fq < 2 ? gr * 8 + 4 * fq : gc * 8 + 4 * (fq - 2));
                            const f32x4 t0 = *(const f32x4*)tp, t1 = *(const f32x4*)(tp + 2);
                            const f32x4 cs = {t0[0], t0[2], t1[0], t1[2]}, sn = {t0[1], t0[3], t1[1], t1[3]};
                            const f32x4 o1 = x1 * cs - x2 * sn, o2 = x1 * sn + x2 * cs; x1 = o1; x2 = o2; }
                        *(u32x4*)(QM + (size_t)r * 768 + col0 + bj * 128) = pack8(x1, x2);
                    } else *(u32x4*)(KVM + (size_t)r * 1024 + (col0 - 768) + bj * 128) = pack8(x1, x2);
                }
            }
    }
};

struct EpiOut {
    static constexpr bool PERM = true;
    const float* x; const float* MOD; bf16* X1;
    __device__ __forceinline__ void operator()(const Acc& acc, const Unit& u, int wr, int wc, int fr, int fq) const {
        const int b = u.pm / 16; const float* gt = MOD + b * 6144 + 2048;
        const int row0 = u.pm * 256 + wr * 64 + fr, col0 = u.pn * 256 + wc * 32 + 8 * fq;
        f32x4 gv[2][2];
#pragma unroll
        for (int bj = 0; bj < 2; ++bj)
#pragma unroll
            for (int n = 0; n < 2; ++n) gv[bj][n] = *(const f32x4*)(gt + col0 + bj * 128 + n * 4);
#pragma unroll
        for (int ai = 0; ai < 2; ++ai)
#pragma unroll
            for (int m = 0; m < 4; ++m) { const size_t off = (size_t)(row0 + ai * 128 + m * 16) * DM + col0;
#pragma unroll
                for (int bj = 0; bj < 2; ++bj) { const f32x4 x0 = *(const f32x4*)(x + off + bj * 128), x1 = *(const f32x4*)(x + off + bj * 128 + 4);
                    *(u32x4*)(X1 + off + bj * 128) = pack8(x0 + gv[bj][0] * acc[ai][bj][m][0], x1 + gv[bj][1] * acc[ai][bj][m][1]); } }
    }
};
struct EpiF32 {
    static constexpr bool PERM = false;
    float* O; int ldc;
    __device__ __forceinline__ void operator()(const Acc& acc, const Unit& u, int wr, int wc, int fr, int fq) const {
        const int row0 = u.pm * 256 + wr * 64 + fr, col0 = u.pn * 256 + wc * 32 + 4 * fq;
#pragma unroll
        for (int ai = 0; ai < 2; ++ai)
#pragma unroll
            for (int m = 0; m < 4; ++m) { const size_t off = (size_t)(row0 + ai * 128 + m * 16) * ldc + col0;
#pragma unroll
                for (int bj = 0; bj < 2; ++bj)
#pragma unroll
                    for (int n = 0; n < 2; ++n) *(f32x4*)(O + off + bj * 128 + n * 16) = acc[ai][bj][m][n]; }
    }
};
struct EpiAct {
    static constexpr bool PERM = true;
    bf16* ACT; const float* SW;
    __device__ __forceinline__ void operator()(const Acc& acc, const Unit& u, int wr, int wc, int fr, int fq) const {
        const int half = u.pn & 1, colb = half * 128 + wc * 32 + 8 * fq;
#pragma unroll
        for (int ai = 0; ai < 2; ++ai)
#pragma unroll
            for (int m = 0; m < 4; ++m) { const int tr = ai * 128 + wr * 64 + m * 16 + fr;
                f32x4 a[2];
#pragma unroll
                for (int n = 0; n < 2; ++n) { const f32x4 gt = acc[ai][0][m][n], up = acc[ai][1][m][n];
#pragma unroll
                    for (int e = 0; e < 4; ++e) a[n][e] = gt[e] * __builtin_amdgcn_rcpf(1.f + __expf(-gt[e])) * up[e]; }
                if (tr < u.nv) { const float w = SW[u.r0 + tr]; *(u32x4*)(ACT + (size_t)(u.r0 + tr) * EFF + colb) = pack8(a[0] * w, a[1] * w); } }
    }
};
constexpr float YSCALE = 32.f;
__device__ __forceinline__ unsigned pk4_fp8(f32x4 v) { int w = 0; w = __builtin_amdgcn_cvt_pk_fp8_f32(v[0], v[1], w, false); w = __builtin_amdgcn_cvt_pk_fp8_f32(v[2], v[3], w, true); return (unsigned)w; }
struct EpiY {
    static constexpr bool PERM = true;
    unsigned char* Y;
    __device__ __forceinline__ void operator()(const Acc& acc, const Unit& u, int wr, int wc, int fr, int fq) const {
        const int colb = (u.pn & 3) * 256 + wc * 64 + 16 * fq;
#pragma unroll
        for (int ai = 0; ai < 2; ++ai)
#pragma unroll
            for (int m = 0; m < 4; ++m) { const int tr = ai * 128 + wr * 64 + m * 16 + fr;
                if (tr < u.nv) { u32x4 w; w.x = pk4_fp8(acc[ai][0][m][0] * YSCALE); w.y = pk4_fp8(acc[ai][0][m][1] * YSCALE); w.z = pk4_fp8(acc[ai][1][m][0] * YSCALE); w.w = pk4_fp8(acc[ai][1][m][1] * YSCALE);
                    *(u32x4*)(Y + (size_t)(u.r0 + tr) * DM + colb) = w; } }
    }
};

template <int SUB, bool GATHER> struct ExpSched {
    const LAS int* uc; int nmine; const int* slot_tok;
    __device__ bool next(int i, Unit& u) const {
        if (i >= nmine) return false;
        const int e = __builtin_amdgcn_readfirstlane(uc[i * 4 + 0]), r0 = __builtin_amdgcn_readfirstlane(uc[i * 4 + 1]);
        const int nv = __builtin_amdgcn_readfirstlane(uc[i * 4 + 2]), sub = __builtin_amdgcn_readfirstlane(uc[i * 4 + 3]);
        u.pm = 0; u.pn = e * SUB + sub; u.r0 = r0; u.nv = nv; u.k0 = 0; return true;
    }
    __device__ __forceinline__ int a_row(const Unit& u, int r) const {
        if (GATHER) return r < u.nv ? slot_tok[u.r0 + r] : 0;
        const int s = u.r0 + r; return s < NSLOT ? s : NSLOT - 1;
    }
};
template <int SUB> __device__ __forceinline__ int exp_units_to_lds(LAS int* uc, const int* ut, int nunit, int nfull, int G, int c) {
    const int NF = nfull * SUB, NH = (nunit - nfull) * SUB, cr = G - 1 - c, nlight = (NF % G) ? G - NF % G : 0;
    const int mf = c < NF ? (NF - 1 - c) / G + 1 : 0;
    const int h0 = (cr < nlight && cr < NH) ? 1 : 0;
    const int NH2 = NH > nlight ? NH - nlight : 0, mh = cr < NH2 ? (NH2 - 1 - cr) / G + 1 : 0;
    const int t = threadIdx.x;
    if (t < mf + h0 + mh && t < 64) { const int L = t < mf ? t * G + c : (t < mf + h0 ? NF + cr : NF + nlight + (t - mf - h0) * G + cr); const int cu = L / SUB;
        uc[t * 4 + 0] = ut[cu * 4 + 0]; uc[t * 4 + 1] = ut[cu * 4 + 1]; uc[t * 4 + 2] = ut[cu * 4 + 2]; uc[t * 4 + 3] = L % SUB; }
    __syncthreads();
    return mf + h0 + mh < 64 ? mf + h0 + mh : 64;
}
struct LatOrder : pg8::StaticOrder {
    __device__ bool next(int i, Unit& u) const { if (!pg8::StaticOrder::next(i, u)) return false; u.pm += (u.pm >> 4) + 1; u.r0 = u.pm * 256; return true; }
};
struct RouterOrder {
    int G, c;
    __device__ bool next(int i, Unit& u) const { const int L = i * G + c; if (L >= 256) return false; u.pm = L >> 2; u.pn = 0; u.r0 = u.pm * 256; u.nv = 256; u.k0 = (L & 3) * 256; return true; }
    __device__ __forceinline__ int a_row(const Unit& u, int r) const { return u.pm * 256 + r; }
};
struct UpOrder {
    int G, c;
    __device__ bool next(int i, Unit& u) const { const int L = i * G + c; if (L >= 68 * 7) return false; u.pm = L / 7; u.pn = L % 7; u.r0 = u.pm * 256; u.nv = 256; u.k0 = u.pn < 3 ? 0 : 128; return true; }
    __device__ __forceinline__ int a_row(const Unit& u, int r) const { return u.pm * 256 + r; }
};
struct EpiLogP {
    static constexpr bool PERM = false;
    float* O;
    __device__ __forceinline__ void operator()(const Acc& acc, const Unit& u, int wr, int wc, int fr, int fq) const {
        float* base = O + (size_t)(u.k0 >> 8) * MLAT * NEXP;
        const int row0 = u.pm * 256 + wr * 64 + fr, col0 = wc * 32 + 4 * fq;
#pragma unroll
        for (int ai = 0; ai < 2; ++ai)
#pragma unroll
            for (int m = 0; m < 4; ++m) { const size_t off = (size_t)(row0 + ai * 128 + m * 16) * NEXP + col0;
#pragma unroll
                for (int bj = 0; bj < 2; ++bj)
#pragma unroll
                    for (int n = 0; n < 2; ++n) *(f32x4*)(base + off + bj * 128 + n * 16) = acc[ai][bj][m][n]; }
    }
};

namespace attn {
#define SBAR() __builtin_amdgcn_sched_barrier(0)
constexpr float THR = 8.f;
template <int MODE> struct Cfg;
template <> struct Cfg<0> { static constexpr int DQK = 96, DV = 64, LDQ = 768, LDK0 = 1024, LDK1 = 2048, LDV = 1024; static constexpr float SCALE = 0.10206207261596575f; };
template <> struct Cfg<1> { static constexpr int DQK = 64, DV = 128, LDQ = 2048, LDK0 = 2048, LDK1 = 2048, LDV = 2048; static constexpr float SCALE = 0.125f; };
__device__ __forceinline__ int crow(int r, int hi) { return (r & 3) + 8 * (r >> 2) + 4 * hi; }
__device__ __forceinline__ unsigned cvtpk(float lo, float hi) { unsigned r; asm volatile("v_cvt_pk_bf16_f32 %0, %1, %2" : "=v"(r) : "v"(lo), "v"(hi)); return r; }

constexpr float THR2 = 11.5f;
__device__ __forceinline__ float max3f(float a, float b, float c) { return __builtin_fmaxf(__builtin_fmaxf(a, b), c); }
template <int ABL = 0> __device__ __forceinline__ void partialSM(f32x16& p0, f32x16& p1, float& m_reg, float& alpha, bool first) {
    float a = max3f(p0[0], p0[1], p1[0]), b = max3f(p0[2], p0[3], p1[1]); a = max3f(a, p1[2], p1[3]);
#pragma unroll
    for (int r = 4; r < 16; r += 4) { a = max3f(a, p0[r], p0[r + 1]); b = max3f(b, p0[r + 2], p0[r + 3]); a = max3f(a, p1[r], p1[r + 1]); b = max3f(b, p1[r + 2], p1[r + 3]); }
    float pmax = __builtin_fmaxf(a, b);
    if (ABL == 7) pmax = p0[0];
    { auto rr = __builtin_amdgcn_permlane32_swap(__float_as_uint(pmax), __float_as_uint(pmax), false, false);
      pmax = __builtin_fmaxf(__uint_as_float(rr[0]), __uint_as_float(rr[1])); }
    alpha = 1.f;
    if (__builtin_expect(first || __any(pmax > THR2), 0)) {
        const float dl = first ? pmax : __builtin_fmaxf(pmax, 0.f);
        m_reg += dl; alpha = first ? 1.f : __builtin_amdgcn_exp2f(-dl);
#pragma unroll
        for (int r = 0; r < 16; ++r) { p0[r] -= dl; p1[r] -= dl; }
    }
#pragma unroll
    for (int r = 0; r < 16; ++r) p0[r] = ABL == 1 ? p0[r] * 0.5f : __builtin_amdgcn_exp2f(p0[r]);
}
template <int ABL = 0> __device__ __forceinline__ void finishSM(f32x16& p0, f32x16& p1, float alpha, float& l_reg, bf16x8& pa0, bf16x8& pa1, bf16x8& pa2, bf16x8& pa3) {
#pragma unroll
    for (int r = 0; r < 16; ++r) p1[r] = ABL == 1 ? p1[r] * 0.5f : __builtin_amdgcn_exp2f(p1[r]);
    float ps = 0;
    if (ABL == 2) ps = p0[0] + p1[15]; else {
        float s0 = p0[0] + p0[4], s1 = p0[1] + p0[5], s2 = p0[2] + p0[6], s3 = p0[3] + p0[7];
        s0 += p0[8]; s1 += p0[9]; s2 += p0[10]; s3 += p0[11]; s0 += p0[12]; s1 += p0[13]; s2 += p0[14]; s3 += p0[15];
#pragma unroll
        for (int r = 0; r < 16; r += 4) { s0 += p1[r]; s1 += p1[r + 1]; s2 += p1[r + 2]; s3 += p1[r + 3]; }
        ps = (s0 + s1) + (s2 + s3); }
    { auto rr = __builtin_amdgcn_permlane32_swap(__float_as_uint(ps), __float_as_uint(ps), false, false);
      ps = __uint_as_float(rr[0]) + __uint_as_float(rr[1]); }
    l_reg = l_reg * alpha + ps;
#define PK4(P, BASE, OUT) do { u32x4 w = {cvtpk(P[BASE + 0], P[BASE + 1]), cvtpk(P[BASE + 2], P[BASE + 3]), cvtpk(P[BASE + 4], P[BASE + 5]), cvtpk(P[BASE + 6], P[BASE + 7])}; OUT = *reinterpret_cast<bf16x8*>(&w); } while (0)
    PK4(p0, 0, pa0); PK4(p0, 8, pa1); PK4(p1, 0, pa2); PK4(p1, 8, pa3);
#undef PK4
}
template <int NQ, int KROW, int ABL = 0> __device__ __forceinline__ void qkt(f32x16& p0, f32x16& p1, const LAS char* Ks, const bf16x8* qr, float m_ref, int r32, int hi) {
    f32x16 negm;
#pragma unroll
    for (int r = 0; r < 16; ++r) negm[r] = -m_ref;
    p0 = negm; p1 = negm;
#pragma unroll
    for (int d0 = 0; d0 < NQ; ++d0) { const int cb = d0 * 32 + hi * 16;
        const bf16x8 b0 = *(const LAS bf16x8*)(Ks + r32 * KROW + cb);
        const bf16x8 b1 = *(const LAS bf16x8*)(Ks + (32 + r32) * KROW + cb);
        if (ABL == 4) { asm volatile("" :: "v"(b0), "v"(b1)); } else {
        p0 = __builtin_amdgcn_mfma_f32_32x32x16_bf16(b0, qr[d0], p0, 0, 0, 0);
        p1 = __builtin_amdgcn_mfma_f32_32x32x16_bf16(b1, qr[d0], p1, 0, 0, 0); } }
}
template <int NC> __device__ __forceinline__ int v_st(int k, int c) { const int kk = k; return ((kk >> 3) * NC + (c >> 5)) * 512 + ((kk & 7) * 32 + (c & 31)) * 2; }
__device__ __forceinline__ int v_rd_base(int lane) { return ((lane & 3) << 3) | (((lane >> 2) & 3) << 6) | (((lane >> 4) & 1) << 5) | (((lane >> 5) & 1) << 8); }
template <int OFF> __device__ __forceinline__ s16x4 tr_read(int vb) {
    s16x4 r; asm volatile("ds_read_b64_tr_b16 %0, %1 offset:%2" : "=&v"(r) : "v"(vb), "i"(OFF) : "memory"); return r;
}
template <int NC, int D0, int ABL = 0> __device__ __forceinline__ void pv_one(f32x16& od, int vb, bf16x8 pa0, bf16x8 pa1, bf16x8 pa2, bf16x8 pa3) {
#define VOFF(ks, half) (D0 * 512 + (ks) * (NC * 1024) + (half) * (NC * 512))
    const s16x4 l0 = tr_read<VOFF(0, 0)>(vb), h0 = tr_read<VOFF(0, 1)>(vb), l1 = tr_read<VOFF(1, 0)>(vb), h1 = tr_read<VOFF(1, 1)>(vb);
    const s16x4 l2 = tr_read<VOFF(2, 0)>(vb), h2 = tr_read<VOFF(2, 1)>(vb), l3 = tr_read<VOFF(3, 0)>(vb), h3 = tr_read<VOFF(3, 1)>(vb);
#undef VOFF
    asm volatile("s_waitcnt lgkmcnt(0)" ::: "memory"); SBAR();
#define PK(L, H) (bf16x8){L[0], L[1], L[2], L[3], H[0], H[1], H[2], H[3]}
    if (ABL == 3) { asm volatile("" :: "v"(l0), "v"(h0), "v"(l1), "v"(h1), "v"(l2), "v"(h2), "v"(l3), "v"(h3)); return; }
    od = __builtin_amdgcn_mfma_f32_32x32x16_bf16(pa0, PK(l0, h0), od, 0, 0, 0);
    od = __builtin_amdgcn_mfma_f32_32x32x16_bf16(pa1, PK(l1, h1), od, 0, 0, 0);
    od = __builtin_amdgcn_mfma_f32_32x32x16_bf16(pa2, PK(l2, h2), od, 0, 0, 0);
    od = __builtin_amdgcn_mfma_f32_32x32x16_bf16(pa3, PK(l3, h3), od, 0, 0, 0);
#undef PK
}
template <int NC, int ABL = 0> __device__ __forceinline__ void pv_all(f32x16* o, int vb, bf16x8 pa0, bf16x8 pa1, bf16x8 pa2, bf16x8 pa3) {
    pv_one<NC, 0, ABL>(o[0], vb, pa0, pa1, pa2, pa3); pv_one<NC, 1, ABL>(o[1], vb, pa0, pa1, pa2, pa3);
    if constexpr (NC == 4) { pv_one<NC, 2, ABL>(o[2], vb, pa0, pa1, pa2, pa3); pv_one<NC, 3, ABL>(o[3], vb, pa0, pa1, pa2, pa3); }
}
template <int MODE> constexpr int lds_bytes() { return 4 * (64 * Cfg<MODE>::DV * 2 + 2 * (Cfg<MODE>::DQK / 16) * 1024) + 8 * 64 * 4; }

template <int MODE, int EPI, int ABL = 0>
__device__ __forceinline__ void unit_regs(const bf16* __restrict__ Qb, const bf16* __restrict__ K0, const bf16* __restrict__ K1, const bf16* __restrict__ Vh, void* Ob, int ldo, LAS char* lds, char* stash, float lam, const float* gsub) {
    using C = Cfg<MODE>;
    constexpr int DQK = C::DQK, DV = C::DV, NQ = DQK / 16, NC = DV / 32, KROW = DQK * 2 + 16, SHM_K = 64 * KROW, SHM_V = 64 * DV * 2;
    const int tid = threadIdx.x, wid = tid >> 6, lane = tid & 63, r32 = lane & 31, hi = lane >> 5;
    LAS char* V_lds = lds; LAS char* K_lds = lds + 3 * SHM_V;
    LAS float* ws = (LAS float*)(lds + 3 * SHM_V + 3 * SHM_K) + wid * 64; LAS float* li_l = ws; LAS float* al_l = ws + 32;
    float m_reg = 0.f, l_reg = 0; f32x16 o[NC]; bf16x8 qr[NQ];
#pragma unroll
    for (int d = 0; d < NC; ++d) o[d] = f32x16{};
    const bf16* Qw = Qb + (size_t)(wid * 32 + r32) * C::LDQ + hi * 8;
#pragma unroll
    for (int d0 = 0; d0 < NQ; ++d0) qr[d0] = *reinterpret_cast<const bf16x8*>(Qw + d0 * 16);
    const int vb0 = (int)(uintptr_t)V_lds + v_rd_base(lane);
    const int kr0 = tid >> 3, kc0 = tid & 7;
    const int krr = (tid & 255) >> 2, krc = tid & 3;
    const int vr0 = MODE == 0 ? (tid >> 3) : (tid >> 4), vc0 = MODE == 0 ? (tid & 7) * 8 : (tid & 15) * 8;
    const int vst0 = v_st<NC>(vr0, vc0), vst1 = v_st<NC>(32 + vr0, vc0);
    constexpr int NSET = MODE == 0 ? 2 : 1;
    struct { bf16x8 ka, kb, va, vb; } sr_[NSET];
#define SLOAD(i, k0) do { sr_[i].ka = *reinterpret_cast<const bf16x8*>(K0 + (size_t)((k0) + kr0) * C::LDK0 + kc0 * 8); \
        if (MODE == 0) { sr_[i].kb = *reinterpret_cast<const bf16x8*>(K1 + (size_t)((k0) + krr) * C::LDK1 + krc * 8); } \
        sr_[i].va = *reinterpret_cast<const bf16x8*>(Vh + (size_t)((k0) + vr0) * C::LDV + vc0); \
        if (MODE == 1) { sr_[i].vb = *reinterpret_cast<const bf16x8*>(Vh + (size_t)((k0) + 32 + vr0) * C::LDV + vc0); } } while (0)
#define SWRITE(ko, vo, i) do { *(LAS bf16x8*)(K_lds + (ko) + kr0 * KROW + kc0 * 16) = sr_[i].ka; \
        if (MODE == 0) { *(LAS bf16x8*)(K_lds + (ko) + krr * KROW + 128 + krc * 16) = sr_[i].kb; } \
        *(LAS bf16x8*)(V_lds + (vo) + vst0) = sr_[i].va; \
        if (MODE == 1) { *(LAS bf16x8*)(V_lds + (vo) + vst1) = sr_[i].vb; } } while (0)
#define SWAIT() do { if (NSET == 2) asm volatile("s_waitcnt vmcnt(3)" ::: "memory"); } while (0)
#define RESC(a) do { if (__any((a) < 1.f)) { if (hi == 0) al_l[r32] = (a); asm volatile("s_waitcnt lgkmcnt(0)" ::: "memory"); \
        _Pragma("unroll") for (int d = 0; d < NC; ++d) _Pragma("unroll") for (int r = 0; r < 16; ++r) o[d][r] *= al_l[crow(r, hi)]; } } while (0)
    f32x16 pA0, pA1, pB0, pB1; float alA = 1.f, alB = 1.f; bf16x8 pa0, pa1, pa2, pa3; constexpr int NT = NTOK / 64;
#define STEP(PC0, PC1, ALC, PP0, PP1, ALP, jj, SQ, SV, SW) do { constexpr int SETN = ((jj##_c) + 1) % NSET; \
        if (ABL != 6 && (jj) + 1 < NT) { SWAIT(); SWRITE((SW) * SHM_K, (SW) * SHM_V, SETN); } \
        SBAR(); qkt<NQ, KROW, ABL>(PC0, PC1, K_lds + (SQ) * SHM_K, qr, m_reg, r32, hi); \
        finishSM<ABL>(PP0, PP1, ALP, l_reg, pa0, pa1, pa2, pa3); SBAR(); \
        if (ABL != 6 && (jj) + 1 + NSET < NT) SLOAD(SETN, ((jj) + 1 + NSET) * 64); SBAR(); \
        pv_all<NC, ABL>(o, vb0 + (SV) * SHM_V, pa0, pa1, pa2, pa3); partialSM<ABL>(PC0, PC1, m_reg, ALC, false); \
        RESC(ALC); if (ABL != 5) __syncthreads(); } while (0)
    static_assert((NT - 2) % 6 == 0, "tile count: steps 1..NT-2 in groups of 6");
    SLOAD(0, 0); asm volatile("s_waitcnt vmcnt(0)" ::: "memory"); SWRITE(0, 0, 0);
    SLOAD(1 % NSET, 64); if (NSET == 2) SLOAD(0, 128); __syncthreads();
    SWAIT(); SWRITE(SHM_K, SHM_V, 1 % NSET);
    qkt<NQ, KROW>(pA0, pA1, K_lds, qr, m_reg, r32, hi);
    SLOAD(1 % NSET, (1 + NSET) * 64);
    partialSM(pA0, pA1, m_reg, alA, true);
    __syncthreads();
    for (int j = 1; j + 1 < NT; j += 6) {
        constexpr int j_c = 1, j1_c = 2, j2_c = 3, j3_c = 4, j4_c = 5, j5_c = 6; const int j1 = j + 1, j2 = j + 2, j3 = j + 3, j4 = j + 4, j5 = j + 5;
        STEP(pB0, pB1, alB, pA0, pA1, alA, j,  1, 0, 2);
        STEP(pA0, pA1, alA, pB0, pB1, alB, j1, 2, 1, 0);
        STEP(pB0, pB1, alB, pA0, pA1, alA, j2, 0, 2, 1);
        STEP(pA0, pA1, alA, pB0, pB1, alB, j3, 1, 0, 2);
        STEP(pB0, pB1, alB, pA0, pA1, alA, j4, 2, 1, 0);
        STEP(pA0, pA1, alA, pB0, pB1, alB, j5, 0, 2, 1);
    }
    { constexpr int jt_c = NT - 1; const int jt = NT - 1;
      STEP(pB0, pB1, alB, pA0, pA1, alA, jt, (NT - 1) % 3, (NT - 2) % 3, NT % 3); }
    finishSM(pB0, pB1, alB, l_reg, pa0, pa1, pa2, pa3); SBAR();
    pv_all<NC>(o, vb0 + ((NT - 1) % 3) * SHM_V, pa0, pa1, pa2, pa3);
#undef STEP
    if (hi == 0) li_l[r32] = l_reg; asm volatile("s_waitcnt lgkmcnt(0)" ::: "memory");
    float rli[16];
#pragma unroll
    for (int r = 0; r < 16; ++r) rli[r] = __builtin_amdgcn_rcpf(li_l[crow(r, hi)]);
    asm volatile("" : "+s"(ldo), "+s"(stash), "+s"(gsub), "+s"(Ob));
    if constexpr (MODE == 0) {
#pragma unroll
        for (int r = 0; r < 16; ++r) { const int orow = wid * 32 + crow(r, hi);
#pragma unroll
            for (int d0 = 0; d0 < NC; ++d0) ((bf16*)Ob)[(size_t)orow * ldo + d0 * 32 + r32] = (bf16)f2bf(o[d0][r] * rli[r]); }
    } else if constexpr (EPI == 1) {
        char* st = stash + wid * 8192 + lane * 16;
#pragma unroll
        for (int d0 = 0; d0 < NC; ++d0)
#pragma unroll
            for (int q = 0; q < 2; ++q) { u32x4 w;
                w.x = cvtpk(o[d0][8 * q + 0] * rli[8 * q + 0], o[d0][8 * q + 1] * rli[8 * q + 1]); w.y = cvtpk(o[d0][8 * q + 2] * rli[8 * q + 2], o[d0][8 * q + 3] * rli[8 * q + 3]);
                w.z = cvtpk(o[d0][8 * q + 4] * rli[8 * q + 4], o[d0][8 * q + 5] * rli[8 * q + 5]); w.w = cvtpk(o[d0][8 * q + 6] * rli[8 * q + 6], o[d0][8 * q + 7] * rli[8 * q + 7]);
                *(u32x4*)(st + (d0 * 2 + q) * 1024) = w; }
        asm volatile("s_waitcnt vmcnt(0)" ::: "memory");
    } else {
        const char* st = stash + wid * 8192 + lane * 16;
#pragma unroll
        for (int d0 = 0; d0 < NC; ++d0) {
            const u32x4 wa = *(const u32x4*)(st + (d0 * 2 + 0) * 1024), wb = *(const u32x4*)(st + (d0 * 2 + 1) * 1024);
            f32x16 od;
            od[0] = __builtin_bit_cast(float, wa.x << 16); od[1] = __builtin_bit_cast(float, wa.x & 0xffff0000u); od[2] = __builtin_bit_cast(float, wa.y << 16); od[3] = __builtin_bit_cast(float, wa.y & 0xffff0000u);
            od[4] = __builtin_bit_cast(float, wa.z << 16); od[5] = __builtin_bit_cast(float, wa.z & 0xffff0000u); od[6] = __builtin_bit_cast(float, wa.w << 16); od[7] = __builtin_bit_cast(float, wa.w & 0xffff0000u);
            od[8] = __builtin_bit_cast(float, wb.x << 16); od[9] = __builtin_bit_cast(float, wb.x & 0xffff0000u); od[10] = __builtin_bit_cast(float, wb.y << 16); od[11] = __builtin_bit_cast(float, wb.y & 0xffff0000u);
            od[12] = __builtin_bit_cast(float, wb.z << 16); od[13] = __builtin_bit_cast(float, wb.z & 0xffff0000u); od[14] = __builtin_bit_cast(float, wb.w << 16); od[15] = __builtin_bit_cast(float, wb.w & 0xffff0000u);
#pragma unroll
            for (int r = 0; r < 16; ++r) od[r] -= lam * (o[d0][r] * rli[r]);
            o[d0] = od;
        }
        f32x16 ssv;
#pragma unroll
        for (int r = 0; r < 16; ++r) { float x = 0.f;
#pragma unroll
            for (int d0 = 0; d0 < NC; ++d0) x += o[d0][r] * o[d0][r];
            x += __builtin_bit_cast(float, __builtin_amdgcn_update_dpp(0, __builtin_bit_cast(int, x), 0x111, 0xf, 0xf, false));
            x += __builtin_bit_cast(float, __builtin_amdgcn_update_dpp(0, __builtin_bit_cast(int, x), 0x112, 0xf, 0xf, false));
            x += __builtin_bit_cast(float, __builtin_amdgcn_update_dpp(0, __builtin_bit_cast(int, x), 0x114, 0xf, 0xf, false));
            x += __builtin_bit_cast(float, __builtin_amdgcn_update_dpp(0, __builtin_bit_cast(int, x), 0x118, 0xf, 0xf, false));
            x += __builtin_bit_cast(float, __builtin_amdgcn_update_dpp(0, __builtin_bit_cast(int, x), 0x142, 0xa, 0xf, false));
            const float t0 = __builtin_bit_cast(float, __builtin_amdgcn_readlane(__builtin_bit_cast(int, x), 31)), t1 = __builtin_bit_cast(float, __builtin_amdgcn_readlane(__builtin_bit_cast(int, x), 63));
            ssv[r] = rsqrtf((hi ? t1 : t0) * (1.f / 128.f) + EPS) * (1.f - LAM_INIT); }
#pragma unroll
        for (int d0 = 0; d0 < NC; ++d0) { const float g = gsub[d0 * 32 + r32];
#pragma unroll
            for (int r = 0; r < 16; ++r) { const int orow = wid * 32 + crow(r, hi); ((bf16*)Ob)[(size_t)orow * ldo + d0 * 32 + r32] = (bf16)f2bf(o[d0][r] * ssv[r] * g); } }
    }
    __syncthreads();
#undef SLOAD
#undef SWRITE
#undef SWAIT
#undef RESC
}

template <int NQ, int ABL = 0> __device__ __forceinline__ void qkt_c(f32x16& p0, f32x16& p1, const LAS char* Ks, const bf16x8* qr, float m_ref, int r32, int hi) {
    f32x16 negm;
#pragma unroll
    for (int r = 0; r < 16; ++r) negm[r] = -m_ref;
    p0 = negm; p1 = negm;
#pragma unroll
    for (int d0 = 0; d0 < NQ; ++d0) { const LAS char* kp = Ks + (2 * d0 + hi) * 1024 + r32 * 16;
        const bf16x8 b0 = *(const LAS bf16x8*)kp, b1 = *(const LAS bf16x8*)(kp + 512);
        p0 = __builtin_amdgcn_mfma_f32_32x32x16_bf16(b0, qr[d0], p0, 0, 0, 0);
        p1 = __builtin_amdgcn_mfma_f32_32x32x16_bf16(b1, qr[d0], p1, 0, 0, 0); }
}
template <int MODE, int EPI, int ABL = 0>
__device__ __forceinline__ void unit_dma(const bf16* __restrict__ Qb, const bf16* __restrict__ K0, const bf16* __restrict__ K1, const bf16* __restrict__ Vh, void* Ob, int ldo, LAS char* lds, char* stash, float lam, const float* gsub) {
    using C = Cfg<MODE>;
    constexpr int DQK = C::DQK, DV = C::DV, NQ = DQK / 16, NC = DV / 32, KS = 2 * NQ * 1024, VS = 64 * DV * 2, NT = NTOK / 64;
    const int tid = threadIdx.x, lane = tid & 63, r32 = lane & 31, hi = lane >> 5; const int wid = __builtin_amdgcn_readfirstlane(tid >> 6);
    LAS char* K_lds = lds; LAS char* V_lds = lds + 4 * KS;
    LAS float* ws = (LAS float*)(lds + 4 * KS + 4 * VS) + wid * 64; LAS float* li_l = ws; LAS float* al_l = ws + 32;
    const bf16* ksA = K0 + (size_t)lane * C::LDK0 + wid * 8;
    const bf16* ksB = MODE == 0 ? K1 + (size_t)lane * C::LDK1 + (wid & 3) * 8 : nullptr;
    auto vsrc = [&](int p) -> const bf16* { const int st = 2 * p + (lane >> 5), k8 = st / NC, cb = st % NC; return Vh + (size_t)(k8 * 8 + ((lane >> 2) & 7)) * C::LDV + cb * 32 + (lane & 3) * 8; };
    const bf16* vsA = vsrc(wid); const bf16* vsB = MODE == 1 ? vsrc(wid + 8) : nullptr;
#define GLDS(src, dst) __builtin_amdgcn_global_load_lds((const unsigned*)(src), (LAS unsigned*)(dst), 16, 0, 0)
#define DMA(t, sl) do { GLDS(ksA + (size_t)(t) * 64 * C::LDK0, K_lds + (sl) * KS + wid * 1024); \
        if (MODE == 0) GLDS(ksB + (size_t)(t) * 64 * C::LDK1, K_lds + (sl) * KS + (8 + (wid & 3)) * 1024); \
        GLDS(vsA + (size_t)(t) * 64 * C::LDV, V_lds + (sl) * VS + wid * 1024); \
        if (MODE == 1) GLDS(vsB + (size_t)(t) * 64 * C::LDV, V_lds + (sl) * VS + (wid + 8) * 1024); } while (0)
#define WAIT_BAR(N) asm volatile("s_waitcnt vmcnt(" #N ") lgkmcnt(0)\n\ts_barrier" ::: "memory")
#define RESC(a) do { if (__any((a) < 1.f)) { if (hi == 0) al_l[r32] = (a); asm volatile("s_waitcnt lgkmcnt(0)" ::: "memory"); \
        _Pragma("unroll") for (int d = 0; d < NC; ++d) _Pragma("unroll") for (int r = 0; r < 16; ++r) o[d][r] *= al_l[crow(r, hi)]; } } while (0)
    DMA(0, 0); DMA(1, 1);
    float m_reg = 0.f, l_reg = 0; f32x16 o[NC]; bf16x8 qr[NQ];
#pragma unroll
    for (int d = 0; d < NC; ++d) o[d] = f32x16{};
    const bf16* Qw = Qb + (size_t)(wid * 32 + r32) * C::LDQ + hi * 8;
#pragma unroll
    for (int d0 = 0; d0 < NQ; ++d0) qr[d0] = *reinterpret_cast<const bf16x8*>(Qw + d0 * 16);
    const int vb0 = (int)(uintptr_t)V_lds + v_rd_base(lane);
    f32x16 pA0, pA1, pB0, pB1; float alA = 1.f, alB = 1.f; bf16x8 pa0, pa1, pa2, pa3;
    WAIT_BAR(0);
#define STEPD(PC0, PC1, ALC, PP0, PP1, ALP, jj, SQ, SV, SW, ISSUE, NW) do { \
        if (ISSUE) DMA((jj) + 2, SW); \
        SBAR(); qkt_c<NQ, ABL>(PC0, PC1, K_lds + (SQ) * KS, qr, m_reg, r32, hi); \
        finishSM<ABL>(PP0, PP1, ALP, l_reg, pa0, pa1, pa2, pa3); SBAR(); \
        pv_all<NC, ABL>(o, vb0 + (SV) * VS, pa0, pa1, pa2, pa3); partialSM<ABL>(PC0, PC1, m_reg, ALC, false); \
        RESC(ALC); if ((NW) == 3) WAIT_BAR(3); else WAIT_BAR(0); } while (0)
    static_assert(NT == 68, "tile schedule below: steps 1..64 in groups of 4, then 65, 66, 67");
    DMA(2, 2); qkt_c<NQ, ABL>(pA0, pA1, K_lds, qr, m_reg, r32, hi); partialSM<ABL>(pA0, pA1, m_reg, alA, true); WAIT_BAR(3);
    for (int j = 1; j < 65; j += 4) {
        STEPD(pB0, pB1, alB, pA0, pA1, alA, j,     1, 0, 3, true, 3);
        STEPD(pA0, pA1, alA, pB0, pB1, alB, j + 1, 2, 1, 0, true, 3);
        STEPD(pB0, pB1, alB, pA0, pA1, alA, j + 2, 3, 2, 1, true, 3);
        STEPD(pA0, pA1, alA, pB0, pB1, alB, j + 3, 0, 3, 2, true, 3);
    }
    STEPD(pB0, pB1, alB, pA0, pA1, alA, 65, 1, 0, 3, true, 3);
    STEPD(pA0, pA1, alA, pB0, pB1, alB, 66, 2, 1, 0, false, 0);
    STEPD(pB0, pB1, alB, pA0, pA1, alA, 67, 3, 2, 1, false, 0);
    finishSM<ABL>(pB0, pB1, alB, l_reg, pa0, pa1, pa2, pa3); SBAR();
    pv_all<NC, ABL>(o, vb0 + 3 * VS, pa0, pa1, pa2, pa3);
#undef STEPD
    if (hi == 0) li_l[r32] = l_reg; asm volatile("s_waitcnt lgkmcnt(0)" ::: "memory");
    float rli[16];
#pragma unroll
    for (int r = 0; r < 16; ++r) rli[r] = __builtin_amdgcn_rcpf(li_l[crow(r, hi)]);
    asm volatile("" : "+s"(ldo), "+s"(stash), "+s"(gsub), "+s"(Ob));
    if constexpr (MODE == 0) {
#pragma unroll
        for (int r = 0; r < 16; ++r) { const int orow = wid * 32 + crow(r, hi);
#pragma unroll
            for (int d0 = 0; d0 < NC; ++d0) ((bf16*)Ob)[(size_t)orow * ldo + d0 * 32 + r32] = (bf16)f2bf(o[d0][r] * rli[r]); }
    } else if constexpr (EPI == 1) {
        char* st = stash + wid * 8192 + lane * 16;
#pragma unroll
        for (int d0 = 0; d0 < NC; ++d0)
#pragma unroll
            for (int q = 0; q < 2; ++q) { u32x4 w;
                w.x = cvtpk(o[d0][8 * q + 0] * rli[8 * q + 0], o[d0][8 * q + 1] * rli[8 * q + 1]); w.y = cvtpk(o[d0][8 * q + 2] * rli[8 * q + 2], o[d0][8 * q + 3] * rli[8 * q + 3]);
                w.z = cvtpk(o[d0][8 * q + 4] * rli[8 * q + 4], o[d0][8 * q + 5] * rli[8 * q + 5]); w.w = cvtpk(o[d0][8 * q + 6] * rli[8 * q + 6], o[d0][8 * q + 7] * rli[8 * q + 7]);
                *(u32x4*)(st + (d0 * 2 + q) * 1024) = w; }
        asm volatile("s_waitcnt vmcnt(0)" ::: "memory");
    } else {
        const char* st = stash + wid * 8192 + lane * 16;
#pragma unroll
        for (int d0 = 0; d0 < NC; ++d0) {
            const u32x4 wa = *(const u32x4*)(st + (d0 * 2 + 0) * 1024), wb = *(const u32x4*)(st + (d0 * 2 + 1) * 1024);
            f32x16 od;
            od[0] = __builtin_bit_cast(float, wa.x << 16); od[1] = __builtin_bit_cast(float, wa.x & 0xffff0000u); od[2] = __builtin_bit_cast(float, wa.y << 16); od[3] = __builtin_bit_cast(float, wa.y & 0xffff0000u);
            od[4] = __builtin_bit_cast(float, wa.z << 16); od[5] = __builtin_bit_cast(float, wa.z & 0xffff0000u); od[6] = __builtin_bit_cast(float, wa.w << 16); od[7] = __builtin_bit_cast(float, wa.w & 0xffff0000u);
            od[8] = __builtin_bit_cast(float, wb.x << 16); od[9] = __builtin_bit_cast(float, wb.x & 0xffff0000u); od[10] = __builtin_bit_cast(float, wb.y << 16); od[11] = __builtin_bit_cast(float, wb.y & 0xffff0000u);
            od[12] = __builtin_bit_cast(float, wb.z << 16); od[13] = __builtin_bit_cast(float, wb.z & 0xffff0000u); od[14] = __builtin_bit_cast(float, wb.w << 16); od[15] = __builtin_bit_cast(float, wb.w & 0xffff0000u);
#pragma unroll
            for (int r = 0; r < 16; ++r) od[r] -= lam * (o[d0][r] * rli[r]);
            o[d0] = od;
        }
        f32x16 ssv;
#pragma unroll
        for (int r = 0; r < 16; ++r) { float x = 0.f;
#pragma unroll
            for (int d0 = 0; d0 < NC; ++d0) x += o[d0][r] * o[d0][r];
            x += __builtin_bit_cast(float, __builtin_amdgcn_update_dpp(0, __builtin_bit_cast(int, x), 0x111, 0xf, 0xf, false));
            x += __builtin_bit_cast(float, __builtin_amdgcn_update_dpp(0, __builtin_bit_cast(int, x), 0x112, 0xf, 0xf, false));
            x += __builtin_bit_cast(float, __builtin_amdgcn_update_dpp(0, __builtin_bit_cast(int, x), 0x114, 0xf, 0xf, false));
            x += __builtin_bit_cast(float, __builtin_amdgcn_update_dpp(0, __builtin_bit_cast(int, x), 0x118, 0xf, 0xf, false));
            x += __builtin_bit_cast(float, __builtin_amdgcn_update_dpp(0, __builtin_bit_cast(int, x), 0x142, 0xa, 0xf, false));
            const float t0 = __builtin_bit_cast(float, __builtin_amdgcn_readlane(__builtin_bit_cast(int, x), 31)), t1 = __builtin_bit_cast(float, __builtin_amdgcn_readlane(__builtin_bit_cast(int, x), 63));
            ssv[r] = rsqrtf((hi ? t1 : t0) * (1.f / 128.f) + EPS) * (1.f - LAM_INIT); }
#pragma unroll
        for (int d0 = 0; d0 < NC; ++d0) { const float g = gsub[d0 * 32 + r32];
#pragma unroll
            for (int r = 0; r < 16; ++r) { const int orow = wid * 32 + crow(r, hi); ((bf16*)Ob)[(size_t)orow * ldo + d0 * 32 + r32] = (bf16)f2bf(o[d0][r] * ssv[r] * g); } }
    }
    __syncthreads();
#undef GLDS
#undef DMA
#undef WAIT_BAR
#undef RESC
}

template <int I> struct IC { static constexpr int value = I; };
template <int I, int N, class F> __device__ __forceinline__ void sfor(F&& f) { if constexpr (I < N) { f(IC<I>{}); sfor<I + 1, N>(f); } }
template <int MODE> struct GC {
    using C = Cfg<MODE>;
    static constexpr int NQ = C::DQK / 16, NC = C::DV / 32, NMQ = 2 * NQ, NMP = 4 * NC, NG = NMQ + NMP, KS = 2 * NQ * 1024, VS = 64 * C::DV * 2;
    static constexpr int GF = MODE == 0 ? 14 : 16, NPRE = 8, NFIN = 80, NLATE = 24, RD = 3;
    f32x16 S[2][2], o[NC], negm; bf16x8 qr[NQ], kf[NMQ]; s16x4 vl[NMP], vh[NMP]; u32x4 w[4];
    float s[4], mxa, mxb, pmax, t0, t1, m_reg, l_reg, al[2];
    const bf16 *ksA, *ksB, *vsA, *vsB; LAS char *K_lds, *V_lds; const LAS char* kb; int vb0, wid, r32, hi; LAS float* al_l;
};
template <int MODE> __device__ __forceinline__ void g_dma(GC<MODE>& c, int t, int sl) {
    using G = GC<MODE>; using C = Cfg<MODE>;
#define GLDS(src, dst) __builtin_amdgcn_global_load_lds((const unsigned*)(src), (LAS unsigned*)(dst), 16, 0, 0)
    GLDS(c.ksA + (size_t)t * 64 * C::LDK0, c.K_lds + sl * G::KS + c.wid * 1024);
    if (MODE == 0) GLDS(c.ksB + (size_t)t * 64 * C::LDK1, c.K_lds + sl * G::KS + (8 + (c.wid & 3)) * 1024);
    GLDS(c.vsA + (size_t)t * 64 * C::LDV, c.V_lds + sl * G::VS + c.wid * 1024);
    if (MODE == 1) GLDS(c.vsB + (size_t)t * 64 * C::LDV, c.V_lds + sl * G::VS + (c.wid + 8) * 1024);
#undef GLDS
}
template <int MODE, int R> __device__ __forceinline__ void g_kread(GC<MODE>& c, const LAS char* kq) { c.kf[R] = *(const LAS bf16x8*)(kq + (R >> 1) * 2048 + (R & 1) * 512); }
template <int MODE, int I> __device__ __forceinline__ void g_vread(GC<MODE>& c, int vb) {
    constexpr int NC = GC<MODE>::NC, ks = I / NC, cb = I % NC, off = cb * 512 + ks * (NC * 1024);
    c.vl[I] = __builtin_amdgcn_ds_read_tr16_b64_v4i16((LAS s16x4*)(uintptr_t)(vb + off));
    c.vh[I] = __builtin_amdgcn_ds_read_tr16_b64_v4i16((LAS s16x4*)(uintptr_t)(vb + off + NC * 512));
}
template <int MODE, int XP, int I> __device__ __forceinline__ void g_fin(GC<MODE>& c) {
    constexpr int ord[20] = {0, 1, 2, 3, 8, 4, 9, 5, 10, 6, 11, 7, 16, 12, 17, 13, 18, 14, 15, 19};
    constexpr int q = I / 20, code = ord[I % 20], ty = code >> 3, ix = code & 7, h = q >> 1, eb = 8 * (q & 1);
    if constexpr (ty == 0) c.S[XP][h][eb + ix] = __builtin_amdgcn_exp2f(c.S[XP][h][eb + ix]);
    else if constexpr (ty == 1) { if constexpr (q == 0 && ix < 4) c.s[ix] = c.S[XP][h][eb + ix]; else c.s[ix & 3] += c.S[XP][h][eb + ix]; }
    else c.w[q][ix] = cvtpk(c.S[XP][h][eb + 2 * ix], c.S[XP][h][eb + 2 * ix + 1]);
}
template <int MODE, int XC, int I> __device__ __forceinline__ void g_late(GC<MODE>& c) {
    constexpr int XP = XC ^ 1;
    if constexpr (I == 0) c.t0 = c.s[0] + c.s[1];
    else if constexpr (I == 1) c.t1 = c.s[2] + c.s[3];
    else if constexpr (I == 2) c.t0 += c.t1;
    else if constexpr (I == 3) { auto rr = __builtin_amdgcn_permlane32_swap(__float_as_uint(c.t0), __float_as_uint(c.t0), false, false); c.t0 = __uint_as_float(rr[0]); c.t1 = __uint_as_float(rr[1]); }
    else if constexpr (I == 4) c.t0 += c.t1;
    else if constexpr (I == 5) c.l_reg = c.l_reg * c.al[XP] + c.t0;
    else if constexpr (I == 6) c.mxa = max3f(c.S[XC][0][0], c.S[XC][0][1], c.S[XC][1][0]);
    else if constexpr (I == 7) c.mxb = max3f(c.S[XC][0][2], c.S[XC][0][3], c.S[XC][1][1]);
    else if constexpr (I == 8) c.mxa = max3f(c.mxa, c.S[XC][1][2], c.S[XC][1][3]);
    else if constexpr (I < 21) { constexpr int j = I - 9, r = 4 + 4 * (j / 4), sub = j % 4, h = sub >> 1, e = r + 2 * (sub & 1);
        if constexpr ((sub & 1) == 0) c.mxa = max3f(c.mxa, c.S[XC][h][e], c.S[XC][h][e + 1]); else c.mxb = max3f(c.mxb, c.S[XC][h][e], c.S[XC][h][e + 1]); }
    else if constexpr (I == 21) c.pmax = __builtin_fmaxf(c.mxa, c.mxb);
    else if constexpr (I == 22) { auto rr = __builtin_amdgcn_permlane32_swap(__float_as_uint(c.pmax), __float_as_uint(c.pmax), false, false); c.mxa = __uint_as_float(rr[0]); c.mxb = __uint_as_float(rr[1]); }
    else c.pmax = __builtin_fmaxf(c.mxa, c.mxb);
}
template <int MODE, int XC, int G> __device__ __forceinline__ void g_mfma(GC<MODE>& c) {
    using T = GC<MODE>;
    if constexpr (G < T::NMQ) { constexpr int d0 = G >> 1, h = G & 1;
        if constexpr (d0 == 0) c.S[XC][h] = __builtin_amdgcn_mfma_f32_32x32x16_bf16(c.kf[G], c.qr[d0], c.negm, 0, 0, 0);
        else c.S[XC][h] = __builtin_amdgcn_mfma_f32_32x32x16_bf16(c.kf[G], c.qr[d0], c.S[XC][h], 0, 0, 0);
    } else { constexpr int i = G - T::NMQ, ks = i / T::NC, cb = i % T::NC;
        const bf16x8 vf = {c.vl[i][0], c.vl[i][1], c.vl[i][2], c.vl[i][3], c.vh[i][0], c.vh[i][1], c.vh[i][2], c.vh[i][3]};
        c.o[cb] = __builtin_amdgcn_mfma_f32_32x32x16_bf16(__builtin_bit_cast(bf16x8, c.w[ks]), vf, c.o[cb], 0, 0, 0); }
}
#define G_WAIT_BAR(N) asm volatile("s_waitcnt vmcnt(" #N ") lgkmcnt(0)\n\ts_barrier" ::: "memory")
#define G_RESC(a) do { if (__any((a) < 1.f)) { if (c.hi == 0) c.al_l[c.r32] = (a); asm volatile("s_waitcnt lgkmcnt(0)" ::: "memory"); \
        _Pragma("unroll") for (int d = 0; d < T::NC; ++d) _Pragma("unroll") for (int r = 0; r < 16; ++r) c.o[d][r] *= c.al_l[crow(r, c.hi)]; } } while (0)
template <int MODE, int XC, int SQ, int SV, int SW, bool ISSUE, int NW> __device__ __forceinline__ void g_step(GC<MODE>& c, int t) {
    using T = GC<MODE>; constexpr int XP = XC ^ 1;
    if constexpr (ISSUE) g_dma<MODE>(c, t + 2, SW);
    const LAS char* kq = c.kb + SQ * T::KS; const int vb = c.vb0 + SV * T::VS;
    sfor<0, T::RD>([&](auto i) { g_kread<MODE, decltype(i)::value>(c, kq); });
    sfor<0, T::NPRE>([&](auto i) { g_fin<MODE, XP, decltype(i)::value>(c); });
    SBAR();
    sfor<0, T::NG>([&](auto gi) { constexpr int g = decltype(gi)::value, r = g + T::RD;
        g_mfma<MODE, XC, g>(c);
        if constexpr (r < T::NMQ) g_kread<MODE, r>(c, kq); else if constexpr (r < T::NG) g_vread<MODE, r - T::NMQ>(c, vb);
        if constexpr (g < T::GF) { constexpr int lo = T::NPRE + g * (T::NFIN - T::NPRE) / T::GF, hi = T::NPRE + (g + 1) * (T::NFIN - T::NPRE) / T::GF;
            sfor<lo, hi>([&](auto i) { g_fin<MODE, XP, decltype(i)::value>(c); });
        } else { constexpr int lo = (g - T::GF) * T::NLATE / (T::NG - T::GF), hi = (g - T::GF + 1) * T::NLATE / (T::NG - T::GF);
            sfor<lo, hi>([&](auto i) { g_late<MODE, XC, decltype(i)::value>(c); }); }
        SBAR(); });
    c.al[XC] = 1.f;
    if (__builtin_expect(__any(c.pmax > THR2), 0)) {
        const float dl = __builtin_fmaxf(c.pmax, 0.f); c.m_reg += dl; c.al[XC] = __builtin_amdgcn_exp2f(-dl);
#pragma unroll
        for (int r = 0; r < 16; ++r) { c.S[XC][0][r] -= dl; c.S[XC][1][r] -= dl; c.negm[r] = -c.m_reg; }
    }
    asm volatile("" : "+v"(c.negm));
    G_RESC(c.al[XC]);
    if constexpr (NW == 3) G_WAIT_BAR(3); else G_WAIT_BAR(0);
}
template <int MODE, int EPI, int ABL = 0>
__device__ __forceinline__ void unit_gap(const bf16* __restrict__ Qb, const bf16* __restrict__ K0, const bf16* __restrict__ K1, const bf16* __restrict__ Vh, void* Ob, int ldo, LAS char* lds, char* stash, float lam, const float* gsub) {
    using C = Cfg<MODE>; using T = GC<MODE>;
    constexpr int NQ = T::NQ, NC = T::NC, KS = T::KS, VS = T::VS, NT = NTOK / 64;
    int tid_ = threadIdx.x; asm volatile("" : "+v"(tid_));
    const int tid = tid_, lane = tid & 63, r32 = lane & 31, hi = lane >> 5; const int wid = __builtin_amdgcn_readfirstlane(tid >> 6);
    GC<MODE> c;
    c.K_lds = lds; c.V_lds = lds + 4 * KS; c.wid = wid; c.r32 = r32; c.hi = hi;
    LAS float* ws = (LAS float*)(lds + 4 * KS + 4 * VS) + wid * 64; LAS float* li_l = ws; LAS float* al_l = ws + 32; c.al_l = al_l;
    c.ksA = K0 + (size_t)lane * C::LDK0 + wid * 8;
    c.ksB = MODE == 0 ? K1 + (size_t)lane * C::LDK1 + (wid & 3) * 8 : nullptr;
    auto vsrc = [&](int p) -> const bf16* { const int st = 2 * p + (lane >> 5), k8 = st / NC, cb = st % NC; return Vh + (size_t)(k8 * 8 + ((lane >> 2) & 7)) * C::LDV + cb * 32 + (lane & 3) * 8; };
    c.vsA = vsrc(wid); c.vsB = MODE == 1 ? vsrc(wid + 8) : nullptr;
    c.kb = c.K_lds + hi * 1024 + r32 * 16; c.vb0 = (int)(uintptr_t)c.V_lds + v_rd_base(lane);
    g_dma<MODE>(c, 0, 0); g_dma<MODE>(c, 1, 1);
    c.m_reg = 0.f; c.l_reg = 0.f; c.al[0] = c.al[1] = 1.f;
#pragma unroll
    for (int d = 0; d < NC; ++d) c.o[d] = f32x16{};
    const bf16* Qw = Qb + (size_t)(wid * 32 + r32) * C::LDQ + hi * 8;
#pragma unroll
    for (int d0 = 0; d0 < NQ; ++d0) c.qr[d0] = *reinterpret_cast<const bf16x8*>(Qw + d0 * 16);
    G_WAIT_BAR(0);
    static_assert(NT == 68, "tile schedule below: steps 1..64 in groups of 4, then 65, 66, 67");
    {
        g_dma<MODE>(c, 2, 2);
        c.negm = f32x16{};
        sfor<0, T::NMQ>([&](auto i) { g_kread<MODE, decltype(i)::value>(c, c.kb); });
        sfor<0, T::NMQ>([&](auto i) { g_mfma<MODE, 0, decltype(i)::value>(c); });
        sfor<6, T::NLATE>([&](auto i) { g_late<MODE, 0, decltype(i)::value>(c); });
        c.m_reg = c.pmax;
#pragma unroll
        for (int r = 0; r < 16; ++r) { c.S[0][0][r] -= c.pmax; c.S[0][1][r] -= c.pmax; c.negm[r] = -c.m_reg; }
        asm volatile("" : "+v"(c.negm));
        G_WAIT_BAR(3);
    }
    for (int j = 1; j < 65; j += 4) {
        g_step<MODE, 1, 1, 0, 3, true, 3>(c, j);
        g_step<MODE, 0, 2, 1, 0, true, 3>(c, j + 1);
        g_step<MODE, 1, 3, 2, 1, true, 3>(c, j + 2);
        g_step<MODE, 0, 0, 3, 2, true, 3>(c, j + 3);
    }
    g_step<MODE, 1, 1, 0, 3, true, 3>(c, 65);
    g_step<MODE, 0, 2, 1, 0, false, 0>(c, 66);
    g_step<MODE, 1, 3, 2, 1, false, 0>(c, 67);
    {
        const int vb = c.vb0 + 3 * VS;
        sfor<0, T::NMP>([&](auto i) { g_vread<MODE, decltype(i)::value>(c, vb); });
        sfor<0, T::NFIN>([&](auto i) { g_fin<MODE, 1, decltype(i)::value>(c); });
        sfor<0, 6>([&](auto i) { g_late<MODE, 0, decltype(i)::value>(c); });
        sfor<0, T::NMP>([&](auto i) { g_mfma<MODE, 0, T::NMQ + decltype(i)::value>(c); });
    }
    f32x16 (&o)[NC] = c.o; float& l_reg = c.l_reg;
    if (hi == 0) li_l[r32] = l_reg; asm volatile("s_waitcnt lgkmcnt(0)" ::: "memory");
    float rli[16];
#pragma unroll
    for (int r = 0; r < 16; ++r) rli[r] = __builtin_amdgcn_rcpf(li_l[crow(r, hi)]);
    asm volatile("" : "+s"(ldo), "+s"(stash), "+s"(gsub), "+s"(Ob));
    if constexpr (MODE == 0) {
#pragma unroll
        for (int r = 0; r < 16; ++r) { const int orow = wid * 32 + crow(r, hi);
#pragma unroll
            for (int d0 = 0; d0 < NC; ++d0) ((bf16*)Ob)[(size_t)orow * ldo + d0 * 32 + r32] = (bf16)f2bf(o[d0][r] * rli[r]); }
    } else if constexpr (EPI == 1) {
        char* st = stash + wid * 8192 + lane * 16;
#pragma unroll
        for (int d0 = 0; d0 < NC; ++d0)
#pragma unroll
            for (int q = 0; q < 2; ++q) { u32x4 w;
                w.x = cvtpk(o[d0][8 * q + 0] * rli[8 * q + 0], o[d0][8 * q + 1] * rli[8 * q + 1]); w.y = cvtpk(o[d0][8 * q + 2] * rli[8 * q + 2], o[d0][8 * q + 3] * rli[8 * q + 3]);
                w.z = cvtpk(o[d0][8 * q + 4] * rli[8 * q + 4], o[d0][8 * q + 5] * rli[8 * q + 5]); w.w = cvtpk(o[d0][8 * q + 6] * rli[8 * q + 6], o[d0][8 * q + 7] * rli[8 * q + 7]);
                *(u32x4*)(st + (d0 * 2 + q) * 1024) = w; }
        asm volatile("s_waitcnt vmcnt(0)" ::: "memory");
    } else {
        const char* st = stash + wid * 8192 + lane * 16;
#pragma unroll
        for (int d0 = 0; d0 < NC; ++d0) {
            const u32x4 wa = *(const u32x4*)(st + (d0 * 2 + 0) * 1024), wb = *(const u32x4*)(st + (d0 * 2 + 1) * 1024);
            f32x16 od;
            od[0] = __builtin_bit_cast(float, wa.x << 16); od[1] = __builtin_bit_cast(float, wa.x & 0xffff0000u); od[2] = __builtin_bit_cast(float, wa.y << 16); od[3] = __builtin_bit_cast(float, wa.y & 0xffff0000u);
            od[4] = __builtin_bit_cast(float, wa.z << 16); od[5] = __builtin_bit_cast(float, wa.z & 0xffff0000u); od[6] = __builtin_bit_cast(float, wa.w << 16); od[7] = __builtin_bit_cast(float, wa.w & 0xffff0000u);
            od[8] = __builtin_bit_cast(float, wb.x << 16); od[9] = __builtin_bit_cast(float, wb.x & 0xffff0000u); od[10] = __builtin_bit_cast(float, wb.y << 16); od[11] = __builtin_bit_cast(float, wb.y & 0xffff0000u);
            od[12] = __builtin_bit_cast(float, wb.z << 16); od[13] = __builtin_bit_cast(float, wb.z & 0xffff0000u); od[14] = __builtin_bit_cast(float, wb.w << 16); od[15] = __builtin_bit_cast(float, wb.w & 0xffff0000u);
#pragma unroll
            for (int r = 0; r < 16; ++r) od[r] -= lam * (o[d0][r] * rli[r]);
            o[d0] = od;
        }
        f32x16 ssv;
#pragma unroll
        for (int r = 0; r < 16; ++r) { float x = 0.f;
#pragma unroll
            for (int d0 = 0; d0 < NC; ++d0) x += o[d0][r] * o[d0][r];
            x += __builtin_bit_cast(float, __builtin_amdgcn_update_dpp(0, __builtin_bit_cast(int, x), 0x111, 0xf, 0xf, false));
            x += __builtin_bit_cast(float, __builtin_amdgcn_update_dpp(0, __builtin_bit_cast(int, x), 0x112, 0xf, 0xf, false));
            x += __builtin_bit_cast(float, __builtin_amdgcn_update_dpp(0, __builtin_bit_cast(int, x), 0x114, 0xf, 0xf, false));
            x += __builtin_bit_cast(float, __builtin_amdgcn_update_dpp(0, __builtin_bit_cast(int, x), 0x118, 0xf, 0xf, false));
            x += __builtin_bit_cast(float, __builtin_amdgcn_update_dpp(0, __builtin_bit_cast(int, x), 0x142, 0xa, 0xf, false));
            const float t0 = __builtin_bit_cast(float, __builtin_amdgcn_readlane(__builtin_bit_cast(int, x), 31)), t1 = __builtin_bit_cast(float, __builtin_amdgcn_readlane(__builtin_bit_cast(int, x), 63));
            ssv[r] = rsqrtf((hi ? t1 : t0) * (1.f / 128.f) + EPS) * (1.f - LAM_INIT); }
#pragma unroll
        for (int d0 = 0; d0 < NC; ++d0) { const float g = gsub[d0 * 32 + r32];
#pragma unroll
            for (int r = 0; r < 16; ++r) { const int orow = wid * 32 + crow(r, hi); ((bf16*)Ob)[(size_t)orow * ldo + d0 * 32 + r32] = (bf16)f2bf(o[d0][r] * ssv[r] * g); } }
    }
    __syncthreads();
}
#undef G_WAIT_BAR
#undef G_RESC

#ifndef GAPM0
#define GAPM0 1
#endif
#ifndef GAPM1
#define GAPM1 1
#endif
template <int MODE, int EPI, int ABL = 0>
__device__ __forceinline__ void unit(const bf16* __restrict__ Qb, const bf16* __restrict__ K0, const bf16* __restrict__ K1, const bf16* __restrict__ Vh, void* Ob, int ldo, LAS char* lds, char* stash, float lam, const float* gsub) {
    if constexpr ((MODE == 0 && GAPM0) || (MODE == 1 && GAPM1)) unit_gap<MODE, EPI, ABL>(Qb, K0, K1, Vh, Ob, ldo, lds, stash, lam, gsub);
    else unit_dma<MODE, EPI, ABL>(Qb, K0, K1, Vh, Ob, ldo, lds, stash, lam, gsub);
}


#undef SBAR
}

#define XB_TMO      128
#define XB_XCNT(j)  (256  + 64 * (j))
#define XB_XSUB(j)  (1280 + 64 * (j))
#define XB_XGEN(j)  (2304 + 64 * (j))
#define XB_TOP      3328
#define XB_TOPGEN   3392
#define XCD_BAR_WORDS 3456
#define XB_SPIN_CAP (1u << 20)
__device__ __forceinline__ unsigned xb_ld(unsigned* p)              { return __hip_atomic_load(p, __ATOMIC_RELAXED, __HIP_MEMORY_SCOPE_AGENT); }
__device__ __forceinline__ unsigned xb_add(unsigned* p, unsigned v) { return __hip_atomic_fetch_add(p, v, __ATOMIC_RELAXED, __HIP_MEMORY_SCOPE_AGENT); }
__device__ __forceinline__ unsigned xb_xcc_id() { return (unsigned)__builtin_amdgcn_s_getreg((3 << 11) | 20) & 0xFu; }
#define XB_SPIN(cond, bar) do { unsigned _sp = 0; while (cond) { __builtin_amdgcn_s_sleep(1); \
    if ((++_sp & 255u) == 0u) { if (xb_ld(&(bar)[XB_TMO])) break; if (_sp > XB_SPIN_CAP) { atomicAdd(&(bar)[XB_TMO], 1u); break; } } } } while (0)
struct XcdBarrier { unsigned* bar; unsigned x; volatile LAS unsigned* st; };
__device__ __forceinline__ XcdBarrier xcd_barrier_post(unsigned* bar, volatile LAS unsigned* st) {
    XcdBarrier b; b.bar = bar; b.x = xb_xcc_id(); b.st = st;
    if (threadIdx.x == 0) (void)xb_add(&bar[XB_XCNT(b.x)], 1u);
    return b;
}
__device__ __forceinline__ void xcd_barrier_complete(unsigned* bar, unsigned x, unsigned& nloc, unsigned& nx) {
    const unsigned G = gridDim.x * gridDim.y * gridDim.z;
    unsigned sum, cnt, mine, sp = 0u;
    for (;;) {
        sum = 0u; cnt = 0u; mine = 0u;
#pragma unroll
        for (unsigned j = 0; j < 16; ++j) { const unsigned c = xb_ld(&bar[XB_XCNT(j)]); sum += c; cnt += (c > 0u) ? 1u : 0u; mine = (j == x) ? c : mine; }
        if (sum == G) break;
        __builtin_amdgcn_s_sleep(1);
        if ((++sp & 255u) == 0u) { if (xb_ld(&bar[XB_TMO])) break; if (sp > XB_SPIN_CAP) { atomicAdd(&bar[XB_TMO], 1u); break; } }
    }
    nloc = mine > 0u ? mine : 1u; nx = cnt > 0u ? cnt : 1u;
}
__device__ __forceinline__ void xcd_barrier(const XcdBarrier& b) {
    asm volatile("s_waitcnt vmcnt(0)" ::: "memory");
    __syncthreads();
    if (threadIdx.x == 0) {
        unsigned* bar = b.bar;
        __builtin_amdgcn_s_waitcnt(0);
        unsigned nloc = b.st[0], nx = b.st[1];
        if (nloc == 0u) { xcd_barrier_complete(bar, b.x, nloc, nx); b.st[0] = nloc; b.st[1] = nx; }
        const unsigned old = xb_add(&bar[XB_XSUB(b.x)], 1u);
        const unsigned gen = old / nloc;
        if (old + 1u == (gen + 1u) * nloc) {
            __builtin_amdgcn_fence(__ATOMIC_RELEASE, "agent");
            asm volatile("s_waitcnt vmcnt(0)" ::: "memory");
            const unsigned og = xb_add(&bar[XB_TOP], 1u);
            const unsigned tg = og / nx;
            if (og + 1u == (tg + 1u) * nx) xb_add(&bar[XB_TOPGEN], 1u);
            else XB_SPIN(xb_ld(&bar[XB_TOPGEN]) == tg, bar);
            __builtin_amdgcn_fence(__ATOMIC_ACQUIRE, "agent");
            xb_add(&bar[XB_XGEN(b.x)], 1u);
            asm volatile("s_waitcnt vmcnt(0)" ::: "memory");
        } else {
            XB_SPIN(xb_ld(&bar[XB_XGEN(b.x)]) == gen, bar);
            __builtin_amdgcn_fence(__ATOMIC_ACQUIRE, "agent");
            asm volatile("s_waitcnt vmcnt(0)" ::: "memory");
        }
    }
    __syncthreads();
}

constexpr int NWAVES = 8;
constexpr int RING_BYTES = 131072, LDS_BYTES = 147456, LDSCTL_OFF = LDS_BYTES - 2048, MISC_OFF = LDSCTL_OFF + 320, UCACHE_OFF = LDSCTL_OFF + 1024  ;

struct Frame {
    LAS unsigned char* lds; volatile LAS unsigned* MISC; unsigned* ctl;
    int tid, lane, wave, vcu, G;
    Ptrs P;
    __device__ __forceinline__ LAS char* lds_c() const { return (LAS char*)lds; }
};

template <class SrcF> __device__ __forceinline__ void transpose_item(const SrcF& f, int K, bf16* WT, int p0, int k0, LAS float* scr, int lane) {
    float t[32];
#pragma unroll
    for (int i = 0; i < 32; ++i) t[i] = f(k0 + 2 * i + (lane >> 5), p0 + (lane & 31));
#pragma unroll
    for (int i = 0; i < 32; ++i) scr[(2 * i + (lane >> 5)) * 33 + (lane & 31)] = t[i];
    LDS_WAIT(); asm volatile("" ::: "memory");
    const int c = lane & 7;
#pragma unroll
    for (int j = 0; j < 4; ++j) { const int n = (lane >> 3) + 8 * j; const LAS float* s = scr + (8 * c) * 33 + n;
        u32x4 o; o.x = cvt_pk_bf16(s[0 * 33], s[1 * 33]); o.y = cvt_pk_bf16(s[2 * 33], s[3 * 33]); o.z = cvt_pk_bf16(s[4 * 33], s[5 * 33]); o.w = cvt_pk_bf16(s[6 * 33], s[7 * 33]);
        *(u32x4*)(WT + (size_t)(p0 + n) * K + k0 + 8 * c) = o; }
    LDS_WAIT(); asm volatile("" ::: "memory");
}
struct SrcWin { const float* w; __device__ float operator()(int k, int p) const { const int l = p1_logical(p); return l < 0 ? 0.f : w[(size_t)k * IN_COLS + l]; } };
struct SrcWup { const float *gq, *wuq, *gkv, *wukv;
    __device__ float operator()(int k, int p) const {
        if (p < 768) return k < 256 ? gq[k] * wuq[(size_t)k * 768 + qm_logical(p)] : 0.f;
        return k >= 256 ? gkv[k - 256] * wukv[(size_t)(k - 256) * 1024 + (p - 768)] : 0.f; } };
__host__ __device__ __forceinline__ int ctx_dstcol(int cp) { return cp < 128 ? 256 + cp : cp < 160 ? 384 + (cp - 128) : cp < 672 ? 1024 + (cp - 160) : cp < 1184 ? 1536 + (cp - 672) : -1; }
struct SrcCtx { const float* w; __device__ float operator()(int k, int p) const { const int c = ctx_dstcol(p); const int l = c < 0 ? -1 : p1_logical(c); return l < 0 ? 0.f : w[(size_t)k * IN_COLS + l]; } };
struct SrcPlain { const float* w; int N; int coff; __device__ float operator()(int k, int p) const { return w[(size_t)k * N + p + coff]; } };

__device__ __forceinline__ void ph0_prep(Frame& F) {
    LAS float* scr = (LAS float*)(F.lds + F.wave * 16384);
    const int gw = F.vcu * NWAVES + F.wave, NGW = F.G * NWAVES, lane = F.lane;
    const Ptrs& P = F.P; unsigned char* ws = P.ws;
    constexpr int I_IN = 16 * 64, I_UP = 6 * 56, I_OUT = 16 * 32, I_R = 16 * 8, I_CTX = 16 * 38, I_SMALL = I_IN + I_UP + I_OUT + I_R + I_CTX;
    for (int it = gw; it < I_SMALL; it += NGW) {
        int r = it;
        if (r < I_IN) { transpose_item(SrcWin{P.in[8]}, 1024, (bf16*)(ws + WS_WIN), (r % 64) * 32, (r / 64) * 64, scr, lane); continue; } r -= I_IN;
        if (r < I_UP) { transpose_item(SrcWup{P.in[9], P.in[10], P.in[11], P.in[12]}, 384, (bf16*)(ws + WS_WUP), (r % 56) * 32, (r / 56) * 64, scr, lane); continue; } r -= I_UP;
        if (r < I_OUT) { transpose_item(SrcPlain{P.in[18], 1024, 0}, 1024, (bf16*)(ws + WS_WOUT), (r % 32) * 32, (r / 32) * 64, scr, lane); continue; } r -= I_OUT;
        if (r < I_R) { transpose_item(SrcPlain{P.in[19], 256, 0}, 1024, (bf16*)(ws + WS_WR), (r % 8) * 32, (r / 8) * 64, scr, lane); continue; } r -= I_R;
        transpose_item(SrcCtx{P.in[8]}, 1024, (bf16*)(ws + WS_WCTX), (r % 38) * 32, (r / 38) * 64, scr, lane);
    }
    for (int it = gw; it < 96 * 16; it += NGW) {
        const int cg = it % 96, kp = it / 96;
#pragma unroll
        for (int r = 0; r < 5; ++r) { const float c = (r < 4 ? P.in[1] + r * DM : P.in[3])[kp * 64 + lane]; scr[r * 64 + lane] = c / (1.f + __expf(-c)); }
        LDS_WAIT(); asm volatile("" ::: "memory");
        float acc[5] = {0.f, 0.f, 0.f, 0.f, 0.f};
        const float* W = P.in[4] + (size_t)(kp * 64) * 6144 + cg * 64 + lane;
#pragma unroll 8
        for (int kk = 0; kk < 64; ++kk) { const float w = W[(size_t)kk * 6144];
#pragma unroll
            for (int r = 0; r < 5; ++r) acc[r] += scr[r * 64 + kk] * w; }
        LDS_WAIT(); asm volatile("" ::: "memory");
#pragma unroll
        for (int r = 0; r < 5; ++r) ((float*)(ws + WS_MODP))[(size_t)(kp * 5 + r) * 6144 + cg * 64 + lane] = acc[r];
    }
    { const int idx = (F.vcu * 512 + F.tid);
      if (idx < 1024) { const int v = idx / 16, f = idx % 16; const float th = (float)v * exp2f(-(float)f / 16.f * 13.287712379549449f);
          ((float2*)(ws + WS_TAB))[idx] = make_float2(__builtin_amdgcn_cosf(th * 0.15915494309189535f), __builtin_amdgcn_sinf(th * 0.15915494309189535f)); }
      else if (idx < 1536) { const int i2 = idx - 1024, v = i2 / 8, f = i2 % 8; const float th = (float)v * exp2f(-(float)f / 8.f * 13.287712379549449f);
          ((float2*)(ws + WS_TAB))[idx] = make_float2(__builtin_amdgcn_cosf(th * 0.15915494309189535f), __builtin_amdgcn_sinf(th * 0.15915494309189535f)); } }
}
struct CvItem { const float* src; int ld; bf16* dst; int K; };
__device__ __forceinline__ CvItem cv_decode(const Ptrs& P, int it, int lane) {
    constexpr int IPE = 256 + 128; unsigned char* ws = P.ws;
    const int e = it / IPE; int r = it % IPE; CvItem c;
    if (r < 256) { const int p0 = (r % 16) * 32, k0 = (r / 16) * 64, half = p0 >> 8, up = (p0 >> 7) & 1;
        const float* w = e < 256 ? (up ? P.in[22] : P.in[21]) + (size_t)e * DM * EFF : (up ? P.in[25] : P.in[24]);
        c.src = w + (size_t)(k0 + (lane >> 5)) * EFF + half * 128 + (p0 & 127) + (lane & 31); c.ld = EFF; c.K = 1024;
        c.dst = (bf16*)(ws + WS_W13) + ((size_t)e * 512 + p0) * 1024 + k0; }
    else { r -= 256; const int p0 = (r % 32) * 32, k0 = (r / 32) * 64;
        const float* w = e < 256 ? P.in[23] + (size_t)e * EFF * DM : P.in[26];
        c.src = w + (size_t)(k0 + (lane >> 5)) * DM + p0 + (lane & 31); c.ld = DM; c.K = 256;
        c.dst = (bf16*)(ws + WS_W2) + ((size_t)e * 1024 + p0) * 256 + k0; }
    return c;
}
#ifndef CVV
#define CVV 3
#endif
#ifndef CVP
#define CVP 0
#endif
#define CV_LOAD(t, c) do { _Pragma("unroll") for (int _i = 0; _i < 32; ++_i) { if (CVP == 2 && probe) t[_i] = (float)_i; else if (CVV == 3) t[_i] = __builtin_nontemporal_load((c).src + (size_t)(2 * _i) * (c).ld); else t[_i] = (c).src[(size_t)(2 * _i) * (c).ld]; } } while (0)
#define CV_FINISH(t, c) do { _Pragma("unroll") for (int _i = 0; _i < 32; ++_i) scr[(2 * _i + (lane >> 5)) * 33 + (lane & 31)] = t[_i]; \
        LDS_WAIT(); asm volatile("" ::: "memory"); const int _c = lane & 7; \
        _Pragma("unroll") for (int _j = 0; _j < 4; ++_j) { const int _n = (lane >> 3) + 8 * _j; const LAS float* _s = scr + (8 * _c) * 33 + _n; \
            u32x4 _o; _o.x = cvt_pk_bf16(_s[0 * 33], _s[1 * 33]); _o.y = cvt_pk_bf16(_s[2 * 33], _s[3 * 33]); _o.z = cvt_pk_bf16(_s[4 * 33], _s[5 * 33]); _o.w = cvt_pk_bf16(_s[6 * 33], _s[7 * 33]); \
            if (!(CVP == 1 && probe)) *(u32x4*)((c).dst + (size_t)_n * (c).K + 8 * _c) = _o; else asm volatile("" :: "v"(_o)); } \
        LDS_WAIT(); asm volatile("" ::: "memory"); } while (0)
constexpr int CV_EARLY = 0;
__device__ __forceinline__ void ph0_experts(Frame& F, int r_from, int r_to, bool probe = false) {
    LAS float* scr = (LAS float*)(F.lds + F.wave * 16384);
    const int gw = F.vcu * NWAVES + F.wave, NGW = F.G * NWAVES, lane = F.lane, NIT = 257 * 384;
    const Ptrs& P = F.P;
    float ta[32], tb[32];
    const long lim = (long)gw + (long)(r_to < (1 << 20) ? r_to : (1 << 20)) * NGW; const int NE = (int)(lim < NIT ? lim : NIT);
    int it = gw + r_from * NGW; CvItem ca, cb;
    if (it < NE) { ca = cv_decode(P, it, lane); CV_LOAD(ta, ca); }
    for (; it < NE; it += 2 * NGW) {
        const int it2 = it + NGW, it3 = it + 2 * NGW;
        if (it2 < NE) { cb = cv_decode(P, it2, lane); CV_LOAD(tb, cb); }
        CV_FINISH(ta, ca);
        if (it3 < NE) { ca = cv_decode(P, it3, lane); CV_LOAD(ta, ca); }
        if (it2 < NE) CV_FINISH(tb, cb);
    }
    __syncthreads();
}
#undef CV_LOAD
#undef CV_FINISH
__device__ __forceinline__ void ph1_xn(Frame& F) {
    const Ptrs& P = F.P; unsigned char* ws = P.ws; const int lane = F.lane, wave = F.wave, fr = lane & 15, fq = lane >> 4;
    const float* MODP = (const float*)(ws + WS_MODP);
    for (int idx = F.vcu * 512 + F.tid; idx < 5 * 6144; idx += F.G * 512) { const int r = idx / 6144, j = idx % 6144; float a = P.in[5][j];
#pragma unroll
        for (int kp = 0; kp < 16; ++kp) a += MODP[(size_t)(kp * 5 + r) * 6144 + j];
        ((float*)(ws + WS_MOD))[idx] = a; }
    LAS unsigned char* At = F.lds;
    LAS float* sm = (LAS float*)(F.lds + 32768);
    const int t0 = F.vcu * 64, bl = t0 / SEQ;
    for (int i = F.tid; i < 4096; i += 512) { const int j = i & 2047, mrow = i < 2048 ? bl : 4; float a = P.in[5][j];
#pragma unroll
        for (int kp = 0; kp < 16; ++kp) a += MODP[(size_t)(kp * 5 + mrow) * 6144 + j];
        sm[i] = a; }
    __syncthreads();
    {
        f32x4 v[4], nv[4];
        { const f32x4* xr = (const f32x4*)(P.in[0] + (size_t)(t0 + wave * 8) * DM) + lane;
#pragma unroll
          for (int j = 0; j < 4; ++j) v[j] = xr[64 * j]; }
#pragma unroll 1
        for (int i = 0; i < 8; ++i) {
            const int t = t0 + wave * 8 + i, r = bl * NTOK + NCTX + (t - bl * SEQ);
            { const f32x4* xr = (const f32x4*)(P.in[0] + (size_t)(i < 7 ? t + 1 : t) * DM) + lane;
#pragma unroll
              for (int j = 0; j < 4; ++j) nv[j] = xr[64 * j]; }
            float s = 0.f;
#pragma unroll
            for (int j = 0; j < 4; ++j) s += (v[j][0] * v[j][0] + v[j][1] * v[j][1]) + (v[j][2] * v[j][2] + v[j][3] * v[j][3]);
            const float rs = rsqrtf(wave_sum(s) * (1.f / DM) + EPS);
            u32x2* o8 = (u32x2*)((bf16*)(ws + WS_XN) + (size_t)r * DM) + lane;
#pragma unroll
            for (int j = 0; j < 4; ++j) { const int c = 4 * lane + 256 * j; const f32x4 g = *(const f32x4*)(P.in[6] + c);
                const f32x4 sh = *(const LAS f32x4*)(sm + c), sc = *(const LAS f32x4*)(sm + 1024 + c);
                const f32x4 y = (v[j] * rs * g) * (sc + 1.f) + sh;
                u32x2 w; w.x = cvt_pk_bf16(y[0], y[1]); w.y = cvt_pk_bf16(y[2], y[3]); o8[64 * j] = w; }
#pragma unroll
            for (int j = 0; j < 4; ++j) v[j] = nv[j];
        }
    }
    const int mt = F.vcu >> 2, q = F.vcu & 3, bc = mt >> 4, nc0 = (mt & 15) * 16;
#pragma unroll 1
    for (int i = 0; i < 2; ++i) {
        const int r = 2 * wave + i;
        const f32x4* xr = (const f32x4*)(P.in[2] + ((size_t)bc * NCTX + nc0 + r) * DM) + lane;
        f32x4 v[4]; float s = 0.f;
#pragma unroll
        for (int j = 0; j < 4; ++j) { v[j] = xr[64 * j]; s += (v[j][0] * v[j][0] + v[j][1] * v[j][1]) + (v[j][2] * v[j][2] + v[j][3] * v[j][3]); }
        const float rs = rsqrtf(wave_sum(s) * (1.f / DM) + EPS);
#pragma unroll
        for (int j = 0; j < 4; ++j) { const int c = 4 * lane + 256 * j; const f32x4 g = *(const f32x4*)(P.in[6] + c);
            const f32x4 sh = *(const LAS f32x4*)(sm + 2048 + c), sc = *(const LAS f32x4*)(sm + 3072 + c);
            const f32x4 y = (v[j] * rs * g) * (sc + 1.f) + sh;
            u32x2 w; w.x = cvt_pk_bf16(y[0], y[1]); w.y = cvt_pk_bf16(y[2], y[3]);
            const int ch = (lane >> 1) + 32 * j;
            *(LAS u32x2*)(At + r * 2048 + ((ch ^ r) << 4) + (lane & 1) * 8) = w; }
    }
    __syncthreads();
    {
        const int nt0 = wave < 3 ? 3 * wave : 9 + 2 * (wave - 3), nnt = wave < 3 ? 3 : 2;
        const bf16* wb = (const bf16*)(ws + WS_WCTX) + (size_t)(q * 304 + nt0 * 16 + fr) * 1024 + 8 * fq;
        f32x4 acc[3];
#pragma unroll
        for (int j = 0; j < 3; ++j) acc[j] = (f32x4){0.f, 0.f, 0.f, 0.f};
        bf16x8 bq[4][3], nb[4][3];
#pragma unroll
        for (int u = 0; u < 4; ++u)
#pragma unroll
            for (int j = 0; j < 3; ++j) bq[u][j] = (j < nnt) ? *(const bf16x8*)(wb + (size_t)j * 16 * 1024 + 32 * u) : bf16x8{};
#pragma unroll 1
        for (int k4 = 0; k4 < 8; ++k4) {
            if (k4 < 7) {
#pragma unroll
                for (int u = 0; u < 4; ++u)
#pragma unroll
                    for (int j = 0; j < 3; ++j) nb[u][j] = (j < nnt) ? *(const bf16x8*)(wb + (size_t)j * 16 * 1024 + 32 * (4 * (k4 + 1) + u)) : bf16x8{}; }
#pragma unroll
            for (int u = 0; u < 4; ++u) { const int ch = 4 * (4 * k4 + u) + fq;
                const bf16x8 a = *(const LAS bf16x8*)(At + fr * 2048 + ((ch ^ fr) << 4));
#pragma unroll
                for (int j = 0; j < 3; ++j) acc[j] = __builtin_amdgcn_mfma_f32_16x16x32_bf16(bq[u][j], a, acc[j], 0, 0, 0); }
#pragma unroll
            for (int u = 0; u < 4; ++u)
#pragma unroll
                for (int j = 0; j < 3; ++j) bq[u][j] = nb[u][j];
        }
        const int r = bc * NTOK + nc0 + fr; bf16* P1 = (bf16*)(ws + WS_P1); float ssq = 0.f;
#pragma unroll
        for (int j = 0; j < 3; ++j) if (j < nnt) { const int cp = q * 304 + (nt0 + j) * 16 + 4 * fq, dc = ctx_dstcol(cp);
            if (dc >= 0) { u32x2 w; w.x = cvt_pk_bf16(acc[j][0], acc[j][1]); w.y = cvt_pk_bf16(acc[j][2], acc[j][3]); *(u32x2*)(P1 + (size_t)r * NP1 + dc) = w; }
            if (cp < 128) ssq += (acc[j][0] * acc[j][0] + acc[j][1] * acc[j][1]) + (acc[j][2] * acc[j][2] + acc[j][3] * acc[j][3]); }
        if (q == 0 && wave < 4) { ssq += __shfl_xor(ssq, 16); ssq += __shfl_xor(ssq, 32);
            if (fq == 0) ((float*)(ws + WS_SSQ))[(size_t)r * 8 + 4 + wave] = ssq; }
    }
    __syncthreads();
}
__device__ __forceinline__ void ph6_h2(Frame& F) {
    const Ptrs& P = F.P; unsigned char* ws = P.ws;
    const int gw = F.vcu * NWAVES + F.wave, NGW = F.G * NWAVES;
    f32x4 v[4], nv[4];
    if (gw < MLAT) { const f32x4* xr = (const f32x4*)((const float*)(ws + WS_X1) + (size_t)gw * DM) + F.lane;
#pragma unroll
        for (int j = 0; j < 4; ++j) v[j] = xr[64 * j]; }
    for (int t = gw; t < MLAT; t += NGW) {
        const int b = t / SEQ; const float* md = (const float*)(ws + WS_MOD) + b * 6144;
        { const int tn = t + NGW < MLAT ? t + NGW : t; const f32x4* xr = (const f32x4*)((const float*)(ws + WS_X1) + (size_t)tn * DM) + F.lane;
#pragma unroll
          for (int j = 0; j < 4; ++j) nv[j] = xr[64 * j]; }
        float s = 0.f;
#pragma unroll
        for (int j = 0; j < 4; ++j) s += (v[j][0] * v[j][0] + v[j][1] * v[j][1]) + (v[j][2] * v[j][2] + v[j][3] * v[j][3]);
        const float rs = rsqrtf(wave_sum(s) * (1.f / DM) + EPS);
        u32x2* o8 = (u32x2*)((bf16*)(ws + WS_H2) + (size_t)t * DM) + F.lane;
#pragma unroll
        for (int j = 0; j < 4; ++j) { const int c = 4 * F.lane + 256 * j; const f32x4 g = *(const f32x4*)(P.in[7] + c);
            const f32x4 sh = *(const f32x4*)(md + 3072 + c), sc = *(const f32x4*)(md + 4096 + c);
            const f32x4 y = (v[j] * rs * g) * (sc + 1.f) + sh;
            u32x2 w; w.x = cvt_pk_bf16(y[0], y[1]); w.y = cvt_pk_bf16(y[2], y[3]); o8[64 * j] = w; }
#pragma unroll
        for (int j = 0; j < 4; ++j) v[j] = nv[j];
    }
}
__device__ __forceinline__ void ph7_route(Frame& F) {
    const Ptrs& P = F.P; unsigned char* ws = P.ws; const int lane = F.lane;
    const int gw = F.vcu * NWAVES + F.wave, NGW = F.G * NWAVES;
    const f32x4 bi = ((const f32x4*)P.in[20])[lane];
    for (int t = gw; t < MLAT; t += NGW) {
        f32x4 lg = ((const f32x4*)(ws + WS_LOGP))[(size_t)t * 64 + lane];
#pragma unroll
        for (int kp = 1; kp < 4; ++kp) lg += ((const f32x4*)(ws + WS_LOGP))[((size_t)kp * MLAT + t) * 64 + lane];
        float s[4], v[4];
#pragma unroll
        for (int i = 0; i < 4; ++i) { s[i] = 1.f / (1.f + __expf(-lg[i])); v[i] = s[i] + bi[i]; }
        float m1 = fmaxf(v[0], v[1]), m2 = fminf(v[0], v[1]);
#pragma unroll
        for (int i = 2; i < 4; ++i) { const float x = v[i]; m2 = fmaxf(m2, fminf(m1, x)); m1 = fmaxf(m1, x); }
#pragma unroll
        for (int o = 1; o < 8; o <<= 1) { const float b1 = __shfl_xor(m1, o), b2 = __shfl_xor(m2, o); const float n1 = fmaxf(m1, b1), n2 = fmaxf(fminf(m1, b1), fmaxf(m2, b2)); m1 = n1; m2 = n2; }
        const float gs = m1 + m2; const int g = lane >> 3; int rank = 0;
#pragma unroll
        for (int j = 0; j < 8; ++j) { const float o = __shfl(gs, j * 8); rank += (o > gs || (o == gs && j < g)) ? 1 : 0; }
        if (rank >= 4) { v[0] = v[1] = v[2] = v[3] = -INFINITY; }
        int my_e = 0; float my_s = 0.f, ssum = 0.f;
#pragma unroll
        for (int k = 0; k < 8; ++k) {
            float bv = v[0]; int bi_ = 0;
#pragma unroll
            for (int i = 1; i < 4; ++i) if (v[i] > bv) { bv = v[i]; bi_ = i; }
            int be = lane * 4 + bi_;
#pragma unroll
            for (int o = 1; o < 64; o <<= 1) { const float ov = __shfl_xor(bv, o); const int oe = __shfl_xor(be, o); if (ov > bv || (ov == bv && oe < be)) { bv = ov; be = oe; } }
            const int wl = be >> 2, wi = be & 3;
            float sv = wi == 0 ? s[0] : wi == 1 ? s[1] : wi == 2 ? s[2] : s[3];
            sv = __shfl(sv, wl);
            if (lane == wl) { if (wi == 0) v[0] = -INFINITY; else if (wi == 1) v[1] = -INFINITY; else if (wi == 2) v[2] = -INFINITY; else v[3] = -INFINITY; }
            ssum += sv; if (lane == k) { my_e = be; my_s = sv; }
        }
        if (lane < 8) {
            int* cnt = (int*)(ws + WS_CTL) + CW_COUNT;
            const int rk = atomicAdd(&cnt[my_e], 1);
            ((int*)(ws + WS_EIDX))[(size_t)t * 8 + lane] = my_e;
            ((float*)(ws + WS_EW))[(size_t)t * 8 + lane] = my_s / ssum * 2.5f;
            ((int*)(ws + WS_ERANK))[(size_t)t * 8 + lane] = rk;
        }
    }
}
__device__ __forceinline__ void ph_route3(Frame& F) {
    const Ptrs& P = F.P; unsigned char* ws = P.ws; const int lane = F.lane, wave = F.wave, fr = lane & 15, fq = lane >> 4;
    LAS unsigned char* At = F.lds;
    const bf16* Wr = (const bf16*)(ws + WS_WR);
    const f32x4 bi = ((const f32x4*)P.in[20])[lane];
    for (int grp = F.vcu; grp < MLAT / 64; grp += F.G) {
        const int t0 = grp * 64, b = t0 / SEQ; const float* md = (const float*)(ws + WS_MOD) + b * 6144;
        u32x4 v[2], nv[2];
        { const u32x4* xr = (const u32x4*)((const bf16*)(ws + WS_X1) + (size_t)(t0 + wave * 8) * DM) + lane; v[0] = xr[0]; v[1] = xr[64]; }
#pragma unroll 1
        for (int i = 0; i < 8; ++i) {
            const int r = wave * 8 + i, t = t0 + r;
            { const int rn = i < 7 ? t + 1 : t; const u32x4* xr = (const u32x4*)((const bf16*)(ws + WS_X1) + (size_t)rn * DM) + lane; nv[0] = xr[0]; nv[1] = xr[64]; }
            float xf[2][8]; float s = 0.f;
#pragma unroll
            for (int h = 0; h < 2; ++h)
#pragma unroll
                for (int d = 0; d < 4; ++d) { xf[h][2 * d] = bflo(v[h][d]); xf[h][2 * d + 1] = bfhi(v[h][d]); s += xf[h][2 * d] * xf[h][2 * d] + xf[h][2 * d + 1] * xf[h][2 * d + 1]; }
            const float rs = rsqrtf(wave_sum(s) * (1.f / DM) + EPS);
#pragma unroll
            for (int h = 0; h < 2; ++h) { const int c = 8 * lane + 512 * h; f32x4 y[2];
#pragma unroll
                for (int q = 0; q < 2; ++q) { const f32x4 g = *(const f32x4*)(P.in[7] + c + 4 * q), sh = *(const f32x4*)(md + 3072 + c + 4 * q), sc = *(const f32x4*)(md + 4096 + c + 4 * q);
                    const f32x4 xv = {xf[h][4 * q], xf[h][4 * q + 1], xf[h][4 * q + 2], xf[h][4 * q + 3]}; y[q] = (xv * rs * g) * (sc + 1.f) + sh; }
                const u32x4 w = pack8(y[0], y[1]);
                *(u32x4*)((bf16*)(ws + WS_H2) + (size_t)t * DM + c) = w;
                const int ch = lane + 64 * h;
                *(LAS u32x4*)(At + r * 2048 + ((ch ^ (r & 15)) << 4)) = w; }
            v[0] = nv[0]; v[1] = nv[1];
        }
        __syncthreads();
        f32x4 acc[4][2];
#pragma unroll
        for (int m = 0; m < 4; ++m) { acc[m][0] = (f32x4){0.f, 0.f, 0.f, 0.f}; acc[m][1] = (f32x4){0.f, 0.f, 0.f, 0.f}; }
        const bf16* wb = Wr + (size_t)(wave * 32 + fr) * 1024 + 8 * fq;
        bf16x8 bq[4][2], nb[4][2];
#pragma unroll
        for (int u = 0; u < 4; ++u) { bq[u][0] = *(const bf16x8*)(wb + 32 * u); bq[u][1] = *(const bf16x8*)(wb + 16 * 1024 + 32 * u); }
#pragma unroll 1
        for (int k4 = 0; k4 < 8; ++k4) {
            if (k4 < 7) {
#pragma unroll
                for (int u = 0; u < 4; ++u) { nb[u][0] = *(const bf16x8*)(wb + 32 * (4 * (k4 + 1) + u)); nb[u][1] = *(const bf16x8*)(wb + 16 * 1024 + 32 * (4 * (k4 + 1) + u)); } }
#pragma unroll
            for (int u = 0; u < 4; ++u) { const int ks = 4 * k4 + u, ch = 4 * ks + fq;
#pragma unroll
                for (int m = 0; m < 4; ++m) { const int r = 16 * m + fr;
                    const bf16x8 a = *(const LAS bf16x8*)(At + r * 2048 + ((ch ^ (r & 15)) << 4));
                    acc[m][0] = __builtin_amdgcn_mfma_f32_16x16x32_bf16(bq[u][0], a, acc[m][0], 0, 0, 0);
                    acc[m][1] = __builtin_amdgcn_mfma_f32_16x16x32_bf16(bq[u][1], a, acc[m][1], 0, 0, 0); } }
#pragma unroll
            for (int u = 0; u < 4; ++u) { bq[u][0] = nb[u][0]; bq[u][1] = nb[u][1]; }
        }
        __syncthreads();
        LAS float* Lg = (LAS float*)F.lds;
#pragma unroll
        for (int m = 0; m < 4; ++m)
#pragma unroll
            for (int n = 0; n < 2; ++n) *(LAS f32x4*)(Lg + (16 * m + fr) * 260 + wave * 32 + 16 * n + 4 * fq) = acc[m][n];
        __syncthreads();
#pragma unroll 1
        for (int i = 0; i < 8; ++i) {
            const int r = wave * 8 + i, t = t0 + r;
            const f32x4 lg = *(const LAS f32x4*)(Lg + r * 260 + 4 * lane);
            float s[4], vv[4];
#pragma unroll
            for (int q = 0; q < 4; ++q) { s[q] = 1.f / (1.f + __expf(-lg[q])); vv[q] = s[q] + bi[q]; }
            float m1 = fmaxf(vv[0], vv[1]), m2 = fminf(vv[0], vv[1]);
#pragma unroll
            for (int q = 2; q < 4; ++q) { const float x = vv[q]; m2 = fmaxf(m2, fminf(m1, x)); m1 = fmaxf(m1, x); }
#pragma unroll
            for (int o = 1; o < 8; o <<= 1) { const float b1 = __shfl_xor(m1, o), b2 = __shfl_xor(m2, o); const float n1 = fmaxf(m1, b1), n2 = fmaxf(fminf(m1, b1), fmaxf(m2, b2)); m1 = n1; m2 = n2; }
            const float gs = m1 + m2; const int g = lane >> 3; int rank = 0;
#pragma unroll
            for (int j = 0; j < 8; ++j) { const float o = __builtin_bit_cast(float, __builtin_amdgcn_readlane(__builtin_bit_cast(int, gs), j * 8)); rank += (o > gs || (o == gs && j < g)) ? 1 : 0; }
            unsigned key[4];
#pragma unroll
            for (int q = 0; q < 4; ++q) key[q] = rank >= 4 ? 0u : ((__builtin_bit_cast(unsigned, vv[q] + 1.f) & 0xFFFFFF00u) | (unsigned)(255 - (lane * 4 + q)));
            int my_e = 0; float my_s = 0.f, ssum = 0.f;
#pragma unroll
            for (int k = 0; k < 8; ++k) {
                unsigned kb = max(max(key[0], key[1]), max(key[2], key[3]));
                kb = max(kb, (unsigned)__builtin_amdgcn_update_dpp(0, (int)kb, 0x111, 0xf, 0xf, false));
                kb = max(kb, (unsigned)__builtin_amdgcn_update_dpp(0, (int)kb, 0x112, 0xf, 0xf, false));
                kb = max(kb, (unsigned)__builtin_amdgcn_update_dpp(0, (int)kb, 0x114, 0xf, 0xf, false));
                kb = max(kb, (unsigned)__builtin_amdgcn_update_dpp(0, (int)kb, 0x118, 0xf, 0xf, false));
                kb = max(kb, (unsigned)__builtin_amdgcn_update_dpp(0, (int)kb, 0x142, 0xa, 0xf, false));
                kb = max(kb, (unsigned)__builtin_amdgcn_update_dpp(0, (int)kb, 0x143, 0xc, 0xf, false));
                const unsigned kw = (unsigned)__builtin_amdgcn_readlane((int)kb, 63);
                const int be = 255 - (int)(kw & 255u), wl = be >> 2, wi = be & 3;
                const float ssel = wi == 0 ? s[0] : wi == 1 ? s[1] : wi == 2 ? s[2] : s[3];
                const float sv = __builtin_bit_cast(float, __builtin_amdgcn_readlane(__builtin_bit_cast(int, ssel), wl));
#pragma unroll
                for (int q = 0; q < 4; ++q) key[q] = key[q] == kw ? 0u : key[q];
                ssum += sv; if (lane == k) { my_e = be; my_s = sv; }
            }
            if (lane < 8) {
                int* cnt = (int*)(ws + WS_CTL) + CW_COUNT;
                const int rk = atomicAdd(&cnt[my_e], 1);
                ((int*)(ws + WS_EIDX))[(size_t)t * 8 + lane] = my_e;
                ((float*)(ws + WS_EW))[(size_t)t * 8 + lane] = my_s / ssum * 2.5f;
                ((int*)(ws + WS_ERANK))[(size_t)t * 8 + lane] = rk;
            }
        }
        __syncthreads();
    }
}
__device__ __forceinline__ void ph8_slots(Frame& F) {
    const Ptrs& P = F.P; unsigned char* ws = P.ws;
    LAS int* off = (LAS int*)F.lds;
    LAS int* cfs = off + 260;
    LAS int* chs = off + 520;
    unsigned* cnt = (unsigned*)(ws + WS_CTL) + CW_COUNT;
    if (F.wave == 0) { const int lane = F.lane; int n[4], cf[4], ch[4], sn = 0, sf = 0, sh = 0;
#pragma unroll
        for (int i = 0; i < 4; ++i) { n[i] = (int)cnt[4 * lane + i]; const int r = n[i] & 255; cf[i] = (n[i] >> 8) + (r > 128 ? 1 : 0); ch[i] = (r > 0 && r <= 128) ? 1 : 0; sn += n[i]; sf += cf[i]; sh += ch[i]; }
        int in = sn, jf = sf, jh = sh;
#pragma unroll
        for (int o = 1; o < 64; o <<= 1) { const int tn = __shfl_up(in, o), tf = __shfl_up(jf, o), th = __shfl_up(jh, o); if (lane >= o) { in += tn; jf += tf; jh += th; } }
        int an = in - sn, af = jf - sf, ah = jh - sh;
#pragma unroll
        for (int i = 0; i < 4; ++i) { off[4 * lane + i] = an; cfs[4 * lane + i] = af; chs[4 * lane + i] = ah; an += n[i]; af += cf[i]; ah += ch[i]; }
        if (lane == 63) { off[256] = an; cfs[256] = af; chs[256] = ah; off[257] = NSLOT; cfs[257] = af + MLAT / 256; chs[257] = ah; } }
    __syncthreads();
    for (int idx = F.vcu * 512 + F.tid; idx < MLAT * 8; idx += F.G * 512) {
        const int e = ((const int*)(ws + WS_EIDX))[idx], rk = ((const int*)(ws + WS_ERANK))[idx];
        const int slot = off[e] + rk;
        ((int*)(ws + WS_SLOTOF))[idx] = slot; ((int*)(ws + WS_SLOTTOK))[slot] = idx >> 3; ((float*)(ws + WS_SLOTW))[slot] = ((const float*)(ws + WS_EW))[idx];
        if (idx < MLAT) { ((int*)(ws + WS_SLOTTOK))[MLAT * 8 + idx] = idx; ((float*)(ws + WS_SLOTW))[MLAT * 8 + idx] = 1.f; }
    }
    if (F.vcu == 0) {
        int* go = (int*)(ws + WS_OFF); int* ut = (int*)(ws + WS_UT);
        const int nfull = cfs[257];
        for (int e = F.tid; e < 258; e += 512) go[e] = off[e];
        for (int e = F.tid; e < 257; e += 512) { const int n = off[e + 1] - off[e], nf = cfs[e + 1] - cfs[e], nh = chs[e + 1] - chs[e];
            for (int j = 0; j < nf; ++j) { int* u = ut + (cfs[e] + j) * 4; u[0] = e; u[1] = off[e] + j * 256; u[2] = min(256, n - j * 256); u[3] = 0; }
            if (nh) { int* u = ut + (nfull + chs[e]) * 4; u[0] = e; u[1] = off[e] + nf * 256; u[2] = n - nf * 256; u[3] = 0; } }
        if (F.tid == 0) { ((int*)(ws + WS_CTL))[CW_NUNIT] = nfull + chs[257]; ((int*)(ws + WS_CTL))[CW_NFULL] = nfull; }
    }
    __syncthreads();
}
__device__ __forceinline__ void ph11_combine(Frame& F) {
    const Ptrs& P = F.P; unsigned char* ws = P.ws; const int lane = F.lane;
    const int gw = F.vcu * NWAVES + F.wave, NGW = F.G * NWAVES;
    const unsigned char* Y = (const unsigned char*)(ws + WS_Y);
    const int cbase = 256 * (lane >> 4) + 32 * ((lane >> 2) & 3) + 8 * (lane & 3);
    u32x4 yw[9], nyw[9]; u32x4 xw[2], nxw[2]; int nsl[8];
    auto ldslots = [&](int t) {
#pragma unroll
        for (int k = 0; k < 8; ++k) nsl[k] = ((const int*)(ws + WS_SLOTOF))[(size_t)t * 8 + k]; };
    auto ldrows = [&](int t) {
#pragma unroll
        for (int k = 0; k < 9; ++k) { const int sl = k < 8 ? nsl[k] : MLAT * 8 + t; nyw[k] = *(const u32x4*)(Y + (size_t)sl * DM + lane * 16); }
        nxw[0] = *(const u32x4*)((const bf16*)(ws + WS_X1) + (size_t)t * DM + cbase); nxw[1] = *(const u32x4*)((const bf16*)(ws + WS_X1) + (size_t)t * DM + cbase + 128); };
    if (gw < MLAT) { ldslots(gw); ldrows(gw); if (gw + NGW < MLAT) ldslots(gw + NGW); }
    for (int t = gw; t < MLAT; t += NGW) {
        const int b = t / SEQ; const float* gt2 = (const float*)(ws + WS_MOD) + b * 6144 + 5120;
#pragma unroll
        for (int k = 0; k < 9; ++k) yw[k] = nyw[k];
        xw[0] = nxw[0]; xw[1] = nxw[1];
        if (t + NGW < MLAT) { ldrows(t + NGW); if (t + 2 * NGW < MLAT) ldslots(t + 2 * NGW); }
        float a[16];
#pragma unroll
        for (int i = 0; i < 16; ++i) a[i] = 0.f;
#pragma unroll
        for (int k = 0; k < 9; ++k)
#pragma unroll
            for (int d = 0; d < 4; ++d) { const int w = (int)yw[k][d];
                const f32x2 lo = __builtin_amdgcn_cvt_pk_f32_fp8(w, false), hi = __builtin_amdgcn_cvt_pk_f32_fp8(w, true);
                a[4 * d + 0] += lo[0]; a[4 * d + 1] += lo[1]; a[4 * d + 2] += hi[0]; a[4 * d + 3] += hi[1]; }
        float ss = 0.f;
#pragma unroll
        for (int q = 0; q < 4; ++q) { const int c = cbase + (q >> 1) * 128 + (q & 1) * 4; const u32x4 xb = xw[q >> 1]; const unsigned x01 = (q & 1) ? xb.z : xb.x, x23 = (q & 1) ? xb.w : xb.y;
            const f32x4 xv = {bflo(x01), bfhi(x01), bflo(x23), bfhi(x23)}, gv = *(const f32x4*)(gt2 + c);
#pragma unroll
            for (int e = 0; e < 4; ++e) { const float v = xv[e] + gv[e] * (a[q * 4 + e] * (1.f / YSCALE)); a[q * 4 + e] = v; ss += v * v; } }
        const float rs = rsqrtf(wave_sum(ss) * (1.f / DM) + EPS);
#pragma unroll
        for (int q = 0; q < 4; ++q) { const int c = cbase + (q >> 1) * 128 + (q & 1) * 4; const f32x4 gf = *(const f32x4*)(P.in[27] + c);
            f32x4 o;
#pragma unroll
            for (int e = 0; e < 4; ++e) o[e] = a[q * 4 + e] * rs * gf[e];
            *(f32x4*)(P.out + (size_t)t * DM + c) = o; }
    }
}
__device__ __forceinline__ void ph4b_diff_finish(Frame& F) {
    const Ptrs& P = F.P; unsigned char* ws = P.ws; const int lane = F.lane;
    const int gw = F.vcu * NWAVES + F.wave, NGW = F.G * NWAVES;
    float d1 = P.in[13][lane] * P.in[14][lane], d2 = P.in[15][lane] * P.in[16][lane];
    d1 = wave_sum(d1); d2 = wave_sum(d2);
    const float lam = __expf(d1) - __expf(d2) + LAM_INIT;
    const float g0 = P.in[17][lane], g1 = P.in[17][64 + lane];
    for (int t = gw; t < MLAT; t += NGW) {
        const float* os = (const float*)(ws + WS_OS) + (size_t)t * 8 * 128;
        float x[4][4];
#pragma unroll
        for (int h = 0; h < 4; ++h) { x[h][0] = os[(2 * h) * 128 + lane]; x[h][1] = os[(2 * h) * 128 + 64 + lane]; x[h][2] = os[(2 * h + 1) * 128 + lane]; x[h][3] = os[(2 * h + 1) * 128 + 64 + lane]; }
#pragma unroll
        for (int h = 0; h < 4; ++h) {
            const float v0 = x[h][0] - lam * x[h][2], v1 = x[h][1] - lam * x[h][3];
            const float rs = rsqrtf(wave_sum(v0 * v0 + v1 * v1) * (1.f / 128.f) + EPS) * (1.f - LAM_INIT);
            bf16* mo = (bf16*)(ws + WS_MIX) + (size_t)t * DM + 512 + h * 128;
            mo[lane] = (bf16)f2bf(v0 * rs * g0); mo[64 + lane] = (bf16)f2bf(v1 * rs * g1); }
    }
}

#ifdef PROBE_UNITS
struct ProbeOrder { int n, c; __device__ bool next(int i, Unit& u) const { if (i >= n) return false; u.pm = (c * n + i) % 60; u.pn = (c + i) % 8; u.r0 = u.pm * 256; u.nv = 256; u.k0 = 0; return true; }
    __device__ __forceinline__ int a_row(const Unit& u, int r) const { return u.pm * 256 + r; } };
struct EpiProbe { static constexpr bool PERM = true; bf16* O; int mode;
    __device__ __forceinline__ void operator()(const Acc& acc, const Unit& u, int wr, int wc, int fr, int fq) const {
        if (mode == 0) {
#pragma unroll
            for (int ai = 0; ai < 2; ++ai)
#pragma unroll
                for (int bj = 0; bj < 2; ++bj)
#pragma unroll
                    for (int m = 0; m < 4; ++m) { asm volatile("" :: "v"(acc[ai][bj][m][0]), "v"(acc[ai][bj][m][1])); }
        } else {
            const int row0 = u.pm * 256 + wr * 64 + fr, col0 = u.pn * 256 + (mode == 2 ? wc * 64 : wc * 32) + 8 * fq; const int bjo = mode == 2 ? 32 : 128;
#pragma unroll
            for (int ai = 0; ai < 2; ++ai)
#pragma unroll
                for (int m = 0; m < 4; ++m) { if (mode == 7 && (ai | m)) { asm volatile("" :: "v"(acc[ai][0][m][0]), "v"(acc[ai][0][m][1]), "v"(acc[ai][1][m][0]), "v"(acc[ai][1][m][1])); continue; } bf16* rowp = mode == 8 ? O + (size_t)u.pm * 256 * NP1 + (size_t)(((wr * 4 + wc) * 8 + ai * 4 + m) * 2) * 512 + (fq * 16 + fr) * 8 : mode == 4 ? O + (size_t)blockIdx.x * 65536 + (size_t)(wr * 64 + fr + ai * 128 + m * 16) * 256 + wc * 32 + 8 * fq : O + (size_t)(row0 + ai * 128 + m * 16) * (mode == 3 ? NP1 + 64 : NP1) + col0;
                    *(u32x4*)(rowp) = pack8(acc[ai][0][m][0], acc[ai][0][m][1]); *(u32x4*)(rowp + (mode == 8 ? 512 : mode == 4 ? 128 : bjo)) = pack8(acc[ai][1][m][0], acc[ai][1][m][1]); }
        }
    }
};
#endif

enum { P_PREP = 0, P_XN, P_INPROJ, P_UP, P_ATTN, P_DIFFFIN, P_OUT, P_H2, P_ROUTER, P_ROUTE, P_SLOTS, P_EXP1, P_EXP2, P_COMB, P_PROBE, P_END };
struct Args { Ptrs P; int ph_lo, ph_hi, li, pad; };
__global__ void __launch_bounds__(NWAVES * 64, 2) mk_fwd(Args args) {
    extern __shared__ __attribute__((aligned(16))) unsigned char lds[];
    Frame F;
    F.lds = (LAS unsigned char*)lds; F.MISC = (volatile LAS unsigned*)(F.lds + MISC_OFF);
    F.tid = threadIdx.x; F.lane = F.tid & 63; F.wave = __builtin_amdgcn_readfirstlane(F.tid >> 6);
    F.G = gridDim.x; { const int bx = blockIdx.x; F.vcu = (F.G % 8 == 0) ? (bx % 8) * (F.G / 8) + bx / 8 : bx; }
    F.P = args.P; unsigned char* ws = args.P.ws; F.ctl = (unsigned*)(ws + WS_CTL);
    for (int u = F.tid; u < (LDS_BYTES - LDSCTL_OFF) / 4; u += NWAVES * 64) ((LAS unsigned*)(F.lds + LDSCTL_OFF))[u] = 0u;
    __syncthreads();
    XcdBarrier bar = xcd_barrier_post(F.ctl + CW_BAR + args.li * XCD_BAR_WORDS, F.MISC + 8);
    const int lo = args.ph_lo, hi = args.ph_hi;
#ifndef PHMASK
#define PHMASK 0xFFFF
#endif
#define IN(k) ((((PHMASK) >> (k)) & 1) && lo <= (k) && (k) < hi)
#define SKEW(ticks) do { const unsigned long long t0_ = __builtin_amdgcn_s_memrealtime(); const unsigned long long w_ = (unsigned long long)((F.vcu & 3) * (ticks)); while (__builtin_amdgcn_s_memrealtime() - t0_ < w_) __builtin_amdgcn_s_sleep(8); } while (0)
#define SEAM(k) do { if (IN(k) && IN((k) + 1)) xcd_barrier(bar); } while (0)
#define SEAM_SKIP1(k) do { if (IN(k) && IN((k) + 2)) xcd_barrier(bar); } while (0)
#define SEAM_SKIP2(k) do { if (IN(k) && IN((k) + 3)) xcd_barrier(bar); } while (0)
    if (IN(P_PREP)) { ph0_prep(F); } SEAM(P_PREP);
    if (IN(P_XN)) { ph1_xn(F); } SEAM(P_XN);
    if (IN(P_INPROJ)) {
        pg8::Gemm g{(const bf16*)(ws + WS_XN), (const bf16*)(ws + WS_WIN), 1024, 1024, 1024}; LatOrder S; S.init(MLAT, NP1, F.G, (int)blockIdx.x);
        EpiInProj E{(bf16*)(ws + WS_P1), (float*)(ws + WS_SSQ), (const float2*)(ws + WS_TAB), (const float2*)(ws + WS_TAB) + 1024};
#ifdef SKEW_INPROJ
        SKEW(SKEW_INPROJ);
#endif
        pg8::gemm_phase(F.lds, g, S, E);
        if (CV_EARLY > 0 && (int)blockIdx.x >= (MALL / 256) * (NP1 / 256) - 2 * F.G) ph0_experts(F, 0, CV_EARLY);
    } SEAM(P_INPROJ);
    if (IN(P_UP)) {
        pg8::Gemm g{(const bf16*)(ws + WS_P1), (const bf16*)(ws + WS_WUP), 2048, 384, 256}; UpOrder S{F.G, F.vcu};
        EpiUp E{(bf16*)(ws + WS_QM), (bf16*)(ws + WS_KVM), (const float*)(ws + WS_SSQ), (const float2*)(ws + WS_TAB) + 1024};
        pg8::gemm_phase(F.lds, g, S, E);
    } SEAM(P_UP);
    if (IN(P_ATTN)) {
        const bf16* P1 = (const bf16*)(ws + WS_P1); const bf16* QM = (const bf16*)(ws + WS_QM); const bf16* KVM = (const bf16*)(ws + WS_KVM);
        const int cslot = F.vcu % 5; int ui = 0;
        bool conv_done = false; int U = F.vcu;
        const int conv_from = ((int)blockIdx.x >= (MALL / 256) * (NP1 / 256) - 2 * F.G) ? CV_EARLY : 0;
        for (; U < 512; U += F.G, ++ui) {
            if (ui == cslot) { ph0_experts(F, conv_from, 1 << 30); conv_done = true; }
            const int bh = U >> 4, qb = U & 15, b = bh >> 3, hh = bh & 7;
            const bf16* K0 = KVM + (size_t)b * NTOK * 1024 + hh * 128;
            attn::unit<0, 0>(QM + (size_t)(b * NTOK + NCTX + qb * 256) * 768 + hh * 96, K0, P1 + (size_t)b * NTOK * NP1 + 384, K0 + 64,
                             (bf16*)(ws + WS_MIX) + (size_t)(b * SEQ + qb * 256) * DM + hh * 64, DM, F.lds_c(), nullptr, 0.f, nullptr);
        }
        char* stash = (char*)(ws + WS_OS) + (size_t)F.vcu * 65536;
        const int Ud0 = U;
        for (; U < 768; U += 1024, ++ui) {
            if (ui == cslot) { ph0_experts(F, conv_from, 1 << 30); conv_done = true; }
            const int Up = U - 512, bh = Up >> 4, qb = Up & 15, b = bh >> 2, h = bh & 3;
            const bf16* Pb = P1 + (size_t)b * NTOK * NP1;
            attn::unit<1, 1>(P1 + (size_t)(b * NTOK + NCTX + qb * 256) * NP1 + 512 + (2 * h) * 64, Pb + 1024 + (2 * h) * 64, nullptr, Pb + 1536 + h * 128, nullptr, 0, F.lds_c(),
                             stash, 0.f, nullptr);
        }
        for (U = Ud0; U < 768; U += 1024, ++ui) {
            if (ui == cslot) { ph0_experts(F, conv_from, 1 << 30); conv_done = true; }
            const int Up = U - 512, bh = Up >> 4, qb = Up & 15, b = bh >> 2, h = bh & 3;
            const bf16* Pb = P1 + (size_t)b * NTOK * NP1;
            float lam; { float d1 = F.P.in[13][F.lane] * F.P.in[14][F.lane], d2 = F.P.in[15][F.lane] * F.P.in[16][F.lane]; d1 = wave_sum(d1); d2 = wave_sum(d2); lam = __expf(d1) - __expf(d2) + LAM_INIT; }
            attn::unit<1, 2>(P1 + (size_t)(b * NTOK + NCTX + qb * 256) * NP1 + 512 + (2 * h + 1) * 64, Pb + 1024 + (2 * h + 1) * 64, nullptr, Pb + 1536 + h * 128,
                             (bf16*)(ws + WS_MIX) + (size_t)(b * SEQ + qb * 256) * DM + 512 + h * 128, DM, F.lds_c(), stash, lam, F.P.in[17]);
        }
        if (!conv_done) ph0_experts(F, conv_from, 1 << 30);
#ifdef CONV_PROBE
        if (F.vcu % 5 == 0) ph0_experts(F, 0, 1 << 30, true);
#endif

    } SEAM_SKIP1(P_ATTN);
#ifdef ATTN_PROBE
    if (IN(P_DIFFFIN)) { const bf16* P1 = (const bf16*)(ws + WS_P1); const bf16* QM = (const bf16*)(ws + WS_QM); const bf16* KVM = (const bf16*)(ws + WS_KVM);
        { const int Upr = F.vcu, bh = Upr >> 4, qb = Upr & 15, b = bh >> 3, hh = bh & 7;
          const bf16* K0 = KVM + (size_t)b * NTOK * 1024 + hh * 128;
          attn::unit<ATTN_PROBE_MODE, 0, ATTN_PROBE>(ATTN_PROBE_MODE == 0 ? QM + (size_t)(b * NTOK + NCTX + qb * 256) * 768 + hh * 96 : P1 + (size_t)(b * NTOK + NCTX + qb * 256) * NP1 + 512 + hh * 64,
                             ATTN_PROBE_MODE == 0 ? K0 : P1 + (size_t)b * NTOK * NP1 + 1024 + hh * 64, P1 + (size_t)b * NTOK * NP1 + 384, ATTN_PROBE_MODE == 0 ? K0 + 64 : P1 + (size_t)b * NTOK * NP1 + 1536 + (hh >> 1) * 128,
                             (bf16*)(ws + WS_TMP) + (size_t)Upr * 256 * DM, DM, F.lds_c(), nullptr, 0.f, nullptr); } }
#endif
    if (IN(P_OUT)) {
        pg8::Gemm g{(const bf16*)(ws + WS_MIX), (const bf16*)(ws + WS_WOUT), 1024, 1024, 1024}; pg8::StaticOrder S; S.init(MLAT, DM, F.G, (int)blockIdx.x);
        EpiOut E{F.P.in[0], (const float*)(ws + WS_MOD), (bf16*)(ws + WS_X1)};
        pg8::gemm_phase(F.lds, g, S, E);
    } SEAM(P_OUT);
    if (IN(P_H2)) { ph_route3(F); } SEAM_SKIP2(P_H2);
    if (IN(P_SLOTS)) { ph8_slots(F); } SEAM(P_SLOTS);
    if (IN(P_EXP1)) {
        const int nu = (int)xb_ld(F.ctl + CW_NUNIT), nfu = (int)xb_ld(F.ctl + CW_NFULL); LAS int* uc = (LAS int*)(F.lds + UCACHE_OFF);
        const int nmine = exp_units_to_lds<2>(uc, (const int*)(ws + WS_UT), nu, nfu, F.G, F.vcu);
        pg8::Gemm g{(const bf16*)(ws + WS_H2), (const bf16*)(ws + WS_W13), 1024, 1024, 1024};
        ExpSched<2, true> S{uc, nmine, (const int*)(ws + WS_SLOTTOK)};
        EpiAct E{(bf16*)(ws + WS_ACT), (const float*)(ws + WS_SLOTW)};
#ifdef SKEW_EXP1
        SKEW(SKEW_EXP1);
#endif
        pg8::gemm_phase(F.lds, g, S, E);
    } SEAM(P_EXP1);
    if (IN(P_EXP2)) {
        const int nu = (int)xb_ld(F.ctl + CW_NUNIT), nfu = (int)xb_ld(F.ctl + CW_NFULL); LAS int* uc = (LAS int*)(F.lds + UCACHE_OFF);
        const int nmine = exp_units_to_lds<4>(uc, (const int*)(ws + WS_UT), nu, nfu, F.G, F.vcu);
        pg8::Gemm g{(const bf16*)(ws + WS_ACT), (const bf16*)(ws + WS_W2), 256, 256, 256};
        ExpSched<4, false> S{uc, nmine, nullptr};
        EpiY E{(unsigned char*)(ws + WS_Y)};
#ifdef SKEW_EXP2
        SKEW(SKEW_EXP2);
#endif
        pg8::gemm_phase(F.lds, g, S, E);
    } SEAM(P_EXP2);
    if (IN(P_COMB)) { ph11_combine(F); } SEAM(P_COMB);
#ifdef PROBE_UNITS
    if (IN(P_PROBE)) {
        pg8::Gemm g{(const bf16*)(ws + WS_P1), (const bf16*)(ws + WS_WIN), 2048, 1024, PROBE_K}; ProbeOrder S{PROBE_UNITS, F.vcu};
        EpiProbe E{(bf16*)(ws + WS_TMP), PROBE_EPI};
        pg8::gemm_phase(F.lds, g, S, E);
    }
#endif
#undef IN
#undef SEAM
}

static int g_grid = 0;
static int mk_setup() {
    if (g_grid) return g_grid;
    int dev = 0, cus = 0;
    if (hipGetDevice(&dev) != hipSuccess || hipDeviceGetAttribute(&cus, hipDeviceAttributeMultiprocessorCount, dev) != hipSuccess) { fprintf(stderr, "kernel_launch: device query failed\n"); g_grid = -1; return -1; }
    if (hipFuncSetAttribute((const void*)mk_fwd, hipFuncAttributeMaxDynamicSharedMemorySize, LDS_BYTES) != hipSuccess) { fprintf(stderr, "kernel_launch: hipFuncSetAttribute failed\n"); g_grid = -1; return -1; }
    int per_cu = 0;
    if (hipOccupancyMaxActiveBlocksPerMultiprocessor(&per_cu, (const void*)mk_fwd, NWAVES * 64, LDS_BYTES) != hipSuccess || per_cu < 1) { fprintf(stderr, "kernel_launch: occupancy query says %d blocks/CU\n", per_cu); }
    (void)hipGetLastError();
    if (cus != 256) { fprintf(stderr, "kernel_launch: this build's work split assumes a 256-CU device (found %d CUs); nothing launched\n", cus); g_grid = -1; return -1; }
    g_grid = cus;
    return g_grid;
}
static void mk_run(const Ptrs& P, int lo, int hi, int li, hipStream_t stream) {
    Args a{}; a.P = P; a.ph_lo = lo; a.ph_hi = hi; a.li = li; a.pad = 0;
    hipLaunchKernelGGL(mk_fwd, dim3(g_grid), dim3(NWAVES * 64), LDS_BYTES, stream, a);
}
extern "C" void kernel_launch(void* const* d_in, const int* in_sizes, int n_in, void* d_out, int out_size, void* d_ws, size_t ws_size, hipStream_t stream) {
    if (n_in != 28 || out_size != MLAT * DM || ws_size < WS_END) { fprintf(stderr, "kernel_launch: unexpected shapes n_in %d out %d ws %zu\n", n_in, out_size, ws_size); return; }
    if (mk_setup() <= 0) return;
    Ptrs P{}; for (int i = 0; i < 28; ++i) P.in[i] = (const float*)d_in[i]; P.out = (float*)d_out; P.ws = (unsigned char*)d_ws;
    (void)hipMemsetAsync((char*)d_ws + WS_CTL, 0, 1 * MiB, stream);
    int li = 0;
#define FAST(lo, hi) mk_run(P, lo, hi, li++, stream)
    FAST(P_PREP, (defs_probe ? P_PROBE : P_COMB) + 1);
#undef FAST
}
```

```cpp
constexpr bool defs_probe = false;
#include <hip/hip_runtime.h>
#include <cstdio>
#include <cstdint>

constexpr int NB = 4, SEQ = 4096, NCTX = 256, NTOK = SEQ + NCTX, DM = 1024;
constexpr int MALL = NB * NTOK;
constexpr int MLAT = NB * SEQ;
constexpr int IN_COLS = 1952, NP1 = 2048;
constexpr int NEXP = 256, TOPK = 8, EFF = 256;
constexpr int NSLOT = MLAT * TOPK + MLAT;
constexpr float EPS = 1e-6f;
constexpr float LAM_INIT = 0.2f;

typedef unsigned short bf16;
__device__ __forceinline__ unsigned f2bf(float f) { unsigned u = __builtin_bit_cast(unsigned, f); return (u + 0x7fffu + ((u >> 16) & 1u)) >> 16; }
__device__ __forceinline__ float bf2f(bf16 h) { return __builtin_bit_cast(float, (unsigned)h << 16); }

constexpr size_t MiB = 1u << 20;
constexpr size_t WS_CTL = 0;
constexpr size_t WS_MOD = 3 * MiB;
constexpr size_t WS_TAB = 3 * MiB + 512 * 1024;
constexpr size_t WS_X1 = 402 * MiB;
constexpr size_t WS_SSQ = 466 * MiB;
constexpr size_t WS_EIDX = 467 * MiB;
constexpr size_t WS_EW = WS_EIDX + 512 * 1024;
constexpr size_t WS_ERANK = 468 * MiB;
constexpr size_t WS_SLOTOF = WS_ERANK + 512 * 1024;
constexpr size_t WS_SLOTTOK = 469 * MiB;
constexpr size_t WS_SLOTW = 470 * MiB;
constexpr size_t WS_OFF = 471 * MiB;
constexpr size_t WS_XN = 472 * MiB;
constexpr size_t WS_P1 = 506 * MiB;
constexpr size_t WS_QM = 574 * MiB;
constexpr size_t WS_KVM = 600 * MiB;
constexpr size_t WS_MIX = 634 * MiB;
constexpr size_t WS_OS = 666 * MiB;
constexpr size_t WS_TMP = 730 * MiB;
constexpr size_t WS_H2 = 472 * MiB;
constexpr size_t WS_H2F = 504 * MiB;
constexpr size_t WS_LOG = 568 * MiB;
constexpr size_t WS_ACT = 584 * MiB;
constexpr size_t WS_Y = 656 * MiB;
constexpr size_t WS_END = 944 * MiB;
constexpr int CW_COUNT = 1024;

__host__ __device__ __forceinline__ int perm32_log(int p) { return 16 * ((p >> 2) & 1) + 4 * (p >> 3) + (p & 3); }
__host__ __device__ __forceinline__ int perm64_log(int p) { return 32 * ((p >> 2) & 1) + 16 * (p >> 5) + 4 * ((p >> 3) & 3) + (p & 3); }
__host__ __device__ __forceinline__ int p1_logical(int p) {
    if (p < 384) return p;
    if (p < 416) return 384 + perm32_log(p - 384);
    if (p < 512) return -1;
    if (p < 1024) { int q = p - 512; return 416 + (q & ~63) + perm64_log(q & 63); }
    if (p < 1536) { int q = p - 1024; return 928 + (q & ~63) + perm64_log(q & 63); }
    return 1440 + (p - 1536);
}
__host__ __device__ __forceinline__ int qm_logical(int p) { int h = p / 96, r = p % 96; return h * 96 + (r < 64 ? r : 64 + perm32_log(r - 64)); }

struct Ptrs {
    const float* in[28]; float* out; unsigned char* ws;
};


#define GAS __attribute__((address_space(1)))
#define LAS __attribute__((address_space(3)))
typedef short bf16x8 __attribute__((ext_vector_type(8)));
typedef short s16x4 __attribute__((ext_vector_type(4)));
typedef float f32x4 __attribute__((ext_vector_type(4)));
typedef float f32x2 __attribute__((ext_vector_type(2)));
typedef float f32x16 __attribute__((ext_vector_type(16)));
typedef float f32x8 __attribute__((ext_vector_type(8)));
typedef unsigned u32x4 __attribute__((ext_vector_type(4)));
typedef unsigned u32x2 __attribute__((ext_vector_type(2)));
#define RLX_AGENT __ATOMIC_RELAXED, __HIP_MEMORY_SCOPE_AGENT
#define LDS_WAIT() asm volatile("s_waitcnt lgkmcnt(0)" ::: "memory")
#define VM_WAIT() asm volatile("s_waitcnt vmcnt(0)" ::: "memory")

constexpr size_t WS_MODP = 1 * MiB;
constexpr size_t WS_WIN = 4 * MiB;
constexpr size_t WS_WUP = 8 * MiB;
constexpr size_t WS_WOUT = 10 * MiB;
constexpr size_t WS_WR = 12 * MiB;
constexpr size_t WS_WCTX = 13 * MiB;
constexpr size_t WS_W13 = 16 * MiB;
constexpr size_t WS_W2 = 273 * MiB;
constexpr size_t WS_UT = WS_OFF + 4096;
static_assert(WS_W2 + (size_t)257 * 1024 * 256 * 2 <= WS_X1, "ws map");
constexpr size_t WS_LOGP = WS_Y;
constexpr int CW_NUNIT = 2048;
constexpr int CW_NFULL = 2049;
constexpr int CW_BAR = 4096;

__device__ __forceinline__ unsigned cvt_pk_bf16(float lo, float hi) { unsigned r; asm volatile("v_cvt_pk_bf16_f32 %0, %1, %2" : "=v"(r) : "v"(lo), "v"(hi)); return r; }
__device__ __forceinline__ unsigned pk2(float lo, float hi) { return f2bf(lo) | (f2bf(hi) << 16); }
__device__ __forceinline__ u32x4 pack8(f32x4 a, f32x4 b) { u32x4 w; w.x = cvt_pk_bf16(a[0], a[1]); w.y = cvt_pk_bf16(a[2], a[3]); w.z = cvt_pk_bf16(b[0], b[1]); w.w = cvt_pk_bf16(b[2], b[3]); return w; }
__device__ __forceinline__ float bflo(unsigned w) { return __builtin_bit_cast(float, w << 16); }
__device__ __forceinline__ float bfhi(unsigned w) { return __builtin_bit_cast(float, w & 0xffff0000u); }
__device__ __forceinline__ float wave_sum(float v) {
#pragma unroll
    for (int o = 1; o < 64; o <<= 1) v += __shfl_xor(v, o);
    return v;
}

namespace pg8 {
constexpr int BM = 256, BK = 64, HALF = 128, HTB = HALF * BK * 2, STAGE_BYTES = 8 * HTB;
__host__ __device__ __forceinline__ int lds_byte(int r, int c) { const int st = (r >> 4) * 2 + (c >> 5), rr = r & 15, cc = c & 31, ob = rr * 64 + cc * 2; return st * 1024 + (ob ^ (((ob >> 9) & 1) << 5)); }
__host__ __device__ __forceinline__ void stage_rc(int b, int& R, int& C) { const int st = b / 1024, sb = b % 1024, swz = sb ^ (((sb >> 9) & 1) << 5); R = (st >> 1) * 16 + swz / 64; C = (st & 1) * 32 + (swz % 64) / 2; }
__host__ __device__ __forceinline__ int perm32(int rho) { const int n = rho >> 4, i = rho & 15; return 8 * (i >> 2) + 4 * n + (i & 3); }

struct Unit { int pm, pn, r0, nv, k0; };
struct Gemm { const bf16* A; const bf16* Bt; int lda, ldb, K; };

struct StaticOrder {
    int nM, nN, nwg, G, c;
    __device__ void init(int M, int N, int G_, int c_) { nM = M / BM; nN = N / BM; nwg = nM * nN; G = G_; c = c_; }
    __device__ bool next(int i, Unit& u) const {
        const long L = (long)i * G + c; if (L >= nwg) return false;
        int wgid = (int)L; { const int q = nwg / 8, r = nwg % 8, xcd = wgid % 8, off = wgid / 8; wgid = (xcd < r ? xcd * (q + 1) : r * (q + 1) + (xcd - r) * q) + off; }
        const int nig = 8 * nN, gid = wgid / nig, fm = gid * 8, gsz = (nM - fm) < 8 ? (nM - fm) : 8;
        u.pm = fm + ((wgid % nig) % gsz); u.pn = (wgid % nig) / gsz; u.r0 = u.pm * BM; u.nv = BM; u.k0 = 0; return true;
    }
    __device__ __forceinline__ int a_row(const Unit& u, int r) const { return u.pm * BM + r; }
};

template <class Epi, class Sched>
__device__ __forceinline__ void gemm_phase(LAS unsigned char* lds, const Gemm g, const Sched& S, const Epi& E) {
    const int tid = threadIdx.x, wid = __builtin_amdgcn_readfirstlane(tid >> 6), lane = tid & 63, wr = wid >> 2, wc = wid & 3, fr = lane & 15, fq = lane >> 4;
    int K = g.K; asm volatile("" : "+s"(K));
    const int nt = K / BK;
    int RA[2], CA[2]; unsigned voffB[2];
#pragma unroll
    for (int i = 0; i < 2; ++i) { int R, C; stage_rc(tid * 16 + i * 8192, R, C); RA[i] = R; CA[i] = C; const int Rb = Epi::PERM ? ((R & ~31) + perm32(R & 31)) : R; voffB[i] = (unsigned)(Rb * g.ldb + C) * 2u; }
    const size_t kstep = (size_t)(BK * 2);
    const size_t hstepB = (size_t)HALF * g.ldb * 2, tstepB = 2 * hstepB;
    const unsigned ldsw = (unsigned)wid * 1024u;
    const int aoff = lds_byte(wr * 64 + fr, fq * 8), boff = lds_byte(wc * 32 + fr, fq * 8);
#define PG8_SA(b, h) (((b) * 2 + (h)) * HTB)
#define PG8_SB(b, h) ((4 + (b) * 2 + (h)) * HTB)
#define PG8_STAGE(bufoff, gbase, voff) do { _Pragma("unroll") for (int _i = 0; _i < 2; ++_i) \
        __builtin_amdgcn_global_load_lds((const unsigned*)((const char*)(gbase) + (voff)[_i]), (LAS unsigned*)(lds + (bufoff) + ldsw + _i * 8192), 16, 0, 0); } while (0)
#define PG8_LDA(dst, b, h) do { _Pragma("unroll") for (int m = 0; m < 4; ++m) _Pragma("unroll") for (int k = 0; k < 2; ++k) dst[m][k] = *(const LAS bf16x8*)(lds + PG8_SA(b, h) + aoff + m * 2048 + k * 1024); } while (0)
#define PG8_LDB(dst, b, h) do { _Pragma("unroll") for (int n = 0; n < 2; ++n) _Pragma("unroll") for (int k = 0; k < 2; ++k) dst[n][k] = *(const LAS bf16x8*)(lds + PG8_SB(b, h) + boff + n * 2048 + k * 1024); } while (0)
#define PG8_MMA(ai, bj, At, Bt) do { __builtin_amdgcn_s_setprio(1); _Pragma("unroll") for (int m = 0; m < 4; ++m) _Pragma("unroll") for (int n = 0; n < 2; ++n) _Pragma("unroll") for (int k = 0; k < 2; ++k) \
        acc[ai][bj][m][n] = __builtin_amdgcn_mfma_f32_16x16x32_bf16(Bt[n][k], At[m][k], acc[ai][bj][m][n], 0, 0, 0); __builtin_amdgcn_s_setprio(0); } while (0)
#define PG8_WAIT_V(n) asm volatile("s_waitcnt vmcnt(" #n ")" ::: "memory")
#define PG8_WAIT_L(n) asm volatile("s_waitcnt lgkmcnt(" #n ")" ::: "memory")
#define PG8_BAR __builtin_amdgcn_s_barrier()
#define PG8_SCHED __builtin_amdgcn_sched_barrier(0)
#define PG8_AOFFS(dst, u) do { _Pragma("unroll") for (int _h = 0; _h < 2; ++_h) _Pragma("unroll") for (int _i = 0; _i < 2; ++_i) \
        dst[_h][_i] = (unsigned)(((size_t)S.a_row(u, _h * HALF + RA[_i]) * (size_t)g.lda + (size_t)(CA[_i] + (u).k0)) * 2u); } while (0)
    Unit cur, nxt; int ui = 0;
    if (!S.next(0, cur)) return;
    f32x4 acc[2][2][4][2];
#pragma unroll
    for (int a = 0; a < 2; ++a)
#pragma unroll
        for (int b = 0; b < 2; ++b)
#pragma unroll
            for (int m = 0; m < 4; ++m)
#pragma unroll
                for (int n = 0; n < 2; ++n) acc[a][b][m][n] = (f32x4){0.f, 0.f, 0.f, 0.f};
    bf16x8 At[4][2], B0[2][2], B1[2][2];
    unsigned vA[2][2], vN[2][2];
    PG8_AOFFS(vA, cur);
    const char* Ab = (const char*)g.A; const char* cB = (const char*)g.Bt + (size_t)cur.pn * tstepB + (size_t)cur.k0 * 2;
    PG8_STAGE(PG8_SB(0, 0), cB, voffB); PG8_STAGE(PG8_SB(0, 1), cB + hstepB, voffB); PG8_STAGE(PG8_SA(0, 0), Ab, vA[0]); PG8_STAGE(PG8_SA(0, 1), Ab, vA[1]);
    if (wr == 1) PG8_BAR;
    PG8_WAIT_V(2); PG8_BAR;
    PG8_STAGE(PG8_SB(1, 0), cB + kstep, voffB); PG8_STAGE(PG8_SA(1, 0), Ab + kstep, vA[0]); PG8_STAGE(PG8_SB(1, 1), cB + hstepB + kstep, voffB);
    PG8_WAIT_V(6); PG8_BAR;
    for (;;) {
        const bool has_next = S.next(ui + 1, nxt);
        const char* nB = has_next ? (const char*)g.Bt + (size_t)nxt.pn * tstepB + (size_t)nxt.k0 * 2 : cB;
        if (has_next) { PG8_AOFFS(vN, nxt); } else { vN[0][0] = vA[0][0]; vN[0][1] = vA[0][1]; vN[1][0] = vA[1][0]; vN[1][1] = vA[1][1]; }
        for (int t = 0; t < nt; t += 2) {
            const bool last = (t == nt - 2); const bool full = cur.nv > HALF;
            const char* a1 = Ab + (size_t)(t + 1) * kstep;
            const char* a2 = Ab + (last ? (size_t)0 : (size_t)(t + 2) * kstep); const char* b2 = last ? nB : cB + (size_t)(t + 2) * kstep;
            const char* a3 = a2 + kstep; const char* b3 = b2 + kstep;
            unsigned w0[2], w1[2];
            w0[0] = last ? vN[0][0] : vA[0][0]; w0[1] = last ? vN[0][1] : vA[0][1]; w1[0] = last ? vN[1][0] : vA[1][0]; w1[1] = last ? vN[1][1] : vA[1][1];
            PG8_LDB(B0, 0, 0); PG8_LDB(B1, 0, 1); PG8_SCHED; PG8_LDA(At, 0, 0); PG8_STAGE(PG8_SA(1, 1), a1, vA[1]);
            PG8_WAIT_V(8); PG8_WAIT_L(0); PG8_BAR; PG8_MMA(0, 0, At, B0); PG8_MMA(0, 1, At, B1); PG8_BAR; PG8_SCHED;
            PG8_LDA(At, 0, 1); PG8_STAGE(PG8_SB(0, 0), b2, voffB); PG8_STAGE(PG8_SB(0, 1), b2 + hstepB, voffB); PG8_STAGE(PG8_SA(0, 0), a2, w0);
            PG8_WAIT_V(8); PG8_WAIT_L(0); PG8_BAR; if (full) { PG8_MMA(1, 0, At, B0); PG8_MMA(1, 1, At, B1); } PG8_BAR; PG8_SCHED;
            PG8_LDB(B0, 1, 0); PG8_LDB(B1, 1, 1); PG8_SCHED; PG8_LDA(At, 1, 0); PG8_STAGE(PG8_SA(0, 1), a2, w1);
            PG8_WAIT_V(8); PG8_WAIT_L(0); PG8_BAR; PG8_MMA(0, 0, At, B0); PG8_MMA(0, 1, At, B1); PG8_BAR; PG8_SCHED;
            PG8_LDA(At, 1, 1); PG8_STAGE(PG8_SB(1, 0), b3, voffB); PG8_STAGE(PG8_SB(1, 1), b3 + hstepB, voffB); PG8_STAGE(PG8_SA(1, 0), a3, w0);
            PG8_WAIT_V(8); PG8_WAIT_L(0); PG8_BAR; if (full) { PG8_MMA(1, 0, At, B0); PG8_MMA(1, 1, At, B1); } PG8_BAR; PG8_SCHED;
        }
        if (wr == 0) PG8_BAR;
        E(acc, cur, wr, wc, fr, fq);
        if (!has_next) break;
#pragma unroll
        for (int a = 0; a < 2; ++a)
#pragma unroll
            for (int b = 0; b < 2; ++b)
#pragma unroll
                for (int m = 0; m < 4; ++m)
#pragma unroll
                    for (int n = 0; n < 2; ++n) acc[a][b][m][n] = (f32x4){0.f, 0.f, 0.f, 0.f};
        cur = nxt; cB = nB; ++ui;
        vA[0][0] = vN[0][0]; vA[0][1] = vN[0][1]; vA[1][0] = vN[1][0]; vA[1][1] = vN[1][1];
        if (wr == 1) PG8_BAR;
    }
    PG8_WAIT_V(0);
    PG8_BAR;
#undef PG8_SA
#undef PG8_SB
#undef PG8_STAGE
#undef PG8_LDA
#undef PG8_LDB
#undef PG8_MMA
#undef PG8_WAIT_V
#undef PG8_WAIT_L
#undef PG8_BAR
#undef PG8_SCHED
#undef PG8_AOFFS
}
}

using pg8::Unit;
typedef f32x4 Acc[2][2][4][2];

struct EpiInProj {
    static constexpr bool PERM = true;
    bf16* P1; float* SSQ; const float2* TD; const float2* TM;
    __device__ __forceinline__ void operator()(const Acc& acc, const Unit& u, int wr, int wc, int fr, int fq) const {
        const int pm = u.pm, pn = u.pn, jt = pm % 17; const bool lat = jt > 0;
        const int row0 = pm * 256 + wr * 64 + fr, col0 = pn * 256 + wc * 32 + 8 * fq;
        if (pn == 0 || pn >= 6 || (pn == 1)) {
#pragma unroll
            for (int ai = 0; ai < 2; ++ai)
#pragma unroll
                for (int m = 0; m < 4; ++m) {
                    const int r = row0 + ai * 128 + m * 16; bf16* rowp = P1 + (size_t)r * NP1 + col0;
                    *(u32x4*)(rowp) = pack8(acc[ai][0][m][0], acc[ai][0][m][1]);
                    if (pn != 1) *(u32x4*)(rowp + 128) = pack8(acc[ai][1][m][0], acc[ai][1][m][1]);
                    if (pn <= 1) {
                        float s = 0.f;
#pragma unroll
                        for (int bj = 0; bj < 2; ++bj) { if (pn == 1 && bj == 1) break;
#pragma unroll
                            for (int n = 0; n < 2; ++n) { const f32x4 x = acc[ai][bj][m][n]; s += (x[0] * x[0] + x[1] * x[1]) + (x[2] * x[2] + x[3] * x[3]); } }
                        s += __shfl_xor(s, 16); s += __shfl_xor(s, 32);
                        if (fq == 0) SSQ[(size_t)r * 8 + pn * 4 + wc] = s;
                    }
                    if (pn == 1 && wc == 0) {
                        f32x4 x1 = acc[ai][1][m][0], x2 = acc[ai][1][m][1], o1 = x1, o2 = x2;
                        if (lat) { const int gr = (jt - 1) * 4 + 2 * ai + wr, gc = 16 * m + fr;
                            const float2* tp = TM + (fq < 2 ? gr * 8 + 4 * fq : gc * 8 + 4 * (fq - 2));
                            const f32x4 t0 = *(const f32x4*)tp, t1 = *(const f32x4*)(tp + 2);
                            const f32x4 cs = {t0[0], t0[2], t1[0], t1[2]}, sn = {t0[1], t0[3], t1[1], t1[3]};
                            o1 = x1 * cs - x2 * sn; o2 = x1 * sn + x2 * cs; }
                        *(u32x4*)(rowp + 128) = pack8(o1, o2);
                    }
                }
        } else {
            const int g = wc & 1; const float qs = pn < 4 ? 0.125f * 1.4426950408889634f : 1.f;
#pragma unroll
            for (int ai = 0; ai < 2; ++ai) {
                const int gr = (jt - 1) * 4 + 2 * ai + wr;
#pragma unroll
                for (int m = 0; m < 4; ++m) {
                    const int r = row0 + ai * 128 + m * 16; bf16* rowp = P1 + (size_t)r * NP1 + col0;
                    f32x4 cs = {1.f, 1.f, 1.f, 1.f}, sn = {0.f, 0.f, 0.f, 0.f};
                    if (lat) { const int gc = 16 * m + fr; const float2* tp = TD + (g == 0 ? gr : gc) * 16 + 4 * fq;
                        const f32x4 t0 = *(const f32x4*)tp, t1 = *(const f32x4*)(tp + 2);
                        cs = (f32x4){t0[0], t0[2], t1[0], t1[2]}; sn = (f32x4){t0[1], t0[3], t1[1], t1[3]}; }
#pragma unroll
                    for (int bj = 0; bj < 2; ++bj) { const f32x4 x1 = acc[ai][bj][m][0] * qs, x2 = acc[ai][bj][m][1] * qs;
                        *(u32x4*)(rowp + bj * 128) = pack8(x1 * cs - x2 * sn, x1 * sn + x2 * cs); }
                }
            }
        }
    }
};

struct EpiUp {
    static constexpr bool PERM = true;
    bf16* QM; bf16* KVM; const float* SSQ; const float2* TM;
    __device__ __forceinline__ void operator()(const Acc& acc, const Unit& u, int wr, int wc, int fr, int fq) const {
        const int pm = u.pm, pn = u.pn, jt = pm % 17; const bool lat = jt > 0, isq = pn < 3;
        const int row0 = pm * 256 + wr * 64 + fr, col0 = pn * 256 + wc * 32 + 8 * fq;
#pragma unroll
        for (int ai = 0; ai < 2; ++ai)
#pragma unroll
            for (int m = 0; m < 4; ++m) {
                const int r = row0 + ai * 128 + m * 16;
                const f32x4 sq = *(const f32x4*)(SSQ + (size_t)r * 8 + (isq ? 0 : 4));
                const float rs = rsqrtf(((sq[0] + sq[1]) + (sq[2] + sq[3])) * (isq ? 1.f / 256.f : 1.f / 128.f) + EPS) * (isq ? 0.10206207261596575f * 1.4426950408889634f : 1.f);
#pragma unroll
                for (int bj = 0; bj < 2; ++bj) {
                    f32x4 x1 = acc[ai][bj][m][0] * rs, x2 = acc[ai][bj][m][1] * rs;
                    if (isq) {
                        const int G = 8 * pn + 4 * bj + wc;
                        if (lat && (G % 3) == 2) { const int gr = (jt - 1) * 4 + 2 * ai + wr, gc = 16 * m + fr;
                            const float2* tp = TM + (fq < 2 ? gr * 8 + 4 * fq : gc * 8 + 4 * (fq - 2));
                            const f32x4 t0 = *(const f32x4*)tp, t1 = *(const f32x4*)(tp + 2);
                            const f32x4 cs = {t0[0], t0[2], t1[0], t1[2]}, sn = {t0[1], t0[3], t1[1], t1[3]};
                            const f32x4 o1 = x1 * cs - x2 * sn, o2 = x1 * sn + x2 * cs; x1 = o1; x2 = o2; }
                        *(u32x4*)(QM + (size_t)r * 768 + col0 + bj * 128) = pack8(x1, x2);
                    } else *(u32x4*)(KVM + (size_t)r * 1024 + (col0 - 768) + bj * 128) = pack8(x1, x2);
                }
            }
    }
};

struct EpiOut {
    static constexpr bool PERM = true;
    const float* x; const float* MOD; bf16* X1;
    __device__ __forceinline__ void operator()(const Acc& acc, const Unit& u, int wr, int wc, int fr, int fq) const {
        const int b = u.pm / 16; const float* gt = MOD + b * 6144 + 2048;
        const int row0 = u.pm * 256 + wr * 64 + fr, col0 = u.pn * 256 + wc * 32 + 8 * fq;
        f32x4 gv[2][2];
#pragma unroll
        for (int bj = 0; bj < 2; ++bj)
#pragma unroll
            for (int n = 0; n < 2; ++n) gv[bj][n] = *(const f32x4*)(gt + col0 + bj * 128 + n * 4);
#pragma unroll
        for (int ai = 0; ai < 2; ++ai)
#pragma unroll
            for (int m = 0; m < 4; ++m) { const size_t off = (size_t)(row0 + ai * 128 + m * 16) * DM + col0;
#pragma unroll
                for (int bj = 0; bj < 2; ++bj) { const f32x4 x0 = *(const f32x4*)(x + off + bj * 128), x1 = *(const f32x4*)(x + off + bj * 128 + 4);
                    *(u32x4*)(X1 + off + bj * 128) = pack8(x0 + gv[bj][0] * acc[ai][bj][m][0], x1 + gv[bj][1] * acc[ai][bj][m][1]); } }
    }
};
struct EpiF32 {
    static constexpr bool PERM = false;
    float* O; int ldc;
    __device__ __forceinline__ void operator()(const Acc& acc, const Unit& u, int wr, int wc, int fr, int fq) const {
        const int row0 = u.pm * 256 + wr * 64 + fr, col0 = u.pn * 256 + wc * 32 + 4 * fq;
#pragma unroll
        for (int ai = 0; ai < 2; ++ai)
#pragma unroll
            for (int m = 0; m < 4; ++m) { const size_t off = (size_t)(row0 + ai * 128 + m * 16) * ldc + col0;
#pragma unroll
                for (int bj = 0; bj < 2; ++bj)
#pragma unroll
                    for (int n = 0; n < 2; ++n) *(f32x4*)(O + off + bj * 128 + n * 16) = acc[ai][bj][m][n]; }
    }
};
struct EpiAct {
    static constexpr bool PERM = true;
    bf16* ACT; const float* SW;
    __device__ __forceinline__ void operator()(const Acc& acc, const Unit& u, int wr, int wc, int fr, int fq) const {
        const int half = u.pn & 1, colb = half * 128 + wc * 32 + 8 * fq;
#pragma unroll
        for (int ai = 0; ai < 2; ++ai)
#pragma unroll
            for (int m = 0; m < 4; ++m) { const int tr = ai * 128 + wr * 64 + m * 16 + fr;
                f32x4 a[2];
#pragma unroll
                for (int n = 0; n < 2; ++n) { const f32x4 gt = acc[ai][0][m][n], up = acc[ai][1][m][n];
#pragma unroll
                    for (int e = 0; e < 4; ++e) a[n][e] = gt[e] * __builtin_amdgcn_rcpf(1.f + __expf(-gt[e])) * up[e]; }
                if (tr < u.nv) { const float w = SW[u.r0 + tr]; *(u32x4*)(ACT + (size_t)(u.r0 + tr) * EFF + colb) = pack8(a[0] * w, a[1] * w); } }
    }
};
constexpr float YSCALE = 32.f;
__device__ __forceinline__ unsigned pk4_fp8(f32x4 v) { int w = 0; w = __builtin_amdgcn_cvt_pk_fp8_f32(v[0], v[1], w, false); w = __builtin_amdgcn_cvt_pk_fp8_f32(v[2], v[3], w, true); return (unsigned)w; }
struct EpiY {
    static constexpr bool PERM = true;
    unsigned char* Y;
    __device__ __forceinline__ void operator()(const Acc& acc, const Unit& u, int wr, int wc, int fr, int fq) const {
        const int colb = (u.pn & 3) * 256 + wc * 64 + 16 * fq;
#pragma unroll
        for (int ai = 0; ai < 2; ++ai)
#pragma unroll
            for (int m = 0; m < 4; ++m) { const int tr = ai * 128 + wr * 64 + m * 16 + fr;
                if (tr < u.nv) { u32x4 w; w.x = pk4_fp8(acc[ai][0][m][0] * YSCALE); w.y = pk4_fp8(acc[ai][0][m][1] * YSCALE); w.z = pk4_fp8(acc[ai][1][m][0] * YSCALE); w.w = pk4_fp8(acc[ai][1][m][1] * YSCALE);
                    *(u32x4*)(Y + (size_t)(u.r0 + tr) * DM + colb) = w; } }
    }
};

template <int SUB, bool GATHER> struct ExpSched {
    const LAS int* uc; int nmine; const int* slot_tok;
    __device__ bool next(int i, Unit& u) const {
        if (i >= nmine) return false;
        const int e = __builtin_amdgcn_readfirstlane(uc[i * 4 + 0]), r0 = __builtin_amdgcn_readfirstlane(uc[i * 4 + 1]);
        const int nv = __builtin_amdgcn_readfirstlane(uc[i * 4 + 2]), sub = __builtin_amdgcn_readfirstlane(uc[i * 4 + 3]);
        u.pm = 0; u.pn = e * SUB + sub; u.r0 = r0; u.nv = nv; u.k0 = 0; return true;
    }
    __device__ __forceinline__ int a_row(const Unit& u, int r) const {
        if (GATHER) return r < u.nv ? slot_tok[u.r0 + r] : 0;
        const int s = u.r0 + r; return s < NSLOT ? s : NSLOT - 1;
    }
};
template <int SUB> __device__ __forceinline__ int exp_units_to_lds(LAS int* uc, const int* ut, int nunit, int nfull, int G, int c) {
    const int NF = nfull * SUB, NH = (nunit - nfull) * SUB, cr = G - 1 - c, nlight = (NF % G) ? G - NF % G : 0;
    const int mf = c < NF ? (NF - 1 - c) / G + 1 : 0;
    const int h0 = (cr < nlight && cr < NH) ? 1 : 0;
    const int NH2 = NH > nlight ? NH - nlight : 0, mh = cr < NH2 ? (NH2 - 1 - cr) / G + 1 : 0;
    const int t = threadIdx.x;
    if (t < mf + h0 + mh && t < 64) { const int L = t < mf ? t * G + c : (t < mf + h0 ? NF + cr : NF + nlight + (t - mf - h0) * G + cr); const int cu = L / SUB;
        uc[t * 4 + 0] = ut[cu * 4 + 0]; uc[t * 4 + 1] = ut[cu * 4 + 1]; uc[t * 4 + 2] = ut[cu * 4 + 2]; uc[t * 4 + 3] = L % SUB; }
    __syncthreads();
    return mf + h0 + mh < 64 ? mf + h0 + mh : 64;
}
struct LatOrder : pg8::StaticOrder {
    __device__ bool next(int i, Unit& u) const { if (!pg8::StaticOrder::next(i, u)) return false; u.pm += (u.pm >> 4) + 1; u.r0 = u.pm * 256; return true; }
};
struct RouterOrder {
    int G, c;
    __device__ bool next(int i, Unit& u) const { const int L = i * G + c; if (L >= 256) return false; u.pm = L >> 2; u.pn = 0; u.r0 = u.pm * 256; u.nv = 256; u.k0 = (L & 3) * 256; return true; }
    __device__ __forceinline__ int a_row(const Unit& u, int r) const { return u.pm * 256 + r; }
};
struct UpOrder {
    int G, c;
    __device__ bool next(int i, Unit& u) const { const int L = i * G + c; if (L >= 68 * 7) return false; u.pm = L / 7; u.pn = L % 7; u.r0 = u.pm * 256; u.nv = 256; u.k0 = u.pn < 3 ? 0 : 128; return true; }
    __device__ __forceinline__ int a_row(const Unit& u, int r) const { return u.pm * 256 + r; }
};
struct EpiLogP {
    static constexpr bool PERM = false;
    float* O;
    __device__ __forceinline__ void operator()(const Acc& acc, const Unit& u, int wr, int wc, int fr, int fq) const {
        float* base = O + (size_t)(u.k0 >> 8) * MLAT * NEXP;
        const int row0 = u.pm * 256 + wr * 64 + fr, col0 = wc * 32 + 4 * fq;
#pragma unroll
        for (int ai = 0; ai < 2; ++ai)
#pragma unroll
            for (int m = 0; m < 4; ++m) { const size_t off = (size_t)(row0 + ai * 128 + m * 16) * NEXP + col0;
#pragma unroll
                for (int bj = 0; bj < 2; ++bj)
#pragma unroll
                    for (int n = 0; n < 2; ++n) *(f32x4*)(base + off + bj * 128 + n * 16) = acc[ai][bj][m][n]; }
    }
};

namespace attn {
#define SBAR() __builtin_amdgcn_sched_barrier(0)
constexpr float THR = 8.f;
template <int MODE> struct Cfg;
template <> struct Cfg<0> { static constexpr int DQK = 96, DV = 64, LDQ = 768, LDK0 = 1024, LDK1 = 2048, LDV = 1024; static constexpr float SCALE = 0.10206207261596575f; };
template <> struct Cfg<1> { static constexpr int DQK = 64, DV = 128, LDQ = 2048, LDK0 = 2048, LDK1 = 2048, LDV = 2048; static constexpr float SCALE = 0.125f; };
__device__ __forceinline__ int crow(int r, int hi) { return (r & 3) + 8 * (r >> 2) + 4 * hi; }
typedef __bf16 bf16x2n __attribute__((ext_vector_type(2)));
typedef float f32x2n __attribute__((ext_vector_type(2)));
__device__ __forceinline__ unsigned cvtpk(float lo, float hi) { const f32x2n v = {lo, hi}; return __builtin_bit_cast(unsigned, __builtin_convertvector(v, bf16x2n)); }

constexpr float THR2 = 11.5f;
__device__ __forceinline__ float max3f(float a, float b, float c) { return __builtin_fmaxf(__builtin_fmaxf(a, b), c); }
template <int ABL = 0> __device__ __forceinline__ void partialSM(f32x16& p0, f32x16& p1, float& m_reg, float& alpha, bool first) {
    float a = max3f(p0[0], p0[1], p1[0]), b = max3f(p0[2], p0[3], p1[1]); a = max3f(a, p1[2], p1[3]);
#pragma unroll
    for (int r = 4; r < 16; r += 4) { a = max3f(a, p0[r], p0[r + 1]); b = max3f(b, p0[r + 2], p0[r + 3]); a = max3f(a, p1[r], p1[r + 1]); b = max3f(b, p1[r + 2], p1[r + 3]); }
    float pmax = __builtin_fmaxf(a, b);
    if (ABL == 7) pmax = p0[0];
    { auto rr = __builtin_amdgcn_permlane32_swap(__float_as_uint(pmax), __float_as_uint(pmax), false, false);
      pmax = __builtin_fmaxf(__uint_as_float(rr[0]), __uint_as_float(rr[1])); }
    alpha = 1.f;
    if (__builtin_expect(first || __any(pmax > THR2), 0)) {
        const float dl = first ? pmax : __builtin_fmaxf(pmax, 0.f);
        m_reg += dl; alpha = first ? 1.f : __builtin_amdgcn_exp2f(-dl);
#pragma unroll
        for (int r = 0; r < 16; ++r) { p0[r] -= dl; p1[r] -= dl; }
    }
#pragma unroll
    for (int r = 0; r < 16; ++r) p0[r] = ABL == 1 ? p0[r] * 0.5f : __builtin_amdgcn_exp2f(p0[r]);
}
template <int ABL = 0> __device__ __forceinline__ void finishSM(f32x16& p0, f32x16& p1, float alpha, float& l_reg, bf16x8& pa0, bf16x8& pa1, bf16x8& pa2, bf16x8& pa3) {
#pragma unroll
    for (int r = 0; r < 16; ++r) p1[r] = ABL == 1 ? p1[r] * 0.5f : __builtin_amdgcn_exp2f(p1[r]);
    float ps = 0;
    if (ABL == 2) ps = p0[0] + p1[15]; else {
        float s0 = p0[0] + p0[4], s1 = p0[1] + p0[5], s2 = p0[2] + p0[6], s3 = p0[3] + p0[7];
        s0 += p0[8]; s1 += p0[9]; s2 += p0[10]; s3 += p0[11]; s0 += p0[12]; s1 += p0[13]; s2 += p0[14]; s3 += p0[15];
#pragma unroll
        for (int r = 0; r < 16; r += 4) { s0 += p1[r]; s1 += p1[r + 1]; s2 += p1[r + 2]; s3 += p1[r + 3]; }
        ps = (s0 + s1) + (s2 + s3); }
    { auto rr = __builtin_amdgcn_permlane32_swap(__float_as_uint(ps), __float_as_uint(ps), false, false);
      ps = __uint_as_float(rr[0]) + __uint_as_float(rr[1]); }
    l_reg = l_reg * alpha + ps;
#define PK4(P, BASE, OUT) do { u32x4 w = {cvtpk(P[BASE + 0], P[BASE + 1]), cvtpk(P[BASE + 2], P[BASE + 3]), cvtpk(P[BASE + 4], P[BASE + 5]), cvtpk(P[BASE + 6], P[BASE + 7])}; OUT = *reinterpret_cast<bf16x8*>(&w); } while (0)
    PK4(p0, 0, pa0); PK4(p0, 8, pa1); PK4(p1, 0, pa2); PK4(p1, 8, pa3);
#undef PK4
}
template <int NQ, int KROW, int ABL = 0> __device__ __forceinline__ void qkt(f32x16& p0, f32x16& p1, const LAS char* Ks, const bf16x8* qr, float m_ref, int r32, int hi) {
    f32x16 negm;
#pragma unroll
    for (int r = 0; r < 16; ++r) negm[r] = -m_ref;
    p0 = negm; p1 = negm;
#pragma unroll
    for (int d0 = 0; d0 < NQ; ++d0) { const int cb = d0 * 32 + hi * 16;
        const bf16x8 b0 = *(const LAS bf16x8*)(Ks + r32 * KROW + cb);
        const bf16x8 b1 = *(const LAS bf16x8*)(Ks + (32 + r32) * KROW + cb);
        if (ABL == 4) { asm volatile("" :: "v"(b0), "v"(b1)); } else {
        p0 = __builtin_amdgcn_mfma_f32_32x32x16_bf16(b0, qr[d0], p0, 0, 0, 0);
        p1 = __builtin_amdgcn_mfma_f32_32x32x16_bf16(b1, qr[d0], p1, 0, 0, 0); } }
}
template <int NC> __device__ __forceinline__ int v_st(int k, int c) { const int kk = k; return ((kk >> 3) * NC + (c >> 5)) * 512 + ((kk & 7) * 32 + (c & 31)) * 2; }
__device__ __forceinline__ int v_rd_base(int lane) { return ((lane & 3) << 3) | (((lane >> 2) & 3) << 6) | (((lane >> 4) & 1) << 5) | (((lane >> 5) & 1) << 8); }
template <int OFF> __device__ __forceinline__ s16x4 tr_read(int vb) {
    s16x4 r; asm volatile("ds_read_b64_tr_b16 %0, %1 offset:%2" : "=&v"(r) : "v"(vb), "i"(OFF) : "memory"); return r;
}
template <int NC, int D0, int ABL = 0> __device__ __forceinline__ void pv_one(f32x16& od, int vb, bf16x8 pa0, bf16x8 pa1, bf16x8 pa2, bf16x8 pa3) {
#define VOFF(ks, half) (D0 * 512 + (ks) * (NC * 1024) + (half) * (NC * 512))
    const s16x4 l0 = tr_read<VOFF(0, 0)>(vb), h0 = tr_read<VOFF(0, 1)>(vb), l1 = tr_read<VOFF(1, 0)>(vb), h1 = tr_read<VOFF(1, 1)>(vb);
    const s16x4 l2 = tr_read<VOFF(2, 0)>(vb), h2 = tr_read<VOFF(2, 1)>(vb), l3 = tr_read<VOFF(3, 0)>(vb), h3 = tr_read<VOFF(3, 1)>(vb);
#undef VOFF
    asm volatile("s_waitcnt lgkmcnt(0)" ::: "memory"); SBAR();
#define PK(L, H) (bf16x8){L[0], L[1], L[2], L[3], H[0], H[1], H[2], H[3]}
    if (ABL == 3) { asm volatile("" :: "v"(l0), "v"(h0), "v"(l1), "v"(h1), "v"(l2), "v"(h2), "v"(l3), "v"(h3)); return; }
    od = __builtin_amdgcn_mfma_f32_32x32x16_bf16(pa0, PK(l0, h0), od, 0, 0, 0);
    od = __builtin_amdgcn_mfma_f32_32x32x16_bf16(pa1, PK(l1, h1), od, 0, 0, 0);
    od = __builtin_amdgcn_mfma_f32_32x32x16_bf16(pa2, PK(l2, h2), od, 0, 0, 0);
    od = __builtin_amdgcn_mfma_f32_32x32x16_bf16(pa3, PK(l3, h3), od, 0, 0, 0);
#undef PK
}
template <int NC, int ABL = 0> __device__ __forceinline__ void pv_all(f32x16* o, int vb, bf16x8 pa0, bf16x8 pa1, bf16x8 pa2, bf16x8 pa3) {
    pv_one<NC, 0, ABL>(o[0], vb, pa0, pa1, pa2, pa3); pv_one<NC, 1, ABL>(o[1], vb, pa0, pa1, pa2, pa3);
    if constexpr (NC == 4) { pv_one<NC, 2, ABL>(o[2], vb, pa0, pa1, pa2, pa3); pv_one<NC, 3, ABL>(o[3], vb, pa0, pa1, pa2, pa3); }
}
template <int MODE> constexpr int lds_bytes() { return 4 * (64 * Cfg<MODE>::DV * 2 + 2 * (Cfg<MODE>::DQK / 16) * 1024) + 8 * 64 * 4; }

template <int MODE, int EPI, int ABL = 0>
__device__ __forceinline__ void unit_regs(const bf16* __restrict__ Qb, const bf16* __restrict__ K0, const bf16* __restrict__ K1, const bf16* __restrict__ Vh, void* Ob, int ldo, LAS char* lds, char* stash, float lam, const float* gsub) {
    using C = Cfg<MODE>;
    constexpr int DQK = C::DQK, DV = C::DV, NQ = DQK / 16, NC = DV / 32, KROW = DQK * 2 + 16, SHM_K = 64 * KROW, SHM_V = 64 * DV * 2;
    const int tid = threadIdx.x, wid = tid >> 6, lane = tid & 63, r32 = lane & 31, hi = lane >> 5;
    LAS char* V_lds = lds; LAS char* K_lds = lds + 3 * SHM_V;
    LAS float* ws = (LAS float*)(lds + 3 * SHM_V + 3 * SHM_K) + wid * 64; LAS float* li_l = ws; LAS float* al_l = ws + 32;
    float m_reg = 0.f, l_reg = 0; f32x16 o[NC]; bf16x8 qr[NQ];
#pragma unroll
    for (int d = 0; d < NC; ++d) o[d] = f32x16{};
    const bf16* Qw = Qb + (size_t)(wid * 32 + r32) * C::LDQ + hi * 8;
#pragma unroll
    for (int d0 = 0; d0 < NQ; ++d0) qr[d0] = *reinterpret_cast<const bf16x8*>(Qw + d0 * 16);
    const int vb0 = (int)(uintptr_t)V_lds + v_rd_base(lane);
    const int kr0 = tid >> 3, kc0 = tid & 7;
    const int krr = (tid & 255) >> 2, krc = tid & 3;
    const int vr0 = MODE == 0 ? (tid >> 3) : (tid >> 4), vc0 = MODE == 0 ? (tid & 7) * 8 : (tid & 15) * 8;
    const int vst0 = v_st<NC>(vr0, vc0), vst1 = v_st<NC>(32 + vr0, vc0);
    constexpr int NSET = MODE == 0 ? 2 : 1;
    struct { bf16x8 ka, kb, va, vb; } sr_[NSET];
#define SLOAD(i, k0) do { sr_[i].ka = *reinterpret_cast<const bf16x8*>(K0 + (size_t)((k0) + kr0) * C::LDK0 + kc0 * 8); \
        if (MODE == 0) { sr_[i].kb = *reinterpret_cast<const bf16x8*>(K1 + (size_t)((k0) + krr) * C::LDK1 + krc * 8); } \
        sr_[i].va = *reinterpret_cast<const bf16x8*>(Vh + (size_t)((k0) + vr0) * C::LDV + vc0); \
        if (MODE == 1) { sr_[i].vb = *reinterpret_cast<const bf16x8*>(Vh + (size_t)((k0) + 32 + vr0) * C::LDV + vc0); } } while (0)
#define SWRITE(ko, vo, i) do { *(LAS bf16x8*)(K_lds + (ko) + kr0 * KROW + kc0 * 16) = sr_[i].ka; \
        if (MODE == 0) { *(LAS bf16x8*)(K_lds + (ko) + krr * KROW + 128 + krc * 16) = sr_[i].kb; } \
        *(LAS bf16x8*)(V_lds + (vo) + vst0) = sr_[i].va; \
        if (MODE == 1) { *(LAS bf16x8*)(V_lds + (vo) + vst1) = sr_[i].vb; } } while (0)
#define SWAIT() do { if (NSET == 2) asm volatile("s_waitcnt vmcnt(3)" ::: "memory"); } while (0)
#define RESC(a) do { if (__any((a) < 1.f)) { if (hi == 0) al_l[r32] = (a); asm volatile("s_waitcnt lgkmcnt(0)" ::: "memory"); \
        _Pragma("unroll") for (int d = 0; d < NC; ++d) _Pragma("unroll") for (int r = 0; r < 16; ++r) o[d][r] *= al_l[crow(r, hi)]; } } while (0)
    f32x16 pA0, pA1, pB0, pB1; float alA = 1.f, alB = 1.f; bf16x8 pa0, pa1, pa2, pa3; constexpr int NT = NTOK / 64;
#define STEP(PC0, PC1, ALC, PP0, PP1, ALP, jj, SQ, SV, SW) do { constexpr int SETN = ((jj##_c) + 1) % NSET; \
        if (ABL != 6 && (jj) + 1 < NT) { SWAIT(); SWRITE((SW) * SHM_K, (SW) * SHM_V, SETN); } \
        SBAR(); qkt<NQ, KROW, ABL>(PC0, PC1, K_lds + (SQ) * SHM_K, qr, m_reg, r32, hi); \
        finishSM<ABL>(PP0, PP1, ALP, l_reg, pa0, pa1, pa2, pa3); SBAR(); \
        if (ABL != 6 && (jj) + 1 + NSET < NT) SLOAD(SETN, ((jj) + 1 + NSET) * 64); SBAR(); \
        pv_all<NC, ABL>(o, vb0 + (SV) * SHM_V, pa0, pa1, pa2, pa3); partialSM<ABL>(PC0, PC1, m_reg, ALC, false); \
        RESC(ALC); if (ABL != 5) __syncthreads(); } while (0)
    static_assert((NT - 2) % 6 == 0, "tile count: steps 1..NT-2 in groups of 6");
    SLOAD(0, 0); asm volatile("s_waitcnt vmcnt(0)" ::: "memory"); SWRITE(0, 0, 0);
    SLOAD(1 % NSET, 64); if (NSET == 2) SLOAD(0, 128); __syncthreads();
    SWAIT(); SWRITE(SHM_K, SHM_V, 1 % NSET);
    qkt<NQ, KROW>(pA0, pA1, K_lds, qr, m_reg, r32, hi);
    SLOAD(1 % NSET, (1 + NSET) * 64);
    partialSM(pA0, pA1, m_reg, alA, true);
    __syncthreads();
    for (int j = 1; j + 1 < NT; j += 6) {
        constexpr int j_c = 1, j1_c = 2, j2_c = 3, j3_c = 4, j4_c = 5, j5_c = 6; const int j1 = j + 1, j2 = j + 2, j3 = j + 3, j4 = j + 4, j5 = j + 5;
        STEP(pB0, pB1, alB, pA0, pA1, alA, j,  1, 0, 2);
        STEP(pA0, pA1, alA, pB0, pB1, alB, j1, 2, 1, 0);
        STEP(pB0, pB1, alB, pA0, pA1, alA, j2, 0, 2, 1);
        STEP(pA0, pA1, alA, pB0, pB1, alB, j3, 1, 0, 2);
        STEP(pB0, pB1, alB, pA0, pA1, alA, j4, 2, 1, 0);
        STEP(pA0, pA1, alA, pB0, pB1, alB, j5, 0, 2, 1);
    }
    { constexpr int jt_c = NT - 1; const int jt = NT - 1;
      STEP(pB0, pB1, alB, pA0, pA1, alA, jt, (NT - 1) % 3, (NT - 2) % 3, NT % 3); }
    finishSM(pB0, pB1, alB, l_reg, pa0, pa1, pa2, pa3); SBAR();
    pv_all<NC>(o, vb0 + ((NT - 1) % 3) * SHM_V, pa0, pa1, pa2, pa3);
#undef STEP
    if (hi == 0) li_l[r32] = l_reg; asm volatile("s_waitcnt lgkmcnt(0)" ::: "memory");
    float rli[16];
#pragma unroll
    for (int r = 0; r < 16; ++r) rli[r] = __builtin_amdgcn_rcpf(li_l[crow(r, hi)]);
    asm volatile("" : "+s"(ldo), "+s"(stash), "+s"(gsub), "+s"(Ob));
    if constexpr (MODE == 0) {
#pragma unroll
        for (int r = 0; r < 16; ++r) { const int orow = wid * 32 + crow(r, hi);
#pragma unroll
            for (int d0 = 0; d0 < NC; ++d0) ((bf16*)Ob)[(size_t)orow * ldo + d0 * 32 + r32] = (bf16)f2bf(o[d0][r] * rli[r]); }
    } else if constexpr (EPI == 1) {
        char* st = stash + wid * 8192 + lane * 16;
#pragma unroll
        for (int d0 = 0; d0 < NC; ++d0)
#pragma unroll
            for (int q = 0; q < 2; ++q) { u32x4 w;
                w.x = cvtpk(o[d0][8 * q + 0] * rli[8 * q + 0], o[d0][8 * q + 1] * rli[8 * q + 1]); w.y = cvtpk(o[d0][8 * q + 2] * rli[8 * q + 2], o[d0][8 * q + 3] * rli[8 * q + 3]);
                w.z = cvtpk(o[d0][8 * q + 4] * rli[8 * q + 4], o[d0][8 * q + 5] * rli[8 * q + 5]); w.w = cvtpk(o[d0][8 * q + 6] * rli[8 * q + 6], o[d0][8 * q + 7] * rli[8 * q + 7]);
                *(u32x4*)(st + (d0 * 2 + q) * 1024) = w; }
        asm volatile("s_waitcnt vmcnt(0)" ::: "memory");
    } else {
        const char* st = stash + wid * 8192 + lane * 16;
#pragma unroll
        for (int d0 = 0; d0 < NC; ++d0) {
            const u32x4 wa = *(const u32x4*)(st + (d0 * 2 + 0) * 1024), wb = *(const u32x4*)(st + (d0 * 2 + 1) * 1024);
            f32x16 od;
            od[0] = __builtin_bit_cast(float, wa.x << 16); od[1] = __builtin_bit_cast(float, wa.x & 0xffff0000u); od[2] = __builtin_bit_cast(float, wa.y << 16); od[3] = __builtin_bit_cast(float, wa.y & 0xffff0000u);
            od[4] = __builtin_bit_cast(float, wa.z << 16); od[5] = __builtin_bit_cast(float, wa.z & 0xffff0000u); od[6] = __builtin_bit_cast(float, wa.w << 16); od[7] = __builtin_bit_cast(float, wa.w & 0xffff0000u);
            od[8] = __builtin_bit_cast(float, wb.x << 16); od[9] = __builtin_bit_cast(float, wb.x & 0xffff0000u); od[10] = __builtin_bit_cast(float, wb.y << 16); od[11] = __builtin_bit_cast(float, wb.y & 0xffff0000u);
            od[12] = __builtin_bit_cast(float, wb.z << 16); od[13] = __builtin_bit_cast(float, wb.z & 0xffff0000u); od[14] = __builtin_bit_cast(float, wb.w << 16); od[15] = __builtin_bit_cast(float, wb.w & 0xffff0000u);
#pragma unroll
            for (int r = 0; r < 16; ++r) od[r] -= lam * (o[d0][r] * rli[r]);
            o[d0] = od;
        }
        f32x16 ssv;
#pragma unroll
        for (int r = 0; r < 16; ++r) { float x = 0.f;
#pragma unroll
            for (int d0 = 0; d0 < NC; ++d0) x += o[d0][r] * o[d0][r];
            x += __builtin_bit_cast(float, __builtin_amdgcn_update_dpp(0, __builtin_bit_cast(int, x), 0x111, 0xf, 0xf, false));
            x += __builtin_bit_cast(float, __builtin_amdgcn_update_dpp(0, __builtin_bit_cast(int, x), 0x112, 0xf, 0xf, false));
            x += __builtin_bit_cast(float, __builtin_amdgcn_update_dpp(0, __builtin_bit_cast(int, x), 0x114, 0xf, 0xf, false));
            x += __builtin_bit_cast(float, __builtin_amdgcn_update_dpp(0, __builtin_bit_cast(int, x), 0x118, 0xf, 0xf, false));
            x += __builtin_bit_cast(float, __builtin_amdgcn_update_dpp(0, __builtin_bit_cast(int, x), 0x142, 0xa, 0xf, false));
            const float t0 = __builtin_bit_cast(float, __builtin_amdgcn_readlane(__builtin_bit_cast(int, x), 31)), t1 = __builtin_bit_cast(float, __builtin_amdgcn_readlane(__builtin_bit_cast(int, x), 63));
            ssv[r] = rsqrtf((hi ? t1 : t0) * (1.f / 128.f) + EPS) * (1.f - LAM_INIT); }
#pragma unroll
        for (int d0 = 0; d0 < NC; ++d0) { const float g = gsub[d0 * 32 + r32];
#pragma unroll
            for (int r = 0; r < 16; ++r) { const int orow = wid * 32 + crow(r, hi); ((bf16*)Ob)[(size_t)orow * ldo + d0 * 32 + r32] = (bf16)f2bf(o[d0][r] * ssv[r] * g); } }
    }
    __syncthreads();
#undef SLOAD
#undef SWRITE
#undef SWAIT
#undef RESC
}

template <int NQ, int ABL = 0> __device__ __forceinline__ void qkt_c(f32x16& p0, f32x16& p1, const LAS char* Ks, const bf16x8* qr, float m_ref, int r32, int hi) {
    f32x16 negm;
#pragma unroll
    for (int r = 0; r < 16; ++r) negm[r] = -m_ref;
    p0 = negm; p1 = negm;
#pragma unroll
    for (int d0 = 0; d0 < NQ; ++d0) { const LAS char* kp = Ks + (2 * d0 + hi) * 1024 + r32 * 16;
        const bf16x8 b0 = *(const LAS bf16x8*)kp, b1 = *(const LAS bf16x8*)(kp + 512);
        p0 = __builtin_amdgcn_mfma_f32_32x32x16_bf16(b0, qr[d0], p0, 0, 0, 0);
        p1 = __builtin_amdgcn_mfma_f32_32x32x16_bf16(b1, qr[d0], p1, 0, 0, 0); }
}
template <int MODE, int EPI, int ABL = 0>
__device__ __forceinline__ void unit_dma(const bf16* __restrict__ Qb, const bf16* __restrict__ K0, const bf16* __restrict__ K1, const bf16* __restrict__ Vh, void* Ob, int ldo, LAS char* lds, char* stash, float lam, const float* gsub) {
    using C = Cfg<MODE>;
    constexpr int DQK = C::DQK, DV = C::DV, NQ = DQK / 16, NC = DV / 32, KS = 2 * NQ * 1024, VS = 64 * DV * 2, NT = NTOK / 64;
    const int tid = threadIdx.x, lane = tid & 63, r32 = lane & 31, hi = lane >> 5; const int wid = __builtin_amdgcn_readfirstlane(tid >> 6);
    LAS char* K_lds = lds; LAS char* V_lds = lds + 4 * KS;
    LAS float* ws = (LAS float*)(lds + 4 * KS + 4 * VS) + wid * 64; LAS float* li_l = ws; LAS float* al_l = ws + 32;
    const bf16* ksA = K0 + (size_t)lane * C::LDK0 + wid * 8;
    const bf16* ksB = MODE == 0 ? K1 + (size_t)lane * C::LDK1 + (wid & 3) * 8 : nullptr;
    auto vsrc = [&](int p) -> const bf16* { const int st = 2 * p + (lane >> 5), k8 = st / NC, cb = st % NC; return Vh + (size_t)(k8 * 8 + ((lane >> 2) & 7)) * C::LDV + cb * 32 + (lane & 3) * 8; };
    const bf16* vsA = vsrc(wid); const bf16* vsB = MODE == 1 ? vsrc(wid + 8) : nullptr;
#define GLDS(src, dst) __builtin_amdgcn_global_load_lds((const unsigned*)(src), (LAS unsigned*)(dst), 16, 0, 0)
#define DMA(t, sl) do { GLDS(ksA + (size_t)(t) * 64 * C::LDK0, K_lds + (sl) * KS + wid * 1024); \
        if (MODE == 0) GLDS(ksB + (size_t)(t) * 64 * C::LDK1, K_lds + (sl) * KS + (8 + (wid & 3)) * 1024); \
        GLDS(vsA + (size_t)(t) * 64 * C::LDV, V_lds + (sl) * VS + wid * 1024); \
        if (MODE == 1) GLDS(vsB + (size_t)(t) * 64 * C::LDV, V_lds + (sl) * VS + (wid + 8) * 1024); } while (0)
#define WAIT_BAR(N) asm volatile("s_waitcnt vmcnt(" #N ") lgkmcnt(0)\n\ts_barrier" ::: "memory")
#define RESC(a) do { if (__any((a) < 1.f)) { if (hi == 0) al_l[r32] = (a); asm volatile("s_waitcnt lgkmcnt(0)" ::: "memory"); \
        _Pragma("unroll") for (int d = 0; d < NC; ++d) _Pragma("unroll") for (int r = 0; r < 16; ++r) o[d][r] *= al_l[crow(r, hi)]; } } while (0)
    DMA(0, 0); DMA(1, 1);
    float m_reg = 0.f, l_reg = 0; f32x16 o[NC]; bf16x8 qr[NQ];
#pragma unroll
    for (int d = 0; d < NC; ++d) o[d] = f32x16{};
    const bf16* Qw = Qb + (size_t)(wid * 32 + r32) * C::LDQ + hi * 8;
#pragma unroll
    for (int d0 = 0; d0 < NQ; ++d0) qr[d0] = *reinterpret_cast<const bf16x8*>(Qw + d0 * 16);
    const int vb0 = (int)(uintptr_t)V_lds + v_rd_base(lane);
    f32x16 pA0, pA1, pB0, pB1; float alA = 1.f, alB = 1.f; bf16x8 pa0, pa1, pa2, pa3;
    WAIT_BAR(0);
#define STEPD(PC0, PC1, ALC, PP0, PP1, ALP, jj, SQ, SV, SW, ISSUE, NW) do { \
        if (ISSUE) DMA((jj) + 2, SW); \
        SBAR(); qkt_c<NQ, ABL>(PC0, PC1, K_lds + (SQ) * KS, qr, m_reg, r32, hi); \
        finishSM<ABL>(PP0, PP1, ALP, l_reg, pa0, pa1, pa2, pa3); SBAR(); \
        pv_all<NC, ABL>(o, vb0 + (SV) * VS, pa0, pa1, pa2, pa3); partialSM<ABL>(PC0, PC1, m_reg, ALC, false); \
        RESC(ALC); if ((NW) == 3) WAIT_BAR(3); else WAIT_BAR(0); } while (0)
    static_assert(NT == 68, "tile schedule below: steps 1..64 in groups of 4, then 65, 66, 67");
    DMA(2, 2); qkt_c<NQ, ABL>(pA0, pA1, K_lds, qr, m_reg, r32, hi); partialSM<ABL>(pA0, pA1, m_reg, alA, true); WAIT_BAR(3);
    for (int j = 1; j < 65; j += 4) {
        STEPD(pB0, pB1, alB, pA0, pA1, alA, j,     1, 0, 3, true, 3);
        STEPD(pA0, pA1, alA, pB0, pB1, alB, j + 1, 2, 1, 0, true, 3);
        STEPD(pB0, pB1, alB, pA0, pA1, alA, j + 2, 3, 2, 1, true, 3);
        STEPD(pA0, pA1, alA, pB0, pB1, alB, j + 3, 0, 3, 2, true, 3);
    }
    STEPD(pB0, pB1, alB, pA0, pA1, alA, 65, 1, 0, 3, true, 3);
    STEPD(pA0, pA1, alA, pB0, pB1, alB, 66, 2, 1, 0, false, 0);
    STEPD(pB0, pB1, alB, pA0, pA1, alA, 67, 3, 2, 1, false, 0);
    finishSM<ABL>(pB0, pB1, alB, l_reg, pa0, pa1, pa2, pa3); SBAR();
    pv_all<NC, ABL>(o, vb0 + 3 * VS, pa0, pa1, pa2, pa3);
#undef STEPD
    if (hi == 0) li_l[r32] = l_reg; asm volatile("s_waitcnt lgkmcnt(0)" ::: "memory");
    float rli[16];
#pragma unroll
    for (int r = 0; r < 16; ++r) rli[r] = __builtin_amdgcn_rcpf(li_l[crow(r, hi)]);
    asm volatile("" : "+s"(ldo), "+s"(stash), "+s"(gsub), "+s"(Ob));
    if constexpr (MODE == 0) {
#pragma unroll
        for (int r = 0; r < 16; ++r) { const int orow = wid * 32 + crow(r, hi);
#pragma unroll
            for (int d0 = 0; d0 < NC; ++d0) ((bf16*)Ob)[(size_t)orow * ldo + d0 * 32 + r32] = (bf16)f2bf(o[d0][r] * rli[r]); }
    } else if constexpr (EPI == 1) {
        char* st = stash + wid * 8192 + lane * 16;
#pragma unroll
        for (int d0 = 0; d0 < NC; ++d0)
#pragma unroll
            for (int q = 0; q < 2; ++q) { u32x4 w;
                w.x = cvtpk(o[d0][8 * q + 0] * rli[8 * q + 0], o[d0][8 * q + 1] * rli[8 * q + 1]); w.y = cvtpk(o[d0][8 * q + 2] * rli[8 * q + 2], o[d0][8 * q + 3] * rli[8 * q + 3]);
                w.z = cvtpk(o[d0][8 * q + 4] * rli[8 * q + 4], o[d0][8 * q + 5] * rli[8 * q + 5]); w.w = cvtpk(o[d0][8 * q + 6] * rli[8 * q + 6], o[d0][8 * q + 7] * rli[8 * q + 7]);
                *(u32x4*)(st + (d0 * 2 + q) * 1024) = w; }
        asm volatile("s_waitcnt vmcnt(0)" ::: "memory");
    } else {
        const char* st = stash + wid * 8192 + lane * 16;
#pragma unroll
        for (int d0 = 0; d0 < NC; ++d0) {
            const u32x4 wa = *(const u32x4*)(st + (d0 * 2 + 0) * 1024), wb = *(const u32x4*)(st + (d0 * 2 + 1) * 1024);
            f32x16 od;
            od[0] = __builtin_bit_cast(float, wa.x << 16); od[1] = __builtin_bit_cast(float, wa.x & 0xffff0000u); od[2] = __builtin_bit_cast(float, wa.y << 16); od[3] = __builtin_bit_cast(float, wa.y & 0xffff0000u);
            od[4] = __builtin_bit_cast(float, wa.z << 16); od[5] = __builtin_bit_cast(float, wa.z & 0xffff0000u); od[6] = __builtin_bit_cast(float, wa.w << 16); od[7] = __builtin_bit_cast(float, wa.w & 0xffff0000u);
            od[8] = __builtin_bit_cast(float, wb.x << 16); od[9] = __builtin_bit_cast(float, wb.x & 0xffff0000u); od[10] = __builtin_bit_cast(float, wb.y << 16); od[11] = __builtin_bit_cast(float, wb.y & 0xffff0000u);
            od[12] = __builtin_bit_cast(float, wb.z << 16); od[13] = __builtin_bit_cast(float, wb.z & 0xffff0000u); od[14] = __builtin_bit_cast(float, wb.w << 16); od[15] = __builtin_bit_cast(float, wb.w & 0xffff0000u);
#pragma unroll
            for (int r = 0; r < 16; ++r) od[r] -= lam * (o[d0][r] * rli[r]);
            o[d0] = od;
        }
        f32x16 ssv;
#pragma unroll
        for (int r = 0; r < 16; ++r) { float x = 0.f;
#pragma unroll
            for (int d0 = 0; d0 < NC; ++d0) x += o[d0][r] * o[d0][r];
            x += __builtin_bit_cast(float, __builtin_amdgcn_update_dpp(0, __builtin_bit_cast(int, x), 0x111, 0xf, 0xf, false));
            x += __builtin_bit_cast(float, __builtin_amdgcn_update_dpp(0, __builtin_bit_cast(int, x), 0x112, 0xf, 0xf, false));
            x += __builtin_bit_cast(float, __builtin_amdgcn_update_dpp(0, __builtin_bit_cast(int, x), 0x114, 0xf, 0xf, false));
            x += __builtin_bit_cast(float, __builtin_amdgcn_update_dpp(0, __builtin_bit_cast(int, x), 0x118, 0xf, 0xf, false));
            x += __builtin_bit_cast(float, __builtin_amdgcn_update_dpp(0, __builtin_bit_cast(int, x), 0x142, 0xa, 0xf, false));
            const float t0 = __builtin_bit_cast(float, __builtin_amdgcn_readlane(__builtin_bit_cast(int, x), 31)), t1 = __builtin_bit_cast(float, __builtin_amdgcn_readlane(__builtin_bit_cast(int, x), 63));
            ssv[r] = rsqrtf((hi ? t1 : t0) * (1.f / 128.f) + EPS) * (1.f - LAM_INIT); }
#pragma unroll
        for (int d0 = 0; d0 < NC; ++d0) { const float g = gsub[d0 * 32 + r32];
#pragma unroll
            for (int r = 0; r < 16; ++r) { const int orow = wid * 32 + crow(r, hi); ((bf16*)Ob)[(size_t)orow * ldo + d0 * 32 + r32] = (bf16)f2bf(o[d0][r] * ssv[r] * g); } }
    }
    __syncthreads();
#undef GLDS
#undef DMA
#undef WAIT_BAR
#undef RESC
}

template <int I> struct IC { static constexpr int value = I; };
template <int I, int N, class F> __device__ __forceinline__ void sfor(F&& f) { if constexpr (I < N) { f(IC<I>{}); sfor<I + 1, N>(f); } }
template <int MODE> struct GC {
    using C = Cfg<MODE>;
    static constexpr int NQ = C::DQK / 16, NC = C::DV / 32, NMQ = 2 * NQ, NMP = 4 * NC, NG = NMQ + NMP, KS = 2 * NQ * 1024, VS = 64 * C::DV * 2;
    static constexpr int GF = MODE == 0 ? 14 : 16, NPRE = 8, NFIN = 80, NLATE = 24, RD = 3;
    f32x16 S[2][2], o[NC], negm; bf16x8 qr[NQ], kf[NMQ]; s16x4 vl[NMP], vh[NMP]; u32x4 w[4];
    float s[4], mxa, mxb, pmax, t0, t1, m_reg, l_reg, al[2];
    const bf16 *ksA, *ksB, *vsA, *vsB; LAS char *K_lds, *V_lds; const LAS char* kb; int vb0, wid, r32, hi; LAS float* al_l;
};
template <int MODE> __device__ __forceinline__ void g_dma(GC<MODE>& c, int t, int sl) {
    using G = GC<MODE>; using C = Cfg<MODE>;
#define GLDS(src, dst) __builtin_amdgcn_global_load_lds((const unsigned*)(src), (LAS unsigned*)(dst), 16, 0, 0)
    GLDS(c.ksA + (size_t)t * 64 * C::LDK0, c.K_lds + sl * G::KS + c.wid * 1024);
    if (MODE == 0) GLDS(c.ksB + (size_t)t * 64 * C::LDK1, c.K_lds + sl * G::KS + (8 + (c.wid & 3)) * 1024);
    GLDS(c.vsA + (size_t)t * 64 * C::LDV, c.V_lds + sl * G::VS + c.wid * 1024);
    if (MODE == 1) GLDS(c.vsB + (size_t)t * 64 * C::LDV, c.V_lds + sl * G::VS + (c.wid + 8) * 1024);
#undef GLDS
}
template <int MODE, int R> __device__ __forceinline__ void g_kread(GC<MODE>& c, const LAS char* kq) { c.kf[R] = *(const LAS bf16x8*)(kq + (R >> 1) * 2048 + (R & 1) * 512); }
template <int MODE, int I> __device__ __forceinline__ void g_vread(GC<MODE>& c, int vb) {
    constexpr int NC = GC<MODE>::NC, ks = I / NC, cb = I % NC, off = cb * 512 + ks * (NC * 1024);
    c.vl[I] = __builtin_amdgcn_ds_read_tr16_b64_v4i16((LAS s16x4*)(uintptr_t)(vb + off));
    c.vh[I] = __builtin_amdgcn_ds_read_tr16_b64_v4i16((LAS s16x4*)(uintptr_t)(vb + off + NC * 512));
}
template <int MODE, int XP, int I> __device__ __forceinline__ void g_fin(GC<MODE>& c) {
    constexpr int ord[20] = {0, 1, 2, 3, 8, 4, 9, 5, 10, 6, 11, 7, 16, 12, 17, 13, 18, 14, 15, 19};
    constexpr int q = I / 20, code = ord[I % 20], ty = code >> 3, ix = code & 7, h = q >> 1, eb = 8 * (q & 1);
    if constexpr (ty == 0) c.S[XP][h][eb + ix] = __builtin_amdgcn_exp2f(c.S[XP][h][eb + ix]);
    else if constexpr (ty == 1) { if constexpr (q == 0 && ix < 4) c.s[ix] = c.S[XP][h][eb + ix]; else c.s[ix & 3] += c.S[XP][h][eb + ix]; }
    else c.w[q][ix] = cvtpk(c.S[XP][h][eb + 2 * ix], c.S[XP][h][eb + 2 * ix + 1]);
}
template <int MODE, int XC, int I> __device__ __forceinline__ void g_late(GC<MODE>& c) {
    constexpr int XP = XC ^ 1;
    if constexpr (I == 0) c.t0 = c.s[0] + c.s[1];
    else if constexpr (I == 1) c.t1 = c.s[2] + c.s[3];
    else if constexpr (I == 2) c.t0 += c.t1;
    else if constexpr (I == 3) { auto rr = __builtin_amdgcn_permlane32_swap(__float_as_uint(c.t0), __float_as_uint(c.t0), false, false); c.t0 = __uint_as_float(rr[0]); c.t1 = __uint_as_float(rr[1]); }
    else if constexpr (I == 4) c.t0 += c.t1;
    else if constexpr (I == 5) c.l_reg = c.l_reg * c.al[XP] + c.t0;
    else if constexpr (I == 6) c.mxa = max3f(c.S[XC][0][0], c.S[XC][0][1], c.S[XC][1][0]);
    else if constexpr (I == 7) c.mxb = max3f(c.S[XC][0][2], c.S[XC][0][3], c.S[XC][1][1]);
    else if constexpr (I == 8) c.mxa = max3f(c.mxa, c.S[XC][1][2], c.S[XC][1][3]);
    else if constexpr (I < 21) { constexpr int j = I - 9, r = 4 + 4 * (j / 4), sub = j % 4, h = sub >> 1, e = r + 2 * (sub & 1);
        if constexpr ((sub & 1) == 0) c.mxa = max3f(c.mxa, c.S[XC][h][e], c.S[XC][h][e + 1]); else c.mxb = max3f(c.mxb, c.S[XC][h][e], c.S[XC][h][e + 1]); }
    else if constexpr (I == 21) c.pmax = __builtin_fmaxf(c.mxa, c.mxb);
    else if constexpr (I == 22) { auto rr = __builtin_amdgcn_permlane32_swap(__float_as_uint(c.pmax), __float_as_uint(c.pmax), false, false); c.mxa = __uint_as_float(rr[0]); c.mxb = __uint_as_float(rr[1]); }
    else c.pmax = __builtin_fmaxf(c.mxa, c.mxb);
}
template <int MODE, int XC, int G> __device__ __forceinline__ void g_mfma(GC<MODE>& c) {
    using T = GC<MODE>;
    if constexpr (G < T::NMQ) { constexpr int d0 = G >> 1, h = G & 1;
        if constexpr (d0 == 0) c.S[XC][h] = __builtin_amdgcn_mfma_f32_32x32x16_bf16(c.kf[G], c.qr[d0], c.negm, 0, 0, 0);
        else c.S[XC][h] = __builtin_amdgcn_mfma_f32_32x32x16_bf16(c.kf[G], c.qr[d0], c.S[XC][h], 0, 0, 0);
    } else { constexpr int i = G - T::NMQ, ks = i / T::NC, cb = i % T::NC;
        const bf16x8 vf = {c.vl[i][0], c.vl[i][1], c.vl[i][2], c.vl[i][3], c.vh[i][0], c.vh[i][1], c.vh[i][2], c.vh[i][3]};
        c.o[cb] = __builtin_amdgcn_mfma_f32_32x32x16_bf16(__builtin_bit_cast(bf16x8, c.w[ks]), vf, c.o[cb], 0, 0, 0); }
}
#define G_WAIT_BAR(N) asm volatile("s_waitcnt vmcnt(" #N ") lgkmcnt(0)\n\ts_barrier" ::: "memory")
#define G_RESC(a) do { if (__any((a) < 1.f)) { if (c.hi == 0) c.al_l[c.r32] = (a); asm volatile("s_waitcnt lgkmcnt(0)" ::: "memory"); \
        _Pragma("unroll") for (int d = 0; d < T::NC; ++d) _Pragma("unroll") for (int r = 0; r < 16; ++r) c.o[d][r] *= c.al_l[crow(r, c.hi)]; } } while (0)
template <int MODE, int XC, int SQ, int SV, int SW, bool ISSUE, int NW, int ABL = 0> __device__ __forceinline__ void g_step(GC<MODE>& c, int t) {
    using T = GC<MODE>; constexpr int XP = XC ^ 1;
    if constexpr (ISSUE && ABL != 3) g_dma<MODE>(c, t + 2, SW);
    const LAS char* kq = c.kb + SQ * T::KS; const int vb = c.vb0 + SV * T::VS;
    if constexpr (ABL != 5) sfor<0, T::RD>([&](auto i) { g_kread<MODE, decltype(i)::value>(c, kq); });
    if constexpr (ABL != 1) sfor<0, T::NPRE>([&](auto i) { g_fin<MODE, XP, decltype(i)::value>(c); });
    SBAR();
    sfor<0, T::NG>([&](auto gi) { constexpr int g = decltype(gi)::value, r = g + T::RD;
        if constexpr (ABL != 2) g_mfma<MODE, XC, g>(c);
        else { if constexpr (g < T::NMQ) asm volatile("" :: "v"(c.kf[g])); else asm volatile("" :: "v"(c.vl[g - T::NMQ]), "v"(c.vh[g - T::NMQ])); }
        if constexpr (ABL == 5) {} else if constexpr (r < T::NMQ) g_kread<MODE, r>(c, kq); else if constexpr (r < T::NG) g_vread<MODE, r - T::NMQ>(c, vb);
        if constexpr (ABL == 1) {} else if constexpr (g < T::GF) { constexpr int lo = T::NPRE + g * (T::NFIN - T::NPRE) / T::GF, hi = T::NPRE + (g + 1) * (T::NFIN - T::NPRE) / T::GF;
            sfor<lo, hi>([&](auto i) { g_fin<MODE, XP, decltype(i)::value>(c); });
        } else { constexpr int lo = (g - T::GF) * T::NLATE / (T::NG - T::GF), hi = (g - T::GF + 1) * T::NLATE / (T::NG - T::GF);
            sfor<lo, hi>([&](auto i) { g_late<MODE, XC, decltype(i)::value>(c); }); }
        SBAR(); });
    if constexpr (ABL == 1) c.pmax = 0.f;
    c.al[XC] = 1.f;
    if (__builtin_expect(__any(c.pmax > THR2), 0)) {
        const float dl = __builtin_fmaxf(c.pmax, 0.f); c.al[XC] = __builtin_amdgcn_exp2f(-dl);
        const float x = -dl; const unsigned xh = __float_as_uint(x) & 0xffff0000u; const float r1 = x - __uint_as_float(xh);
        const unsigned xm = __float_as_uint(r1) & 0xffff0000u; const float r2 = r1 - __uint_as_float(xm); const unsigned xl = __float_as_uint(r2) & 0xffff0000u;
        const unsigned one = c.hi == 0 ? 0x3f803f80u : 0u;
        const u32x4 av = {one, one & 0xffffu, 0u, 0u}, bv = {c.hi == 0 ? ((xh >> 16) | xm) : 0u, c.hi == 0 ? (xl >> 16) : 0u, 0u, 0u};
        const bf16x8 A1 = __builtin_bit_cast(bf16x8, av), B1 = __builtin_bit_cast(bf16x8, bv);
        c.S[XC][0] = __builtin_amdgcn_mfma_f32_32x32x16_bf16(A1, B1, c.S[XC][0], 0, 0, 0);
        c.S[XC][1] = __builtin_amdgcn_mfma_f32_32x32x16_bf16(A1, B1, c.S[XC][1], 0, 0, 0);
        c.negm = __builtin_amdgcn_mfma_f32_32x32x16_bf16(A1, B1, c.negm, 0, 0, 0);
    }
    G_RESC(c.al[XC]);
    if constexpr (ABL == 4) { if constexpr (NW == 3) asm volatile("s_waitcnt vmcnt(3) lgkmcnt(0)" ::: "memory"); else asm volatile("s_waitcnt vmcnt(0) lgkmcnt(0)" ::: "memory"); }
    else if constexpr (NW == 3) G_WAIT_BAR(3); else G_WAIT_BAR(0);
}
template <int MODE, int EPI, int ABL = 0>
__device__ __forceinline__ void unit_gap(const bf16* __restrict__ Qb, const bf16* __restrict__ K0, const bf16* __restrict__ K1, const bf16* __restrict__ Vh, void* Ob, int ldo, LAS char* lds, char* stash, float lam, const float* gsub) {
    using C = Cfg<MODE>; using T = GC<MODE>;
    constexpr int NQ = T::NQ, NC = T::NC, KS = T::KS, VS = T::VS, NT = NTOK / 64;
    int tid_ = threadIdx.x; asm volatile("" : "+v"(tid_));
    const int tid = tid_, lane = tid & 63, r32 = lane & 31, hi = lane >> 5; const int wid = __builtin_amdgcn_readfirstlane(tid >> 6);
    GC<MODE> c;
    c.K_lds = lds; c.V_lds = lds + 4 * KS; c.wid = wid; c.r32 = r32; c.hi = hi;
    LAS float* ws = (LAS float*)(lds + 4 * KS + 4 * VS) + wid * 64; LAS float* li_l = ws; LAS float* al_l = ws + 32; c.al_l = al_l;
    c.ksA = K0 + (size_t)lane * C::LDK0 + wid * 8;
    c.ksB = MODE == 0 ? K1 + (size_t)lane * C::LDK1 + (wid & 3) * 8 : nullptr;
    auto vsrc = [&](int p) -> const bf16* { const int st = 2 * p + (lane >> 5), k8 = st / NC, cb = st % NC; return Vh + (size_t)(k8 * 8 + ((lane >> 2) & 7)) * C::LDV + cb * 32 + (lane & 3) * 8; };
    c.vsA = vsrc(wid); c.vsB = MODE == 1 ? vsrc(wid + 8) : nullptr;
    c.kb = c.K_lds + hi * 1024 + r32 * 16; c.vb0 = (int)(uintptr_t)c.V_lds + v_rd_base(lane);
    g_dma<MODE>(c, 0, 0); g_dma<MODE>(c, 1, 1);
    c.m_reg = 0.f; c.l_reg = 0.f; c.al[0] = c.al[1] = 1.f;
#pragma unroll
    for (int d = 0; d < NC; ++d) c.o[d] = f32x16{};
    const bf16* Qw = Qb + (size_t)(wid * 32 + r32) * C::LDQ + hi * 8;
#pragma unroll
    for (int d0 = 0; d0 < NQ; ++d0) c.qr[d0] = *reinterpret_cast<const bf16x8*>(Qw + d0 * 16);
    G_WAIT_BAR(0);
    static_assert(NT == 68, "tile schedule below: steps 1..64 in groups of 4, then 65, 66, 67");
    {
        g_dma<MODE>(c, 2, 2);
        c.negm = f32x16{};
        sfor<0, T::NMQ>([&](auto i) { g_kread<MODE, decltype(i)::value>(c, c.kb); });
        sfor<0, T::NMQ>([&](auto i) { g_mfma<MODE, 0, decltype(i)::value>(c); });
        sfor<6, T::NLATE>([&](auto i) { g_late<MODE, 0, decltype(i)::value>(c); });
        c.m_reg = c.pmax;
#pragma unroll
        for (int r = 0; r < 16; ++r) { c.S[0][0][r] -= c.pmax; c.S[0][1][r] -= c.pmax; c.negm[r] = -c.m_reg; }
        asm volatile("" : "+v"(c.negm));
        G_WAIT_BAR(3);
    }
    for (int j = 1; j < 65; j += 4) {
        g_step<MODE, 1, 1, 0, 3, true, 3, ABL>(c, j);
        g_step<MODE, 0, 2, 1, 0, true, 3, ABL>(c, j + 1);
        g_step<MODE, 1, 3, 2, 1, true, 3, ABL>(c, j + 2);
        g_step<MODE, 0, 0, 3, 2, true, 3, ABL>(c, j + 3);
    }
    g_step<MODE, 1, 1, 0, 3, true, 3, ABL>(c, 65);
    g_step<MODE, 0, 2, 1, 0, false, 0, ABL>(c, 66);
    g_step<MODE, 1, 3, 2, 1, false, 0, ABL>(c, 67);
    {
        const int vb = c.vb0 + 3 * VS;
        sfor<0, T::NMP>([&](auto i) { g_vread<MODE, decltype(i)::value>(c, vb); });
        sfor<0, T::NFIN>([&](auto i) { g_fin<MODE, 1, decltype(i)::value>(c); });
        sfor<0, 6>([&](auto i) { g_late<MODE, 0, decltype(i)::value>(c); });
        sfor<0, T::NMP>([&](auto i) { g_mfma<MODE, 0, T::NMQ + decltype(i)::value>(c); });
    }
    f32x16 (&o)[NC] = c.o; float& l_reg = c.l_reg;
    if (hi == 0) li_l[r32] = l_reg; asm volatile("s_waitcnt lgkmcnt(0)" ::: "memory");
    float rli[16];
#pragma unroll
    for (int r = 0; r < 16; ++r) rli[r] = __builtin_amdgcn_rcpf(li_l[crow(r, hi)]);
    asm volatile("" : "+s"(ldo), "+s"(stash), "+s"(gsub), "+s"(Ob));
    if constexpr (MODE == 0) {
#pragma unroll
        for (int r = 0; r < 16; ++r) { const int orow = wid * 32 + crow(r, hi);
#pragma unroll
            for (int d0 = 0; d0 < NC; ++d0) ((bf16*)Ob)[(size_t)orow * ldo + d0 * 32 + r32] = (bf16)f2bf(o[d0][r] * rli[r]); }
    } else if constexpr (EPI == 1) {
        char* st = stash + wid * 8192 + lane * 16;
#pragma unroll
        for (int d0 = 0; d0 < NC; ++d0)
#pragma unroll
            for (int q = 0; q < 2; ++q) { u32x4 w;
                w.x = cvtpk(o[d0][8 * q + 0] * rli[8 * q + 0], o[d0][8 * q + 1] * rli[8 * q + 1]); w.y = cvtpk(o[d0][8 * q + 2] * rli[8 * q + 2], o[d0][8 * q + 3] * rli[8 * q + 3]);
                w.z = cvtpk(o[d0][8 * q + 4] * rli[8 * q + 4], o[d0][8 * q + 5] * rli[8 * q + 5]); w.w = cvtpk(o[d0][8 * q + 6] * rli[8 * q + 6], o[d0][8 * q + 7] * rli[8 * q + 7]);
                *(u32x4*)(st + (d0 * 2 + q) * 1024) = w; }
        asm volatile("s_waitcnt vmcnt(0)" ::: "memory");
    } else {
        const char* st = stash + wid * 8192 + lane * 16;
#pragma unroll
        for (int d0 = 0; d0 < NC; ++d0) {
            const u32x4 wa = *(const u32x4*)(st + (d0 * 2 + 0) * 1024), wb = *(const u32x4*)(st + (d0 * 2 + 1) * 1024);
            f32x16 od;
            od[0] = __builtin_bit_cast(float, wa.x << 16); od[1] = __builtin_bit_cast(float, wa.x & 0xffff0000u); od[2] = __builtin_bit_cast(float, wa.y << 16); od[3] = __builtin_bit_cast(float, wa.y & 0xffff0000u);
            od[4] = __builtin_bit_cast(float, wa.z << 16); od[5] = __builtin_bit_cast(float, wa.z & 0xffff0000u); od[6] = __builtin_bit_cast(float, wa.w << 16); od[7] = __builtin_bit_cast(float, wa.w & 0xffff0000u);
            od[8] = __builtin_bit_cast(float, wb.x << 16); od[9] = __builtin_bit_cast(float, wb.x & 0xffff0000u); od[10] = __builtin_bit_cast(float, wb.y << 16); od[11] = __builtin_bit_cast(float, wb.y & 0xffff0000u);
            od[12] = __builtin_bit_cast(float, wb.z << 16); od[13] = __builtin_bit_cast(float, wb.z & 0xffff0000u); od[14] = __builtin_bit_cast(float, wb.w << 16); od[15] = __builtin_bit_cast(float, wb.w & 0xffff0000u);
#pragma unroll
            for (int r = 0; r < 16; ++r) od[r] -= lam * (o[d0][r] * rli[r]);
            o[d0] = od;
        }
        f32x16 ssv;
#pragma unroll
        for (int r = 0; r < 16; ++r) { float x = 0.f;
#pragma unroll
            for (int d0 = 0; d0 < NC; ++d0) x += o[d0][r] * o[d0][r];
            x += __builtin_bit_cast(float, __builtin_amdgcn_update_dpp(0, __builtin_bit_cast(int, x), 0x111, 0xf, 0xf, false));
            x += __builtin_bit_cast(float, __builtin_amdgcn_update_dpp(0, __builtin_bit_cast(int, x), 0x112, 0xf, 0xf, false));
            x += __builtin_bit_cast(float, __builtin_amdgcn_update_dpp(0, __builtin_bit_cast(int, x), 0x114, 0xf, 0xf, false));
            x += __builtin_bit_cast(float, __builtin_amdgcn_update_dpp(0, __builtin_bit_cast(int, x), 0x118, 0xf, 0xf, false));
            x += __builtin_bit_cast(float, __builtin_amdgcn_update_dpp(0, __builtin_bit_cast(int, x), 0x142, 0xa, 0xf, false));
            const float t0 = __builtin_bit_cast(float, __builtin_amdgcn_readlane(__builtin_bit_cast(int, x), 31)), t1 = __builtin_bit_cast(float, __builtin_amdgcn_readlane(__builtin_bit_cast(int, x), 63));
            ssv[r] = rsqrtf((hi ? t1 : t0) * (1.f / 128.f) + EPS) * (1.f - LAM_INIT); }
#pragma unroll
        for (int d0 = 0; d0 < NC; ++d0) { const float g = gsub[d0 * 32 + r32];
#pragma unroll
            for (int r = 0; r < 16; ++r) { const int orow = wid * 32 + crow(r, hi); ((bf16*)Ob)[(size_t)orow * ldo + d0 * 32 + r32] = (bf16)f2bf(o[d0][r] * ssv[r] * g); } }
    }
    __syncthreads();
}
#undef G_WAIT_BAR
#undef G_RESC

#ifndef GAPM0
#define GAPM0 1
#endif
#ifndef GAPM1
#define GAPM1 1
#endif
template <int MODE, int EPI, int ABL = 0>
__device__ __forceinline__ void unit(const bf16* __restrict__ Qb, const bf16* __restrict__ K0, const bf16* __restrict__ K1, const bf16* __restrict__ Vh, void* Ob, int ldo, LAS char* lds, char* stash, float lam, const float* gsub) {
    if constexpr ((MODE == 0 && GAPM0) || (MODE == 1 && GAPM1)) unit_gap<MODE, EPI, ABL>(Qb, K0, K1, Vh, Ob, ldo, lds, stash, lam, gsub);
    else unit_dma<MODE, EPI, ABL>(Qb, K0, K1, Vh, Ob, ldo, lds, stash, lam, gsub);
}


#undef SBAR
}

#define XB_TMO      128
#define XB_XCNT(j)  (256  + 64 * (j))
#define XB_XSUB(j)  (1280 + 64 * (j))
#define XB_XGEN(j)  (2304 + 64 * (j))
#define XB_TOP      3328
#define XB_TOPGEN   3392
#define XCD_BAR_WORDS 3456
#define XB_SPIN_CAP (1u << 20)
__device__ __forceinline__ unsigned xb_ld(unsigned* p)              { return __hip_atomic_load(p, __ATOMIC_RELAXED, __HIP_MEMORY_SCOPE_AGENT); }
__device__ __forceinline__ unsigned xb_add(unsigned* p, unsigned v) { return __hip_atomic_fetch_add(p, v, __ATOMIC_RELAXED, __HIP_MEMORY_SCOPE_AGENT); }
__device__ __forceinline__ unsigned xb_xcc_id() { return (unsigned)__builtin_amdgcn_s_getreg((3 << 11) | 20) & 0xFu; }
#define XB_SPIN(cond, bar) do { unsigned _sp = 0; while (cond) { __builtin_amdgcn_s_sleep(1); \
    if ((++_sp & 255u) == 0u) { if (xb_ld(&(bar)[XB_TMO])) break; if (_sp > XB_SPIN_CAP) { atomicAdd(&(bar)[XB_TMO], 1u); break; } } } } while (0)
struct XcdBarrier { unsigned* bar; unsigned x; volatile LAS unsigned* st; };
__device__ __forceinline__ XcdBarrier xcd_barrier_post(unsigned* bar, volatile LAS unsigned* st) {
    XcdBarrier b; b.bar = bar; b.x = xb_xcc_id(); b.st = st;
    if (threadIdx.x == 0) (void)xb_add(&bar[XB_XCNT(b.x)], 1u);
    return b;
}
__device__ __forceinline__ void xcd_barrier_complete(unsigned* bar, unsigned x, unsigned& nloc, unsigned& nx) {
    const unsigned G = gridDim.x * gridDim.y * gridDim.z;
    unsigned sum, cnt, mine, sp = 0u;
    for (;;) {
        sum = 0u; cnt = 0u; mine = 0u;
#pragma unroll
        for (unsigned j = 0; j < 16; ++j) { const unsigned c = xb_ld(&bar[XB_XCNT(j)]); sum += c; cnt += (c > 0u) ? 1u : 0u; mine = (j == x) ? c : mine; }
        if (sum == G) break;
        __builtin_amdgcn_s_sleep(1);
        if ((++sp & 255u) == 0u) { if (xb_ld(&bar[XB_TMO])) break; if (sp > XB_SPIN_CAP) { atomicAdd(&bar[XB_TMO], 1u); break; } }
    }
    nloc = mine > 0u ? mine : 1u; nx = cnt > 0u ? cnt : 1u;
}
__device__ __forceinline__ void xcd_barrier(const XcdBarrier& b) {
    asm volatile("s_waitcnt vmcnt(0)" ::: "memory");
    __syncthreads();
    if (threadIdx.x == 0) {
        unsigned* bar = b.bar;
        __builtin_amdgcn_s_waitcnt(0);
        unsigned nloc = b.st[0], nx = b.st[1];
        if (nloc == 0u) { xcd_barrier_complete(bar, b.x, nloc, nx); b.st[0] = nloc; b.st[1] = nx; }
        const unsigned old = xb_add(&bar[XB_XSUB(b.x)], 1u);
        const unsigned gen = old / nloc;
        if (old + 1u == (gen + 1u) * nloc) {
            __builtin_amdgcn_fence(__ATOMIC_RELEASE, "agent");
            asm volatile("s_waitcnt vmcnt(0)" ::: "memory");
            const unsigned og = xb_add(&bar[XB_TOP], 1u);
            const unsigned tg = og / nx;
            if (og + 1u == (tg + 1u) * nx) xb_add(&bar[XB_TOPGEN], 1u);
            else XB_SPIN(xb_ld(&bar[XB_TOPGEN]) == tg, bar);
            __builtin_amdgcn_fence(__ATOMIC_ACQUIRE, "agent");
            xb_add(&bar[XB_XGEN(b.x)], 1u);
            asm volatile("s_waitcnt vmcnt(0)" ::: "memory");
        } else {
            XB_SPIN(xb_ld(&bar[XB_XGEN(b.x)]) == gen, bar);
            __builtin_amdgcn_fence(__ATOMIC_ACQUIRE, "agent");
            asm volatile("s_waitcnt vmcnt(0)" ::: "memory");
        }
    }
    __syncthreads();
}

constexpr int NWAVES = 8;
constexpr int RING_BYTES = 131072, LDS_BYTES = 147456, LDSCTL_OFF = LDS_BYTES - 2048, MISC_OFF = LDSCTL_OFF + 320, UCACHE_OFF = LDSCTL_OFF + 1024  ;

struct Frame {
    LAS unsigned char* lds; volatile LAS unsigned* MISC; unsigned* ctl;
    int tid, lane, wave, vcu, G;
    Ptrs P;
    __device__ __forceinline__ LAS char* lds_c() const { return (LAS char*)lds; }
};

template <class SrcF> __device__ __forceinline__ void transpose_item(const SrcF& f, int K, bf16* WT, int p0, int k0, LAS float* scr, int lane) {
    float t[32];
#pragma unroll
    for (int i = 0; i < 32; ++i) t[i] = f(k0 + 2 * i + (lane >> 5), p0 + (lane & 31));
#pragma unroll
    for (int i = 0; i < 32; ++i) scr[(2 * i + (lane >> 5)) * 33 + (lane & 31)] = t[i];
    LDS_WAIT(); asm volatile("" ::: "memory");
    const int c = lane & 7;
#pragma unroll
    for (int j = 0; j < 4; ++j) { const int n = (lane >> 3) + 8 * j; const LAS float* s = scr + (8 * c) * 33 + n;
        u32x4 o; o.x = cvt_pk_bf16(s[0 * 33], s[1 * 33]); o.y = cvt_pk_bf16(s[2 * 33], s[3 * 33]); o.z = cvt_pk_bf16(s[4 * 33], s[5 * 33]); o.w = cvt_pk_bf16(s[6 * 33], s[7 * 33]);
        *(u32x4*)(WT + (size_t)(p0 + n) * K + k0 + 8 * c) = o; }
    LDS_WAIT(); asm volatile("" ::: "memory");
}
struct SrcWin { const float* w; __device__ float operator()(int k, int p) const { const int l = p1_logical(p); return l < 0 ? 0.f : w[(size_t)k * IN_COLS + l]; } };
struct SrcWup { const float *gq, *wuq, *gkv, *wukv;
    __device__ float operator()(int k, int p) const {
        if (p < 768) return k < 256 ? gq[k] * wuq[(size_t)k * 768 + qm_logical(p)] : 0.f;
        return k >= 256 ? gkv[k - 256] * wukv[(size_t)(k - 256) * 1024 + (p - 768)] : 0.f; } };
__host__ __device__ __forceinline__ int ctx_dstcol(int cp) { return cp < 128 ? 256 + cp : cp < 160 ? 384 + (cp - 128) : cp < 672 ? 1024 + (cp - 160) : cp < 1184 ? 1536 + (cp - 672) : -1; }
struct SrcCtx { const float* w; __device__ float operator()(int k, int p) const { const int c = ctx_dstcol(p); const int l = c < 0 ? -1 : p1_logical(c); return l < 0 ? 0.f : w[(size_t)k * IN_COLS + l]; } };
struct SrcPlain { const float* w; int N; int coff; __device__ float operator()(int k, int p) const { return w[(size_t)k * N + p + coff]; } };

__device__ __forceinline__ void ph0_prep(Frame& F) {
    LAS float* scr = (LAS float*)(F.lds + F.wave * 16384);
    const int gw = F.vcu * NWAVES + F.wave, NGW = F.G * NWAVES, lane = F.lane;
    const Ptrs& P = F.P; unsigned char* ws = P.ws;
    constexpr int I_IN = 16 * 64, I_UP = 6 * 56, I_OUT = 16 * 32, I_R = 16 * 8, I_CTX = 16 * 38, I_SMALL = I_IN + I_UP + I_OUT + I_R + I_CTX;
    for (int it = gw; it < I_SMALL; it += NGW) {
        int r = it;
        if (r < I_IN) { transpose_item(SrcWin{P.in[8]}, 1024, (bf16*)(ws + WS_WIN), (r % 64) * 32, (r / 64) * 64, scr, lane); continue; } r -= I_IN;
        if (r < I_UP) { transpose_item(SrcWup{P.in[9], P.in[10], P.in[11], P.in[12]}, 384, (bf16*)(ws + WS_WUP), (r % 56) * 32, (r / 56) * 64, scr, lane); continue; } r -= I_UP;
        if (r < I_OUT) { transpose_item(SrcPlain{P.in[18], 1024, 0}, 1024, (bf16*)(ws + WS_WOUT), (r % 32) * 32, (r / 32) * 64, scr, lane); continue; } r -= I_OUT;
        if (r < I_R) { transpose_item(SrcPlain{P.in[19], 256, 0}, 1024, (bf16*)(ws + WS_WR), (r % 8) * 32, (r / 8) * 64, scr, lane); continue; } r -= I_R;
        transpose_item(SrcCtx{P.in[8]}, 1024, (bf16*)(ws + WS_WCTX), (r % 38) * 32, (r / 38) * 64, scr, lane);
    }
    for (int it = gw; it < 96 * 16; it += NGW) {
        const int cg = it % 96, kp = it / 96;
#pragma unroll
        for (int r = 0; r < 5; ++r) { const float c = (r < 4 ? P.in[1] + r * DM : P.in[3])[kp * 64 + lane]; scr[r * 64 + lane] = c / (1.f + __expf(-c)); }
        LDS_WAIT(); asm volatile("" ::: "memory");
        float acc[5] = {0.f, 0.f, 0.f, 0.f, 0.f};
        const float* W = P.in[4] + (size_t)(kp * 64) * 6144 + cg * 64 + lane;
#pragma unroll 8
        for (int kk = 0; kk < 64; ++kk) { const float w = W[(size_t)kk * 6144];
#pragma unroll
            for (int r = 0; r < 5; ++r) acc[r] += scr[r * 64 + kk] * w; }
        LDS_WAIT(); asm volatile("" ::: "memory");
#pragma unroll
        for (int r = 0; r < 5; ++r) ((float*)(ws + WS_MODP))[(size_t)(kp * 5 + r) * 6144 + cg * 64 + lane] = acc[r];
    }
    { const int idx = (F.vcu * 512 + F.tid);
      if (idx < 1024) { const int v = idx / 16, f = idx % 16; const float th = (float)v * exp2f(-(float)f / 16.f * 13.287712379549449f);
          ((float2*)(ws + WS_TAB))[idx] = make_float2(__builtin_amdgcn_cosf(th * 0.15915494309189535f), __builtin_amdgcn_sinf(th * 0.15915494309189535f)); }
      else if (idx < 1536) { const int i2 = idx - 1024, v = i2 / 8, f = i2 % 8; const float th = (float)v * exp2f(-(float)f / 8.f * 13.287712379549449f);
          ((float2*)(ws + WS_TAB))[idx] = make_float2(__builtin_amdgcn_cosf(th * 0.15915494309189535f), __builtin_amdgcn_sinf(th * 0.15915494309189535f)); } }
}
struct CvItem { const float* src; int ld; bf16* dst; int K; };
__device__ __forceinline__ CvItem cv_decode(const Ptrs& P, int it, int lane) {
    constexpr int IPE = 256 + 128; unsigned char* ws = P.ws;
    const int e = it / IPE; int r = it % IPE; CvItem c;
    if (r < 256) { const int p0 = (r % 16) * 32, k0 = (r / 16) * 64, half = p0 >> 8, up = (p0 >> 7) & 1;
        const float* w = e < 256 ? (up ? P.in[22] : P.in[21]) + (size_t)e * DM * EFF : (up ? P.in[25] : P.in[24]);
        c.src = w + (size_t)(k0 + (lane >> 5)) * EFF + half * 128 + (p0 & 127) + (lane & 31); c.ld = EFF; c.K = 1024;
        c.dst = (bf16*)(ws + WS_W13) + ((size_t)e * 512 + p0) * 1024 + k0; }
    else { r -= 256; const int p0 = (r % 32) * 32, k0 = (r / 32) * 64;
        const float* w = e < 256 ? P.in[23] + (size_t)e * EFF * DM : P.in[26];
        c.src = w + (size_t)(k0 + (lane >> 5)) * DM + p0 + (lane & 31); c.ld = DM; c.K = 256;
        c.dst = (bf16*)(ws + WS_W2) + ((size_t)e * 1024 + p0) * 256 + k0; }
    return c;
}
#ifndef CVV
#define CVV 3
#endif
#ifndef CVP
#define CVP 0
#endif
#define CV_LOAD(t, c) do { _Pragma("unroll") for (int _i = 0; _i < 32; ++_i) { if (CVP == 2 && probe) t[_i] = (float)_i; else if (CVV == 3) t[_i] = __builtin_nontemporal_load((c).src + (size_t)(2 * _i) * (c).ld); else t[_i] = (c).src[(size_t)(2 * _i) * (c).ld]; } } while (0)
#define CV_FINISH(t, c) do { _Pragma("unroll") for (int _i = 0; _i < 32; ++_i) scr[(2 * _i + (lane >> 5)) * 33 + (lane & 31)] = t[_i]; \
        LDS_WAIT(); asm volatile("" ::: "memory"); const int _c = lane & 7; \
        _Pragma("unroll") for (int _j = 0; _j < 4; ++_j) { const int _n = (lane >> 3) + 8 * _j; const LAS float* _s = scr + (8 * _c) * 33 + _n; \
            u32x4 _o; _o.x = cvt_pk_bf16(_s[0 * 33], _s[1 * 33]); _o.y = cvt_pk_bf16(_s[2 * 33], _s[3 * 33]); _o.z = cvt_pk_bf16(_s[4 * 33], _s[5 * 33]); _o.w = cvt_pk_bf16(_s[6 * 33], _s[7 * 33]); \
            if (!(CVP == 1 && probe)) *(u32x4*)((c).dst + (size_t)_n * (c).K + 8 * _c) = _o; else asm volatile("" :: "v"(_o)); } \
        LDS_WAIT(); asm volatile("" ::: "memory"); } while (0)
constexpr int CV_EARLY = 0;
__device__ __forceinline__ void ph0_experts(Frame& F, int r_from, int r_to, bool probe = false) {
    __syncthreads();
    LAS float* scr = (LAS float*)(F.lds + F.wave * 16384);
    const int gw = F.vcu * NWAVES + F.wave, NGW = F.G * NWAVES, lane = F.lane, NIT = 257 * 384;
    const Ptrs& P = F.P;
    float ta[32], tb[32];
    const long lim = (long)gw + (long)(r_to < (1 << 20) ? r_to : (1 << 20)) * NGW; const int NE = (int)(lim < NIT ? lim : NIT);
    int it = gw + r_from * NGW; CvItem ca, cb;
    if (it < NE) { ca = cv_decode(P, it, lane); CV_LOAD(ta, ca); }
    for (; it < NE; it += 2 * NGW) {
        const int it2 = it + NGW, it3 = it + 2 * NGW;
        if (it2 < NE) { cb = cv_decode(P, it2, lane); CV_LOAD(tb, cb); }
        CV_FINISH(ta, ca);
        if (it3 < NE) { ca = cv_decode(P, it3, lane); CV_LOAD(ta, ca); }
        if (it2 < NE) CV_FINISH(tb, cb);
    }
    __syncthreads();
}
#undef CV_LOAD
#undef CV_FINISH
__device__ __forceinline__ void ph1_xn(Frame& F) {
    const Ptrs& P = F.P; unsigned char* ws = P.ws; const int lane = F.lane, wave = F.wave, fr = lane & 15, fq = lane >> 4;
    const float* MODP = (const float*)(ws + WS_MODP);
    for (int idx = F.vcu * 512 + F.tid; idx < 5 * 6144; idx += F.G * 512) { const int r = idx / 6144, j = idx % 6144; float a = P.in[5][j];
#pragma unroll
        for (int kp = 0; kp < 16; ++kp) a += MODP[(size_t)(kp * 5 + r) * 6144 + j];
        ((float*)(ws + WS_MOD))[idx] = a; }
    LAS unsigned char* At = F.lds;
    LAS float* sm = (LAS float*)(F.lds + 32768);
    const int t0 = F.vcu * 64, bl = t0 / SEQ;
    for (int i = F.tid; i < 4096; i += 512) { const int j = i & 2047, mrow = i < 2048 ? bl : 4; float a = P.in[5][j];
#pragma unroll
        for (int kp = 0; kp < 16; ++kp) a += MODP[(size_t)(kp * 5 + mrow) * 6144 + j];
        sm[i] = a; }
    __syncthreads();
    {
        f32x4 v[4], nv[4];
        { const f32x4* xr = (const f32x4*)(P.in[0] + (size_t)(t0 + wave * 8) * DM) + lane;
#pragma unroll
          for (int j = 0; j < 4; ++j) v[j] = xr[64 * j]; }
#pragma unroll 1
        for (int i = 0; i < 8; ++i) {
            const int t = t0 + wave * 8 + i, r = bl * NTOK + NCTX + (t - bl * SEQ);
            { const f32x4* xr = (const f32x4*)(P.in[0] + (size_t)(i < 7 ? t + 1 : t) * DM) + lane;
#pragma unroll
              for (int j = 0; j < 4; ++j) nv[j] = xr[64 * j]; }
            float s = 0.f;
#pragma unroll
            for (int j = 0; j < 4; ++j) s += (v[j][0] * v[j][0] + v[j][1] * v[j][1]) + (v[j][2] * v[j][2] + v[j][3] * v[j][3]);
            const float rs = rsqrtf(wave_sum(s) * (1.f / DM) + EPS);
            u32x2* o8 = (u32x2*)((bf16*)(ws + WS_XN) + (size_t)r * DM) + lane;
#pragma unroll
            for (int j = 0; j < 4; ++j) { const int c = 4 * lane + 256 * j; const f32x4 g = *(const f32x4*)(P.in[6] + c);
                const f32x4 sh = *(const LAS f32x4*)(sm + c), sc = *(const LAS f32x4*)(sm + 1024 + c);
                const f32x4 y = (v[j] * rs * g) * (sc + 1.f) + sh;
                u32x2 w; w.x = cvt_pk_bf16(y[0], y[1]); w.y = cvt_pk_bf16(y[2], y[3]); o8[64 * j] = w; }
#pragma unroll
            for (int j = 0; j < 4; ++j) v[j] = nv[j];
        }
    }
    const int mt = F.vcu >> 2, q = F.vcu & 3, bc = mt >> 4, nc0 = (mt & 15) * 16;
#pragma unroll 1
    for (int i = 0; i < 2; ++i) {
        const int r = 2 * wave + i;
        const f32x4* xr = (const f32x4*)(P.in[2] + ((size_t)bc * NCTX + nc0 + r) * DM) + lane;
        f32x4 v[4]; float s = 0.f;
#pragma unroll
        for (int j = 0; j < 4; ++j) { v[j] = xr[64 * j]; s += (v[j][0] * v[j][0] + v[j][1] * v[j][1]) + (v[j][2] * v[j][2] + v[j][3] * v[j][3]); }
        const float rs = rsqrtf(wave_sum(s) * (1.f / DM) + EPS);
#pragma unroll
        for (int j = 0; j < 4; ++j) { const int c = 4 * lane + 256 * j; const f32x4 g = *(const f32x4*)(P.in[6] + c);
            const f32x4 sh = *(const LAS f32x4*)(sm + 2048 + c), sc = *(const LAS f32x4*)(sm + 3072 + c);
            const f32x4 y = (v[j] * rs * g) * (sc + 1.f) + sh;
            u32x2 w; w.x = cvt_pk_bf16(y[0], y[1]); w.y = cvt_pk_bf16(y[2], y[3]);
            const int ch = (lane >> 1) + 32 * j;
            *(LAS u32x2*)(At + r * 2048 + ((ch ^ r) << 4) + (lane & 1) * 8) = w; }
    }
    __syncthreads();
    {
        const int nt0 = wave < 3 ? 3 * wave : 9 + 2 * (wave - 3), nnt = wave < 3 ? 3 : 2;
        const bf16* wb = (const bf16*)(ws + WS_WCTX) + (size_t)(q * 304 + nt0 * 16 + fr) * 1024 + 8 * fq;
        f32x4 acc[3];
#pragma unroll
        for (int j = 0; j < 3; ++j) acc[j] = (f32x4){0.f, 0.f, 0.f, 0.f};
        bf16x8 bq[4][3], nb[4][3];
#pragma unroll
        for (int u = 0; u < 4; ++u)
#pragma unroll
            for (int j = 0; j < 3; ++j) bq[u][j] = (j < nnt) ? *(const bf16x8*)(wb + (size_t)j * 16 * 1024 + 32 * u) : bf16x8{};
#pragma unroll 1
        for (int k4 = 0; k4 < 8; ++k4) {
            if (k4 < 7) {
#pragma unroll
                for (int u = 0; u < 4; ++u)
#pragma unroll
                    for (int j = 0; j < 3; ++j) nb[u][j] = (j < nnt) ? *(const bf16x8*)(wb + (size_t)j * 16 * 1024 + 32 * (4 * (k4 + 1) + u)) : bf16x8{}; }
#pragma unroll
            for (int u = 0; u < 4; ++u) { const int ch = 4 * (4 * k4 + u) + fq;
                const bf16x8 a = *(const LAS bf16x8*)(At + fr * 2048 + ((ch ^ fr) << 4));
#pragma unroll
                for (int j = 0; j < 3; ++j) acc[j] = __builtin_amdgcn_mfma_f32_16x16x32_bf16(bq[u][j], a, acc[j], 0, 0, 0); }
#pragma unroll
            for (int u = 0; u < 4; ++u)
#pragma unroll
                for (int j = 0; j < 3; ++j) bq[u][j] = nb[u][j];
        }
        const int r = bc * NTOK + nc0 + fr; bf16* P1 = (bf16*)(ws + WS_P1); float ssq = 0.f;
#pragma unroll
        for (int j = 0; j < 3; ++j) if (j < nnt) { const int cp = q * 304 + (nt0 + j) * 16 + 4 * fq, dc = ctx_dstcol(cp);
            if (dc >= 0) { u32x2 w; w.x = cvt_pk_bf16(acc[j][0], acc[j][1]); w.y = cvt_pk_bf16(acc[j][2], acc[j][3]); *(u32x2*)(P1 + (size_t)r * NP1 + dc) = w; }
            if (cp < 128) ssq += (acc[j][0] * acc[j][0] + acc[j][1] * acc[j][1]) + (acc[j][2] * acc[j][2] + acc[j][3] * acc[j][3]); }
        if (q == 0 && wave < 4) { ssq += __shfl_xor(ssq, 16); ssq += __shfl_xor(ssq, 32);
            if (fq == 0) ((float*)(ws + WS_SSQ))[(size_t)r * 8 + 4 + wave] = ssq; }
    }
    __syncthreads();
}
__device__ __forceinline__ void ph6_h2(Frame& F) {
    const Ptrs& P = F.P; unsigned char* ws = P.ws;
    const int gw = F.vcu * NWAVES + F.wave, NGW = F.G * NWAVES;
    f32x4 v[4], nv[4];
    if (gw < MLAT) { const f32x4* xr = (const f32x4*)((const float*)(ws + WS_X1) + (size_t)gw * DM) + F.lane;
#pragma unroll
        for (int j = 0; j < 4; ++j) v[j] = xr[64 * j]; }
    for (int t = gw; t < MLAT; t += NGW) {
        const int b = t / SEQ; const float* md = (const float*)(ws + WS_MOD) + b * 6144;
        { const int tn = t + NGW < MLAT ? t + NGW : t; const f32x4* xr = (const f32x4*)((const float*)(ws + WS_X1) + (size_t)tn * DM) + F.lane;
#pragma unroll
          for (int j = 0; j < 4; ++j) nv[j] = xr[64 * j]; }
        float s = 0.f;
#pragma unroll
        for (int j = 0; j < 4; ++j) s += (v[j][0] * v[j][0] + v[j][1] * v[j][1]) + (v[j][2] * v[j][2] + v[j][3] * v[j][3]);
        const float rs = rsqrtf(wave_sum(s) * (1.f / DM) + EPS);
        u32x2* o8 = (u32x2*)((bf16*)(ws + WS_H2) + (size_t)t * DM) + F.lane;
#pragma unroll
        for (int j = 0; j < 4; ++j) { const int c = 4 * F.lane + 256 * j; const f32x4 g = *(const f32x4*)(P.in[7] + c);
            const f32x4 sh = *(const f32x4*)(md + 3072 + c), sc = *(const f32x4*)(md + 4096 + c);
            const f32x4 y = (v[j] * rs * g) * (sc + 1.f) + sh;
            u32x2 w; w.x = cvt_pk_bf16(y[0], y[1]); w.y = cvt_pk_bf16(y[2], y[3]); o8[64 * j] = w; }
#pragma unroll
        for (int j = 0; j < 4; ++j) v[j] = nv[j];
    }
}
__device__ __forceinline__ void ph7_route(Frame& F) {
    const Ptrs& P = F.P; unsigned char* ws = P.ws; const int lane = F.lane;
    const int gw = F.vcu * NWAVES + F.wave, NGW = F.G * NWAVES;
    const f32x4 bi = ((const f32x4*)P.in[20])[lane];
    for (int t = gw; t < MLAT; t += NGW) {
        f32x4 lg = ((const f32x4*)(ws + WS_LOGP))[(size_t)t * 64 + lane];
#pragma unroll
        for (int kp = 1; kp < 4; ++kp) lg += ((const f32x4*)(ws + WS_LOGP))[((size_t)kp * MLAT + t) * 64 + lane];
        float s[4], v[4];
#pragma unroll
        for (int i = 0; i < 4; ++i) { s[i] = 1.f / (1.f + __expf(-lg[i])); v[i] = s[i] + bi[i]; }
        float m1 = fmaxf(v[0], v[1]), m2 = fminf(v[0], v[1]);
#pragma unroll
        for (int i = 2; i < 4; ++i) { const float x = v[i]; m2 = fmaxf(m2, fminf(m1, x)); m1 = fmaxf(m1, x); }
#pragma unroll
        for (int o = 1; o < 8; o <<= 1) { const float b1 = __shfl_xor(m1, o), b2 = __shfl_xor(m2, o); const float n1 = fmaxf(m1, b1), n2 = fmaxf(fminf(m1, b1), fmaxf(m2, b2)); m1 = n1; m2 = n2; }
        const float gs = m1 + m2; const int g = lane >> 3; int rank = 0;
#pragma unroll
        for (int j = 0; j < 8; ++j) { const float o = __shfl(gs, j * 8); rank += (o > gs || (o == gs && j < g)) ? 1 : 0; }
        if (rank >= 4) { v[0] = v[1] = v[2] = v[3] = -INFINITY; }
        int my_e = 0; float my_s = 0.f, ssum = 0.f;
#pragma unroll
        for (int k = 0; k < 8; ++k) {
            float bv = v[0]; int bi_ = 0;
#pragma unroll
            for (int i = 1; i < 4; ++i) if (v[i] > bv) { bv = v[i]; bi_ = i; }
            int be = lane * 4 + bi_;
#pragma unroll
            for (int o = 1; o < 64; o <<= 1) { const float ov = __shfl_xor(bv, o); const int oe = __shfl_xor(be, o); if (ov > bv || (ov == bv && oe < be)) { bv = ov; be = oe; } }
            const int wl = be >> 2, wi = be & 3;
            float sv = wi == 0 ? s[0] : wi == 1 ? s[1] : wi == 2 ? s[2] : s[3];
            sv = __shfl(sv, wl);
            if (lane == wl) { if (wi == 0) v[0] = -INFINITY; else if (wi == 1) v[1] = -INFINITY; else if (wi == 2) v[2] = -INFINITY; else v[3] = -INFINITY; }
            ssum += sv; if (lane == k) { my_e = be; my_s = sv; }
        }
        if (lane < 8) {
            int* cnt = (int*)(ws + WS_CTL) + CW_COUNT;
            const int rk = atomicAdd(&cnt[my_e], 1);
            ((int*)(ws + WS_EIDX))[(size_t)t * 8 + lane] = my_e;
            ((float*)(ws + WS_EW))[(size_t)t * 8 + lane] = my_s / ssum * 2.5f;
            ((int*)(ws + WS_ERANK))[(size_t)t * 8 + lane] = rk;
        }
    }
}
__device__ __forceinline__ void ph_route3(Frame& F) {
    const Ptrs& P = F.P; unsigned char* ws = P.ws; const int lane = F.lane, wave = F.wave, fr = lane & 15, fq = lane >> 4;
    LAS unsigned char* At = F.lds;
    const bf16* Wr = (const bf16*)(ws + WS_WR);
    const f32x4 bi = ((const f32x4*)P.in[20])[lane];
    for (int grp = F.vcu; grp < MLAT / 64; grp += F.G) {
        const int t0 = grp * 64, b = t0 / SEQ; const float* md = (const float*)(ws + WS_MOD) + b * 6144;
        u32x4 v[2], nv[2];
        { const u32x4* xr = (const u32x4*)((const bf16*)(ws + WS_X1) + (size_t)(t0 + wave * 8) * DM) + lane; v[0] = xr[0]; v[1] = xr[64]; }
#pragma unroll 1
        for (int i = 0; i < 8; ++i) {
            const int r = wave * 8 + i, t = t0 + r;
            { const int rn = i < 7 ? t + 1 : t; const u32x4* xr = (const u32x4*)((const bf16*)(ws + WS_X1) + (size_t)rn * DM) + lane; nv[0] = xr[0]; nv[1] = xr[64]; }
            float xf[2][8]; float s = 0.f;
#pragma unroll
            for (int h = 0; h < 2; ++h)
#pragma unroll
                for (int d = 0; d < 4; ++d) { xf[h][2 * d] = bflo(v[h][d]); xf[h][2 * d + 1] = bfhi(v[h][d]); s += xf[h][2 * d] * xf[h][2 * d] + xf[h][2 * d + 1] * xf[h][2 * d + 1]; }
            const float rs = rsqrtf(wave_sum(s) * (1.f / DM) + EPS);
#pragma unroll
            for (int h = 0; h < 2; ++h) { const int c = 8 * lane + 512 * h; f32x4 y[2];
#pragma unroll
                for (int q = 0; q < 2; ++q) { const f32x4 g = *(const f32x4*)(P.in[7] + c + 4 * q), sh = *(const f32x4*)(md + 3072 + c + 4 * q), sc = *(const f32x4*)(md + 4096 + c + 4 * q);
                    const f32x4 xv = {xf[h][4 * q], xf[h][4 * q + 1], xf[h][4 * q + 2], xf[h][4 * q + 3]}; y[q] = (xv * rs * g) * (sc + 1.f) + sh; }
                const u32x4 w = pack8(y[0], y[1]);
                *(u32x4*)((bf16*)(ws + WS_H2) + (size_t)t * DM + c) = w;
                const int ch = lane + 64 * h;
                *(LAS u32x4*)(At + r * 2048 + ((ch ^ (r & 15)) << 4)) = w; }
            v[0] = nv[0]; v[1] = nv[1];
        }
        __syncthreads();
        f32x4 acc[4][2];
#pragma unroll
        for (int m = 0; m < 4; ++m) { acc[m][0] = (f32x4){0.f, 0.f, 0.f, 0.f}; acc[m][1] = (f32x4){0.f, 0.f, 0.f, 0.f}; }
        const bf16* wb = Wr + (size_t)(wave * 32 + fr) * 1024 + 8 * fq;
        bf16x8 bq[4][2], nb[4][2];
#pragma unroll
        for (int u = 0; u < 4; ++u) { bq[u][0] = *(const bf16x8*)(wb + 32 * u); bq[u][1] = *(const bf16x8*)(wb + 16 * 1024 + 32 * u); }
#pragma unroll 1
        for (int k4 = 0; k4 < 8; ++k4) {
            if (k4 < 7) {
#pragma unroll
                for (int u = 0; u < 4; ++u) { nb[u][0] = *(const bf16x8*)(wb + 32 * (4 * (k4 + 1) + u)); nb[u][1] = *(const bf16x8*)(wb + 16 * 1024 + 32 * (4 * (k4 + 1) + u)); } }
#pragma unroll
            for (int u = 0; u < 4; ++u) { const int ks = 4 * k4 + u, ch = 4 * ks + fq;
#pragma unroll
                for (int m = 0; m < 4; ++m) { const int r = 16 * m + fr;
                    const bf16x8 a = *(const LAS bf16x8*)(At + r * 2048 + ((ch ^ (r & 15)) << 4));
                    acc[m][0] = __builtin_amdgcn_mfma_f32_16x16x32_bf16(bq[u][0], a, acc[m][0], 0, 0, 0);
                    acc[m][1] = __builtin_amdgcn_mfma_f32_16x16x32_bf16(bq[u][1], a, acc[m][1], 0, 0, 0); } }
#pragma unroll
            for (int u = 0; u < 4; ++u) { bq[u][0] = nb[u][0]; bq[u][1] = nb[u][1]; }
        }
        __syncthreads();
        LAS float* Lg = (LAS float*)F.lds;
#pragma unroll
        for (int m = 0; m < 4; ++m)
#pragma unroll
            for (int n = 0; n < 2; ++n) *(LAS f32x4*)(Lg + (16 * m + fr) * 260 + wave * 32 + 16 * n + 4 * fq) = acc[m][n];
        __syncthreads();
#pragma unroll 1
        for (int i = 0; i < 8; ++i) {
            const int r = wave * 8 + i, t = t0 + r;
            const f32x4 lg = *(const LAS f32x4*)(Lg + r * 260 + 4 * lane);
            float s[4], vv[4];
#pragma unroll
            for (int q = 0; q < 4; ++q) { s[q] = 1.f / (1.f + __expf(-lg[q])); vv[q] = s[q] + bi[q]; }
            float m1 = fmaxf(vv[0], vv[1]), m2 = fminf(vv[0], vv[1]);
#pragma unroll
            for (int q = 2; q < 4; ++q) { const float x = vv[q]; m2 = fmaxf(m2, fminf(m1, x)); m1 = fmaxf(m1, x); }
#pragma unroll
            for (int o = 1; o < 8; o <<= 1) { const float b1 = __shfl_xor(m1, o), b2 = __shfl_xor(m2, o); const float n1 = fmaxf(m1, b1), n2 = fmaxf(fminf(m1, b1), fmaxf(m2, b2)); m1 = n1; m2 = n2; }
            const float gs = m1 + m2; const int g = lane >> 3; int rank = 0;
#pragma unroll
            for (int j = 0; j < 8; ++j) { const float o = __builtin_bit_cast(float, __builtin_amdgcn_readlane(__builtin_bit_cast(int, gs), j * 8)); rank += (o > gs || (o == gs && j < g)) ? 1 : 0; }
            unsigned key[4];
#pragma unroll
            for (int q = 0; q < 4; ++q) key[q] = rank >= 4 ? 0u : ((__builtin_bit_cast(unsigned, vv[q] + 1.f) & 0xFFFFFF00u) | (unsigned)(255 - (lane * 4 + q)));
            int my_e = 0; float my_s = 0.f, ssum = 0.f;
#pragma unroll
            for (int k = 0; k < 8; ++k) {
                unsigned kb = max(max(key[0], key[1]), max(key[2], key[3]));
                kb = max(kb, (unsigned)__builtin_amdgcn_update_dpp(0, (int)kb, 0x111, 0xf, 0xf, false));
                kb = max(kb, (unsigned)__builtin_amdgcn_update_dpp(0, (int)kb, 0x112, 0xf, 0xf, false));
                kb = max(kb, (unsigned)__builtin_amdgcn_update_dpp(0, (int)kb, 0x114, 0xf, 0xf, false));
                kb = max(kb, (unsigned)__builtin_amdgcn_update_dpp(0, (int)kb, 0x118, 0xf, 0xf, false));
                kb = max(kb, (unsigned)__builtin_amdgcn_update_dpp(0, (int)kb, 0x142, 0xa, 0xf, false));
                kb = max(kb, (unsigned)__builtin_amdgcn_update_dpp(0, (int)kb, 0x143, 0xc, 0xf, false));
                const unsigned kw = (unsigned)__builtin_amdgcn_readlane((int)kb, 63);
                const int be = 255 - (int)(kw & 255u), wl = be >> 2, wi = be & 3;
                const float ssel = wi == 0 ? s[0] : wi == 1 ? s[1] : wi == 2 ? s[2] : s[3];
                const float sv = __builtin_bit_cast(float, __builtin_amdgcn_readlane(__builtin_bit_cast(int, ssel), wl));
#pragma unroll
                for (int q = 0; q < 4; ++q) key[q] = key[q] == kw ? 0u : key[q];
                ssum += sv; if (lane == k) { my_e = be; my_s = sv; }
            }
            if (lane < 8) {
                int* cnt = (int*)(ws + WS_CTL) + CW_COUNT;
                const int rk = atomicAdd(&cnt[my_e], 1);
                ((int*)(ws + WS_EIDX))[(size_t)t * 8 + lane] = my_e;
                ((float*)(ws + WS_EW))[(size_t)t * 8 + lane] = my_s / ssum * 2.5f;
                ((int*)(ws + WS_ERANK))[(size_t)t * 8 + lane] = rk;
            }
        }
        __syncthreads();
    }
}
__device__ __forceinline__ void ph8_slots(Frame& F) {
    const Ptrs& P = F.P; unsigned char* ws = P.ws;
    LAS int* off = (LAS int*)F.lds;
    LAS int* cfs = off + 260;
    LAS int* chs = off + 520;
    unsigned* cnt = (unsigned*)(ws + WS_CTL) + CW_COUNT;
    if (F.wave == 0) { const int lane = F.lane; int n[4], cf[4], ch[4], sn = 0, sf = 0, sh = 0;
#pragma unroll
        for (int i = 0; i < 4; ++i) { n[i] = (int)cnt[4 * lane + i]; const int r = n[i] & 255; cf[i] = (n[i] >> 8) + (r > 128 ? 1 : 0); ch[i] = (r > 0 && r <= 128) ? 1 : 0; sn += n[i]; sf += cf[i]; sh += ch[i]; }
        int in = sn, jf = sf, jh = sh;
#pragma unroll
        for (int o = 1; o < 64; o <<= 1) { const int tn = __shfl_up(in, o), tf = __shfl_up(jf, o), th = __shfl_up(jh, o); if (lane >= o) { in += tn; jf += tf; jh += th; } }
        int an = in - sn, af = jf - sf, ah = jh - sh;
#pragma unroll
        for (int i = 0; i < 4; ++i) { off[4 * lane + i] = an; cfs[4 * lane + i] = af; chs[4 * lane + i] = ah; an += n[i]; af += cf[i]; ah += ch[i]; }
        if (lane == 63) { off[256] = an; cfs[256] = af; chs[256] = ah; off[257] = NSLOT; cfs[257] = af + MLAT / 256; chs[257] = ah; } }
    __syncthreads();
    for (int idx = F.vcu * 512 + F.tid; idx < MLAT * 8; idx += F.G * 512) {
        const int e = ((const int*)(ws + WS_EIDX))[idx], rk = ((const int*)(ws + WS_ERANK))[idx];
        const int slot = off[e] + rk;
        ((int*)(ws + WS_SLOTOF))[idx] = slot; ((int*)(ws + WS_SLOTTOK))[slot] = idx >> 3; ((float*)(ws + WS_SLOTW))[slot] = ((const float*)(ws + WS_EW))[idx];
        if (idx < MLAT) { ((int*)(ws + WS_SLOTTOK))[MLAT * 8 + idx] = idx; ((float*)(ws + WS_SLOTW))[MLAT * 8 + idx] = 1.f; }
    }
    if (F.vcu == 0) {
        int* go = (int*)(ws + WS_OFF); int* ut = (int*)(ws + WS_UT);
        const int nfull = cfs[257];
        for (int e = F.tid; e < 258; e += 512) go[e] = off[e];
        for (int e = F.tid; e < 257; e += 512) { const int n = off[e + 1] - off[e], nf = cfs[e + 1] - cfs[e], nh = chs[e + 1] - chs[e];
            for (int j = 0; j < nf; ++j) { int* u = ut + (cfs[e] + j) * 4; u[0] = e; u[1] = off[e] + j * 256; u[2] = min(256, n - j * 256); u[3] = 0; }
            if (nh) { int* u = ut + (nfull + chs[e]) * 4; u[0] = e; u[1] = off[e] + nf * 256; u[2] = n - nf * 256; u[3] = 0; } }
        if (F.tid == 0) { ((int*)(ws + WS_CTL))[CW_NUNIT] = nfull + chs[257]; ((int*)(ws + WS_CTL))[CW_NFULL] = nfull; }
    }
    __syncthreads();
}
__device__ __forceinline__ void ph11_combine(Frame& F) {
    const Ptrs& P = F.P; unsigned char* ws = P.ws; const int lane = F.lane;
    const int gw = F.vcu * NWAVES + F.wave, NGW = F.G * NWAVES;
    const unsigned char* Y = (const unsigned char*)(ws + WS_Y);
    const int cbase = 256 * (lane >> 4) + 32 * ((lane >> 2) & 3) + 8 * (lane & 3);
    u32x4 yw[9], nyw[9]; u32x4 xw[2], nxw[2]; int nsl[8];
    auto ldslots = [&](int t) {
#pragma unroll
        for (int k = 0; k < 8; ++k) nsl[k] = ((const int*)(ws + WS_SLOTOF))[(size_t)t * 8 + k]; };
    auto ldrows = [&](int t) {
#pragma unroll
        for (int k = 0; k < 9; ++k) { const int sl = k < 8 ? nsl[k] : MLAT * 8 + t; nyw[k] = *(const u32x4*)(Y + (size_t)sl * DM + lane * 16); }
        nxw[0] = *(const u32x4*)((const bf16*)(ws + WS_X1) + (size_t)t * DM + cbase); nxw[1] = *(const u32x4*)((const bf16*)(ws + WS_X1) + (size_t)t * DM + cbase + 128); };
    if (gw < MLAT) { ldslots(gw); ldrows(gw); if (gw + NGW < MLAT) ldslots(gw + NGW); }
    for (int t = gw; t < MLAT; t += NGW) {
        const int b = t / SEQ; const float* gt2 = (const float*)(ws + WS_MOD) + b * 6144 + 5120;
#pragma unroll
        for (int k = 0; k < 9; ++k) yw[k] = nyw[k];
        xw[0] = nxw[0]; xw[1] = nxw[1];
        if (t + NGW < MLAT) { ldrows(t + NGW); if (t + 2 * NGW < MLAT) ldslots(t + 2 * NGW); }
        float a[16];
#pragma unroll
        for (int i = 0; i < 16; ++i) a[i] = 0.f;
#pragma unroll
        for (int k = 0; k < 9; ++k)
#pragma unroll
            for (int d = 0; d < 4; ++d) { const int w = (int)yw[k][d];
                const f32x2 lo = __builtin_amdgcn_cvt_pk_f32_fp8(w, false), hi = __builtin_amdgcn_cvt_pk_f32_fp8(w, true);
                a[4 * d + 0] += lo[0]; a[4 * d + 1] += lo[1]; a[4 * d + 2] += hi[0]; a[4 * d + 3] += hi[1]; }
        float ss = 0.f;
#pragma unroll
        for (int q = 0; q < 4; ++q) { const int c = cbase + (q >> 1) * 128 + (q & 1) * 4; const u32x4 xb = xw[q >> 1]; const unsigned x01 = (q & 1) ? xb.z : xb.x, x23 = (q & 1) ? xb.w : xb.y;
            const f32x4 xv = {bflo(x01), bfhi(x01), bflo(x23), bfhi(x23)}, gv = *(const f32x4*)(gt2 + c);
#pragma unroll
            for (int e = 0; e < 4; ++e) { const float v = xv[e] + gv[e] * (a[q * 4 + e] * (1.f / YSCALE)); a[q * 4 + e] = v; ss += v * v; } }
        const float rs = rsqrtf(wave_sum(ss) * (1.f / DM) + EPS);
#pragma unroll
        for (int q = 0; q < 4; ++q) { const int c = cbase + (q >> 1) * 128 + (q & 1) * 4; const f32x4 gf = *(const f32x4*)(P.in[27] + c);
            f32x4 o;
#pragma unroll
            for (int e = 0; e < 4; ++e) o[e] = a[q * 4 + e] * rs * gf[e];
            *(f32x4*)(P.out + (size_t)t * DM + c) = o; }
    }
}
__device__ __forceinline__ void ph4b_diff_finish(Frame& F) {
    const Ptrs& P = F.P; unsigned char* ws = P.ws; const int lane = F.lane;
    const int gw = F.vcu * NWAVES + F.wave, NGW = F.G * NWAVES;
    float d1 = P.in[13][lane] * P.in[14][lane], d2 = P.in[15][lane] * P.in[16][lane];
    d1 = wave_sum(d1); d2 = wave_sum(d2);
    const float lam = __expf(d1) - __expf(d2) + LAM_INIT;
    const float g0 = P.in[17][lane], g1 = P.in[17][64 + lane];
    for (int t = gw; t < MLAT; t += NGW) {
        const float* os = (const float*)(ws + WS_OS) + (size_t)t * 8 * 128;
        float x[4][4];
#pragma unroll
        for (int h = 0; h < 4; ++h) { x[h][0] = os[(2 * h) * 128 + lane]; x[h][1] = os[(2 * h) * 128 + 64 + lane]; x[h][2] = os[(2 * h + 1) * 128 + lane]; x[h][3] = os[(2 * h + 1) * 128 + 64 + lane]; }
#pragma unroll
        for (int h = 0; h < 4; ++h) {
            const float v0 = x[h][0] - lam * x[h][2], v1 = x[h][1] - lam * x[h][3];
            const float rs = rsqrtf(wave_sum(v0 * v0 + v1 * v1) * (1.f / 128.f) + EPS) * (1.f - LAM_INIT);
            bf16* mo = (bf16*)(ws + WS_MIX) + (size_t)t * DM + 512 + h * 128;
            mo[lane] = (bf16)f2bf(v0 * rs * g0); mo[64 + lane] = (bf16)f2bf(v1 * rs * g1); }
    }
}

#ifdef PROBE_UNITS
struct ProbeOrder { int n, c; __device__ bool next(int i, Unit& u) const { if (i >= n) return false; u.pm = (c * n + i) % 60; u.pn = (c + i) % 8; u.r0 = u.pm * 256; u.nv = 256; u.k0 = 0; return true; }
    __device__ __forceinline__ int a_row(const Unit& u, int r) const { return u.pm * 256 + r; } };
struct EpiProbe { static constexpr bool PERM = true; bf16* O; int mode;
    __device__ __forceinline__ void operator()(const Acc& acc, const Unit& u, int wr, int wc, int fr, int fq) const {
        if (mode == 0) {
#pragma unroll
            for (int ai = 0; ai < 2; ++ai)
#pragma unroll
                for (int bj = 0; bj < 2; ++bj)
#pragma unroll
                    for (int m = 0; m < 4; ++m) { asm volatile("" :: "v"(acc[ai][bj][m][0]), "v"(acc[ai][bj][m][1])); }
        } else {
            const int row0 = u.pm * 256 + wr * 64 + fr, col0 = u.pn * 256 + (mode == 2 ? wc * 64 : wc * 32) + 8 * fq; const int bjo = mode == 2 ? 32 : 128;
#pragma unroll
            for (int ai = 0; ai < 2; ++ai)
#pragma unroll
                for (int m = 0; m < 4; ++m) { if (mode == 7 && (ai | m)) { asm volatile("" :: "v"(acc[ai][0][m][0]), "v"(acc[ai][0][m][1]), "v"(acc[ai][1][m][0]), "v"(acc[ai][1][m][1])); continue; } bf16* rowp = mode == 8 ? O + (size_t)u.pm * 256 * NP1 + (size_t)(((wr * 4 + wc) * 8 + ai * 4 + m) * 2) * 512 + (fq * 16 + fr) * 8 : mode == 4 ? O + (size_t)blockIdx.x * 65536 + (size_t)(wr * 64 + fr + ai * 128 + m * 16) * 256 + wc * 32 + 8 * fq : O + (size_t)(row0 + ai * 128 + m * 16) * (mode == 3 ? NP1 + 64 : NP1) + col0;
                    *(u32x4*)(rowp) = pack8(acc[ai][0][m][0], acc[ai][0][m][1]); *(u32x4*)(rowp + (mode == 8 ? 512 : mode == 4 ? 128 : bjo)) = pack8(acc[ai][1][m][0], acc[ai][1][m][1]); }
        }
    }
};
#endif

enum { P_PREP = 0, P_XN, P_INPROJ, P_UP, P_ATTN, P_DIFFFIN, P_OUT, P_H2, P_ROUTER, P_ROUTE, P_SLOTS, P_EXP1, P_EXP2, P_COMB, P_PROBE, P_END };
struct Args { Ptrs P; int ph_lo, ph_hi, li, pad; };
__global__ void __launch_bounds__(NWAVES * 64, 2) mk_fwd(Args args) {
    extern __shared__ __attribute__((aligned(16))) unsigned char lds[];
    Frame F;
    F.lds = (LAS unsigned char*)lds; F.MISC = (volatile LAS unsigned*)(F.lds + MISC_OFF);
    F.tid = threadIdx.x; F.lane = F.tid & 63; F.wave = __builtin_amdgcn_readfirstlane(F.tid >> 6);
    F.G = gridDim.x; { const int bx = blockIdx.x; F.vcu = (F.G % 8 == 0) ? (bx % 8) * (F.G / 8) + bx / 8 : bx; }
    F.P = args.P; unsigned char* ws = args.P.ws; F.ctl = (unsigned*)(ws + WS_CTL);
    for (int u = F.tid; u < (LDS_BYTES - LDSCTL_OFF) / 4; u += NWAVES * 64) ((LAS unsigned*)(F.lds + LDSCTL_OFF))[u] = 0u;
    __syncthreads();
    XcdBarrier bar = xcd_barrier_post(F.ctl + CW_BAR + args.li * XCD_BAR_WORDS, F.MISC + 8);
    const int lo = args.ph_lo, hi = args.ph_hi;
#ifndef PHMASK
#define PHMASK 0xFFFF
#endif
#define IN(k) ((((PHMASK) >> (k)) & 1) && lo <= (k) && (k) < hi)
#define SKEW(ticks) do { const unsigned long long t0_ = __builtin_amdgcn_s_memrealtime(); const unsigned long long w_ = (unsigned long long)((F.vcu & 3) * (ticks)); while (__builtin_amdgcn_s_memrealtime() - t0_ < w_) __builtin_amdgcn_s_sleep(8); } while (0)
#define SEAM(k) do { if (IN(k) && IN((k) + 1)) xcd_barrier(bar); } while (0)
#define SEAM_SKIP1(k) do { if (IN(k) && IN((k) + 2)) xcd_barrier(bar); } while (0)
#define SEAM_SKIP2(k) do { if (IN(k) && IN((k) + 3)) xcd_barrier(bar); } while (0)
    if (IN(P_PREP)) { ph0_prep(F); } SEAM(P_PREP);
    if (IN(P_XN)) { ph1_xn(F); } SEAM(P_XN);
    if (IN(P_INPROJ)) {
        pg8::Gemm g{(const bf16*)(ws + WS_XN), (const bf16*)(ws + WS_WIN), 1024, 1024, 1024}; LatOrder S; S.init(MLAT, NP1, F.G, (int)blockIdx.x);
        EpiInProj E{(bf16*)(ws + WS_P1), (float*)(ws + WS_SSQ), (const float2*)(ws + WS_TAB), (const float2*)(ws + WS_TAB) + 1024};
#ifdef SKEW_INPROJ
        SKEW(SKEW_INPROJ);
#endif
        pg8::gemm_phase(F.lds, g, S, E);
        if (CV_EARLY > 0 && (int)blockIdx.x >= (MALL / 256) * (NP1 / 256) - 2 * F.G) ph0_experts(F, 0, CV_EARLY);
    } SEAM(P_INPROJ);
    if (IN(P_UP)) {
        pg8::Gemm g{(const bf16*)(ws + WS_P1), (const bf16*)(ws + WS_WUP), 2048, 384, 256}; UpOrder S{F.G, F.vcu};
        EpiUp E{(bf16*)(ws + WS_QM), (bf16*)(ws + WS_KVM), (const float*)(ws + WS_SSQ), (const float2*)(ws + WS_TAB) + 1024};
        pg8::gemm_phase(F.lds, g, S, E);
    } SEAM(P_UP);
    if (IN(P_ATTN)) {
        const bf16* P1 = (const bf16*)(ws + WS_P1); const bf16* QM = (const bf16*)(ws + WS_QM); const bf16* KVM = (const bf16*)(ws + WS_KVM);
        const int cslot = F.vcu % 5; int ui = 0;
        bool conv_done = false; int U = F.vcu;
        const int conv_from = ((int)blockIdx.x >= (MALL / 256) * (NP1 / 256) - 2 * F.G) ? CV_EARLY : 0;
        for (; U < 512; U += F.G, ++ui) {
            if (ui == cslot) { ph0_experts(F, conv_from, 1 << 30); conv_done = true; }
            const int bh = U >> 4, qb = U & 15, b = bh >> 3, hh = bh & 7;
            const bf16* K0 = KVM + (size_t)b * NTOK * 1024 + hh * 128;
            attn::unit<0, 0>(QM + (size_t)(b * NTOK + NCTX + qb * 256) * 768 + hh * 96, K0, P1 + (size_t)b * NTOK * NP1 + 384, K0 + 64,
                             (bf16*)(ws + WS_MIX) + (size_t)(b * SEQ + qb * 256) * DM + hh * 64, DM, F.lds_c(), nullptr, 0.f, nullptr);
        }
        char* stash = (char*)(ws + WS_OS) + (size_t)F.vcu * 65536;
        const int Ud0 = U;
        for (; U < 768; U += 1024, ++ui) {
            if (ui == cslot) { ph0_experts(F, conv_from, 1 << 30); conv_done = true; }
            const int Up = U - 512, bh = Up >> 4, qb = Up & 15, b = bh >> 2, h = bh & 3;
            const bf16* Pb = P1 + (size_t)b * NTOK * NP1;
            attn::unit<1, 1>(P1 + (size_t)(b * NTOK + NCTX + qb * 256) * NP1 + 512 + (2 * h) * 64, Pb + 1024 + (2 * h) * 64, nullptr, Pb + 1536 + h * 128, nullptr, 0, F.lds_c(),
                             stash, 0.f, nullptr);
        }
        for (U = Ud0; U < 768; U += 1024, ++ui) {
            if (ui == cslot) { ph0_experts(F, conv_from, 1 << 30); conv_done = true; }
            const int Up = U - 512, bh = Up >> 4, qb = Up & 15, b = bh >> 2, h = bh & 3;
            const bf16* Pb = P1 + (size_t)b * NTOK * NP1;
            float lam; { float d1 = F.P.in[13][F.lane] * F.P.in[14][F.lane], d2 = F.P.in[15][F.lane] * F.P.in[16][F.lane]; d1 = wave_sum(d1); d2 = wave_sum(d2); lam = __expf(d1) - __expf(d2) + LAM_INIT; }
            attn::unit<1, 2>(P1 + (size_t)(b * NTOK + NCTX + qb * 256) * NP1 + 512 + (2 * h + 1) * 64, Pb + 1024 + (2 * h + 1) * 64, nullptr, Pb + 1536 + h * 128,
                             (bf16*)(ws + WS_MIX) + (size_t)(b * SEQ + qb * 256) * DM + 512 + h * 128, DM, F.lds_c(), stash, lam, F.P.in[17]);
        }
        if (!conv_done) ph0_experts(F, conv_from, 1 << 30);
#ifdef CONV_PROBE
        if (F.vcu % 5 == 0) ph0_experts(F, 0, 1 << 30, true);
#endif

    } SEAM_SKIP1(P_ATTN);
#ifdef ATTN_PROBE
    if (IN(P_DIFFFIN)) { const bf16* P1 = (const bf16*)(ws + WS_P1); const bf16* QM = (const bf16*)(ws + WS_QM); const bf16* KVM = (const bf16*)(ws + WS_KVM);
        { const int Upr = F.vcu, bh = Upr >> 4, qb = Upr & 15, b = bh >> 3, hh = bh & 7;
          const bf16* K0 = KVM + (size_t)b * NTOK * 1024 + hh * 128;
          attn::unit<ATTN_PROBE_MODE, 0, ATTN_PROBE>(ATTN_PROBE_MODE == 0 ? QM + (size_t)(b * NTOK + NCTX + qb * 256) * 768 + hh * 96 : P1 + (size_t)(b * NTOK + NCTX + qb * 256) * NP1 + 512 + hh * 64,
                             ATTN_PROBE_MODE == 0 ? K0 : P1 + (size_t)b * NTOK * NP1 + 1024 + hh * 64, P1 + (size_t)b * NTOK * NP1 + 384, ATTN_PROBE_MODE == 0 ? K0 + 64 : P1 + (size_t)b * NTOK * NP1 + 1536 + (hh >> 1) * 128,
                             (bf16*)(ws + WS_TMP) + (size_t)Upr * 256 * DM, DM, F.lds_c(), nullptr, 0.f, nullptr); } }
#endif
    if (IN(P_OUT)) {
        pg8::Gemm g{(const bf16*)(ws + WS_MIX), (const bf16*)(ws + WS_WOUT), 1024, 1024, 1024}; pg8::StaticOrder S; S.init(MLAT, DM, F.G, (int)blockIdx.x);
        EpiOut E{F.P.in[0], (const float*)(ws + WS_MOD), (bf16*)(ws + WS_X1)};
        pg8::gemm_phase(F.lds, g, S, E);
    } SEAM(P_OUT);
    if (IN(P_H2)) { ph_route3(F); } SEAM_SKIP2(P_H2);
    if (IN(P_SLOTS)) { ph8_slots(F); } SEAM(P_SLOTS);
    if (IN(P_EXP1)) {
        const int nu = (int)xb_ld(F.ctl + CW_NUNIT), nfu = (int)xb_ld(F.ctl + CW_NFULL); LAS int* uc = (LAS int*)(F.lds + UCACHE_OFF);
        const int nmine = exp_units_to_lds<2>(uc, (const int*)(ws + WS_UT), nu, nfu, F.G, F.vcu);
        pg8::Gemm g{(const bf16*)(ws + WS_H2), (const bf16*)(ws + WS_W13), 1024, 1024, 1024};
        ExpSched<2, true> S{uc, nmine, (const int*)(ws + WS_SLOTTOK)};
        EpiAct E{(bf16*)(ws + WS_ACT), (const float*)(ws + WS_SLOTW)};
#ifdef SKEW_EXP1
        SKEW(SKEW_EXP1);
#endif
        pg8::gemm_phase(F.lds, g, S, E);
    } SEAM(P_EXP1);
    if (IN(P_EXP2)) {
        const int nu = (int)xb_ld(F.ctl + CW_NUNIT), nfu = (int)xb_ld(F.ctl + CW_NFULL); LAS int* uc = (LAS int*)(F.lds + UCACHE_OFF);
        const int nmine = exp_units_to_lds<4>(uc, (const int*)(ws + WS_UT), nu, nfu, F.G, F.vcu);
        pg8::Gemm g{(const bf16*)(ws + WS_ACT), (const bf16*)(ws + WS_W2), 256, 256, 256};
        ExpSched<4, false> S{uc, nmine, nullptr};
        EpiY E{(unsigned char*)(ws + WS_Y)};
#ifdef SKEW_EXP2
        SKEW(SKEW_EXP2);
#endif
        pg8::gemm_phase(F.lds, g, S, E);
    } SEAM(P_EXP2);
    if (IN(P_COMB)) { ph11_combine(F); } SEAM(P_COMB);
#ifdef PROBE_UNITS
    if (IN(P_PROBE)) {
        pg8::Gemm g{(const bf16*)(ws + WS_P1), (const bf16*)(ws + WS_WIN), 2048, 1024, PROBE_K}; ProbeOrder S{PROBE_UNITS, F.vcu};
        EpiProbe E{(bf16*)(ws + WS_TMP), PROBE_EPI};
        pg8::gemm_phase(F.lds, g, S, E);
    }
#endif
#undef IN
#undef SEAM
}

static int g_grid = 0;
static int mk_setup() {
    if (g_grid) return g_grid;
    int dev = 0, cus = 0;
    if (hipGetDevice(&dev) != hipSuccess || hipDeviceGetAttribute(&cus, hipDeviceAttributeMultiprocessorCount, dev) != hipSuccess) { fprintf(stderr, "kernel_launch: device query failed\n"); g_grid = -1; return -1; }
    if (hipFuncSetAttribute((const void*)mk_fwd, hipFuncAttributeMaxDynamicSharedMemorySize, LDS_BYTES) != hipSuccess) { fprintf(stderr, "kernel_launch: hipFuncSetAttribute failed\n"); g_grid = -1; return -1; }
    int per_cu = 0;
    if (hipOccupancyMaxActiveBlocksPerMultiprocessor(&per_cu, (const void*)mk_fwd, NWAVES * 64, LDS_BYTES) != hipSuccess || per_cu < 1) { fprintf(stderr, "kernel_launch: occupancy query says %d blocks/CU\n", per_cu); }
    (void)hipGetLastError();
    if (cus != 256) { fprintf(stderr, "kernel_launch: this build's work split assumes a 256-CU device (found %d CUs); nothing launched\n", cus); g_grid = -1; return -1; }
    g_grid = cus;
    return g_grid;
}
static void mk_run(const Ptrs& P, int lo, int hi, int li, hipStream_t stream) {
    Args a{}; a.P = P; a.ph_lo = lo; a.ph_hi = hi; a.li = li; a.pad = 0;
    hipLaunchKernelGGL(mk_fwd, dim3(g_grid), dim3(NWAVES * 64), LDS_BYTES, stream, a);
}
extern "C" void kernel_launch(void* const* d_in, const int* in_sizes, int n_in, void* d_out, int out_size, void* d_ws, size_t ws_size, hipStream_t stream) {
    if (n_in != 28 || out_size != MLAT * DM || ws_size < WS_END) { fprintf(stderr, "kernel_launch: unexpected shapes n_in %d out %d ws %zu\n", n_in, out_size, ws_size); return; }
    if (mk_setup() <= 0) return;
    Ptrs P{}; for (int i = 0; i < 28; ++i) P.in[i] = (const float*)d_in[i]; P.out = (float*)d_out; P.ws = (unsigned char*)d_ws;
    (void)hipMemsetAsync((char*)d_ws + WS_CTL, 0, 1 * MiB, stream);
    int li = 0;
#define FAST(lo, hi) mk_run(P, lo, hi, li++, stream)
    FAST(P_PREP, (defs_probe ? P_PROBE : P_COMB) + 1);
#undef FAST
}
```

```cpp
constexpr bool defs_probe = false;
#include <hip/hip_runtime.h>
#include <cstdio>
#include <cstdint>

constexpr int NB = 4, SEQ = 4096, NCTX = 256, NTOK = SEQ + NCTX, DM = 1024;
constexpr int MALL = NB * NTOK;
constexpr int MLAT = NB * SEQ;
constexpr int IN_COLS = 1952, NP1 = 2048;
constexpr int NEXP = 256, TOPK = 8, EFF = 256;
constexpr int NSLOT = MLAT * TOPK + MLAT;
constexpr float EPS = 1e-6f;
constexpr float LAM_INIT = 0.2f;

typedef unsigned short bf16;
__device__ __forceinline__ unsigned f2bf(float f) { unsigned u = __builtin_bit_cast(unsigned, f); return (u + 0x7fffu + ((u >> 16) & 1u)) >> 16; }
__device__ __forceinline__ float bf2f(bf16 h) { return __builtin_bit_cast(float, (unsigned)h << 16); }

constexpr size_t MiB = 1u << 20;
constexpr size_t WS_CTL = 0;
constexpr size_t WS_MOD = 3 * MiB;
constexpr size_t WS_TAB = 3 * MiB + 512 * 1024;
constexpr size_t WS_X1 = 402 * MiB;
constexpr size_t WS_SSQ = 466 * MiB;
constexpr size_t WS_EIDX = 467 * MiB;
constexpr size_t WS_EW = WS_EIDX + 512 * 1024;
constexpr size_t WS_ERANK = 468 * MiB;
constexpr size_t WS_SLOTOF = WS_ERANK + 512 * 1024;
constexpr size_t WS_SLOTTOK = 469 * MiB;
constexpr size_t WS_SLOTW = 470 * MiB;
constexpr size_t WS_OFF = 471 * MiB;
constexpr size_t WS_XN = 472 * MiB;
constexpr size_t WS_P1 = 506 * MiB;
constexpr size_t WS_QM = 574 * MiB;
constexpr size_t WS_KVM = 600 * MiB;
constexpr size_t WS_MIX = 634 * MiB;
constexpr size_t WS_OS = 666 * MiB;
constexpr size_t WS_TMP = 730 * MiB;
constexpr size_t WS_H2 = 472 * MiB;
constexpr size_t WS_H2F = 504 * MiB;
constexpr size_t WS_LOG = 568 * MiB;
constexpr size_t WS_ACT = 584 * MiB;
constexpr size_t WS_Y = 656 * MiB;
constexpr size_t WS_END = 944 * MiB;
constexpr int CW_COUNT = 1024;

__host__ __device__ __forceinline__ int perm32_log(int p) { return 16 * ((p >> 2) & 1) + 4 * (p >> 3) + (p & 3); }
__host__ __device__ __forceinline__ int perm64_log(int p) { return 32 * ((p >> 2) & 1) + 16 * (p >> 5) + 4 * ((p >> 3) & 3) + (p & 3); }
__host__ __device__ __forceinline__ int p1_logical(int p) {
    if (p < 384) return p;
    if (p < 416) return 384 + perm32_log(p - 384);
    if (p < 512) return -1;
    if (p < 1024) { int q = p - 512; return 416 + (q & ~63) + perm64_log(q & 63); }
    if (p < 1536) { int q = p - 1024; return 928 + (q & ~63) + perm64_log(q & 63); }
    return 1440 + (p - 1536);
}
__host__ __device__ __forceinline__ int qm_logical(int p) { int h = p / 96, r = p % 96; return h * 96 + (r < 64 ? r : 64 + perm32_log(r - 64)); }

struct Ptrs {
    const float* in[28]; float* out; unsigned char* ws;
};


#define GAS __attribute__((address_space(1)))
#define LAS __attribute__((address_space(3)))
typedef short bf16x8 __attribute__((ext_vector_type(8)));
typedef short s16x4 __attribute__((ext_vector_type(4)));
typedef float f32x4 __attribute__((ext_vector_type(4)));
typedef float f32x2 __attribute__((ext_vector_type(2)));
typedef float f32x16 __attribute__((ext_vector_type(16)));
typedef float f32x8 __attribute__((ext_vector_type(8)));
typedef unsigned u32x4 __attribute__((ext_vector_type(4)));
typedef unsigned u32x2 __attribute__((ext_vector_type(2)));
#define RLX_AGENT __ATOMIC_RELAXED, __HIP_MEMORY_SCOPE_AGENT
#define LDS_WAIT() asm volatile("s_waitcnt lgkmcnt(0)" ::: "memory")
#define VM_WAIT() asm volatile("s_waitcnt vmcnt(0)" ::: "memory")

constexpr size_t WS_MODP = 1 * MiB;
constexpr size_t WS_WIN = 4 * MiB;
constexpr size_t WS_WUP = 8 * MiB;
constexpr size_t WS_WOUT = 10 * MiB;
constexpr size_t WS_WR = 12 * MiB;
constexpr size_t WS_WCTX = 13 * MiB;
constexpr size_t WS_W13 = 16 * MiB;
constexpr size_t WS_W2 = 273 * MiB;
constexpr size_t WS_UT = WS_OFF + 4096;
static_assert(WS_W2 + (size_t)257 * 1024 * 256 * 2 <= WS_X1, "ws map");
constexpr size_t WS_LOGP = WS_Y;
constexpr int CW_NUNIT = 2048;
constexpr int CW_NFULL = 2049;
constexpr int CW_BAR = 4096;

typedef __bf16 bf16x2n_t __attribute__((ext_vector_type(2)));
typedef float f32x2n_t __attribute__((ext_vector_type(2)));
__device__ __forceinline__ unsigned cvt_pk_bf16(float lo, float hi) { const f32x2n_t v = {lo, hi}; return __builtin_bit_cast(unsigned, __builtin_convertvector(v, bf16x2n_t)); }
__device__ __forceinline__ unsigned pk2(float lo, float hi) { return f2bf(lo) | (f2bf(hi) << 16); }
__device__ __forceinline__ u32x4 pack8(f32x4 a, f32x4 b) { u32x4 w; w.x = cvt_pk_bf16(a[0], a[1]); w.y = cvt_pk_bf16(a[2], a[3]); w.z = cvt_pk_bf16(b[0], b[1]); w.w = cvt_pk_bf16(b[2], b[3]); return w; }
__device__ __forceinline__ float bflo(unsigned w) { return __builtin_bit_cast(float, w << 16); }
__device__ __forceinline__ float bfhi(unsigned w) { return __builtin_bit_cast(float, w & 0xffff0000u); }
__device__ __forceinline__ float wave_sum(float v) {
#pragma unroll
    for (int o = 1; o < 64; o <<= 1) v += __shfl_xor(v, o);
    return v;
}

namespace pg8 {
constexpr int BM = 256, BK = 64, HALF = 128, HTB = HALF * BK * 2, STAGE_BYTES = 8 * HTB;
__host__ __device__ __forceinline__ int lds_byte(int r, int c) { const int st = (r >> 4) * 2 + (c >> 5), rr = r & 15, cc = c & 31, ob = rr * 64 + cc * 2; return st * 1024 + (ob ^ (((ob >> 9) & 1) << 5)); }
__host__ __device__ __forceinline__ void stage_rc(int b, int& R, int& C) { const int st = b / 1024, sb = b % 1024, swz = sb ^ (((sb >> 9) & 1) << 5); R = (st >> 1) * 16 + swz / 64; C = (st & 1) * 32 + (swz % 64) / 2; }
__host__ __device__ __forceinline__ int perm32(int rho) { const int n = rho >> 4, i = rho & 15; return 8 * (i >> 2) + 4 * n + (i & 3); }

struct Unit { int pm, pn, r0, nv, k0; };
struct Gemm { const bf16* A; const bf16* Bt; int lda, ldb, K; };

struct StaticOrder {
    int nM, nN, nwg, G, c;
    __device__ void init(int M, int N, int G_, int c_) { nM = M / BM; nN = N / BM; nwg = nM * nN; G = G_; c = c_; }
    __device__ bool next(int i, Unit& u) const {
        const long L = (long)i * G + c; if (L >= nwg) return false;
        int wgid = (int)L; { const int q = nwg / 8, r = nwg % 8, xcd = wgid % 8, off = wgid / 8; wgid = (xcd < r ? xcd * (q + 1) : r * (q + 1) + (xcd - r) * q) + off; }
        const int nig = 8 * nN, gid = wgid / nig, fm = gid * 8, gsz = (nM - fm) < 8 ? (nM - fm) : 8;
        u.pm = fm + ((wgid % nig) % gsz); u.pn = (wgid % nig) / gsz; u.r0 = u.pm * BM; u.nv = BM; u.k0 = 0; return true;
    }
    __device__ __forceinline__ int a_row(const Unit& u, int r) const { return u.pm * BM + r; }
};

template <class Epi, class Sched>
__device__ __forceinline__ void gemm_phase(LAS unsigned char* lds, const Gemm g, const Sched& S, const Epi& E) {
    const int tid = threadIdx.x, wid = __builtin_amdgcn_readfirstlane(tid >> 6), lane = tid & 63, wr = wid >> 2, wc = wid & 3, fr = lane & 15, fq = lane >> 4;
    int K = g.K; asm volatile("" : "+s"(K));
    const int nt = K / BK;
    int RA[2], CA[2]; unsigned voffB[2];
#pragma unroll
    for (int i = 0; i < 2; ++i) { int R, C; stage_rc(tid * 16 + i * 8192, R, C); RA[i] = R; CA[i] = C; const int Rb = Epi::PERM ? ((R & ~31) + perm32(R & 31)) : R; voffB[i] = (unsigned)(Rb * g.ldb + C) * 2u; }
    const size_t kstep = (size_t)(BK * 2);
    const size_t hstepB = (size_t)HALF * g.ldb * 2, tstepB = 2 * hstepB;
    const unsigned ldsw = (unsigned)wid * 1024u;
    const int aoff = lds_byte(wr * 64 + fr, fq * 8), boff = lds_byte(wc * 32 + fr, fq * 8);
#define PG8_SA(b, h) (((b) * 2 + (h)) * HTB)
#define PG8_SB(b, h) ((4 + (b) * 2 + (h)) * HTB)
#define PG8_STAGE(bufoff, gbase, voff) do { _Pragma("unroll") for (int _i = 0; _i < 2; ++_i) \
        __builtin_amdgcn_global_load_lds((const unsigned*)((const char*)(gbase) + (voff)[_i]), (LAS unsigned*)(lds + (bufoff) + ldsw + _i * 8192), 16, 0, 0); } while (0)
#define PG8_LDA(dst, b, h) do { _Pragma("unroll") for (int m = 0; m < 4; ++m) _Pragma("unroll") for (int k = 0; k < 2; ++k) dst[m][k] = *(const LAS bf16x8*)(lds + PG8_SA(b, h) + aoff + m * 2048 + k * 1024); } while (0)
#define PG8_LDB(dst, b, h) do { _Pragma("unroll") for (int n = 0; n < 2; ++n) _Pragma("unroll") for (int k = 0; k < 2; ++k) dst[n][k] = *(const LAS bf16x8*)(lds + PG8_SB(b, h) + boff + n * 2048 + k * 1024); } while (0)
#define PG8_MMA(ai, bj, At, Bt) do { __builtin_amdgcn_s_setprio(1); _Pragma("unroll") for (int m = 0; m < 4; ++m) _Pragma("unroll") for (int n = 0; n < 2; ++n) _Pragma("unroll") for (int k = 0; k < 2; ++k) \
        acc[ai][bj][m][n] = __builtin_amdgcn_mfma_f32_16x16x32_bf16(Bt[n][k], At[m][k], acc[ai][bj][m][n], 0, 0, 0); __builtin_amdgcn_s_setprio(0); } while (0)
#define PG8_WAIT_V(n) asm volatile("s_waitcnt vmcnt(" #n ")" ::: "memory")
#define PG8_WAIT_L(n) asm volatile("s_waitcnt lgkmcnt(" #n ")" ::: "memory")
#define PG8_BAR __builtin_amdgcn_s_barrier()
#define PG8_SCHED __builtin_amdgcn_sched_barrier(0)
#define PG8_AOFFS(dst, u) do { _Pragma("unroll") for (int _h = 0; _h < 2; ++_h) _Pragma("unroll") for (int _i = 0; _i < 2; ++_i) \
        dst[_h][_i] = (unsigned)(((size_t)S.a_row(u, _h * HALF + RA[_i]) * (size_t)g.lda + (size_t)(CA[_i] + (u).k0)) * 2u); } while (0)
    Unit cur, nxt; int ui = 0;
    if (!S.next(0, cur)) return;
    f32x4 acc[2][2][4][2];
#pragma unroll
    for (int a = 0; a < 2; ++a)
#pragma unroll
        for (int b = 0; b < 2; ++b)
#pragma unroll
            for (int m = 0; m < 4; ++m)
#pragma unroll
                for (int n = 0; n < 2; ++n) acc[a][b][m][n] = (f32x4){0.f, 0.f, 0.f, 0.f};
    bf16x8 At[4][2], B0[2][2], B1[2][2];
    unsigned vA[2][2], vN[2][2];
    PG8_AOFFS(vA, cur);
    const char* Ab = (const char*)g.A; const char* cB = (const char*)g.Bt + (size_t)cur.pn * tstepB + (size_t)cur.k0 * 2;
    PG8_STAGE(PG8_SB(0, 0), cB, voffB); PG8_STAGE(PG8_SB(0, 1), cB + hstepB, voffB); PG8_STAGE(PG8_SA(0, 0), Ab, vA[0]); PG8_STAGE(PG8_SA(0, 1), Ab, vA[1]);
    if (wr == 1) PG8_BAR;
    PG8_WAIT_V(2); PG8_BAR;
    PG8_STAGE(PG8_SB(1, 0), cB + kstep, voffB); PG8_STAGE(PG8_SA(1, 0), Ab + kstep, vA[0]); PG8_STAGE(PG8_SB(1, 1), cB + hstepB + kstep, voffB);
    PG8_WAIT_V(6); PG8_BAR;
    for (;;) {
        const bool has_next = S.next(ui + 1, nxt);
        const char* nB = has_next ? (const char*)g.Bt + (size_t)nxt.pn * tstepB + (size_t)nxt.k0 * 2 : cB;
        if (has_next) { PG8_AOFFS(vN, nxt); } else { vN[0][0] = vA[0][0]; vN[0][1] = vA[0][1]; vN[1][0] = vA[1][0]; vN[1][1] = vA[1][1]; }
        for (int t = 0; t < nt; t += 2) {
            const bool last = (t == nt - 2); const bool full = cur.nv > HALF;
            const char* a1 = Ab + (size_t)(t + 1) * kstep;
            const char* a2 = Ab + (last ? (size_t)0 : (size_t)(t + 2) * kstep); const char* b2 = last ? nB : cB + (size_t)(t + 2) * kstep;
            const char* a3 = a2 + kstep; const char* b3 = b2 + kstep;
            unsigned w0[2], w1[2];
            w0[0] = last ? vN[0][0] : vA[0][0]; w0[1] = last ? vN[0][1] : vA[0][1]; w1[0] = last ? vN[1][0] : vA[1][0]; w1[1] = last ? vN[1][1] : vA[1][1];
            PG8_LDB(B0, 0, 0); PG8_LDB(B1, 0, 1); PG8_SCHED; PG8_LDA(At, 0, 0); PG8_STAGE(PG8_SA(1, 1), a1, vA[1]);
            PG8_WAIT_V(8); PG8_WAIT_L(0); PG8_BAR; PG8_MMA(0, 0, At, B0); PG8_MMA(0, 1, At, B1); PG8_BAR; PG8_SCHED;
            PG8_LDA(At, 0, 1); PG8_STAGE(PG8_SB(0, 0), b2, voffB); PG8_STAGE(PG8_SB(0, 1), b2 + hstepB, voffB); PG8_STAGE(PG8_SA(0, 0), a2, w0);
            PG8_WAIT_V(8); PG8_WAIT_L(0); PG8_BAR; if (full) { PG8_MMA(1, 0, At, B0); PG8_MMA(1, 1, At, B1); } PG8_BAR; PG8_SCHED;
            PG8_LDB(B0, 1, 0); PG8_LDB(B1, 1, 1); PG8_SCHED; PG8_LDA(At, 1, 0); PG8_STAGE(PG8_SA(0, 1), a2, w1);
            PG8_WAIT_V(8); PG8_WAIT_L(0); PG8_BAR; PG8_MMA(0, 0, At, B0); PG8_MMA(0, 1, At, B1); PG8_BAR; PG8_SCHED;
            PG8_LDA(At, 1, 1); PG8_STAGE(PG8_SB(1, 0), b3, voffB); PG8_STAGE(PG8_SB(1, 1), b3 + hstepB, voffB); PG8_STAGE(PG8_SA(1, 0), a3, w0);
            PG8_WAIT_V(8); PG8_WAIT_L(0); PG8_BAR; if (full) { PG8_MMA(1, 0, At, B0); PG8_MMA(1, 1, At, B1); } PG8_BAR; PG8_SCHED;
        }
        if (wr == 0) PG8_BAR;
        E(acc, cur, wr, wc, fr, fq);
        if (!has_next) break;
#pragma unroll
        for (int a = 0; a < 2; ++a)
#pragma unroll
            for (int b = 0; b < 2; ++b)
#pragma unroll
                for (int m = 0; m < 4; ++m)
#pragma unroll
                    for (int n = 0; n < 2; ++n) acc[a][b][m][n] = (f32x4){0.f, 0.f, 0.f, 0.f};
        cur = nxt; cB = nB; ++ui;
        vA[0][0] = vN[0][0]; vA[0][1] = vN[0][1]; vA[1][0] = vN[1][0]; vA[1][1] = vN[1][1];
        if (wr == 1) PG8_BAR;
    }
    PG8_WAIT_V(0);
    PG8_BAR;
#undef PG8_SA
#undef PG8_SB
#undef PG8_STAGE
#undef PG8_LDA
#undef PG8_LDB
#undef PG8_MMA
#undef PG8_WAIT_V
#undef PG8_WAIT_L
#undef PG8_BAR
#undef PG8_SCHED
#undef PG8_AOFFS
}
}

using pg8::Unit;
typedef f32x4 Acc[2][2][4][2];

struct EpiInProj {
    static constexpr bool PERM = true;
    bf16* P1; float* SSQ; const float2* TD; const float2* TM;
    __device__ __forceinline__ void operator()(const Acc& acc, const Unit& u, int wr, int wc, int fr, int fq) const {
        const int pm = u.pm, pn = u.pn, jt = pm % 17; const bool lat = jt > 0;
        const int row0 = pm * 256 + wr * 64 + fr, col0 = pn * 256 + wc * 32 + 8 * fq;
        if (pn == 0 || pn >= 6 || (pn == 1)) {
#pragma unroll
            for (int ai = 0; ai < 2; ++ai)
#pragma unroll
                for (int m = 0; m < 4; ++m) {
                    const int r = row0 + ai * 128 + m * 16; bf16* rowp = P1 + (size_t)r * NP1 + col0;
                    *(u32x4*)(rowp) = pack8(acc[ai][0][m][0], acc[ai][0][m][1]);
                    if (pn != 1) *(u32x4*)(rowp + 128) = pack8(acc[ai][1][m][0], acc[ai][1][m][1]);
                    if (pn <= 1) {
                        float s = 0.f;
#pragma unroll
                        for (int bj = 0; bj < 2; ++bj) { if (pn == 1 && bj == 1) break;
#pragma unroll
                            for (int n = 0; n < 2; ++n) { const f32x4 x = acc[ai][bj][m][n]; s += (x[0] * x[0] + x[1] * x[1]) + (x[2] * x[2] + x[3] * x[3]); } }
                        s += __shfl_xor(s, 16); s += __shfl_xor(s, 32);
                        if (fq == 0) SSQ[(size_t)r * 8 + pn * 4 + wc] = s;
                    }
                    if (pn == 1 && wc == 0) {
                        f32x4 x1 = acc[ai][1][m][0], x2 = acc[ai][1][m][1], o1 = x1, o2 = x2;
                        if (lat) { const int gr = (jt - 1) * 4 + 2 * ai + wr, gc = 16 * m + fr;
                            const float2* tp = TM + (fq < 2 ? gr * 8 + 4 * fq : gc * 8 + 4 * (fq - 2));
                            const f32x4 t0 = *(const f32x4*)tp, t1 = *(const f32x4*)(tp + 2);
                            const f32x4 cs = {t0[0], t0[2], t1[0], t1[2]}, sn = {t0[1], t0[3], t1[1], t1[3]};
                            o1 = x1 * cs - x2 * sn; o2 = x1 * sn + x2 * cs; }
                        *(u32x4*)(rowp + 128) = pack8(o1, o2);
                    }
                }
        } else {
            const int g = wc & 1; const float qs = pn < 4 ? 0.125f * 1.4426950408889634f : 1.f;
#pragma unroll
            for (int ai = 0; ai < 2; ++ai) {
                const int gr = (jt - 1) * 4 + 2 * ai + wr;
#pragma unroll
                for (int m = 0; m < 4; ++m) {
                    const int r = row0 + ai * 128 + m * 16; bf16* rowp = P1 + (size_t)r * NP1 + col0;
                    f32x4 cs = {1.f, 1.f, 1.f, 1.f}, sn = {0.f, 0.f, 0.f, 0.f};
                    if (lat) { const int gc = 16 * m + fr; const float2* tp = TD + (g == 0 ? gr : gc) * 16 + 4 * fq;
                        const f32x4 t0 = *(const f32x4*)tp, t1 = *(const f32x4*)(tp + 2);
                        cs = (f32x4){t0[0], t0[2], t1[0], t1[2]}; sn = (f32x4){t0[1], t0[3], t1[1], t1[3]}; }
#pragma unroll
                    for (int bj = 0; bj < 2; ++bj) { const f32x4 x1 = acc[ai][bj][m][0] * qs, x2 = acc[ai][bj][m][1] * qs;
                        *(u32x4*)(rowp + bj * 128) = pack8(x1 * cs - x2 * sn, x1 * sn + x2 * cs); }
                }
            }
        }
    }
};

struct EpiUp {
    static constexpr bool PERM = true;
    bf16* QM; bf16* KVM; const float* SSQ; const float2* TM;
    __device__ __forceinline__ void operator()(const Acc& acc, const Unit& u, int wr, int wc, int fr, int fq) const {
        const int pm = u.pm, pn = u.pn, jt = pm % 17; const bool lat = jt > 0, isq = pn < 3;
        const int row0 = pm * 256 + wr * 64 + fr, col0 = pn * 256 + wc * 32 + 8 * fq;
#pragma unroll
        for (int ai = 0; ai < 2; ++ai)
#pragma unroll
            for (int m = 0; m < 4; ++m) {
                const int r = row0 + ai * 128 + m * 16;
                const f32x4 sq = *(const f32x4*)(SSQ + (size_t)r * 8 + (isq ? 0 : 4));
                const float rs = rsqrtf(((sq[0] + sq[1]) + (sq[2] + sq[3])) * (isq ? 1.f / 256.f : 1.f / 128.f) + EPS) * (isq ? 0.10206207261596575f * 1.4426950408889634f : 1.f);
#pragma unroll
                for (int bj = 0; bj < 2; ++bj) {
                    f32x4 x1 = acc[ai][bj][m][0] * rs, x2 = acc[ai][bj][m][1] * rs;
                    if (isq) {
                        const int G = 8 * pn + 4 * bj + wc;
                        if (lat && (G % 3) == 2) { const int gr = (jt - 1) * 4 + 2 * ai + wr, gc = 16 * m + fr;
                            const float2* tp = TM + (fq < 2 ? gr * 8 + 4 * fq : gc * 8 + 4 * (fq - 2));
                            const f32x4 t0 = *(const f32x4*)tp, t1 = *(const f32x4*)(tp + 2);
                            const f32x4 cs = {t0[0], t0[2], t1[0], t1[2]}, sn = {t0[1], t0[3], t1[1], t1[3]};
                            const f32x4 o1 = x1 * cs - x2 * sn, o2 = x1 * sn + x2 * cs; x1 = o1; x2 = o2; }
                        *(u32x4*)(QM + (size_t)r * 768 + col0 + bj * 128) = pack8(x1, x2);
                    } else *(u32x4*)(KVM + (size_t)r * 1024 + (col0 - 768) + bj * 128) = pack8(x1, x2);
                }
            }
    }
};

struct EpiOut {
    static constexpr bool PERM = true;
    const float* x; const float* MOD; bf16* X1;
    __device__ __forceinline__ void operator()(const Acc& acc, const Unit& u, int wr, int wc, int fr, int fq) const {
        const int b = u.pm / 16; const float* gt = MOD + b * 6144 + 2048;
        const int row0 = u.pm * 256 + wr * 64 + fr, col0 = u.pn * 256 + wc * 32 + 8 * fq;
        f32x4 gv[2][2];
#pragma unroll
        for (int bj = 0; bj < 2; ++bj)
#pragma unroll
            for (int n = 0; n < 2; ++n) gv[bj][n] = *(const f32x4*)(gt + col0 + bj * 128 + n * 4);
#pragma unroll
        for (int ai = 0; ai < 2; ++ai)
#pragma unroll
            for (int m = 0; m < 4; ++m) { const size_t off = (size_t)(row0 + ai * 128 + m * 16) * DM + col0;
#pragma unroll
                for (int bj = 0; bj < 2; ++bj) { const f32x4 x0 = *(const f32x4*)(x + off + bj * 128), x1 = *(const f32x4*)(x + off + bj * 128 + 4);
                    *(u32x4*)(X1 + off + bj * 128) = pack8(x0 + gv[bj][0] * acc[ai][bj][m][0], x1 + gv[bj][1] * acc[ai][bj][m][1]); } }
    }
};
struct EpiF32 {
    static constexpr bool PERM = false;
    float* O; int ldc;
    __device__ __forceinline__ void operator()(const Acc& acc, const Unit& u, int wr, int wc, int fr, int fq) const {
        const int row0 = u.pm * 256 + wr * 64 + fr, col0 = u.pn * 256 + wc * 32 + 4 * fq;
#pragma unroll
        for (int ai = 0; ai < 2; ++ai)
#pragma unroll
            for (int m = 0; m < 4; ++m) { const size_t off = (size_t)(row0 + ai * 128 + m * 16) * ldc + col0;
#pragma unroll
                for (int bj = 0; bj < 2; ++bj)
#pragma unroll
                    for (int n = 0; n < 2; ++n) *(f32x4*)(O + off + bj * 128 + n * 16) = acc[ai][bj][m][n]; }
    }
};
struct EpiAct {
    static constexpr bool PERM = true;
    bf16* ACT; const float* SW;
    __device__ __forceinline__ void operator()(const Acc& acc, const Unit& u, int wr, int wc, int fr, int fq) const {
        const int half = u.pn & 1, colb = half * 128 + wc * 32 + 8 * fq;
#pragma unroll
        for (int ai = 0; ai < 2; ++ai)
#pragma unroll
            for (int m = 0; m < 4; ++m) { const int tr = ai * 128 + wr * 64 + m * 16 + fr;
                f32x4 a[2];
#pragma unroll
                for (int n = 0; n < 2; ++n) { const f32x4 gt = acc[ai][0][m][n], up = acc[ai][1][m][n];
#pragma unroll
                    for (int e = 0; e < 4; ++e) a[n][e] = gt[e] * __builtin_amdgcn_rcpf(1.f + __expf(-gt[e])) * up[e]; }
                if (tr < u.nv) { const float w = SW[u.r0 + tr]; *(u32x4*)(ACT + (size_t)(u.r0 + tr) * EFF + colb) = pack8(a[0] * w, a[1] * w); } }
    }
};
constexpr float YSCALE = 32.f;
__device__ __forceinline__ unsigned pk4_fp8(f32x4 v) { int w = 0; w = __builtin_amdgcn_cvt_pk_fp8_f32(v[0], v[1], w, false); w = __builtin_amdgcn_cvt_pk_fp8_f32(v[2], v[3], w, true); return (unsigned)w; }
struct EpiY {
    static constexpr bool PERM = true;
    unsigned char* Y;
    __device__ __forceinline__ void operator()(const Acc& acc, const Unit& u, int wr, int wc, int fr, int fq) const {
        const int colb = (u.pn & 3) * 256 + wc * 64 + 16 * fq;
#pragma unroll
        for (int ai = 0; ai < 2; ++ai)
#pragma unroll
            for (int m = 0; m < 4; ++m) { const int tr = ai * 128 + wr * 64 + m * 16 + fr;
                if (tr < u.nv) { u32x4 w; w.x = pk4_fp8(acc[ai][0][m][0] * YSCALE); w.y = pk4_fp8(acc[ai][0][m][1] * YSCALE); w.z = pk4_fp8(acc[ai][1][m][0] * YSCALE); w.w = pk4_fp8(acc[ai][1][m][1] * YSCALE);
                    *(u32x4*)(Y + (size_t)(u.r0 + tr) * DM + colb) = w; } }
    }
};

template <int SUB, bool GATHER> struct ExpSched {
    const LAS int* uc; int nmine; const int* slot_tok;
    __device__ bool next(int i, Unit& u) const {
        if (i >= nmine) return false;
        const int e = __builtin_amdgcn_readfirstlane(uc[i * 4 + 0]), r0 = __builtin_amdgcn_readfirstlane(uc[i * 4 + 1]);
        const int nv = __builtin_amdgcn_readfirstlane(uc[i * 4 + 2]), sub = __builtin_amdgcn_readfirstlane(uc[i * 4 + 3]);
        u.pm = 0; u.pn = e * SUB + sub; u.r0 = r0; u.nv = nv; u.k0 = 0; return true;
    }
    __device__ __forceinline__ int a_row(const Unit& u, int r) const {
        if (GATHER) return r < u.nv ? slot_tok[u.r0 + r] : 0;
        const int s = u.r0 + r; return s < NSLOT ? s : NSLOT - 1;
    }
};
template <int SUB> __device__ __forceinline__ int exp_units_to_lds(LAS int* uc, const int* ut, int nunit, int nfull, int G, int c) {
    const int NF = nfull * SUB, NH = (nunit - nfull) * SUB, cr = G - 1 - c, nlight = (NF % G) ? G - NF % G : 0;
    const int mf = c < NF ? (NF - 1 - c) / G + 1 : 0;
    const int h0 = (cr < nlight && cr < NH) ? 1 : 0;
    const int NH2 = NH > nlight ? NH - nlight : 0, mh = cr < NH2 ? (NH2 - 1 - cr) / G + 1 : 0;
    const int t = threadIdx.x;
    if (t < mf + h0 + mh && t < 64) { const int L = t < mf ? t * G + c : (t < mf + h0 ? NF + cr : NF + nlight + (t - mf - h0) * G + cr); const int cu = L / SUB;
        uc[t * 4 + 0] = ut[cu * 4 + 0]; uc[t * 4 + 1] = ut[cu * 4 + 1]; uc[t * 4 + 2] = ut[cu * 4 + 2]; uc[t * 4 + 3] = L % SUB; }
    __syncthreads();
    return mf + h0 + mh < 64 ? mf + h0 + mh : 64;
}
struct LatOrder : pg8::StaticOrder {
    __device__ bool next(int i, Unit& u) const { if (!pg8::StaticOrder::next(i, u)) return false; u.pm += (u.pm >> 4) + 1; u.r0 = u.pm * 256; return true; }
};
struct RouterOrder {
    int G, c;
    __device__ bool next(int i, Unit& u) const { const int L = i * G + c; if (L >= 256) return false; u.pm = L >> 2; u.pn = 0; u.r0 = u.pm * 256; u.nv = 256; u.k0 = (L & 3) * 256; return true; }
    __device__ __forceinline__ int a_row(const Unit& u, int r) const { return u.pm * 256 + r; }
};
struct UpOrder {
    int G, c;
    __device__ bool next(int i, Unit& u) const { const int L = i * G + c; if (L >= 68 * 7) return false; u.pm = L / 7; u.pn = L % 7; u.r0 = u.pm * 256; u.nv = 256; u.k0 = u.pn < 3 ? 0 : 128; return true; }
    __device__ __forceinline__ int a_row(const Unit& u, int r) const { return u.pm * 256 + r; }
};
struct EpiLogP {
    static constexpr bool PERM = false;
    float* O;
    __device__ __forceinline__ void operator()(const Acc& acc, const Unit& u, int wr, int wc, int fr, int fq) const {
        float* base = O + (size_t)(u.k0 >> 8) * MLAT * NEXP;
        const int row0 = u.pm * 256 + wr * 64 + fr, col0 = wc * 32 + 4 * fq;
#pragma unroll
        for (int ai = 0; ai < 2; ++ai)
#pragma unroll
            for (int m = 0; m < 4; ++m) { const size_t off = (size_t)(row0 + ai * 128 + m * 16) * NEXP + col0;
#pragma unroll
                for (int bj = 0; bj < 2; ++bj)
#pragma unroll
                    for (int n = 0; n < 2; ++n) *(f32x4*)(base + off + bj * 128 + n * 16) = acc[ai][bj][m][n]; }
    }
};

namespace attn {
#define SBAR() __builtin_amdgcn_sched_barrier(0)
constexpr float THR = 8.f;
template <int MODE> struct Cfg;
template <> struct Cfg<0> { static constexpr int DQK = 96, DV = 64, LDQ = 768, LDK0 = 1024, LDK1 = 2048, LDV = 1024; static constexpr float SCALE = 0.10206207261596575f; };
template <> struct Cfg<1> { static constexpr int DQK = 64, DV = 128, LDQ = 2048, LDK0 = 2048, LDK1 = 2048, LDV = 2048; static constexpr float SCALE = 0.125f; };
__device__ __forceinline__ int crow(int r, int hi) { return (r & 3) + 8 * (r >> 2) + 4 * hi; }
typedef __bf16 bf16x2n __attribute__((ext_vector_type(2)));
typedef float f32x2n __attribute__((ext_vector_type(2)));
__device__ __forceinline__ unsigned cvtpk(float lo, float hi) { const f32x2n v = {lo, hi}; return __builtin_bit_cast(unsigned, __builtin_convertvector(v, bf16x2n)); }

constexpr float THR2 = 11.5f;
__device__ __forceinline__ float max3f(float a, float b, float c) { return __builtin_fmaxf(__builtin_fmaxf(a, b), c); }
template <int ABL = 0> __device__ __forceinline__ void partialSM(f32x16& p0, f32x16& p1, float& m_reg, float& alpha, bool first) {
    float a = max3f(p0[0], p0[1], p1[0]), b = max3f(p0[2], p0[3], p1[1]); a = max3f(a, p1[2], p1[3]);
#pragma unroll
    for (int r = 4; r < 16; r += 4) { a = max3f(a, p0[r], p0[r + 1]); b = max3f(b, p0[r + 2], p0[r + 3]); a = max3f(a, p1[r], p1[r + 1]); b = max3f(b, p1[r + 2], p1[r + 3]); }
    float pmax = __builtin_fmaxf(a, b);
    if (ABL == 7) pmax = p0[0];
    { auto rr = __builtin_amdgcn_permlane32_swap(__float_as_uint(pmax), __float_as_uint(pmax), false, false);
      pmax = __builtin_fmaxf(__uint_as_float(rr[0]), __uint_as_float(rr[1])); }
    alpha = 1.f;
    if (__builtin_expect(first || __any(pmax > THR2), 0)) {
        const float dl = first ? pmax : __builtin_fmaxf(pmax, 0.f);
        m_reg += dl; alpha = first ? 1.f : __builtin_amdgcn_exp2f(-dl);
#pragma unroll
        for (int r = 0; r < 16; ++r) { p0[r] -= dl; p1[r] -= dl; }
    }
#pragma unroll
    for (int r = 0; r < 16; ++r) p0[r] = ABL == 1 ? p0[r] * 0.5f : __builtin_amdgcn_exp2f(p0[r]);
}
template <int ABL = 0> __device__ __forceinline__ void finishSM(f32x16& p0, f32x16& p1, float alpha, float& l_reg, bf16x8& pa0, bf16x8& pa1, bf16x8& pa2, bf16x8& pa3) {
#pragma unroll
    for (int r = 0; r < 16; ++r) p1[r] = ABL == 1 ? p1[r] * 0.5f : __builtin_amdgcn_exp2f(p1[r]);
    float ps = 0;
    if (ABL == 2) ps = p0[0] + p1[15]; else {
        float s0 = p0[0] + p0[4], s1 = p0[1] + p0[5], s2 = p0[2] + p0[6], s3 = p0[3] + p0[7];
        s0 += p0[8]; s1 += p0[9]; s2 += p0[10]; s3 += p0[11]; s0 += p0[12]; s1 += p0[13]; s2 += p0[14]; s3 += p0[15];
#pragma unroll
        for (int r = 0; r < 16; r += 4) { s0 += p1[r]; s1 += p1[r + 1]; s2 += p1[r + 2]; s3 += p1[r + 3]; }
        ps = (s0 + s1) + (s2 + s3); }
    { auto rr = __builtin_amdgcn_permlane32_swap(__float_as_uint(ps), __float_as_uint(ps), false, false);
      ps = __uint_as_float(rr[0]) + __uint_as_float(rr[1]); }
    l_reg = l_reg * alpha + ps;
#define PK4(P, BASE, OUT) do { u32x4 w = {cvtpk(P[BASE + 0], P[BASE + 1]), cvtpk(P[BASE + 2], P[BASE + 3]), cvtpk(P[BASE + 4], P[BASE + 5]), cvtpk(P[BASE + 6], P[BASE + 7])}; OUT = *reinterpret_cast<bf16x8*>(&w); } while (0)
    PK4(p0, 0, pa0); PK4(p0, 8, pa1); PK4(p1, 0, pa2); PK4(p1, 8, pa3);
#undef PK4
}
template <int NQ, int KROW, int ABL = 0> __device__ __forceinline__ void qkt(f32x16& p0, f32x16& p1, const LAS char* Ks, const bf16x8* qr, float m_ref, int r32, int hi) {
    f32x16 negm;
#pragma unroll
    for (int r = 0; r < 16; ++r) negm[r] = -m_ref;
    p0 = negm; p1 = negm;
#pragma unroll
    for (int d0 = 0; d0 < NQ; ++d0) { const int cb = d0 * 32 + hi * 16;
        const bf16x8 b0 = *(const LAS bf16x8*)(Ks + r32 * KROW + cb);
        const bf16x8 b1 = *(const LAS bf16x8*)(Ks + (32 + r32) * KROW + cb);
        if (ABL == 4) { asm volatile("" :: "v"(b0), "v"(b1)); } else {
        p0 = __builtin_amdgcn_mfma_f32_32x32x16_bf16(b0, qr[d0], p0, 0, 0, 0);
        p1 = __builtin_amdgcn_mfma_f32_32x32x16_bf16(b1, qr[d0], p1, 0, 0, 0); } }
}
template <int NC> __device__ __forceinline__ int v_st(int k, int c) { const int kk = k; return ((kk >> 3) * NC + (c >> 5)) * 512 + ((kk & 7) * 32 + (c & 31)) * 2; }
__device__ __forceinline__ int v_rd_base(int lane) { return ((lane & 3) << 3) | (((lane >> 2) & 3) << 6) | (((lane >> 4) & 1) << 5) | (((lane >> 5) & 1) << 8); }
template <int OFF> __device__ __forceinline__ s16x4 tr_read(int vb) {
    s16x4 r; asm volatile("ds_read_b64_tr_b16 %0, %1 offset:%2" : "=&v"(r) : "v"(vb), "i"(OFF) : "memory"); return r;
}
template <int NC, int D0, int ABL = 0> __device__ __forceinline__ void pv_one(f32x16& od, int vb, bf16x8 pa0, bf16x8 pa1, bf16x8 pa2, bf16x8 pa3) {
#define VOFF(ks, half) (D0 * 512 + (ks) * (NC * 1024) + (half) * (NC * 512))
    const s16x4 l0 = tr_read<VOFF(0, 0)>(vb), h0 = tr_read<VOFF(0, 1)>(vb), l1 = tr_read<VOFF(1, 0)>(vb), h1 = tr_read<VOFF(1, 1)>(vb);
    const s16x4 l2 = tr_read<VOFF(2, 0)>(vb), h2 = tr_read<VOFF(2, 1)>(vb), l3 = tr_read<VOFF(3, 0)>(vb), h3 = tr_read<VOFF(3, 1)>(vb);
#undef VOFF
    asm volatile("s_waitcnt lgkmcnt(0)" ::: "memory"); SBAR();
#define PK(L, H) (bf16x8){L[0], L[1], L[2], L[3], H[0], H[1], H[2], H[3]}
    if (ABL == 3) { asm volatile("" :: "v"(l0), "v"(h0), "v"(l1), "v"(h1), "v"(l2), "v"(h2), "v"(l3), "v"(h3)); return; }
    od = __builtin_amdgcn_mfma_f32_32x32x16_bf16(pa0, PK(l0, h0), od, 0, 0, 0);
    od = __builtin_amdgcn_mfma_f32_32x32x16_bf16(pa1, PK(l1, h1), od, 0, 0, 0);
    od = __builtin_amdgcn_mfma_f32_32x32x16_bf16(pa2, PK(l2, h2), od, 0, 0, 0);
    od = __builtin_amdgcn_mfma_f32_32x32x16_bf16(pa3, PK(l3, h3), od, 0, 0, 0);
#undef PK
}
template <int NC, int ABL = 0> __device__ __forceinline__ void pv_all(f32x16* o, int vb, bf16x8 pa0, bf16x8 pa1, bf16x8 pa2, bf16x8 pa3) {
    pv_one<NC, 0, ABL>(o[0], vb, pa0, pa1, pa2, pa3); pv_one<NC, 1, ABL>(o[1], vb, pa0, pa1, pa2, pa3);
    if constexpr (NC == 4) { pv_one<NC, 2, ABL>(o[2], vb, pa0, pa1, pa2, pa3); pv_one<NC, 3, ABL>(o[3], vb, pa0, pa1, pa2, pa3); }
}
template <int MODE> constexpr int lds_bytes() { return 4 * (64 * Cfg<MODE>::DV * 2 + 2 * (Cfg<MODE>::DQK / 16) * 1024) + 8 * 64 * 4; }

template <int MODE, int EPI, int ABL = 0>
__device__ __forceinline__ void unit_regs(const bf16* __restrict__ Qb, const bf16* __restrict__ K0, const bf16* __restrict__ K1, const bf16* __restrict__ Vh, void* Ob, int ldo, LAS char* lds, char* stash, float lam, const float* gsub) {
    using C = Cfg<MODE>;
    constexpr int DQK = C::DQK, DV = C::DV, NQ = DQK / 16, NC = DV / 32, KROW = DQK * 2 + 16, SHM_K = 64 * KROW, SHM_V = 64 * DV * 2;
    const int tid = threadIdx.x, wid = tid >> 6, lane = tid & 63, r32 = lane & 31, hi = lane >> 5;
    LAS char* V_lds = lds; LAS char* K_lds = lds + 3 * SHM_V;
    LAS float* ws = (LAS float*)(lds + 3 * SHM_V + 3 * SHM_K) + wid * 64; LAS float* li_l = ws; LAS float* al_l = ws + 32;
    float m_reg = 0.f, l_reg = 0; f32x16 o[NC]; bf16x8 qr[NQ];
#pragma unroll
    for (int d = 0; d < NC; ++d) o[d] = f32x16{};
    const bf16* Qw = Qb + (size_t)(wid * 32 + r32) * C::LDQ + hi * 8;
#pragma unroll
    for (int d0 = 0; d0 < NQ; ++d0) qr[d0] = *reinterpret_cast<const bf16x8*>(Qw + d0 * 16);
    const int vb0 = (int)(uintptr_t)V_lds + v_rd_base(lane);
    const int kr0 = tid >> 3, kc0 = tid & 7;
    const int krr = (tid & 255) >> 2, krc = tid & 3;
    const int vr0 = MODE == 0 ? (tid >> 3) : (tid >> 4), vc0 = MODE == 0 ? (tid & 7) * 8 : (tid & 15) * 8;
    const int vst0 = v_st<NC>(vr0, vc0), vst1 = v_st<NC>(32 + vr0, vc0);
    constexpr int NSET = MODE == 0 ? 2 : 1;
    struct { bf16x8 ka, kb, va, vb; } sr_[NSET];
#define SLOAD(i, k0) do { sr_[i].ka = *reinterpret_cast<const bf16x8*>(K0 + (size_t)((k0) + kr0) * C::LDK0 + kc0 * 8); \
        if (MODE == 0) { sr_[i].kb = *reinterpret_cast<const bf16x8*>(K1 + (size_t)((k0) + krr) * C::LDK1 + krc * 8); } \
        sr_[i].va = *reinterpret_cast<const bf16x8*>(Vh + (size_t)((k0) + vr0) * C::LDV + vc0); \
        if (MODE == 1) { sr_[i].vb = *reinterpret_cast<const bf16x8*>(Vh + (size_t)((k0) + 32 + vr0) * C::LDV + vc0); } } while (0)
#define SWRITE(ko, vo, i) do { *(LAS bf16x8*)(K_lds + (ko) + kr0 * KROW + kc0 * 16) = sr_[i].ka; \
        if (MODE == 0) { *(LAS bf16x8*)(K_lds + (ko) + krr * KROW + 128 + krc * 16) = sr_[i].kb; } \
        *(LAS bf16x8*)(V_lds + (vo) + vst0) = sr_[i].va; \
        if (MODE == 1) { *(LAS bf16x8*)(V_lds + (vo) + vst1) = sr_[i].vb; } } while (0)
#define SWAIT() do { if (NSET == 2) asm volatile("s_waitcnt vmcnt(3)" ::: "memory"); } while (0)
#define RESC(a) do { if (__any((a) < 1.f)) { if (hi == 0) al_l[r32] = (a); asm volatile("s_waitcnt lgkmcnt(0)" ::: "memory"); \
        _Pragma("unroll") for (int d = 0; d < NC; ++d) _Pragma("unroll") for (int r = 0; r < 16; ++r) o[d][r] *= al_l[crow(r, hi)]; } } while (0)
    f32x16 pA0, pA1, pB0, pB1; float alA = 1.f, alB = 1.f; bf16x8 pa0, pa1, pa2, pa3; constexpr int NT = NTOK / 64;
#define STEP(PC0, PC1, ALC, PP0, PP1, ALP, jj, SQ, SV, SW) do { constexpr int SETN = ((jj##_c) + 1) % NSET; \
        if (ABL != 6 && (jj) + 1 < NT) { SWAIT(); SWRITE((SW) * SHM_K, (SW) * SHM_V, SETN); } \
        SBAR(); qkt<NQ, KROW, ABL>(PC0, PC1, K_lds + (SQ) * SHM_K, qr, m_reg, r32, hi); \
        finishSM<ABL>(PP0, PP1, ALP, l_reg, pa0, pa1, pa2, pa3); SBAR(); \
        if (ABL != 6 && (jj) + 1 + NSET < NT) SLOAD(SETN, ((jj) + 1 + NSET) * 64); SBAR(); \
        pv_all<NC, ABL>(o, vb0 + (SV) * SHM_V, pa0, pa1, pa2, pa3); partialSM<ABL>(PC0, PC1, m_reg, ALC, false); \
        RESC(ALC); if (ABL != 5) __syncthreads(); } while (0)
    static_assert((NT - 2) % 6 == 0, "tile count: steps 1..NT-2 in groups of 6");
    SLOAD(0, 0); asm volatile("s_waitcnt vmcnt(0)" ::: "memory"); SWRITE(0, 0, 0);
    SLOAD(1 % NSET, 64); if (NSET == 2) SLOAD(0, 128); __syncthreads();
    SWAIT(); SWRITE(SHM_K, SHM_V, 1 % NSET);
    qkt<NQ, KROW>(pA0, pA1, K_lds, qr, m_reg, r32, hi);
    SLOAD(1 % NSET, (1 + NSET) * 64);
    partialSM(pA0, pA1, m_reg, alA, true);
    __syncthreads();
    for (int j = 1; j + 1 < NT; j += 6) {
        constexpr int j_c = 1, j1_c = 2, j2_c = 3, j3_c = 4, j4_c = 5, j5_c = 6; const int j1 = j + 1, j2 = j + 2, j3 = j + 3, j4 = j + 4, j5 = j + 5;
        STEP(pB0, pB1, alB, pA0, pA1, alA, j,  1, 0, 2);
        STEP(pA0, pA1, alA, pB0, pB1, alB, j1, 2, 1, 0);
        STEP(pB0, pB1, alB, pA0, pA1, alA, j2, 0, 2, 1);
        STEP(pA0, pA1, alA, pB0, pB1, alB, j3, 1, 0, 2);
        STEP(pB0, pB1, alB, pA0, pA1, alA, j4, 2, 1, 0);
        STEP(pA0, pA1, alA, pB0, pB1, alB, j5, 0, 2, 1);
    }
    { constexpr int jt_c = NT - 1; const int jt = NT - 1;
      STEP(pB0, pB1, alB, pA0, pA1, alA, jt, (NT - 1) % 3, (NT - 2) % 3, NT % 3); }
    finishSM(pB0, pB1, alB, l_reg, pa0, pa1, pa2, pa3); SBAR();
    pv_all<NC>(o, vb0 + ((NT - 1) % 3) * SHM_V, pa0, pa1, pa2, pa3);
#undef STEP
    if (hi == 0) li_l[r32] = l_reg; asm volatile("s_waitcnt lgkmcnt(0)" ::: "memory");
    float rli[16];
#pragma unroll
    for (int r = 0; r < 16; ++r) rli[r] = __builtin_amdgcn_rcpf(li_l[crow(r, hi)]);
    asm volatile("" : "+s"(ldo), "+s"(stash), "+s"(gsub), "+s"(Ob));
    if constexpr (MODE == 0) {
#pragma unroll
        for (int r = 0; r < 16; ++r) { const int orow = wid * 32 + crow(r, hi);
#pragma unroll
            for (int d0 = 0; d0 < NC; ++d0) ((bf16*)Ob)[(size_t)orow * ldo + d0 * 32 + r32] = (bf16)f2bf(o[d0][r] * rli[r]); }
    } else if constexpr (EPI == 1) {
        char* st = stash + wid * 8192 + lane * 16;
#pragma unroll
        for (int d0 = 0; d0 < NC; ++d0)
#pragma unroll
            for (int q = 0; q < 2; ++q) { u32x4 w;
                w.x = cvtpk(o[d0][8 * q + 0] * rli[8 * q + 0], o[d0][8 * q + 1] * rli[8 * q + 1]); w.y = cvtpk(o[d0][8 * q + 2] * rli[8 * q + 2], o[d0][8 * q + 3] * rli[8 * q + 3]);
                w.z = cvtpk(o[d0][8 * q + 4] * rli[8 * q + 4], o[d0][8 * q + 5] * rli[8 * q + 5]); w.w = cvtpk(o[d0][8 * q + 6] * rli[8 * q + 6], o[d0][8 * q + 7] * rli[8 * q + 7]);
                *(u32x4*)(st + (d0 * 2 + q) * 1024) = w; }
        asm volatile("s_waitcnt vmcnt(0)" ::: "memory");
    } else {
        const char* st = stash + wid * 8192 + lane * 16;
#pragma unroll
        for (int d0 = 0; d0 < NC; ++d0) {
            const u32x4 wa = *(const u32x4*)(st + (d0 * 2 + 0) * 1024), wb = *(const u32x4*)(st + (d0 * 2 + 1) * 1024);
            f32x16 od;
            od[0] = __builtin_bit_cast(float, wa.x << 16); od[1] = __builtin_bit_cast(float, wa.x & 0xffff0000u); od[2] = __builtin_bit_cast(float, wa.y << 16); od[3] = __builtin_bit_cast(float, wa.y & 0xffff0000u);
            od[4] = __builtin_bit_cast(float, wa.z << 16); od[5] = __builtin_bit_cast(float, wa.z & 0xffff0000u); od[6] = __builtin_bit_cast(float, wa.w << 16); od[7] = __builtin_bit_cast(float, wa.w & 0xffff0000u);
            od[8] = __builtin_bit_cast(float, wb.x << 16); od[9] = __builtin_bit_cast(float, wb.x & 0xffff0000u); od[10] = __builtin_bit_cast(float, wb.y << 16); od[11] = __builtin_bit_cast(float, wb.y & 0xffff0000u);
            od[12] = __builtin_bit_cast(float, wb.z << 16); od[13] = __builtin_bit_cast(float, wb.z & 0xffff0000u); od[14] = __builtin_bit_cast(float, wb.w << 16); od[15] = __builtin_bit_cast(float, wb.w & 0xffff0000u);
#pragma unroll
            for (int r = 0; r < 16; ++r) od[r] -= lam * (o[d0][r] * rli[r]);
            o[d0] = od;
        }
        f32x16 ssv;
#pragma unroll
        for (int r = 0; r < 16; ++r) { float x = 0.f;
#pragma unroll
            for (int d0 = 0; d0 < NC; ++d0) x += o[d0][r] * o[d0][r];
            x += __builtin_bit_cast(float, __builtin_amdgcn_update_dpp(0, __builtin_bit_cast(int, x), 0x111, 0xf, 0xf, false));
            x += __builtin_bit_cast(float, __builtin_amdgcn_update_dpp(0, __builtin_bit_cast(int, x), 0x112, 0xf, 0xf, false));
            x += __builtin_bit_cast(float, __builtin_amdgcn_update_dpp(0, __builtin_bit_cast(int, x), 0x114, 0xf, 0xf, false));
            x += __builtin_bit_cast(float, __builtin_amdgcn_update_dpp(0, __builtin_bit_cast(int, x), 0x118, 0xf, 0xf, false));
            x += __builtin_bit_cast(float, __builtin_amdgcn_update_dpp(0, __builtin_bit_cast(int, x), 0x142, 0xa, 0xf, false));
            const float t0 = __builtin_bit_cast(float, __builtin_amdgcn_readlane(__builtin_bit_cast(int, x), 31)), t1 = __builtin_bit_cast(float, __builtin_amdgcn_readlane(__builtin_bit_cast(int, x), 63));
            ssv[r] = rsqrtf((hi ? t1 : t0) * (1.f / 128.f) + EPS) * (1.f - LAM_INIT); }
#pragma unroll
        for (int d0 = 0; d0 < NC; ++d0) { const float g = gsub[d0 * 32 + r32];
#pragma unroll
            for (int r = 0; r < 16; ++r) { const int orow = wid * 32 + crow(r, hi); ((bf16*)Ob)[(size_t)orow * ldo + d0 * 32 + r32] = (bf16)f2bf(o[d0][r] * ssv[r] * g); } }
    }
    __syncthreads();
#undef SLOAD
#undef SWRITE
#undef SWAIT
#undef RESC
}

template <int NQ, int ABL = 0> __device__ __forceinline__ void qkt_c(f32x16& p0, f32x16& p1, const LAS char* Ks, const bf16x8* qr, float m_ref, int r32, int hi) {
    f32x16 negm;
#pragma unroll
    for (int r = 0; r < 16; ++r) negm[r] = -m_ref;
    p0 = negm; p1 = negm;
#pragma unroll
    for (int d0 = 0; d0 < NQ; ++d0) { const LAS char* kp = Ks + (2 * d0 + hi) * 1024 + r32 * 16;
        const bf16x8 b0 = *(const LAS bf16x8*)kp, b1 = *(const LAS bf16x8*)(kp + 512);
        p0 = __builtin_amdgcn_mfma_f32_32x32x16_bf16(b0, qr[d0], p0, 0, 0, 0);
        p1 = __builtin_amdgcn_mfma_f32_32x32x16_bf16(b1, qr[d0], p1, 0, 0, 0); }
}
template <int MODE, int EPI, int ABL = 0>
__device__ __forceinline__ void unit_dma(const bf16* __restrict__ Qb, const bf16* __restrict__ K0, const bf16* __restrict__ K1, const bf16* __restrict__ Vh, void* Ob, int ldo, LAS char* lds, char* stash, float lam, const float* gsub) {
    using C = Cfg<MODE>;
    constexpr int DQK = C::DQK, DV = C::DV, NQ = DQK / 16, NC = DV / 32, KS = 2 * NQ * 1024, VS = 64 * DV * 2, NT = NTOK / 64;
    const int tid = threadIdx.x, lane = tid & 63, r32 = lane & 31, hi = lane >> 5; const int wid = __builtin_amdgcn_readfirstlane(tid >> 6);
    LAS char* K_lds = lds; LAS char* V_lds = lds + 4 * KS;
    LAS float* ws = (LAS float*)(lds + 4 * KS + 4 * VS) + wid * 64; LAS float* li_l = ws; LAS float* al_l = ws + 32;
    const bf16* ksA = K0 + (size_t)lane * C::LDK0 + wid * 8;
    const bf16* ksB = MODE == 0 ? K1 + (size_t)lane * C::LDK1 + (wid & 3) * 8 : nullptr;
    auto vsrc = [&](int p) -> const bf16* { const int st = 2 * p + (lane >> 5), k8 = st / NC, cb = st % NC; return Vh + (size_t)(k8 * 8 + ((lane >> 2) & 7)) * C::LDV + cb * 32 + (lane & 3) * 8; };
    const bf16* vsA = vsrc(wid); const bf16* vsB = MODE == 1 ? vsrc(wid + 8) : nullptr;
#define GLDS(src, dst) __builtin_amdgcn_global_load_lds((const unsigned*)(src), (LAS unsigned*)(dst), 16, 0, 0)
#define DMA(t, sl) do { GLDS(ksA + (size_t)(t) * 64 * C::LDK0, K_lds + (sl) * KS + wid * 1024); \
        if (MODE == 0) GLDS(ksB + (size_t)(t) * 64 * C::LDK1, K_lds + (sl) * KS + (8 + (wid & 3)) * 1024); \
        GLDS(vsA + (size_t)(t) * 64 * C::LDV, V_lds + (sl) * VS + wid * 1024); \
        if (MODE == 1) GLDS(vsB + (size_t)(t) * 64 * C::LDV, V_lds + (sl) * VS + (wid + 8) * 1024); } while (0)
#define WAIT_BAR(N) asm volatile("s_waitcnt vmcnt(" #N ") lgkmcnt(0)\n\ts_barrier" ::: "memory")
#define RESC(a) do { if (__any((a) < 1.f)) { if (hi == 0) al_l[r32] = (a); asm volatile("s_waitcnt lgkmcnt(0)" ::: "memory"); \
        _Pragma("unroll") for (int d = 0; d < NC; ++d) _Pragma("unroll") for (int r = 0; r < 16; ++r) o[d][r] *= al_l[crow(r, hi)]; } } while (0)
    DMA(0, 0); DMA(1, 1);
    float m_reg = 0.f, l_reg = 0; f32x16 o[NC]; bf16x8 qr[NQ];
#pragma unroll
    for (int d = 0; d < NC; ++d) o[d] = f32x16{};
    const bf16* Qw = Qb + (size_t)(wid * 32 + r32) * C::LDQ + hi * 8;
#pragma unroll
    for (int d0 = 0; d0 < NQ; ++d0) qr[d0] = *reinterpret_cast<const bf16x8*>(Qw + d0 * 16);
    const int vb0 = (int)(uintptr_t)V_lds + v_rd_base(lane);
    f32x16 pA0, pA1, pB0, pB1; float alA = 1.f, alB = 1.f; bf16x8 pa0, pa1, pa2, pa3;
    WAIT_BAR(0);
#define STEPD(PC0, PC1, ALC, PP0, PP1, ALP, jj, SQ, SV, SW, ISSUE, NW) do { \
        if (ISSUE) DMA((jj) + 2, SW); \
        SBAR(); qkt_c<NQ, ABL>(PC0, PC1, K_lds + (SQ) * KS, qr, m_reg, r32, hi); \
        finishSM<ABL>(PP0, PP1, ALP, l_reg, pa0, pa1, pa2, pa3); SBAR(); \
        pv_all<NC, ABL>(o, vb0 + (SV) * VS, pa0, pa1, pa2, pa3); partialSM<ABL>(PC0, PC1, m_reg, ALC, false); \
        RESC(ALC); if ((NW) == 3) WAIT_BAR(3); else WAIT_BAR(0); } while (0)
    static_assert(NT == 68, "tile schedule below: steps 1..64 in groups of 4, then 65, 66, 67");
    DMA(2, 2); qkt_c<NQ, ABL>(pA0, pA1, K_lds, qr, m_reg, r32, hi); partialSM<ABL>(pA0, pA1, m_reg, alA, true); WAIT_BAR(3);
    for (int j = 1; j < 65; j += 4) {
        STEPD(pB0, pB1, alB, pA0, pA1, alA, j,     1, 0, 3, true, 3);
        STEPD(pA0, pA1, alA, pB0, pB1, alB, j + 1, 2, 1, 0, true, 3);
        STEPD(pB0, pB1, alB, pA0, pA1, alA, j + 2, 3, 2, 1, true, 3);
        STEPD(pA0, pA1, alA, pB0, pB1, alB, j + 3, 0, 3, 2, true, 3);
    }
    STEPD(pB0, pB1, alB, pA0, pA1, alA, 65, 1, 0, 3, true, 3);
    STEPD(pA0, pA1, alA, pB0, pB1, alB, 66, 2, 1, 0, false, 0);
    STEPD(pB0, pB1, alB, pA0, pA1, alA, 67, 3, 2, 1, false, 0);
    finishSM<ABL>(pB0, pB1, alB, l_reg, pa0, pa1, pa2, pa3); SBAR();
    pv_all<NC, ABL>(o, vb0 + 3 * VS, pa0, pa1, pa2, pa3);
#undef STEPD
    if (hi == 0) li_l[r32] = l_reg; asm volatile("s_waitcnt lgkmcnt(0)" ::: "memory");
    float rli[16];
#pragma unroll
    for (int r = 0; r < 16; ++r) rli[r] = __builtin_amdgcn_rcpf(li_l[crow(r, hi)]);
    asm volatile("" : "+s"(ldo), "+s"(stash), "+s"(gsub), "+s"(Ob));
    if constexpr (MODE == 0) {
#pragma unroll
        for (int r = 0; r < 16; ++r) { const int orow = wid * 32 + crow(r, hi);
#pragma unroll
            for (int d0 = 0; d0 < NC; ++d0) ((bf16*)Ob)[(size_t)orow * ldo + d0 * 32 + r32] = (bf16)f2bf(o[d0][r] * rli[r]); }
    } else if constexpr (EPI == 1) {
        char* st = stash + wid * 8192 + lane * 16;
#pragma unroll
        for (int d0 = 0; d0 < NC; ++d0)
#pragma unroll
            for (int q = 0; q < 2; ++q) { u32x4 w;
                w.x = cvtpk(o[d0][8 * q + 0] * rli[8 * q + 0], o[d0][8 * q + 1] * rli[8 * q + 1]); w.y = cvtpk(o[d0][8 * q + 2] * rli[8 * q + 2], o[d0][8 * q + 3] * rli[8 * q + 3]);
                w.z = cvtpk(o[d0][8 * q + 4] * rli[8 * q + 4], o[d0][8 * q + 5] * rli[8 * q + 5]); w.w = cvtpk(o[d0][8 * q + 6] * rli[8 * q + 6], o[d0][8 * q + 7] * rli[8 * q + 7]);
                *(u32x4*)(st + (d0 * 2 + q) * 1024) = w; }
        asm volatile("s_waitcnt vmcnt(0)" ::: "memory");
    } else {
        const char* st = stash + wid * 8192 + lane * 16;
#pragma unroll
        for (int d0 = 0; d0 < NC; ++d0) {
            const u32x4 wa = *(const u32x4*)(st + (d0 * 2 + 0) * 1024), wb = *(const u32x4*)(st + (d0 * 2 + 1) * 1024);
            f32x16 od;
            od[0] = __builtin_bit_cast(float, wa.x << 16); od[1] = __builtin_bit_cast(float, wa.x & 0xffff0000u); od[2] = __builtin_bit_cast(float, wa.y << 16); od[3] = __builtin_bit_cast(float, wa.y & 0xffff0000u);
            od[4] = __builtin_bit_cast(float, wa.z << 16); od[5] = __builtin_bit_cast(float, wa.z & 0xffff0000u); od[6] = __builtin_bit_cast(float, wa.w << 16); od[7] = __builtin_bit_cast(float, wa.w & 0xffff0000u);
            od[8] = __builtin_bit_cast(float, wb.x << 16); od[9] = __builtin_bit_cast(float, wb.x & 0xffff0000u); od[10] = __builtin_bit_cast(float, wb.y << 16); od[11] = __builtin_bit_cast(float, wb.y & 0xffff0000u);
            od[12] = __builtin_bit_cast(float, wb.z << 16); od[13] = __builtin_bit_cast(float, wb.z & 0xffff0000u); od[14] = __builtin_bit_cast(float, wb.w << 16); od[15] = __builtin_bit_cast(float, wb.w & 0xffff0000u);
#pragma unroll
            for (int r = 0; r < 16; ++r) od[r] -= lam * (o[d0][r] * rli[r]);
            o[d0] = od;
        }
        f32x16 ssv;
#pragma unroll
        for (int r = 0; r < 16; ++r) { float x = 0.f;
#pragma unroll
            for (int d0 = 0; d0 < NC; ++d0) x += o[d0][r] * o[d0][r];
            x += __builtin_bit_cast(float, __builtin_amdgcn_update_dpp(0, __builtin_bit_cast(int, x), 0x111, 0xf, 0xf, false));
            x += __builtin_bit_cast(float, __builtin_amdgcn_update_dpp(0, __builtin_bit_cast(int, x), 0x112, 0xf, 0xf, false));
            x += __builtin_bit_cast(float, __builtin_amdgcn_update_dpp(0, __builtin_bit_cast(int, x), 0x114, 0xf, 0xf, false));
            x += __builtin_bit_cast(float, __builtin_amdgcn_update_dpp(0, __builtin_bit_cast(int, x), 0x118, 0xf, 0xf, false));
            x += __builtin_bit_cast(float, __builtin_amdgcn_update_dpp(0, __builtin_bit_cast(int, x), 0x142, 0xa, 0xf, false));
            const float t0 = __builtin_bit_cast(float, __builtin_amdgcn_readlane(__builtin_bit_cast(int, x), 31)), t1 = __builtin_bit_cast(float, __builtin_amdgcn_readlane(__builtin_bit_cast(int, x), 63));
            ssv[r] = rsqrtf((hi ? t1 : t0) * (1.f / 128.f) + EPS) * (1.f - LAM_INIT); }
#pragma unroll
        for (int d0 = 0; d0 < NC; ++d0) { const float g = gsub[d0 * 32 + r32];
#pragma unroll
            for (int r = 0; r < 16; ++r) { const int orow = wid * 32 + crow(r, hi); ((bf16*)Ob)[(size_t)orow * ldo + d0 * 32 + r32] = (bf16)f2bf(o[d0][r] * ssv[r] * g); } }
    }
    __syncthreads();
#undef GLDS
#undef DMA
#undef WAIT_BAR
#undef RESC
}

template <int I> struct IC { static constexpr int value = I; };
template <int I, int N, class F> __device__ __forceinline__ void sfor(F&& f) { if constexpr (I < N) { f(IC<I>{}); sfor<I + 1, N>(f); } }
template <int MODE> struct GC {
    using C = Cfg<MODE>;
    static constexpr int NQ = C::DQK / 16, NC = C::DV / 32, NMQ = 2 * NQ, NMP = 4 * NC, NG = NMQ + NMP, KS = 2 * NQ * 1024, VS = 64 * C::DV * 2;
    static constexpr int GF = MODE == 0 ? 14 : 16, NPRE = 8, NFIN = 80, NLATE = 24, RD = 3;
    f32x16 S[2][2], o[NC], negm; bf16x8 qr[NQ], kf[NMQ]; s16x4 vl[NMP], vh[NMP]; u32x4 w[4];
    float s[4], mxa, mxb, pmax, t0, t1, m_reg, l_reg, al[2];
    const bf16 *ksA, *ksB, *vsA, *vsB; LAS char *K_lds, *V_lds; const LAS char* kb; int vb0, wid, r32, hi; LAS float* al_l;
};
template <int MODE> __device__ __forceinline__ void g_dma(GC<MODE>& c, int t, int sl) {
    using G = GC<MODE>; using C = Cfg<MODE>;
#define GLDS(src, dst) __builtin_amdgcn_global_load_lds((const unsigned*)(src), (LAS unsigned*)(dst), 16, 0, 0)
    GLDS(c.ksA + (size_t)t * 64 * C::LDK0, c.K_lds + sl * G::KS + c.wid * 1024);
    if (MODE == 0) GLDS(c.ksB + (size_t)t * 64 * C::LDK1, c.K_lds + sl * G::KS + (8 + (c.wid & 3)) * 1024);
    GLDS(c.vsA + (size_t)t * 64 * C::LDV, c.V_lds + sl * G::VS + c.wid * 1024);
    if (MODE == 1) GLDS(c.vsB + (size_t)t * 64 * C::LDV, c.V_lds + sl * G::VS + (c.wid + 8) * 1024);
#undef GLDS
}
template <int MODE, int R> __device__ __forceinline__ void g_kread(GC<MODE>& c, const LAS char* kq) { c.kf[R] = *(const LAS bf16x8*)(kq + (R >> 1) * 2048 + (R & 1) * 512); }
template <int MODE, int I> __device__ __forceinline__ void g_vread(GC<MODE>& c, int vb) {
    constexpr int NC = GC<MODE>::NC, ks = I / NC, cb = I % NC, off = cb * 512 + ks * (NC * 1024);
    c.vl[I] = __builtin_amdgcn_ds_read_tr16_b64_v4i16((LAS s16x4*)(uintptr_t)(vb + off));
    c.vh[I] = __builtin_amdgcn_ds_read_tr16_b64_v4i16((LAS s16x4*)(uintptr_t)(vb + off + NC * 512));
}
template <int MODE, int XP, int I> __device__ __forceinline__ void g_fin(GC<MODE>& c) {
    constexpr int ord[20] = {0, 1, 2, 3, 8, 4, 9, 5, 10, 6, 11, 7, 16, 12, 17, 13, 18, 14, 15, 19};
    constexpr int q = I / 20, code = ord[I % 20], ty = code >> 3, ix = code & 7, h = q >> 1, eb = 8 * (q & 1);
    if constexpr (ty == 0) c.S[XP][h][eb + ix] = __builtin_amdgcn_exp2f(c.S[XP][h][eb + ix]);
    else if constexpr (ty == 1) { if constexpr (q == 0 && ix < 4) c.s[ix] = c.S[XP][h][eb + ix]; else c.s[ix & 3] += c.S[XP][h][eb + ix]; }
    else c.w[q][ix] = cvtpk(c.S[XP][h][eb + 2 * ix], c.S[XP][h][eb + 2 * ix + 1]);
}
template <int MODE, int XC, int I> __device__ __forceinline__ void g_late(GC<MODE>& c) {
    constexpr int XP = XC ^ 1;
    if constexpr (I == 0) c.t0 = c.s[0] + c.s[1];
    else if constexpr (I == 1) c.t1 = c.s[2] + c.s[3];
    else if constexpr (I == 2) c.t0 += c.t1;
    else if constexpr (I == 3) { auto rr = __builtin_amdgcn_permlane32_swap(__float_as_uint(c.t0), __float_as_uint(c.t0), false, false); c.t0 = __uint_as_float(rr[0]); c.t1 = __uint_as_float(rr[1]); }
    else if constexpr (I == 4) c.t0 += c.t1;
    else if constexpr (I == 5) c.l_reg = c.l_reg * c.al[XP] + c.t0;
    else if constexpr (I == 6) c.mxa = max3f(c.S[XC][0][0], c.S[XC][0][1], c.S[XC][1][0]);
    else if constexpr (I == 7) c.mxb = max3f(c.S[XC][0][2], c.S[XC][0][3], c.S[XC][1][1]);
    else if constexpr (I == 8) c.mxa = max3f(c.mxa, c.S[XC][1][2], c.S[XC][1][3]);
    else if constexpr (I < 21) { constexpr int j = I - 9, r = 4 + 4 * (j / 4), sub = j % 4, h = sub >> 1, e = r + 2 * (sub & 1);
        if constexpr ((sub & 1) == 0) c.mxa = max3f(c.mxa, c.S[XC][h][e], c.S[XC][h][e + 1]); else c.mxb = max3f(c.mxb, c.S[XC][h][e], c.S[XC][h][e + 1]); }
    else if constexpr (I == 21) c.pmax = __builtin_fmaxf(c.mxa, c.mxb);
    else if constexpr (I == 22) { auto rr = __builtin_amdgcn_permlane32_swap(__float_as_uint(c.pmax), __float_as_uint(c.pmax), false, false); c.mxa = __uint_as_float(rr[0]); c.mxb = __uint_as_float(rr[1]); }
    else c.pmax = __builtin_fmaxf(c.mxa, c.mxb);
}
template <int MODE, int XC, int G> __device__ __forceinline__ void g_mfma(GC<MODE>& c) {
    using T = GC<MODE>;
    if constexpr (G < T::NMQ) { constexpr int d0 = G >> 1, h = G & 1;
        if constexpr (d0 == 0) c.S[XC][h] = __builtin_amdgcn_mfma_f32_32x32x16_bf16(c.kf[G], c.qr[d0], c.negm, 0, 0, 0);
        else c.S[XC][h] = __builtin_amdgcn_mfma_f32_32x32x16_bf16(c.kf[G], c.qr[d0], c.S[XC][h], 0, 0, 0);
    } else { constexpr int i = G - T::NMQ, ks = i / T::NC, cb = i % T::NC;
        const bf16x8 vf = {c.vl[i][0], c.vl[i][1], c.vl[i][2], c.vl[i][3], c.vh[i][0], c.vh[i][1], c.vh[i][2], c.vh[i][3]};
        c.o[cb] = __builtin_amdgcn_mfma_f32_32x32x16_bf16(__builtin_bit_cast(bf16x8, c.w[ks]), vf, c.o[cb], 0, 0, 0); }
}
#define G_WAIT_BAR(N) asm volatile("s_waitcnt vmcnt(" #N ") lgkmcnt(0)\n\ts_barrier" ::: "memory")
#define G_RESC(a) do { if (__any((a) < 1.f)) { if (c.hi == 0) c.al_l[c.r32] = (a); asm volatile("s_waitcnt lgkmcnt(0)" ::: "memory"); \
        _Pragma("unroll") for (int d = 0; d < T::NC; ++d) _Pragma("unroll") for (int r = 0; r < 16; ++r) c.o[d][r] *= c.al_l[crow(r, c.hi)]; } } while (0)
template <int MODE, int XC, int SQ, int SV, int SW, bool ISSUE, int NW, int ABL = 0> __device__ __forceinline__ void g_step(GC<MODE>& c, int t) {
    using T = GC<MODE>; constexpr int XP = XC ^ 1;
    if constexpr (ISSUE && ABL != 3) g_dma<MODE>(c, t + 2, SW);
    const LAS char* kq = c.kb + SQ * T::KS; const int vb = c.vb0 + SV * T::VS;
    if constexpr (ABL != 5) sfor<0, T::RD>([&](auto i) { g_kread<MODE, decltype(i)::value>(c, kq); });
    if constexpr (ABL != 1) sfor<0, T::NPRE>([&](auto i) { g_fin<MODE, XP, decltype(i)::value>(c); });
    SBAR();
    sfor<0, T::NG>([&](auto gi) { constexpr int g = decltype(gi)::value, r = g + T::RD;
        if constexpr (ABL != 2) g_mfma<MODE, XC, g>(c);
        else { if constexpr (g < T::NMQ) asm volatile("" :: "v"(c.kf[g])); else asm volatile("" :: "v"(c.vl[g - T::NMQ]), "v"(c.vh[g - T::NMQ])); }
        if constexpr (ABL == 5) {} else if constexpr (r < T::NMQ) g_kread<MODE, r>(c, kq); else if constexpr (r < T::NG) g_vread<MODE, r - T::NMQ>(c, vb);
        if constexpr (ABL == 1) {} else if constexpr (g < T::GF) { constexpr int lo = T::NPRE + g * (T::NFIN - T::NPRE) / T::GF, hi = T::NPRE + (g + 1) * (T::NFIN - T::NPRE) / T::GF;
            sfor<lo, hi>([&](auto i) { g_fin<MODE, XP, decltype(i)::value>(c); });
        } else { constexpr int lo = (g - T::GF) * T::NLATE / (T::NG - T::GF), hi = (g - T::GF + 1) * T::NLATE / (T::NG - T::GF);
            sfor<lo, hi>([&](auto i) { g_late<MODE, XC, decltype(i)::value>(c); }); }
        SBAR(); });
    if constexpr (ABL == 1) c.pmax = 0.f;
    c.al[XC] = 1.f;
    if (__builtin_expect(__any(c.pmax > THR2), 0)) {
        const float dl = __builtin_fmaxf(c.pmax, 0.f); c.al[XC] = __builtin_amdgcn_exp2f(-dl);
        const float x = -dl; const unsigned xh = __float_as_uint(x) & 0xffff0000u; const float r1 = x - __uint_as_float(xh);
        const unsigned xm = __float_as_uint(r1) & 0xffff0000u; const float r2 = r1 - __uint_as_float(xm); const unsigned xl = __float_as_uint(r2) & 0xffff0000u;
        const unsigned one = c.hi == 0 ? 0x3f803f80u : 0u;
        const u32x4 av = {one, one & 0xffffu, 0u, 0u}, bv = {c.hi == 0 ? ((xh >> 16) | xm) : 0u, c.hi == 0 ? (xl >> 16) : 0u, 0u, 0u};
        const bf16x8 A1 = __builtin_bit_cast(bf16x8, av), B1 = __builtin_bit_cast(bf16x8, bv);
        c.S[XC][0] = __builtin_amdgcn_mfma_f32_32x32x16_bf16(A1, B1, c.S[XC][0], 0, 0, 0);
        c.S[XC][1] = __builtin_amdgcn_mfma_f32_32x32x16_bf16(A1, B1, c.S[XC][1], 0, 0, 0);
        c.negm = __builtin_amdgcn_mfma_f32_32x32x16_bf16(A1, B1, c.negm, 0, 0, 0);
    }
    G_RESC(c.al[XC]);
    if constexpr (ABL == 4) { if constexpr (NW == 3) asm volatile("s_waitcnt vmcnt(3) lgkmcnt(0)" ::: "memory"); else asm volatile("s_waitcnt vmcnt(0) lgkmcnt(0)" ::: "memory"); }
    else if constexpr (NW == 3) G_WAIT_BAR(3); else G_WAIT_BAR(0);
}
template <int MODE, int EPI, int ABL = 0>
__device__ __forceinline__ void unit_gap(const bf16* __restrict__ Qb, const bf16* __restrict__ K0, const bf16* __restrict__ K1, const bf16* __restrict__ Vh, void* Ob, int ldo, LAS char* lds, char* stash, float lam, const float* gsub) {
    using C = Cfg<MODE>; using T = GC<MODE>;
    constexpr int NQ = T::NQ, NC = T::NC, KS = T::KS, VS = T::VS, NT = NTOK / 64;
    int tid_ = threadIdx.x; asm volatile("" : "+v"(tid_));
    const int tid = tid_, lane = tid & 63, r32 = lane & 31, hi = lane >> 5; const int wid = __builtin_amdgcn_readfirstlane(tid >> 6);
    GC<MODE> c;
    c.K_lds = lds; c.V_lds = lds + 4 * KS; c.wid = wid; c.r32 = r32; c.hi = hi;
    LAS float* ws = (LAS float*)(lds + 4 * KS + 4 * VS) + wid * 64; LAS float* li_l = ws; LAS float* al_l = ws + 32; c.al_l = al_l;
    c.ksA = K0 + (size_t)lane * C::LDK0 + wid * 8;
    c.ksB = MODE == 0 ? K1 + (size_t)lane * C::LDK1 + (wid & 3) * 8 : nullptr;
    auto vsrc = [&](int p) -> const bf16* { const int st = 2 * p + (lane >> 5), k8 = st / NC, cb = st % NC; return Vh + (size_t)(k8 * 8 + ((lane >> 2) & 7)) * C::LDV + cb * 32 + (lane & 3) * 8; };
    c.vsA = vsrc(wid); c.vsB = MODE == 1 ? vsrc(wid + 8) : nullptr;
    c.kb = c.K_lds + hi * 1024 + r32 * 16; c.vb0 = (int)(uintptr_t)c.V_lds + v_rd_base(lane);
    g_dma<MODE>(c, 0, 0); g_dma<MODE>(c, 1, 1);
    c.m_reg = 0.f; c.l_reg = 0.f; c.al[0] = c.al[1] = 1.f;
#pragma unroll
    for (int d = 0; d < NC; ++d) c.o[d] = f32x16{};
    const bf16* Qw = Qb + (size_t)(wid * 32 + r32) * C::LDQ + hi * 8;
#pragma unroll
    for (int d0 = 0; d0 < NQ; ++d0) c.qr[d0] = *reinterpret_cast<const bf16x8*>(Qw + d0 * 16);
    G_WAIT_BAR(0);
    static_assert(NT == 68, "tile schedule below: steps 1..64 in groups of 4, then 65, 66, 67");
    {
        g_dma<MODE>(c, 2, 2);
        c.negm = f32x16{};
        sfor<0, T::NMQ>([&](auto i) { g_kread<MODE, decltype(i)::value>(c, c.kb); });
        sfor<0, T::NMQ>([&](auto i) { g_mfma<MODE, 0, decltype(i)::value>(c); });
        sfor<6, T::NLATE>([&](auto i) { g_late<MODE, 0, decltype(i)::value>(c); });
        c.m_reg = c.pmax;
#pragma unroll
        for (int r = 0; r < 16; ++r) { c.S[0][0][r] -= c.pmax; c.S[0][1][r] -= c.pmax; c.negm[r] = -c.m_reg; }
        asm volatile("" : "+v"(c.negm));
        G_WAIT_BAR(3);
    }
    for (int j = 1; j < 65; j += 4) {
        g_step<MODE, 1, 1, 0, 3, true, 3, ABL>(c, j);
        g_step<MODE, 0, 2, 1, 0, true, 3, ABL>(c, j + 1);
        g_step<MODE, 1, 3, 2, 1, true, 3, ABL>(c, j + 2);
        g_step<MODE, 0, 0, 3, 2, true, 3, ABL>(c, j + 3);
    }
    g_step<MODE, 1, 1, 0, 3, true, 3, ABL>(c, 65);
    g_step<MODE, 0, 2, 1, 0, false, 0, ABL>(c, 66);
    g_step<MODE, 1, 3, 2, 1, false, 0, ABL>(c, 67);
    {
        const int vb = c.vb0 + 3 * VS;
        sfor<0, T::NMP>([&](auto i) { g_vread<MODE, decltype(i)::value>(c, vb); });
        sfor<0, T::NFIN>([&](auto i) { g_fin<MODE, 1, decltype(i)::value>(c); });
        sfor<0, 6>([&](auto i) { g_late<MODE, 0, decltype(i)::value>(c); });
        sfor<0, T::NMP>([&](auto i) { g_mfma<MODE, 0, T::NMQ + decltype(i)::value>(c); });
    }
    f32x16 (&o)[NC] = c.o; float& l_reg = c.l_reg;
    if (hi == 0) li_l[r32] = l_reg; asm volatile("s_waitcnt lgkmcnt(0)" ::: "memory");
    float rli[16];
#pragma unroll
    for (int r = 0; r < 16; ++r) rli[r] = __builtin_amdgcn_rcpf(li_l[crow(r, hi)]);
    asm volatile("" : "+s"(ldo), "+s"(stash), "+s"(gsub), "+s"(Ob));
    if constexpr (MODE == 0) {
#pragma unroll
        for (int r = 0; r < 16; ++r) { const int orow = wid * 32 + crow(r, hi);
#pragma unroll
            for (int d0 = 0; d0 < NC; ++d0) ((bf16*)Ob)[(size_t)orow * ldo + d0 * 32 + r32] = (bf16)f2bf(o[d0][r] * rli[r]); }
    } else if constexpr (EPI == 1) {
        char* st = stash + wid * 8192 + lane * 16;
#pragma unroll
        for (int d0 = 0; d0 < NC; ++d0)
#pragma unroll
            for (int q = 0; q < 2; ++q) { u32x4 w;
                w.x = cvtpk(o[d0][8 * q + 0] * rli[8 * q + 0], o[d0][8 * q + 1] * rli[8 * q + 1]); w.y = cvtpk(o[d0][8 * q + 2] * rli[8 * q + 2], o[d0][8 * q + 3] * rli[8 * q + 3]);
                w.z = cvtpk(o[d0][8 * q + 4] * rli[8 * q + 4], o[d0][8 * q + 5] * rli[8 * q + 5]); w.w = cvtpk(o[d0][8 * q + 6] * rli[8 * q + 6], o[d0][8 * q + 7] * rli[8 * q + 7]);
                *(u32x4*)(st + (d0 * 2 + q) * 1024) = w; }
        asm volatile("s_waitcnt vmcnt(0)" ::: "memory");
    } else {
        const char* st = stash + wid * 8192 + lane * 16;
#pragma unroll
        for (int d0 = 0; d0 < NC; ++d0) {
            const u32x4 wa = *(const u32x4*)(st + (d0 * 2 + 0) * 1024), wb = *(const u32x4*)(st + (d0 * 2 + 1) * 1024);
            f32x16 od;
            od[0] = __builtin_bit_cast(float, wa.x << 16); od[1] = __builtin_bit_cast(float, wa.x & 0xffff0000u); od[2] = __builtin_bit_cast(float, wa.y << 16); od[3] = __builtin_bit_cast(float, wa.y & 0xffff0000u);
            od[4] = __builtin_bit_cast(float, wa.z << 16); od[5] = __builtin_bit_cast(float, wa.z & 0xffff0000u); od[6] = __builtin_bit_cast(float, wa.w << 16); od[7] = __builtin_bit_cast(float, wa.w & 0xffff0000u);
            od[8] = __builtin_bit_cast(float, wb.x << 16); od[9] = __builtin_bit_cast(float, wb.x & 0xffff0000u); od[10] = __builtin_bit_cast(float, wb.y << 16); od[11] = __builtin_bit_cast(float, wb.y & 0xffff0000u);
            od[12] = __builtin_bit_cast(float, wb.z << 16); od[13] = __builtin_bit_cast(float, wb.z & 0xffff0000u); od[14] = __builtin_bit_cast(float, wb.w << 16); od[15] = __builtin_bit_cast(float, wb.w & 0xffff0000u);
#pragma unroll
            for (int r = 0; r < 16; ++r) od[r] -= lam * (o[d0][r] * rli[r]);
            o[d0] = od;
        }
        f32x16 ssv;
#pragma unroll
        for (int r = 0; r < 16; ++r) { float x = 0.f;
#pragma unroll
            for (int d0 = 0; d0 < NC; ++d0) x += o[d0][r] * o[d0][r];
            x += __builtin_bit_cast(float, __builtin_amdgcn_update_dpp(0, __builtin_bit_cast(int, x), 0x111, 0xf, 0xf, false));
            x += __builtin_bit_cast(float, __builtin_amdgcn_update_dpp(0, __builtin_bit_cast(int, x), 0x112, 0xf, 0xf, false));
            x += __builtin_bit_cast(float, __builtin_amdgcn_update_dpp(0, __builtin_bit_cast(int, x), 0x114, 0xf, 0xf, false));
            x += __builtin_bit_cast(float, __builtin_amdgcn_update_dpp(0, __builtin_bit_cast(int, x), 0x118, 0xf, 0xf, false));
            x += __builtin_bit_cast(float, __builtin_amdgcn_update_dpp(0, __builtin_bit_cast(int, x), 0x142, 0xa, 0xf, false));
            const float t0 = __builtin_bit_cast(float, __builtin_amdgcn_readlane(__builtin_bit_cast(int, x), 31)), t1 = __builtin_bit_cast(float, __builtin_amdgcn_readlane(__builtin_bit_cast(int, x), 63));
            ssv[r] = rsqrtf((hi ? t1 : t0) * (1.f / 128.f) + EPS) * (1.f - LAM_INIT); }
#pragma unroll
        for (int d0 = 0; d0 < NC; ++d0) { const float g = gsub[d0 * 32 + r32];
#pragma unroll
            for (int r = 0; r < 16; ++r) { const int orow = wid * 32 + crow(r, hi); ((bf16*)Ob)[(size_t)orow * ldo + d0 * 32 + r32] = (bf16)f2bf(o[d0][r] * ssv[r] * g); } }
    }
    __syncthreads();
}
#undef G_WAIT_BAR
#undef G_RESC

#ifndef GAPM0
#define GAPM0 1
#endif
#ifndef GAPM1
#define GAPM1 1
#endif
template <int MODE, int EPI, int ABL = 0>
__device__ __forceinline__ void unit(const bf16* __restrict__ Qb, const bf16* __restrict__ K0, const bf16* __restrict__ K1, const bf16* __restrict__ Vh, void* Ob, int ldo, LAS char* lds, char* stash, float lam, const float* gsub) {
    if constexpr ((MODE == 0 && GAPM0) || (MODE == 1 && GAPM1)) unit_gap<MODE, EPI, ABL>(Qb, K0, K1, Vh, Ob, ldo, lds, stash, lam, gsub);
    else unit_dma<MODE, EPI, ABL>(Qb, K0, K1, Vh, Ob, ldo, lds, stash, lam, gsub);
}


#undef SBAR
}

#define XB_TMO      128
#define XB_XCNT(j)  (256  + 64 * (j))
#define XB_XSUB(j)  (1280 + 64 * (j))
#define XB_XGEN(j)  (2304 + 64 * (j))
#define XB_TOP      3328
#define XB_TOPGEN   3392
#define XCD_BAR_WORDS 3456
#define XB_SPIN_CAP (1u << 20)
__device__ __forceinline__ unsigned xb_ld(unsigned* p)              { return __hip_atomic_load(p, __ATOMIC_RELAXED, __HIP_MEMORY_SCOPE_AGENT); }
__device__ __forceinline__ unsigned xb_add(unsigned* p, unsigned v) { return __hip_atomic_fetch_add(p, v, __ATOMIC_RELAXED, __HIP_MEMORY_SCOPE_AGENT); }
__device__ __forceinline__ unsigned xb_xcc_id() { return (unsigned)__builtin_amdgcn_s_getreg((3 << 11) | 20) & 0xFu; }
#define XB_SPIN(cond, bar) do { unsigned _sp = 0; while (cond) { __builtin_amdgcn_s_sleep(1); \
    if ((++_sp & 255u) == 0u) { if (xb_ld(&(bar)[XB_TMO])) break; if (_sp > XB_SPIN_CAP) { atomicAdd(&(bar)[XB_TMO], 1u); break; } } } } while (0)
struct XcdBarrier { unsigned* bar; unsigned x; volatile LAS unsigned* st; };
__device__ __forceinline__ XcdBarrier xcd_barrier_post(unsigned* bar, volatile LAS unsigned* st) {
    XcdBarrier b; b.bar = bar; b.x = xb_xcc_id(); b.st = st;
    if (threadIdx.x == 0) (void)xb_add(&bar[XB_XCNT(b.x)], 1u);
    return b;
}
__device__ __forceinline__ void xcd_barrier_complete(unsigned* bar, unsigned x, unsigned& nloc, unsigned& nx) {
    const unsigned G = gridDim.x * gridDim.y * gridDim.z;
    unsigned sum, cnt, mine, sp = 0u;
    for (;;) {
        sum = 0u; cnt = 0u; mine = 0u;
#pragma unroll
        for (unsigned j = 0; j < 16; ++j) { const unsigned c = xb_ld(&bar[XB_XCNT(j)]); sum += c; cnt += (c > 0u) ? 1u : 0u; mine = (j == x) ? c : mine; }
        if (sum == G) break;
        __builtin_amdgcn_s_sleep(1);
        if ((++sp & 255u) == 0u) { if (xb_ld(&bar[XB_TMO])) break; if (sp > XB_SPIN_CAP) { atomicAdd(&bar[XB_TMO], 1u); break; } }
    }
    nloc = mine > 0u ? mine : 1u; nx = cnt > 0u ? cnt : 1u;
}
__device__ __forceinline__ void xcd_barrier(const XcdBarrier& b) {
    asm volatile("s_waitcnt vmcnt(0)" ::: "memory");
    __syncthreads();
    if (threadIdx.x == 0) {
        unsigned* bar = b.bar;
        __builtin_amdgcn_s_waitcnt(0);
        unsigned nloc = b.st[0], nx = b.st[1];
        if (nloc == 0u) { xcd_barrier_complete(bar, b.x, nloc, nx); b.st[0] = nloc; b.st[1] = nx; }
        const unsigned old = xb_add(&bar[XB_XSUB(b.x)], 1u);
        const unsigned gen = old / nloc;
        if (old + 1u == (gen + 1u) * nloc) {
            __builtin_amdgcn_fence(__ATOMIC_RELEASE, "agent");
            asm volatile("s_waitcnt vmcnt(0)" ::: "memory");
            const unsigned og = xb_add(&bar[XB_TOP], 1u);
            const unsigned tg = og / nx;
            if (og + 1u == (tg + 1u) * nx) xb_add(&bar[XB_TOPGEN], 1u);
            else XB_SPIN(xb_ld(&bar[XB_TOPGEN]) == tg, bar);
            __builtin_amdgcn_fence(__ATOMIC_ACQUIRE, "agent");
            xb_add(&bar[XB_XGEN(b.x)], 1u);
            asm volatile("s_waitcnt vmcnt(0)" ::: "memory");
        } else {
            XB_SPIN(xb_ld(&bar[XB_XGEN(b.x)]) == gen, bar);
            __builtin_amdgcn_fence(__ATOMIC_ACQUIRE, "agent");
            asm volatile("s_waitcnt vmcnt(0)" ::: "memory");
        }
    }
    __syncthreads();
}

constexpr int NWAVES = 8;
constexpr int RING_BYTES = 131072, LDS_BYTES = 147456, LDSCTL_OFF = LDS_BYTES - 2048, MISC_OFF = LDSCTL_OFF + 320, UCACHE_OFF = LDSCTL_OFF + 1024  ;

struct Frame {
    LAS unsigned char* lds; volatile LAS unsigned* MISC; unsigned* ctl;
    int tid, lane, wave, vcu, G;
    Ptrs P;
    __device__ __forceinline__ LAS char* lds_c() const { return (LAS char*)lds; }
};

template <class SrcF> __device__ __forceinline__ void transpose_item(const SrcF& f, int K, bf16* WT, int p0, int k0, LAS float* scr, int lane) {
    float t[32];
#pragma unroll
    for (int i = 0; i < 32; ++i) t[i] = f(k0 + 2 * i + (lane >> 5), p0 + (lane & 31));
#pragma unroll
    for (int i = 0; i < 32; ++i) scr[(2 * i + (lane >> 5)) * 33 + (lane & 31)] = t[i];
    LDS_WAIT(); asm volatile("" ::: "memory");
    const int c = lane & 7;
#pragma unroll
    for (int j = 0; j < 4; ++j) { const int n = (lane >> 3) + 8 * j; const LAS float* s = scr + (8 * c) * 33 + n;
        u32x4 o; o.x = cvt_pk_bf16(s[0 * 33], s[1 * 33]); o.y = cvt_pk_bf16(s[2 * 33], s[3 * 33]); o.z = cvt_pk_bf16(s[4 * 33], s[5 * 33]); o.w = cvt_pk_bf16(s[6 * 33], s[7 * 33]);
        *(u32x4*)(WT + (size_t)(p0 + n) * K + k0 + 8 * c) = o; }
    LDS_WAIT(); asm volatile("" ::: "memory");
}
struct SrcWin { const float* w; __device__ float operator()(int k, int p) const { const int l = p1_logical(p); return l < 0 ? 0.f : w[(size_t)k * IN_COLS + l]; } };
struct SrcWup { const float *gq, *wuq, *gkv, *wukv;
    __device__ float operator()(int k, int p) const {
        if (p < 768) return k < 256 ? gq[k] * wuq[(size_t)k * 768 + qm_logical(p)] : 0.f;
        return k >= 256 ? gkv[k - 256] * wukv[(size_t)(k - 256) * 1024 + (p - 768)] : 0.f; } };
__host__ __device__ __forceinline__ int ctx_dstcol(int cp) { return cp < 128 ? 256 + cp : cp < 160 ? 384 + (cp - 128) : cp < 672 ? 1024 + (cp - 160) : cp < 1184 ? 1536 + (cp - 672) : -1; }
struct SrcCtx { const float* w; __device__ float operator()(int k, int p) const { const int c = ctx_dstcol(p); const int l = c < 0 ? -1 : p1_logical(c); return l < 0 ? 0.f : w[(size_t)k * IN_COLS + l]; } };
struct SrcPlain { const float* w; int N; int coff; __device__ float operator()(int k, int p) const { return w[(size_t)k * N + p + coff]; } };

__device__ __forceinline__ void ph0_prep(Frame& F) {
    LAS float* scr = (LAS float*)(F.lds + F.wave * 16384);
    const int gw = F.vcu * NWAVES + F.wave, NGW = F.G * NWAVES, lane = F.lane;
    const Ptrs& P = F.P; unsigned char* ws = P.ws;
    constexpr int I_IN = 16 * 64, I_UP = 6 * 56, I_OUT = 16 * 32, I_R = 16 * 8, I_CTX = 16 * 38, I_SMALL = I_IN + I_UP + I_OUT + I_R + I_CTX;
    for (int it = gw; it < I_SMALL; it += NGW) {
        int r = it;
        if (r < I_IN) { transpose_item(SrcWin{P.in[8]}, 1024, (bf16*)(ws + WS_WIN), (r % 64) * 32, (r / 64) * 64, scr, lane); continue; } r -= I_IN;
        if (r < I_UP) { transpose_item(SrcWup{P.in[9], P.in[10], P.in[11], P.in[12]}, 384, (bf16*)(ws + WS_WUP), (r % 56) * 32, (r / 56) * 64, scr, lane); continue; } r -= I_UP;
        if (r < I_OUT) { transpose_item(SrcPlain{P.in[18], 1024, 0}, 1024, (bf16*)(ws + WS_WOUT), (r % 32) * 32, (r / 32) * 64, scr, lane); continue; } r -= I_OUT;
        if (r < I_R) { transpose_item(SrcPlain{P.in[19], 256, 0}, 1024, (bf16*)(ws + WS_WR), (r % 8) * 32, (r / 8) * 64, scr, lane); continue; } r -= I_R;
        transpose_item(SrcCtx{P.in[8]}, 1024, (bf16*)(ws + WS_WCTX), (r % 38) * 32, (r / 38) * 64, scr, lane);
    }
    for (int it = gw; it < 96 * 16; it += NGW) {
        const int cg = it % 96, kp = it / 96;
#pragma unroll
        for (int r = 0; r < 5; ++r) { const float c = (r < 4 ? P.in[1] + r * DM : P.in[3])[kp * 64 + lane]; scr[r * 64 + lane] = c / (1.f + __expf(-c)); }
        LDS_WAIT(); asm volatile("" ::: "memory");
        float acc[5] = {0.f, 0.f, 0.f, 0.f, 0.f};
        const float* W = P.in[4] + (size_t)(kp * 64) * 6144 + cg * 64 + lane;
#pragma unroll 8
        for (int kk = 0; kk < 64; ++kk) { const float w = W[(size_t)kk * 6144];
#pragma unroll
            for (int r = 0; r < 5; ++r) acc[r] += scr[r * 64 + kk] * w; }
        LDS_WAIT(); asm volatile("" ::: "memory");
#pragma unroll
        for (int r = 0; r < 5; ++r) ((float*)(ws + WS_MODP))[(size_t)(kp * 5 + r) * 6144 + cg * 64 + lane] = acc[r];
    }
    { const int idx = (F.vcu * 512 + F.tid);
      if (idx < 1024) { const int v = idx / 16, f = idx % 16; const float th = (float)v * exp2f(-(float)f / 16.f * 13.287712379549449f);
          ((float2*)(ws + WS_TAB))[idx] = make_float2(__builtin_amdgcn_cosf(th * 0.15915494309189535f), __builtin_amdgcn_sinf(th * 0.15915494309189535f)); }
      else if (idx < 1536) { const int i2 = idx - 1024, v = i2 / 8, f = i2 % 8; const float th = (float)v * exp2f(-(float)f / 8.f * 13.287712379549449f);
          ((float2*)(ws + WS_TAB))[idx] = make_float2(__builtin_amdgcn_cosf(th * 0.15915494309189535f), __builtin_amdgcn_sinf(th * 0.15915494309189535f)); } }
}
struct CvItem { const float* src; int ld; bf16* dst; int K; };
__device__ __forceinline__ CvItem cv_decode(const Ptrs& P, int it, int lane) {
    constexpr int IPE = 256 + 128; unsigned char* ws = P.ws;
    const int e = it / IPE; int r = it % IPE; CvItem c;
    if (r < 256) { const int p0 = (r % 16) * 32, k0 = (r / 16) * 64, half = p0 >> 8, up = (p0 >> 7) & 1;
        const float* w = e < 256 ? (up ? P.in[22] : P.in[21]) + (size_t)e * DM * EFF : (up ? P.in[25] : P.in[24]);
        c.src = w + (size_t)(k0 + (lane >> 5)) * EFF + half * 128 + (p0 & 127) + (lane & 31); c.ld = EFF; c.K = 1024;
        c.dst = (bf16*)(ws + WS_W13) + ((size_t)e * 512 + p0) * 1024 + k0; }
    else { r -= 256; const int p0 = (r % 32) * 32, k0 = (r / 32) * 64;
        const float* w = e < 256 ? P.in[23] + (size_t)e * EFF * DM : P.in[26];
        c.src = w + (size_t)(k0 + (lane >> 5)) * DM + p0 + (lane & 31); c.ld = DM; c.K = 256;
        c.dst = (bf16*)(ws + WS_W2) + ((size_t)e * 1024 + p0) * 256 + k0; }
    return c;
}
#ifndef CVV
#define CVV 3
#endif
#ifndef CVP
#define CVP 0
#endif
#define CV_LOAD(t, c) do { _Pragma("unroll") for (int _i = 0; _i < 32; ++_i) { if (CVP == 2 && probe) t[_i] = (float)_i; else if (CVV == 3) t[_i] = __builtin_nontemporal_load((c).src + (size_t)(2 * _i) * (c).ld); else t[_i] = (c).src[(size_t)(2 * _i) * (c).ld]; } } while (0)
#define CV_FINISH(t, c) do { _Pragma("unroll") for (int _i = 0; _i < 32; ++_i) scr[(2 * _i + (lane >> 5)) * 33 + (lane & 31)] = t[_i]; \
        LDS_WAIT(); asm volatile("" ::: "memory"); const int _c = lane & 7; \
        _Pragma("unroll") for (int _j = 0; _j < 4; ++_j) { const int _n = (lane >> 3) + 8 * _j; const LAS float* _s = scr + (8 * _c) * 33 + _n; \
            u32x4 _o; _o.x = cvt_pk_bf16(_s[0 * 33], _s[1 * 33]); _o.y = cvt_pk_bf16(_s[2 * 33], _s[3 * 33]); _o.z = cvt_pk_bf16(_s[4 * 33], _s[5 * 33]); _o.w = cvt_pk_bf16(_s[6 * 33], _s[7 * 33]); \
            if (!(CVP == 1 && probe)) *(u32x4*)((c).dst + (size_t)_n * (c).K + 8 * _c) = _o; else asm volatile("" :: "v"(_o)); } \
        LDS_WAIT(); asm volatile("" ::: "memory"); } while (0)
constexpr int CV_EARLY = 0;
__device__ __forceinline__ void ph0_experts(Frame& F, int r_from, int r_to, bool probe = false) {
    __syncthreads();
    LAS float* scr = (LAS float*)(F.lds + F.wave * 16384);
    const int gw = F.vcu * NWAVES + F.wave, NGW = F.G * NWAVES, lane = F.lane, NIT = 257 * 384;
    const Ptrs& P = F.P;
    float ta[32], tb[32];
    const long lim = (long)gw + (long)(r_to < (1 << 20) ? r_to : (1 << 20)) * NGW; const int NE = (int)(lim < NIT ? lim : NIT);
    int it = gw + r_from * NGW; CvItem ca, cb;
    if (it < NE) { ca = cv_decode(P, it, lane); CV_LOAD(ta, ca); }
    for (; it < NE; it += 2 * NGW) {
        const int it2 = it + NGW, it3 = it + 2 * NGW;
        if (it2 < NE) { cb = cv_decode(P, it2, lane); CV_LOAD(tb, cb); }
        CV_FINISH(ta, ca);
        if (it3 < NE) { ca = cv_decode(P, it3, lane); CV_LOAD(ta, ca); }
        if (it2 < NE) CV_FINISH(tb, cb);
    }
    __syncthreads();
}
#undef CV_LOAD
#undef CV_FINISH
__device__ __forceinline__ void ph1_xn(Frame& F) {
    const Ptrs& P = F.P; unsigned char* ws = P.ws; const int lane = F.lane, wave = F.wave, fr = lane & 15, fq = lane >> 4;
    const float* MODP = (const float*)(ws + WS_MODP);
    for (int idx = F.vcu * 512 + F.tid; idx < 5 * 6144; idx += F.G * 512) { const int r = idx / 6144, j = idx % 6144; float a = P.in[5][j];
#pragma unroll
        for (int kp = 0; kp < 16; ++kp) a += MODP[(size_t)(kp * 5 + r) * 6144 + j];
        ((float*)(ws + WS_MOD))[idx] = a; }
    LAS unsigned char* At = F.lds;
    LAS float* sm = (LAS float*)(F.lds + 32768);
    const int t0 = F.vcu * 64, bl = t0 / SEQ;
    for (int i = F.tid; i < 4096; i += 512) { const int j = i & 2047, mrow = i < 2048 ? bl : 4; float a = P.in[5][j];
#pragma unroll
        for (int kp = 0; kp < 16; ++kp) a += MODP[(size_t)(kp * 5 + mrow) * 6144 + j];
        sm[i] = a; }
    __syncthreads();
    {
        f32x4 v[4], nv[4];
        { const f32x4* xr = (const f32x4*)(P.in[0] + (size_t)(t0 + wave * 8) * DM) + lane;
#pragma unroll
          for (int j = 0; j < 4; ++j) v[j] = xr[64 * j]; }
#pragma unroll 1
        for (int i = 0; i < 8; ++i) {
            const int t = t0 + wave * 8 + i, r = bl * NTOK + NCTX + (t - bl * SEQ);
            { const f32x4* xr = (const f32x4*)(P.in[0] + (size_t)(i < 7 ? t + 1 : t) * DM) + lane;
#pragma unroll
              for (int j = 0; j < 4; ++j) nv[j] = xr[64 * j]; }
            float s = 0.f;
#pragma unroll
            for (int j = 0; j < 4; ++j) s += (v[j][0] * v[j][0] + v[j][1] * v[j][1]) + (v[j][2] * v[j][2] + v[j][3] * v[j][3]);
            const float rs = rsqrtf(wave_sum(s) * (1.f / DM) + EPS);
            u32x2* o8 = (u32x2*)((bf16*)(ws + WS_XN) + (size_t)r * DM) + lane;
#pragma unroll
            for (int j = 0; j < 4; ++j) { const int c = 4 * lane + 256 * j; const f32x4 g = *(const f32x4*)(P.in[6] + c);
                const f32x4 sh = *(const LAS f32x4*)(sm + c), sc = *(const LAS f32x4*)(sm + 1024 + c);
                const f32x4 y = (v[j] * rs * g) * (sc + 1.f) + sh;
                u32x2 w; w.x = cvt_pk_bf16(y[0], y[1]); w.y = cvt_pk_bf16(y[2], y[3]); o8[64 * j] = w; }
#pragma unroll
            for (int j = 0; j < 4; ++j) v[j] = nv[j];
        }
    }
    const int mt = F.vcu >> 2, q = F.vcu & 3, bc = mt >> 4, nc0 = (mt & 15) * 16;
#pragma unroll 1
    for (int i = 0; i < 2; ++i) {
        const int r = 2 * wave + i;
        const f32x4* xr = (const f32x4*)(P.in[2] + ((size_t)bc * NCTX + nc0 + r) * DM) + lane;
        f32x4 v[4]; float s = 0.f;
#pragma unroll
        for (int j = 0; j < 4; ++j) { v[j] = xr[64 * j]; s += (v[j][0] * v[j][0] + v[j][1] * v[j][1]) + (v[j][2] * v[j][2] + v[j][3] * v[j][3]); }
        const float rs = rsqrtf(wave_sum(s) * (1.f / DM) + EPS);
#pragma unroll
        for (int j = 0; j < 4; ++j) { const int c = 4 * lane + 256 * j; const f32x4 g = *(const f32x4*)(P.in[6] + c);
            const f32x4 sh = *(const LAS f32x4*)(sm + 2048 + c), sc = *(const LAS f32x4*)(sm + 3072 + c);
            const f32x4 y = (v[j] * rs * g) * (sc + 1.f) + sh;
            u32x2 w; w.x = cvt_pk_bf16(y[0], y[1]); w.y = cvt_pk_bf16(y[2], y[3]);
            const int ch = (lane >> 1) + 32 * j;
            *(LAS u32x2*)(At + r * 2048 + ((ch ^ r) << 4) + (lane & 1) * 8) = w; }
    }
    __syncthreads();
    {
        const int nt0 = wave < 3 ? 3 * wave : 9 + 2 * (wave - 3), nnt = wave < 3 ? 3 : 2;
        const bf16* wb = (const bf16*)(ws + WS_WCTX) + (size_t)(q * 304 + nt0 * 16 + fr) * 1024 + 8 * fq;
        f32x4 acc[3];
#pragma unroll
        for (int j = 0; j < 3; ++j) acc[j] = (f32x4){0.f, 0.f, 0.f, 0.f};
        bf16x8 bq[4][3], nb[4][3];
#pragma unroll
        for (int u = 0; u < 4; ++u)
#pragma unroll
            for (int j = 0; j < 3; ++j) bq[u][j] = (j < nnt) ? *(const bf16x8*)(wb + (size_t)j * 16 * 1024 + 32 * u) : bf16x8{};
#pragma unroll 1
        for (int k4 = 0; k4 < 8; ++k4) {
            if (k4 < 7) {
#pragma unroll
                for (int u = 0; u < 4; ++u)
#pragma unroll
                    for (int j = 0; j < 3; ++j) nb[u][j] = (j < nnt) ? *(const bf16x8*)(wb + (size_t)j * 16 * 1024 + 32 * (4 * (k4 + 1) + u)) : bf16x8{}; }
#pragma unroll
            for (int u = 0; u < 4; ++u) { const int ch = 4 * (4 * k4 + u) + fq;
                const bf16x8 a = *(const LAS bf16x8*)(At + fr * 2048 + ((ch ^ fr) << 4));
#pragma unroll
                for (int j = 0; j < 3; ++j) acc[j] = __builtin_amdgcn_mfma_f32_16x16x32_bf16(bq[u][j], a, acc[j], 0, 0, 0); }
#pragma unroll
            for (int u = 0; u < 4; ++u)
#pragma unroll
                for (int j = 0; j < 3; ++j) bq[u][j] = nb[u][j];
        }
        const int r = bc * NTOK + nc0 + fr; bf16* P1 = (bf16*)(ws + WS_P1); float ssq = 0.f;
#pragma unroll
        for (int j = 0; j < 3; ++j) if (j < nnt) { const int cp = q * 304 + (nt0 + j) * 16 + 4 * fq, dc = ctx_dstcol(cp);
            if (dc >= 0) { u32x2 w; w.x = cvt_pk_bf16(acc[j][0], acc[j][1]); w.y = cvt_pk_bf16(acc[j][2], acc[j][3]); *(u32x2*)(P1 + (size_t)r * NP1 + dc) = w; }
            if (cp < 128) ssq += (acc[j][0] * acc[j][0] + acc[j][1] * acc[j][1]) + (acc[j][2] * acc[j][2] + acc[j][3] * acc[j][3]); }
        if (q == 0 && wave < 4) { ssq += __shfl_xor(ssq, 16); ssq += __shfl_xor(ssq, 32);
            if (fq == 0) ((float*)(ws + WS_SSQ))[(size_t)r * 8 + 4 + wave] = ssq; }
    }
    __syncthreads();
}
__device__ __forceinline__ void ph6_h2(Frame& F) {
    const Ptrs& P = F.P; unsigned char* ws = P.ws;
    const int gw = F.vcu * NWAVES + F.wave, NGW = F.G * NWAVES;
    f32x4 v[4], nv[4];
    if (gw < MLAT) { const f32x4* xr = (const f32x4*)((const float*)(ws + WS_X1) + (size_t)gw * DM) + F.lane;
#pragma unroll
        for (int j = 0; j < 4; ++j) v[j] = xr[64 * j]; }
    for (int t = gw; t < MLAT; t += NGW) {
        const int b = t / SEQ; const float* md = (const float*)(ws + WS_MOD) + b * 6144;
        { const int tn = t + NGW < MLAT ? t + NGW : t; const f32x4* xr = (const f32x4*)((const float*)(ws + WS_X1) + (size_t)tn * DM) + F.lane;
#pragma unroll
          for (int j = 0; j < 4; ++j) nv[j] = xr[64 * j]; }
        float s = 0.f;
#pragma unroll
        for (int j = 0; j < 4; ++j) s += (v[j][0] * v[j][0] + v[j][1] * v[j][1]) + (v[j][2] * v[j][2] + v[j][3] * v[j][3]);
        const float rs = rsqrtf(wave_sum(s) * (1.f / DM) + EPS);
        u32x2* o8 = (u32x2*)((bf16*)(ws + WS_H2) + (size_t)t * DM) + F.lane;
#pragma unroll
        for (int j = 0; j < 4; ++j) { const int c = 4 * F.lane + 256 * j; const f32x4 g = *(const f32x4*)(P.in[7] + c);
            const f32x4 sh = *(const f32x4*)(md + 3072 + c), sc = *(const f32x4*)(md + 4096 + c);
            const f32x4 y = (v[j] * rs * g) * (sc + 1.f) + sh;
            u32x2 w; w.x = cvt_pk_bf16(y[0], y[1]); w.y = cvt_pk_bf16(y[2], y[3]); o8[64 * j] = w; }
#pragma unroll
        for (int j = 0; j < 4; ++j) v[j] = nv[j];
    }
}
__device__ __forceinline__ void ph7_route(Frame& F) {
    const Ptrs& P = F.P; unsigned char* ws = P.ws; const int lane = F.lane;
    const int gw = F.vcu * NWAVES + F.wave, NGW = F.G * NWAVES;
    const f32x4 bi = ((const f32x4*)P.in[20])[lane];
    for (int t = gw; t < MLAT; t += NGW) {
        f32x4 lg = ((const f32x4*)(ws + WS_LOGP))[(size_t)t * 64 + lane];
#pragma unroll
        for (int kp = 1; kp < 4; ++kp) lg += ((const f32x4*)(ws + WS_LOGP))[((size_t)kp * MLAT + t) * 64 + lane];
        float s[4], v[4];
#pragma unroll
        for (int i = 0; i < 4; ++i) { s[i] = 1.f / (1.f + __expf(-lg[i])); v[i] = s[i] + bi[i]; }
        float m1 = fmaxf(v[0], v[1]), m2 = fminf(v[0], v[1]);
#pragma unroll
        for (int i = 2; i < 4; ++i) { const float x = v[i]; m2 = fmaxf(m2, fminf(m1, x)); m1 = fmaxf(m1, x); }
#pragma unroll
        for (int o = 1; o < 8; o <<= 1) { const float b1 = __shfl_xor(m1, o), b2 = __shfl_xor(m2, o); const float n1 = fmaxf(m1, b1), n2 = fmaxf(fminf(m1, b1), fmaxf(m2, b2)); m1 = n1; m2 = n2; }
        const float gs = m1 + m2; const int g = lane >> 3; int rank = 0;
#pragma unroll
        for (int j = 0; j < 8; ++j) { const float o = __shfl(gs, j * 8); rank += (o > gs || (o == gs && j < g)) ? 1 : 0; }
        if (rank >= 4) { v[0] = v[1] = v[2] = v[3] = -INFINITY; }
        int my_e = 0; float my_s = 0.f, ssum = 0.f;
#pragma unroll
        for (int k = 0; k < 8; ++k) {
            float bv = v[0]; int bi_ = 0;
#pragma unroll
            for (int i = 1; i < 4; ++i) if (v[i] > bv) { bv = v[i]; bi_ = i; }
            int be = lane * 4 + bi_;
#pragma unroll
            for (int o = 1; o < 64; o <<= 1) { const float ov = __shfl_xor(bv, o); const int oe = __shfl_xor(be, o); if (ov > bv || (ov == bv && oe < be)) { bv = ov; be = oe; } }
            const int wl = be >> 2, wi = be & 3;
            float sv = wi == 0 ? s[0] : wi == 1 ? s[1] : wi == 2 ? s[2] : s[3];
            sv = __shfl(sv, wl);
            if (lane == wl) { if (wi == 0) v[0] = -INFINITY; else if (wi == 1) v[1] = -INFINITY; else if (wi == 2) v[2] = -INFINITY; else v[3] = -INFINITY; }
            ssum += sv; if (lane == k) { my_e = be; my_s = sv; }
        }
        if (lane < 8) {
            int* cnt = (int*)(ws + WS_CTL) + CW_COUNT;
            const int rk = atomicAdd(&cnt[my_e], 1);
            ((int*)(ws + WS_EIDX))[(size_t)t * 8 + lane] = my_e;
            ((float*)(ws + WS_EW))[(size_t)t * 8 + lane] = my_s / ssum * 2.5f;
            ((int*)(ws + WS_ERANK))[(size_t)t * 8 + lane] = rk;
        }
    }
}
__device__ __forceinline__ void ph_route3(Frame& F) {
    const Ptrs& P = F.P; unsigned char* ws = P.ws; const int lane = F.lane, wave = F.wave, fr = lane & 15, fq = lane >> 4;
    LAS unsigned char* At = F.lds;
    const bf16* Wr = (const bf16*)(ws + WS_WR);
    const f32x4 bi = ((const f32x4*)P.in[20])[lane];
    for (int grp = F.vcu; grp < MLAT / 64; grp += F.G) {
        const int t0 = grp * 64, b = t0 / SEQ; const float* md = (const float*)(ws + WS_MOD) + b * 6144;
        u32x4 v[2], nv[2];
        { const u32x4* xr = (const u32x4*)((const bf16*)(ws + WS_X1) + (size_t)(t0 + wave * 8) * DM) + lane; v[0] = xr[0]; v[1] = xr[64]; }
#pragma unroll 1
        for (int i = 0; i < 8; ++i) {
            const int r = wave * 8 + i, t = t0 + r;
            { const int rn = i < 7 ? t + 1 : t; const u32x4* xr = (const u32x4*)((const bf16*)(ws + WS_X1) + (size_t)rn * DM) + lane; nv[0] = xr[0]; nv[1] = xr[64]; }
            float xf[2][8]; float s = 0.f;
#pragma unroll
            for (int h = 0; h < 2; ++h)
#pragma unroll
                for (int d = 0; d < 4; ++d) { xf[h][2 * d] = bflo(v[h][d]); xf[h][2 * d + 1] = bfhi(v[h][d]); s += xf[h][2 * d] * xf[h][2 * d] + xf[h][2 * d + 1] * xf[h][2 * d + 1]; }
            const float rs = rsqrtf(wave_sum(s) * (1.f / DM) + EPS);
#pragma unroll
            for (int h = 0; h < 2; ++h) { const int c = 8 * lane + 512 * h; f32x4 y[2];
#pragma unroll
                for (int q = 0; q < 2; ++q) { const f32x4 g = *(const f32x4*)(P.in[7] + c + 4 * q), sh = *(const f32x4*)(md + 3072 + c + 4 * q), sc = *(const f32x4*)(md + 4096 + c + 4 * q);
                    const f32x4 xv = {xf[h][4 * q], xf[h][4 * q + 1], xf[h][4 * q + 2], xf[h][4 * q + 3]}; y[q] = (xv * rs * g) * (sc + 1.f) + sh; }
                const u32x4 w = pack8(y[0], y[1]);
                *(u32x4*)((bf16*)(ws + WS_H2) + (size_t)t * DM + c) = w;
                const int ch = lane + 64 * h;
                *(LAS u32x4*)(At + r * 2048 + ((ch ^ (r & 15)) << 4)) = w; }
            v[0] = nv[0]; v[1] = nv[1];
        }
        __syncthreads();
        f32x4 acc[4][2];
#pragma unroll
        for (int m = 0; m < 4; ++m) { acc[m][0] = (f32x4){0.f, 0.f, 0.f, 0.f}; acc[m][1] = (f32x4){0.f, 0.f, 0.f, 0.f}; }
        const bf16* wb = Wr + (size_t)(wave * 32 + fr) * 1024 + 8 * fq;
        bf16x8 bq[4][2], nb[4][2];
#pragma unroll
        for (int u = 0; u < 4; ++u) { bq[u][0] = *(const bf16x8*)(wb + 32 * u); bq[u][1] = *(const bf16x8*)(wb + 16 * 1024 + 32 * u); }
#pragma unroll 1
        for (int k4 = 0; k4 < 8; ++k4) {
            if (k4 < 7) {
#pragma unroll
                for (int u = 0; u < 4; ++u) { nb[u][0] = *(const bf16x8*)(wb + 32 * (4 * (k4 + 1) + u)); nb[u][1] = *(const bf16x8*)(wb + 16 * 1024 + 32 * (4 * (k4 + 1) + u)); } }
#pragma unroll
            for (int u = 0; u < 4; ++u) { const int ks = 4 * k4 + u, ch = 4 * ks + fq;
#pragma unroll
                for (int m = 0; m < 4; ++m) { const int r = 16 * m + fr;
                    const bf16x8 a = *(const LAS bf16x8*)(At + r * 2048 + ((ch ^ (r & 15)) << 4));
                    acc[m][0] = __builtin_amdgcn_mfma_f32_16x16x32_bf16(bq[u][0], a, acc[m][0], 0, 0, 0);
                    acc[m][1] = __builtin_amdgcn_mfma_f32_16x16x32_bf16(bq[u][1], a, acc[m][1], 0, 0, 0); } }
#pragma unroll
            for (int u = 0; u < 4; ++u) { bq[u][0] = nb[u][0]; bq[u][1] = nb[u][1]; }
        }
        __syncthreads();
        LAS float* Lg = (LAS float*)F.lds;
#pragma unroll
        for (int m = 0; m < 4; ++m)
#pragma unroll
            for (int n = 0; n < 2; ++n) *(LAS f32x4*)(Lg + (16 * m + fr) * 260 + wave * 32 + 16 * n + 4 * fq) = acc[m][n];
        __syncthreads();
#pragma unroll 1
        for (int i = 0; i < 8; ++i) {
            const int r = wave * 8 + i, t = t0 + r;
            const f32x4 lg = *(const LAS f32x4*)(Lg + r * 260 + 4 * lane);
            float s[4], vv[4];
#pragma unroll
            for (int q = 0; q < 4; ++q) { s[q] = 1.f / (1.f + __expf(-lg[q])); vv[q] = s[q] + bi[q]; }
            float m1 = fmaxf(vv[0], vv[1]), m2 = fminf(vv[0], vv[1]);
#pragma unroll
            for (int q = 2; q < 4; ++q) { const float x = vv[q]; m2 = fmaxf(m2, fminf(m1, x)); m1 = fmaxf(m1, x); }
#pragma unroll
            for (int o = 1; o < 8; o <<= 1) { const float b1 = __shfl_xor(m1, o), b2 = __shfl_xor(m2, o); const float n1 = fmaxf(m1, b1), n2 = fmaxf(fminf(m1, b1), fmaxf(m2, b2)); m1 = n1; m2 = n2; }
            const float gs = m1 + m2; const int g = lane >> 3; int rank = 0;
#pragma unroll
            for (int j = 0; j < 8; ++j) { const float o = __builtin_bit_cast(float, __builtin_amdgcn_readlane(__builtin_bit_cast(int, gs), j * 8)); rank += (o > gs || (o == gs && j < g)) ? 1 : 0; }
            unsigned key[4];
#pragma unroll
            for (int q = 0; q < 4; ++q) key[q] = rank >= 4 ? 0u : ((__builtin_bit_cast(unsigned, vv[q] + 1.f) & 0xFFFFFF00u) | (unsigned)(255 - (lane * 4 + q)));
            int my_e = 0; float my_s = 0.f, ssum = 0.f;
#pragma unroll
            for (int k = 0; k < 8; ++k) {
                unsigned kb = max(max(key[0], key[1]), max(key[2], key[3]));
                kb = max(kb, (unsigned)__builtin_amdgcn_update_dpp(0, (int)kb, 0x111, 0xf, 0xf, false));
                kb = max(kb, (unsigned)__builtin_amdgcn_update_dpp(0, (int)kb, 0x112, 0xf, 0xf, false));
                kb = max(kb, (unsigned)__builtin_amdgcn_update_dpp(0, (int)kb, 0x114, 0xf, 0xf, false));
                kb = max(kb, (unsigned)__builtin_amdgcn_update_dpp(0, (int)kb, 0x118, 0xf, 0xf, false));
                kb = max(kb, (unsigned)__builtin_amdgcn_update_dpp(0, (int)kb, 0x142, 0xa, 0xf, false));
                kb = max(kb, (unsigned)__builtin_amdgcn_update_dpp(0, (int)kb, 0x143, 0xc, 0xf, false));
                const unsigned kw = (unsigned)__builtin_amdgcn_readlane((int)kb, 63);
                const int be = 255 - (int)(kw & 255u), wl = be >> 2, wi = be & 3;
                const float ssel = wi == 0 ? s[0] : wi == 1 ? s[1] : wi == 2 ? s[2] : s[3];
                const float sv = __builtin_bit_cast(float, __builtin_amdgcn_readlane(__builtin_bit_cast(int, ssel), wl));
#pragma unroll
                for (int q = 0; q < 4; ++q) key[q] = key[q] == kw ? 0u : key[q];
                ssum += sv; if (lane == k) { my_e = be; my_s = sv; }
            }
            if (lane < 8) {
                int* cnt = (int*)(ws + WS_CTL) + CW_COUNT;
                const int rk = atomicAdd(&cnt[my_e], 1);
                ((int*)(ws + WS_EIDX))[(size_t)t * 8 + lane] = my_e;
                ((float*)(ws + WS_EW))[(size_t)t * 8 + lane] = my_s / ssum * 2.5f;
                ((int*)(ws + WS_ERANK))[(size_t)t * 8 + lane] = rk;
            }
        }
        __syncthreads();
    }
}
__device__ __forceinline__ void ph8_slots(Frame& F) {
    const Ptrs& P = F.P; unsigned char* ws = P.ws;
    LAS int* off = (LAS int*)F.lds;
    LAS int* cfs = off + 260;
    LAS int* chs = off + 520;
    unsigned* cnt = (unsigned*)(ws + WS_CTL) + CW_COUNT;
    if (F.wave == 0) { const int lane = F.lane; int n[4], cf[4], ch[4], sn = 0, sf = 0, sh = 0;
#pragma unroll
        for (int i = 0; i < 4; ++i) { n[i] = (int)cnt[4 * lane + i]; const int r = n[i] & 255; cf[i] = (n[i] >> 8) + (r > 128 ? 1 : 0); ch[i] = (r > 0 && r <= 128) ? 1 : 0; sn += n[i]; sf += cf[i]; sh += ch[i]; }
        int in = sn, jf = sf, jh = sh;
#pragma unroll
        for (int o = 1; o < 64; o <<= 1) { const int tn = __shfl_up(in, o), tf = __shfl_up(jf, o), th = __shfl_up(jh, o); if (lane >= o) { in += tn; jf += tf; jh += th; } }
        int an = in - sn, af = jf - sf, ah = jh - sh;
#pragma unroll
        for (int i = 0; i < 4; ++i) { off[4 * lane + i] = an; cfs[4 * lane + i] = af; chs[4 * lane + i] = ah; an += n[i]; af += cf[i]; ah += ch[i]; }
        if (lane == 63) { off[256] = an; cfs[256] = af; chs[256] = ah; off[257] = NSLOT; cfs[257] = af + MLAT / 256; chs[257] = ah; } }
    __syncthreads();
    for (int idx = F.vcu * 512 + F.tid; idx < MLAT * 8; idx += F.G * 512) {
        const int e = ((const int*)(ws + WS_EIDX))[idx], rk = ((const int*)(ws + WS_ERANK))[idx];
        const int slot = off[e] + rk;
        ((int*)(ws + WS_SLOTOF))[idx] = slot; ((int*)(ws + WS_SLOTTOK))[slot] = idx >> 3; ((float*)(ws + WS_SLOTW))[slot] = ((const float*)(ws + WS_EW))[idx];
        if (idx < MLAT) { ((int*)(ws + WS_SLOTTOK))[MLAT * 8 + idx] = idx; ((float*)(ws + WS_SLOTW))[MLAT * 8 + idx] = 1.f; }
    }
    if (F.vcu == 0) {
        int* go = (int*)(ws + WS_OFF); int* ut = (int*)(ws + WS_UT);
        const int nfull = cfs[257];
        for (int e = F.tid; e < 258; e += 512) go[e] = off[e];
        for (int e = F.tid; e < 257; e += 512) { const int n = off[e + 1] - off[e], nf = cfs[e + 1] - cfs[e], nh = chs[e + 1] - chs[e];
            for (int j = 0; j < nf; ++j) { int* u = ut + (cfs[e] + j) * 4; u[0] = e; u[1] = off[e] + j * 256; u[2] = min(256, n - j * 256); u[3] = 0; }
            if (nh) { int* u = ut + (nfull + chs[e]) * 4; u[0] = e; u[1] = off[e] + nf * 256; u[2] = n - nf * 256; u[3] = 0; } }
        if (F.tid == 0) { ((int*)(ws + WS_CTL))[CW_NUNIT] = nfull + chs[257]; ((int*)(ws + WS_CTL))[CW_NFULL] = nfull; }
    }
    __syncthreads();
}
__device__ __forceinline__ void ph11_combine(Frame& F) {
    const Ptrs& P = F.P; unsigned char* ws = P.ws; const int lane = F.lane;
    const int gw = F.vcu * NWAVES + F.wave, NGW = F.G * NWAVES;
    const unsigned char* Y = (const unsigned char*)(ws + WS_Y);
    const int cbase = 256 * (lane >> 4) + 32 * ((lane >> 2) & 3) + 8 * (lane & 3);
    u32x4 yw[9], nyw[9]; u32x4 xw[2], nxw[2]; int nsl[8];
    auto ldslots = [&](int t) {
#pragma unroll
        for (int k = 0; k < 8; ++k) nsl[k] = ((const int*)(ws + WS_SLOTOF))[(size_t)t * 8 + k]; };
    auto ldrows = [&](int t) {
#pragma unroll
        for (int k = 0; k < 9; ++k) { const int sl = k < 8 ? nsl[k] : MLAT * 8 + t; nyw[k] = *(const u32x4*)(Y + (size_t)sl * DM + lane * 16); }
        nxw[0] = *(const u32x4*)((const bf16*)(ws + WS_X1) + (size_t)t * DM + cbase); nxw[1] = *(const u32x4*)((const bf16*)(ws + WS_X1) + (size_t)t * DM + cbase + 128); };
    if (gw < MLAT) { ldslots(gw); ldrows(gw); if (gw + NGW < MLAT) ldslots(gw + NGW); }
    for (int t = gw; t < MLAT; t += NGW) {
        const int b = t / SEQ; const float* gt2 = (const float*)(ws + WS_MOD) + b * 6144 + 5120;
#pragma unroll
        for (int k = 0; k < 9; ++k) yw[k] = nyw[k];
        xw[0] = nxw[0]; xw[1] = nxw[1];
        if (t + NGW < MLAT) { ldrows(t + NGW); if (t + 2 * NGW < MLAT) ldslots(t + 2 * NGW); }
        float a[16];
#pragma unroll
        for (int i = 0; i < 16; ++i) a[i] = 0.f;
#pragma unroll
        for (int k = 0; k < 9; ++k)
#pragma unroll
            for (int d = 0; d < 4; ++d) { const int w = (int)yw[k][d];
                const f32x2 lo = __builtin_amdgcn_cvt_pk_f32_fp8(w, false), hi = __builtin_amdgcn_cvt_pk_f32_fp8(w, true);
                a[4 * d + 0] += lo[0]; a[4 * d + 1] += lo[1]; a[4 * d + 2] += hi[0]; a[4 * d + 3] += hi[1]; }
        float ss = 0.f;
#pragma unroll
        for (int q = 0; q < 4; ++q) { const int c = cbase + (q >> 1) * 128 + (q & 1) * 4; const u32x4 xb = xw[q >> 1]; const unsigned x01 = (q & 1) ? xb.z : xb.x, x23 = (q & 1) ? xb.w : xb.y;
            const f32x4 xv = {bflo(x01), bfhi(x01), bflo(x23), bfhi(x23)}, gv = *(const f32x4*)(gt2 + c);
#pragma unroll
            for (int e = 0; e < 4; ++e) { const float v = xv[e] + gv[e] * (a[q * 4 + e] * (1.f / YSCALE)); a[q * 4 + e] = v; ss += v * v; } }
        const float rs = rsqrtf(wave_sum(ss) * (1.f / DM) + EPS);
#pragma unroll
        for (int q = 0; q < 4; ++q) { const int c = cbase + (q >> 1) * 128 + (q & 1) * 4; const f32x4 gf = *(const f32x4*)(P.in[27] + c);
            f32x4 o;
#pragma unroll
            for (int e = 0; e < 4; ++e) o[e] = a[q * 4 + e] * rs * gf[e];
            *(f32x4*)(P.out + (size_t)t * DM + c) = o; }
    }
}
__device__ __forceinline__ void ph4b_diff_finish(Frame& F) {
    const Ptrs& P = F.P; unsigned char* ws = P.ws; const int lane = F.lane;
    const int gw = F.vcu * NWAVES + F.wave, NGW = F.G * NWAVES;
    float d1 = P.in[13][lane] * P.in[14][lane], d2 = P.in[15][lane] * P.in[16][lane];
    d1 = wave_sum(d1); d2 = wave_sum(d2);
    const float lam = __expf(d1) - __expf(d2) + LAM_INIT;
    const float g0 = P.in[17][lane], g1 = P.in[17][64 + lane];
    for (int t = gw; t < MLAT; t += NGW) {
        const float* os = (const float*)(ws + WS_OS) + (size_t)t * 8 * 128;
        float x[4][4];
#pragma unroll
        for (int h = 0; h < 4; ++h) { x[h][0] = os[(2 * h) * 128 + lane]; x[h][1] = os[(2 * h) * 128 + 64 + lane]; x[h][2] = os[(2 * h + 1) * 128 + lane]; x[h][3] = os[(2 * h + 1) * 128 + 64 + lane]; }
#pragma unroll
        for (int h = 0; h < 4; ++h) {
            const float v0 = x[h][0] - lam * x[h][2], v1 = x[h][1] - lam * x[h][3];
            const float rs = rsqrtf(wave_sum(v0 * v0 + v1 * v1) * (1.f / 128.f) + EPS) * (1.f - LAM_INIT);
            bf16* mo = (bf16*)(ws + WS_MIX) + (size_t)t * DM + 512 + h * 128;
            mo[lane] = (bf16)f2bf(v0 * rs * g0); mo[64 + lane] = (bf16)f2bf(v1 * rs * g1); }
    }
}

#ifdef PROBE_UNITS
struct ProbeOrder { int n, c; __device__ bool next(int i, Unit& u) const { if (i >= n) return false; u.pm = (c * n + i) % 60; u.pn = (c + i) % 8; u.r0 = u.pm * 256; u.nv = 256; u.k0 = 0; return true; }
    __device__ __forceinline__ int a_row(const Unit& u, int r) const { return u.pm * 256 + r; } };
struct EpiProbe { static constexpr bool PERM = true; bf16* O; int mode;
    __device__ __forceinline__ void operator()(const Acc& acc, const Unit& u, int wr, int wc, int fr, int fq) const {
        if (mode == 0) {
#pragma unroll
            for (int ai = 0; ai < 2; ++ai)
#pragma unroll
                for (int bj = 0; bj < 2; ++bj)
#pragma unroll
                    for (int m = 0; m < 4; ++m) { asm volatile("" :: "v"(acc[ai][bj][m][0]), "v"(acc[ai][bj][m][1])); }
        } else {
            const int row0 = u.pm * 256 + wr * 64 + fr, col0 = u.pn * 256 + (mode == 2 ? wc * 64 : wc * 32) + 8 * fq; const int bjo = mode == 2 ? 32 : 128;
#pragma unroll
            for (int ai = 0; ai < 2; ++ai)
#pragma unroll
                for (int m = 0; m < 4; ++m) { if (mode == 7 && (ai | m)) { asm volatile("" :: "v"(acc[ai][0][m][0]), "v"(acc[ai][0][m][1]), "v"(acc[ai][1][m][0]), "v"(acc[ai][1][m][1])); continue; } bf16* rowp = mode == 8 ? O + (size_t)u.pm * 256 * NP1 + (size_t)(((wr * 4 + wc) * 8 + ai * 4 + m) * 2) * 512 + (fq * 16 + fr) * 8 : mode == 4 ? O + (size_t)blockIdx.x * 65536 + (size_t)(wr * 64 + fr + ai * 128 + m * 16) * 256 + wc * 32 + 8 * fq : O + (size_t)(row0 + ai * 128 + m * 16) * (mode == 3 ? NP1 + 64 : NP1) + col0;
                    *(u32x4*)(rowp) = pack8(acc[ai][0][m][0], acc[ai][0][m][1]); *(u32x4*)(rowp + (mode == 8 ? 512 : mode == 4 ? 128 : bjo)) = pack8(acc[ai][1][m][0], acc[ai][1][m][1]); }
        }
    }
};
#endif

enum { P_PREP = 0, P_XN, P_INPROJ, P_UP, P_ATTN, P_DIFFFIN, P_OUT, P_H2, P_ROUTER, P_ROUTE, P_SLOTS, P_EXP1, P_EXP2, P_COMB, P_PROBE, P_END };
struct Args { Ptrs P; int ph_lo, ph_hi, li, pad; };
__global__ void __launch_bounds__(NWAVES * 64, 2) mk_fwd(Args args) {
    extern __shared__ __attribute__((aligned(16))) unsigned char lds[];
    Frame F;
    F.lds = (LAS unsigned char*)lds; F.MISC = (volatile LAS unsigned*)(F.lds + MISC_OFF);
    F.tid = threadIdx.x; F.lane = F.tid & 63; F.wave = __builtin_amdgcn_readfirstlane(F.tid >> 6);
    F.G = gridDim.x; { const int bx = blockIdx.x; F.vcu = (F.G % 8 == 0) ? (bx % 8) * (F.G / 8) + bx / 8 : bx; }
    F.P = args.P; unsigned char* ws = args.P.ws; F.ctl = (unsigned*)(ws + WS_CTL);
    for (int u = F.tid; u < (LDS_BYTES - LDSCTL_OFF) / 4; u += NWAVES * 64) ((LAS unsigned*)(F.lds + LDSCTL_OFF))[u] = 0u;
    __syncthreads();
    XcdBarrier bar = xcd_barrier_post(F.ctl + CW_BAR + args.li * XCD_BAR_WORDS, F.MISC + 8);
    const int lo = args.ph_lo, hi = args.ph_hi;
#ifndef PHMASK
#define PHMASK 0xFFFF
#endif
#define IN(k) ((((PHMASK) >> (k)) & 1) && lo <= (k) && (k) < hi)
#define SKEW(ticks) do { const unsigned long long t0_ = __builtin_amdgcn_s_memrealtime(); const unsigned long long w_ = (unsigned long long)((F.vcu & 3) * (ticks)); while (__builtin_amdgcn_s_memrealtime() - t0_ < w_) __builtin_amdgcn_s_sleep(8); } while (0)
#define SEAM(k) do { if (IN(k) && IN((k) + 1)) xcd_barrier(bar); } while (0)
#define SEAM_SKIP1(k) do { if (IN(k) && IN((k) + 2)) xcd_barrier(bar); } while (0)
#define SEAM_SKIP2(k) do { if (IN(k) && IN((k) + 3)) xcd_barrier(bar); } while (0)
    if (IN(P_PREP)) { ph0_prep(F); } SEAM(P_PREP);
    if (IN(P_XN)) { ph1_xn(F); } SEAM(P_XN);
    if (IN(P_INPROJ)) {
        pg8::Gemm g{(const bf16*)(ws + WS_XN), (const bf16*)(ws + WS_WIN), 1024, 1024, 1024}; LatOrder S; S.init(MLAT, NP1, F.G, (int)blockIdx.x);
        EpiInProj E{(bf16*)(ws + WS_P1), (float*)(ws + WS_SSQ), (const float2*)(ws + WS_TAB), (const float2*)(ws + WS_TAB) + 1024};
#ifdef SKEW_INPROJ
        SKEW(SKEW_INPROJ);
#endif
        pg8::gemm_phase(F.lds, g, S, E);
        if (CV_EARLY > 0 && (int)blockIdx.x >= (MALL / 256) * (NP1 / 256) - 2 * F.G) ph0_experts(F, 0, CV_EARLY);
    } SEAM(P_INPROJ);
    if (IN(P_UP)) {
        pg8::Gemm g{(const bf16*)(ws + WS_P1), (const bf16*)(ws + WS_WUP), 2048, 384, 256}; UpOrder S{F.G, F.vcu};
        EpiUp E{(bf16*)(ws + WS_QM), (bf16*)(ws + WS_KVM), (const float*)(ws + WS_SSQ), (const float2*)(ws + WS_TAB) + 1024};
        pg8::gemm_phase(F.lds, g, S, E);
    } SEAM(P_UP);
    if (IN(P_ATTN)) {
        const bf16* P1 = (const bf16*)(ws + WS_P1); const bf16* QM = (const bf16*)(ws + WS_QM); const bf16* KVM = (const bf16*)(ws + WS_KVM);
        const int cslot = F.vcu % 5; int ui = 0;
        bool conv_done = false; int U = F.vcu;
        const int conv_from = ((int)blockIdx.x >= (MALL / 256) * (NP1 / 256) - 2 * F.G) ? CV_EARLY : 0;
        for (; U < 512; U += F.G, ++ui) {
            if (ui == cslot) { ph0_experts(F, conv_from, 1 << 30); conv_done = true; }
            const int bh = U >> 4, qb = U & 15, b = bh >> 3, hh = bh & 7;
            const bf16* K0 = KVM + (size_t)b * NTOK * 1024 + hh * 128;
            attn::unit<0, 0>(QM + (size_t)(b * NTOK + NCTX + qb * 256) * 768 + hh * 96, K0, P1 + (size_t)b * NTOK * NP1 + 384, K0 + 64,
                             (bf16*)(ws + WS_MIX) + (size_t)(b * SEQ + qb * 256) * DM + hh * 64, DM, F.lds_c(), nullptr, 0.f, nullptr);
        }
        char* stash = (char*)(ws + WS_OS) + (size_t)F.vcu * 65536;
        const int Ud0 = U;
        for (; U < 768; U += 1024, ++ui) {
            if (ui == cslot) { ph0_experts(F, conv_from, 1 << 30); conv_done = true; }
            const int Up = U - 512, bh = Up >> 4, qb = Up & 15, b = bh >> 2, h = bh & 3;
            const bf16* Pb = P1 + (size_t)b * NTOK * NP1;
            attn::unit<1, 1>(P1 + (size_t)(b * NTOK + NCTX + qb * 256) * NP1 + 512 + (2 * h) * 64, Pb + 1024 + (2 * h) * 64, nullptr, Pb + 1536 + h * 128, nullptr, 0, F.lds_c(),
                             stash, 0.f, nullptr);
        }
        for (U = Ud0; U < 768; U += 1024, ++ui) {
            if (ui == cslot) { ph0_experts(F, conv_from, 1 << 30); conv_done = true; }
            const int Up = U - 512, bh = Up >> 4, qb = Up & 15, b = bh >> 2, h = bh & 3;
            const bf16* Pb = P1 + (size_t)b * NTOK * NP1;
            float lam; { float d1 = F.P.in[13][F.lane] * F.P.in[14][F.lane], d2 = F.P.in[15][F.lane] * F.P.in[16][F.lane]; d1 = wave_sum(d1); d2 = wave_sum(d2); lam = __expf(d1) - __expf(d2) + LAM_INIT; }
            attn::unit<1, 2>(P1 + (size_t)(b * NTOK + NCTX + qb * 256) * NP1 + 512 + (2 * h + 1) * 64, Pb + 1024 + (2 * h + 1) * 64, nullptr, Pb + 1536 + h * 128,
                             (bf16*)(ws + WS_MIX) + (size_t)(b * SEQ + qb * 256) * DM + 512 + h * 128, DM, F.lds_c(), stash, lam, F.P.in[17]);
        }
        if (!conv_done) ph0_experts(F, conv_from, 1 << 30);
#ifdef CONV_PROBE
        if (F.vcu % 5 == 0) ph0_experts(F, 0, 1 << 30, true);
#endif

    } SEAM_SKIP1(P_ATTN);
#ifdef ATTN_PROBE
    if (IN(P_DIFFFIN)) { const bf16* P1 = (const bf16*)(ws + WS_P1); const bf16* QM = (const bf16*)(ws + WS_QM); const bf16* KVM = (const bf16*)(ws + WS_KVM);
        { const int Upr = F.vcu, bh = Upr >> 4, qb = Upr & 15, b = bh >> 3, hh = bh & 7;
          const bf16* K0 = KVM + (size_t)b * NTOK * 1024 + hh * 128;
          attn::unit<ATTN_PROBE_MODE, 0, ATTN_PROBE>(ATTN_PROBE_MODE == 0 ? QM + (size_t)(b * NTOK + NCTX + qb * 256) * 768 + hh * 96 : P1 + (size_t)(b * NTOK + NCTX + qb * 256) * NP1 + 512 + hh * 64,
                             ATTN_PROBE_MODE == 0 ? K0 : P1 + (size_t)b * NTOK * NP1 + 1024 + hh * 64, P1 + (size_t)b * NTOK * NP1 + 384, ATTN_PROBE_MODE == 0 ? K0 + 64 : P1 + (size_t)b * NTOK * NP1 + 1536 + (hh >> 1) * 128,
                             (bf16*)(ws + WS_TMP) + (size_t)Upr * 256 * DM, DM, F.lds_c(), nullptr, 0.f, nullptr); } }
#endif
    if (IN(P_OUT)) {
        pg8::Gemm g{(const bf16*)(ws + WS_MIX), (const bf16*)(ws + WS_WOUT), 1024, 1024, 1024}; pg8::StaticOrder S; S.init(MLAT, DM, F.G, (int)blockIdx.x);
        EpiOut E{F.P.in[0], (const float*)(ws + WS_MOD), (bf16*)(ws + WS_X1)};
        pg8::gemm_phase(F.lds, g, S, E);
    } SEAM(P_OUT);
    if (IN(P_H2)) { ph_route3(F); } SEAM_SKIP2(P_H2);
    if (IN(P_SLOTS)) { ph8_slots(F); } SEAM(P_SLOTS);
    if (IN(P_EXP1)) {
        const int nu = (int)xb_ld(F.ctl + CW_NUNIT), nfu = (int)xb_ld(F.ctl + CW_NFULL); LAS int* uc = (LAS int*)(F.lds + UCACHE_OFF);
        const int nmine = exp_units_to_lds<2>(uc, (const int*)(ws + WS_UT), nu, nfu, F.G, F.vcu);
        pg8::Gemm g{(const bf16*)(ws + WS_H2), (const bf16*)(ws + WS_W13), 1024, 1024, 1024};
        ExpSched<2, true> S{uc, nmine, (const int*)(ws + WS_SLOTTOK)};
        EpiAct E{(bf16*)(ws + WS_ACT), (const float*)(ws + WS_SLOTW)};
#ifdef SKEW_EXP1
        SKEW(SKEW_EXP1);
#endif
        pg8::gemm_phase(F.lds, g, S, E);
    } SEAM(P_EXP1);
    if (IN(P_EXP2)) {
        const int nu = (int)xb_ld(F.ctl + CW_NUNIT), nfu = (int)xb_ld(F.ctl + CW_NFULL); LAS int* uc = (LAS int*)(F.lds + UCACHE_OFF);
        const int nmine = exp_units_to_lds<4>(uc, (const int*)(ws + WS_UT), nu, nfu, F.G, F.vcu);
        pg8::Gemm g{(const bf16*)(ws + WS_ACT), (const bf16*)(ws + WS_W2), 256, 256, 256};
        ExpSched<4, false> S{uc, nmine, nullptr};
        EpiY E{(unsigned char*)(ws + WS_Y)};
#ifdef SKEW_EXP2
        SKEW(SKEW_EXP2);
#endif
        pg8::gemm_phase(F.lds, g, S, E);
    } SEAM(P_EXP2);
    if (IN(P_COMB)) { ph11_combine(F); } SEAM(P_COMB);
#ifdef PROBE_UNITS
    if (IN(P_PROBE)) {
        pg8::Gemm g{(const bf16*)(ws + WS_P1), (const bf16*)(ws + WS_WIN), 2048, 1024, PROBE_K}; ProbeOrder S{PROBE_UNITS, F.vcu};
        EpiProbe E{(bf16*)(ws + WS_TMP), PROBE_EPI};
        pg8::gemm_phase(F.lds, g, S, E);
    }
#endif
#undef IN
#undef SEAM
}

static int g_grid = 0;
static int mk_setup() {
    if (g_grid) return g_grid;
    int dev = 0, cus = 0;
    if (hipGetDevice(&dev) != hipSuccess || hipDeviceGetAttribute(&cus, hipDeviceAttributeMultiprocessorCount, dev) != hipSuccess) { fprintf(stderr, "kernel_launch: device query failed\n"); g_grid = -1; return -1; }
    if (hipFuncSetAttribute((const void*)mk_fwd, hipFuncAttributeMaxDynamicSharedMemorySize, LDS_BYTES) != hipSuccess) { fprintf(stderr, "kernel_launch: hipFuncSetAttribute failed\n"); g_grid = -1; return -1; }
    int per_cu = 0;
    if (hipOccupancyMaxActiveBlocksPerMultiprocessor(&per_cu, (const void*)mk_fwd, NWAVES * 64, LDS_BYTES) != hipSuccess || per_cu < 1) { fprintf(stderr, "kernel_launch: occupancy query says %d blocks/CU\n", per_cu); }
    (void)hipGetLastError();
    if (cus != 256) { fprintf(stderr, "kernel_launch: this build's work split assumes a 256-CU device (found %d CUs); nothing launched\n", cus); g_grid = -1; return -1; }
    g_grid = cus;
    return g_grid;
}
static void mk_run(const Ptrs& P, int lo, int hi, int li, hipStream_t stream) {
    Args a{}; a.P = P; a.ph_lo = lo; a.ph_hi = hi; a.li = li; a.pad = 0;
    hipLaunchKernelGGL(mk_fwd, dim3(g_grid), dim3(NWAVES * 64), LDS_BYTES, stream, a);
}
extern "C" void kernel_launch(void* const* d_in, const int* in_sizes, int n_in, void* d_out, int out_size, void* d_ws, size_t ws_size, hipStream_t stream) {
    if (n_in != 28 || out_size != MLAT * DM || ws_size < WS_END) { fprintf(stderr, "kernel_launch: unexpected shapes n_in %d out %d ws %zu\n", n_in, out_size, ws_size); return; }
    if (mk_setup() <= 0) return;
    Ptrs P{}; for (int i = 0; i < 28; ++i) P.in[i] = (const float*)d_in[i]; P.out = (float*)d_out; P.ws = (unsigned char*)d_ws;
    (void)hipMemsetAsync((char*)d_ws + WS_CTL, 0, 1 * MiB, stream);
    int li = 0;
#define FAST(lo, hi) mk_run(P, lo, hi, li++, stream)
    FAST(P_PREP, (defs_probe ? P_PROBE : P_COMB) + 1);
#undef FAST
}
```

```cpp
constexpr bool defs_probe = false;
#include <hip/hip_runtime.h>
#include <cstdio>
#include <cstdint>

constexpr int NB = 4, SEQ = 4096, NCTX = 256, NTOK = SEQ + NCTX, DM = 1024;
constexpr int MALL = NB * NTOK;
constexpr int MLAT = NB * SEQ;
constexpr int IN_COLS = 1952, NP1 = 2048;
constexpr int NEXP = 256, TOPK = 8, EFF = 256;
constexpr int NSLOT = MLAT * TOPK + MLAT;
constexpr float EPS = 1e-6f;
constexpr float LAM_INIT = 0.2f;

typedef unsigned short bf16;
__device__ __forceinline__ unsigned f2bf(float f) { unsigned u = __builtin_bit_cast(unsigned, f); return (u + 0x7fffu + ((u >> 16) & 1u)) >> 16; }
__device__ __forceinline__ float bf2f(bf16 h) { return __builtin_bit_cast(float, (unsigned)h << 16); }

constexpr size_t MiB = 1u << 20;
constexpr size_t WS_CTL = 0;
constexpr size_t WS_MOD = 3 * MiB;
constexpr size_t WS_TAB = 3 * MiB + 512 * 1024;
constexpr size_t WS_X1 = 402 * MiB;
constexpr size_t WS_SSQ = 466 * MiB;
constexpr size_t WS_EIDX = 467 * MiB;
constexpr size_t WS_EW = WS_EIDX + 512 * 1024;
constexpr size_t WS_ERANK = 468 * MiB;
constexpr size_t WS_SLOTOF = WS_ERANK + 512 * 1024;
constexpr size_t WS_SLOTTOK = 469 * MiB;
constexpr size_t WS_SLOTW = 470 * MiB;
constexpr size_t WS_OFF = 471 * MiB;
constexpr size_t WS_XN = 472 * MiB;
constexpr size_t WS_P1 = 506 * MiB;
constexpr size_t WS_QM = 574 * MiB;
constexpr size_t WS_KVM = 600 * MiB;
constexpr size_t WS_MIX = 634 * MiB;
constexpr size_t WS_OS = 666 * MiB;
constexpr size_t WS_TMP = 730 * MiB;
constexpr size_t WS_H2 = 472 * MiB;
constexpr size_t WS_H2F = 504 * MiB;
constexpr size_t WS_LOG = 568 * MiB;
constexpr size_t WS_ACT = 584 * MiB;
constexpr size_t WS_Y = 656 * MiB;
constexpr size_t WS_END = 944 * MiB;
constexpr int CW_COUNT = 1024;

__host__ __device__ __forceinline__ int perm32_log(int p) { return 16 * ((p >> 2) & 1) + 4 * (p >> 3) + (p & 3); }
__host__ __device__ __forceinline__ int perm64_log(int p) { return 32 * ((p >> 2) & 1) + 16 * (p >> 5) + 4 * ((p >> 3) & 3) + (p & 3); }
__host__ __device__ __forceinline__ int p1_logical(int p) {
    if (p < 384) return p;
    if (p < 416) return 384 + perm32_log(p - 384);
    if (p < 512) return -1;
    if (p < 1024) { int q = p - 512; return 416 + (q & ~63) + perm64_log(q & 63); }
    if (p < 1536) { int q = p - 1024; return 928 + (q & ~63) + perm64_log(q & 63); }
    return 1440 + (p - 1536);
}
__host__ __device__ __forceinline__ int qm_logical(int p) { int h = p / 96, r = p % 96; return h * 96 + (r < 64 ? r : 64 + perm32_log(r - 64)); }

struct Ptrs {
    const float* in[28]; float* out; unsigned char* ws;
};


#define GAS __attribute__((address_space(1)))
#define LAS __attribute__((address_space(3)))
typedef short bf16x8 __attribute__((ext_vector_type(8)));
typedef short s16x4 __attribute__((ext_vector_type(4)));
typedef float f32x4 __attribute__((ext_vector_type(4)));
typedef float f32x2 __attribute__((ext_vector_type(2)));
typedef float f32x16 __attribute__((ext_vector_type(16)));
typedef float f32x8 __attribute__((ext_vector_type(8)));
typedef unsigned u32x4 __attribute__((ext_vector_type(4)));
typedef unsigned u32x2 __attribute__((ext_vector_type(2)));
#define RLX_AGENT __ATOMIC_RELAXED, __HIP_MEMORY_SCOPE_AGENT
#define LDS_WAIT() asm volatile("s_waitcnt lgkmcnt(0)" ::: "memory")
#define VM_WAIT() asm volatile("s_waitcnt vmcnt(0)" ::: "memory")

constexpr size_t WS_MODP = 1 * MiB;
constexpr size_t WS_WIN = 4 * MiB;
constexpr size_t WS_WUP = 8 * MiB;
constexpr size_t WS_WOUT = 10 * MiB;
constexpr size_t WS_WR = 12 * MiB;
constexpr size_t WS_WCTX = 13 * MiB;
constexpr size_t WS_W13 = 16 * MiB;
constexpr size_t WS_W2 = 273 * MiB;
constexpr size_t WS_UT = WS_OFF + 4096;
static_assert(WS_W2 + (size_t)257 * 1024 * 256 * 2 <= WS_X1, "ws map");
constexpr size_t WS_LOGP = WS_Y;
constexpr int CW_NUNIT = 2048;
constexpr int CW_NFULL = 2049;
constexpr int CW_BAR = 4096;

typedef __bf16 bf16x2n_t __attribute__((ext_vector_type(2)));
typedef float f32x2n_t __attribute__((ext_vector_type(2)));
__device__ __forceinline__ unsigned cvt_pk_bf16(float lo, float hi) { const f32x2n_t v = {lo, hi}; return __builtin_bit_cast(unsigned, __builtin_convertvector(v, bf16x2n_t)); }
__device__ __forceinline__ unsigned pk2(float lo, float hi) { return f2bf(lo) | (f2bf(hi) << 16); }
__device__ __forceinline__ u32x4 pack8(f32x4 a, f32x4 b) { u32x4 w; w.x = cvt_pk_bf16(a[0], a[1]); w.y = cvt_pk_bf16(a[2], a[3]); w.z = cvt_pk_bf16(b[0], b[1]); w.w = cvt_pk_bf16(b[2], b[3]); return w; }
__device__ __forceinline__ float bflo(unsigned w) { return __builtin_bit_cast(float, w << 16); }
__device__ __forceinline__ float bfhi(unsigned w) { return __builtin_bit_cast(float, w & 0xffff0000u); }
__device__ __forceinline__ float wave_sum(float v) {
#pragma unroll
    for (int o = 1; o < 64; o <<= 1) v += __shfl_xor(v, o);
    return v;
}

namespace pg8 {
constexpr int BM = 256, BK = 64, HALF = 128, HTB = HALF * BK * 2, STAGE_BYTES = 8 * HTB;
__host__ __device__ __forceinline__ int lds_byte(int r, int c) { const int st = (r >> 4) * 2 + (c >> 5), rr = r & 15, cc = c & 31, ob = rr * 64 + cc * 2; return st * 1024 + (ob ^ (((ob >> 9) & 1) << 5)); }
__host__ __device__ __forceinline__ void stage_rc(int b, int& R, int& C) { const int st = b / 1024, sb = b % 1024, swz = sb ^ (((sb >> 9) & 1) << 5); R = (st >> 1) * 16 + swz / 64; C = (st & 1) * 32 + (swz % 64) / 2; }
__host__ __device__ __forceinline__ int perm32(int rho) { const int n = rho >> 4, i = rho & 15; return 8 * (i >> 2) + 4 * n + (i & 3); }

struct Unit { int pm, pn, r0, nv, k0; };
struct Gemm { const bf16* A; const bf16* Bt; int lda, ldb, K; };

struct StaticOrder {
    int nM, nN, nwg, G, c;
    __device__ void init(int M, int N, int G_, int c_) { nM = M / BM; nN = N / BM; nwg = nM * nN; G = G_; c = c_; }
    __device__ bool next(int i, Unit& u) const {
        const long L = (long)i * G + c; if (L >= nwg) return false;
        int wgid = (int)L; { const int q = nwg / 8, r = nwg % 8, xcd = wgid % 8, off = wgid / 8; wgid = (xcd < r ? xcd * (q + 1) : r * (q + 1) + (xcd - r) * q) + off; }
        const int nig = 8 * nN, gid = wgid / nig, fm = gid * 8, gsz = (nM - fm) < 8 ? (nM - fm) : 8;
        u.pm = fm + ((wgid % nig) % gsz); u.pn = (wgid % nig) / gsz; u.r0 = u.pm * BM; u.nv = BM; u.k0 = 0; return true;
    }
    __device__ __forceinline__ int a_row(const Unit& u, int r) const { return u.pm * BM + r; }
};

template <class Epi, class Sched>
__device__ __forceinline__ void gemm_phase(LAS unsigned char* lds, const Gemm g, const Sched& S, const Epi& E) {
    const int tid = threadIdx.x, wid = __builtin_amdgcn_readfirstlane(tid >> 6), lane = tid & 63, wr = wid >> 2, wc = wid & 3, fr = lane & 15, fq = lane >> 4;
    int K = g.K; asm volatile("" : "+s"(K));
    const int nt = K / BK;
    int RA[2], CA[2]; unsigned voffB[2];
#pragma unroll
    for (int i = 0; i < 2; ++i) { int R, C; stage_rc(tid * 16 + i * 8192, R, C); RA[i] = R; CA[i] = C; const int Rb = Epi::PERM ? ((R & ~31) + perm32(R & 31)) : R; voffB[i] = (unsigned)(Rb * g.ldb + C) * 2u; }
    const size_t kstep = (size_t)(BK * 2);
    const size_t hstepB = (size_t)HALF * g.ldb * 2, tstepB = 2 * hstepB;
    const unsigned ldsw = (unsigned)wid * 1024u;
    const int aoff = lds_byte(wr * 64 + fr, fq * 8), boff = lds_byte(wc * 32 + fr, fq * 8);
#define PG8_SA(b, h) (((b) * 2 + (h)) * HTB)
#define PG8_SB(b, h) ((4 + (b) * 2 + (h)) * HTB)
#define PG8_STAGE(bufoff, gbase, voff) do { _Pragma("unroll") for (int _i = 0; _i < 2; ++_i) \
        __builtin_amdgcn_global_load_lds((const unsigned*)((const char*)(gbase) + (voff)[_i]), (LAS unsigned*)(lds + (bufoff) + ldsw + _i * 8192), 16, 0, 0); } while (0)
#define PG8_LDA(dst, b, h) do { _Pragma("unroll") for (int m = 0; m < 4; ++m) _Pragma("unroll") for (int k = 0; k < 2; ++k) dst[m][k] = *(const LAS bf16x8*)(lds + PG8_SA(b, h) + aoff + m * 2048 + k * 1024); } while (0)
#define PG8_LDB(dst, b, h) do { _Pragma("unroll") for (int n = 0; n < 2; ++n) _Pragma("unroll") for (int k = 0; k < 2; ++k) dst[n][k] = *(const LAS bf16x8*)(lds + PG8_SB(b, h) + boff + n * 2048 + k * 1024); } while (0)
#define PG8_MMA(ai, bj, At, Bt) do { __builtin_amdgcn_s_setprio(1); _Pragma("unroll") for (int m = 0; m < 4; ++m) _Pragma("unroll") for (int n = 0; n < 2; ++n) _Pragma("unroll") for (int k = 0; k < 2; ++k) \
        acc[ai][bj][m][n] = __builtin_amdgcn_mfma_f32_16x16x32_bf16(Bt[n][k], At[m][k], acc[ai][bj][m][n], 0, 0, 0); __builtin_amdgcn_s_setprio(0); } while (0)
#define PG8_WAIT_V(n) asm volatile("s_waitcnt vmcnt(" #n ")" ::: "memory")
#define PG8_WAIT_L(n) asm volatile("s_waitcnt lgkmcnt(" #n ")" ::: "memory")
#define PG8_BAR __builtin_amdgcn_s_barrier()
#define PG8_SCHED __builtin_amdgcn_sched_barrier(0)
#define PG8_AOFFS(dst, u) do { _Pragma("unroll") for (int _h = 0; _h < 2; ++_h) _Pragma("unroll") for (int _i = 0; _i < 2; ++_i) \
        dst[_h][_i] = (unsigned)(((size_t)S.a_row(u, _h * HALF + RA[_i]) * (size_t)g.lda + (size_t)(CA[_i] + (u).k0)) * 2u); } while (0)
    Unit cur, nxt; int ui = 0;
    if (!S.next(0, cur)) return;
    f32x4 acc[2][2][4][2];
#pragma unroll
    for (int a = 0; a < 2; ++a)
#pragma unroll
        for (int b = 0; b < 2; ++b)
#pragma unroll
            for (int m = 0; m < 4; ++m)
#pragma unroll
                for (int n = 0; n < 2; ++n) acc[a][b][m][n] = (f32x4){0.f, 0.f, 0.f, 0.f};
    bf16x8 At[4][2], B0[2][2], B1[2][2];
    unsigned vA[2][2], vN[2][2];
    PG8_AOFFS(vA, cur);
    const char* Ab = (const char*)g.A; const char* cB = (const char*)g.Bt + (size_t)cur.pn * tstepB + (size_t)cur.k0 * 2;
    PG8_STAGE(PG8_SB(0, 0), cB, voffB); PG8_STAGE(PG8_SB(0, 1), cB + hstepB, voffB); PG8_STAGE(PG8_SA(0, 0), Ab, vA[0]); PG8_STAGE(PG8_SA(0, 1), Ab, vA[1]);
    if (wr == 1) PG8_BAR;
    PG8_WAIT_V(2); PG8_BAR;
    PG8_STAGE(PG8_SB(1, 0), cB + kstep, voffB); PG8_STAGE(PG8_SA(1, 0), Ab + kstep, vA[0]); PG8_STAGE(PG8_SB(1, 1), cB + hstepB + kstep, voffB);
    PG8_WAIT_V(6); PG8_BAR;
    for (;;) {
        const bool has_next = S.next(ui + 1, nxt);
        const char* nB = has_next ? (const char*)g.Bt + (size_t)nxt.pn * tstepB + (size_t)nxt.k0 * 2 : cB;
        if (has_next) { PG8_AOFFS(vN, nxt); } else { vN[0][0] = vA[0][0]; vN[0][1] = vA[0][1]; vN[1][0] = vA[1][0]; vN[1][1] = vA[1][1]; }
        for (int t = 0; t < nt; t += 2) {
            const bool last = (t == nt - 2); const bool full = cur.nv > HALF;
            const char* a1 = Ab + (size_t)(t + 1) * kstep;
            const char* a2 = Ab + (last ? (size_t)0 : (size_t)(t + 2) * kstep); const char* b2 = last ? nB : cB + (size_t)(t + 2) * kstep;
            const char* a3 = a2 + kstep; const char* b3 = b2 + kstep;
            unsigned w0[2], w1[2];
            w0[0] = last ? vN[0][0] : vA[0][0]; w0[1] = last ? vN[0][1] : vA[0][1]; w1[0] = last ? vN[1][0] : vA[1][0]; w1[1] = last ? vN[1][1] : vA[1][1];
            PG8_LDB(B0, 0, 0); PG8_LDB(B1, 0, 1); PG8_SCHED; PG8_LDA(At, 0, 0); PG8_STAGE(PG8_SA(1, 1), a1, vA[1]);
            PG8_WAIT_V(8); PG8_WAIT_L(0); PG8_BAR; PG8_MMA(0, 0, At, B0); PG8_MMA(0, 1, At, B1); PG8_BAR; PG8_SCHED;
            PG8_LDA(At, 0, 1); PG8_STAGE(PG8_SB(0, 0), b2, voffB); PG8_STAGE(PG8_SB(0, 1), b2 + hstepB, voffB); PG8_STAGE(PG8_SA(0, 0), a2, w0);
            PG8_WAIT_V(8); PG8_WAIT_L(0); PG8_BAR; if (full) { PG8_MMA(1, 0, At, B0); PG8_MMA(1, 1, At, B1); } PG8_BAR; PG8_SCHED;
            PG8_LDB(B0, 1, 0); PG8_LDB(B1, 1, 1); PG8_SCHED; PG8_LDA(At, 1, 0); PG8_STAGE(PG8_SA(0, 1), a2, w1);
            PG8_WAIT_V(8); PG8_WAIT_L(0); PG8_BAR; PG8_MMA(0, 0, At, B0); PG8_MMA(0, 1, At, B1); PG8_BAR; PG8_SCHED;
            PG8_LDA(At, 1, 1); PG8_STAGE(PG8_SB(1, 0), b3, voffB); PG8_STAGE(PG8_SB(1, 1), b3 + hstepB, voffB); PG8_STAGE(PG8_SA(1, 0), a3, w0);
            PG8_WAIT_V(8); PG8_WAIT_L(0); PG8_BAR; if (full) { PG8_MMA(1, 0, At, B0); PG8_MMA(1, 1, At, B1); } PG8_BAR; PG8_SCHED;
        }
        if (wr == 0) PG8_BAR;
        E(acc, cur, wr, wc, fr, fq);
        if (!has_next) break;
#pragma unroll
        for (int a = 0; a < 2; ++a)
#pragma unroll
            for (int b = 0; b < 2; ++b)
#pragma unroll
                for (int m = 0; m < 4; ++m)
#pragma unroll
                    for (int n = 0; n < 2; ++n) acc[a][b][m][n] = (f32x4){0.f, 0.f, 0.f, 0.f};
        cur = nxt; cB = nB; ++ui;
        vA[0][0] = vN[0][0]; vA[0][1] = vN[0][1]; vA[1][0] = vN[1][0]; vA[1][1] = vN[1][1];
        if (wr == 1) PG8_BAR;
    }
    PG8_WAIT_V(0);
    PG8_BAR;
#undef PG8_SA
#undef PG8_SB
#undef PG8_STAGE
#undef PG8_LDA
#undef PG8_LDB
#undef PG8_MMA
#undef PG8_WAIT_V
#undef PG8_WAIT_L
#undef PG8_BAR
#undef PG8_SCHED
#undef PG8_AOFFS
}
}

using pg8::Unit;
typedef f32x4 Acc[2][2][4][2];

struct EpiInProj {
    static constexpr bool PERM = true;
    bf16* P1; float* SSQ; const float2* TD; const float2* TM;
    __device__ __forceinline__ void operator()(const Acc& acc, const Unit& u, int wr, int wc, int fr, int fq) const {
        const int pm = u.pm, pn = u.pn, jt = pm % 17; const bool lat = jt > 0;
        const int row0 = pm * 256 + wr * 64 + fr, col0 = pn * 256 + wc * 32 + 8 * fq;
        if (pn == 0 || pn >= 6 || (pn == 1)) {
#pragma unroll
            for (int ai = 0; ai < 2; ++ai)
#pragma unroll
                for (int m = 0; m < 4; ++m) {
                    const int r = row0 + ai * 128 + m * 16; bf16* rowp = P1 + (size_t)r * NP1 + col0;
                    *(u32x4*)(rowp) = pack8(acc[ai][0][m][0], acc[ai][0][m][1]);
                    if (pn != 1) *(u32x4*)(rowp + 128) = pack8(acc[ai][1][m][0], acc[ai][1][m][1]);
                    if (pn <= 1) {
                        float s = 0.f;
#pragma unroll
                        for (int bj = 0; bj < 2; ++bj) { if (pn == 1 && bj == 1) break;
#pragma unroll
                            for (int n = 0; n < 2; ++n) { const f32x4 x = acc[ai][bj][m][n]; s += (x[0] * x[0] + x[1] * x[1]) + (x[2] * x[2] + x[3] * x[3]); } }
                        s += __shfl_xor(s, 16); s += __shfl_xor(s, 32);
                        if (fq == 0) SSQ[(size_t)r * 8 + pn * 4 + wc] = s;
                    }
                    if (pn == 1 && wc == 0) {
                        f32x4 x1 = acc[ai][1][m][0], x2 = acc[ai][1][m][1], o1 = x1, o2 = x2;
                        if (lat) { const int gr = (jt - 1) * 4 + 2 * ai + wr, gc = 16 * m + fr;
                            const float2* tp = TM + (fq < 2 ? gr * 8 + 4 * fq : gc * 8 + 4 * (fq - 2));
                            const f32x4 t0 = *(const f32x4*)tp, t1 = *(const f32x4*)(tp + 2);
                            const f32x4 cs = {t0[0], t0[2], t1[0], t1[2]}, sn = {t0[1], t0[3], t1[1], t1[3]};
                            o1 = x1 * cs - x2 * sn; o2 = x1 * sn + x2 * cs; }
                        *(u32x4*)(rowp + 128) = pack8(o1, o2);
                    }
                }
        } else {
            const int g = wc & 1; const float qs = pn < 4 ? 0.125f * 1.4426950408889634f : 1.f;
#pragma unroll
            for (int ai = 0; ai < 2; ++ai) {
                const int gr = (jt - 1) * 4 + 2 * ai + wr;
#pragma unroll
                for (int m = 0; m < 4; ++m) {
                    const int r = row0 + ai * 128 + m * 16; bf16* rowp = P1 + (size_t)r * NP1 + col0;
                    f32x4 cs = {1.f, 1.f, 1.f, 1.f}, sn = {0.f, 0.f, 0.f, 0.f};
                    if (lat) { const int gc = 16 * m + fr; const float2* tp = TD + (g == 0 ? gr : gc) * 16 + 4 * fq;
                        const f32x4 t0 = *(const f32x4*)tp, t1 = *(const f32x4*)(tp + 2);
                        cs = (f32x4){t0[0], t0[2], t1[0], t1[2]}; sn = (f32x4){t0[1], t0[3], t1[1], t1[3]}; }
#pragma unroll
                    for (int bj = 0; bj < 2; ++bj) { const f32x4 x1 = acc[ai][bj][m][0] * qs, x2 = acc[ai][bj][m][1] * qs;
                        *(u32x4*)(rowp + bj * 128) = pack8(x1 * cs - x2 * sn, x1 * sn + x2 * cs); }
                }
            }
        }
    }
};

struct EpiUp {
    static constexpr bool PERM = true;
    bf16* QM; bf16* KVM; const float* SSQ; const float2* TM;
    __device__ __forceinline__ void operator()(const Acc& acc, const Unit& u, int wr, int wc, int fr, int fq) const {
        const int pm = u.pm, pn = u.pn, jt = pm % 17; const bool lat = jt > 0, isq = pn < 3;
        const int row0 = pm * 256 + wr * 64 + fr, col0 = pn * 256 + wc * 32 + 8 * fq;
#pragma unroll
        for (int ai = 0; ai < 2; ++ai)
#pragma unroll
            for (int m = 0; m < 4; ++m) {
                const int r = row0 + ai * 128 + m * 16;
                const f32x4 sq = *(const f32x4*)(SSQ + (size_t)r * 8 + (isq ? 0 : 4));
                const float rs = rsqrtf(((sq[0] + sq[1]) + (sq[2] + sq[3])) * (isq ? 1.f / 256.f : 1.f / 128.f) + EPS) * (isq ? 0.10206207261596575f * 1.4426950408889634f : 1.f);
#pragma unroll
                for (int bj = 0; bj < 2; ++bj) {
                    f32x4 x1 = acc[ai][bj][m][0] * rs, x2 = acc[ai][bj][m][1] * rs;
                    if (isq) {
                        const int G = 8 * pn + 4 * bj + wc;
                        if (lat && (G % 3) == 2) { const int gr = (jt - 1) * 4 + 2 * ai + wr, gc = 16 * m + fr;
                            const float2* tp = TM + (fq < 2 ? gr * 8 + 4 * fq : gc * 8 + 4 * (fq - 2));
                            const f32x4 t0 = *(const f32x4*)tp, t1 = *(const f32x4*)(tp + 2);
                            const f32x4 cs = {t0[0], t0[2], t1[0], t1[2]}, sn = {t0[1], t0[3], t1[1], t1[3]};
                            const f32x4 o1 = x1 * cs - x2 * sn, o2 = x1 * sn + x2 * cs; x1 = o1; x2 = o2; }
                        *(u32x4*)(QM + (size_t)r * 768 + col0 + bj * 128) = pack8(x1, x2);
                    } else *(u32x4*)(KVM + (size_t)r * 1024 + (col0 - 768) + bj * 128) = pack8(x1, x2);
                }
            }
    }
};

struct EpiOut {
    static constexpr bool PERM = true;
    const float* x; const float* MOD; bf16* X1;
    __device__ __forceinline__ void operator()(const Acc& acc, const Unit& u, int wr, int wc, int fr, int fq) const {
        const int b = u.pm / 16; const float* gt = MOD + b * 6144 + 2048;
        const int row0 = u.pm * 256 + wr * 64 + fr, col0 = u.pn * 256 + wc * 32 + 8 * fq;
        f32x4 gv[2][2];
#pragma unroll
        for (int bj = 0; bj < 2; ++bj)
#pragma unroll
            for (int n = 0; n < 2; ++n) gv[bj][n] = *(const f32x4*)(gt + col0 + bj * 128 + n * 4);
#pragma unroll
        for (int ai = 0; ai < 2; ++ai)
#pragma unroll
            for (int m = 0; m < 4; ++m) { const size_t off = (size_t)(row0 + ai * 128 + m * 16) * DM + col0;
#pragma unroll
                for (int bj = 0; bj < 2; ++bj) { const f32x4 x0 = *(const f32x4*)(x + off + bj * 128), x1 = *(const f32x4*)(x + off + bj * 128 + 4);
                    *(u32x4*)(X1 + off + bj * 128) = pack8(x0 + gv[bj][0] * acc[ai][bj][m][0], x1 + gv[bj][1] * acc[ai][bj][m][1]); } }
    }
};
struct EpiF32 {
    static constexpr bool PERM = false;
    float* O; int ldc;
    __device__ __forceinline__ void operator()(const Acc& acc, const Unit& u, int wr, int wc, int fr, int fq) const {
        const int row0 = u.pm * 256 + wr * 64 + fr, col0 = u.pn * 256 + wc * 32 + 4 * fq;
#pragma unroll
        for (int ai = 0; ai < 2; ++ai)
#pragma unroll
            for (int m = 0; m < 4; ++m) { const size_t off = (size_t)(row0 + ai * 128 + m * 16) * ldc + col0;
#pragma unroll
                for (int bj = 0; bj < 2; ++bj)
#pragma unroll
                    for (int n = 0; n < 2; ++n) *(f32x4*)(O + off + bj * 128 + n * 16) = acc[ai][bj][m][n]; }
    }
};
struct EpiAct {
    static constexpr bool PERM = true;
    bf16* ACT; const float* SW;
    __device__ __forceinline__ void operator()(const Acc& acc, const Unit& u, int wr, int wc, int fr, int fq) const {
        const int half = u.pn & 1, colb = half * 128 + wc * 32 + 8 * fq;
#pragma unroll
        for (int ai = 0; ai < 2; ++ai)
#pragma unroll
            for (int m = 0; m < 4; ++m) { const int tr = ai * 128 + wr * 64 + m * 16 + fr;
                f32x4 a[2];
#pragma unroll
                for (int n = 0; n < 2; ++n) { const f32x4 gt = acc[ai][0][m][n], up = acc[ai][1][m][n];
#pragma unroll
                    for (int e = 0; e < 4; ++e) a[n][e] = gt[e] * __builtin_amdgcn_rcpf(1.f + __expf(-gt[e])) * up[e]; }
                if (tr < u.nv) { const float w = SW[u.r0 + tr]; *(u32x4*)(ACT + (size_t)(u.r0 + tr) * EFF + colb) = pack8(a[0] * w, a[1] * w); } }
    }
};
constexpr float YSCALE = 32.f;
__device__ __forceinline__ unsigned pk4_fp8(f32x4 v) { int w = 0; w = __builtin_amdgcn_cvt_pk_fp8_f32(v[0], v[1], w, false); w = __builtin_amdgcn_cvt_pk_fp8_f32(v[2], v[3], w, true); return (unsigned)w; }
struct EpiY {
    static constexpr bool PERM = true;
    unsigned char* Y;
    __device__ __forceinline__ void operator()(const Acc& acc, const Unit& u, int wr, int wc, int fr, int fq) const {
        const int colb = (u.pn & 3) * 256 + wc * 64 + 16 * fq;
#pragma unroll
        for (int ai = 0; ai < 2; ++ai)
#pragma unroll
            for (int m = 0; m < 4; ++m) { const int tr = ai * 128 + wr * 64 + m * 16 + fr;
                if (tr < u.nv) { u32x4 w; w.x = pk4_fp8(acc[ai][0][m][0] * YSCALE); w.y = pk4_fp8(acc[ai][0][m][1] * YSCALE); w.z = pk4_fp8(acc[ai][1][m][0] * YSCALE); w.w = pk4_fp8(acc[ai][1][m][1] * YSCALE);
                    *(u32x4*)(Y + (size_t)(u.r0 + tr) * DM + colb) = w; } }
    }
};

template <int SUB, bool GATHER> struct ExpSched {
    const LAS int* uc; int nmine; const int* slot_tok;
    __device__ bool next(int i, Unit& u) const {
        if (i >= nmine) return false;
        const int e = __builtin_amdgcn_readfirstlane(uc[i * 4 + 0]), r0 = __builtin_amdgcn_readfirstlane(uc[i * 4 + 1]);
        const int nv = __builtin_amdgcn_readfirstlane(uc[i * 4 + 2]), sub = __builtin_amdgcn_readfirstlane(uc[i * 4 + 3]);
        u.pm = 0; u.pn = e * SUB + sub; u.r0 = r0; u.nv = nv; u.k0 = 0; return true;
    }
    __device__ __forceinline__ int a_row(const Unit& u, int r) const {
        if (GATHER) return r < u.nv ? slot_tok[u.r0 + r] : 0;
        const int s = u.r0 + r; return s < NSLOT ? s : NSLOT - 1;
    }
};
template <int SUB> __device__ __forceinline__ int exp_units_to_lds(LAS int* uc, const int* ut, int nunit, int nfull, int G, int c) {
    const int NF = nfull * SUB, NH = (nunit - nfull) * SUB, cr = G - 1 - c, nlight = (NF % G) ? G - NF % G : 0;
    const int mf = c < NF ? (NF - 1 - c) / G + 1 : 0;
    const int h0 = (cr < nlight && cr < NH) ? 1 : 0;
    const int NH2 = NH > nlight ? NH - nlight : 0, mh = cr < NH2 ? (NH2 - 1 - cr) / G + 1 : 0;
    const int t = threadIdx.x;
    if (t < mf + h0 + mh && t < 64) { const int L = t < mf ? t * G + c : (t < mf + h0 ? NF + cr : NF + nlight + (t - mf - h0) * G + cr); const int cu = L / SUB;
        uc[t * 4 + 0] = ut[cu * 4 + 0]; uc[t * 4 + 1] = ut[cu * 4 + 1]; uc[t * 4 + 2] = ut[cu * 4 + 2]; uc[t * 4 + 3] = L % SUB; }
    __syncthreads();
    return mf + h0 + mh < 64 ? mf + h0 + mh : 64;
}
struct LatOrder : pg8::StaticOrder {
    __device__ bool next(int i, Unit& u) const { if (!pg8::StaticOrder::next(i, u)) return false; u.pm += (u.pm >> 4) + 1; u.r0 = u.pm * 256; return true; }
};
struct RouterOrder {
    int G, c;
    __device__ bool next(int i, Unit& u) const { const int L = i * G + c; if (L >= 256) return false; u.pm = L >> 2; u.pn = 0; u.r0 = u.pm * 256; u.nv = 256; u.k0 = (L & 3) * 256; return true; }
    __device__ __forceinline__ int a_row(const Unit& u, int r) const { return u.pm * 256 + r; }
};
struct UpOrder {
    int G, c;
    __device__ bool next(int i, Unit& u) const { const int L = i * G + c; if (L >= 68 * 7) return false; u.pm = L / 7; u.pn = L % 7; u.r0 = u.pm * 256; u.nv = 256; u.k0 = u.pn < 3 ? 0 : 128; return true; }
    __device__ __forceinline__ int a_row(const Unit& u, int r) const { return u.pm * 256 + r; }
};
struct EpiLogP {
    static constexpr bool PERM = false;
    float* O;
    __device__ __forceinline__ void operator()(const Acc& acc, const Unit& u, int wr, int wc, int fr, int fq) const {
        float* base = O + (size_t)(u.k0 >> 8) * MLAT * NEXP;
        const int row0 = u.pm * 256 + wr * 64 + fr, col0 = wc * 32 + 4 * fq;
#pragma unroll
        for (int ai = 0; ai < 2; ++ai)
#pragma unroll
            for (int m = 0; m < 4; ++m) { const size_t off = (size_t)(row0 + ai * 128 + m * 16) * NEXP + col0;
#pragma unroll
                for (int bj = 0; bj < 2; ++bj)
#pragma unroll
                    for (int n = 0; n < 2; ++n) *(f32x4*)(base + off + bj * 128 + n * 16) = acc[ai][bj][m][n]; }
    }
};

namespace attn {
#define SBAR() __builtin_amdgcn_sched_barrier(0)
constexpr float THR = 8.f;
template <int MODE> struct Cfg;
template <> struct Cfg<0> { static constexpr int DQK = 96, DV = 64, LDQ = 768, LDK0 = 1024, LDK1 = 2048, LDV = 1024; static constexpr float SCALE = 0.10206207261596575f; };
template <> struct Cfg<1> { static constexpr int DQK = 64, DV = 128, LDQ = 2048, LDK0 = 2048, LDK1 = 2048, LDV = 2048; static constexpr float SCALE = 0.125f; };
__device__ __forceinline__ int crow(int r, int hi) { return (r & 3) + 8 * (r >> 2) + 4 * hi; }
typedef __bf16 bf16x2n __attribute__((ext_vector_type(2)));
typedef float f32x2n __attribute__((ext_vector_type(2)));
__device__ __forceinline__ unsigned cvtpk(float lo, float hi) { const f32x2n v = {lo, hi}; return __builtin_bit_cast(unsigned, __builtin_convertvector(v, bf16x2n)); }

constexpr float THR2 = 11.5f;
__device__ __forceinline__ float max3f(float a, float b, float c) { return __builtin_fmaxf(__builtin_fmaxf(a, b), c); }
template <int ABL = 0> __device__ __forceinline__ void partialSM(f32x16& p0, f32x16& p1, float& m_reg, float& alpha, bool first) {
    float a = max3f(p0[0], p0[1], p1[0]), b = max3f(p0[2], p0[3], p1[1]); a = max3f(a, p1[2], p1[3]);
#pragma unroll
    for (int r = 4; r < 16; r += 4) { a = max3f(a, p0[r], p0[r + 1]); b = max3f(b, p0[r + 2], p0[r + 3]); a = max3f(a, p1[r], p1[r + 1]); b = max3f(b, p1[r + 2], p1[r + 3]); }
    float pmax = __builtin_fmaxf(a, b);
    if (ABL == 7) pmax = p0[0];
    { auto rr = __builtin_amdgcn_permlane32_swap(__float_as_uint(pmax), __float_as_uint(pmax), false, false);
      pmax = __builtin_fmaxf(__uint_as_float(rr[0]), __uint_as_float(rr[1])); }
    alpha = 1.f;
    if (__builtin_expect(first || __any(pmax > THR2), 0)) {
        const float dl = first ? pmax : __builtin_fmaxf(pmax, 0.f);
        m_reg += dl; alpha = first ? 1.f : __builtin_amdgcn_exp2f(-dl);
#pragma unroll
        for (int r = 0; r < 16; ++r) { p0[r] -= dl; p1[r] -= dl; }
    }
#pragma unroll
    for (int r = 0; r < 16; ++r) p0[r] = ABL == 1 ? p0[r] * 0.5f : __builtin_amdgcn_exp2f(p0[r]);
}
template <int ABL = 0> __device__ __forceinline__ void finishSM(f32x16& p0, f32x16& p1, float alpha, float& l_reg, bf16x8& pa0, bf16x8& pa1, bf16x8& pa2, bf16x8& pa3) {
#pragma unroll
    for (int r = 0; r < 16; ++r) p1[r] = ABL == 1 ? p1[r] * 0.5f : __builtin_amdgcn_exp2f(p1[r]);
    float ps = 0;
    if (ABL == 2) ps = p0[0] + p1[15]; else {
        float s0 = p0[0] + p0[4], s1 = p0[1] + p0[5], s2 = p0[2] + p0[6], s3 = p0[3] + p0[7];
        s0 += p0[8]; s1 += p0[9]; s2 += p0[10]; s3 += p0[11]; s0 += p0[12]; s1 += p0[13]; s2 += p0[14]; s3 += p0[15];
#pragma unroll
        for (int r = 0; r < 16; r += 4) { s0 += p1[r]; s1 += p1[r + 1]; s2 += p1[r + 2]; s3 += p1[r + 3]; }
        ps = (s0 + s1) + (s2 + s3); }
    { auto rr = __builtin_amdgcn_permlane32_swap(__float_as_uint(ps), __float_as_uint(ps), false, false);
      ps = __uint_as_float(rr[0]) + __uint_as_float(rr[1]); }
    l_reg = l_reg * alpha + ps;
#define PK4(P, BASE, OUT) do { u32x4 w = {cvtpk(P[BASE + 0], P[BASE + 1]), cvtpk(P[BASE + 2], P[BASE + 3]), cvtpk(P[BASE + 4], P[BASE + 5]), cvtpk(P[BASE + 6], P[BASE + 7])}; OUT = *reinterpret_cast<bf16x8*>(&w); } while (0)
    PK4(p0, 0, pa0); PK4(p0, 8, pa1); PK4(p1, 0, pa2); PK4(p1, 8, pa3);
#undef PK4
}
template <int NQ, int KROW, int ABL = 0> __device__ __forceinline__ void qkt(f32x16& p0, f32x16& p1, const LAS char* Ks, const bf16x8* qr, float m_ref, int r32, int hi) {
    f32x16 negm;
#pragma unroll
    for (int r = 0; r < 16; ++r) negm[r] = -m_ref;
    p0 = negm; p1 = negm;
#pragma unroll
    for (int d0 = 0; d0 < NQ; ++d0) { const int cb = d0 * 32 + hi * 16;
        const bf16x8 b0 = *(const LAS bf16x8*)(Ks + r32 * KROW + cb);
        const bf16x8 b1 = *(const LAS bf16x8*)(Ks + (32 + r32) * KROW + cb);
        if (ABL == 4) { asm volatile("" :: "v"(b0), "v"(b1)); } else {
        p0 = __builtin_amdgcn_mfma_f32_32x32x16_bf16(b0, qr[d0], p0, 0, 0, 0);
        p1 = __builtin_amdgcn_mfma_f32_32x32x16_bf16(b1, qr[d0], p1, 0, 0, 0); } }
}
template <int NC> __device__ __forceinline__ int v_st(int k, int c) { const int kk = k; return ((kk >> 3) * NC + (c >> 5)) * 512 + ((kk & 7) * 32 + (c & 31)) * 2; }
__device__ __forceinline__ int v_rd_base(int lane) { return ((lane & 3) << 3) | (((lane >> 2) & 3) << 6) | (((lane >> 4) & 1) << 5) | (((lane >> 5) & 1) << 8); }
template <int OFF> __device__ __forceinline__ s16x4 tr_read(int vb) {
    s16x4 r; asm volatile("ds_read_b64_tr_b16 %0, %1 offset:%2" : "=&v"(r) : "v"(vb), "i"(OFF) : "memory"); return r;
}
template <int NC, int D0, int ABL = 0> __device__ __forceinline__ void pv_one(f32x16& od, int vb, bf16x8 pa0, bf16x8 pa1, bf16x8 pa2, bf16x8 pa3) {
#define VOFF(ks, half) (D0 * 512 + (ks) * (NC * 1024) + (half) * (NC * 512))
    const s16x4 l0 = tr_read<VOFF(0, 0)>(vb), h0 = tr_read<VOFF(0, 1)>(vb), l1 = tr_read<VOFF(1, 0)>(vb), h1 = tr_read<VOFF(1, 1)>(vb);
    const s16x4 l2 = tr_read<VOFF(2, 0)>(vb), h2 = tr_read<VOFF(2, 1)>(vb), l3 = tr_read<VOFF(3, 0)>(vb), h3 = tr_read<VOFF(3, 1)>(vb);
#undef VOFF
    asm volatile("s_waitcnt lgkmcnt(0)" ::: "memory"); SBAR();
#define PK(L, H) (bf16x8){L[0], L[1], L[2], L[3], H[0], H[1], H[2], H[3]}
    if (ABL == 3) { asm volatile("" :: "v"(l0), "v"(h0), "v"(l1), "v"(h1), "v"(l2), "v"(h2), "v"(l3), "v"(h3)); return; }
    od = __builtin_amdgcn_mfma_f32_32x32x16_bf16(pa0, PK(l0, h0), od, 0, 0, 0);
    od = __builtin_amdgcn_mfma_f32_32x32x16_bf16(pa1, PK(l1, h1), od, 0, 0, 0);
    od = __builtin_amdgcn_mfma_f32_32x32x16_bf16(pa2, PK(l2, h2), od, 0, 0, 0);
    od = __builtin_amdgcn_mfma_f32_32x32x16_bf16(pa3, PK(l3, h3), od, 0, 0, 0);
#undef PK
}
template <int NC, int ABL = 0> __device__ __forceinline__ void pv_all(f32x16* o, int vb, bf16x8 pa0, bf16x8 pa1, bf16x8 pa2, bf16x8 pa3) {
    pv_one<NC, 0, ABL>(o[0], vb, pa0, pa1, pa2, pa3); pv_one<NC, 1, ABL>(o[1], vb, pa0, pa1, pa2, pa3);
    if constexpr (NC == 4) { pv_one<NC, 2, ABL>(o[2], vb, pa0, pa1, pa2, pa3); pv_one<NC, 3, ABL>(o[3], vb, pa0, pa1, pa2, pa3); }
}
template <int MODE> constexpr int lds_bytes() { return 4 * (64 * Cfg<MODE>::DV * 2 + 2 * (Cfg<MODE>::DQK / 16) * 1024) + 8 * 64 * 4; }

template <int MODE, int EPI, int ABL = 0>
__device__ __forceinline__ void unit_regs(const bf16* __restrict__ Qb, const bf16* __restrict__ K0, const bf16* __restrict__ K1, const bf16* __restrict__ Vh, void* Ob, int ldo, LAS char* lds, char* stash, float lam, const float* gsub) {
    using C = Cfg<MODE>;
    constexpr int DQK = C::DQK, DV = C::DV, NQ = DQK / 16, NC = DV / 32, KROW = DQK * 2 + 16, SHM_K = 64 * KROW, SHM_V = 64 * DV * 2;
    const int tid = threadIdx.x, wid = tid >> 6, lane = tid & 63, r32 = lane & 31, hi = lane >> 5;
    LAS char* V_lds = lds; LAS char* K_lds = lds + 3 * SHM_V;
    LAS float* ws = (LAS float*)(lds + 3 * SHM_V + 3 * SHM_K) + wid * 64; LAS float* li_l = ws; LAS float* al_l = ws + 32;
    float m_reg = 0.f, l_reg = 0; f32x16 o[NC]; bf16x8 qr[NQ];
#pragma unroll
    for (int d = 0; d < NC; ++d) o[d] = f32x16{};
    const bf16* Qw = Qb + (size_t)(wid * 32 + r32) * C::LDQ + hi * 8;
#pragma unroll
    for (int d0 = 0; d0 < NQ; ++d0) qr[d0] = *reinterpret_cast<const bf16x8*>(Qw + d0 * 16);
    const int vb0 = (int)(uintptr_t)V_lds + v_rd_base(lane);
    const int kr0 = tid >> 3, kc0 = tid & 7;
    const int krr = (tid & 255) >> 2, krc = tid & 3;
    const int vr0 = MODE == 0 ? (tid >> 3) : (tid >> 4), vc0 = MODE == 0 ? (tid & 7) * 8 : (tid & 15) * 8;
    const int vst0 = v_st<NC>(vr0, vc0), vst1 = v_st<NC>(32 + vr0, vc0);
    constexpr int NSET = MODE == 0 ? 2 : 1;
    struct { bf16x8 ka, kb, va, vb; } sr_[NSET];
#define SLOAD(i, k0) do { sr_[i].ka = *reinterpret_cast<const bf16x8*>(K0 + (size_t)((k0) + kr0) * C::LDK0 + kc0 * 8); \
        if (MODE == 0) { sr_[i].kb = *reinterpret_cast<const bf16x8*>(K1 + (size_t)((k0) + krr) * C::LDK1 + krc * 8); } \
        sr_[i].va = *reinterpret_cast<const bf16x8*>(Vh + (size_t)((k0) + vr0) * C::LDV + vc0); \
        if (MODE == 1) { sr_[i].vb = *reinterpret_cast<const bf16x8*>(Vh + (size_t)((k0) + 32 + vr0) * C::LDV + vc0); } } while (0)
#define SWRITE(ko, vo, i) do { *(LAS bf16x8*)(K_lds + (ko) + kr0 * KROW + kc0 * 16) = sr_[i].ka; \
        if (MODE == 0) { *(LAS bf16x8*)(K_lds + (ko) + krr * KROW + 128 + krc * 16) = sr_[i].kb; } \
        *(LAS bf16x8*)(V_lds + (vo) + vst0) = sr_[i].va; \
        if (MODE == 1) { *(LAS bf16x8*)(V_lds + (vo) + vst1) = sr_[i].vb; } } while (0)
#define SWAIT() do { if (NSET == 2) asm volatile("s_waitcnt vmcnt(3)" ::: "memory"); } while (0)
#define RESC(a) do { if (__any((a) < 1.f)) { if (hi == 0) al_l[r32] = (a); asm volatile("s_waitcnt lgkmcnt(0)" ::: "memory"); \
        _Pragma("unroll") for (int d = 0; d < NC; ++d) _Pragma("unroll") for (int r = 0; r < 16; ++r) o[d][r] *= al_l[crow(r, hi)]; } } while (0)
    f32x16 pA0, pA1, pB0, pB1; float alA = 1.f, alB = 1.f; bf16x8 pa0, pa1, pa2, pa3; constexpr int NT = NTOK / 64;
#define STEP(PC0, PC1, ALC, PP0, PP1, ALP, jj, SQ, SV, SW) do { constexpr int SETN = ((jj##_c) + 1) % NSET; \
        if (ABL != 6 && (jj) + 1 < NT) { SWAIT(); SWRITE((SW) * SHM_K, (SW) * SHM_V, SETN); } \
        SBAR(); qkt<NQ, KROW, ABL>(PC0, PC1, K_lds + (SQ) * SHM_K, qr, m_reg, r32, hi); \
        finishSM<ABL>(PP0, PP1, ALP, l_reg, pa0, pa1, pa2, pa3); SBAR(); \
        if (ABL != 6 && (jj) + 1 + NSET < NT) SLOAD(SETN, ((jj) + 1 + NSET) * 64); SBAR(); \
        pv_all<NC, ABL>(o, vb0 + (SV) * SHM_V, pa0, pa1, pa2, pa3); partialSM<ABL>(PC0, PC1, m_reg, ALC, false); \
        RESC(ALC); if (ABL != 5) __syncthreads(); } while (0)
    static_assert((NT - 2) % 6 == 0, "tile count: steps 1..NT-2 in groups of 6");
    SLOAD(0, 0); asm volatile("s_waitcnt vmcnt(0)" ::: "memory"); SWRITE(0, 0, 0);
    SLOAD(1 % NSET, 64); if (NSET == 2) SLOAD(0, 128); __syncthreads();
    SWAIT(); SWRITE(SHM_K, SHM_V, 1 % NSET);
    qkt<NQ, KROW>(pA0, pA1, K_lds, qr, m_reg, r32, hi);
    SLOAD(1 % NSET, (1 + NSET) * 64);
    partialSM(pA0, pA1, m_reg, alA, true);
    __syncthreads();
    for (int j = 1; j + 1 < NT; j += 6) {
        constexpr int j_c = 1, j1_c = 2, j2_c = 3, j3_c = 4, j4_c = 5, j5_c = 6; const int j1 = j + 1, j2 = j + 2, j3 = j + 3, j4 = j + 4, j5 = j + 5;
        STEP(pB0, pB1, alB, pA0, pA1, alA, j,  1, 0, 2);
        STEP(pA0, pA1, alA, pB0, pB1, alB, j1, 2, 1, 0);
        STEP(pB0, pB1, alB, pA0, pA1, alA, j2, 0, 2, 1);
        STEP(pA0, pA1, alA, pB0, pB1, alB, j3, 1, 0, 2);
        STEP(pB0, pB1, alB, pA0, pA1, alA, j4, 2, 1, 0);
        STEP(pA0, pA1, alA, pB0, pB1, alB, j5, 0, 2, 1);
    }
    { constexpr int jt_c = NT - 1; const int jt = NT - 1;
      STEP(pB0, pB1, alB, pA0, pA1, alA, jt, (NT - 1) % 3, (NT - 2) % 3, NT % 3); }
    finishSM(pB0, pB1, alB, l_reg, pa0, pa1, pa2, pa3); SBAR();
    pv_all<NC>(o, vb0 + ((NT - 1) % 3) * SHM_V, pa0, pa1, pa2, pa3);
#undef STEP
    if (hi == 0) li_l[r32] = l_reg; asm volatile("s_waitcnt lgkmcnt(0)" ::: "memory");
    float rli[16];
#pragma unroll
    for (int r = 0; r < 16; ++r) rli[r] = __builtin_amdgcn_rcpf(li_l[crow(r, hi)]);
    asm volatile("" : "+s"(ldo), "+s"(stash), "+s"(gsub), "+s"(Ob));
    if constexpr (MODE == 0) {
#pragma unroll
        for (int r = 0; r < 16; ++r) { const int orow = wid * 32 + crow(r, hi);
#pragma unroll
            for (int d0 = 0; d0 < NC; ++d0) ((bf16*)Ob)[(size_t)orow * ldo + d0 * 32 + r32] = (bf16)f2bf(o[d0][r] * rli[r]); }
    } else if constexpr (EPI == 1) {
        char* st = stash + wid * 8192 + lane * 16;
#pragma unroll
        for (int d0 = 0; d0 < NC; ++d0)
#pragma unroll
            for (int q = 0; q < 2; ++q) { u32x4 w;
                w.x = cvtpk(o[d0][8 * q + 0] * rli[8 * q + 0], o[d0][8 * q + 1] * rli[8 * q + 1]); w.y = cvtpk(o[d0][8 * q + 2] * rli[8 * q + 2], o[d0][8 * q + 3] * rli[8 * q + 3]);
                w.z = cvtpk(o[d0][8 * q + 4] * rli[8 * q + 4], o[d0][8 * q + 5] * rli[8 * q + 5]); w.w = cvtpk(o[d0][8 * q + 6] * rli[8 * q + 6], o[d0][8 * q + 7] * rli[8 * q + 7]);
                *(u32x4*)(st + (d0 * 2 + q) * 1024) = w; }
        asm volatile("s_waitcnt vmcnt(0)" ::: "memory");
    } else {
        const char* st = stash + wid * 8192 + lane * 16;
#pragma unroll
        for (int d0 = 0; d0 < NC; ++d0) {
            const u32x4 wa = *(const u32x4*)(st + (d0 * 2 + 0) * 1024), wb = *(const u32x4*)(st + (d0 * 2 + 1) * 1024);
            f32x16 od;
            od[0] = __builtin_bit_cast(float, wa.x << 16); od[1] = __builtin_bit_cast(float, wa.x & 0xffff0000u); od[2] = __builtin_bit_cast(float, wa.y << 16); od[3] = __builtin_bit_cast(float, wa.y & 0xffff0000u);
            od[4] = __builtin_bit_cast(float, wa.z << 16); od[5] = __builtin_bit_cast(float, wa.z & 0xffff0000u); od[6] = __builtin_bit_cast(float, wa.w << 16); od[7] = __builtin_bit_cast(float, wa.w & 0xffff0000u);
            od[8] = __builtin_bit_cast(float, wb.x << 16); od[9] = __builtin_bit_cast(float, wb.x & 0xffff0000u); od[10] = __builtin_bit_cast(float, wb.y << 16); od[11] = __builtin_bit_cast(float, wb.y & 0xffff0000u);
            od[12] = __builtin_bit_cast(float, wb.z << 16); od[13] = __builtin_bit_cast(float, wb.z & 0xffff0000u); od[14] = __builtin_bit_cast(float, wb.w << 16); od[15] = __builtin_bit_cast(float, wb.w & 0xffff0000u);
#pragma unroll
            for (int r = 0; r < 16; ++r) od[r] -= lam * (o[d0][r] * rli[r]);
            o[d0] = od;
        }
        f32x16 ssv;
#pragma unroll
        for (int r = 0; r < 16; ++r) { float x = 0.f;
#pragma unroll
            for (int d0 = 0; d0 < NC; ++d0) x += o[d0][r] * o[d0][r];
            x += __builtin_bit_cast(float, __builtin_amdgcn_update_dpp(0, __builtin_bit_cast(int, x), 0x111, 0xf, 0xf, false));
            x += __builtin_bit_cast(float, __builtin_amdgcn_update_dpp(0, __builtin_bit_cast(int, x), 0x112, 0xf, 0xf, false));
            x += __builtin_bit_cast(float, __builtin_amdgcn_update_dpp(0, __builtin_bit_cast(int, x), 0x114, 0xf, 0xf, false));
            x += __builtin_bit_cast(float, __builtin_amdgcn_update_dpp(0, __builtin_bit_cast(int, x), 0x118, 0xf, 0xf, false));
            x += __builtin_bit_cast(float, __builtin_amdgcn_update_dpp(0, __builtin_bit_cast(int, x), 0x142, 0xa, 0xf, false));
            const float t0 = __builtin_bit_cast(float, __builtin_amdgcn_readlane(__builtin_bit_cast(int, x), 31)), t1 = __builtin_bit_cast(float, __builtin_amdgcn_readlane(__builtin_bit_cast(int, x), 63));
            ssv[r] = rsqrtf((hi ? t1 : t0) * (1.f / 128.f) + EPS) * (1.f - LAM_INIT); }
#pragma unroll
        for (int d0 = 0; d0 < NC; ++d0) { const float g = gsub[d0 * 32 + r32];
#pragma unroll
            for (int r = 0; r < 16; ++r) { const int orow = wid * 32 + crow(r, hi); ((bf16*)Ob)[(size_t)orow * ldo + d0 * 32 + r32] = (bf16)f2bf(o[d0][r] * ssv[r] * g); } }
    }
    __syncthreads();
#undef SLOAD
#undef SWRITE
#undef SWAIT
#undef RESC
}

template <int NQ, int ABL = 0> __device__ __forceinline__ void qkt_c(f32x16& p0, f32x16& p1, const LAS char* Ks, const bf16x8* qr, float m_ref, int r32, int hi) {
    f32x16 negm;
#pragma unroll
    for (int r = 0; r < 16; ++r) negm[r] = -m_ref;
    p0 = negm; p1 = negm;
#pragma unroll
    for (int d0 = 0; d0 < NQ; ++d0) { const LAS char* kp = Ks + (2 * d0 + hi) * 1024 + r32 * 16;
        const bf16x8 b0 = *(const LAS bf16x8*)kp, b1 = *(const LAS bf16x8*)(kp + 512);
        p0 = __builtin_amdgcn_mfma_f32_32x32x16_bf16(b0, qr[d0], p0, 0, 0, 0);
        p1 = __builtin_amdgcn_mfma_f32_32x32x16_bf16(b1, qr[d0], p1, 0, 0, 0); }
}
template <int MODE, int EPI, int ABL = 0>
__device__ __forceinline__ void unit_dma(const bf16* __restrict__ Qb, const bf16* __restrict__ K0, const bf16* __restrict__ K1, const bf16* __restrict__ Vh, void* Ob, int ldo, LAS char* lds, char* stash, float lam, const float* gsub) {
    using C = Cfg<MODE>;
    constexpr int DQK = C::DQK, DV = C::DV, NQ = DQK / 16, NC = DV / 32, KS = 2 * NQ * 1024, VS = 64 * DV * 2, NT = NTOK / 64;
    const int tid = threadIdx.x, lane = tid & 63, r32 = lane & 31, hi = lane >> 5; const int wid = __builtin_amdgcn_readfirstlane(tid >> 6);
    LAS char* K_lds = lds; LAS char* V_lds = lds + 4 * KS;
    LAS float* ws = (LAS float*)(lds + 4 * KS + 4 * VS) + wid * 64; LAS float* li_l = ws; LAS float* al_l = ws + 32;
    const bf16* ksA = K0 + (size_t)lane * C::LDK0 + wid * 8;
    const bf16* ksB = MODE == 0 ? K1 + (size_t)lane * C::LDK1 + (wid & 3) * 8 : nullptr;
    auto vsrc = [&](int p) -> const bf16* { const int st = 2 * p + (lane >> 5), k8 = st / NC, cb = st % NC; return Vh + (size_t)(k8 * 8 + ((lane >> 2) & 7)) * C::LDV + cb * 32 + (lane & 3) * 8; };
    const bf16* vsA = vsrc(wid); const bf16* vsB = MODE == 1 ? vsrc(wid + 8) : nullptr;
#define GLDS(src, dst) __builtin_amdgcn_global_load_lds((const unsigned*)(src), (LAS unsigned*)(dst), 16, 0, 0)
#define DMA(t, sl) do { GLDS(ksA + (size_t)(t) * 64 * C::LDK0, K_lds + (sl) * KS + wid * 1024); \
        if (MODE == 0) GLDS(ksB + (size_t)(t) * 64 * C::LDK1, K_lds + (sl) * KS + (8 + (wid & 3)) * 1024); \
        GLDS(vsA + (size_t)(t) * 64 * C::LDV, V_lds + (sl) * VS + wid * 1024); \
        if (MODE == 1) GLDS(vsB + (size_t)(t) * 64 * C::LDV, V_lds + (sl) * VS + (wid + 8) * 1024); } while (0)
#define WAIT_BAR(N) asm volatile("s_waitcnt vmcnt(" #N ") lgkmcnt(0)\n\ts_barrier" ::: "memory")
#define RESC(a) do { if (__any((a) < 1.f)) { if (hi == 0) al_l[r32] = (a); asm volatile("s_waitcnt lgkmcnt(0)" ::: "memory"); \
        _Pragma("unroll") for (int d = 0; d < NC; ++d) _Pragma("unroll") for (int r = 0; r < 16; ++r) o[d][r] *= al_l[crow(r, hi)]; } } while (0)
    DMA(0, 0); DMA(1, 1);
    float m_reg = 0.f, l_reg = 0; f32x16 o[NC]; bf16x8 qr[NQ];
#pragma unroll
    for (int d = 0; d < NC; ++d) o[d] = f32x16{};
    const bf16* Qw = Qb + (size_t)(wid * 32 + r32) * C::LDQ + hi * 8;
#pragma unroll
    for (int d0 = 0; d0 < NQ; ++d0) qr[d0] = *reinterpret_cast<const bf16x8*>(Qw + d0 * 16);
    const int vb0 = (int)(uintptr_t)V_lds + v_rd_base(lane);
    f32x16 pA0, pA1, pB0, pB1; float alA = 1.f, alB = 1.f; bf16x8 pa0, pa1, pa2, pa3;
    WAIT_BAR(0);
#define STEPD(PC0, PC1, ALC, PP0, PP1, ALP, jj, SQ, SV, SW, ISSUE, NW) do { \
        if (ISSUE) DMA((jj) + 2, SW); \
        SBAR(); qkt_c<NQ, ABL>(PC0, PC1, K_lds + (SQ) * KS, qr, m_reg, r32, hi); \
        finishSM<ABL>(PP0, PP1, ALP, l_reg, pa0, pa1, pa2, pa3); SBAR(); \
        pv_all<NC, ABL>(o, vb0 + (SV) * VS, pa0, pa1, pa2, pa3); partialSM<ABL>(PC0, PC1, m_reg, ALC, false); \
        RESC(ALC); if ((NW) == 3) WAIT_BAR(3); else WAIT_BAR(0); } while (0)
    static_assert(NT == 68, "tile schedule below: steps 1..64 in groups of 4, then 65, 66, 67");
    DMA(2, 2); qkt_c<NQ, ABL>(pA0, pA1, K_lds, qr, m_reg, r32, hi); partialSM<ABL>(pA0, pA1, m_reg, alA, true); WAIT_BAR(3);
    for (int j = 1; j < 65; j += 4) {
        STEPD(pB0, pB1, alB, pA0, pA1, alA, j,     1, 0, 3, true, 3);
        STEPD(pA0, pA1, alA, pB0, pB1, alB, j + 1, 2, 1, 0, true, 3);
        STEPD(pB0, pB1, alB, pA0, pA1, alA, j + 2, 3, 2, 1, true, 3);
        STEPD(pA0, pA1, alA, pB0, pB1, alB, j + 3, 0, 3, 2, true, 3);
    }
    STEPD(pB0, pB1, alB, pA0, pA1, alA, 65, 1, 0, 3, true, 3);
    STEPD(pA0, pA1, alA, pB0, pB1, alB, 66, 2, 1, 0, false, 0);
    STEPD(pB0, pB1, alB, pA0, pA1, alA, 67, 3, 2, 1, false, 0);
    finishSM<ABL>(pB0, pB1, alB, l_reg, pa0, pa1, pa2, pa3); SBAR();
    pv_all<NC, ABL>(o, vb0 + 3 * VS, pa0, pa1, pa2, pa3);
#undef STEPD
    if (hi == 0) li_l[r32] = l_reg; asm volatile("s_waitcnt lgkmcnt(0)" ::: "memory");
    float rli[16];
#pragma unroll
    for (int r = 0; r < 16; ++r) rli[r] = __builtin_amdgcn_rcpf(li_l[crow(r, hi)]);
    asm volatile("" : "+s"(ldo), "+s"(stash), "+s"(gsub), "+s"(Ob));
    if constexpr (MODE == 0) {
#pragma unroll
        for (int r = 0; r < 16; ++r) { const int orow = wid * 32 + crow(r, hi);
#pragma unroll
            for (int d0 = 0; d0 < NC; ++d0) ((bf16*)Ob)[(size_t)orow * ldo + d0 * 32 + r32] = (bf16)f2bf(o[d0][r] * rli[r]); }
    } else if constexpr (EPI == 1) {
        char* st = stash + wid * 8192 + lane * 16;
#pragma unroll
        for (int d0 = 0; d0 < NC; ++d0)
#pragma unroll
            for (int q = 0; q < 2; ++q) { u32x4 w;
                w.x = cvtpk(o[d0][8 * q + 0] * rli[8 * q + 0], o[d0][8 * q + 1] * rli[8 * q + 1]); w.y = cvtpk(o[d0][8 * q + 2] * rli[8 * q + 2], o[d0][8 * q + 3] * rli[8 * q + 3]);
                w.z = cvtpk(o[d0][8 * q + 4] * rli[8 * q + 4], o[d0][8 * q + 5] * rli[8 * q + 5]); w.w = cvtpk(o[d0][8 * q + 6] * rli[8 * q + 6], o[d0][8 * q + 7] * rli[8 * q + 7]);
                *(u32x4*)(st + (d0 * 2 + q) * 1024) = w; }
        asm volatile("s_waitcnt vmcnt(0)" ::: "memory");
    } else {
        const char* st = stash + wid * 8192 + lane * 16;
#pragma unroll
        for (int d0 = 0; d0 < NC; ++d0) {
            const u32x4 wa = *(const u32x4*)(st + (d0 * 2 + 0) * 1024), wb = *(const u32x4*)(st + (d0 * 2 + 1) * 1024);
            f32x16 od;
            od[0] = __builtin_bit_cast(float, wa.x << 16); od[1] = __builtin_bit_cast(float, wa.x & 0xffff0000u); od[2] = __builtin_bit_cast(float, wa.y << 16); od[3] = __builtin_bit_cast(float, wa.y & 0xffff0000u);
            od[4] = __builtin_bit_cast(float, wa.z << 16); od[5] = __builtin_bit_cast(float, wa.z & 0xffff0000u); od[6] = __builtin_bit_cast(float, wa.w << 16); od[7] = __builtin_bit_cast(float, wa.w & 0xffff0000u);
            od[8] = __builtin_bit_cast(float, wb.x << 16); od[9] = __builtin_bit_cast(float, wb.x & 0xffff0000u); od[10] = __builtin_bit_cast(float, wb.y << 16); od[11] = __builtin_bit_cast(float, wb.y & 0xffff0000u);
            od[12] = __builtin_bit_cast(float, wb.z << 16); od[13] = __builtin_bit_cast(float, wb.z & 0xffff0000u); od[14] = __builtin_bit_cast(float, wb.w << 16); od[15] = __builtin_bit_cast(float, wb.w & 0xffff0000u);
#pragma unroll
            for (int r = 0; r < 16; ++r) od[r] -= lam * (o[d0][r] * rli[r]);
            o[d0] = od;
        }
        f32x16 ssv;
#pragma unroll
        for (int r = 0; r < 16; ++r) { float x = 0.f;
#pragma unroll
            for (int d0 = 0; d0 < NC; ++d0) x += o[d0][r] * o[d0][r];
            x += __builtin_bit_cast(float, __builtin_amdgcn_update_dpp(0, __builtin_bit_cast(int, x), 0x111, 0xf, 0xf, false));
            x += __builtin_bit_cast(float, __builtin_amdgcn_update_dpp(0, __builtin_bit_cast(int, x), 0x112, 0xf, 0xf, false));
            x += __builtin_bit_cast(float, __builtin_amdgcn_update_dpp(0, __builtin_bit_cast(int, x), 0x114, 0xf, 0xf, false));
            x += __builtin_bit_cast(float, __builtin_amdgcn_update_dpp(0, __builtin_bit_cast(int, x), 0x118, 0xf, 0xf, false));
            x += __builtin_bit_cast(float, __builtin_amdgcn_update_dpp(0, __builtin_bit_cast(int, x), 0x142, 0xa, 0xf, false));
            const float t0 = __builtin_bit_cast(float, __builtin_amdgcn_readlane(__builtin_bit_cast(int, x), 31)), t1 = __builtin_bit_cast(float, __builtin_amdgcn_readlane(__builtin_bit_cast(int, x), 63));
            ssv[r] = rsqrtf((hi ? t1 : t0) * (1.f / 128.f) + EPS) * (1.f - LAM_INIT); }
#pragma unroll
        for (int d0 = 0; d0 < NC; ++d0) { const float g = gsub[d0 * 32 + r32];
#pragma unroll
            for (int r = 0; r < 16; ++r) { const int orow = wid * 32 + crow(r, hi); ((bf16*)Ob)[(size_t)orow * ldo + d0 * 32 + r32] = (bf16)f2bf(o[d0][r] * ssv[r] * g); } }
    }
    __syncthreads();
#undef GLDS
#undef DMA
#undef WAIT_BAR
#undef RESC
}

template <int I> struct IC { static constexpr int value = I; };
template <int I, int N, class F> __device__ __forceinline__ void sfor(F&& f) { if constexpr (I < N) { f(IC<I>{}); sfor<I + 1, N>(f); } }
template <int MODE> struct GC {
    using C = Cfg<MODE>;
    static constexpr int NQ = C::DQK / 16, NC = C::DV / 32, NMQ = 2 * NQ, NMP = 4 * NC, NG = NMQ + NMP, KS = 2 * NQ * 1024, VS = 64 * C::DV * 2;
    static constexpr int GF = MODE == 0 ? 14 : 16, NPRE = 8, NFIN = 80, NLATE = 24, RD = 3;
    f32x16 S[2][2], o[NC], negm; bf16x8 qr[NQ], kf[NMQ]; s16x4 vl[NMP], vh[NMP]; u32x4 w[4];
    float s[4], mxa, mxb, pmax, t0, t1, m_reg, l_reg, al[2];
    const bf16 *ksA, *ksB, *vsA, *vsB; LAS char *K_lds, *V_lds; const LAS char* kb; int vb0, wid, r32, hi; LAS float* al_l;
};
template <int MODE> __device__ __forceinline__ void g_dma(GC<MODE>& c, int t, int sl) {
    using G = GC<MODE>; using C = Cfg<MODE>;
#define GLDS(src, dst) __builtin_amdgcn_global_load_lds((const unsigned*)(src), (LAS unsigned*)(dst), 16, 0, 0)
    GLDS(c.ksA + (size_t)t * 64 * C::LDK0, c.K_lds + sl * G::KS + c.wid * 1024);
    if (MODE == 0) GLDS(c.ksB + (size_t)t * 64 * C::LDK1, c.K_lds + sl * G::KS + (8 + (c.wid & 3)) * 1024);
    GLDS(c.vsA + (size_t)t * 64 * C::LDV, c.V_lds + sl * G::VS + c.wid * 1024);
    if (MODE == 1) GLDS(c.vsB + (size_t)t * 64 * C::LDV, c.V_lds + sl * G::VS + (c.wid + 8) * 1024);
#undef GLDS
}
template <int MODE, int R> __device__ __forceinline__ void g_kread(GC<MODE>& c, const LAS char* kq) { c.kf[R] = *(const LAS bf16x8*)(kq + (R >> 1) * 2048 + (R & 1) * 512); }
template <int MODE, int I> __device__ __forceinline__ void g_vread(GC<MODE>& c, int vb) {
    constexpr int NC = GC<MODE>::NC, ks = I / NC, cb = I % NC, off = cb * 512 + ks * (NC * 1024);
    c.vl[I] = __builtin_amdgcn_ds_read_tr16_b64_v4i16((LAS s16x4*)(uintptr_t)(vb + off));
    c.vh[I] = __builtin_amdgcn_ds_read_tr16_b64_v4i16((LAS s16x4*)(uintptr_t)(vb + off + NC * 512));
}
template <int MODE, int XP, int I> __device__ __forceinline__ void g_fin(GC<MODE>& c) {
    constexpr int ord[20] = {0, 1, 2, 3, 8, 4, 9, 5, 10, 6, 11, 7, 16, 12, 17, 13, 18, 14, 15, 19};
    constexpr int q = I / 20, code = ord[I % 20], ty = code >> 3, ix = code & 7, h = q >> 1, eb = 8 * (q & 1);
    if constexpr (ty == 0) c.S[XP][h][eb + ix] = __builtin_amdgcn_exp2f(c.S[XP][h][eb + ix]);
    else if constexpr (ty == 1) { if constexpr (q == 0 && ix < 4) c.s[ix] = c.S[XP][h][eb + ix]; else c.s[ix & 3] += c.S[XP][h][eb + ix]; }
    else c.w[q][ix] = cvtpk(c.S[XP][h][eb + 2 * ix], c.S[XP][h][eb + 2 * ix + 1]);
}
template <int MODE, int XC, int I> __device__ __forceinline__ void g_late(GC<MODE>& c) {
    constexpr int XP = XC ^ 1;
    if constexpr (I == 0) c.t0 = c.s[0] + c.s[1];
    else if constexpr (I == 1) c.t1 = c.s[2] + c.s[3];
    else if constexpr (I == 2) c.t0 += c.t1;
    else if constexpr (I == 3) { auto rr = __builtin_amdgcn_permlane32_swap(__float_as_uint(c.t0), __float_as_uint(c.t0), false, false); c.t0 = __uint_as_float(rr[0]); c.t1 = __uint_as_float(rr[1]); }
    else if constexpr (I == 4) c.t0 += c.t1;
    else if constexpr (I == 5) c.l_reg = c.l_reg * c.al[XP] + c.t0;
    else if constexpr (I == 6) c.mxa = max3f(c.S[XC][0][0], c.S[XC][0][1], c.S[XC][1][0]);
    else if constexpr (I == 7) c.mxb = max3f(c.S[XC][0][2], c.S[XC][0][3], c.S[XC][1][1]);
    else if constexpr (I == 8) c.mxa = max3f(c.mxa, c.S[XC][1][2], c.S[XC][1][3]);
    else if constexpr (I < 21) { constexpr int j = I - 9, r = 4 + 4 * (j / 4), sub = j % 4, h = sub >> 1, e = r + 2 * (sub & 1);
        if constexpr ((sub & 1) == 0) c.mxa = max3f(c.mxa, c.S[XC][h][e], c.S[XC][h][e + 1]); else c.mxb = max3f(c.mxb, c.S[XC][h][e], c.S[XC][h][e + 1]); }
    else if constexpr (I == 21) c.pmax = __builtin_fmaxf(c.mxa, c.mxb);
    else if constexpr (I == 22) { auto rr = __builtin_amdgcn_permlane32_swap(__float_as_uint(c.pmax), __float_as_uint(c.pmax), false, false); c.mxa = __uint_as_float(rr[0]); c.mxb = __uint_as_float(rr[1]); }
    else c.pmax = __builtin_fmaxf(c.mxa, c.mxb);
}
template <int MODE, int XC, int G> __device__ __forceinline__ void g_mfma(GC<MODE>& c) {
    using T = GC<MODE>;
    if constexpr (G < T::NMQ) { constexpr int d0 = G >> 1, h = G & 1;
        if constexpr (d0 == 0) c.S[XC][h] = __builtin_amdgcn_mfma_f32_32x32x16_bf16(c.kf[G], c.qr[d0], c.negm, 0, 0, 0);
        else c.S[XC][h] = __builtin_amdgcn_mfma_f32_32x32x16_bf16(c.kf[G], c.qr[d0], c.S[XC][h], 0, 0, 0);
    } else { constexpr int i = G - T::NMQ, ks = i / T::NC, cb = i % T::NC;
        const bf16x8 vf = {c.vl[i][0], c.vl[i][1], c.vl[i][2], c.vl[i][3], c.vh[i][0], c.vh[i][1], c.vh[i][2], c.vh[i][3]};
        c.o[cb] = __builtin_amdgcn_mfma_f32_32x32x16_bf16(__builtin_bit_cast(bf16x8, c.w[ks]), vf, c.o[cb], 0, 0, 0); }
}
#define G_WAIT_BAR(N) asm volatile("s_waitcnt vmcnt(" #N ") lgkmcnt(0)\n\ts_barrier" ::: "memory")
#define G_RESC(a) do { if (__any((a) < 1.f)) { if (c.hi == 0) c.al_l[c.r32] = (a); asm volatile("s_waitcnt lgkmcnt(0)" ::: "memory"); \
        _Pragma("unroll") for (int d = 0; d < T::NC; ++d) _Pragma("unroll") for (int r = 0; r < 16; ++r) c.o[d][r] *= c.al_l[crow(r, c.hi)]; } } while (0)
template <int MODE, int XC, int SQ, int SV, int SW, bool ISSUE, int NW, int ABL = 0> __device__ __forceinline__ void g_step(GC<MODE>& c, int t) {
    using T = GC<MODE>; constexpr int XP = XC ^ 1;
    if constexpr (ISSUE && ABL != 3) g_dma<MODE>(c, t + 2, SW);
    const LAS char* kq = c.kb + SQ * T::KS; const int vb = c.vb0 + SV * T::VS;
    if constexpr (ABL != 5) sfor<0, T::RD>([&](auto i) { g_kread<MODE, decltype(i)::value>(c, kq); });
    if constexpr (ABL != 1) sfor<0, T::NPRE>([&](auto i) { g_fin<MODE, XP, decltype(i)::value>(c); });
    SBAR();
    sfor<0, T::NG>([&](auto gi) { constexpr int g = decltype(gi)::value, r = g + T::RD;
        if constexpr (ABL != 2) g_mfma<MODE, XC, g>(c);
        else { if constexpr (g < T::NMQ) asm volatile("" :: "v"(c.kf[g])); else asm volatile("" :: "v"(c.vl[g - T::NMQ]), "v"(c.vh[g - T::NMQ])); }
        if constexpr (ABL == 5) {} else if constexpr (r < T::NMQ) g_kread<MODE, r>(c, kq); else if constexpr (r < T::NG) g_vread<MODE, r - T::NMQ>(c, vb);
        if constexpr (ABL == 1) {} else if constexpr (g < T::GF) { constexpr int lo = T::NPRE + g * (T::NFIN - T::NPRE) / T::GF, hi = T::NPRE + (g + 1) * (T::NFIN - T::NPRE) / T::GF;
            sfor<lo, hi>([&](auto i) { g_fin<MODE, XP, decltype(i)::value>(c); });
        } else { constexpr int lo = (g - T::GF) * T::NLATE / (T::NG - T::GF), hi = (g - T::GF + 1) * T::NLATE / (T::NG - T::GF);
            sfor<lo, hi>([&](auto i) { g_late<MODE, XC, decltype(i)::value>(c); }); }
        SBAR(); });
    if constexpr (ABL == 1) c.pmax = 0.f;
    c.al[XC] = 1.f;
    if (__builtin_expect(__any(c.pmax > THR2), 0)) {
        const float dl = __builtin_fmaxf(c.pmax, 0.f); c.al[XC] = __builtin_amdgcn_exp2f(-dl);
        const float x = -dl; const unsigned xh = __float_as_uint(x) & 0xffff0000u; const float r1 = x - __uint_as_float(xh);
        const unsigned xm = __float_as_uint(r1) & 0xffff0000u; const float r2 = r1 - __uint_as_float(xm); const unsigned xl = __float_as_uint(r2) & 0xffff0000u;
        const unsigned one = c.hi == 0 ? 0x3f803f80u : 0u;
        const u32x4 av = {one, one & 0xffffu, 0u, 0u}, bv = {c.hi == 0 ? ((xh >> 16) | xm) : 0u, c.hi == 0 ? (xl >> 16) : 0u, 0u, 0u};
        const bf16x8 A1 = __builtin_bit_cast(bf16x8, av), B1 = __builtin_bit_cast(bf16x8, bv);
        c.S[XC][0] = __builtin_amdgcn_mfma_f32_32x32x16_bf16(A1, B1, c.S[XC][0], 0, 0, 0);
        c.S[XC][1] = __builtin_amdgcn_mfma_f32_32x32x16_bf16(A1, B1, c.S[XC][1], 0, 0, 0);
        c.negm = __builtin_amdgcn_mfma_f32_32x32x16_bf16(A1, B1, c.negm, 0, 0, 0);
    }
    G_RESC(c.al[XC]);
    if constexpr (ABL == 4) { if constexpr (NW == 3) asm volatile("s_waitcnt vmcnt(3) lgkmcnt(0)" ::: "memory"); else asm volatile("s_waitcnt vmcnt(0) lgkmcnt(0)" ::: "memory"); }
    else if constexpr (NW == 3) G_WAIT_BAR(3); else G_WAIT_BAR(0);
}
template <int MODE, int EPI, int ABL = 0>
__device__ __forceinline__ void unit_gap(const bf16* __restrict__ Qb, const bf16* __restrict__ K0, const bf16* __restrict__ K1, const bf16* __restrict__ Vh, void* Ob, int ldo, LAS char* lds, char* stash, float lam, const float* gsub) {
    using C = Cfg<MODE>; using T = GC<MODE>;
    constexpr int NQ = T::NQ, NC = T::NC, KS = T::KS, VS = T::VS, NT = NTOK / 64;
    int tid_ = threadIdx.x; asm volatile("" : "+v"(tid_));
    const int tid = tid_, lane = tid & 63, r32 = lane & 31, hi = lane >> 5; const int wid = __builtin_amdgcn_readfirstlane(tid >> 6);
    GC<MODE> c;
    c.K_lds = lds; c.V_lds = lds + 4 * KS; c.wid = wid; c.r32 = r32; c.hi = hi;
    LAS float* ws = (LAS float*)(lds + 4 * KS + 4 * VS) + wid * 64; LAS float* li_l = ws; LAS float* al_l = ws + 32; c.al_l = al_l;
    c.ksA = K0 + (size_t)lane * C::LDK0 + wid * 8;
    c.ksB = MODE == 0 ? K1 + (size_t)lane * C::LDK1 + (wid & 3) * 8 : nullptr;
    auto vsrc = [&](int p) -> const bf16* { const int st = 2 * p + (lane >> 5), k8 = st / NC, cb = st % NC; return Vh + (size_t)(k8 * 8 + ((lane >> 2) & 7)) * C::LDV + cb * 32 + (lane & 3) * 8; };
    c.vsA = vsrc(wid); c.vsB = MODE == 1 ? vsrc(wid + 8) : nullptr;
    c.kb = c.K_lds + hi * 1024 + r32 * 16; c.vb0 = (int)(uintptr_t)c.V_lds + v_rd_base(lane);
    g_dma<MODE>(c, 0, 0); g_dma<MODE>(c, 1, 1);
    c.m_reg = 0.f; c.l_reg = 0.f; c.al[0] = c.al[1] = 1.f;
#pragma unroll
    for (int d = 0; d < NC; ++d) c.o[d] = f32x16{};
    const bf16* Qw = Qb + (size_t)(wid * 32 + r32) * C::LDQ + hi * 8;
#pragma unroll
    for (int d0 = 0; d0 < NQ; ++d0) c.qr[d0] = *reinterpret_cast<const bf16x8*>(Qw + d0 * 16);
    G_WAIT_BAR(0);
    static_assert(NT == 68, "tile schedule below: steps 1..64 in groups of 4, then 65, 66, 67");
    {
        g_dma<MODE>(c, 2, 2);
        c.negm = f32x16{};
        sfor<0, T::NMQ>([&](auto i) { g_kread<MODE, decltype(i)::value>(c, c.kb); });
        sfor<0, T::NMQ>([&](auto i) { g_mfma<MODE, 0, decltype(i)::value>(c); });
        sfor<6, T::NLATE>([&](auto i) { g_late<MODE, 0, decltype(i)::value>(c); });
        c.m_reg = c.pmax;
#pragma unroll
        for (int r = 0; r < 16; ++r) { c.S[0][0][r] -= c.pmax; c.S[0][1][r] -= c.pmax; c.negm[r] = -c.m_reg; }
        asm volatile("" : "+v"(c.negm));
        G_WAIT_BAR(3);
    }
    for (int j = 1; j < 65; j += 4) {
        g_step<MODE, 1, 1, 0, 3, true, 3, ABL>(c, j);
        g_step<MODE, 0, 2, 1, 0, true, 3, ABL>(c, j + 1);
        g_step<MODE, 1, 3, 2, 1, true, 3, ABL>(c, j + 2);
        g_step<MODE, 0, 0, 3, 2, true, 3, ABL>(c, j + 3);
    }
    g_step<MODE, 1, 1, 0, 3, true, 3, ABL>(c, 65);
    g_step<MODE, 0, 2, 1, 0, false, 0, ABL>(c, 66);
    g_step<MODE, 1, 3, 2, 1, false, 0, ABL>(c, 67);
    {
        const int vb = c.vb0 + 3 * VS;
        sfor<0, T::NMP>([&](auto i) { g_vread<MODE, decltype(i)::value>(c, vb); });
        sfor<0, T::NFIN>([&](auto i) { g_fin<MODE, 1, decltype(i)::value>(c); });
        sfor<0, 6>([&](auto i) { g_late<MODE, 0, decltype(i)::value>(c); });
        sfor<0, T::NMP>([&](auto i) { g_mfma<MODE, 0, T::NMQ + decltype(i)::value>(c); });
    }
    f32x16 (&o)[NC] = c.o; float& l_reg = c.l_reg;
    if (hi == 0) li_l[r32] = l_reg; asm volatile("s_waitcnt lgkmcnt(0)" ::: "memory");
    float rli[16];
#pragma unroll
    for (int r = 0; r < 16; ++r) rli[r] = __builtin_amdgcn_rcpf(li_l[crow(r, hi)]);
    asm volatile("" : "+s"(ldo), "+s"(stash), "+s"(gsub), "+s"(Ob));
    if constexpr (MODE == 0) {
#pragma unroll
        for (int r = 0; r < 16; ++r) { const int orow = wid * 32 + crow(r, hi);
#pragma unroll
            for (int d0 = 0; d0 < NC; ++d0) ((bf16*)Ob)[(size_t)orow * ldo + d0 * 32 + r32] = (bf16)f2bf(o[d0][r] * rli[r]); }
    } else if constexpr (EPI == 1) {
        char* st = stash + wid * 8192 + lane * 16;
#pragma unroll
        for (int d0 = 0; d0 < NC; ++d0)
#pragma unroll
            for (int q = 0; q < 2; ++q) { u32x4 w;
                w.x = cvtpk(o[d0][8 * q + 0] * rli[8 * q + 0], o[d0][8 * q + 1] * rli[8 * q + 1]); w.y = cvtpk(o[d0][8 * q + 2] * rli[8 * q + 2], o[d0][8 * q + 3] * rli[8 * q + 3]);
                w.z = cvtpk(o[d0][8 * q + 4] * rli[8 * q + 4], o[d0][8 * q + 5] * rli[8 * q + 5]); w.w = cvtpk(o[d0][8 * q + 6] * rli[8 * q + 6], o[d0][8 * q + 7] * rli[8 * q + 7]);
                *(u32x4*)(st + (d0 * 2 + q) * 1024) = w; }
        asm volatile("s_waitcnt vmcnt(0)" ::: "memory");
    } else {
        const char* st = stash + wid * 8192 + lane * 16;
#pragma unroll
        for (int d0 = 0; d0 < NC; ++d0) {
            const u32x4 wa = *(const u32x4*)(st + (d0 * 2 + 0) * 1024), wb = *(const u32x4*)(st + (d0 * 2 + 1) * 1024);
            f32x16 od;
            od[0] = __builtin_bit_cast(float, wa.x << 16); od[1] = __builtin_bit_cast(float, wa.x & 0xffff0000u); od[2] = __builtin_bit_cast(float, wa.y << 16); od[3] = __builtin_bit_cast(float, wa.y & 0xffff0000u);
            od[4] = __builtin_bit_cast(float, wa.z << 16); od[5] = __builtin_bit_cast(float, wa.z & 0xffff0000u); od[6] = __builtin_bit_cast(float, wa.w << 16); od[7] = __builtin_bit_cast(float, wa.w & 0xffff0000u);
            od[8] = __builtin_bit_cast(float, wb.x << 16); od[9] = __builtin_bit_cast(float, wb.x & 0xffff0000u); od[10] = __builtin_bit_cast(float, wb.y << 16); od[11] = __builtin_bit_cast(float, wb.y & 0xffff0000u);
            od[12] = __builtin_bit_cast(float, wb.z << 16); od[13] = __builtin_bit_cast(float, wb.z & 0xffff0000u); od[14] = __builtin_bit_cast(float, wb.w << 16); od[15] = __builtin_bit_cast(float, wb.w & 0xffff0000u);
#pragma unroll
            for (int r = 0; r < 16; ++r) od[r] -= lam * (o[d0][r] * rli[r]);
            o[d0] = od;
        }
        f32x16 ssv;
#pragma unroll
        for (int r = 0; r < 16; ++r) { float x = 0.f;
#pragma unroll
            for (int d0 = 0; d0 < NC; ++d0) x += o[d0][r] * o[d0][r];
            x += __builtin_bit_cast(float, __builtin_amdgcn_update_dpp(0, __builtin_bit_cast(int, x), 0x111, 0xf, 0xf, false));
            x += __builtin_bit_cast(float, __builtin_amdgcn_update_dpp(0, __builtin_bit_cast(int, x), 0x112, 0xf, 0xf, false));
            x += __builtin_bit_cast(float, __builtin_amdgcn_update_dpp(0, __builtin_bit_cast(int, x), 0x114, 0xf, 0xf, false));
            x += __builtin_bit_cast(float, __builtin_amdgcn_update_dpp(0, __builtin_bit_cast(int, x), 0x118, 0xf, 0xf, false));
            x += __builtin_bit_cast(float, __builtin_amdgcn_update_dpp(0, __builtin_bit_cast(int, x), 0x142, 0xa, 0xf, false));
            const float t0 = __builtin_bit_cast(float, __builtin_amdgcn_readlane(__builtin_bit_cast(int, x), 31)), t1 = __builtin_bit_cast(float, __builtin_amdgcn_readlane(__builtin_bit_cast(int, x), 63));
            ssv[r] = rsqrtf((hi ? t1 : t0) * (1.f / 128.f) + EPS) * (1.f - LAM_INIT); }
#pragma unroll
        for (int d0 = 0; d0 < NC; ++d0) { const float g = gsub[d0 * 32 + r32];
#pragma unroll
            for (int r = 0; r < 16; ++r) { const int orow = wid * 32 + crow(r, hi); ((bf16*)Ob)[(size_t)orow * ldo + d0 * 32 + r32] = (bf16)f2bf(o[d0][r] * ssv[r] * g); } }
    }
    __syncthreads();
}
#undef G_WAIT_BAR
#undef G_RESC

#ifndef GAPM0
#define GAPM0 1
#endif
#ifndef GAPM1
#define GAPM1 1
#endif
template <int MODE, int EPI, int ABL = 0>
__device__ __forceinline__ void unit(const bf16* __restrict__ Qb, const bf16* __restrict__ K0, const bf16* __restrict__ K1, const bf16* __restrict__ Vh, void* Ob, int ldo, LAS char* lds, char* stash, float lam, const float* gsub) {
    if constexpr ((MODE == 0 && GAPM0) || (MODE == 1 && GAPM1)) unit_gap<MODE, EPI, ABL>(Qb, K0, K1, Vh, Ob, ldo, lds, stash, lam, gsub);
    else unit_dma<MODE, EPI, ABL>(Qb, K0, K1, Vh, Ob, ldo, lds, stash, lam, gsub);
}


#undef SBAR
}

#define XB_TMO      128
#define XB_XCNT(j)  (256  + 64 * (j))
#define XB_XSUB(j)  (1280 + 64 * (j))
#define XB_XGEN(j)  (2304 + 64 * (j))
#define XB_TOP      3328
#define XB_TOPGEN   3392
#define XCD_BAR_WORDS 3456
#define XB_SPIN_CAP (1u << 20)
__device__ __forceinline__ unsigned xb_ld(unsigned* p)              { return __hip_atomic_load(p, __ATOMIC_RELAXED, __HIP_MEMORY_SCOPE_AGENT); }
__device__ __forceinline__ unsigned xb_add(unsigned* p, unsigned v) { return __hip_atomic_fetch_add(p, v, __ATOMIC_RELAXED, __HIP_MEMORY_SCOPE_AGENT); }
__device__ __forceinline__ unsigned xb_xcc_id() { return (unsigned)__builtin_amdgcn_s_getreg((3 << 11) | 20) & 0xFu; }
#define XB_SPIN(cond, bar) do { unsigned _sp = 0; while (cond) { __builtin_amdgcn_s_sleep(1); \
    if ((++_sp & 255u) == 0u) { if (xb_ld(&(bar)[XB_TMO])) break; if (_sp > XB_SPIN_CAP) { atomicAdd(&(bar)[XB_TMO], 1u); break; } } } } while (0)
struct XcdBarrier { unsigned* bar; unsigned x; volatile LAS unsigned* st; };
__device__ __forceinline__ XcdBarrier xcd_barrier_post(unsigned* bar, volatile LAS unsigned* st) {
    XcdBarrier b; b.bar = bar; b.x = xb_xcc_id(); b.st = st;
    if (threadIdx.x == 0) (void)xb_add(&bar[XB_XCNT(b.x)], 1u);
    return b;
}
__device__ __forceinline__ void xcd_barrier_complete(unsigned* bar, unsigned x, unsigned& nloc, unsigned& nx) {
    const unsigned G = gridDim.x * gridDim.y * gridDim.z;
    unsigned sum, cnt, mine, sp = 0u;
    for (;;) {
        sum = 0u; cnt = 0u; mine = 0u;
#pragma unroll
        for (unsigned j = 0; j < 16; ++j) { const unsigned c = xb_ld(&bar[XB_XCNT(j)]); sum += c; cnt += (c > 0u) ? 1u : 0u; mine = (j == x) ? c : mine; }
        if (sum == G) break;
        __builtin_amdgcn_s_sleep(1);
        if ((++sp & 255u) == 0u) { if (xb_ld(&bar[XB_TMO])) break; if (sp > XB_SPIN_CAP) { atomicAdd(&bar[XB_TMO], 1u); break; } }
    }
    nloc = mine > 0u ? mine : 1u; nx = cnt > 0u ? cnt : 1u;
}
__device__ __forceinline__ void xcd_barrier(const XcdBarrier& b) {
    asm volatile("s_waitcnt vmcnt(0)" ::: "memory");
    __syncthreads();
    if (threadIdx.x == 0) {
        unsigned* bar = b.bar;
        __builtin_amdgcn_s_waitcnt(0);
        unsigned nloc = b.st[0], nx = b.st[1];
        if (nloc == 0u) { xcd_barrier_complete(bar, b.x, nloc, nx); b.st[0] = nloc; b.st[1] = nx; }
        const unsigned old = xb_add(&bar[XB_XSUB(b.x)], 1u);
        const unsigned gen = old / nloc;
        if (old + 1u == (gen + 1u) * nloc) {
            __builtin_amdgcn_fence(__ATOMIC_RELEASE, "agent");
            asm volatile("s_waitcnt vmcnt(0)" ::: "memory");
            const unsigned og = xb_add(&bar[XB_TOP], 1u);
            const unsigned tg = og / nx;
            if (og + 1u == (tg + 1u) * nx) xb_add(&bar[XB_TOPGEN], 1u);
            else XB_SPIN(xb_ld(&bar[XB_TOPGEN]) == tg, bar);
            __builtin_amdgcn_fence(__ATOMIC_ACQUIRE, "agent");
            xb_add(&bar[XB_XGEN(b.x)], 1u);
            asm volatile("s_waitcnt vmcnt(0)" ::: "memory");
        } else {
            XB_SPIN(xb_ld(&bar[XB_XGEN(b.x)]) == gen, bar);
            __builtin_amdgcn_fence(__ATOMIC_ACQUIRE, "agent");
            asm volatile("s_waitcnt vmcnt(0)" ::: "memory");
        }
    }
    __syncthreads();
}

constexpr int NWAVES = 8;
constexpr int RING_BYTES = 131072, LDS_BYTES = 147456, LDSCTL_OFF = LDS_BYTES - 2048, MISC_OFF = LDSCTL_OFF + 320, UCACHE_OFF = LDSCTL_OFF + 1024  ;

struct Frame {
    LAS unsigned char* lds; volatile LAS unsigned* MISC; unsigned* ctl;
    int tid, lane, wave, vcu, G;
    Ptrs P;
    __device__ __forceinline__ LAS char* lds_c() const { return (LAS char*)lds; }
};

template <class SrcF> __device__ __forceinline__ void transpose_item(const SrcF& f, int K, bf16* WT, int p0, int k0, LAS float* scr, int lane) {
    float t[32];
#pragma unroll
    for (int i = 0; i < 32; ++i) t[i] = f(k0 + 2 * i + (lane >> 5), p0 + (lane & 31));
#pragma unroll
    for (int i = 0; i < 32; ++i) scr[(2 * i + (lane >> 5)) * 33 + (lane & 31)] = t[i];
    LDS_WAIT(); asm volatile("" ::: "memory");
    const int c = lane & 7;
#pragma unroll
    for (int j = 0; j < 4; ++j) { const int n = (lane >> 3) + 8 * j; const LAS float* s = scr + (8 * c) * 33 + n;
        u32x4 o; o.x = cvt_pk_bf16(s[0 * 33], s[1 * 33]); o.y = cvt_pk_bf16(s[2 * 33], s[3 * 33]); o.z = cvt_pk_bf16(s[4 * 33], s[5 * 33]); o.w = cvt_pk_bf16(s[6 * 33], s[7 * 33]);
        *(u32x4*)(WT + (size_t)(p0 + n) * K + k0 + 8 * c) = o; }
    LDS_WAIT(); asm volatile("" ::: "memory");
}
struct SrcWin { const float* w; __device__ float operator()(int k, int p) const { const int l = p1_logical(p); return l < 0 ? 0.f : w[(size_t)k * IN_COLS + l]; } };
struct SrcWup { const float *gq, *wuq, *gkv, *wukv;
    __device__ float operator()(int k, int p) const {
        if (p < 768) return k < 256 ? gq[k] * wuq[(size_t)k * 768 + qm_logical(p)] : 0.f;
        return k >= 256 ? gkv[k - 256] * wukv[(size_t)(k - 256) * 1024 + (p - 768)] : 0.f; } };
__host__ __device__ __forceinline__ int ctx_dstcol(int cp) { return cp < 128 ? 256 + cp : cp < 160 ? 384 + (cp - 128) : cp < 672 ? 1024 + (cp - 160) : cp < 1184 ? 1536 + (cp - 672) : -1; }
struct SrcCtx { const float* w; __device__ float operator()(int k, int p) const { const int c = ctx_dstcol(p); const int l = c < 0 ? -1 : p1_logical(c); return l < 0 ? 0.f : w[(size_t)k * IN_COLS + l]; } };
struct SrcPlain { const float* w; int N; int coff; __device__ float operator()(int k, int p) const { return w[(size_t)k * N + p + coff]; } };

__device__ __forceinline__ void ph0_prep(Frame& F) {
    LAS float* scr = (LAS float*)(F.lds + F.wave * 16384);
    const int gw = F.vcu * NWAVES + F.wave, NGW = F.G * NWAVES, lane = F.lane;
    const Ptrs& P = F.P; unsigned char* ws = P.ws;
    constexpr int I_IN = 16 * 64, I_UP = 6 * 56, I_OUT = 16 * 32, I_R = 16 * 8, I_CTX = 16 * 38, I_SMALL = I_IN + I_UP + I_OUT + I_R + I_CTX;
    for (int it = gw; it < I_SMALL; it += NGW) {
        int r = it;
        if (r < I_IN) { transpose_item(SrcWin{P.in[8]}, 1024, (bf16*)(ws + WS_WIN), (r % 64) * 32, (r / 64) * 64, scr, lane); continue; } r -= I_IN;
        if (r < I_UP) { transpose_item(SrcWup{P.in[9], P.in[10], P.in[11], P.in[12]}, 384, (bf16*)(ws + WS_WUP), (r % 56) * 32, (r / 56) * 64, scr, lane); continue; } r -= I_UP;
        if (r < I_OUT) { transpose_item(SrcPlain{P.in[18], 1024, 0}, 1024, (bf16*)(ws + WS_WOUT), (r % 32) * 32, (r / 32) * 64, scr, lane); continue; } r -= I_OUT;
        if (r < I_R) { transpose_item(SrcPlain{P.in[19], 256, 0}, 1024, (bf16*)(ws + WS_WR), (r % 8) * 32, (r / 8) * 64, scr, lane); continue; } r -= I_R;
        transpose_item(SrcCtx{P.in[8]}, 1024, (bf16*)(ws + WS_WCTX), (r % 38) * 32, (r / 38) * 64, scr, lane);
    }
    for (int it = gw; it < 96 * 16; it += NGW) {
        const int cg = it % 96, kp = it / 96;
#pragma unroll
        for (int r = 0; r < 5; ++r) { const float c = (r < 4 ? P.in[1] + r * DM : P.in[3])[kp * 64 + lane]; scr[r * 64 + lane] = c / (1.f + __expf(-c)); }
        LDS_WAIT(); asm volatile("" ::: "memory");
        float acc[5] = {0.f, 0.f, 0.f, 0.f, 0.f};
        const float* W = P.in[4] + (size_t)(kp * 64) * 6144 + cg * 64 + lane;
#pragma unroll 8
        for (int kk = 0; kk < 64; ++kk) { const float w = W[(size_t)kk * 6144];
#pragma unroll
            for (int r = 0; r < 5; ++r) acc[r] += scr[r * 64 + kk] * w; }
        LDS_WAIT(); asm volatile("" ::: "memory");
#pragma unroll
        for (int r = 0; r < 5; ++r) ((float*)(ws + WS_MODP))[(size_t)(kp * 5 + r) * 6144 + cg * 64 + lane] = acc[r];
    }
    { const int idx = (F.vcu * 512 + F.tid);
      if (idx < 1024) { const int v = idx / 16, f = idx % 16; const float th = (float)v * exp2f(-(float)f / 16.f * 13.287712379549449f);
          ((float2*)(ws + WS_TAB))[idx] = make_float2(__builtin_amdgcn_cosf(th * 0.15915494309189535f), __builtin_amdgcn_sinf(th * 0.15915494309189535f)); }
      else if (idx < 1536) { const int i2 = idx - 1024, v = i2 / 8, f = i2 % 8; const float th = (float)v * exp2f(-(float)f / 8.f * 13.287712379549449f);
          ((float2*)(ws + WS_TAB))[idx] = make_float2(__builtin_amdgcn_cosf(th * 0.15915494309189535f), __builtin_amdgcn_sinf(th * 0.15915494309189535f)); } }
}
struct CvItem { const float* src; int ld; bf16* dst; int K; };
__device__ __forceinline__ CvItem cv_decode(const Ptrs& P, int it, int lane) {
    constexpr int IPE = 256 + 128; unsigned char* ws = P.ws;
    const int e = it / IPE; int r = it % IPE; CvItem c;
    if (r < 256) { const int p0 = (r % 16) * 32, k0 = (r / 16) * 64, half = p0 >> 8, up = (p0 >> 7) & 1;
        const float* w = e < 256 ? (up ? P.in[22] : P.in[21]) + (size_t)e * DM * EFF : (up ? P.in[25] : P.in[24]);
        c.src = w + (size_t)(k0 + (lane >> 5)) * EFF + half * 128 + (p0 & 127) + (lane & 31); c.ld = EFF; c.K = 1024;
        c.dst = (bf16*)(ws + WS_W13) + ((size_t)e * 512 + p0) * 1024 + k0; }
    else { r -= 256; const int p0 = (r % 32) * 32, k0 = (r / 32) * 64;
        const float* w = e < 256 ? P.in[23] + (size_t)e * EFF * DM : P.in[26];
        c.src = w + (size_t)(k0 + (lane >> 5)) * DM + p0 + (lane & 31); c.ld = DM; c.K = 256;
        c.dst = (bf16*)(ws + WS_W2) + ((size_t)e * 1024 + p0) * 256 + k0; }
    return c;
}
#ifndef CVV
#define CVV 3
#endif
#ifndef CVP
#define CVP 0
#endif
#define CV_LOAD(t, c) do { _Pragma("unroll") for (int _i = 0; _i < 32; ++_i) { if (CVP == 2 && probe) t[_i] = (float)_i; else if (CVV == 3) t[_i] = __builtin_nontemporal_load((c).src + (size_t)(2 * _i) * (c).ld); else t[_i] = (c).src[(size_t)(2 * _i) * (c).ld]; } } while (0)
#define CV_FINISH(t, c) do { _Pragma("unroll") for (int _i = 0; _i < 32; ++_i) scr[(2 * _i + (lane >> 5)) * 33 + (lane & 31)] = t[_i]; \
        LDS_WAIT(); asm volatile("" ::: "memory"); const int _c = lane & 7; \
        _Pragma("unroll") for (int _j = 0; _j < 4; ++_j) { const int _n = (lane >> 3) + 8 * _j; const LAS float* _s = scr + (8 * _c) * 33 + _n; \
            u32x4 _o; _o.x = cvt_pk_bf16(_s[0 * 33], _s[1 * 33]); _o.y = cvt_pk_bf16(_s[2 * 33], _s[3 * 33]); _o.z = cvt_pk_bf16(_s[4 * 33], _s[5 * 33]); _o.w = cvt_pk_bf16(_s[6 * 33], _s[7 * 33]); \
            if (!(CVP == 1 && probe)) *(u32x4*)((c).dst + (size_t)_n * (c).K + 8 * _c) = _o; else asm volatile("" :: "v"(_o)); } \
        LDS_WAIT(); asm volatile("" ::: "memory"); } while (0)
constexpr int CV_EARLY = 0;
__device__ __forceinline__ void ph0_experts(Frame& F, int r_from, int r_to, bool probe = false) {
    __syncthreads();
    LAS float* scr = (LAS float*)(F.lds + F.wave * 16384);
    const int gw = F.vcu * NWAVES + F.wave, NGW = F.G * NWAVES, lane = F.lane, NIT = 257 * 384;
    const Ptrs& P = F.P;
    float ta[32], tb[32];
    const long lim = (long)gw + (long)(r_to < (1 << 20) ? r_to : (1 << 20)) * NGW; const int NE = (int)(lim < NIT ? lim : NIT);
    int it = gw + r_from * NGW; CvItem ca, cb;
    if (it < NE) { ca = cv_decode(P, it, lane); CV_LOAD(ta, ca); }
    for (; it < NE; it += 2 * NGW) {
        const int it2 = it + NGW, it3 = it + 2 * NGW;
        if (it2 < NE) { cb = cv_decode(P, it2, lane); CV_LOAD(tb, cb); }
        CV_FINISH(ta, ca);
        if (it3 < NE) { ca = cv_decode(P, it3, lane); CV_LOAD(ta, ca); }
        if (it2 < NE) CV_FINISH(tb, cb);
    }
    __syncthreads();
}
#undef CV_LOAD
#undef CV_FINISH
__device__ __forceinline__ void ph1_xn(Frame& F) {
    const Ptrs& P = F.P; unsigned char* ws = P.ws; const int lane = F.lane, wave = F.wave, fr = lane & 15, fq = lane >> 4;
    const float* MODP = (const float*)(ws + WS_MODP);
    for (int idx = F.vcu * 512 + F.tid; idx < 5 * 6144; idx += F.G * 512) { const int r = idx / 6144, j = idx % 6144; float a = P.in[5][j];
#pragma unroll
        for (int kp = 0; kp < 16; ++kp) a += MODP[(size_t)(kp * 5 + r) * 6144 + j];
        ((float*)(ws + WS_MOD))[idx] = a; }
    LAS unsigned char* At = F.lds;
    LAS float* sm = (LAS float*)(F.lds + 32768);
    const int t0 = F.vcu * 64, bl = t0 / SEQ;
    for (int i = F.tid; i < 4096; i += 512) { const int j = i & 2047, mrow = i < 2048 ? bl : 4; float a = P.in[5][j];
#pragma unroll
        for (int kp = 0; kp < 16; ++kp) a += MODP[(size_t)(kp * 5 + mrow) * 6144 + j];
        sm[i] = a; }
    __syncthreads();
    {
        f32x4 v[4], nv[4];
        { const f32x4* xr = (const f32x4*)(P.in[0] + (size_t)(t0 + wave * 8) * DM) + lane;
#pragma unroll
          for (int j = 0; j < 4; ++j) v[j] = xr[64 * j]; }
#pragma unroll 1
        for (int i = 0; i < 8; ++i) {
            const int t = t0 + wave * 8 + i, r = bl * NTOK + NCTX + (t - bl * SEQ);
            { const f32x4* xr = (const f32x4*)(P.in[0] + (size_t)(i < 7 ? t + 1 : t) * DM) + lane;
#pragma unroll
              for (int j = 0; j < 4; ++j) nv[j] = xr[64 * j]; }
            float s = 0.f;
#pragma unroll
            for (int j = 0; j < 4; ++j) s += (v[j][0] * v[j][0] + v[j][1] * v[j][1]) + (v[j][2] * v[j][2] + v[j][3] * v[j][3]);
            const float rs = rsqrtf(wave_sum(s) * (1.f / DM) + EPS);
            u32x2* o8 = (u32x2*)((bf16*)(ws + WS_XN) + (size_t)r * DM) + lane;
#pragma unroll
            for (int j = 0; j < 4; ++j) { const int c = 4 * lane + 256 * j; const f32x4 g = *(const f32x4*)(P.in[6] + c);
                const f32x4 sh = *(const LAS f32x4*)(sm + c), sc = *(const LAS f32x4*)(sm + 1024 + c);
                const f32x4 y = (v[j] * rs * g) * (sc + 1.f) + sh;
                u32x2 w; w.x = cvt_pk_bf16(y[0], y[1]); w.y = cvt_pk_bf16(y[2], y[3]); o8[64 * j] = w; }
#pragma unroll
            for (int j = 0; j < 4; ++j) v[j] = nv[j];
        }
    }
    const int mt = F.vcu >> 2, q = F.vcu & 3, bc = mt >> 4, nc0 = (mt & 15) * 16;
#pragma unroll 1
    for (int i = 0; i < 2; ++i) {
        const int r = 2 * wave + i;
        const f32x4* xr = (const f32x4*)(P.in[2] + ((size_t)bc * NCTX + nc0 + r) * DM) + lane;
        f32x4 v[4]; float s = 0.f;
#pragma unroll
        for (int j = 0; j < 4; ++j) { v[j] = xr[64 * j]; s += (v[j][0] * v[j][0] + v[j][1] * v[j][1]) + (v[j][2] * v[j][2] + v[j][3] * v[j][3]); }
        const float rs = rsqrtf(wave_sum(s) * (1.f / DM) + EPS);
#pragma unroll
        for (int j = 0; j < 4; ++j) { const int c = 4 * lane + 256 * j; const f32x4 g = *(const f32x4*)(P.in[6] + c);
            const f32x4 sh = *(const LAS f32x4*)(sm + 2048 + c), sc = *(const LAS f32x4*)(sm + 3072 + c);
            const f32x4 y = (v[j] * rs * g) * (sc + 1.f) + sh;
            u32x2 w; w.x = cvt_pk_bf16(y[0], y[1]); w.y = cvt_pk_bf16(y[2], y[3]);
            const int ch = (lane >> 1) + 32 * j;
            *(LAS u32x2*)(At + r * 2048 + ((ch ^ r) << 4) + (lane & 1) * 8) = w; }
    }
    __syncthreads();
    {
        const int nt0 = wave < 3 ? 3 * wave : 9 + 2 * (wave - 3), nnt = wave < 3 ? 3 : 2;
        const bf16* wb = (const bf16*)(ws + WS_WCTX) + (size_t)(q * 304 + nt0 * 16 + fr) * 1024 + 8 * fq;
        f32x4 acc[3];
#pragma unroll
        for (int j = 0; j < 3; ++j) acc[j] = (f32x4){0.f, 0.f, 0.f, 0.f};
        bf16x8 bq[4][3], nb[4][3];
#pragma unroll
        for (int u = 0; u < 4; ++u)
#pragma unroll
            for (int j = 0; j < 3; ++j) bq[u][j] = (j < nnt) ? *(const bf16x8*)(wb + (size_t)j * 16 * 1024 + 32 * u) : bf16x8{};
#pragma unroll 1
        for (int k4 = 0; k4 < 8; ++k4) {
            if (k4 < 7) {
#pragma unroll
                for (int u = 0; u < 4; ++u)
#pragma unroll
                    for (int j = 0; j < 3; ++j) nb[u][j] = (j < nnt) ? *(const bf16x8*)(wb + (size_t)j * 16 * 1024 + 32 * (4 * (k4 + 1) + u)) : bf16x8{}; }
#pragma unroll
            for (int u = 0; u < 4; ++u) { const int ch = 4 * (4 * k4 + u) + fq;
                const bf16x8 a = *(const LAS bf16x8*)(At + fr * 2048 + ((ch ^ fr) << 4));
#pragma unroll
                for (int j = 0; j < 3; ++j) acc[j] = __builtin_amdgcn_mfma_f32_16x16x32_bf16(bq[u][j], a, acc[j], 0, 0, 0); }
#pragma unroll
            for (int u = 0; u < 4; ++u)
#pragma unroll
                for (int j = 0; j < 3; ++j) bq[u][j] = nb[u][j];
        }
        const int r = bc * NTOK + nc0 + fr; bf16* P1 = (bf16*)(ws + WS_P1); float ssq = 0.f;
#pragma unroll
        for (int j = 0; j < 3; ++j) if (j < nnt) { const int cp = q * 304 + (nt0 + j) * 16 + 4 * fq, dc = ctx_dstcol(cp);
            if (dc >= 0) { u32x2 w; w.x = cvt_pk_bf16(acc[j][0], acc[j][1]); w.y = cvt_pk_bf16(acc[j][2], acc[j][3]); *(u32x2*)(P1 + (size_t)r * NP1 + dc) = w; }
            if (cp < 128) ssq += (acc[j][0] * acc[j][0] + acc[j][1] * acc[j][1]) + (acc[j][2] * acc[j][2] + acc[j][3] * acc[j][3]); }
        if (q == 0 && wave < 4) { ssq += __shfl_xor(ssq, 16); ssq += __shfl_xor(ssq, 32);
            if (fq == 0) ((float*)(ws + WS_SSQ))[(size_t)r * 8 + 4 + wave] = ssq; }
    }
    __syncthreads();
}
__device__ __forceinline__ void ph6_h2(Frame& F) {
    const Ptrs& P = F.P; unsigned char* ws = P.ws;
    const int gw = F.vcu * NWAVES + F.wave, NGW = F.G * NWAVES;
    f32x4 v[4], nv[4];
    if (gw < MLAT) { const f32x4* xr = (const f32x4*)((const float*)(ws + WS_X1) + (size_t)gw * DM) + F.lane;
#pragma unroll
        for (int j = 0; j < 4; ++j) v[j] = xr[64 * j]; }
    for (int t = gw; t < MLAT; t += NGW) {
        const int b = t / SEQ; const float* md = (const float*)(ws + WS_MOD) + b * 6144;
        { const int tn = t + NGW < MLAT ? t + NGW : t; const f32x4* xr = (const f32x4*)((const float*)(ws + WS_X1) + (size_t)tn * DM) + F.lane;
#pragma unroll
          for (int j = 0; j < 4; ++j) nv[j] = xr[64 * j]; }
        float s = 0.f;
#pragma unroll
        for (int j = 0; j < 4; ++j) s += (v[j][0] * v[j][0] + v[j][1] * v[j][1]) + (v[j][2] * v[j][2] + v[j][3] * v[j][3]);
        const float rs = rsqrtf(wave_sum(s) * (1.f / DM) + EPS);
        u32x2* o8 = (u32x2*)((bf16*)(ws + WS_H2) + (size_t)t * DM) + F.lane;
#pragma unroll
        for (int j = 0; j < 4; ++j) { const int c = 4 * F.lane + 256 * j; const f32x4 g = *(const f32x4*)(P.in[7] + c);
            const f32x4 sh = *(const f32x4*)(md + 3072 + c), sc = *(const f32x4*)(md + 4096 + c);
            const f32x4 y = (v[j] * rs * g) * (sc + 1.f) + sh;
            u32x2 w; w.x = cvt_pk_bf16(y[0], y[1]); w.y = cvt_pk_bf16(y[2], y[3]); o8[64 * j] = w; }
#pragma unroll
        for (int j = 0; j < 4; ++j) v[j] = nv[j];
    }
}
__device__ __forceinline__ void ph7_route(Frame& F) {
    const Ptrs& P = F.P; unsigned char* ws = P.ws; const int lane = F.lane;
    const int gw = F.vcu * NWAVES + F.wave, NGW = F.G * NWAVES;
    const f32x4 bi = ((const f32x4*)P.in[20])[lane];
    for (int t = gw; t < MLAT; t += NGW) {
        f32x4 lg = ((const f32x4*)(ws + WS_LOGP))[(size_t)t * 64 + lane];
#pragma unroll
        for (int kp = 1; kp < 4; ++kp) lg += ((const f32x4*)(ws + WS_LOGP))[((size_t)kp * MLAT + t) * 64 + lane];
        float s[4], v[4];
#pragma unroll
        for (int i = 0; i < 4; ++i) { s[i] = 1.f / (1.f + __expf(-lg[i])); v[i] = s[i] + bi[i]; }
        float m1 = fmaxf(v[0], v[1]), m2 = fminf(v[0], v[1]);
#pragma unroll
        for (int i = 2; i < 4; ++i) { const float x = v[i]; m2 = fmaxf(m2, fminf(m1, x)); m1 = fmaxf(m1, x); }
#pragma unroll
        for (int o = 1; o < 8; o <<= 1) { const float b1 = __shfl_xor(m1, o), b2 = __shfl_xor(m2, o); const float n1 = fmaxf(m1, b1), n2 = fmaxf(fminf(m1, b1), fmaxf(m2, b2)); m1 = n1; m2 = n2; }
        const float gs = m1 + m2; const int g = lane >> 3; int rank = 0;
#pragma unroll
        for (int j = 0; j < 8; ++j) { const float o = __shfl(gs, j * 8); rank += (o > gs || (o == gs && j < g)) ? 1 : 0; }
        if (rank >= 4) { v[0] = v[1] = v[2] = v[3] = -INFINITY; }
        int my_e = 0; float my_s = 0.f, ssum = 0.f;
#pragma unroll
        for (int k = 0; k < 8; ++k) {
            float bv = v[0]; int bi_ = 0;
#pragma unroll
            for (int i = 1; i < 4; ++i) if (v[i] > bv) { bv = v[i]; bi_ = i; }
            int be = lane * 4 + bi_;
#pragma unroll
            for (int o = 1; o < 64; o <<= 1) { const float ov = __shfl_xor(bv, o); const int oe = __shfl_xor(be, o); if (ov > bv || (ov == bv && oe < be)) { bv = ov; be = oe; } }
            const int wl = be >> 2, wi = be & 3;
            float sv = wi == 0 ? s[0] : wi == 1 ? s[1] : wi == 2 ? s[2] : s[3];
            sv = __shfl(sv, wl);
            if (lane == wl) { if (wi == 0) v[0] = -INFINITY; else if (wi == 1) v[1] = -INFINITY; else if (wi == 2) v[2] = -INFINITY; else v[3] = -INFINITY; }
            ssum += sv; if (lane == k) { my_e = be; my_s = sv; }
        }
        if (lane < 8) {
            int* cnt = (int*)(ws + WS_CTL) + CW_COUNT;
            const int rk = atomicAdd(&cnt[my_e], 1);
            ((int*)(ws + WS_EIDX))[(size_t)t * 8 + lane] = my_e;
            ((float*)(ws + WS_EW))[(size_t)t * 8 + lane] = my_s / ssum * 2.5f;
            ((int*)(ws + WS_ERANK))[(size_t)t * 8 + lane] = rk;
        }
    }
}
__device__ __forceinline__ void ph_route3(Frame& F) {
    const Ptrs& P = F.P; unsigned char* ws = P.ws; const int lane = F.lane, wave = F.wave, fr = lane & 15, fq = lane >> 4;
    LAS unsigned char* At = F.lds;
    const bf16* Wr = (const bf16*)(ws + WS_WR);
    const f32x4 bi = ((const f32x4*)P.in[20])[lane];
    for (int grp = F.vcu; grp < MLAT / 64; grp += F.G) {
        const int t0 = grp * 64, b = t0 / SEQ; const float* md = (const float*)(ws + WS_MOD) + b * 6144;
        u32x4 v[2], nv[2];
        { const u32x4* xr = (const u32x4*)((const bf16*)(ws + WS_X1) + (size_t)(t0 + wave * 8) * DM) + lane; v[0] = xr[0]; v[1] = xr[64]; }
#pragma unroll 1
        for (int i = 0; i < 8; ++i) {
            const int r = wave * 8 + i, t = t0 + r;
            { const int rn = i < 7 ? t + 1 : t; const u32x4* xr = (const u32x4*)((const bf16*)(ws + WS_X1) + (size_t)rn * DM) + lane; nv[0] = xr[0]; nv[1] = xr[64]; }
            float xf[2][8]; float s = 0.f;
#pragma unroll
            for (int h = 0; h < 2; ++h)
#pragma unroll
                for (int d = 0; d < 4; ++d) { xf[h][2 * d] = bflo(v[h][d]); xf[h][2 * d + 1] = bfhi(v[h][d]); s += xf[h][2 * d] * xf[h][2 * d] + xf[h][2 * d + 1] * xf[h][2 * d + 1]; }
            const float rs = rsqrtf(wave_sum(s) * (1.f / DM) + EPS);
#pragma unroll
            for (int h = 0; h < 2; ++h) { const int c = 8 * lane + 512 * h; f32x4 y[2];
#pragma unroll
                for (int q = 0; q < 2; ++q) { const f32x4 g = *(const f32x4*)(P.in[7] + c + 4 * q), sh = *(const f32x4*)(md + 3072 + c + 4 * q), sc = *(const f32x4*)(md + 4096 + c + 4 * q);
                    const f32x4 xv = {xf[h][4 * q], xf[h][4 * q + 1], xf[h][4 * q + 2], xf[h][4 * q + 3]}; y[q] = (xv * rs * g) * (sc + 1.f) + sh; }
                const u32x4 w = pack8(y[0], y[1]);
                *(u32x4*)((bf16*)(ws + WS_H2) + (size_t)t * DM + c) = w;
                const int ch = lane + 64 * h;
                *(LAS u32x4*)(At + r * 2048 + ((ch ^ (r & 15)) << 4)) = w; }
            v[0] = nv[0]; v[1] = nv[1];
        }
        __syncthreads();
        f32x4 acc[4][2];
#pragma unroll
        for (int m = 0; m < 4; ++m) { acc[m][0] = (f32x4){0.f, 0.f, 0.f, 0.f}; acc[m][1] = (f32x4){0.f, 0.f, 0.f, 0.f}; }
        const bf16* wb = Wr + (size_t)(wave * 32 + fr) * 1024 + 8 * fq;
        bf16x8 bq[4][4][2];
#define R3_LOAD(set, kb) do { _Pragma("unroll") for (int u = 0; u < 4; ++u) { bq[set][u][0] = *(const bf16x8*)(wb + 32 * (4 * (kb) + u)); bq[set][u][1] = *(const bf16x8*)(wb + 16 * 1024 + 32 * (4 * (kb) + u)); } } while (0)
        R3_LOAD(0, 0); R3_LOAD(1, 1); R3_LOAD(2, 2);
#pragma unroll
        for (int k4 = 0; k4 < 8; ++k4) {
            if (k4 + 3 < 8) R3_LOAD((k4 + 3) & 3, k4 + 3);
#pragma unroll
            for (int u = 0; u < 4; ++u) { const int ks = 4 * k4 + u, ch = 4 * ks + fq;
#pragma unroll
                for (int m = 0; m < 4; ++m) { const int r = 16 * m + fr;
                    const bf16x8 a = *(const LAS bf16x8*)(At + r * 2048 + ((ch ^ (r & 15)) << 4));
                    acc[m][0] = __builtin_amdgcn_mfma_f32_16x16x32_bf16(bq[k4 & 3][u][0], a, acc[m][0], 0, 0, 0);
                    acc[m][1] = __builtin_amdgcn_mfma_f32_16x16x32_bf16(bq[k4 & 3][u][1], a, acc[m][1], 0, 0, 0); } }
        }
#undef R3_LOAD
        __syncthreads();
        LAS float* Lg = (LAS float*)F.lds;
#pragma unroll
        for (int m = 0; m < 4; ++m)
#pragma unroll
            for (int n = 0; n < 2; ++n) *(LAS f32x4*)(Lg + (16 * m + fr) * 260 + wave * 32 + 16 * n + 4 * fq) = acc[m][n];
        __syncthreads();
#pragma unroll 1
        for (int i = 0; i < 8; ++i) {
            const int r = wave * 8 + i, t = t0 + r;
            const f32x4 lg = *(const LAS f32x4*)(Lg + r * 260 + 4 * lane);
            float s[4], vv[4];
#pragma unroll
            for (int q = 0; q < 4; ++q) { s[q] = 1.f / (1.f + __expf(-lg[q])); vv[q] = s[q] + bi[q]; }
            float m1 = fmaxf(vv[0], vv[1]), m2 = fminf(vv[0], vv[1]);
#pragma unroll
            for (int q = 2; q < 4; ++q) { const float x = vv[q]; m2 = fmaxf(m2, fminf(m1, x)); m1 = fmaxf(m1, x); }
#pragma unroll
            for (int o = 1; o < 8; o <<= 1) { const float b1 = __shfl_xor(m1, o), b2 = __shfl_xor(m2, o); const float n1 = fmaxf(m1, b1), n2 = fmaxf(fminf(m1, b1), fmaxf(m2, b2)); m1 = n1; m2 = n2; }
            const float gs = m1 + m2; const int g = lane >> 3; int rank = 0;
#pragma unroll
            for (int j = 0; j < 8; ++j) { const float o = __builtin_bit_cast(float, __builtin_amdgcn_readlane(__builtin_bit_cast(int, gs), j * 8)); rank += (o > gs || (o == gs && j < g)) ? 1 : 0; }
            unsigned key[4];
#pragma unroll
            for (int q = 0; q < 4; ++q) key[q] = rank >= 4 ? 0u : ((__builtin_bit_cast(unsigned, vv[q] + 1.f) & 0xFFFFFF00u) | (unsigned)(255 - (lane * 4 + q)));
            int my_e = 0; float my_s = 0.f, ssum = 0.f;
#pragma unroll
            for (int k = 0; k < 8; ++k) {
                unsigned kb = max(max(key[0], key[1]), max(key[2], key[3]));
                kb = max(kb, (unsigned)__builtin_amdgcn_update_dpp(0, (int)kb, 0x111, 0xf, 0xf, false));
                kb = max(kb, (unsigned)__builtin_amdgcn_update_dpp(0, (int)kb, 0x112, 0xf, 0xf, false));
                kb = max(kb, (unsigned)__builtin_amdgcn_update_dpp(0, (int)kb, 0x114, 0xf, 0xf, false));
                kb = max(kb, (unsigned)__builtin_amdgcn_update_dpp(0, (int)kb, 0x118, 0xf, 0xf, false));
                kb = max(kb, (unsigned)__builtin_amdgcn_update_dpp(0, (int)kb, 0x142, 0xa, 0xf, false));
                kb = max(kb, (unsigned)__builtin_amdgcn_update_dpp(0, (int)kb, 0x143, 0xc, 0xf, false));
                const unsigned kw = (unsigned)__builtin_amdgcn_readlane((int)kb, 63);
                const int be = 255 - (int)(kw & 255u), wl = be >> 2, wi = be & 3;
                const float ssel = wi == 0 ? s[0] : wi == 1 ? s[1] : wi == 2 ? s[2] : s[3];
                const float sv = __builtin_bit_cast(float, __builtin_amdgcn_readlane(__builtin_bit_cast(int, ssel), wl));
#pragma unroll
                for (int q = 0; q < 4; ++q) key[q] = key[q] == kw ? 0u : key[q];
                ssum += sv; if (lane == k) { my_e = be; my_s = sv; }
            }
            if (lane < 8) {
                int* cnt = (int*)(ws + WS_CTL) + CW_COUNT;
                const int rk = atomicAdd(&cnt[my_e], 1);
                ((int*)(ws + WS_EIDX))[(size_t)t * 8 + lane] = my_e;
                ((float*)(ws + WS_EW))[(size_t)t * 8 + lane] = my_s / ssum * 2.5f;
                ((int*)(ws + WS_ERANK))[(size_t)t * 8 + lane] = rk;
            }
        }
        __syncthreads();
    }
}
__device__ __forceinline__ void ph8_slots(Frame& F) {
    const Ptrs& P = F.P; unsigned char* ws = P.ws;
    LAS int* off = (LAS int*)F.lds;
    LAS int* cfs = off + 260;
    LAS int* chs = off + 520;
    unsigned* cnt = (unsigned*)(ws + WS_CTL) + CW_COUNT;
    if (F.wave == 0) { const int lane = F.lane; int n[4], cf[4], ch[4], sn = 0, sf = 0, sh = 0;
#pragma unroll
        for (int i = 0; i < 4; ++i) { n[i] = (int)cnt[4 * lane + i]; const int r = n[i] & 255; cf[i] = (n[i] >> 8) + (r > 128 ? 1 : 0); ch[i] = (r > 0 && r <= 128) ? 1 : 0; sn += n[i]; sf += cf[i]; sh += ch[i]; }
        int in = sn, jf = sf, jh = sh;
#pragma unroll
        for (int o = 1; o < 64; o <<= 1) { const int tn = __shfl_up(in, o), tf = __shfl_up(jf, o), th = __shfl_up(jh, o); if (lane >= o) { in += tn; jf += tf; jh += th; } }
        int an = in - sn, af = jf - sf, ah = jh - sh;
#pragma unroll
        for (int i = 0; i < 4; ++i) { off[4 * lane + i] = an; cfs[4 * lane + i] = af; chs[4 * lane + i] = ah; an += n[i]; af += cf[i]; ah += ch[i]; }
        if (lane == 63) { off[256] = an; cfs[256] = af; chs[256] = ah; off[257] = NSLOT; cfs[257] = af + MLAT / 256; chs[257] = ah; } }
    __syncthreads();
    for (int idx = F.vcu * 512 + F.tid; idx < MLAT * 8; idx += F.G * 512) {
        const int e = ((const int*)(ws + WS_EIDX))[idx], rk = ((const int*)(ws + WS_ERANK))[idx];
        const int slot = off[e] + rk;
        ((int*)(ws + WS_SLOTOF))[idx] = slot; ((int*)(ws + WS_SLOTTOK))[slot] = idx >> 3; ((float*)(ws + WS_SLOTW))[slot] = ((const float*)(ws + WS_EW))[idx];
        if (idx < MLAT) { ((int*)(ws + WS_SLOTTOK))[MLAT * 8 + idx] = idx; ((float*)(ws + WS_SLOTW))[MLAT * 8 + idx] = 1.f; }
    }
    if (F.vcu == 0) {
        int* go = (int*)(ws + WS_OFF); int* ut = (int*)(ws + WS_UT);
        const int nfull = cfs[257];
        for (int e = F.tid; e < 258; e += 512) go[e] = off[e];
        for (int e = F.tid; e < 257; e += 512) { const int n = off[e + 1] - off[e], nf = cfs[e + 1] - cfs[e], nh = chs[e + 1] - chs[e];
            for (int j = 0; j < nf; ++j) { int* u = ut + (cfs[e] + j) * 4; u[0] = e; u[1] = off[e] + j * 256; u[2] = min(256, n - j * 256); u[3] = 0; }
            if (nh) { int* u = ut + (nfull + chs[e]) * 4; u[0] = e; u[1] = off[e] + nf * 256; u[2] = n - nf * 256; u[3] = 0; } }
        if (F.tid == 0) { ((int*)(ws + WS_CTL))[CW_NUNIT] = nfull + chs[257]; ((int*)(ws + WS_CTL))[CW_NFULL] = nfull; }
    }
    __syncthreads();
}
__device__ __forceinline__ void ph11_combine(Frame& F) {
    const Ptrs& P = F.P; unsigned char* ws = P.ws; const int lane = F.lane;
    const int gw = F.vcu * NWAVES + F.wave, NGW = F.G * NWAVES;
    const unsigned char* Y = (const unsigned char*)(ws + WS_Y);
    const int cbase = 256 * (lane >> 4) + 32 * ((lane >> 2) & 3) + 8 * (lane & 3);
    u32x4 yw[9], nyw[9]; u32x4 xw[2], nxw[2]; int nsl[8];
    auto ldslots = [&](int t) {
#pragma unroll
        for (int k = 0; k < 8; ++k) nsl[k] = ((const int*)(ws + WS_SLOTOF))[(size_t)t * 8 + k]; };
    auto ldrows = [&](int t) {
#pragma unroll
        for (int k = 0; k < 9; ++k) { const int sl = k < 8 ? nsl[k] : MLAT * 8 + t; nyw[k] = *(const u32x4*)(Y + (size_t)sl * DM + lane * 16); }
        nxw[0] = *(const u32x4*)((const bf16*)(ws + WS_X1) + (size_t)t * DM + cbase); nxw[1] = *(const u32x4*)((const bf16*)(ws + WS_X1) + (size_t)t * DM + cbase + 128); };
    if (gw < MLAT) { ldslots(gw); ldrows(gw); if (gw + NGW < MLAT) ldslots(gw + NGW); }
    for (int t = gw; t < MLAT; t += NGW) {
        const int b = t / SEQ; const float* gt2 = (const float*)(ws + WS_MOD) + b * 6144 + 5120;
#pragma unroll
        for (int k = 0; k < 9; ++k) yw[k] = nyw[k];
        xw[0] = nxw[0]; xw[1] = nxw[1];
        if (t + NGW < MLAT) { ldrows(t + NGW); if (t + 2 * NGW < MLAT) ldslots(t + 2 * NGW); }
        float a[16];
#pragma unroll
        for (int i = 0; i < 16; ++i) a[i] = 0.f;
#pragma unroll
        for (int k = 0; k < 9; ++k)
#pragma unroll
            for (int d = 0; d < 4; ++d) { const int w = (int)yw[k][d];
                const f32x2 lo = __builtin_amdgcn_cvt_pk_f32_fp8(w, false), hi = __builtin_amdgcn_cvt_pk_f32_fp8(w, true);
                a[4 * d + 0] += lo[0]; a[4 * d + 1] += lo[1]; a[4 * d + 2] += hi[0]; a[4 * d + 3] += hi[1]; }
        float ss = 0.f;
#pragma unroll
        for (int q = 0; q < 4; ++q) { const int c = cbase + (q >> 1) * 128 + (q & 1) * 4; const u32x4 xb = xw[q >> 1]; const unsigned x01 = (q & 1) ? xb.z : xb.x, x23 = (q & 1) ? xb.w : xb.y;
            const f32x4 xv = {bflo(x01), bfhi(x01), bflo(x23), bfhi(x23)}, gv = *(const f32x4*)(gt2 + c);
#pragma unroll
            for (int e = 0; e < 4; ++e) { const float v = xv[e] + gv[e] * (a[q * 4 + e] * (1.f / YSCALE)); a[q * 4 + e] = v; ss += v * v; } }
        const float rs = rsqrtf(wave_sum(ss) * (1.f / DM) + EPS);
#pragma unroll
        for (int q = 0; q < 4; ++q) { const int c = cbase + (q >> 1) * 128 + (q & 1) * 4; const f32x4 gf = *(const f32x4*)(P.in[27] + c);
            f32x4 o;
#pragma unroll
            for (int e = 0; e < 4; ++e) o[e] = a[q * 4 + e] * rs * gf[e];
            *(f32x4*)(P.out + (size_t)t * DM + c) = o; }
    }
}
__device__ __forceinline__ void ph4b_diff_finish(Frame& F) {
    const Ptrs& P = F.P; unsigned char* ws = P.ws; const int lane = F.lane;
    const int gw = F.vcu * NWAVES + F.wave, NGW = F.G * NWAVES;
    float d1 = P.in[13][lane] * P.in[14][lane], d2 = P.in[15][lane] * P.in[16][lane];
    d1 = wave_sum(d1); d2 = wave_sum(d2);
    const float lam = __expf(d1) - __expf(d2) + LAM_INIT;
    const float g0 = P.in[17][lane], g1 = P.in[17][64 + lane];
    for (int t = gw; t < MLAT; t += NGW) {
        const float* os = (const float*)(ws + WS_OS) + (size_t)t * 8 * 128;
        float x[4][4];
#pragma unroll
        for (int h = 0; h < 4; ++h) { x[h][0] = os[(2 * h) * 128 + lane]; x[h][1] = os[(2 * h) * 128 + 64 + lane]; x[h][2] = os[(2 * h + 1) * 128 + lane]; x[h][3] = os[(2 * h + 1) * 128 + 64 + lane]; }
#pragma unroll
        for (int h = 0; h < 4; ++h) {
            const float v0 = x[h][0] - lam * x[h][2], v1 = x[h][1] - lam * x[h][3];
            const float rs = rsqrtf(wave_sum(v0 * v0 + v1 * v1) * (1.f / 128.f) + EPS) * (1.f - LAM_INIT);
            bf16* mo = (bf16*)(ws + WS_MIX) + (size_t)t * DM + 512 + h * 128;
            mo[lane] = (bf16)f2bf(v0 * rs * g0); mo[64 + lane] = (bf16)f2bf(v1 * rs * g1); }
    }
}

#ifdef PROBE_UNITS
struct ProbeOrder { int n, c; __device__ bool next(int i, Unit& u) const { if (i >= n) return false; u.pm = (c * n + i) % 60; u.pn = (c + i) % 8; u.r0 = u.pm * 256; u.nv = 256; u.k0 = 0; return true; }
    __device__ __forceinline__ int a_row(const Unit& u, int r) const { return u.pm * 256 + r; } };
struct EpiProbe { static constexpr bool PERM = true; bf16* O; int mode;
    __device__ __forceinline__ void operator()(const Acc& acc, const Unit& u, int wr, int wc, int fr, int fq) const {
        if (mode == 0) {
#pragma unroll
            for (int ai = 0; ai < 2; ++ai)
#pragma unroll
                for (int bj = 0; bj < 2; ++bj)
#pragma unroll
                    for (int m = 0; m < 4; ++m) { asm volatile("" :: "v"(acc[ai][bj][m][0]), "v"(acc[ai][bj][m][1])); }
        } else {
            const int row0 = u.pm * 256 + wr * 64 + fr, col0 = u.pn * 256 + (mode == 2 ? wc * 64 : wc * 32) + 8 * fq; const int bjo = mode == 2 ? 32 : 128;
#pragma unroll
            for (int ai = 0; ai < 2; ++ai)
#pragma unroll
                for (int m = 0; m < 4; ++m) { if (mode == 7 && (ai | m)) { asm volatile("" :: "v"(acc[ai][0][m][0]), "v"(acc[ai][0][m][1]), "v"(acc[ai][1][m][0]), "v"(acc[ai][1][m][1])); continue; } bf16* rowp = mode == 8 ? O + (size_t)u.pm * 256 * NP1 + (size_t)(((wr * 4 + wc) * 8 + ai * 4 + m) * 2) * 512 + (fq * 16 + fr) * 8 : mode == 4 ? O + (size_t)blockIdx.x * 65536 + (size_t)(wr * 64 + fr + ai * 128 + m * 16) * 256 + wc * 32 + 8 * fq : O + (size_t)(row0 + ai * 128 + m * 16) * (mode == 3 ? NP1 + 64 : NP1) + col0;
                    *(u32x4*)(rowp) = pack8(acc[ai][0][m][0], acc[ai][0][m][1]); *(u32x4*)(rowp + (mode == 8 ? 512 : mode == 4 ? 128 : bjo)) = pack8(acc[ai][1][m][0], acc[ai][1][m][1]); }
        }
    }
};
#endif

enum { P_PREP = 0, P_XN, P_INPROJ, P_UP, P_ATTN, P_DIFFFIN, P_OUT, P_H2, P_ROUTER, P_ROUTE, P_SLOTS, P_EXP1, P_EXP2, P_COMB, P_PROBE, P_END };
struct Args { Ptrs P; int ph_lo, ph_hi, li, pad; };
__global__ void __launch_bounds__(NWAVES * 64, 2) mk_fwd(Args args) {
    extern __shared__ __attribute__((aligned(16))) unsigned char lds[];
    Frame F;
    F.lds = (LAS unsigned char*)lds; F.MISC = (volatile LAS unsigned*)(F.lds + MISC_OFF);
    F.tid = threadIdx.x; F.lane = F.tid & 63; F.wave = __builtin_amdgcn_readfirstlane(F.tid >> 6);
    F.G = gridDim.x; { const int bx = blockIdx.x; F.vcu = (F.G % 8 == 0) ? (bx % 8) * (F.G / 8) + bx / 8 : bx; }
    F.P = args.P; unsigned char* ws = args.P.ws; F.ctl = (unsigned*)(ws + WS_CTL);
    for (int u = F.tid; u < (LDS_BYTES - LDSCTL_OFF) / 4; u += NWAVES * 64) ((LAS unsigned*)(F.lds + LDSCTL_OFF))[u] = 0u;
    __syncthreads();
    XcdBarrier bar = xcd_barrier_post(F.ctl + CW_BAR + args.li * XCD_BAR_WORDS, F.MISC + 8);
    const int lo = args.ph_lo, hi = args.ph_hi;
#ifndef PHMASK
#define PHMASK 0xFFFF
#endif
#define IN(k) ((((PHMASK) >> (k)) & 1) && lo <= (k) && (k) < hi)
#define SKEW(ticks) do { const unsigned long long t0_ = __builtin_amdgcn_s_memrealtime(); const unsigned long long w_ = (unsigned long long)((F.vcu & 3) * (ticks)); while (__builtin_amdgcn_s_memrealtime() - t0_ < w_) __builtin_amdgcn_s_sleep(8); } while (0)
#define SEAM(k) do { if (IN(k) && IN((k) + 1)) xcd_barrier(bar); } while (0)
#define SEAM_SKIP1(k) do { if (IN(k) && IN((k) + 2)) xcd_barrier(bar); } while (0)
#define SEAM_SKIP2(k) do { if (IN(k) && IN((k) + 3)) xcd_barrier(bar); } while (0)
    if (IN(P_PREP)) { ph0_prep(F); } SEAM(P_PREP);
    if (IN(P_XN)) { ph1_xn(F); } SEAM(P_XN);
    if (IN(P_INPROJ)) {
        pg8::Gemm g{(const bf16*)(ws + WS_XN), (const bf16*)(ws + WS_WIN), 1024, 1024, 1024}; LatOrder S; S.init(MLAT, NP1, F.G, (int)blockIdx.x);
        EpiInProj E{(bf16*)(ws + WS_P1), (float*)(ws + WS_SSQ), (const float2*)(ws + WS_TAB), (const float2*)(ws + WS_TAB) + 1024};
#ifdef SKEW_INPROJ
        SKEW(SKEW_INPROJ);
#endif
        pg8::gemm_phase(F.lds, g, S, E);
        if (CV_EARLY > 0 && (int)blockIdx.x >= (MALL / 256) * (NP1 / 256) - 2 * F.G) ph0_experts(F, 0, CV_EARLY);
    } SEAM(P_INPROJ);
    if (IN(P_UP)) {
        pg8::Gemm g{(const bf16*)(ws + WS_P1), (const bf16*)(ws + WS_WUP), 2048, 384, 256}; UpOrder S{F.G, F.vcu};
        EpiUp E{(bf16*)(ws + WS_QM), (bf16*)(ws + WS_KVM), (const float*)(ws + WS_SSQ), (const float2*)(ws + WS_TAB) + 1024};
        pg8::gemm_phase(F.lds, g, S, E);
    } SEAM(P_UP);
    if (IN(P_ATTN)) {
        const bf16* P1 = (const bf16*)(ws + WS_P1); const bf16* QM = (const bf16*)(ws + WS_QM); const bf16* KVM = (const bf16*)(ws + WS_KVM);
        const int cslot = F.vcu % 5; int ui = 0;
        bool conv_done = false; int U = F.vcu;
        const int conv_from = ((int)blockIdx.x >= (MALL / 256) * (NP1 / 256) - 2 * F.G) ? CV_EARLY : 0;
        for (; U < 512; U += F.G, ++ui) {
            if (ui == cslot) { ph0_experts(F, conv_from, 1 << 30); conv_done = true; }
            const int bh = U >> 4, qb = U & 15, b = bh >> 3, hh = bh & 7;
            const bf16* K0 = KVM + (size_t)b * NTOK * 1024 + hh * 128;
            attn::unit<0, 0>(QM + (size_t)(b * NTOK + NCTX + qb * 256) * 768 + hh * 96, K0, P1 + (size_t)b * NTOK * NP1 + 384, K0 + 64,
                             (bf16*)(ws + WS_MIX) + (size_t)(b * SEQ + qb * 256) * DM + hh * 64, DM, F.lds_c(), nullptr, 0.f, nullptr);
        }
        char* stash = (char*)(ws + WS_OS) + (size_t)F.vcu * 65536;
        const int Ud0 = U;
        for (; U < 768; U += 1024, ++ui) {
            if (ui == cslot) { ph0_experts(F, conv_from, 1 << 30); conv_done = true; }
            const int Up = U - 512, bh = Up >> 4, qb = Up & 15, b = bh >> 2, h = bh & 3;
            const bf16* Pb = P1 + (size_t)b * NTOK * NP1;
            attn::unit<1, 1>(P1 + (size_t)(b * NTOK + NCTX + qb * 256) * NP1 + 512 + (2 * h) * 64, Pb + 1024 + (2 * h) * 64, nullptr, Pb + 1536 + h * 128, nullptr, 0, F.lds_c(),
                             stash, 0.f, nullptr);
        }
        for (U = Ud0; U < 768; U += 1024, ++ui) {
            if (ui == cslot) { ph0_experts(F, conv_from, 1 << 30); conv_done = true; }
            const int Up = U - 512, bh = Up >> 4, qb = Up & 15, b = bh >> 2, h = bh & 3;
            const bf16* Pb = P1 + (size_t)b * NTOK * NP1;
            float lam; { float d1 = F.P.in[13][F.lane] * F.P.in[14][F.lane], d2 = F.P.in[15][F.lane] * F.P.in[16][F.lane]; d1 = wave_sum(d1); d2 = wave_sum(d2); lam = __expf(d1) - __expf(d2) + LAM_INIT; }
            attn::unit<1, 2>(P1 + (size_t)(b * NTOK + NCTX + qb * 256) * NP1 + 512 + (2 * h + 1) * 64, Pb + 1024 + (2 * h + 1) * 64, nullptr, Pb + 1536 + h * 128,
                             (bf16*)(ws + WS_MIX) + (size_t)(b * SEQ + qb * 256) * DM + 512 + h * 128, DM, F.lds_c(), stash, lam, F.P.in[17]);
        }
        if (!conv_done) ph0_experts(F, conv_from, 1 << 30);
#ifdef CONV_PROBE
        if (F.vcu % 5 == 0) ph0_experts(F, 0, 1 << 30, true);
#endif

    } SEAM_SKIP1(P_ATTN);
#ifdef ATTN_PROBE
    if (IN(P_DIFFFIN)) { const bf16* P1 = (const bf16*)(ws + WS_P1); const bf16* QM = (const bf16*)(ws + WS_QM); const bf16* KVM = (const bf16*)(ws + WS_KVM);
        { const int Upr = F.vcu, bh = Upr >> 4, qb = Upr & 15, b = bh >> 3, hh = bh & 7;
          const bf16* K0 = KVM + (size_t)b * NTOK * 1024 + hh * 128;
          attn::unit<ATTN_PROBE_MODE, 0, ATTN_PROBE>(ATTN_PROBE_MODE == 0 ? QM + (size_t)(b * NTOK + NCTX + qb * 256) * 768 + hh * 96 : P1 + (size_t)(b * NTOK + NCTX + qb * 256) * NP1 + 512 + hh * 64,
                             ATTN_PROBE_MODE == 0 ? K0 : P1 + (size_t)b * NTOK * NP1 + 1024 + hh * 64, P1 + (size_t)b * NTOK * NP1 + 384, ATTN_PROBE_MODE == 0 ? K0 + 64 : P1 + (size_t)b * NTOK * NP1 + 1536 + (hh >> 1) * 128,
                             (bf16*)(ws + WS_TMP) + (size_t)Upr * 256 * DM, DM, F.lds_c(), nullptr, 0.f, nullptr); } }
#endif
    if (IN(P_OUT)) {
        pg8::Gemm g{(const bf16*)(ws + WS_MIX), (const bf16*)(ws + WS_WOUT), 1024, 1024, 1024}; pg8::StaticOrder S; S.init(MLAT, DM, F.G, (int)blockIdx.x);
        EpiOut E{F.P.in[0], (const float*)(ws + WS_MOD), (bf16*)(ws + WS_X1)};
        pg8::gemm_phase(F.lds, g, S, E);
    } SEAM(P_OUT);
    if (IN(P_H2)) { ph_route3(F); } SEAM_SKIP2(P_H2);
    if (IN(P_SLOTS)) { ph8_slots(F); } SEAM(P_SLOTS);
    if (IN(P_EXP1)) {
        const int nu = (int)xb_ld(F.ctl + CW_NUNIT), nfu = (int)xb_ld(F.ctl + CW_NFULL); LAS int* uc = (LAS int*)(F.lds + UCACHE_OFF);
        const int nmine = exp_units_to_lds<2>(uc, (const int*)(ws + WS_UT), nu, nfu, F.G, F.vcu);
        pg8::Gemm g{(const bf16*)(ws + WS_H2), (const bf16*)(ws + WS_W13), 1024, 1024, 1024};
        ExpSched<2, true> S{uc, nmine, (const int*)(ws + WS_SLOTTOK)};
        EpiAct E{(bf16*)(ws + WS_ACT), (const float*)(ws + WS_SLOTW)};
#ifdef SKEW_EXP1
        SKEW(SKEW_EXP1);
#endif
        pg8::gemm_phase(F.lds, g, S, E);
    } SEAM(P_EXP1);
    if (IN(P_EXP2)) {
        const int nu = (int)xb_ld(F.ctl + CW_NUNIT), nfu = (int)xb_ld(F.ctl + CW_NFULL); LAS int* uc = (LAS int*)(F.lds + UCACHE_OFF);
        const int nmine = exp_units_to_lds<4>(uc, (const int*)(ws + WS_UT), nu, nfu, F.G, F.vcu);
        pg8::Gemm g{(const bf16*)(ws + WS_ACT), (const bf16*)(ws + WS_W2), 256, 256, 256};
        ExpSched<4, false> S{uc, nmine, nullptr};
        EpiY E{(unsigned char*)(ws + WS_Y)};
#ifdef SKEW_EXP2
        SKEW(SKEW_EXP2);
#endif
        pg8::gemm_phase(F.lds, g, S, E);
    } SEAM(P_EXP2);
    if (IN(P_COMB)) { ph11_combine(F); } SEAM(P_COMB);
#ifdef PROBE_UNITS
    if (IN(P_PROBE)) {
        pg8::Gemm g{(const bf16*)(ws + WS_P1), (const bf16*)(ws + WS_WIN), 2048, 1024, PROBE_K}; ProbeOrder S{PROBE_UNITS, F.vcu};
        EpiProbe E{(bf16*)(ws + WS_TMP), PROBE_EPI};
        pg8::gemm_phase(F.lds, g, S, E);
    }
#endif
#undef IN
#undef SEAM
}

static int g_grid = 0;
static int mk_setup() {
    if (g_grid) return g_grid;
    int dev = 0, cus = 0;
    if (hipGetDevice(&dev) != hipSuccess || hipDeviceGetAttribute(&cus, hipDeviceAttributeMultiprocessorCount, dev) != hipSuccess) { fprintf(stderr, "kernel_launch: device query failed\n"); g_grid = -1; return -1; }
    if (hipFuncSetAttribute((const void*)mk_fwd, hipFuncAttributeMaxDynamicSharedMemorySize, LDS_BYTES) != hipSuccess) { fprintf(stderr, "kernel_launch: hipFuncSetAttribute failed\n"); g_grid = -1; return -1; }
    int per_cu = 0;
    if (hipOccupancyMaxActiveBlocksPerMultiprocessor(&per_cu, (const void*)mk_fwd, NWAVES * 64, LDS_BYTES) != hipSuccess || per_cu < 1) { fprintf(stderr, "kernel_launch: occupancy query says %d blocks/CU\n", per_cu); }
    (void)hipGetLastError();
    if (cus != 256) { fprintf(stderr, "kernel_launch: this build's work split assumes a 256-CU device (found %d CUs); nothing launched\n", cus); g_grid = -1; return -1; }
    g_grid = cus;
    return g_grid;
}
static void mk_run(const Ptrs& P, int lo, int hi, int li, hipStream_t stream) {
    Args a{}; a.P = P; a.ph_lo = lo; a.ph_hi = hi; a.li = li; a.pad = 0;
    hipLaunchKernelGGL(mk_fwd, dim3(g_grid), dim3(NWAVES * 64), LDS_BYTES, stream, a);
}
extern "C" void kernel_launch(void* const* d_in, const int* in_sizes, int n_in, void* d_out, int out_size, void* d_ws, size_t ws_size, hipStream_t stream) {
    if (n_in != 28 || out_size != MLAT * DM || ws_size < WS_END) { fprintf(stderr, "kernel_launch: unexpected shapes n_in %d out %d ws %zu\n", n_in, out_size, ws_size); return; }
    if (mk_setup() <= 0) return;
    Ptrs P{}; for (int i = 0; i < 28; ++i) P.in[i] = (const float*)d_in[i]; P.out = (float*)d_out; P.ws = (unsigned char*)d_ws;
    (void)hipMemsetAsync((char*)d_ws + WS_CTL, 0, 1 * MiB, stream);
    int li = 0;
#define FAST(lo, hi) mk_run(P, lo, hi, li++, stream)
    FAST(P_PREP, (defs_probe ? P_PROBE : P_COMB) + 1);
#undef FAST
}
```
